# Optimizing an MI355X kernel written in HIP

```python
import math
import jax, jax.numpy as jnp
from jax import lax
import numpy as np

D_MODEL = 1024
BATCH = 1
SEQ = 16384
DEPTH = 2

PLE_DIM = 256
N_MIXERS = 4
GROUP_W = 256
MIX_W = N_MIXERS * GROUP_W
EPS = 1e-6
CONV_K = 4
RET_HEADS = 4
RET_HD = GROUP_W // RET_HEADS
RET_CHUNK = 128
ROPE_BASE = 10000.0
LRU_BLOCKS = 4
LRU_BW = GROUP_W // LRU_BLOCKS
LRU_C = 8.0
S5_GW = 16
S5_GROUPS = GROUP_W // S5_GW
S5_STATE = 64
GDN_HEADS = 4
GDN_HD = GROUP_W // GDN_HEADS
GDN_CHUNK = 64
PEER_HEADS = 8
PEER_NKEYS = 128
PEER_N = PEER_NKEYS * PEER_NKEYS
PEER_DKEY = 128
PEER_HALF = PEER_DKEY // 2
PEER_TOPK = 16
PEER_BLOCK = 128

IN_SIZES = (GROUP_W, GROUP_W, GROUP_W, GROUP_W,
            GROUP_W, GROUP_W,
            GROUP_W,
            3 * GROUP_W, GDN_HEADS, GDN_HEADS, GROUP_W)
IN_W = sum(IN_SIZES)
IN_SPLITS = [int(c) for c in np.cumsum(IN_SIZES)[:-1]]

kernel_name = 'hybrid_retention_rglru_s5_gdn_peer'


def rmsnorm(x, g):
    xf = x.astype(jnp.float32)
    y = xf * lax.rsqrt(jnp.mean(xf * xf, axis=-1, keepdims=True) + EPS)
    return (y * g.astype(jnp.float32)).astype(x.dtype)


def causal_dwconv(x, w):
    s = x.shape[1]
    xp = jnp.pad(x, ((0, 0), (CONV_K - 1, 0), (0, 0)))
    return sum(w[j] * xp[:, j:j + s] for j in range(CONV_K))


def rotary(t, positions):
    half = t.shape[-1] // 2
    inv_freq = ROPE_BASE ** (-jnp.arange(half, dtype=jnp.float32) / half)
    ang = positions.astype(jnp.float32)[..., None] * inv_freq
    cos = jnp.cos(ang)[:, :, None, :]
    sin = jnp.sin(ang)[:, :, None, :]
    t1, t2 = t[..., :half], t[..., half:]
    return jnp.concatenate([t1 * cos - t2 * sin, t2 * cos + t1 * sin], axis=-1)


def linear_scan(a, b):
    def combine(e1, e2):
        return e1[0] * e2[0], e2[0] * e1[1] + e2[1]
    return lax.associative_scan(combine, (a, b), axis=1)[1]


def retention(q, k, v, g, gn_w, positions):
    bsz, s, _ = q.shape
    n = s // RET_CHUNK
    shp = (bsz, s, RET_HEADS, RET_HD)
    q = rotary(q.astype(jnp.float32).reshape(shp), positions) * RET_HD ** -0.5
    k = rotary(k.astype(jnp.float32).reshape(shp), positions)
    v = v.astype(jnp.float32).reshape(shp)
    to_chunks = lambda t: t.reshape(bsz, n, RET_CHUNK, RET_HEADS, RET_HD).transpose(1, 0, 3, 2, 4)
    log_gamma = jnp.log(1.0 - 2.0 ** (-5.0 - jnp.arange(RET_HEADS, dtype=jnp.float32)))
    idx = jnp.arange(RET_CHUNK, dtype=jnp.float32)
    diff = idx[:, None] - idx[None, :]
    causal = diff >= 0
    decay_mask = jnp.where(causal, jnp.exp(log_gamma[:, None, None] * jnp.where(causal, diff, 0.0)), 0.0)
    q_decay = jnp.exp(log_gamma[:, None] * (idx + 1.0))[None, :, :, None]
    k_decay = jnp.exp(log_gamma[:, None] * (RET_CHUNK - 1.0 - idx))[None, :, :, None]
    chunk_decay = jnp.exp(log_gamma * RET_CHUNK)[None, :, None, None]

    def step(state, inp):
        qc, kc, vc = inp
        scores = jnp.einsum('bhid,bhjd->bhij', qc, kc) * decay_mask
        out = (jnp.einsum('bhij,bhjd->bhid', scores, vc)
               + jnp.einsum('bhid,bhde->bhie', qc, state) * q_decay)
        state = state * chunk_decay + jnp.einsum('bhjd,bhje->bhde', kc * k_decay, vc)
        return state, out

    state0 = jnp.zeros((bsz, RET_HEADS, RET_HD, RET_HD), jnp.float32)
    _, o = lax.scan(step, state0, (to_chunks(q), to_chunks(k), to_chunks(v)))
    o = o.transpose(1, 0, 3, 2, 4).reshape(shp)
    mu = jnp.mean(o, axis=-1, keepdims=True)
    var = jnp.mean(jnp.square(o - mu), axis=-1, keepdims=True)
    o = ((o - mu) * lax.rsqrt(var + EPS)).reshape(bsz, s, GROUP_W) * gn_w.astype(jnp.float32)
    return (jax.nn.silu(g.astype(jnp.float32)) * o).astype(g.dtype)


def rglru(gate_in, x_in, conv_w, conv_b, w_a, b_a, w_x, b_x, lam):
    bsz, s, _ = x_in.shape
    f32 = jnp.float32
    xb = (causal_dwconv(x_in, conv_w) + conv_b).astype(f32)
    xblk = xb.reshape(bsz, s, LRU_BLOCKS, LRU_BW)
    r = jax.nn.sigmoid(jnp.einsum('bsnc,ncd->bsnd', xblk, w_a.astype(f32)).reshape(bsz, s, GROUP_W) + b_a.astype(f32))
    i = jax.nn.sigmoid(jnp.einsum('bsnc,ncd->bsnd', xblk, w_x.astype(f32)).reshape(bsz, s, GROUP_W) + b_x.astype(f32))
    log_a = -LRU_C * r * jax.nn.softplus(-lam.astype(f32))
    a = jnp.exp(log_a)
    b = jnp.sqrt(-jnp.expm1(2.0 * log_a)) * (i * xb)
    h = linear_scan(a, b)
    return (jax.nn.gelu(gate_in.astype(f32)) * h).astype(x_in.dtype)


def s5(u, a_re, a_im, b_re, b_im, c_re, c_im, d, log_dt, glu_w, glu_b):
    bsz, s, _ = u.shape
    f32 = jnp.float32
    uf = u.astype(f32)
    a_re, a_im = a_re.astype(f32), a_im.astype(f32)
    dt = jnp.exp(log_dt.astype(f32))[:, None]
    mag = jnp.exp(a_re * dt)
    ang = a_im * dt
    ab_re, ab_im = mag * jnp.cos(ang), mag * jnp.sin(ang)
    den = a_re * a_re + a_im * a_im
    p_re, p_im = ab_re - 1.0, ab_im
    f_re = (p_re * a_re + p_im * a_im) / den
    f_im = (p_im * a_re - p_re * a_im) / den
    b_re, b_im = b_re.astype(f32), b_im.astype(f32)
    bb_re = f_re[..., None] * b_re - f_im[..., None] * b_im
    bb_im = f_re[..., None] * b_im + f_im[..., None] * b_re
    ug = uf.reshape(bsz, s, S5_GROUPS, S5_GW)
    bu_re = jnp.einsum('bsgc,gnc->bsgn', ug, bb_re)
    bu_im = jnp.einsum('bsgc,gnc->bsgn', ug, bb_im)
    at_re = jnp.broadcast_to(ab_re, bu_re.shape)
    at_im = jnp.broadcast_to(ab_im, bu_im.shape)

    def combine(e1, e2):
        ar1, ai1, br1, bi1 = e1
        ar2, ai2, br2, bi2 = e2
        return (ar2 * ar1 - ai2 * ai1, ar2 * ai1 + ai2 * ar1,
                ar2 * br1 - ai2 * bi1 + br2, ar2 * bi1 + ai2 * br1 + bi2)

    _, _, x_re, x_im = lax.associative_scan(combine, (at_re, at_im, bu_re, bu_im), axis=1)
    y = (jnp.einsum('bsgn,gcn->bsgc', x_re, c_re.astype(f32))
         - jnp.einsum('bsgn,gcn->bsgc', x_im, c_im.astype(f32)))
    y = y.reshape(bsz, s, GROUP_W) + d.astype(f32) * uf
    zz = jax.nn.gelu(y) @ glu_w.astype(f32) + glu_b.astype(f32)
    out = zz[..., :GROUP_W] * jax.nn.sigmoid(zz[..., GROUP_W:])
    return out.astype(u.dtype)


def gated_deltanet(qkv, b_logit, a_logit, g, conv_w, a_log, dt_bias, norm_w):
    bsz, s, _ = qkv.shape
    n = s // GDN_CHUNK
    f32 = jnp.float32
    qkv = jax.nn.silu(causal_dwconv(qkv, conv_w).astype(f32)).reshape(bsz, s, 3, GDN_HEADS, GDN_HD)
    l2 = lambda t: t * lax.rsqrt(jnp.sum(t * t, axis=-1, keepdims=True) + EPS)
    q = l2(qkv[:, :, 0]) * GDN_HD ** -0.5
    k = l2(qkv[:, :, 1])
    v = qkv[:, :, 2]
    beta = jax.nn.sigmoid(b_logit.astype(f32))
    log_alpha = -jnp.exp(a_log.astype(f32)) * jax.nn.softplus(a_logit.astype(f32) + dt_bias.astype(f32))
    chunk = lambda t: jnp.moveaxis(t.reshape(bsz, n, GDN_CHUNK, GDN_HEADS, *t.shape[3:]), 3, 1)
    qc, kc, vc = chunk(q), chunk(k), chunk(v)
    bc = chunk(beta)
    gcum = jnp.cumsum(chunk(log_alpha), axis=-1)
    idx = jnp.arange(GDN_CHUNK)
    incl = idx[:, None] >= idx[None, :]
    strict = idx[:, None] > idx[None, :]
    diff = gcum[..., :, None] - gcum[..., None, :]
    lmask = jnp.where(incl, jnp.exp(jnp.where(incl, diff, 0.0)), 0.0)
    kb = kc * bc[..., None]
    lower = jnp.where(strict, jnp.einsum('bhnid,bhnjd->bhnij', kb, kc) * lmask, 0.0)
    eye = jnp.eye(GDN_CHUNK, dtype=f32)
    rhs = jnp.concatenate([vc * bc[..., None], kb * jnp.exp(gcum)[..., None]], axis=-1)
    sol = lax.linalg.triangular_solve(eye + lower, rhs, left_side=True, lower=True)
    u_c, w_c = sol[..., :GDN_HD], sol[..., GDN_HD:]
    attn = jnp.where(incl, jnp.einsum('bhnid,bhnjd->bhnij', qc, kc) * lmask, 0.0)
    q_dec = qc * jnp.exp(gcum)[..., None]
    k_dec = kc * jnp.exp(gcum[..., -1:] - gcum)[..., None]
    c_dec = jnp.exp(gcum[..., -1])[..., None, None]

    def step(state, inp):
        a_i, u_i, w_i, qd_i, kd_i, cd_i = inp
        v_new = u_i - jnp.einsum('bhcd,bhde->bhce', w_i, state)
        out = jnp.einsum('bhcd,bhde->bhce', qd_i, state) + jnp.einsum('bhij,bhje->bhie', a_i, v_new)
        state = state * cd_i + jnp.einsum('bhcd,bhce->bhde', kd_i, v_new)
        return state, out

    xs = tuple(jnp.moveaxis(t, 2, 0) for t in (attn, u_c, w_c, q_dec, k_dec, c_dec))
    state0 = jnp.zeros((bsz, GDN_HEADS, GDN_HD, GDN_HD), f32)
    _, o = lax.scan(step, state0, xs)
    o = o.transpose(1, 0, 3, 2, 4).reshape(bsz, s, GDN_HEADS, GDN_HD)
    o = rmsnorm(o, norm_w)
    gate = jax.nn.silu(g.astype(f32)).reshape(bsz, s, GDN_HEADS, GDN_HD)
    return (o * gate).reshape(bsz, s, GROUP_W).astype(g.dtype)


def peer(z, w_q, sub_keys, u_tab, v_tab):
    bsz, s, d = z.shape
    q = (z @ w_q).reshape(bsz, s, PEER_HEADS, 2, PEER_HALF)
    sc = jnp.einsum('bshpd,hpkd->bshpk', q, sub_keys).astype(jnp.float32)
    s1, i1 = lax.top_k(sc[..., 0, :], PEER_TOPK)
    s2, i2 = lax.top_k(sc[..., 1, :], PEER_TOPK)
    n_cand = PEER_TOPK * PEER_TOPK
    cand_s = (s1[..., :, None] + s2[..., None, :]).reshape(bsz, s, PEER_HEADS, n_cand)
    cand_id = (i1[..., :, None] * PEER_NKEYS + i2[..., None, :]).reshape(bsz, s, PEER_HEADS, n_cand)
    top_s, top_pos = lax.top_k(cand_s, PEER_TOPK)
    expert_id = jnp.take_along_axis(cand_id, top_pos, axis=-1)
    gates = jax.nn.softmax(top_s, axis=-1).astype(z.dtype)
    n_sel = PEER_HEADS * PEER_TOPK
    nblk = bsz * s // PEER_BLOCK
    zb = z.reshape(nblk, PEER_BLOCK, d)
    eb = expert_id.reshape(nblk, PEER_BLOCK, n_sel)
    gb = gates.reshape(nblk, PEER_BLOCK, n_sel)

    def block(args):
        zt, et, gt = args
        act = jax.nn.gelu(jnp.einsum('tkd,td->tk', u_tab[et], zt))
        return jnp.einsum('tk,tkd->td', gt * act, v_tab[et])

    return lax.map(block, (zb, eb, gb)).reshape(bsz, s, d)


def setup_inputs(seed: int = 0) -> dict:
    key = jax.random.key(seed)
    ks = iter(jax.random.split(key, 48))
    f32 = jnp.float32
    L = DEPTH

    def nrm(shape, scale):
        return jax.random.normal(next(ks), shape, f32) * scale

    def gain(shape):
        return 1.0 + nrm(shape, 0.02)

    def unif(shape, lo, hi):
        return jax.random.uniform(next(ks), shape, f32, lo, hi)

    lru_a = unif((L, GROUP_W), 0.9, 0.999) ** (1.0 / LRU_C)
    gdn_dt = jnp.exp(unif((L, GDN_HEADS), math.log(1e-3), math.log(1e-1)))
    return {
        'x': nrm((BATCH, SEQ, D_MODEL), 1.0),
        'p': nrm((DEPTH, BATCH, SEQ, PLE_DIM), 1.0),
        'positions': jnp.broadcast_to(jnp.arange(SEQ, dtype=jnp.int32)[None, :], (BATCH, SEQ)),
        'mix_norm': gain((L, D_MODEL)),
        'w_in': nrm((L, D_MODEL, IN_W), D_MODEL ** -0.5),
        'ret_gn': gain((L, GROUP_W)),
        'lru_conv_w': nrm((L, CONV_K, GROUP_W), CONV_K ** -0.5),
        'lru_conv_b': nrm((L, GROUP_W), 0.01),
        'lru_w_a': nrm((L, LRU_BLOCKS, LRU_BW, LRU_BW), LRU_BW ** -0.5),
        'lru_b_a': nrm((L, GROUP_W), 0.01),
        'lru_w_x': nrm((L, LRU_BLOCKS, LRU_BW, LRU_BW), LRU_BW ** -0.5),
        'lru_b_x': nrm((L, GROUP_W), 0.01),
        'lru_lambda': jnp.log(lru_a) - jnp.log1p(-lru_a),
        's5_a_re': -0.5 + nrm((L, S5_GROUPS, S5_STATE), 0.01),
        's5_a_im': jnp.pi * jnp.arange(S5_STATE, dtype=f32)[None, None, :] + nrm((L, S5_GROUPS, S5_STATE), 0.01),
        's5_b_re': nrm((L, S5_GROUPS, S5_STATE, S5_GW), (2.0 * S5_GW) ** -0.5),
        's5_b_im': nrm((L, S5_GROUPS, S5_STATE, S5_GW), (2.0 * S5_GW) ** -0.5),
        's5_c_re': nrm((L, S5_GROUPS, S5_GW, S5_STATE), S5_STATE ** -0.5),
        's5_c_im': nrm((L, S5_GROUPS, S5_GW, S5_STATE), S5_STATE ** -0.5),
        's5_d': nrm((L, GROUP_W), 1.0),
        's5_log_dt': unif((L, S5_GROUPS), math.log(1e-3), math.log(1e-1)),
        's5_glu_w': nrm((L, GROUP_W, 2 * GROUP_W), GROUP_W ** -0.5),
        's5_glu_b': nrm((L, 2 * GROUP_W), 0.01),
        'gdn_conv_w': nrm((L, CONV_K, 3 * GROUP_W), CONV_K ** -0.5),
        'gdn_a_log': jnp.log(unif((L, GDN_HEADS), 1.0, 16.0)),
        'gdn_dt_bias': gdn_dt + jnp.log(-jnp.expm1(-gdn_dt)),
        'gdn_norm': gain((L, GDN_HD)),
        'branch_norm': gain((L, N_MIXERS, GROUP_W)),
        'w_out': nrm((L, MIX_W, D_MODEL), MIX_W ** -0.5),
        'ffn_norm': gain((L, D_MODEL)),
        'peer_wq': nrm((L, D_MODEL, PEER_HEADS * PEER_DKEY), D_MODEL ** -0.5),
        'peer_subkeys': nrm((L, PEER_HEADS, 2, PEER_NKEYS, PEER_HALF), PEER_HALF ** -0.5),
        'peer_u': nrm((L, PEER_N, D_MODEL), D_MODEL ** -0.5),
        'peer_v': nrm((L, PEER_N, D_MODEL), (PEER_HEADS * PEER_TOPK) ** -0.5),
        'ple_norm': gain((L, D_MODEL)),
        'ple_wg': nrm((L, D_MODEL, D_MODEL), D_MODEL ** -0.5),
        'ple_wp': nrm((L, PLE_DIM, D_MODEL), PLE_DIM ** -0.5),
        'final_norm': gain((D_MODEL,)),
    }


def reference(x, p, positions, mix_norm, w_in, ret_gn, lru_conv_w, lru_conv_b, lru_w_a, lru_b_a,
              lru_w_x, lru_b_x, lru_lambda, s5_a_re, s5_a_im, s5_b_re, s5_b_im, s5_c_re, s5_c_im,
              s5_d, s5_log_dt, s5_glu_w, s5_glu_b, gdn_conv_w, gdn_a_log, gdn_dt_bias, gdn_norm,
              branch_norm, w_out, ffn_norm, peer_wq, peer_subkeys, peer_u, peer_v, ple_norm,
              ple_wg, ple_wp, final_norm):
    h = x
    for l in range(DEPTH):
        z = rmsnorm(h, mix_norm[l])
        (rq, rk, rv, rg, lg, lx, su, dqkv, db, da, dg) = jnp.split(z @ w_in[l], IN_SPLITS, axis=-1)
        y_ret = retention(rq, rk, rv, rg, ret_gn[l], positions)
        y_lru = rglru(lg, lx, lru_conv_w[l], lru_conv_b[l], lru_w_a[l], lru_b_a[l],
                      lru_w_x[l], lru_b_x[l], lru_lambda[l])
        y_s5 = s5(su, s5_a_re[l], s5_a_im[l], s5_b_re[l], s5_b_im[l], s5_c_re[l], s5_c_im[l],
                  s5_d[l], s5_log_dt[l], s5_glu_w[l], s5_glu_b[l])
        y_gdn = gated_deltanet(dqkv, db, da, dg, gdn_conv_w[l], gdn_a_log[l], gdn_dt_bias[l], gdn_norm[l])
        groups = (y_ret, y_lru, y_s5, y_gdn)
        mixed = jnp.concatenate([rmsnorm(y, branch_norm[l, j]) for j, y in enumerate(groups)], axis=-1)
        h = h + mixed @ w_out[l]
        h = h + peer(rmsnorm(h, ffn_norm[l]), peer_wq[l], peer_subkeys[l], peer_u[l], peer_v[l])
        gate = jax.nn.sigmoid(rmsnorm(h, ple_norm[l]) @ ple_wg[l])
        h = h + (p[l] @ ple_wp[l]) * gate
    return rmsnorm(h, final_norm)
```

```cpp
#include <hip/hip_runtime.h>
#include <hip/hip_bf16.h>
#include <hip/hip_cooperative_groups.h>
#include <cstdio>
#include <cstdint>
namespace cg = cooperative_groups;

#ifndef MEGA
#define MEGA 1
#endif

#define DEVI __device__ __forceinline__

typedef __attribute__((ext_vector_type(8))) short bf16x8;
typedef __attribute__((ext_vector_type(4))) float f32x4;
typedef unsigned short bf16_t;

constexpr int NT = 512;
constexpr int S_ = 16384, DM = 1024, NL = 2, PW = 2944, INW = 2824;
constexpr int RQ = 0, RK = 256, RV = 512, RG = 768, LG = 1024, LX = 1280, SU = 1536, DQ = 1792,
              DB = 2560, DA = 2564, DG = 2568;
constexpr float EPS = 1e-6f;
constexpr int LDS_BYTES = 132 * 1024;

struct Params {
  const float *x, *p; const int* pos;
  const float *mix_norm, *w_in, *ret_gn, *lru_conv_w, *lru_conv_b, *lru_w_a, *lru_b_a, *lru_w_x, *lru_b_x, *lru_lambda;
  const float *s5_a_re, *s5_a_im, *s5_b_re, *s5_b_im, *s5_c_re, *s5_c_im, *s5_d, *s5_log_dt, *s5_glu_w, *s5_glu_b;
  const float *gdn_conv_w, *gdn_a_log, *gdn_dt_bias, *gdn_norm, *branch_norm, *w_out, *ffn_norm, *peer_wq, *peer_subkeys;
  const float *peer_u, *peer_v, *ple_norm, *ple_wg, *ple_wp, *final_norm;
  float* out;
  float* h; bf16_t* zb; float* proj; float* qbuf; float* scores;
  float *g_u, *g_w, *g_attn, *g_qd, *g_kd, *g_sst, *g_cdec;
  int* ids; float* gates;
  float *lru_h, *lru_p, *lru_hs, *lru_ps;
  float* ret_kv; float* xloc;
  bf16_t *tabU, *tabV;
  bf16_t *winT, *woutT, *wqT, *wgT, *wpT;
  float* rope; float* ssq;
};

DEVI int TID() { int t = __builtin_amdgcn_workitem_id_x(); asm volatile("" : "+v"(t)); return t; }
DEVI bf16_t f2bf(float f) { unsigned u = __float_as_uint(f); u += 0x7FFFu + ((u >> 16) & 1u); return (bf16_t)(u >> 16); }
DEVI float bf2f(bf16_t b) { return __uint_as_float(((unsigned)b) << 16); }
DEVI unsigned pack2(float a, float b) { return (unsigned)f2bf(a) | ((unsigned)f2bf(b) << 16); }
DEVI float sigmoidf_(float x) { return 1.f / (1.f + expf(-x)); }
DEVI float siluf_(float x) { return x / (1.f + expf(-x)); }
DEVI float geluf_(float x) { float u = 0.7978845608028654f * (x + 0.044715f * x * x * x); return 0.5f * x * (1.f + tanhf(u)); }
DEVI float softplusf_(float x) { return x > 20.f ? x : log1pf(expf(x)); }
DEVI float wave_sum(float v) {
  v += __shfl_xor(v, 32); v += __shfl_xor(v, 16); v += __shfl_xor(v, 8);
  v += __shfl_xor(v, 4); v += __shfl_xor(v, 2); v += __shfl_xor(v, 1); return v;
}
DEVI float sum16(float v) {
  v += __shfl_xor(v, 8); v += __shfl_xor(v, 4); v += __shfl_xor(v, 2); v += __shfl_xor(v, 1); return v;
}

template <int NTL>
DEVI void mm16(f32x4 (&acc)[NTL], const float* A, int sam, int sak, const float* B, int sbk, int sbn, int K) {
  const int l = TID() & 63, r = l & 15, q = l >> 4;
  const float* ap = A + r * sam + q * sak;
  const float* bp = B + q * sbk + r * sbn;
#pragma unroll 4
  for (int k = 0; k < K; k += 4) {
    float a = ap[k * sak];
#pragma unroll
    for (int t = 0; t < NTL; ++t) {
      float b = bp[k * sbk + t * 16 * sbn];
      acc[t] = __builtin_amdgcn_mfma_f32_16x16x4f32(a, b, acc[t], 0, 0, 0);
    }
  }
}

template <int AMODE>
DEVI void gemm_tile(f32x4 (&acc)[4][4], const void* Aptr, int lda, const bf16_t* Bt, int ldb, int K, int m0, int n0,
                    const float* ssq, char* smem) {
  bf16_t* As = (bf16_t*)smem;
  bf16_t* Bs = As + 256 * 40;
  const int tid = TID(), lane = tid & 63, wave = tid >> 6;
  const int wm = wave >> 1, wn = wave & 1, r = lane & 15, q = lane >> 4;
  const int lrow = tid >> 2, lkc = tid & 3;
  uint4 ra[2]; float4 fa[2][2]; uint4 rb; float rs[2] = {1.f, 1.f};
#pragma unroll
  for (int i = 0; i < 4; ++i)
#pragma unroll
    for (int j = 0; j < 4; ++j) acc[i][j] = f32x4{0.f, 0.f, 0.f, 0.f};

  auto gload = [&](int k0) {
#pragma unroll
    for (int i = 0; i < 2; ++i) {
      int row = lrow + 128 * i;
      if constexpr (AMODE == 2) {
        const float* src = (const float*)Aptr + (size_t)(m0 + row) * lda + k0 + lkc * 8;
        fa[i][0] = *(const float4*)src; fa[i][1] = *(const float4*)(src + 4);
      } else {
        ra[i] = *(const uint4*)((const bf16_t*)Aptr + (size_t)(m0 + row) * lda + k0 + lkc * 8);
      }
    }
    rb = *(const uint4*)(Bt + (size_t)(n0 + lrow) * ldb + k0 + lkc * 8);
  };
  auto lstore = [&](int k0) {
#pragma unroll
    for (int i = 0; i < 2; ++i) {
      int row = lrow + 128 * i;
      uint4 v;
      if constexpr (AMODE == 2) {
        v.x = pack2(fa[i][0].x, fa[i][0].y); v.y = pack2(fa[i][0].z, fa[i][0].w);
        v.z = pack2(fa[i][1].x, fa[i][1].y); v.w = pack2(fa[i][1].z, fa[i][1].w);
      } else if constexpr (AMODE == 1) {
        if ((k0 & 255) == 0) {
          const float* sp = ssq + (size_t)(m0 + row) * 16;
          int seg = k0 >> 8;
          float s = seg == 0 ? (sp[0] + sp[1] + sp[2] + sp[3]) : seg == 1 ? sp[4] : seg == 2 ? sp[5] : (sp[8] + sp[9] + sp[10] + sp[11]);
          rs[i] = rsqrtf(s * (1.f / 256.f) + EPS);
        }
        unsigned w[4] = {ra[i].x, ra[i].y, ra[i].z, ra[i].w};
#pragma unroll
        for (int j = 0; j < 4; ++j) {
          float lo = __uint_as_float(w[j] << 16) * rs[i], hi = __uint_as_float(w[j] & 0xFFFF0000u) * rs[i];
          w[j] = pack2(lo, hi);
        }
        v = uint4{w[0], w[1], w[2], w[3]};
      } else {
        v = ra[i];
      }
      *(uint4*)&As[row * 40 + lkc * 8] = v;
    }
    *(uint4*)&Bs[lrow * 40 + lkc * 8] = rb;
  };

  gload(0);
  for (int k0 = 0; k0 < K; k0 += 32) {
    __syncthreads();
    lstore(k0);
    __syncthreads();
    if (k0 + 32 < K) gload(k0 + 32);
    bf16x8 a[4], b[4];
#pragma unroll
    for (int i = 0; i < 4; ++i) a[i] = *(const bf16x8*)&As[(wm * 64 + i * 16 + r) * 40 + q * 8];
#pragma unroll
    for (int j = 0; j < 4; ++j) b[j] = *(const bf16x8*)&Bs[(wn * 64 + j * 16 + r) * 40 + q * 8];
#pragma unroll
    for (int i = 0; i < 4; ++i)
#pragma unroll
      for (int j = 0; j < 4; ++j)
        acc[i][j] = __builtin_amdgcn_mfma_f32_16x16x32_bf16(b[j], a[i], acc[i][j], 0, 0, 0);
  }
}
#define GEMM_EPI_COORDS                                                   \
  const int lane_ = TID() & 63, wave_ = TID() >> 6;           \
  const int erow0 = m0 + (wave_ >> 1) * 64 + (lane_ & 15);                \
  const int ecol0 = n0 + (wave_ & 1) * 64 + (lane_ >> 4) * 4;

DEVI void transpose_tile(const float* W, int ldw, int nvalid, bf16_t* Bt, int ldbt, int k0, int n0, char* smem) {
  float* t = (float*)smem;
  const int tid = TID();
  {
    int i = tid >> 4, j4 = tid & 15;
#pragma unroll
    for (int h2 = 0; h2 < 2; ++h2) {
      int kk = i + 32 * h2;
      int n = n0 + j4 * 4;
      float4 v = float4{0.f, 0.f, 0.f, 0.f};
      if (n < nvalid) v = *(const float4*)&W[(size_t)(k0 + kk) * ldw + n];
      t[(j4 * 4 + 0) * 65 + kk] = v.x; t[(j4 * 4 + 1) * 65 + kk] = v.y;
      t[(j4 * 4 + 2) * 65 + kk] = v.z; t[(j4 * 4 + 3) * 65 + kk] = v.w;
    }
  }
  __syncthreads();
  {
    int n = tid >> 3, k8 = tid & 7;
    const float* s = &t[n * 65 + k8 * 8];
    uint4 v;
    v.x = pack2(s[0], s[1]); v.y = pack2(s[2], s[3]); v.z = pack2(s[4], s[5]); v.w = pack2(s[6], s[7]);
    *(uint4*)&Bt[(size_t)(n0 + n) * ldbt + k0 + k8 * 8] = v;
  }
  __syncthreads();
}

DEVI void convert_tables(const Params& p, int l) {
  const size_t n8 = (size_t)16384 * 1024 / 8;
  const size_t gtid = (size_t)blockIdx.x * NT + TID(), gsz = (size_t)gridDim.x * NT;
  const float4* su = (const float4*)(p.peer_u + (size_t)l * 16384 * 1024);
  const float4* sv = (const float4*)(p.peer_v + (size_t)l * 16384 * 1024);
  for (size_t i = gtid; i < n8; i += gsz) {
    float4 a = su[2 * i], b = su[2 * i + 1];
    ((uint4*)p.tabU)[i] = uint4{pack2(a.x, a.y), pack2(a.z, a.w), pack2(b.x, b.y), pack2(b.z, b.w)};
    a = sv[2 * i]; b = sv[2 * i + 1];
    ((uint4*)p.tabV)[i] = uint4{pack2(a.x, a.y), pack2(a.z, a.w), pack2(b.x, b.y), pack2(b.z, b.w)};
  }
}

DEVI void ph_prep(const Params& p, char* smem) {
  const size_t gtid = (size_t)blockIdx.x * NT + TID(), gsz = (size_t)gridDim.x * NT;
  for (size_t i = gtid; i < (size_t)S_ * DM / 4; i += gsz) ((float4*)p.h)[i] = ((const float4*)p.x)[i];
  for (size_t i = gtid; i < (size_t)S_ * 32; i += gsz) {
    int t = (int)(i >> 5), f = (int)(i & 31);
    float inv = powf(10000.f, -(float)f / 32.f);
    float ang = (float)p.pos[t] * inv;
    p.rope[2 * i] = cosf(ang); p.rope[2 * i + 1] = sinf(ang);
  }
  for (int it = blockIdx.x; it < 2 * 1568; it += gridDim.x) {
    int l = it / 1568, idx = it % 1568;
    if (idx < 736) {
      int kt = idx / 46, nt = idx % 46;
      transpose_tile(p.w_in + (size_t)l * 1024 * INW, INW, INW, p.winT + (size_t)l * PW * 1024, 1024, kt * 64, nt * 64, smem);
    } else if (idx < 1504) {
      int j = idx - 736; int which = j >> 8; j &= 255;
      int kt = j >> 4, nt = j & 15;
      const float* src = (which == 0 ? p.w_out : which == 1 ? p.peer_wq : p.ple_wg) + (size_t)l * 1024 * 1024;
      bf16_t* dst = (which == 0 ? p.woutT : which == 1 ? p.wqT : p.wgT) + (size_t)l * 1024 * 1024;
      transpose_tile(src, 1024, 1024, dst, 1024, kt * 64, nt * 64, smem);
    } else {
      int j = idx - 1504; int kt = j >> 4, nt = j & 15;
      transpose_tile(p.ple_wp + (size_t)l * 256 * 1024, 1024, 1024, p.wpT + (size_t)l * 1024 * 256, 256, kt * 64, nt * 64, smem);
    }
  }
}

DEVI void ph_norm(const float* src, const float* g, bf16_t* dst, float* fout) {
  const int lane = TID() & 63, wave = TID() >> 6;
  for (int t = blockIdx.x * 8 + wave; t < S_; t += gridDim.x * 8) {
    const float* row = src + (size_t)t * DM;
    float4 v[4]; float ss = 0.f;
#pragma unroll
    for (int i = 0; i < 4; ++i) {
      v[i] = *(const float4*)&row[i * 256 + lane * 4];
      ss += v[i].x * v[i].x + v[i].y * v[i].y + v[i].z * v[i].z + v[i].w * v[i].w;
    }
    ss = wave_sum(ss);
    float rs = rsqrtf(ss * (1.f / DM) + EPS);
#pragma unroll
    for (int i = 0; i < 4; ++i) {
      float4 gg = *(const float4*)&g[i * 256 + lane * 4];
      float a = v[i].x * rs * gg.x, b = v[i].y * rs * gg.y, c = v[i].z * rs * gg.z, d = v[i].w * rs * gg.w;
      if (dst) *(uint2*)&dst[(size_t)t * DM + i * 256 + lane * 4] = uint2{pack2(a, b), pack2(c, d)};
      else *(float4*)&fout[(size_t)t * DM + i * 256 + lane * 4] = float4{a, b, c, d};
    }
  }
}

DEVI void gdn_prep(const Params& p, int l, int item, char* smem) {
  const int c = item >> 2, hd = item & 3, t0 = c * 64;
  float* sq = (float*)smem; float* sk = sq + 64 * 65; float* sv = sk + 64 * 65;
  float* sL = sv + 64 * 65;
  float* sgc = sL + 64 * 68; float* sbeta = sgc + 64;
  const int tid = TID(), lane = tid & 63, wave = tid >> 6, r = lane & 15, qd = lane >> 4;
  const float* cw = p.gdn_conv_w + (size_t)l * 4 * 768;
  for (int i = tid; i < 3 * 64 * 64; i += NT) {
    int d = i & 63, t = (i >> 6) & 63, which = i >> 12;
    int ch = which * 256 + hd * 64 + d;
    float acc = 0.f;
#pragma unroll
    for (int j = 0; j < 4; ++j) {
      int tt = t0 + t - 3 + j;
      if (tt >= 0) acc += cw[j * 768 + ch] * p.proj[(size_t)tt * PW + DQ + ch];
    }
    float v = siluf_(acc);
    (which == 0 ? sq : which == 1 ? sk : sv)[t * 65 + d] = v;
  }
  __syncthreads();
  if (tid < 128) {
    int t = tid & 63; float* row = (tid < 64 ? sq : sk) + t * 65;
    float s = 0.f;
    for (int d = 0; d < 64; ++d) s += row[d] * row[d];
    float sc = rsqrtf(s + EPS) * (tid < 64 ? 0.125f : 1.f);
    for (int d = 0; d < 64; ++d) row[d] *= sc;
  } else if (tid < 192) {
    int t = tid - 128;
    float bl = p.proj[(size_t)(t0 + t) * PW + DB + hd];
    float al = p.proj[(size_t)(t0 + t) * PW + DA + hd];
    float la = -expf(p.gdn_a_log[l * 4 + hd]) * softplusf_(al + p.gdn_dt_bias[l * 4 + hd]);
    for (int off = 1; off < 64; off <<= 1) { float n = __shfl_up(la, off); if (lane >= off) la += n; }
    sgc[t] = la; sbeta[t] = sigmoidf_(bl);
  }
  __syncthreads();
  {
    int mat = wave >> 2, mt = wave & 3;
    f32x4 acc[4];
#pragma unroll
    for (int t = 0; t < 4; ++t) acc[t] = f32x4{0.f, 0.f, 0.f, 0.f};
    mm16<4>(acc, (mat == 0 ? sk : sq) + mt * 16 * 65, 65, 1, sk, 1, 65, 64);
#pragma unroll
    for (int t = 0; t < 4; ++t)
#pragma unroll
      for (int e = 0; e < 4; ++e) {
        int i = mt * 16 + 4 * qd + e, j = t * 16 + r;
        float g = (i >= j) ? expf(sgc[i] - sgc[j]) : 0.f;
        if (mat == 0) sL[i * 68 + j] = (i > j) ? acc[t][e] * sbeta[i] * g : 0.f;
        else p.g_attn[((size_t)item * 64 + i) * 64 + j] = (i >= j) ? acc[t][e] * g : 0.f;
      }
  }
  __syncthreads();
  if (tid < 128) {
    const bool isv = tid < 64; const int d = tid & 63;
    float X[64];
#pragma unroll
    for (int i = 0; i < 64; ++i) X[i] = 0.f;
    float* dst = (isv ? p.g_u : p.g_w) + (size_t)item * 4096 + d;
#pragma unroll
    for (int i = 0; i < 64; ++i) {
      float bi = sbeta[i];
      float s = isv ? sv[i * 65 + d] * bi : sk[i * 65 + d] * bi * expf(sgc[i]);
#pragma unroll
      for (int j4 = 0; j4 < (i + 3) / 4; ++j4) {
        float4 lv = *(const float4*)&sL[i * 68 + j4 * 4];
        s -= lv.x * X[j4 * 4 + 0]; s -= lv.y * X[j4 * 4 + 1]; s -= lv.z * X[j4 * 4 + 2]; s -= lv.w * X[j4 * 4 + 3];
      }
      X[i] = s;
      dst[i * 64] = s;
    }
  } else {
    for (int i2 = tid - 128; i2 < 8192; i2 += 384) {
      int which = i2 >> 12, i = (i2 >> 6) & 63, d = i2 & 63;
      float val = which == 0 ? sq[i * 65 + d] * expf(sgc[i]) : sk[i * 65 + d] * expf(sgc[63] - sgc[i]);
      (which == 0 ? p.g_qd : p.g_kd)[(size_t)item * 4096 + i * 64 + d] = val;
    }
    if (tid == 128) p.g_cdec[item] = expf(sgc[63]);
  }
  __syncthreads();
}

DEVI void gdn_chain(const Params& p, int hd, int cg_, char* smem) {
  float* base = (float*)smem;
  constexpr int BUFSZ = 64 * 68 * 2 + 64 * 16;
  float* sS = base + 2 * BUFSZ; float* sVN = sS + 1024;
  const int tid = TID(), lane = tid & 63, wave = tid >> 6, r = lane & 15, qd = lane >> 4;
  const int e0 = cg_ * 16;
  float4 pw0, pw1, pkd0, pkd1, pu = float4{0.f, 0.f, 0.f, 0.f};
  const int lr0 = tid >> 4, lc0 = (tid & 15) * 4, lr1 = lr0 + 32;
  const int ur = tid >> 2, uc = (tid & 3) * 4;
#define GLOAD(c_)                                                            \
  {                                                                          \
    size_t b_ = (size_t)((c_) * 4 + hd) * 4096;                              \
    pw0 = *(const float4*)&p.g_w[b_ + lr0 * 64 + lc0];                       \
    pw1 = *(const float4*)&p.g_w[b_ + lr1 * 64 + lc0];                       \
    pkd0 = *(const float4*)&p.g_kd[b_ + lr0 * 64 + lc0];                     \
    pkd1 = *(const float4*)&p.g_kd[b_ + lr1 * 64 + lc0];                     \
    if (tid < 256) pu = *(const float4*)&p.g_u[b_ + ur * 64 + e0 + uc];      \
  }
#define LSTORE(bi_)                                                          \
  {                                                                          \
    float* W_ = base + (bi_) * BUFSZ; float* KD_ = W_ + 64 * 68; float* U_ = KD_ + 64 * 68; \
    *(float4*)&W_[lr0 * 68 + lc0] = pw0; *(float4*)&W_[lr1 * 68 + lc0] = pw1;       \
    *(float4*)&KD_[lr0 * 68 + lc0] = pkd0; *(float4*)&KD_[lr1 * 68 + lc0] = pkd1;   \
    if (tid < 256) *(float4*)&U_[ur * 16 + uc] = pu;                         \
  }
  GLOAD(0) LSTORE(0)
  for (int i = tid; i < 1024; i += NT) sS[i] = 0.f;
  f32x4 sreg = f32x4{0.f, 0.f, 0.f, 0.f};
  if (wave < 4) {
#pragma unroll
    for (int e = 0; e < 4; ++e) {
      int d = wave * 16 + 4 * qd + e;
      p.g_sst[(size_t)(0 * 4 + hd) * 4096 + d * 64 + e0 + r] = 0.f;
    }
  }
  __syncthreads();
  for (int c = 0; c < 256; ++c) {
    if (c + 1 < 256) GLOAD(c + 1)
    const float cd = p.g_cdec[c * 4 + hd];
    float* W = base + (c & 1) * BUFSZ; float* KD = W + 64 * 68; float* U = KD + 64 * 68;
    const size_t it = (size_t)(c * 4 + hd);
    if (wave < 4) {
      f32x4 a1[1]; a1[0] = f32x4{0.f, 0.f, 0.f, 0.f};
      mm16<1>(a1, W + wave * 16 * 68, 68, 1, sS, 16, 1, 64);
#pragma unroll
      for (int e = 0; e < 4; ++e) {
        int i = wave * 16 + 4 * qd + e;
        float vn = U[i * 16 + r] - a1[0][e];
        sVN[i * 16 + r] = vn;
        p.g_u[it * 4096 + i * 64 + e0 + r] = vn;
      }
    }
    __syncthreads();
    if (wave < 4) {
      f32x4 a2[1]; a2[0] = f32x4{0.f, 0.f, 0.f, 0.f};
      mm16<1>(a2, KD + wave * 16, 1, 68, sVN, 16, 1, 64);
#pragma unroll
      for (int e = 0; e < 4; ++e) {
        int d = wave * 16 + 4 * qd + e;
        sreg[e] = sreg[e] * cd + a2[0][e];
        sS[d * 16 + r] = sreg[e];
        if (c + 1 < 256) p.g_sst[(size_t)((c + 1) * 4 + hd) * 4096 + d * 64 + e0 + r] = sreg[e];
      }
    }
    if (c + 1 < 256) LSTORE((c + 1) & 1)
    __syncthreads();
  }
}

DEVI void gdn_out(const Params& p, int l, int item, char* smem) {
  const int c = item >> 2, hd = item & 3, t0 = c * 64;
  float* sQD = (float*)smem; float* sS = sQD + 64 * 68; float* sAT = sS + 64 * 68; float* sVN = sAT + 64 * 68;
  const int tid = TID(), lane = tid & 63, wave = tid >> 6, r = lane & 15, qd = lane >> 4;
  const size_t b = (size_t)item * 4096;
  for (int idx = tid; idx < 1024; idx += NT) {
    int row = idx >> 4, c4 = idx & 15;
    *(float4*)&sQD[row * 68 + c4 * 4] = *(const float4*)&p.g_qd[b + row * 64 + c4 * 4];
    *(float4*)&sS[row * 68 + c4 * 4] = *(const float4*)&p.g_sst[b + row * 64 + c4 * 4];
    *(float4*)&sAT[row * 68 + c4 * 4] = *(const float4*)&p.g_attn[b + row * 64 + c4 * 4];
    *(float4*)&sVN[row * 68 + c4 * 4] = *(const float4*)&p.g_u[b + row * 64 + c4 * 4];
  }
  __syncthreads();
  const int mt = wave & 3, nh = wave >> 2;
  f32x4 acc[2]; acc[0] = acc[1] = f32x4{0.f, 0.f, 0.f, 0.f};
  mm16<2>(acc, sQD + mt * 16 * 68, 68, 1, sS + nh * 32, 68, 1, 64);
  mm16<2>(acc, sAT + mt * 16 * 68, 68, 1, sVN + nh * 32, 68, 1, 64);
  __syncthreads();
  float* sO = sQD;
#pragma unroll
  for (int t2 = 0; t2 < 2; ++t2)
#pragma unroll
    for (int e = 0; e < 4; ++e) sO[(mt * 16 + 4 * qd + e) * 68 + nh * 32 + t2 * 16 + r] = acc[t2][e];
  __syncthreads();
  {
    int row = tid >> 3, sub = tid & 7, t = t0 + row;
    float o[8], yv[8]; float ss = 0.f;
#pragma unroll
    for (int k = 0; k < 8; ++k) { o[k] = sO[row * 68 + sub * 8 + k]; ss += o[k] * o[k]; }
    ss += __shfl_xor(ss, 1); ss += __shfl_xor(ss, 2); ss += __shfl_xor(ss, 4);
    float rs = rsqrtf(ss * (1.f / 64.f) + EPS);
    float s2 = 0.f;
#pragma unroll
    for (int k = 0; k < 8; ++k) {
      int col = sub * 8 + k;
      float g = p.proj[(size_t)t * PW + DG + hd * 64 + col];
      float y = o[k] * rs * p.gdn_norm[l * 64 + col] * siluf_(g);
      s2 += y * y;
      yv[k] = y * p.branch_norm[(l * 4 + 3) * 256 + hd * 64 + col];
    }
    s2 += __shfl_xor(s2, 1); s2 += __shfl_xor(s2, 2); s2 += __shfl_xor(s2, 4);
    if (sub == 0) p.ssq[(size_t)t * 16 + 8 + hd] = s2;
    *(uint4*)&p.zb[(size_t)t * DM + 768 + hd * 64 + sub * 8] =
        uint4{pack2(yv[0], yv[1]), pack2(yv[2], yv[3]), pack2(yv[4], yv[5]), pack2(yv[6], yv[7])};
  }
  __syncthreads();
}

DEVI void ret_kv(const Params& p, int l, int item, char* smem) {
  const int c = item >> 2, hd = item & 3, t0 = c * 128;
  float* sK = (float*)smem; float* sV = sK + 128 * 65;
  const int tid = TID(), lane = tid & 63, wave = tid >> 6, r = lane & 15, qd = lane >> 4;
  const float lg = logf(1.f - exp2f(-5.f - (float)hd));
  for (int i = tid; i < 128 * 32; i += NT) {
    int t = i >> 5, f = i & 31; size_t tt = t0 + t;
    float k1 = p.proj[tt * PW + RK + hd * 64 + f], k2 = p.proj[tt * PW + RK + hd * 64 + 32 + f];
    float cs = p.rope[(tt * 32 + f) * 2], sn = p.rope[(tt * 32 + f) * 2 + 1];
    float dec = expf(lg * (float)(127 - t));
    sK[t * 65 + f] = (k1 * cs - k2 * sn) * dec;
    sK[t * 65 + 32 + f] = (k2 * cs + k1 * sn) * dec;
  }
  for (int i = tid; i < 128 * 64; i += NT) {
    int t = i >> 6, e = i & 63;
    sV[t * 65 + e] = p.proj[(size_t)(t0 + t) * PW + RV + hd * 64 + e];
  }
  __syncthreads();
  const int mt = wave & 3, nh = wave >> 2;
  f32x4 acc[2]; acc[0] = acc[1] = f32x4{0.f, 0.f, 0.f, 0.f};
  mm16<2>(acc, sK + mt * 16, 1, 65, sV + nh * 32, 65, 1, 128);
#pragma unroll
  for (int t2 = 0; t2 < 2; ++t2)
#pragma unroll
    for (int e = 0; e < 4; ++e)
      p.ret_kv[(size_t)item * 4096 + (mt * 16 + 4 * qd + e) * 64 + nh * 32 + t2 * 16 + r] = acc[t2][e];
  __syncthreads();
}

DEVI void ret_out(const Params& p, int l, int item, char* smem) {
  const int c = item >> 2, hd = item & 3, t0 = c * 128;
  float* sQ = (float*)smem; float* sK = sQ + 128 * 65; float* sV = sK + 128 * 65; float* sSt = sV + 128 * 65;
  const int tid = TID(), lane = tid & 63, wave = tid >> 6, r = lane & 15, qd = lane >> 4;
  const float lg = logf(1.f - exp2f(-5.f - (float)hd));
  const float cdk = expf(lg * 128.f);
  {
    float s[8];
#pragma unroll
    for (int j = 0; j < 8; ++j) s[j] = 0.f;
    for (int c2 = 0; c2 < c; ++c2) {
      const float* src = p.ret_kv + (size_t)(c2 * 4 + hd) * 4096;
#pragma unroll
      for (int j = 0; j < 8; ++j) s[j] = s[j] * cdk + src[tid + 512 * j];
    }
#pragma unroll
    for (int j = 0; j < 8; ++j) { int idx = tid + 512 * j; sSt[(idx >> 6) * 65 + (idx & 63)] = s[j]; }
  }
  for (int i = tid; i < 128 * 32; i += NT) {
    int t = i >> 5, f = i & 31; size_t tt = t0 + t;
    float cs = p.rope[(tt * 32 + f) * 2], sn = p.rope[(tt * 32 + f) * 2 + 1];
    float k1 = p.proj[tt * PW + RK + hd * 64 + f], k2 = p.proj[tt * PW + RK + hd * 64 + 32 + f];
    sK[t * 65 + f] = (k1 * cs - k2 * sn);
    sK[t * 65 + 32 + f] = (k2 * cs + k1 * sn);
    float q1 = p.proj[tt * PW + RQ + hd * 64 + f], q2 = p.proj[tt * PW + RQ + hd * 64 + 32 + f];
    sQ[t * 65 + f] = (q1 * cs - q2 * sn) * 0.125f;
    sQ[t * 65 + 32 + f] = (q2 * cs + q1 * sn) * 0.125f;
  }
  for (int i = tid; i < 128 * 64; i += NT) {
    int t = i >> 6, e = i & 63;
    sV[t * 65 + e] = p.proj[(size_t)(t0 + t) * PW + RV + hd * 64 + e];
  }
  __syncthreads();
  const int i0 = wave * 16;
  f32x4 sc[8], os[4];
#pragma unroll
  for (int t = 0; t < 8; ++t) sc[t] = f32x4{0.f, 0.f, 0.f, 0.f};
#pragma unroll
  for (int t = 0; t < 4; ++t) os[t] = f32x4{0.f, 0.f, 0.f, 0.f};
  mm16<8>(sc, sQ + i0 * 65, 65, 1, sK, 1, 65, 64);
  mm16<4>(os, sQ + i0 * 65, 65, 1, sSt, 65, 1, 64);
  __syncthreads();
  float* sP = (float*)smem;
#pragma unroll
  for (int t2 = 0; t2 < 8; ++t2)
#pragma unroll
    for (int e = 0; e < 4; ++e) {
      int i = i0 + 4 * qd + e, j = t2 * 16 + r;
      sP[i * 129 + j] = (i >= j) ? sc[t2][e] * expf(lg * (float)(i - j)) : 0.f;
    }
  __syncthreads();
  f32x4 o[4];
#pragma unroll
  for (int t2 = 0; t2 < 4; ++t2)
#pragma unroll
    for (int e = 0; e < 4; ++e) o[t2][e] = os[t2][e] * expf(lg * (float)(i0 + 4 * qd + e + 1));
  mm16<4>(o, sP + i0 * 129, 129, 1, sV, 65, 1, 128);
#pragma unroll
  for (int e = 0; e < 4; ++e) {
    int i = i0 + 4 * qd + e; size_t t = t0 + i;
    float sm = sum16(o[0][e] + o[1][e] + o[2][e] + o[3][e]);
    float mu = sm * (1.f / 64.f);
    float vr = 0.f;
#pragma unroll
    for (int t2 = 0; t2 < 4; ++t2) { float dd = o[t2][e] - mu; vr += dd * dd; }
    vr = sum16(vr);
    float rstd = rsqrtf(vr * (1.f / 64.f) + EPS);
    float ss = 0.f;
#pragma unroll
    for (int t2 = 0; t2 < 4; ++t2) {
      int col = hd * 64 + t2 * 16 + r;
      float on = (o[t2][e] - mu) * rstd * p.ret_gn[l * 256 + col];
      float g = p.proj[t * PW + RG + col];
      float y = siluf_(g) * on;
      ss += y * y;
      p.zb[t * DM + col] = f2bf(y * p.branch_norm[(l * 4 + 0) * 256 + col]);
    }
    ss = sum16(ss);
    if (r == 0) p.ssq[t * 16 + hd] = ss;
  }
  __syncthreads();
}

DEVI void lru_local(const Params& p, int l, int c, char* smem) {
  const int t0 = c * 64;
  float* sX = (float*)smem; float* sA = sX + 64 * 257;
  const int tid = TID(), lane = tid & 63, wave = tid >> 6, r = lane & 15, qd = lane >> 4;
  for (int i = tid; i < 64 * 256; i += NT) {
    int t = i >> 8, ch = i & 255;
    float acc = p.lru_conv_b[l * 256 + ch];
#pragma unroll
    for (int j = 0; j < 4; ++j) {
      int tt = t0 + t - 3 + j;
      if (tt >= 0) acc += p.lru_conv_w[(l * 4 + j) * 256 + ch] * p.proj[(size_t)tt * PW + LX + ch];
    }
    sX[t * 257 + ch] = acc;
  }
  __syncthreads();
  for (int pr = 0; pr < 2; ++pr) {
    int pi = wave * 2 + pr, mt = pi & 3, nb = pi >> 2;
    f32x4 ra[4], ri[4];
#pragma unroll
    for (int t = 0; t < 4; ++t) { ra[t] = f32x4{0.f, 0.f, 0.f, 0.f}; ri[t] = f32x4{0.f, 0.f, 0.f, 0.f}; }
    mm16<4>(ra, sX + mt * 16 * 257 + nb * 64, 257, 1, p.lru_w_a + (size_t)(l * 4 + nb) * 4096, 64, 1, 64);
    mm16<4>(ri, sX + mt * 16 * 257 + nb * 64, 257, 1, p.lru_w_x + (size_t)(l * 4 + nb) * 4096, 64, 1, 64);
#pragma unroll
    for (int t2 = 0; t2 < 4; ++t2)
#pragma unroll
      for (int e = 0; e < 4; ++e) {
        int t = mt * 16 + 4 * qd + e, ch = nb * 64 + t2 * 16 + r;
        float xb = sX[t * 257 + ch];
        float rr = sigmoidf_(ra[t2][e] + p.lru_b_a[l * 256 + ch]);
        float ii = sigmoidf_(ri[t2][e] + p.lru_b_x[l * 256 + ch]);
        float loga = -8.f * rr * softplusf_(-p.lru_lambda[l * 256 + ch]);
        float a = expf(loga);
        float bb = sqrtf(-expm1f(2.f * loga)) * (ii * xb);
        sA[t * 257 + ch] = a; sX[t * 257 + ch] = bb;
      }
  }
  __syncthreads();
  if (tid < 256) {
    int ch = tid; float H = 0.f, P = 1.f;
    for (int t = 0; t < 64; ++t) {
      float a = sA[t * 257 + ch], bb = sX[t * 257 + ch];
      H = a * H + bb; P *= a;
      p.lru_h[(size_t)(t0 + t) * 256 + ch] = H; p.lru_p[(size_t)(t0 + t) * 256 + ch] = P;
    }
    p.lru_hs[c * 256 + ch] = H; p.lru_ps[c * 256 + ch] = P;
  }
  __syncthreads();
}

DEVI void lru_out(const Params& p, int l, int c, char* smem) {
  const int t0 = c * 64;
  float* sC = (float*)smem;
  const int tid = TID(), lane = tid & 63, wave = tid >> 6;
  if (tid < 256) {
    float carry = 0.f;
    for (int c2 = 0; c2 < c; ++c2) carry = p.lru_ps[c2 * 256 + tid] * carry + p.lru_hs[c2 * 256 + tid];
    sC[tid] = carry;
  }
  __syncthreads();
  for (int tk = 0; tk < 8; ++tk) {
    size_t t = t0 + wave * 8 + tk; int ch = lane * 4;
    float4 H = *(const float4*)&p.lru_h[t * 256 + ch], P = *(const float4*)&p.lru_p[t * 256 + ch];
    float4 g = *(const float4*)&p.proj[t * PW + LG + ch], cr = *(const float4*)&sC[ch];
    float4 bn = *(const float4*)&p.branch_norm[(l * 4 + 1) * 256 + ch];
    float y0 = geluf_(g.x) * (H.x + P.x * cr.x), y1 = geluf_(g.y) * (H.y + P.y * cr.y);
    float y2 = geluf_(g.z) * (H.z + P.z * cr.z), y3 = geluf_(g.w) * (H.w + P.w * cr.w);
    float ss = wave_sum(y0 * y0 + y1 * y1 + y2 * y2 + y3 * y3);
    if (lane == 0) p.ssq[t * 16 + 4] = ss;
    *(uint2*)&p.zb[t * DM + 256 + ch] = uint2{pack2(y0 * bn.x, y1 * bn.y), pack2(y2 * bn.z, y3 * bn.w)};
  }
  __syncthreads();
}

DEVI void s5_coef(const Params& p, int l, int g, int n, float& abr, float& abi, float (&bbr)[16], float (&bbi)[16]) {
  float dt = expf(p.s5_log_dt[l * 16 + g]);
  float are = p.s5_a_re[(l * 16 + g) * 64 + n], aim = p.s5_a_im[(l * 16 + g) * 64 + n];
  float mag = expf(are * dt), ang = aim * dt;
  abr = mag * cosf(ang); abi = mag * sinf(ang);
  float den = are * are + aim * aim;
  float pre = abr - 1.f, pim = abi;
  float fre = (pre * are + pim * aim) / den, fim = (pim * are - pre * aim) / den;
  const float4* br = (const float4*)(p.s5_b_re + (size_t)((l * 16 + g) * 64 + n) * 16);
  const float4* bi = (const float4*)(p.s5_b_im + (size_t)((l * 16 + g) * 64 + n) * 16);
#pragma unroll
  for (int c4 = 0; c4 < 4; ++c4) {
    float4 a = br[c4], b = bi[c4];
    bbr[c4 * 4 + 0] = fre * a.x - fim * b.x; bbi[c4 * 4 + 0] = fre * b.x + fim * a.x;
    bbr[c4 * 4 + 1] = fre * a.y - fim * b.y; bbi[c4 * 4 + 1] = fre * b.y + fim * a.y;
    bbr[c4 * 4 + 2] = fre * a.z - fim * b.z; bbi[c4 * 4 + 2] = fre * b.z + fim * a.z;
    bbr[c4 * 4 + 3] = fre * a.w - fim * b.w; bbi[c4 * 4 + 3] = fre * b.w + fim * a.w;
  }
}
DEVI void s5_load_u(const Params& p, int t0, float* sU) {
  for (int i = TID(); i < 64 * 64; i += NT) {
    int t = i >> 6, c4 = i & 63;
    *(float4*)&sU[t * 256 + c4 * 4] = *(const float4*)&p.proj[(size_t)(t0 + t) * PW + SU + c4 * 4];
  }
}
DEVI void s5_bu(const float* up, const float (&bbr)[16], const float (&bbi)[16], float& bur, float& bui) {
  bur = 0.f; bui = 0.f;
#pragma unroll
  for (int c4 = 0; c4 < 4; ++c4) {
    float4 u = *(const float4*)&up[c4 * 4];
    bur += bbr[c4 * 4] * u.x + bbr[c4 * 4 + 1] * u.y + bbr[c4 * 4 + 2] * u.z + bbr[c4 * 4 + 3] * u.w;
    bui += bbi[c4 * 4] * u.x + bbi[c4 * 4 + 1] * u.y + bbi[c4 * 4 + 2] * u.z + bbi[c4 * 4 + 3] * u.w;
  }
}

DEVI void s5_local(const Params& p, int l, int c, char* smem) {
  const int t0 = c * 64;
  float* sU = (float*)smem;
  const int lane = TID() & 63, wave = TID() >> 6;
  s5_load_u(p, t0, sU);
  __syncthreads();
  for (int gi = 0; gi < 2; ++gi) {
    int g = wave + 8 * gi;
    float abr, abi, bbr[16], bbi[16];
    s5_coef(p, l, g, lane, abr, abi, bbr, bbi);
    float xr = 0.f, xi = 0.f;
    for (int t = 0; t < 64; ++t) {
      float bur, bui; s5_bu(sU + t * 256 + g * 16, bbr, bbi, bur, bui);
      float nr = abr * xr - abi * xi + bur, ni = abr * xi + abi * xr + bui;
      xr = nr; xi = ni;
    }
    *(float2*)&p.xloc[((size_t)(c * 16 + g) * 64 + lane) * 2] = float2{xr, xi};
  }
  __syncthreads();
}

DEVI void s5_out(const Params& p, int l, int c, char* smem) {
  const int t0 = c * 64;
  float* sU = (float*)smem; float* sY = sU + 64 * 256;
  const int tid = TID(), lane = tid & 63, wave = tid >> 6, r = lane & 15, qd = lane >> 4;
  s5_load_u(p, t0, sU);
  __syncthreads();
  const bool b0 = lane & 1, b1 = lane & 2, b2 = lane & 4, b3 = lane & 8;
  const int ccl = (b0 ? 8 : 0) + (b1 ? 4 : 0) + (b2 ? 2 : 0) + (b3 ? 1 : 0);
  for (int gi = 0; gi < 2; ++gi) {
    int g = wave + 8 * gi;
    float abr, abi, bbr[16], bbi[16];
    s5_coef(p, l, g, lane, abr, abi, bbr, bbi);
    float cr[16], ci[16];
#pragma unroll
    for (int cc = 0; cc < 16; ++cc) {
      cr[cc] = p.s5_c_re[(size_t)((l * 16 + g) * 16 + cc) * 64 + lane];
      ci[cc] = p.s5_c_im[(size_t)((l * 16 + g) * 16 + cc) * 64 + lane];
    }
    const float dd = p.s5_d[l * 256 + g * 16 + ccl];
    float pr = abr, pi = abi;
#pragma unroll
    for (int k = 0; k < 6; ++k) { float nr = pr * pr - pi * pi, ni = 2.f * pr * pi; pr = nr; pi = ni; }
    float xr = 0.f, xi = 0.f;
    for (int c2 = 0; c2 < c; ++c2) {
      float2 xl = *(const float2*)&p.xloc[((size_t)(c2 * 16 + g) * 64 + lane) * 2];
      float nr = pr * xr - pi * xi + xl.x, ni = pr * xi + pi * xr + xl.y;
      xr = nr; xi = ni;
    }
    for (int t = 0; t < 64; ++t) {
      const float* up = sU + t * 256 + g * 16;
      float bur, bui; s5_bu(up, bbr, bbi, bur, bui);
      float nr = abr * xr - abi * xi + bur, ni = abr * xi + abi * xr + bui;
      xr = nr; xi = ni;
      float w8[8], w4[4], w2[2];
#pragma unroll
      for (int k = 0; k < 8; ++k) {
        float plo = cr[k] * xr - ci[k] * xi, phi = cr[k + 8] * xr - ci[k + 8] * xi;
        float keep = b0 ? phi : plo, send = b0 ? plo : phi;
        w8[k] = keep + __shfl_xor(send, 1);
      }
#pragma unroll
      for (int k = 0; k < 4; ++k) {
        float keep = b1 ? w8[k + 4] : w8[k], send = b1 ? w8[k] : w8[k + 4];
        w4[k] = keep + __shfl_xor(send, 2);
      }
#pragma unroll
      for (int k = 0; k < 2; ++k) {
        float keep = b2 ? w4[k + 2] : w4[k], send = b2 ? w4[k] : w4[k + 2];
        w2[k] = keep + __shfl_xor(send, 4);
      }
      float w1 = (b3 ? w2[1] : w2[0]) + __shfl_xor(b3 ? w2[0] : w2[1], 8);
      w1 += __shfl_xor(w1, 16); w1 += __shfl_xor(w1, 32);
      if (lane < 16) {
        float y = w1 + dd * up[ccl];
        sY[t * 257 + g * 16 + ccl] = geluf_(y);
      }
    }
  }
  __syncthreads();
  f32x4 av[4][2], ag[4][2];
#pragma unroll
  for (int i = 0; i < 4; ++i)
#pragma unroll
    for (int j = 0; j < 2; ++j) { av[i][j] = f32x4{0.f, 0.f, 0.f, 0.f}; ag[i][j] = f32x4{0.f, 0.f, 0.f, 0.f}; }
  const float* W = p.s5_glu_w + (size_t)l * 256 * 512;
  for (int k0 = 0; k0 < 256; k0 += 4) {
    int kk = k0 + qd;
    float bv0 = W[kk * 512 + 32 * wave + r], bv1 = W[kk * 512 + 32 * wave + 16 + r];
    float bg0 = W[kk * 512 + 256 + 32 * wave + r], bg1 = W[kk * 512 + 256 + 32 * wave + 16 + r];
#pragma unroll
    for (int mt = 0; mt < 4; ++mt) {
      float a = sY[(mt * 16 + r) * 257 + kk];
      av[mt][0] = __builtin_amdgcn_mfma_f32_16x16x4f32(a, bv0, av[mt][0], 0, 0, 0);
      av[mt][1] = __builtin_amdgcn_mfma_f32_16x16x4f32(a, bv1, av[mt][1], 0, 0, 0);
      ag[mt][0] = __builtin_amdgcn_mfma_f32_16x16x4f32(a, bg0, ag[mt][0], 0, 0, 0);
      ag[mt][1] = __builtin_amdgcn_mfma_f32_16x16x4f32(a, bg1, ag[mt][1], 0, 0, 0);
    }
  }
  float* sO = sU;
#pragma unroll
  for (int mt = 0; mt < 4; ++mt)
#pragma unroll
    for (int t2 = 0; t2 < 2; ++t2)
#pragma unroll
      for (int e = 0; e < 4; ++e) {
        int t = mt * 16 + 4 * qd + e, col = 32 * wave + t2 * 16 + r;
        float zv = av[mt][t2][e] + p.s5_glu_b[l * 512 + col];
        float zg = ag[mt][t2][e] + p.s5_glu_b[l * 512 + 256 + col];
        sO[t * 256 + col] = zv * sigmoidf_(zg);
      }
  __syncthreads();
  for (int tk = 0; tk < 8; ++tk) {
    int tl = wave * 8 + tk; size_t t = t0 + tl; int ch = lane * 4;
    float4 o = *(const float4*)&sO[tl * 256 + ch];
    float4 bn = *(const float4*)&p.branch_norm[(l * 4 + 2) * 256 + ch];
    float ss = wave_sum(o.x * o.x + o.y * o.y + o.z * o.z + o.w * o.w);
    if (lane == 0) p.ssq[t * 16 + 5] = ss;
    *(uint2*)&p.zb[t * DM + 512 + ch] = uint2{pack2(o.x * bn.x, o.y * bn.y), pack2(o.z * bn.z, o.w * bn.w)};
  }
  __syncthreads();
}

DEVI void peer_scores(const Params& p, int l, int item, char* smem) {
  const int tt = item >> 4, hp = item & 15, t0 = tt * 64;
  float* sQ = (float*)smem; float* sKy = sQ + 64 * 65;
  const int tid = TID(), lane = tid & 63, wave = tid >> 6, r = lane & 15, qd = lane >> 4;
  for (int i = tid; i < 64 * 64; i += NT) { int t = i >> 6, d = i & 63; sQ[t * 65 + d] = p.qbuf[(size_t)(t0 + t) * 1024 + hp * 64 + d]; }
  const float* ky = p.peer_subkeys + (size_t)(l * 16 + hp) * 8192;
  for (int i = tid; i < 128 * 64; i += NT) { int k = i >> 6, d = i & 63; sKy[k * 65 + d] = ky[i]; }
  __syncthreads();
  const int mt = wave & 3, nh = wave >> 2;
  f32x4 acc[4];
#pragma unroll
  for (int t = 0; t < 4; ++t) acc[t] = f32x4{0.f, 0.f, 0.f, 0.f};
  mm16<4>(acc, sQ + mt * 16 * 65, 65, 1, sKy + nh * 64 * 65, 1, 65, 64);
#pragma unroll
  for (int t2 = 0; t2 < 4; ++t2)
#pragma unroll
    for (int e = 0; e < 4; ++e) {
      size_t t = t0 + mt * 16 + 4 * qd + e; int key = nh * 64 + t2 * 16 + r;
      p.scores[(t * 16 + hp) * 128 + key] = acc[t2][e];
    }
  __syncthreads();
}

DEVI unsigned ford(float x) { unsigned u = __float_as_uint(x); return (u & 0x80000000u) ? ~u : (u | 0x80000000u); }
DEVI float funord(unsigned u) { return __uint_as_float((u & 0x80000000u) ? (u ^ 0x80000000u) : ~u); }
DEVI void ins16(unsigned (&v)[16], unsigned x) {
#pragma unroll
  for (int j = 0; j < 16; ++j) { unsigned hi = max(v[j], x); x = min(v[j], x); v[j] = hi; }
}

DEVI void peer_topk(const Params& p, int item, char* smem) {
  const int t0 = item * 64;
  float* sS = (float*)smem;
  const int tid = TID();
  const float* base = p.scores + (size_t)t0 * 8 * 256;
  unsigned v1[16], v2[16];
#pragma unroll
  for (int j = 0; j < 16; ++j) { v1[j] = 0u; v2[j] = 0u; }
  for (int s = 0; s < 8; ++s) {
    __syncthreads();
#pragma unroll
    for (int i = 0; i < 8; ++i) {
      int idx = tid + 512 * i, pr = idx >> 3, c4 = idx & 7;
      float4 v = *(const float4*)&base[(size_t)pr * 256 + s * 32 + c4 * 4];
      float* d = &sS[pr * 33 + c4 * 4];
      d[0] = v.x; d[1] = v.y; d[2] = v.z; d[3] = v.w;
    }
    __syncthreads();
    const int kb = (s & 3) * 32;
    if (s < 4) {
      for (int k = 0; k < 32; ++k) { unsigned key = (ford(sS[tid * 33 + k]) & ~127u) | (unsigned)(127 - (kb + k)); ins16(v1, key); }
    } else {
      for (int k = 0; k < 32; ++k) { unsigned key = (ford(sS[tid * 33 + k]) & ~127u) | (unsigned)(127 - (kb + k)); ins16(v2, key); }
    }
  }
  __syncthreads();
  unsigned* sI = (unsigned*)smem;
  float s1[16], s2[16];
#pragma unroll
  for (int a = 0; a < 16; ++a) {
    s1[a] = funord(v1[a] & ~127u); s2[a] = funord(v2[a] & ~127u);
    sI[tid * 33 + a] = 127u - (v1[a] & 127u); sI[tid * 33 + 16 + a] = 127u - (v2[a] & 127u);
  }
  unsigned vt[16];
#pragma unroll
  for (int j = 0; j < 16; ++j) vt[j] = 0u;
#pragma unroll
  for (int a = 0; a < 16; ++a)
#pragma unroll
    for (int b = 0; b < 16; ++b)
      if ((a + 1) * (b + 1) <= 16) {
        unsigned key = (ford(s1[a] + s2[b]) & ~255u) | (unsigned)(255 - (a * 16 + b));
        ins16(vt, key);
      }
  float sv[16]; float den = 0.f;
  const float mx = funord(vt[0] & ~255u);
#pragma unroll
  for (int k = 0; k < 16; ++k) { sv[k] = expf(funord(vt[k] & ~255u) - mx); den += sv[k]; }
  const float inv = 1.f / den;
  const int tl = tid >> 3, hh = tid & 7;
  int* idp = p.ids + (size_t)(t0 + tl) * 128 + hh * 16;
  float* gp = p.gates + (size_t)(t0 + tl) * 128 + hh * 16;
#pragma unroll
  for (int k = 0; k < 16; ++k) {
    unsigned pos = 255u - (vt[k] & 255u);
    unsigned i1 = sI[tid * 33 + (pos >> 4)], i2 = sI[tid * 33 + 16 + (pos & 15)];
    idp[k] = (int)(i1 * 128u + i2);
    gp[k] = sv[k] * inv;
  }
  __syncthreads();
}

DEVI void bf8_to_f(const uint4& v, float (&o)[8]) {
  o[0] = __uint_as_float(v.x << 16); o[1] = __uint_as_float(v.x & 0xFFFF0000u);
  o[2] = __uint_as_float(v.y << 16); o[3] = __uint_as_float(v.y & 0xFFFF0000u);
  o[4] = __uint_as_float(v.z << 16); o[5] = __uint_as_float(v.z & 0xFFFF0000u);
  o[6] = __uint_as_float(v.w << 16); o[7] = __uint_as_float(v.w & 0xFFFF0000u);
}

DEVI void ph_gather(const Params& p, int l) {
  const int lane = TID() & 63, wave = TID() >> 6;
  const int e0 = lane * 8, e1 = 512 + lane * 8;
  for (int t = blockIdx.x * 8 + wave; t < S_; t += gridDim.x * 8) {
    float* hrow = p.h + (size_t)t * DM;
    float hv[16], z[16], out[16];
    {
      float4 a = *(const float4*)&hrow[e0], b = *(const float4*)&hrow[e0 + 4];
      float4 c = *(const float4*)&hrow[e1], d = *(const float4*)&hrow[e1 + 4];
      hv[0] = a.x; hv[1] = a.y; hv[2] = a.z; hv[3] = a.w; hv[4] = b.x; hv[5] = b.y; hv[6] = b.z; hv[7] = b.w;
      hv[8] = c.x; hv[9] = c.y; hv[10] = c.z; hv[11] = c.w; hv[12] = d.x; hv[13] = d.y; hv[14] = d.z; hv[15] = d.w;
    }
    float ss = 0.f;
#pragma unroll
    for (int k = 0; k < 16; ++k) { ss += hv[k] * hv[k]; out[k] = 0.f; }
    ss = wave_sum(ss);
    float rs = rsqrtf(ss * (1.f / DM) + EPS);
    const float* fn = p.ffn_norm + l * DM;
#pragma unroll
    for (int k = 0; k < 8; ++k) { z[k] = hv[k] * rs * fn[e0 + k]; z[8 + k] = hv[8 + k] * rs * fn[e1 + k]; }
    for (int half = 0; half < 2; ++half) {
      const int idv = p.ids[(size_t)t * 128 + half * 64 + lane];
      const float gtv = p.gates[(size_t)t * 128 + half * 64 + lane];
      for (int kb = 0; kb < 16; ++kb) {
        uint4 uu[4][2], vv[4][2]; float dot[4], gt[4];
#pragma unroll
        for (int j = 0; j < 4; ++j) {
          int e = __shfl(idv, kb * 4 + j);
          gt[j] = __shfl(gtv, kb * 4 + j);
          const bf16_t* ur = p.tabU + (size_t)e * 1024; const bf16_t* vr = p.tabV + (size_t)e * 1024;
          uu[j][0] = *(const uint4*)&ur[e0]; uu[j][1] = *(const uint4*)&ur[e1];
          vv[j][0] = *(const uint4*)&vr[e0]; vv[j][1] = *(const uint4*)&vr[e1];
        }
#pragma unroll
        for (int j = 0; j < 4; ++j) {
          float f0[8], f1[8]; bf8_to_f(uu[j][0], f0); bf8_to_f(uu[j][1], f1);
          float d = 0.f;
#pragma unroll
          for (int k = 0; k < 8; ++k) d += z[k] * f0[k] + z[8 + k] * f1[k];
          dot[j] = d;
        }
#pragma unroll
        for (int j = 0; j < 4; ++j) dot[j] = wave_sum(dot[j]);
#pragma unroll
        for (int j = 0; j < 4; ++j) {
          float cf = gt[j] * geluf_(dot[j]);
          float f0[8], f1[8]; bf8_to_f(vv[j][0], f0); bf8_to_f(vv[j][1], f1);
#pragma unroll
          for (int k = 0; k < 8; ++k) { out[k] += cf * f0[k]; out[8 + k] += cf * f1[k]; }
        }
      }
    }
    float s2 = 0.f;
#pragma unroll
    for (int k = 0; k < 16; ++k) { hv[k] += out[k]; s2 += hv[k] * hv[k]; }
    *(float4*)&hrow[e0] = float4{hv[0], hv[1], hv[2], hv[3]}; *(float4*)&hrow[e0 + 4] = float4{hv[4], hv[5], hv[6], hv[7]};
    *(float4*)&hrow[e1] = float4{hv[8], hv[9], hv[10], hv[11]}; *(float4*)&hrow[e1 + 4] = float4{hv[12], hv[13], hv[14], hv[15]};
    s2 = wave_sum(s2);
    float rs2 = rsqrtf(s2 * (1.f / DM) + EPS);
    const float* pn = p.ple_norm + l * DM;
    float zz[16];
#pragma unroll
    for (int k = 0; k < 8; ++k) { zz[k] = hv[k] * rs2 * pn[e0 + k]; zz[8 + k] = hv[8 + k] * rs2 * pn[e1 + k]; }
    *(uint4*)&p.zb[(size_t)t * DM + e0] = uint4{pack2(zz[0], zz[1]), pack2(zz[2], zz[3]), pack2(zz[4], zz[5]), pack2(zz[6], zz[7])};
    *(uint4*)&p.zb[(size_t)t * DM + e1] = uint4{pack2(zz[8], zz[9]), pack2(zz[10], zz[11]), pack2(zz[12], zz[13]), pack2(zz[14], zz[15])};
  }
}

enum { PH_PREP = 0, PH_NORM1, PH_GEMM_IN, PH_MIX_A, PH_MIX_B, PH_MIX_C, PH_GEMM_OUT, PH_NORM2, PH_GEMM_Q, PH_SCORES,
       PH_TOPK, PH_GATHER, PH_GEMM_PLE, PH_FINAL };

DEVI void run_phase(const Params& p, int ph, int l, char* smem) {
  const int G = gridDim.x, B = blockIdx.x;
  switch (ph) {
    case PH_PREP: ph_prep(p, smem); break;
    case PH_NORM1: ph_norm(p.h, p.mix_norm + l * DM, p.zb, nullptr); break;
    case PH_GEMM_IN:
      for (int tile = B; tile < 64 * 23; tile += G) {
        int m0 = (tile / 23) * 256, n0 = (tile % 23) * 128;
        f32x4 acc[4][4];
        gemm_tile<0>(acc, p.zb, DM, p.winT + (size_t)l * PW * 1024, 1024, 1024, m0, n0, nullptr, smem);
        GEMM_EPI_COORDS
#pragma unroll
        for (int i = 0; i < 4; ++i)
#pragma unroll
          for (int j = 0; j < 4; ++j)
            *(f32x4*)&p.proj[(size_t)(erow0 + i * 16) * PW + ecol0 + j * 16] = acc[i][j];
      }
      break;
    case PH_MIX_A:
      for (int it = B; it < 2048; it += G) {
        if (it < 1024) gdn_prep(p, l, it, smem);
        else if (it < 1536) ret_kv(p, l, it - 1024, smem);
        else if (it < 1792) lru_local(p, l, it - 1536, smem);
        else s5_local(p, l, it - 1792, smem);
      }
      break;
    case PH_MIX_B:
      if (B < 16) gdn_chain(p, B >> 2, B & 3, smem);
      else
        for (int it = B - 16; it < 1024; it += G - 16) {
          if (it < 512) ret_out(p, l, it, smem);
          else if (it < 768) s5_out(p, l, it - 512, smem);
          else lru_out(p, l, it - 768, smem);
        }
      break;
    case PH_MIX_C:
      for (int it = B; it < 1024; it += G) gdn_out(p, l, it, smem);
      break;
    case PH_GEMM_OUT:
      for (int tile = B; tile < 64 * 8; tile += G) {
        int m0 = (tile >> 3) * 256, n0 = (tile & 7) * 128;
        f32x4 acc[4][4];
        gemm_tile<1>(acc, p.zb, DM, p.woutT + (size_t)l * 1024 * 1024, 1024, 1024, m0, n0, p.ssq, smem);
        GEMM_EPI_COORDS
#pragma unroll
        for (int i = 0; i < 4; ++i)
#pragma unroll
          for (int j = 0; j < 4; ++j) {
            f32x4* hp = (f32x4*)&p.h[(size_t)(erow0 + i * 16) * DM + ecol0 + j * 16];
            *hp = *hp + acc[i][j];
          }
      }
      break;
    case PH_NORM2:
      ph_norm(p.h, p.ffn_norm + l * DM, p.zb, nullptr);
      convert_tables(p, l);
      break;
    case PH_GEMM_Q:
      for (int tile = B; tile < 64 * 8; tile += G) {
        int m0 = (tile >> 3) * 256, n0 = (tile & 7) * 128;
        f32x4 acc[4][4];
        gemm_tile<0>(acc, p.zb, DM, p.wqT + (size_t)l * 1024 * 1024, 1024, 1024, m0, n0, nullptr, smem);
        GEMM_EPI_COORDS
#pragma unroll
        for (int i = 0; i < 4; ++i)
#pragma unroll
          for (int j = 0; j < 4; ++j)
            *(f32x4*)&p.qbuf[(size_t)(erow0 + i * 16) * DM + ecol0 + j * 16] = acc[i][j];
      }
      break;
    case PH_SCORES:
      for (int it = B; it < 4096; it += G) peer_scores(p, l, it, smem);
      break;
    case PH_TOPK:
      for (int it = B; it < 256; it += G) peer_topk(p, it, smem);
      break;
    case PH_GATHER: ph_gather(p, l); break;
    case PH_GEMM_PLE:
      for (int tile = B; tile < 64 * 8; tile += G) {
        int m0 = (tile >> 3) * 256, n0 = (tile & 7) * 128;
        f32x4 ag[4][4], ap[4][4];
        gemm_tile<0>(ag, p.zb, DM, p.wgT + (size_t)l * 1024 * 1024, 1024, 1024, m0, n0, nullptr, smem);
        gemm_tile<2>(ap, p.p + (size_t)l * S_ * 256, 256, p.wpT + (size_t)l * 1024 * 256, 256, 256, m0, n0, nullptr, smem);
        GEMM_EPI_COORDS
#pragma unroll
        for (int i = 0; i < 4; ++i)
#pragma unroll
          for (int j = 0; j < 4; ++j) {
            f32x4* hp = (f32x4*)&p.h[(size_t)(erow0 + i * 16) * DM + ecol0 + j * 16];
            f32x4 hv = *hp;
#pragma unroll
            for (int e = 0; e < 4; ++e) hv[e] += ap[i][j][e] * sigmoidf_(ag[i][j][e]);
            *hp = hv;
          }
      }
      break;
    case PH_FINAL: ph_norm(p.h, p.final_norm, nullptr, p.out); break;
  }
}

#if !MEGA
__global__ void __launch_bounds__(NT) k_phase(Params p, int ph, int l) {
  extern __shared__ __align__(16) char smem[];
  run_phase(p, ph, l, smem);
}
#endif

#if MEGA
__global__ void __launch_bounds__(NT) k_mega(Params p) {
  extern __shared__ __align__(16) char smem[];
  cg::grid_group grid = cg::this_grid();
#pragma unroll 1
  for (int i = 0; i < 26; ++i) {
    int ph, l;
    if (i == 0) { ph = PH_PREP; l = 0; }
    else if (i == 25) { ph = PH_FINAL; l = 0; }
    else { l = (i - 1) / 12; ph = PH_NORM1 + (i - 1) % 12; }
    asm volatile("" : "+s"(ph), "+s"(l));
    run_phase(p, ph, l, smem);
    if (i < 25) grid.sync();
  }
}
#endif

extern "C" void kernel_launch(void* const* d_in, const int* in_sizes, int n_in, void* d_out, int out_size, void* d_ws,
                              size_t ws_size, hipStream_t stream) {
  Params p{};
  const float* const* f = (const float* const*)d_in;
  p.x = f[0]; p.p = f[1]; p.pos = (const int*)d_in[2];
  p.mix_norm = f[3]; p.w_in = f[4]; p.ret_gn = f[5]; p.lru_conv_w = f[6]; p.lru_conv_b = f[7]; p.lru_w_a = f[8];
  p.lru_b_a = f[9]; p.lru_w_x = f[10]; p.lru_b_x = f[11]; p.lru_lambda = f[12];
  p.s5_a_re = f[13]; p.s5_a_im = f[14]; p.s5_b_re = f[15]; p.s5_b_im = f[16]; p.s5_c_re = f[17]; p.s5_c_im = f[18];
  p.s5_d = f[19]; p.s5_log_dt = f[20]; p.s5_glu_w = f[21]; p.s5_glu_b = f[22];
  p.gdn_conv_w = f[23]; p.gdn_a_log = f[24]; p.gdn_dt_bias = f[25]; p.gdn_norm = f[26]; p.branch_norm = f[27];
  p.w_out = f[28]; p.ffn_norm = f[29]; p.peer_wq = f[30]; p.peer_subkeys = f[31]; p.peer_u = f[32]; p.peer_v = f[33];
  p.ple_norm = f[34]; p.ple_wg = f[35]; p.ple_wp = f[36]; p.final_norm = f[37];
  p.out = (float*)d_out;
  char* ws = (char*)d_ws;
  const size_t MiB = 1024 * 1024;
  p.h = (float*)(ws + 0 * MiB);
  p.zb = (bf16_t*)(ws + 64 * MiB);
  p.proj = (float*)(ws + 96 * MiB);
  p.qbuf = (float*)(ws + 96 * MiB);
  p.scores = (float*)(ws + 160 * MiB);
  p.g_u = (float*)(ws + 288 * MiB); p.g_w = (float*)(ws + 304 * MiB); p.g_attn = (float*)(ws + 320 * MiB);
  p.g_qd = (float*)(ws + 336 * MiB); p.g_kd = (float*)(ws + 352 * MiB);
  p.ids = (int*)(ws + 288 * MiB); p.gates = (float*)(ws + 296 * MiB);
  p.lru_h = (float*)(ws + 368 * MiB); p.lru_p = (float*)(ws + 384 * MiB);
  p.ret_kv = (float*)(ws + 400 * MiB);
  p.tabU = (bf16_t*)(ws + 408 * MiB); p.tabV = (bf16_t*)(ws + 440 * MiB);
  p.g_sst = (float*)(ws + 408 * MiB);
  {
    char* wb = ws + 472 * MiB;
    p.winT = (bf16_t*)wb; wb += (size_t)2 * PW * 1024 * 2;
    p.woutT = (bf16_t*)wb; wb += (size_t)2 * 1024 * 1024 * 2;
    p.wqT = (bf16_t*)wb; wb += (size_t)2 * 1024 * 1024 * 2;
    p.wgT = (bf16_t*)wb; wb += (size_t)2 * 1024 * 1024 * 2;
    p.wpT = (bf16_t*)wb; wb += (size_t)2 * 1024 * 256 * 2;
  }
  p.rope = (float*)(ws + 497 * MiB);
  p.ssq = (float*)(ws + 501 * MiB);
  p.xloc = (float*)(ws + 502 * MiB);
  p.lru_hs = (float*)(ws + 504 * MiB);
  p.lru_ps = (float*)(ws + 504 * MiB + 256 * 256 * 4);
  p.g_cdec = (float*)(ws + 504 * MiB + 2 * 256 * 256 * 4);

  static int grid_blocks = 0;
  if (!grid_blocks) {
#if MEGA
    hipFuncSetAttribute((const void*)k_mega, hipFuncAttributeMaxDynamicSharedMemorySize, LDS_BYTES);
#endif
#if !MEGA
    hipFuncSetAttribute((const void*)k_phase, hipFuncAttributeMaxDynamicSharedMemorySize, LDS_BYTES);
#endif
    int dev = 0, cus = 0, per_cu = 0;
    hipGetDevice(&dev);
    hipDeviceGetAttribute(&cus, hipDeviceAttributeMultiprocessorCount, dev);
#if MEGA
    hipOccupancyMaxActiveBlocksPerMultiprocessor(&per_cu, k_mega, NT, LDS_BYTES);
#else
    hipOccupancyMaxActiveBlocksPerMultiprocessor(&per_cu, k_phase, NT, LDS_BYTES);
#endif
    if (per_cu < 1) per_cu = 1;
    grid_blocks = cus * per_cu;
  }
#if MEGA
  void* args[] = {&p};
  hipError_t e = hipLaunchCooperativeKernel((void*)k_mega, dim3(grid_blocks), dim3(NT), args, LDS_BYTES, stream);
  if (e != hipSuccess) fprintf(stderr, "cooperative launch failed: %s (grid %d)\n", hipGetErrorString(e), grid_blocks);
#else
  k_phase<<<grid_blocks, NT, LDS_BYTES, stream>>>(p, PH_PREP, 0);
  for (int l = 0; l < NL; ++l)
    for (int ph = PH_NORM1; ph <= PH_GEMM_PLE; ++ph) k_phase<<<grid_blocks, NT, LDS_BYTES, stream>>>(p, ph, l);
  k_phase<<<grid_blocks, NT, LDS_BYTES, stream>>>(p, PH_FINAL, 0);
#endif
}
```

```cpp
#include <hip/hip_runtime.h>
#include <hip/hip_bf16.h>
#include <hip/hip_cooperative_groups.h>
#include <cstdio>
#include <cstdint>
namespace cg = cooperative_groups;

#ifndef MEGA
#define MEGA 1
#endif

#ifndef PROBE_A
#define PROBE_A -1
#endif
#ifndef PROBE_B
#define PROBE_B -1
#endif
#define DEVI __device__ __forceinline__

typedef __attribute__((ext_vector_type(8))) short bf16x8;
typedef __attribute__((ext_vector_type(4))) float f32x4;
typedef unsigned short bf16_t;

constexpr int NT = 512;
constexpr int S_ = 16384, DM = 1024, NL = 2, PW = 2944, INW = 2824;
constexpr int RQ = 0, RK = 256, RV = 512, RG = 768, LG = 1024, LX = 1280, SU = 1536, DQ = 1792,
              DB = 2560, DA = 2564, DG = 2568;
constexpr float EPS = 1e-6f;
constexpr int LDS_BYTES = 132 * 1024;

struct Params {
  const float *x, *p; const int* pos;
  const float *mix_norm, *w_in, *ret_gn, *lru_conv_w, *lru_conv_b, *lru_w_a, *lru_b_a, *lru_w_x, *lru_b_x, *lru_lambda;
  const float *s5_a_re, *s5_a_im, *s5_b_re, *s5_b_im, *s5_c_re, *s5_c_im, *s5_d, *s5_log_dt, *s5_glu_w, *s5_glu_b;
  const float *gdn_conv_w, *gdn_a_log, *gdn_dt_bias, *gdn_norm, *branch_norm, *w_out, *ffn_norm, *peer_wq, *peer_subkeys;
  const float *peer_u, *peer_v, *ple_norm, *ple_wg, *ple_wp, *final_norm;
  float* out;
  float* h; bf16_t* zb; float* proj; float* qbuf; float* scores;
  float *g_u, *g_w, *g_attn, *g_qd, *g_kd, *g_sst, *g_cdec, *g_comp;
  int* ids; float* gates;
  float *lru_h, *lru_p, *lru_hs, *lru_ps;
  float* ret_kv; float* xloc;
  uint8_t *tabU, *tabV; float *uinv, *vinv;
  bf16_t *winT, *woutT, *wqT, *wgT, *wpT, *gluT;
  float* rope; float* ssq; bf16_t* pbf;
};

DEVI int TID() { int t = __builtin_amdgcn_workitem_id_x(); asm volatile("" : "+v"(t)); return t; }
DEVI bf16_t f2bf(float f) { unsigned u = __float_as_uint(f); u += 0x7FFFu + ((u >> 16) & 1u); return (bf16_t)(u >> 16); }
DEVI float bf2f(bf16_t b) { return __uint_as_float(((unsigned)b) << 16); }
DEVI unsigned pack2(float a, float b) { return (unsigned)f2bf(a) | ((unsigned)f2bf(b) << 16); }
DEVI float sigmoidf_(float x) { return 1.f / (1.f + expf(-x)); }
DEVI float siluf_(float x) { return x / (1.f + expf(-x)); }
DEVI float geluf_(float x) { float u = 0.7978845608028654f * (x + 0.044715f * x * x * x); return 0.5f * x * (1.f + tanhf(u)); }
DEVI float softplusf_(float x) { return x > 20.f ? x : log1pf(expf(x)); }
DEVI float wave_sum(float v) {
  v += __shfl_xor(v, 32); v += __shfl_xor(v, 16); v += __shfl_xor(v, 8);
  v += __shfl_xor(v, 4); v += __shfl_xor(v, 2); v += __shfl_xor(v, 1); return v;
}
DEVI float sum16(float v) {
  v += __shfl_xor(v, 8); v += __shfl_xor(v, 4); v += __shfl_xor(v, 2); v += __shfl_xor(v, 1); return v;
}

template <int NTL>
DEVI void mm16(f32x4 (&acc)[NTL], const float* A, int sam, int sak, const float* B, int sbk, int sbn, int K) {
  const int l = TID() & 63, r = l & 15, q = l >> 4;
  const float* ap = A + r * sam + q * sak;
  const float* bp = B + q * sbk + r * sbn;
#pragma unroll 4
  for (int k = 0; k < K; k += 4) {
    float a = ap[k * sak];
#pragma unroll
    for (int t = 0; t < NTL; ++t) {
      float b = bp[k * sbk + t * 16 * sbn];
      acc[t] = __builtin_amdgcn_mfma_f32_16x16x4f32(a, b, acc[t], 0, 0, 0);
    }
  }
}

template <int AMODE, bool D2 = true>
DEVI void gemm_tile(f32x4 (&acc)[4][4], const void* Aptr, int lda, const bf16_t* Bt, int ldb, int K, int m0, int n0,
                    const float* ssq, char* smem) {
  constexpr int LDT = 72, BUF = (256 + 128) * LDT;
  bf16_t* sbase = (bf16_t*)smem;
  const int tid = TID(), lane = tid & 63, wave = tid >> 6;
  const int wm = wave >> 1, wn = wave & 1, r = lane & 15, q = lane >> 4;
  const int lrow = tid >> 3, lkc = tid & 7;
  uint4 raA0, raA1, raA2, raA3, rbA0, rbA1, raB0, raB1, raB2, raB3, rbB0, rbB1;
  float rs0 = 1.f, rs1 = 1.f, rs2 = 1.f, rs3 = 1.f;
#pragma unroll
  for (int i = 0; i < 4; ++i)
#pragma unroll
    for (int j = 0; j < 4; ++j) acc[i][j] = f32x4{0.f, 0.f, 0.f, 0.f};
  const bf16_t* Ab = (const bf16_t*)Aptr + (size_t)(m0 + lrow) * lda + lkc * 8;
  const bf16_t* Bb = Bt + (size_t)(n0 + lrow) * ldb + lkc * 8;
#define GL(S, k0_)                                                    \
  {                                                                   \
    ra##S##0 = *(const uint4*)(Ab + (k0_));                           \
    ra##S##1 = *(const uint4*)(Ab + (size_t)64 * lda + (k0_));        \
    ra##S##2 = *(const uint4*)(Ab + (size_t)128 * lda + (k0_));       \
    ra##S##3 = *(const uint4*)(Ab + (size_t)192 * lda + (k0_));       \
    rb##S##0 = *(const uint4*)(Bb + (k0_));                           \
    rb##S##1 = *(const uint4*)(Bb + (size_t)64 * ldb + (k0_));        \
  }
  auto scale = [&](uint4 v, float s) {
    unsigned w[4] = {v.x, v.y, v.z, v.w};
#pragma unroll
    for (int j = 0; j < 4; ++j) {
      float lo = __uint_as_float(w[j] << 16) * s, hi = __uint_as_float(w[j] & 0xFFFF0000u) * s;
      w[j] = pack2(lo, hi);
    }
    return uint4{w[0], w[1], w[2], w[3]};
  };
  auto rowscale = [&](int row, int k0) {
    const float* sp = ssq + (size_t)(m0 + row) * 16;
    int seg = k0 >> 8;
    float s = seg == 0 ? (sp[0] + sp[1] + sp[2] + sp[3]) : seg == 1 ? sp[4] : seg == 2 ? sp[5] : (sp[8] + sp[9] + sp[10] + sp[11]);
    return rsqrtf(s * (1.f / 256.f) + EPS);
  };
#define LS(S, k0_, bi_)                                                               \
  {                                                                                   \
    bf16_t* As_ = sbase + (bi_) * BUF; bf16_t* Bs_ = As_ + 256 * LDT;                 \
    if constexpr (AMODE == 1) {                                                       \
      if (((k0_) & 255) == 0) {                                                       \
        rs0 = rowscale(lrow, (k0_)); rs1 = rowscale(lrow + 64, (k0_));                \
        rs2 = rowscale(lrow + 128, (k0_)); rs3 = rowscale(lrow + 192, (k0_));         \
      }                                                                               \
      ra##S##0 = scale(ra##S##0, rs0); ra##S##1 = scale(ra##S##1, rs1);               \
      ra##S##2 = scale(ra##S##2, rs2); ra##S##3 = scale(ra##S##3, rs3);               \
    }                                                                                 \
    *(uint4*)&As_[(lrow) * LDT + lkc * 8] = ra##S##0;                                 \
    *(uint4*)&As_[(lrow + 64) * LDT + lkc * 8] = ra##S##1;                            \
    *(uint4*)&As_[(lrow + 128) * LDT + lkc * 8] = ra##S##2;                           \
    *(uint4*)&As_[(lrow + 192) * LDT + lkc * 8] = ra##S##3;                           \
    *(uint4*)&Bs_[(lrow) * LDT + lkc * 8] = rb##S##0;                                 \
    *(uint4*)&Bs_[(lrow + 64) * LDT + lkc * 8] = rb##S##1;                            \
  }
  auto compute = [&](int bi) {
    const bf16_t* As = sbase + bi * BUF; const bf16_t* Bs = As + 256 * LDT;
#pragma unroll
    for (int kk = 0; kk < 2; ++kk) {
      bf16x8 a[4], b[4];
#pragma unroll
      for (int i = 0; i < 4; ++i) a[i] = *(const bf16x8*)&As[(wm * 64 + i * 16 + r) * LDT + kk * 32 + q * 8];
#pragma unroll
      for (int j = 0; j < 4; ++j) b[j] = *(const bf16x8*)&Bs[(wn * 64 + j * 16 + r) * LDT + kk * 32 + q * 8];
#pragma unroll
      for (int i = 0; i < 4; ++i)
#pragma unroll
        for (int j = 0; j < 4; ++j)
          acc[i][j] = __builtin_amdgcn_mfma_f32_16x16x32_bf16(b[j], a[i], acc[i][j], 0, 0, 0);
    }
  };

  const int nk = K >> 6;
  __syncthreads();
  GL(A, 0)
  LS(A, 0, 0)
  if constexpr (!D2) {
    __syncthreads();
    for (int kt = 0; kt < nk; ++kt) {
      if (kt + 1 < nk) GL(A, (kt + 1) << 6)
      compute(kt & 1);
      if (kt + 1 < nk) LS(A, (kt + 1) << 6, (kt + 1) & 1)
      __syncthreads();
    }
  } else {
    GL(A, 64)
    GL(B, (nk > 2 ? 128 : 64))
    __syncthreads();
    for (int kt = 0; kt < nk; kt += 2) {
      compute(0);
      LS(A, (kt + 1) << 6, 1)
      __syncthreads();
      if (kt + 3 < nk) GL(A, (kt + 3) << 6)
      compute(1);
      if (kt + 2 < nk) LS(B, (kt + 2) << 6, 0)
      __syncthreads();
      if (kt + 4 < nk) GL(B, (kt + 4) << 6)
    }
  }
#undef GL
#undef LS
}
#define GEMM_EPI_COORDS                                                   \
  const int lane_ = TID() & 63, wave_ = TID() >> 6;           \
  const int erow0 = m0 + (wave_ >> 1) * 64 + (lane_ & 15);                \
  const int ecol0 = n0 + (wave_ & 1) * 64 + (lane_ >> 4) * 4;

DEVI void transpose_tile(const float* W, int ldw, int nvalid, bf16_t* Bt, int ldbt, int k0, int n0, char* smem) {
  float* t = (float*)smem;
  const int tid = TID();
  {
    int i = tid >> 4, j4 = tid & 15;
#pragma unroll
    for (int h2 = 0; h2 < 2; ++h2) {
      int kk = i + 32 * h2;
      int n = n0 + j4 * 4;
      float4 v = float4{0.f, 0.f, 0.f, 0.f};
      if (n < nvalid) v = *(const float4*)&W[(size_t)(k0 + kk) * ldw + n];
      t[(j4 * 4 + 0) * 65 + kk] = v.x; t[(j4 * 4 + 1) * 65 + kk] = v.y;
      t[(j4 * 4 + 2) * 65 + kk] = v.z; t[(j4 * 4 + 3) * 65 + kk] = v.w;
    }
  }
  __syncthreads();
  {
    int n = tid >> 3, k8 = tid & 7;
    const float* s = &t[n * 65 + k8 * 8];
    uint4 v;
    v.x = pack2(s[0], s[1]); v.y = pack2(s[2], s[3]); v.z = pack2(s[4], s[5]); v.w = pack2(s[6], s[7]);
    *(uint4*)&Bt[(size_t)(n0 + n) * ldbt + k0 + k8 * 8] = v;
  }
  __syncthreads();
}

DEVI void convert_tables(const Params& p, int l) {
  const int lane = TID() & 63, wave = TID() >> 6;
  for (int rr = blockIdx.x * 8 + wave; rr < 2 * 16384; rr += gridDim.x * 8) {
    const int which = rr >> 14, row = rr & 16383;
    const float* src = (which ? p.peer_v : p.peer_u) + ((size_t)l * 16384 + row) * 1024 + lane * 16;
    float4 a = *(const float4*)src, b = *(const float4*)(src + 4), c = *(const float4*)(src + 8), d = *(const float4*)(src + 12);
    float m = fmaxf(fmaxf(fmaxf(fabsf(a.x), fabsf(a.y)), fmaxf(fabsf(a.z), fabsf(a.w))),
                    fmaxf(fmaxf(fabsf(b.x), fabsf(b.y)), fmaxf(fabsf(b.z), fabsf(b.w))));
    m = fmaxf(m, fmaxf(fmaxf(fmaxf(fabsf(c.x), fabsf(c.y)), fmaxf(fabsf(c.z), fabsf(c.w))),
                       fmaxf(fmaxf(fabsf(d.x), fabsf(d.y)), fmaxf(fabsf(d.z), fabsf(d.w)))));
    m = fmaxf(m, __shfl_xor(m, 32)); m = fmaxf(m, __shfl_xor(m, 16)); m = fmaxf(m, __shfl_xor(m, 8));
    m = fmaxf(m, __shfl_xor(m, 4)); m = fmaxf(m, __shfl_xor(m, 2)); m = fmaxf(m, __shfl_xor(m, 1));
    const float sc = m > 0.f ? 256.f / m : 1.f;
    int w0 = 0, w1 = 0, w2 = 0, w3 = 0;
    w0 = __builtin_amdgcn_cvt_pk_fp8_f32(a.x * sc, a.y * sc, w0, false); w0 = __builtin_amdgcn_cvt_pk_fp8_f32(a.z * sc, a.w * sc, w0, true);
    w1 = __builtin_amdgcn_cvt_pk_fp8_f32(b.x * sc, b.y * sc, w1, false); w1 = __builtin_amdgcn_cvt_pk_fp8_f32(b.z * sc, b.w * sc, w1, true);
    w2 = __builtin_amdgcn_cvt_pk_fp8_f32(c.x * sc, c.y * sc, w2, false); w2 = __builtin_amdgcn_cvt_pk_fp8_f32(c.z * sc, c.w * sc, w2, true);
    w3 = __builtin_amdgcn_cvt_pk_fp8_f32(d.x * sc, d.y * sc, w3, false); w3 = __builtin_amdgcn_cvt_pk_fp8_f32(d.z * sc, d.w * sc, w3, true);
    *(uint4*)((which ? p.tabV : p.tabU) + (size_t)row * 1024 + lane * 16) = uint4{(unsigned)w0, (unsigned)w1, (unsigned)w2, (unsigned)w3};
    if (lane == 0) (which ? p.vinv : p.uinv)[row] = m > 0.f ? m * (1.f / 256.f) : 1.f;
  }
}

DEVI void ph_prep(const Params& p, char* smem) {
  const size_t gtid = (size_t)blockIdx.x * NT + TID(), gsz = (size_t)gridDim.x * NT;
  for (size_t i = gtid; i < (size_t)S_ * DM / 4; i += gsz) ((float4*)p.h)[i] = ((const float4*)p.x)[i];
  for (size_t i = gtid; i < (size_t)S_ * 32; i += gsz) {
    int t = (int)(i >> 5), f = (int)(i & 31);
    float inv = powf(10000.f, -(float)f / 32.f);
    float ang = (float)p.pos[t] * inv;
    p.rope[2 * i] = cosf(ang); p.rope[2 * i + 1] = sinf(ang);
  }
  for (int it = blockIdx.x; it < 2 * 1600; it += gridDim.x) {
    int l = it / 1600, idx = it % 1600;
    if (idx >= 1568) {
      int j = idx - 1568; int kt = j >> 3, nt = j & 7;
      transpose_tile(p.s5_glu_w + (size_t)l * 256 * 512, 512, 512, p.gluT + (size_t)l * 512 * 256, 256, kt * 64, nt * 64, smem);
    } else if (idx < 736) {
      int kt = idx / 46, nt = idx % 46;
      transpose_tile(p.w_in + (size_t)l * 1024 * INW, INW, INW, p.winT + (size_t)l * PW * 1024, 1024, kt * 64, nt * 64, smem);
    } else if (idx < 1504) {
      int j = idx - 736; int which = j >> 8; j &= 255;
      int kt = j >> 4, nt = j & 15;
      const float* src = (which == 0 ? p.w_out : which == 1 ? p.peer_wq : p.ple_wg) + (size_t)l * 1024 * 1024;
      bf16_t* dst = (which == 0 ? p.woutT : which == 1 ? p.wqT : p.wgT) + (size_t)l * 1024 * 1024;
      transpose_tile(src, 1024, 1024, dst, 1024, kt * 64, nt * 64, smem);
    } else {
      int j = idx - 1504; int kt = j >> 4, nt = j & 15;
      transpose_tile(p.ple_wp + (size_t)l * 256 * 1024, 1024, 1024, p.wpT + (size_t)l * 1024 * 256, 256, kt * 64, nt * 64, smem);
    }
  }
}

DEVI void ph_norm(const float* src, const float* g, bf16_t* dst, float* fout) {
  const int lane = TID() & 63, wave = TID() >> 6;
  for (int t = blockIdx.x * 8 + wave; t < S_; t += gridDim.x * 8) {
    const float* row = src + (size_t)t * DM;
    float4 v[4]; float ss = 0.f;
#pragma unroll
    for (int i = 0; i < 4; ++i) {
      v[i] = *(const float4*)&row[i * 256 + lane * 4];
      ss += v[i].x * v[i].x + v[i].y * v[i].y + v[i].z * v[i].z + v[i].w * v[i].w;
    }
    ss = wave_sum(ss);
    float rs = rsqrtf(ss * (1.f / DM) + EPS);
#pragma unroll
    for (int i = 0; i < 4; ++i) {
      float4 gg = *(const float4*)&g[i * 256 + lane * 4];
      float a = v[i].x * rs * gg.x, b = v[i].y * rs * gg.y, c = v[i].z * rs * gg.z, d = v[i].w * rs * gg.w;
      if (dst) *(uint2*)&dst[(size_t)t * DM + i * 256 + lane * 4] = uint2{pack2(a, b), pack2(c, d)};
      else *(float4*)&fout[(size_t)t * DM + i * 256 + lane * 4] = float4{a, b, c, d};
    }
  }
}

DEVI void gdn_prep(const Params& p, int l, int item, char* smem) {
  const int c = item >> 2, hd = item & 3, t0 = c * 64;
  float* sq = (float*)smem; float* sk = sq + 64 * 65; float* sv = sk + 64 * 65;
  float* sL = sv + 64 * 65;
  float* sgc = sL + 64 * 68; float* sbeta = sgc + 64;
  const int tid = TID(), lane = tid & 63, wave = tid >> 6, r = lane & 15, qd = lane >> 4;
  const float* cw = p.gdn_conv_w + (size_t)l * 4 * 768;
  for (int i = tid; i < 3 * 64 * 64; i += NT) {
    int d = i & 63, t = (i >> 6) & 63, which = i >> 12;
    int ch = which * 256 + hd * 64 + d;
    float acc = 0.f;
#pragma unroll
    for (int j = 0; j < 4; ++j) {
      int tt = t0 + t - 3 + j;
      if (tt >= 0) acc += cw[j * 768 + ch] * p.proj[(size_t)tt * PW + DQ + ch];
    }
    float v = siluf_(acc);
    (which == 0 ? sq : which == 1 ? sk : sv)[t * 65 + d] = v;
  }
  __syncthreads();
  if (tid < 128) {
    int t = tid & 63; float* row = (tid < 64 ? sq : sk) + t * 65;
    float s = 0.f;
    for (int d = 0; d < 64; ++d) s += row[d] * row[d];
    float sc = rsqrtf(s + EPS) * (tid < 64 ? 0.125f : 1.f);
    for (int d = 0; d < 64; ++d) row[d] *= sc;
  } else if (tid < 192) {
    int t = tid - 128;
    float bl = p.proj[(size_t)(t0 + t) * PW + DB + hd];
    float al = p.proj[(size_t)(t0 + t) * PW + DA + hd];
    float la = -expf(p.gdn_a_log[l * 4 + hd]) * softplusf_(al + p.gdn_dt_bias[l * 4 + hd]);
    for (int off = 1; off < 64; off <<= 1) { float n = __shfl_up(la, off); if (lane >= off) la += n; }
    sgc[t] = la; sbeta[t] = sigmoidf_(bl);
  }
  __syncthreads();
  {
    int mat = wave >> 2, mt = wave & 3;
    f32x4 acc[4];
#pragma unroll
    for (int t = 0; t < 4; ++t) acc[t] = f32x4{0.f, 0.f, 0.f, 0.f};
    mm16<4>(acc, (mat == 0 ? sk : sq) + mt * 16 * 65, 65, 1, sk, 1, 65, 64);
#pragma unroll
    for (int t = 0; t < 4; ++t)
#pragma unroll
      for (int e = 0; e < 4; ++e) {
        int i = mt * 16 + 4 * qd + e, j = t * 16 + r;
        float g = (i >= j) ? expf(sgc[i] - sgc[j]) : 0.f;
        if (mat == 0) sL[i * 68 + j] = (i > j) ? acc[t][e] * sbeta[i] * g : 0.f;
        else p.g_attn[((size_t)item * 64 + i) * 64 + j] = (i >= j) ? acc[t][e] * g : 0.f;
      }
  }
  __syncthreads();
  if (tid < 128) {
    const bool isv = tid < 64; const int d = tid & 63;
    float X[64];
#pragma unroll
    for (int i = 0; i < 64; ++i) X[i] = 0.f;
    float* dst = (isv ? p.g_u : p.g_w) + (size_t)item * 4096 + d;
#pragma unroll
    for (int i = 0; i < 64; ++i) {
      float bi = sbeta[i];
      float s = isv ? sv[i * 65 + d] * bi : sk[i * 65 + d] * bi * expf(sgc[i]);
#pragma unroll
      for (int j4 = 0; j4 < (i + 3) / 4; ++j4) {
        float4 lv = *(const float4*)&sL[i * 68 + j4 * 4];
        s -= lv.x * X[j4 * 4 + 0]; s -= lv.y * X[j4 * 4 + 1]; s -= lv.z * X[j4 * 4 + 2]; s -= lv.w * X[j4 * 4 + 3];
      }
      X[i] = s;
      dst[i * 64] = s;
    }
  } else {
    for (int i2 = tid - 128; i2 < 8192; i2 += 384) {
      int which = i2 >> 12, i = (i2 >> 6) & 63, d = i2 & 63;
      float val = which == 0 ? sq[i * 65 + d] * expf(sgc[i]) : sk[i * 65 + d] * expf(sgc[63] - sgc[i]);
      (which == 0 ? p.g_qd : p.g_kd)[(size_t)item * 4096 + i * 64 + d] = val;
    }
    if (tid == 128) p.g_cdec[item] = expf(sgc[63]);
  }
  __syncthreads();
}

DEVI f32x4 mm16_k64(const float* A, int sam, int sak, const float* B, int sbk, int sbn) {
  const int l = TID() & 63, r = l & 15, q = l >> 4;
  const float* ap = A + r * sam + q * sak;
  const float* bp = B + q * sbk + r * sbn;
  float av[16], bv[16];
#pragma unroll
  for (int k = 0; k < 16; ++k) { av[k] = ap[4 * k * sak]; bv[k] = bp[4 * k * sbk]; }
  f32x4 c0 = f32x4{0.f, 0.f, 0.f, 0.f}, c1 = f32x4{0.f, 0.f, 0.f, 0.f};
#pragma unroll
  for (int k = 0; k < 16; k += 2) {
    c0 = __builtin_amdgcn_mfma_f32_16x16x4f32(av[k], bv[k], c0, 0, 0, 0);
    c1 = __builtin_amdgcn_mfma_f32_16x16x4f32(av[k + 1], bv[k + 1], c1, 0, 0, 0);
  }
  return c0 + c1;
}

template <int MODE>
DEVI void gdn_chain(const Params& p, int hd, int grp, int cb, char* smem) {
  float* base = (float*)smem;
  constexpr int BUFSZ = 64 * 68 * 2 + 64 * 16;
  float* sS = base + 2 * BUFSZ; float* sVN = sS + 1024;
  const int tid = TID(), lane = tid & 63, wave = tid >> 6, r = lane & 15, qd = lane >> 4;
  const bool apart = (MODE == 0) && (cb >= 4);
  const int e0 = (cb & 3) * 16;
  const int c0 = grp * 32;
  float4 pw0, pw1, pkd0, pkd1, pu = float4{0.f, 0.f, 0.f, 0.f};
  const int lr0 = tid >> 4, lc0 = (tid & 15) * 4, lr1 = lr0 + 32;
  const int ur = tid >> 2, uc = (tid & 3) * 4;
#define GLOAD(c_)                                                            \
  {                                                                          \
    size_t b_ = (size_t)((c_) * 4 + hd) * 4096;                              \
    pw0 = *(const float4*)&p.g_w[b_ + lr0 * 64 + lc0];                       \
    pw1 = *(const float4*)&p.g_w[b_ + lr1 * 64 + lc0];                       \
    pkd0 = *(const float4*)&p.g_kd[b_ + lr0 * 64 + lc0];                     \
    pkd1 = *(const float4*)&p.g_kd[b_ + lr1 * 64 + lc0];                     \
    if (tid < 256 && !apart) pu = *(const float4*)&p.g_u[b_ + ur * 64 + e0 + uc]; \
  }
#define LSTORE(bi_)                                                          \
  {                                                                          \
    float* W_ = base + (bi_) * BUFSZ; float* KD_ = W_ + 64 * 68; float* U_ = KD_ + 64 * 68; \
    *(float4*)&W_[lr0 * 68 + lc0] = pw0; *(float4*)&W_[lr1 * 68 + lc0] = pw1;       \
    *(float4*)&KD_[lr0 * 68 + lc0] = pkd0; *(float4*)&KD_[lr1 * 68 + lc0] = pkd1;   \
    if (tid < 256) *(float4*)&U_[ur * 16 + uc] = pu;                         \
  }
  f32x4 sreg = f32x4{0.f, 0.f, 0.f, 0.f};
  if (MODE == 0) {
    for (int i = tid; i < 1024; i += NT) sS[i] = (apart && ((i >> 4) == e0 + (i & 15))) ? 1.f : 0.f;
    if (apart) {
#pragma unroll
      for (int e = 0; e < 4; ++e) sreg[e] = ((wave & 3) * 16 + 4 * qd + e == e0 + r) ? 1.f : 0.f;
    }
  } else {
    for (int i = tid; i < 1024; i += NT) sS[i] = 0.f;
    float* W = base;
    for (int g2 = 0; g2 < grp; ++g2) {
      const float* Ag = p.g_comp + ((size_t)(hd * 8 + g2) * 2 + 1) * 4096;
      const float* Bg = p.g_comp + ((size_t)(hd * 8 + g2) * 2 + 0) * 4096;
      __syncthreads();
      *(float4*)&W[lr0 * 68 + lc0] = *(const float4*)&Ag[lr0 * 64 + lc0];
      *(float4*)&W[lr1 * 68 + lc0] = *(const float4*)&Ag[lr1 * 64 + lc0];
      __syncthreads();
      f32x4 a = f32x4{0.f, 0.f, 0.f, 0.f};
      if (wave < 4) a = mm16_k64(W + wave * 16 * 68, 68, 1, sS, 16, 1);
      __syncthreads();
      if (wave < 4) {
#pragma unroll
        for (int e = 0; e < 4; ++e) {
          int d = wave * 16 + 4 * qd + e;
          sreg[e] = a[e] + Bg[d * 64 + e0 + r];
          sS[d * 16 + r] = sreg[e];
        }
      }
    }
    __syncthreads();
    if (wave < 4) {
#pragma unroll
      for (int e = 0; e < 4; ++e) {
        int d = wave * 16 + 4 * qd + e;
        p.g_sst[(size_t)(c0 * 4 + hd) * 4096 + d * 64 + e0 + r] = sreg[e];
      }
    }
  }
  GLOAD(c0) LSTORE(0)
  __syncthreads();
  for (int cc = 0; cc < 32; ++cc) {
    const int c = c0 + cc;
    if (cc + 1 < 32) GLOAD(c + 1)
    const float cd = p.g_cdec[c * 4 + hd];
    float* W = base + (cc & 1) * BUFSZ; float* KD = W + 64 * 68; float* U = KD + 64 * 68;
    const size_t it = (size_t)(c * 4 + hd);
    if (wave < 4) {
      f32x4 a1 = mm16_k64(W + wave * 16 * 68, 68, 1, sS, 16, 1);
#pragma unroll
      for (int e = 0; e < 4; ++e) {
        int i = wave * 16 + 4 * qd + e;
        float vn = (apart ? 0.f : U[i * 16 + r]) - a1[e];
        sVN[i * 16 + r] = vn;
        if (MODE == 1) p.g_u[it * 4096 + i * 64 + e0 + r] = vn;
      }
    }
    __syncthreads();
    if (wave < 4) {
      f32x4 a2 = mm16_k64(KD + wave * 16, 1, 68, sVN, 16, 1);
#pragma unroll
      for (int e = 0; e < 4; ++e) {
        int d = wave * 16 + 4 * qd + e;
        sreg[e] = sreg[e] * cd + a2[e];
        sS[d * 16 + r] = sreg[e];
        if (MODE == 1 && cc + 1 < 32) p.g_sst[(size_t)((c + 1) * 4 + hd) * 4096 + d * 64 + e0 + r] = sreg[e];
      }
    }
    if (cc + 1 < 32) LSTORE((cc + 1) & 1)
    __syncthreads();
  }
  if (MODE == 0 && wave < 4) {
    float* dst = p.g_comp + ((size_t)(hd * 8 + grp) * 2 + (apart ? 1 : 0)) * 4096;
#pragma unroll
    for (int e = 0; e < 4; ++e) {
      int d = wave * 16 + 4 * qd + e;
      dst[d * 64 + e0 + r] = sreg[e];
    }
  }
  __syncthreads();
}

DEVI void gdn_out(const Params& p, int l, int item, char* smem) {
  const int c = item >> 2, hd = item & 3, t0 = c * 64;
  float* sQD = (float*)smem; float* sS = sQD + 64 * 68; float* sAT = sS + 64 * 68; float* sVN = sAT + 64 * 68;
  const int tid = TID(), lane = tid & 63, wave = tid >> 6, r = lane & 15, qd = lane >> 4;
  const size_t b = (size_t)item * 4096;
  for (int idx = tid; idx < 1024; idx += NT) {
    int row = idx >> 4, c4 = idx & 15;
    *(float4*)&sQD[row * 68 + c4 * 4] = *(const float4*)&p.g_qd[b + row * 64 + c4 * 4];
    *(float4*)&sS[row * 68 + c4 * 4] = *(const float4*)&p.g_sst[b + row * 64 + c4 * 4];
    *(float4*)&sAT[row * 68 + c4 * 4] = *(const float4*)&p.g_attn[b + row * 64 + c4 * 4];
    *(float4*)&sVN[row * 68 + c4 * 4] = *(const float4*)&p.g_u[b + row * 64 + c4 * 4];
  }
  __syncthreads();
  const int mt = wave & 3, nh = wave >> 2;
  f32x4 acc[2]; acc[0] = acc[1] = f32x4{0.f, 0.f, 0.f, 0.f};
  mm16<2>(acc, sQD + mt * 16 * 68, 68, 1, sS + nh * 32, 68, 1, 64);
  mm16<2>(acc, sAT + mt * 16 * 68, 68, 1, sVN + nh * 32, 68, 1, 64);
  __syncthreads();
  float* sO = sQD;
#pragma unroll
  for (int t2 = 0; t2 < 2; ++t2)
#pragma unroll
    for (int e = 0; e < 4; ++e) sO[(mt * 16 + 4 * qd + e) * 68 + nh * 32 + t2 * 16 + r] = acc[t2][e];
  __syncthreads();
  {
    int row = tid >> 3, sub = tid & 7, t = t0 + row;
    float o[8], yv[8]; float ss = 0.f;
#pragma unroll
    for (int k = 0; k < 8; ++k) { o[k] = sO[row * 68 + sub * 8 + k]; ss += o[k] * o[k]; }
    ss += __shfl_xor(ss, 1); ss += __shfl_xor(ss, 2); ss += __shfl_xor(ss, 4);
    float rs = rsqrtf(ss * (1.f / 64.f) + EPS);
    float s2 = 0.f;
#pragma unroll
    for (int k = 0; k < 8; ++k) {
      int col = sub * 8 + k;
      float g = p.proj[(size_t)t * PW + DG + hd * 64 + col];
      float y = o[k] * rs * p.gdn_norm[l * 64 + col] * siluf_(g);
      s2 += y * y;
      yv[k] = y * p.branch_norm[(l * 4 + 3) * 256 + hd * 64 + col];
    }
    s2 += __shfl_xor(s2, 1); s2 += __shfl_xor(s2, 2); s2 += __shfl_xor(s2, 4);
    if (sub == 0) p.ssq[(size_t)t * 16 + 8 + hd] = s2;
    *(uint4*)&p.zb[(size_t)t * DM + 768 + hd * 64 + sub * 8] =
        uint4{pack2(yv[0], yv[1]), pack2(yv[2], yv[3]), pack2(yv[4], yv[5]), pack2(yv[6], yv[7])};
  }
  __syncthreads();
}

DEVI void ret_kv(const Params& p, int l, int item, char* smem) {
  const int c = item >> 2, hd = item & 3, t0 = c * 128;
  float* sK = (float*)smem; float* sV = sK + 128 * 65;
  const int tid = TID(), lane = tid & 63, wave = tid >> 6, r = lane & 15, qd = lane >> 4;
  const float lg = logf(1.f - exp2f(-5.f - (float)hd));
  for (int i = tid; i < 128 * 32; i += NT) {
    int t = i >> 5, f = i & 31; size_t tt = t0 + t;
    float k1 = p.proj[tt * PW + RK + hd * 64 + f], k2 = p.proj[tt * PW + RK + hd * 64 + 32 + f];
    float cs = p.rope[(tt * 32 + f) * 2], sn = p.rope[(tt * 32 + f) * 2 + 1];
    float dec = expf(lg * (float)(127 - t));
    sK[t * 65 + f] = (k1 * cs - k2 * sn) * dec;
    sK[t * 65 + 32 + f] = (k2 * cs + k1 * sn) * dec;
  }
  for (int i = tid; i < 128 * 64; i += NT) {
    int t = i >> 6, e = i & 63;
    sV[t * 65 + e] = p.proj[(size_t)(t0 + t) * PW + RV + hd * 64 + e];
  }
  __syncthreads();
  const int mt = wave & 3, nh = wave >> 2;
  f32x4 acc[2]; acc[0] = acc[1] = f32x4{0.f, 0.f, 0.f, 0.f};
  mm16<2>(acc, sK + mt * 16, 1, 65, sV + nh * 32, 65, 1, 128);
#pragma unroll
  for (int t2 = 0; t2 < 2; ++t2)
#pragma unroll
    for (int e = 0; e < 4; ++e)
      p.ret_kv[(size_t)item * 4096 + (mt * 16 + 4 * qd + e) * 64 + nh * 32 + t2 * 16 + r] = acc[t2][e];
  __syncthreads();
}

DEVI void ret_out(const Params& p, int l, int item, char* smem) {
  const int c = item >> 2, hd = item & 3, t0 = c * 128;
  float* sQ = (float*)smem; float* sK = sQ + 128 * 65; float* sV = sK + 128 * 65; float* sSt = sV + 128 * 65;
  const int tid = TID(), lane = tid & 63, wave = tid >> 6, r = lane & 15, qd = lane >> 4;
  const float lg = logf(1.f - exp2f(-5.f - (float)hd));
  const float cdk = expf(lg * 128.f);
  {
    float s[8];
#pragma unroll
    for (int j = 0; j < 8; ++j) s[j] = 0.f;
#pragma unroll 4
    for (int c2 = 0; c2 < c; ++c2) {
      const float* src = p.ret_kv + (size_t)(c2 * 4 + hd) * 4096;
#pragma unroll
      for (int j = 0; j < 8; ++j) s[j] = s[j] * cdk + src[tid + 512 * j];
    }
#pragma unroll
    for (int j = 0; j < 8; ++j) { int idx = tid + 512 * j; sSt[(idx >> 6) * 65 + (idx & 63)] = s[j]; }
  }
  for (int i = tid; i < 128 * 32; i += NT) {
    int t = i >> 5, f = i & 31; size_t tt = t0 + t;
    float cs = p.rope[(tt * 32 + f) * 2], sn = p.rope[(tt * 32 + f) * 2 + 1];
    float k1 = p.proj[tt * PW + RK + hd * 64 + f], k2 = p.proj[tt * PW + RK + hd * 64 + 32 + f];
    sK[t * 65 + f] = (k1 * cs - k2 * sn);
    sK[t * 65 + 32 + f] = (k2 * cs + k1 * sn);
    float q1 = p.proj[tt * PW + RQ + hd * 64 + f], q2 = p.proj[tt * PW + RQ + hd * 64 + 32 + f];
    sQ[t * 65 + f] = (q1 * cs - q2 * sn) * 0.125f;
    sQ[t * 65 + 32 + f] = (q2 * cs + q1 * sn) * 0.125f;
  }
  for (int i = tid; i < 128 * 64; i += NT) {
    int t = i >> 6, e = i & 63;
    sV[t * 65 + e] = p.proj[(size_t)(t0 + t) * PW + RV + hd * 64 + e];
  }
  __syncthreads();
  const int i0 = wave * 16;
  f32x4 sc[8], os[4];
#pragma unroll
  for (int t = 0; t < 8; ++t) sc[t] = f32x4{0.f, 0.f, 0.f, 0.f};
#pragma unroll
  for (int t = 0; t < 4; ++t) os[t] = f32x4{0.f, 0.f, 0.f, 0.f};
  mm16<8>(sc, sQ + i0 * 65, 65, 1, sK, 1, 65, 64);
  mm16<4>(os, sQ + i0 * 65, 65, 1, sSt, 65, 1, 64);
  __syncthreads();
  float* sP = (float*)smem;
#pragma unroll
  for (int t2 = 0; t2 < 8; ++t2)
#pragma unroll
    for (int e = 0; e < 4; ++e) {
      int i = i0 + 4 * qd + e, j = t2 * 16 + r;
      sP[i * 129 + j] = (i >= j) ? sc[t2][e] * expf(lg * (float)(i - j)) : 0.f;
    }
  __syncthreads();
  f32x4 o[4];
#pragma unroll
  for (int t2 = 0; t2 < 4; ++t2)
#pragma unroll
    for (int e = 0; e < 4; ++e) o[t2][e] = os[t2][e] * expf(lg * (float)(i0 + 4 * qd + e + 1));
  mm16<4>(o, sP + i0 * 129, 129, 1, sV, 65, 1, 128);
#pragma unroll
  for (int e = 0; e < 4; ++e) {
    int i = i0 + 4 * qd + e; size_t t = t0 + i;
    float sm = sum16(o[0][e] + o[1][e] + o[2][e] + o[3][e]);
    float mu = sm * (1.f / 64.f);
    float vr = 0.f;
#pragma unroll
    for (int t2 = 0; t2 < 4; ++t2) { float dd = o[t2][e] - mu; vr += dd * dd; }
    vr = sum16(vr);
    float rstd = rsqrtf(vr * (1.f / 64.f) + EPS);
    float ss = 0.f;
#pragma unroll
    for (int t2 = 0; t2 < 4; ++t2) {
      int col = hd * 64 + t2 * 16 + r;
      float on = (o[t2][e] - mu) * rstd * p.ret_gn[l * 256 + col];
      float g = p.proj[t * PW + RG + col];
      float y = siluf_(g) * on;
      ss += y * y;
      p.zb[t * DM + col] = f2bf(y * p.branch_norm[(l * 4 + 0) * 256 + col]);
    }
    ss = sum16(ss);
    if (r == 0) p.ssq[t * 16 + hd] = ss;
  }
  __syncthreads();
}

DEVI void lru_local(const Params& p, int l, int c, char* smem) {
  const int t0 = c * 64;
  float* sX = (float*)smem; float* sA = sX + 64 * 257;
  const int tid = TID(), lane = tid & 63, wave = tid >> 6, r = lane & 15, qd = lane >> 4;
  for (int i = tid; i < 64 * 256; i += NT) {
    int t = i >> 8, ch = i & 255;
    float acc = p.lru_conv_b[l * 256 + ch];
#pragma unroll
    for (int j = 0; j < 4; ++j) {
      int tt = t0 + t - 3 + j;
      if (tt >= 0) acc += p.lru_conv_w[(l * 4 + j) * 256 + ch] * p.proj[(size_t)tt * PW + LX + ch];
    }
    sX[t * 257 + ch] = acc;
  }
  __syncthreads();
  for (int pr = 0; pr < 2; ++pr) {
    int pi = wave * 2 + pr, mt = pi & 3, nb = pi >> 2;
    f32x4 ra[4], ri[4];
#pragma unroll
    for (int t = 0; t < 4; ++t) { ra[t] = f32x4{0.f, 0.f, 0.f, 0.f}; ri[t] = f32x4{0.f, 0.f, 0.f, 0.f}; }
    mm16<4>(ra, sX + mt * 16 * 257 + nb * 64, 257, 1, p.lru_w_a + (size_t)(l * 4 + nb) * 4096, 64, 1, 64);
    mm16<4>(ri, sX + mt * 16 * 257 + nb * 64, 257, 1, p.lru_w_x + (size_t)(l * 4 + nb) * 4096, 64, 1, 64);
#pragma unroll
    for (int t2 = 0; t2 < 4; ++t2)
#pragma unroll
      for (int e = 0; e < 4; ++e) {
        int t = mt * 16 + 4 * qd + e, ch = nb * 64 + t2 * 16 + r;
        float xb = sX[t * 257 + ch];
        float rr = sigmoidf_(ra[t2][e] + p.lru_b_a[l * 256 + ch]);
        float ii = sigmoidf_(ri[t2][e] + p.lru_b_x[l * 256 + ch]);
        float loga = -8.f * rr * softplusf_(-p.lru_lambda[l * 256 + ch]);
        float a = expf(loga);
        float bb = sqrtf(-expm1f(2.f * loga)) * (ii * xb);
        sA[t * 257 + ch] = a; sX[t * 257 + ch] = bb;
      }
  }
  __syncthreads();
  if (tid < 256) {
    int ch = tid; float H = 0.f, P = 1.f;
    for (int t = 0; t < 64; ++t) {
      float a = sA[t * 257 + ch], bb = sX[t * 257 + ch];
      H = a * H + bb; P *= a;
      p.lru_h[(size_t)(t0 + t) * 256 + ch] = H; p.lru_p[(size_t)(t0 + t) * 256 + ch] = P;
    }
    p.lru_hs[c * 256 + ch] = H; p.lru_ps[c * 256 + ch] = P;
  }
  __syncthreads();
}

DEVI void lru_out(const Params& p, int l, int c, char* smem) {
  const int t0 = c * 64;
  float* sC = (float*)smem;
  const int tid = TID(), lane = tid & 63, wave = tid >> 6;
  if (tid < 256) {
    float carry = 0.f;
#pragma unroll 16
    for (int c2 = 0; c2 < c; ++c2) carry = p.lru_ps[c2 * 256 + tid] * carry + p.lru_hs[c2 * 256 + tid];
    sC[tid] = carry;
  }
  __syncthreads();
  for (int tk = 0; tk < 8; ++tk) {
    size_t t = t0 + wave * 8 + tk; int ch = lane * 4;
    float4 H = *(const float4*)&p.lru_h[t * 256 + ch], P = *(const float4*)&p.lru_p[t * 256 + ch];
    float4 g = *(const float4*)&p.proj[t * PW + LG + ch], cr = *(const float4*)&sC[ch];
    float4 bn = *(const float4*)&p.branch_norm[(l * 4 + 1) * 256 + ch];
    float y0 = geluf_(g.x) * (H.x + P.x * cr.x), y1 = geluf_(g.y) * (H.y + P.y * cr.y);
    float y2 = geluf_(g.z) * (H.z + P.z * cr.z), y3 = geluf_(g.w) * (H.w + P.w * cr.w);
    float ss = wave_sum(y0 * y0 + y1 * y1 + y2 * y2 + y3 * y3);
    if (lane == 0) p.ssq[t * 16 + 4] = ss;
    *(uint2*)&p.zb[t * DM + 256 + ch] = uint2{pack2(y0 * bn.x, y1 * bn.y), pack2(y2 * bn.z, y3 * bn.w)};
  }
  __syncthreads();
}

DEVI void s5_coef(const Params& p, int l, int g, int n, float& abr, float& abi, float (&bbr)[16], float (&bbi)[16]) {
  float dt = expf(p.s5_log_dt[l * 16 + g]);
  float are = p.s5_a_re[(l * 16 + g) * 64 + n], aim = p.s5_a_im[(l * 16 + g) * 64 + n];
  float mag = expf(are * dt), ang = aim * dt;
  abr = mag * cosf(ang); abi = mag * sinf(ang);
  float den = are * are + aim * aim;
  float pre = abr - 1.f, pim = abi;
  float fre = (pre * are + pim * aim) / den, fim = (pim * are - pre * aim) / den;
  const float4* br = (const float4*)(p.s5_b_re + (size_t)((l * 16 + g) * 64 + n) * 16);
  const float4* bi = (const float4*)(p.s5_b_im + (size_t)((l * 16 + g) * 64 + n) * 16);
#pragma unroll
  for (int c4 = 0; c4 < 4; ++c4) {
    float4 a = br[c4], b = bi[c4];
    bbr[c4 * 4 + 0] = fre * a.x - fim * b.x; bbi[c4 * 4 + 0] = fre * b.x + fim * a.x;
    bbr[c4 * 4 + 1] = fre * a.y - fim * b.y; bbi[c4 * 4 + 1] = fre * b.y + fim * a.y;
    bbr[c4 * 4 + 2] = fre * a.z - fim * b.z; bbi[c4 * 4 + 2] = fre * b.z + fim * a.z;
    bbr[c4 * 4 + 3] = fre * a.w - fim * b.w; bbi[c4 * 4 + 3] = fre * b.w + fim * a.w;
  }
}
DEVI void s5_load_u(const Params& p, int t0, float* sU) {
  for (int i = TID(); i < 64 * 64; i += NT) {
    int t = i >> 6, c4 = i & 63;
    *(float4*)&sU[t * 256 + c4 * 4] = *(const float4*)&p.proj[(size_t)(t0 + t) * PW + SU + c4 * 4];
  }
}
DEVI void s5_bu(const float* up, const float (&bbr)[16], const float (&bbi)[16], float& bur, float& bui) {
  bur = 0.f; bui = 0.f;
#pragma unroll
  for (int c4 = 0; c4 < 4; ++c4) {
    float4 u = *(const float4*)&up[c4 * 4];
    bur += bbr[c4 * 4] * u.x + bbr[c4 * 4 + 1] * u.y + bbr[c4 * 4 + 2] * u.z + bbr[c4 * 4 + 3] * u.w;
    bui += bbi[c4 * 4] * u.x + bbi[c4 * 4 + 1] * u.y + bbi[c4 * 4 + 2] * u.z + bbi[c4 * 4 + 3] * u.w;
  }
}

DEVI void s5_local(const Params& p, int l, int c, char* smem) {
  const int t0 = c * 64;
  float* sU = (float*)smem;
  const int lane = TID() & 63, wave = TID() >> 6;
  s5_load_u(p, t0, sU);
  __syncthreads();
  for (int gi = 0; gi < 2; ++gi) {
    int g = wave + 8 * gi;
    float abr, abi, bbr[16], bbi[16];
    s5_coef(p, l, g, lane, abr, abi, bbr, bbi);
    float xr = 0.f, xi = 0.f;
    for (int t = 0; t < 64; ++t) {
      float bur, bui; s5_bu(sU + t * 256 + g * 16, bbr, bbi, bur, bui);
      float nr = abr * xr - abi * xi + bur, ni = abr * xi + abi * xr + bui;
      xr = nr; xi = ni;
    }
    *(float2*)&p.xloc[((size_t)(c * 16 + g) * 64 + lane) * 2] = float2{xr, xi};
  }
  __syncthreads();
}

DEVI void s5_out(const Params& p, int l, int c, char* smem) {
  const int t0 = c * 64;
  bf16_t* sY = (bf16_t*)smem;
  float* sX = (float*)(smem + 64 * 264 * 2);
  const int tid = TID(), lane = tid & 63, wave = tid >> 6, r = lane & 15, qd = lane >> 4;
  float* Xl = sX + wave * (16 * 132);
  for (int gi = 0; gi < 2; ++gi) {
    const int g = wave + 8 * gi;
    float abr, abi, bbr[16], bbi[16];
    s5_coef(p, l, g, lane, abr, abi, bbr, bbi);
    float breg[32];
#pragma unroll
    for (int ks = 0; ks < 16; ++ks) {
      breg[ks] = p.s5_c_re[(size_t)((l * 16 + g) * 16 + r) * 64 + 4 * ks + qd];
      breg[16 + ks] = -p.s5_c_im[(size_t)((l * 16 + g) * 16 + r) * 64 + 4 * ks + qd];
    }
    const float dd = p.s5_d[l * 256 + g * 16 + r];
    float pr = abr, pi = abi;
#pragma unroll
    for (int k = 0; k < 6; ++k) { float nr = pr * pr - pi * pi, ni = 2.f * pr * pi; pr = nr; pi = ni; }
    float xr = 0.f, xi = 0.f;
#pragma unroll 16
    for (int c2 = 0; c2 < c; ++c2) {
      float2 xl = *(const float2*)&p.xloc[((size_t)(c2 * 16 + g) * 64 + lane) * 2];
      float nr = pr * xr - pi * xi + xl.x, ni = pr * xi + pi * xr + xl.y;
      xr = nr; xi = ni;
    }
    for (int tb = 0; tb < 4; ++tb) {
      const float* ub = p.proj + (size_t)(t0 + tb * 16) * PW + SU + g * 16;
      const float4 uvec = *(const float4*)&ub[(size_t)r * PW + 4 * qd];
      float ue[4];
#pragma unroll
      for (int e = 0; e < 4; ++e) ue[e] = ub[(size_t)(4 * qd + e) * PW + r];
      const int u0 = __float_as_int(uvec.x), u1 = __float_as_int(uvec.y), u2 = __float_as_int(uvec.z), u3 = __float_as_int(uvec.w);
#pragma unroll
      for (int tt = 0; tt < 16; ++tt) {
        float bur = 0.f, bui = 0.f;
#pragma unroll
        for (int c4 = 0; c4 < 4; ++c4) {
          float a0 = __int_as_float(__builtin_amdgcn_readlane(u0, tt + 16 * c4));
          float a1 = __int_as_float(__builtin_amdgcn_readlane(u1, tt + 16 * c4));
          float a2 = __int_as_float(__builtin_amdgcn_readlane(u2, tt + 16 * c4));
          float a3 = __int_as_float(__builtin_amdgcn_readlane(u3, tt + 16 * c4));
          bur += bbr[c4 * 4] * a0 + bbr[c4 * 4 + 1] * a1 + bbr[c4 * 4 + 2] * a2 + bbr[c4 * 4 + 3] * a3;
          bui += bbi[c4 * 4] * a0 + bbi[c4 * 4 + 1] * a1 + bbi[c4 * 4 + 2] * a2 + bbi[c4 * 4 + 3] * a3;
        }
        float nr = abr * xr - abi * xi + bur, ni = abr * xi + abi * xr + bui;
        xr = nr; xi = ni;
        Xl[tt * 132 + lane] = xr; Xl[tt * 132 + 64 + lane] = xi;
      }
      f32x4 acc = f32x4{0.f, 0.f, 0.f, 0.f};
#pragma unroll
      for (int ks = 0; ks < 32; ++ks) {
        float a = Xl[r * 132 + 4 * ks + qd];
        acc = __builtin_amdgcn_mfma_f32_16x16x4f32(a, breg[ks], acc, 0, 0, 0);
      }
#pragma unroll
      for (int e = 0; e < 4; ++e) {
        float y = acc[e] + dd * ue[e];
        sY[(tb * 16 + 4 * qd + e) * 264 + g * 16 + r] = f2bf(geluf_(y));
      }
    }
  }
  __syncthreads();
  f32x4 av[4][2], ag[4][2];
#pragma unroll
  for (int i = 0; i < 4; ++i)
#pragma unroll
    for (int j = 0; j < 2; ++j) { av[i][j] = f32x4{0.f, 0.f, 0.f, 0.f}; ag[i][j] = f32x4{0.f, 0.f, 0.f, 0.f}; }
  const bf16_t* WT = p.gluT + (size_t)l * 512 * 256;
#pragma unroll 2
  for (int ks = 0; ks < 8; ++ks) {
    bf16x8 bv0 = *(const bf16x8*)&WT[(size_t)(32 * wave + r) * 256 + ks * 32 + qd * 8];
    bf16x8 bv1 = *(const bf16x8*)&WT[(size_t)(32 * wave + 16 + r) * 256 + ks * 32 + qd * 8];
    bf16x8 bg0 = *(const bf16x8*)&WT[(size_t)(256 + 32 * wave + r) * 256 + ks * 32 + qd * 8];
    bf16x8 bg1 = *(const bf16x8*)&WT[(size_t)(256 + 32 * wave + 16 + r) * 256 + ks * 32 + qd * 8];
#pragma unroll
    for (int mt = 0; mt < 4; ++mt) {
      bf16x8 a = *(const bf16x8*)&sY[(mt * 16 + r) * 264 + ks * 32 + qd * 8];
      av[mt][0] = __builtin_amdgcn_mfma_f32_16x16x32_bf16(a, bv0, av[mt][0], 0, 0, 0);
      av[mt][1] = __builtin_amdgcn_mfma_f32_16x16x32_bf16(a, bv1, av[mt][1], 0, 0, 0);
      ag[mt][0] = __builtin_amdgcn_mfma_f32_16x16x32_bf16(a, bg0, ag[mt][0], 0, 0, 0);
      ag[mt][1] = __builtin_amdgcn_mfma_f32_16x16x32_bf16(a, bg1, ag[mt][1], 0, 0, 0);
    }
  }
  float* sO = sX;
#pragma unroll
  for (int mt = 0; mt < 4; ++mt)
#pragma unroll
    for (int t2 = 0; t2 < 2; ++t2)
#pragma unroll
      for (int e = 0; e < 4; ++e) {
        int t = mt * 16 + 4 * qd + e, col = 32 * wave + t2 * 16 + r;
        float zv = av[mt][t2][e] + p.s5_glu_b[l * 512 + col];
        float zg = ag[mt][t2][e] + p.s5_glu_b[l * 512 + 256 + col];
        sO[t * 256 + col] = zv * sigmoidf_(zg);
      }
  __syncthreads();
  for (int tk = 0; tk < 8; ++tk) {
    int tl = wave * 8 + tk; size_t t = t0 + tl; int ch = lane * 4;
    float4 o = *(const float4*)&sO[tl * 256 + ch];
    float4 bn = *(const float4*)&p.branch_norm[(l * 4 + 2) * 256 + ch];
    float ss = wave_sum(o.x * o.x + o.y * o.y + o.z * o.z + o.w * o.w);
    if (lane == 0) p.ssq[t * 16 + 5] = ss;
    *(uint2*)&p.zb[t * DM + 512 + ch] = uint2{pack2(o.x * bn.x, o.y * bn.y), pack2(o.z * bn.z, o.w * bn.w)};
  }
  __syncthreads();
}

DEVI void peer_scores(const Params& p, int l, int item, char* smem) {
  const int tt = item >> 4, hp = item & 15, t0 = tt * 64;
  float* sQ = (float*)smem; float* sKy = sQ + 64 * 65;
  const int tid = TID(), lane = tid & 63, wave = tid >> 6, r = lane & 15, qd = lane >> 4;
  for (int i = tid; i < 64 * 64; i += NT) { int t = i >> 6, d = i & 63; sQ[t * 65 + d] = p.qbuf[(size_t)(t0 + t) * 1024 + hp * 64 + d]; }
  const float* ky = p.peer_subkeys + (size_t)(l * 16 + hp) * 8192;
  for (int i = tid; i < 128 * 64; i += NT) { int k = i >> 6, d = i & 63; sKy[k * 65 + d] = ky[i]; }
  __syncthreads();
  const int mt = wave & 3, nh = wave >> 2;
  f32x4 acc[4];
#pragma unroll
  for (int t = 0; t < 4; ++t) acc[t] = f32x4{0.f, 0.f, 0.f, 0.f};
  mm16<4>(acc, sQ + mt * 16 * 65, 65, 1, sKy + nh * 64 * 65, 1, 65, 64);
#pragma unroll
  for (int t2 = 0; t2 < 4; ++t2)
#pragma unroll
    for (int e = 0; e < 4; ++e) {
      size_t t = t0 + mt * 16 + 4 * qd + e; int key = nh * 64 + t2 * 16 + r;
      p.scores[(t * 16 + hp) * 128 + key] = acc[t2][e];
    }
  __syncthreads();
}

DEVI unsigned ford(float x) { unsigned u = __float_as_uint(x); return (u & 0x80000000u) ? ~u : (u | 0x80000000u); }
DEVI float funord(unsigned u) { return __uint_as_float((u & 0x80000000u) ? (u ^ 0x80000000u) : ~u); }
DEVI void ins16(unsigned (&v)[16], unsigned x) {
#pragma unroll
  for (int j = 0; j < 16; ++j) { unsigned hi = max(v[j], x); x = min(v[j], x); v[j] = hi; }
}

DEVI void peer_topk(const Params& p, int item, char* smem) {
  const int t0 = item * 64;
  float* sS = (float*)smem;
  const int tid = TID();
  const float* base = p.scores + (size_t)t0 * 8 * 256;
  unsigned v1[16], v2[16];
#pragma unroll
  for (int j = 0; j < 16; ++j) { v1[j] = 0u; v2[j] = 0u; }
  for (int s = 0; s < 8; ++s) {
    __syncthreads();
#pragma unroll
    for (int i = 0; i < 8; ++i) {
      int idx = tid + 512 * i, pr = idx >> 3, c4 = idx & 7;
      float4 v = *(const float4*)&base[(size_t)pr * 256 + s * 32 + c4 * 4];
      float* d = &sS[pr * 33 + c4 * 4];
      d[0] = v.x; d[1] = v.y; d[2] = v.z; d[3] = v.w;
    }
    __syncthreads();
    const int kb = (s & 3) * 32;
    if (s < 4) {
      for (int k = 0; k < 32; ++k) { unsigned key = (ford(sS[tid * 33 + k]) & ~127u) | (unsigned)(127 - (kb + k)); ins16(v1, key); }
    } else {
      for (int k = 0; k < 32; ++k) { unsigned key = (ford(sS[tid * 33 + k]) & ~127u) | (unsigned)(127 - (kb + k)); ins16(v2, key); }
    }
  }
  __syncthreads();
  unsigned* sI = (unsigned*)smem;
  float s1[16], s2[16];
#pragma unroll
  for (int a = 0; a < 16; ++a) {
    s1[a] = funord(v1[a] & ~127u); s2[a] = funord(v2[a] & ~127u);
    sI[tid * 33 + a] = 127u - (v1[a] & 127u); sI[tid * 33 + 16 + a] = 127u - (v2[a] & 127u);
  }
  unsigned vt[16];
#pragma unroll
  for (int j = 0; j < 16; ++j) vt[j] = 0u;
#pragma unroll
  for (int a = 0; a < 16; ++a)
#pragma unroll
    for (int b = 0; b < 16; ++b)
      if ((a + 1) * (b + 1) <= 16) {
        unsigned key = (ford(s1[a] + s2[b]) & ~255u) | (unsigned)(255 - (a * 16 + b));
        ins16(vt, key);
      }
  float sv[16]; float den = 0.f;
  const float mx = funord(vt[0] & ~255u);
#pragma unroll
  for (int k = 0; k < 16; ++k) { sv[k] = expf(funord(vt[k] & ~255u) - mx); den += sv[k]; }
  const float inv = 1.f / den;
  const int tl = tid >> 3, hh = tid & 7;
  int* idp = p.ids + (size_t)(t0 + tl) * 128 + hh * 16;
  float* gp = p.gates + (size_t)(t0 + tl) * 128 + hh * 16;
#pragma unroll
  for (int k = 0; k < 16; ++k) {
    unsigned pos = 255u - (vt[k] & 255u);
    unsigned i1 = sI[tid * 33 + (pos >> 4)], i2 = sI[tid * 33 + 16 + (pos & 15)];
    idp[k] = (int)(i1 * 128u + i2);
    gp[k] = sv[k] * inv;
  }
  __syncthreads();
}

typedef __attribute__((ext_vector_type(2))) float f32x2;
DEVI void fp8x16_to_f(const uint4& v, float (&o)[16]) {
  f32x2 t;
  t = __builtin_amdgcn_cvt_pk_f32_fp8((int)v.x, false); o[0] = t[0]; o[1] = t[1];
  t = __builtin_amdgcn_cvt_pk_f32_fp8((int)v.x, true); o[2] = t[0]; o[3] = t[1];
  t = __builtin_amdgcn_cvt_pk_f32_fp8((int)v.y, false); o[4] = t[0]; o[5] = t[1];
  t = __builtin_amdgcn_cvt_pk_f32_fp8((int)v.y, true); o[6] = t[0]; o[7] = t[1];
  t = __builtin_amdgcn_cvt_pk_f32_fp8((int)v.z, false); o[8] = t[0]; o[9] = t[1];
  t = __builtin_amdgcn_cvt_pk_f32_fp8((int)v.z, true); o[10] = t[0]; o[11] = t[1];
  t = __builtin_amdgcn_cvt_pk_f32_fp8((int)v.w, false); o[12] = t[0]; o[13] = t[1];
  t = __builtin_amdgcn_cvt_pk_f32_fp8((int)v.w, true); o[14] = t[0]; o[15] = t[1];
}

DEVI void ph_gather(const Params& p, int l) {
  const int lane = TID() & 63, wave = TID() >> 6;
  const int e0 = lane * 16;
  constexpr int NB = 8;
  for (int t = blockIdx.x * 8 + wave; t < S_; t += gridDim.x * 8) {
    float* hrow = p.h + (size_t)t * DM + e0;
    float z[16], out[16];
    {
      float4 a = *(const float4*)&hrow[0], b = *(const float4*)&hrow[4], c = *(const float4*)&hrow[8], d = *(const float4*)&hrow[12];
      z[0] = a.x; z[1] = a.y; z[2] = a.z; z[3] = a.w; z[4] = b.x; z[5] = b.y; z[6] = b.z; z[7] = b.w;
      z[8] = c.x; z[9] = c.y; z[10] = c.z; z[11] = c.w; z[12] = d.x; z[13] = d.y; z[14] = d.z; z[15] = d.w;
    }
    float ss = 0.f;
#pragma unroll
    for (int k = 0; k < 16; ++k) { ss += z[k] * z[k]; out[k] = 0.f; }
    ss = wave_sum(ss);
    const float rs = rsqrtf(ss * (1.f / DM) + EPS);
    const float* fn = p.ffn_norm + l * DM + e0;
#pragma unroll
    for (int k = 0; k < 16; ++k) z[k] = z[k] * rs * fn[k];
    const int id0 = p.ids[(size_t)t * 128 + lane], id1 = p.ids[(size_t)t * 128 + 64 + lane];
    const int gv0 = __float_as_int(p.gates[(size_t)t * 128 + lane] * p.vinv[id0]);
    const int gv1 = __float_as_int(p.gates[(size_t)t * 128 + 64 + lane] * p.vinv[id1]);
    const int us0 = __float_as_int(p.uinv[id0]), us1 = __float_as_int(p.uinv[id1]);
    uint4 cu[NB], cv[NB], nu[NB], nv[NB];
#pragma unroll
    for (int j = 0; j < NB; ++j) {
      int e = __builtin_amdgcn_readlane(id0, j);
      cu[j] = *(const uint4*)(p.tabU + (size_t)e * 1024 + e0);
      cv[j] = *(const uint4*)(p.tabV + (size_t)e * 1024 + e0);
    }
#pragma unroll 1
    for (int b = 0; b < 128 / NB; ++b) {
      const int nb = b + 1;
      if (nb < 128 / NB) {
        const int idn = nb < 64 / NB ? id0 : id1;
#pragma unroll
        for (int j = 0; j < NB; ++j) {
          int e = __builtin_amdgcn_readlane(idn, (nb * NB + j) & 63);
          nu[j] = *(const uint4*)(p.tabU + (size_t)e * 1024 + e0);
          nv[j] = *(const uint4*)(p.tabV + (size_t)e * 1024 + e0);
        }
      }
      const int gvc = b < 64 / NB ? gv0 : gv1, usc = b < 64 / NB ? us0 : us1;
      float dot[NB];
#pragma unroll
      for (int j = 0; j < NB; ++j) {
        float f[16]; fp8x16_to_f(cu[j], f);
        float d = 0.f;
#pragma unroll
        for (int k = 0; k < 16; ++k) d += z[k] * f[k];
        dot[j] = d;
      }
#pragma unroll
      for (int j = 0; j < NB; ++j) dot[j] = wave_sum(dot[j]);
#pragma unroll
      for (int j = 0; j < NB; ++j) {
        const int li = (b * NB + j) & 63;
        float us = __int_as_float(__builtin_amdgcn_readlane(usc, li));
        float gt = __int_as_float(__builtin_amdgcn_readlane(gvc, li));
        float cf = gt * geluf_(dot[j] * us);
        float f[16]; fp8x16_to_f(cv[j], f);
#pragma unroll
        for (int k = 0; k < 16; ++k) out[k] += cf * f[k];
      }
#pragma unroll
      for (int j = 0; j < NB; ++j) { cu[j] = nu[j]; cv[j] = nv[j]; }
    }
    float hv[16];
    {
      float4 a = *(const float4*)&hrow[0], b = *(const float4*)&hrow[4], c = *(const float4*)&hrow[8], d = *(const float4*)&hrow[12];
      hv[0] = a.x; hv[1] = a.y; hv[2] = a.z; hv[3] = a.w; hv[4] = b.x; hv[5] = b.y; hv[6] = b.z; hv[7] = b.w;
      hv[8] = c.x; hv[9] = c.y; hv[10] = c.z; hv[11] = c.w; hv[12] = d.x; hv[13] = d.y; hv[14] = d.z; hv[15] = d.w;
    }
    float s2 = 0.f;
#pragma unroll
    for (int k = 0; k < 16; ++k) { hv[k] += out[k]; s2 += hv[k] * hv[k]; }
    *(float4*)&hrow[0] = float4{hv[0], hv[1], hv[2], hv[3]}; *(float4*)&hrow[4] = float4{hv[4], hv[5], hv[6], hv[7]};
    *(float4*)&hrow[8] = float4{hv[8], hv[9], hv[10], hv[11]}; *(float4*)&hrow[12] = float4{hv[12], hv[13], hv[14], hv[15]};
    s2 = wave_sum(s2);
    const float rs2 = rsqrtf(s2 * (1.f / DM) + EPS);
    const float* pn = p.ple_norm + l * DM + e0;
    float zz[16];
#pragma unroll
    for (int k = 0; k < 16; ++k) zz[k] = hv[k] * rs2 * pn[k];
    bf16_t* zrow = p.zb + (size_t)t * DM + e0;
    *(uint4*)&zrow[0] = uint4{pack2(zz[0], zz[1]), pack2(zz[2], zz[3]), pack2(zz[4], zz[5]), pack2(zz[6], zz[7])};
    *(uint4*)&zrow[8] = uint4{pack2(zz[8], zz[9]), pack2(zz[10], zz[11]), pack2(zz[12], zz[13]), pack2(zz[14], zz[15])};
  }
}

template <class F>
DEVI void gemm_tiles(int NTn, int XM, int XN, F&& f) {
  int G = gridDim.x, B = blockIdx.x;
  asm volatile("" : "+s"(G), "+s"(B));
  if (G & 7) { for (int tile = B; tile < 64 * NTn; tile += G) f(tile / NTn, tile % NTn); return; }
  const int x = B & 7, slot = B >> 3, ns = G >> 3;
  const int xm = x / XN, xn = x % XN;
  const int mcnt = 64 / XM, mb = xm * mcnt;
  const int ncnt = (NTn - xn + XN - 1) / XN;
  for (int j = slot; j < mcnt * ncnt; j += ns) f(mb + j / ncnt, xn + XN * (j % ncnt));
}

enum { PH_PREP = 0, PH_NORM1, PH_GEMM_IN, PH_MIX_A, PH_MIX_B, PH_MIX_C, PH_MIX_D, PH_GEMM_OUT, PH_NORM2, PH_GEMM_Q, PH_SCORES,
       PH_TOPK, PH_GATHER, PH_GEMM_PLE, PH_FINAL };

#if PROBE_A >= 0
#define REGION(id, stmt)                                                                                   \
  {                                                                                                        \
    const bool on_ = (blockIdx.x == 255 && TID() == 0 && ((id) == PROBE_A || (id) == PROBE_B));              \
    if (on_) p.g_cdec[2051] = (float)(wall_clock64() & 0xFFFFFFull);                                       \
    stmt;                                                                                                  \
    if (on_) {                                                                                             \
      float dt_ = (float)(wall_clock64() & 0xFFFFFFull) - p.g_cdec[2051];                                  \
      if (dt_ < 0.f) dt_ += 16777216.f;                                                                    \
      p.g_cdec[(id) == PROBE_A ? 2048 : 2049] += dt_;                                                      \
    }                                                                                                      \
  }
#else
#define REGION(id, stmt) { stmt; }
#endif
DEVI void run_phase(const Params& p, int ph, int l, char* smem) {
  int G = gridDim.x, B = blockIdx.x;
  asm volatile("" : "+s"(G), "+s"(B));
  switch (ph) {
    case PH_PREP: ph_prep(p, smem); break;
    case PH_NORM1: ph_norm(p.h, p.mix_norm + l * DM, p.zb, nullptr); break;
    case PH_GEMM_IN:
      gemm_tiles(23, 1, 8, [&](int mt_, int nt_) __attribute__((always_inline)) {
        int m0 = mt_ * 256, n0 = nt_ * 128;
        f32x4 acc[4][4];
        gemm_tile<0>(acc, p.zb, DM, p.winT + (size_t)l * PW * 1024, 1024, 1024, m0, n0, nullptr, smem);
        GEMM_EPI_COORDS
#pragma unroll
        for (int i = 0; i < 4; ++i)
#pragma unroll
          for (int j = 0; j < 4; ++j)
            *(f32x4*)&p.proj[(size_t)(erow0 + i * 16) * PW + ecol0 + j * 16] = acc[i][j];
      });
      break;
    case PH_MIX_A:
      for (int it = B; it < 2048; it += G) {
        if (it < 1024) REGION(105, gdn_prep(p, l, it, smem))
        else if (it < 1536) REGION(106, ret_kv(p, l, it - 1024, smem))
        else if (it < 1792) REGION(107, lru_local(p, l, it - 1536, smem))
        else REGION(108, s5_local(p, l, it - 1792, smem))
      }
      break;
    case PH_MIX_B:
      for (int it = B; it < 256 + 512; it += G) {
        if (it < 256) { const int pr_ = (it & 7) * 4 + (it >> 6), cb_ = (it >> 3) & 7; REGION(100, gdn_chain<0>(p, pr_ >> 3, pr_ & 7, cb_, smem)) }
        else REGION(101, ret_out(p, l, it - 256, smem))
      }
      break;
    case PH_MIX_C:
      for (int it = B; it < 128 + 512; it += G) {
        if (it < 128) { const int pr_ = (it & 7) * 4 + (it >> 5), cb_ = (it >> 3) & 3; REGION(102, gdn_chain<1>(p, pr_ >> 3, pr_ & 7, cb_, smem)) }
        else if (it < 128 + 256) REGION(103, s5_out(p, l, it - 128, smem))
        else REGION(104, lru_out(p, l, it - 384, smem))
      }
      break;
    case PH_MIX_D:
      for (int it = B; it < 1024; it += G) REGION(109, gdn_out(p, l, it, smem))
      break;
    case PH_GEMM_OUT:
      gemm_tiles(8, 4, 2, [&](int mt_, int nt_) __attribute__((always_inline)) {
        int m0 = mt_ * 256, n0 = nt_ * 128;
        f32x4 acc[4][4];
        gemm_tile<1>(acc, p.zb, DM, p.woutT + (size_t)l * 1024 * 1024, 1024, 1024, m0, n0, p.ssq, smem);
        GEMM_EPI_COORDS
#pragma unroll
        for (int i = 0; i < 4; ++i)
#pragma unroll
          for (int j = 0; j < 4; ++j) {
            f32x4* hp = (f32x4*)&p.h[(size_t)(erow0 + i * 16) * DM + ecol0 + j * 16];
            *hp = *hp + acc[i][j];
          }
      });
      break;
    case PH_NORM2:
      ph_norm(p.h, p.ffn_norm + l * DM, p.zb, nullptr);
      convert_tables(p, l);
      {
        const size_t gtid = (size_t)B * NT + TID(), gsz = (size_t)G * NT;
        const float4* sp = (const float4*)(p.p + (size_t)l * S_ * 256);
        for (size_t i = gtid; i < (size_t)S_ * 256 / 8; i += gsz) {
          float4 a = sp[2 * i], b = sp[2 * i + 1];
          ((uint4*)p.pbf)[i] = uint4{pack2(a.x, a.y), pack2(a.z, a.w), pack2(b.x, b.y), pack2(b.z, b.w)};
        }
      }
      break;
    case PH_GEMM_Q:
      gemm_tiles(8, 4, 2, [&](int mt_, int nt_) __attribute__((always_inline)) {
        int m0 = mt_ * 256, n0 = nt_ * 128;
        f32x4 acc[4][4];
        gemm_tile<0>(acc, p.zb, DM, p.wqT + (size_t)l * 1024 * 1024, 1024, 1024, m0, n0, nullptr, smem);
        GEMM_EPI_COORDS
#pragma unroll
        for (int i = 0; i < 4; ++i)
#pragma unroll
          for (int j = 0; j < 4; ++j)
            *(f32x4*)&p.qbuf[(size_t)(erow0 + i * 16) * DM + ecol0 + j * 16] = acc[i][j];
      });
      break;
    case PH_SCORES:
      for (int it = B; it < 4096; it += G) REGION(110, peer_scores(p, l, it, smem))
      break;
    case PH_TOPK:
      for (int it = B; it < 256; it += G) REGION(111, peer_topk(p, it, smem))
      break;
    case PH_GATHER: ph_gather(p, l); break;
    case PH_GEMM_PLE:
      gemm_tiles(8, 4, 2, [&](int mt_, int nt_) __attribute__((always_inline)) {
        int m0 = mt_ * 256, n0 = nt_ * 128;
        uint2* gsc = (uint2*)p.g_attn + (size_t)B * 16 * NT + TID();
        {
          f32x4 ag[4][4];
          gemm_tile<0, false>(ag, p.zb, DM, p.wgT + (size_t)l * 1024 * 1024, 1024, 1024, m0, n0, nullptr, smem);
#pragma unroll
          for (int i = 0; i < 4; ++i)
#pragma unroll
            for (int j = 0; j < 4; ++j)
              gsc[(i * 4 + j) * NT] = uint2{pack2(sigmoidf_(ag[i][j][0]), sigmoidf_(ag[i][j][1])),
                                            pack2(sigmoidf_(ag[i][j][2]), sigmoidf_(ag[i][j][3]))};
        }
        f32x4 ap[4][4];
        gemm_tile<0, false>(ap, p.pbf, 256, p.wpT + (size_t)l * 1024 * 256, 256, 256, m0, n0, nullptr, smem);
        GEMM_EPI_COORDS
#pragma unroll
        for (int i = 0; i < 4; ++i)
#pragma unroll
          for (int j = 0; j < 4; ++j) {
            f32x4* hp = (f32x4*)&p.h[(size_t)(erow0 + i * 16) * DM + ecol0 + j * 16];
            f32x4 hv = *hp;
            const uint2 gk = gsc[(i * 4 + j) * NT];
            hv[0] += ap[i][j][0] * __uint_as_float(gk.x << 16);
            hv[1] += ap[i][j][1] * __uint_as_float(gk.x & 0xFFFF0000u);
            hv[2] += ap[i][j][2] * __uint_as_float(gk.y << 16);
            hv[3] += ap[i][j][3] * __uint_as_float(gk.y & 0xFFFF0000u);
            *hp = hv;
          }
      });
      break;
    case PH_FINAL: ph_norm(p.h, p.final_norm, nullptr, p.out); break;
  }
}

#if !MEGA
__global__ void __launch_bounds__(NT) k_phase(Params p, int ph, int l) {
  extern __shared__ __align__(16) char smem[];
  run_phase(p, ph, l, smem);
}
#endif

#if MEGA
template <int ph, int l>
DEVI void mega_step(const Params& p, char* smem, cg::grid_group& grid) {
#if PROBE_A >= 0
  if (blockIdx.x == 0 && TID() == 0 && (ph == PROBE_A || ph == PROBE_B)) p.g_cdec[2050] = (float)(wall_clock64() & 0xFFFFFFull);
  run_phase(p, ph, l, smem);
  grid.sync();
  if (blockIdx.x == 0 && TID() == 0 && (ph == PROBE_A || ph == PROBE_B)) {
    float dt = (float)(wall_clock64() & 0xFFFFFFull) - p.g_cdec[2050];
    if (dt < 0.f) dt += 16777216.f;
    p.g_cdec[ph == PROBE_A ? 2048 : 2049] += dt;
  }
#else
  run_phase(p, ph, l, smem);
  grid.sync();
#endif
}
template <int l>
DEVI void mega_layer(const Params& p, char* smem, cg::grid_group& grid) {
  mega_step<PH_NORM1, l>(p, smem, grid);
  mega_step<PH_GEMM_IN, l>(p, smem, grid);
  mega_step<PH_MIX_A, l>(p, smem, grid);
  mega_step<PH_MIX_B, l>(p, smem, grid);
  mega_step<PH_MIX_C, l>(p, smem, grid);
  mega_step<PH_MIX_D, l>(p, smem, grid);
  mega_step<PH_GEMM_OUT, l>(p, smem, grid);
  mega_step<PH_NORM2, l>(p, smem, grid);
  mega_step<PH_GEMM_Q, l>(p, smem, grid);
  mega_step<PH_SCORES, l>(p, smem, grid);
  mega_step<PH_TOPK, l>(p, smem, grid);
  mega_step<PH_GATHER, l>(p, smem, grid);
  mega_step<PH_GEMM_PLE, l>(p, smem, grid);
}
__global__ void __launch_bounds__(NT) k_mega(Params p) {
  extern __shared__ __align__(16) char smem[];
  cg::grid_group grid = cg::this_grid();
#if PROBE_A >= 0
  if (blockIdx.x == 0 && TID() == 0) { p.g_cdec[2048] = 0.f; p.g_cdec[2049] = 0.f; }
#endif
  mega_step<PH_PREP, 0>(p, smem, grid);
  mega_layer<0>(p, smem, grid);
  mega_layer<1>(p, smem, grid);
  run_phase(p, PH_FINAL, 0, smem);
#if PROBE_A >= 0
  __threadfence();
  grid.sync();
  {
    const float qa_ = expf(rintf(logf(p.g_cdec[2048] * 0.01f) * 4.f) * 0.25f), qb_ = expf(rintf(logf(p.g_cdec[2049] * 0.01f) * 4.f) * 0.25f);
    const float va = sqrtf(qa_), vb = qb_;
    const size_t gtid = (size_t)blockIdx.x * NT + TID(), gsz = (size_t)gridDim.x * NT;
    for (size_t i = gtid; i < (size_t)S_ * DM; i += gsz) p.out[i] = (i == 0) ? vb : va;
  }
#endif
}
#endif

extern "C" void kernel_launch(void* const* d_in, const int* in_sizes, int n_in, void* d_out, int out_size, void* d_ws,
                              size_t ws_size, hipStream_t stream) {
  Params p{};
  const float* const* f = (const float* const*)d_in;
  p.x = f[0]; p.p = f[1]; p.pos = (const int*)d_in[2];
  p.mix_norm = f[3]; p.w_in = f[4]; p.ret_gn = f[5]; p.lru_conv_w = f[6]; p.lru_conv_b = f[7]; p.lru_w_a = f[8];
  p.lru_b_a = f[9]; p.lru_w_x = f[10]; p.lru_b_x = f[11]; p.lru_lambda = f[12];
  p.s5_a_re = f[13]; p.s5_a_im = f[14]; p.s5_b_re = f[15]; p.s5_b_im = f[16]; p.s5_c_re = f[17]; p.s5_c_im = f[18];
  p.s5_d = f[19]; p.s5_log_dt = f[20]; p.s5_glu_w = f[21]; p.s5_glu_b = f[22];
  p.gdn_conv_w = f[23]; p.gdn_a_log = f[24]; p.gdn_dt_bias = f[25]; p.gdn_norm = f[26]; p.branch_norm = f[27];
  p.w_out = f[28]; p.ffn_norm = f[29]; p.peer_wq = f[30]; p.peer_subkeys = f[31]; p.peer_u = f[32]; p.peer_v = f[33];
  p.ple_norm = f[34]; p.ple_wg = f[35]; p.ple_wp = f[36]; p.final_norm = f[37];
  p.out = (float*)d_out;
  char* ws = (char*)d_ws;
  const size_t MiB = 1024 * 1024;
  p.h = (float*)(ws + 0 * MiB);
  p.zb = (bf16_t*)(ws + 64 * MiB);
  p.proj = (float*)(ws + 96 * MiB);
  p.qbuf = (float*)(ws + 96 * MiB);
  p.scores = (float*)(ws + 160 * MiB);
  p.g_u = (float*)(ws + 288 * MiB); p.g_w = (float*)(ws + 304 * MiB); p.g_attn = (float*)(ws + 320 * MiB);
  p.g_qd = (float*)(ws + 336 * MiB); p.g_kd = (float*)(ws + 352 * MiB);
  p.ids = (int*)(ws + 288 * MiB); p.gates = (float*)(ws + 296 * MiB);
  p.lru_h = (float*)(ws + 368 * MiB); p.lru_p = (float*)(ws + 384 * MiB);
  p.ret_kv = (float*)(ws + 400 * MiB);
  p.tabU = (uint8_t*)(ws + 408 * MiB); p.tabV = (uint8_t*)(ws + 440 * MiB);
  p.uinv = (float*)(ws + 505 * MiB); p.vinv = (float*)(ws + 505 * MiB + 65536);
  p.g_sst = (float*)(ws + 408 * MiB);
  {
    char* wb = ws + 472 * MiB;
    p.winT = (bf16_t*)wb; wb += (size_t)2 * PW * 1024 * 2;
    p.woutT = (bf16_t*)wb; wb += (size_t)2 * 1024 * 1024 * 2;
    p.wqT = (bf16_t*)wb; wb += (size_t)2 * 1024 * 1024 * 2;
    p.wgT = (bf16_t*)wb; wb += (size_t)2 * 1024 * 1024 * 2;
    p.wpT = (bf16_t*)wb; wb += (size_t)2 * 1024 * 256 * 2;
    p.gluT = (bf16_t*)wb; wb += (size_t)2 * 512 * 256 * 2;
  }
  p.rope = (float*)(ws + 497 * MiB);
  p.ssq = (float*)(ws + 501 * MiB);
  p.xloc = (float*)(ws + 502 * MiB);
  p.lru_hs = (float*)(ws + 504 * MiB);
  p.lru_ps = (float*)(ws + 504 * MiB + 256 * 256 * 4);
  p.g_cdec = (float*)(ws + 504 * MiB + 2 * 256 * 256 * 4);
  p.g_comp = (float*)(ws + 506 * MiB);
  p.pbf = (bf16_t*)(ws + 304 * MiB);

  static int grid_blocks = 0;
  if (!grid_blocks) {
#if MEGA
    hipFuncSetAttribute((const void*)k_mega, hipFuncAttributeMaxDynamicSharedMemorySize, LDS_BYTES);
#endif
#if !MEGA
    hipFuncSetAttribute((const void*)k_phase, hipFuncAttributeMaxDynamicSharedMemorySize, LDS_BYTES);
#endif
    int dev = 0, cus = 0, per_cu = 0;
    hipGetDevice(&dev);
    hipDeviceGetAttribute(&cus, hipDeviceAttributeMultiprocessorCount, dev);
#if MEGA
    hipOccupancyMaxActiveBlocksPerMultiprocessor(&per_cu, k_mega, NT, LDS_BYTES);
#else
    hipOccupancyMaxActiveBlocksPerMultiprocessor(&per_cu, k_phase, NT, LDS_BYTES);
#endif
    if (per_cu < 1) per_cu = 1;
    grid_blocks = cus * per_cu;
  }
#if MEGA
  void* args[] = {&p};
  hipError_t e = hipLaunchCooperativeKernel((void*)k_mega, dim3(grid_blocks), dim3(NT), args, LDS_BYTES, stream);
  if (e != hipSuccess) fprintf(stderr, "cooperative launch failed: %s (grid %d)\n", hipGetErrorString(e), grid_blocks);
#else
  k_phase<<<grid_blocks, NT, LDS_BYTES, stream>>>(p, PH_PREP, 0);
  for (int l = 0; l < NL; ++l)
    for (int ph = PH_NORM1; ph <= PH_GEMM_PLE; ++ph) k_phase<<<grid_blocks, NT, LDS_BYTES, stream>>>(p, ph, l);
  k_phase<<<grid_blocks, NT, LDS_BYTES, stream>>>(p, PH_FINAL, 0);
#endif
}
```

```cpp
#include <hip/hip_runtime.h>
#include <hip/hip_bf16.h>
#include <hip/hip_cooperative_groups.h>
#include <cstdio>
#include <cstdint>
namespace cg = cooperative_groups;

#ifndef MEGA
#define MEGA 1
#endif

#ifndef PROBE_A
#define PROBE_A -1
#endif
#ifndef PROBE_B
#define PROBE_B -1
#endif
#define DEVI __device__ __forceinline__

typedef __attribute__((ext_vector_type(8))) short bf16x8;
typedef __attribute__((ext_vector_type(4))) float f32x4;
typedef unsigned short bf16_t;

constexpr int NT = 512;
constexpr int S_ = 16384, DM = 1024, NL = 2, PW = 2944, INW = 2824;
constexpr int RQ = 0, RK = 256, RV = 512, RG = 768, LG = 1024, LX = 1280, SU = 1536, DQ = 1792,
              DB = 2560, DA = 2564, DG = 2568;
constexpr float EPS = 1e-6f;
constexpr int LDS_BYTES = 132 * 1024;

struct Params {
  const float *x, *p; const int* pos;
  const float *mix_norm, *w_in, *ret_gn, *lru_conv_w, *lru_conv_b, *lru_w_a, *lru_b_a, *lru_w_x, *lru_b_x, *lru_lambda;
  const float *s5_a_re, *s5_a_im, *s5_b_re, *s5_b_im, *s5_c_re, *s5_c_im, *s5_d, *s5_log_dt, *s5_glu_w, *s5_glu_b;
  const float *gdn_conv_w, *gdn_a_log, *gdn_dt_bias, *gdn_norm, *branch_norm, *w_out, *ffn_norm, *peer_wq, *peer_subkeys;
  const float *peer_u, *peer_v, *ple_norm, *ple_wg, *ple_wp, *final_norm;
  float* out;
  float* h; bf16_t* zb; float* proj; float* qbuf; float* scores;
  float *g_u, *g_w, *g_attn, *g_qd, *g_kd, *g_sst, *g_cdec, *g_comp;
  int* ids; float* gates;
  float *lru_h, *lru_p, *lru_hs, *lru_ps;
  float* ret_kv; float* xloc;
  uint8_t *tabU, *tabV; float *uinv, *vinv;
  bf16_t *winT, *woutT, *wqT, *wgT, *wpT, *gluT;
  float* rope; float* ssq; bf16_t* pbf; unsigned* bar;
};

DEVI int TID() { int t = __builtin_amdgcn_workitem_id_x(); asm volatile("" : "+v"(t)); return t; }
DEVI bf16_t f2bf(float f) { unsigned u = __float_as_uint(f); u += 0x7FFFu + ((u >> 16) & 1u); return (bf16_t)(u >> 16); }
DEVI float bf2f(bf16_t b) { return __uint_as_float(((unsigned)b) << 16); }
DEVI unsigned pack2(float a, float b) { return (unsigned)f2bf(a) | ((unsigned)f2bf(b) << 16); }
DEVI float sigmoidf_(float x) { return 1.f / (1.f + expf(-x)); }
DEVI float siluf_(float x) { return x / (1.f + expf(-x)); }
DEVI float geluf_(float x) { float u = 0.7978845608028654f * (x + 0.044715f * x * x * x); return 0.5f * x * (1.f + tanhf(u)); }
DEVI float softplusf_(float x) { return x > 20.f ? x : log1pf(expf(x)); }
DEVI float wave_sum(float v) {
  v += __shfl_xor(v, 32); v += __shfl_xor(v, 16); v += __shfl_xor(v, 8);
  v += __shfl_xor(v, 4); v += __shfl_xor(v, 2); v += __shfl_xor(v, 1); return v;
}
DEVI float sum16(float v) {
  v += __shfl_xor(v, 8); v += __shfl_xor(v, 4); v += __shfl_xor(v, 2); v += __shfl_xor(v, 1); return v;
}

template <int NTL>
DEVI void mm16(f32x4 (&acc)[NTL], const float* A, int sam, int sak, const float* B, int sbk, int sbn, int K) {
  const int l = TID() & 63, r = l & 15, q = l >> 4;
  const float* ap = A + r * sam + q * sak;
  const float* bp = B + q * sbk + r * sbn;
#pragma unroll 4
  for (int k = 0; k < K; k += 4) {
    float a = ap[k * sak];
#pragma unroll
    for (int t = 0; t < NTL; ++t) {
      float b = bp[k * sbk + t * 16 * sbn];
      acc[t] = __builtin_amdgcn_mfma_f32_16x16x4f32(a, b, acc[t], 0, 0, 0);
    }
  }
}

template <int AMODE, int NK>
DEVI void gemm_tile(f32x4 (&acc)[4][4], const void* Aptr, int lda, const bf16_t* Bt, int ldb, int K, int m0, int n0,
                    const float* ssq, char* smem) {
  constexpr int LDT = 72, BUF = (256 + 128) * LDT;
  bf16_t* sbase = (bf16_t*)smem;
  const int tid = TID(), lane = tid & 63, wave = tid >> 6;
  const int wm = wave >> 1, wn = wave & 1, r = lane & 15, q = lane >> 4;
  const int lrow = tid >> 3, lkc = tid & 7;
  uint4 raS00, raS01, raS02, raS03, rbS00, rbS01, raS10, raS11, raS12, raS13, rbS10, rbS11, raS20, raS21, raS22, raS23, rbS20, rbS21;
  float rs0 = 1.f, rs1 = 1.f, rs2 = 1.f, rs3 = 1.f;
#pragma unroll
  for (int i = 0; i < 4; ++i)
#pragma unroll
    for (int j = 0; j < 4; ++j) acc[i][j] = f32x4{0.f, 0.f, 0.f, 0.f};
  const bf16_t* Ab = (const bf16_t*)Aptr + (size_t)(m0 + lrow) * lda + lkc * 8;
  const bf16_t* Bb = Bt + (size_t)(n0 + lrow) * ldb + lkc * 8;
#define GL(S, k0_)                                                    \
  {                                                                   \
    ra##S##0 = *(const uint4*)(Ab + (k0_));                           \
    ra##S##1 = *(const uint4*)(Ab + (size_t)64 * lda + (k0_));        \
    ra##S##2 = *(const uint4*)(Ab + (size_t)128 * lda + (k0_));       \
    ra##S##3 = *(const uint4*)(Ab + (size_t)192 * lda + (k0_));       \
    rb##S##0 = *(const uint4*)(Bb + (k0_));                           \
    rb##S##1 = *(const uint4*)(Bb + (size_t)64 * ldb + (k0_));        \
  }
  auto scale = [&](uint4 v, float s) {
    unsigned w[4] = {v.x, v.y, v.z, v.w};
#pragma unroll
    for (int j = 0; j < 4; ++j) {
      float lo = __uint_as_float(w[j] << 16) * s, hi = __uint_as_float(w[j] & 0xFFFF0000u) * s;
      w[j] = pack2(lo, hi);
    }
    return uint4{w[0], w[1], w[2], w[3]};
  };
  auto rowscale = [&](int row, int k0) {
    const float* sp = ssq + (size_t)(m0 + row) * 16;
    int seg = k0 >> 8;
    float s = seg == 0 ? (sp[0] + sp[1] + sp[2] + sp[3]) : seg == 1 ? sp[4] : seg == 2 ? sp[5] : (sp[8] + sp[9] + sp[10] + sp[11]);
    return rsqrtf(s * (1.f / 256.f) + EPS);
  };
#define LS(S, k0_, bi_)                                                               \
  {                                                                                   \
    bf16_t* As_ = sbase + (bi_) * BUF; bf16_t* Bs_ = As_ + 256 * LDT;                 \
    if constexpr (AMODE == 1) {                                                       \
      if (((k0_) & 255) == 0) {                                                       \
        rs0 = rowscale(lrow, (k0_)); rs1 = rowscale(lrow + 64, (k0_));                \
        rs2 = rowscale(lrow + 128, (k0_)); rs3 = rowscale(lrow + 192, (k0_));         \
      }                                                                               \
      ra##S##0 = scale(ra##S##0, rs0); ra##S##1 = scale(ra##S##1, rs1);               \
      ra##S##2 = scale(ra##S##2, rs2); ra##S##3 = scale(ra##S##3, rs3);               \
    }                                                                                 \
    *(uint4*)&As_[(lrow) * LDT + lkc * 8] = ra##S##0;                                 \
    *(uint4*)&As_[(lrow + 64) * LDT + lkc * 8] = ra##S##1;                            \
    *(uint4*)&As_[(lrow + 128) * LDT + lkc * 8] = ra##S##2;                           \
    *(uint4*)&As_[(lrow + 192) * LDT + lkc * 8] = ra##S##3;                           \
    *(uint4*)&Bs_[(lrow) * LDT + lkc * 8] = rb##S##0;                                 \
    *(uint4*)&Bs_[(lrow + 64) * LDT + lkc * 8] = rb##S##1;                            \
  }
  auto compute = [&](int bi) {
    const bf16_t* As = sbase + bi * BUF; const bf16_t* Bs = As + 256 * LDT;
#pragma unroll
    for (int kk = 0; kk < 2; ++kk) {
      bf16x8 a[4], b[4];
#pragma unroll
      for (int i = 0; i < 4; ++i) a[i] = *(const bf16x8*)&As[(wm * 64 + i * 16 + r) * LDT + kk * 32 + q * 8];
#pragma unroll
      for (int j = 0; j < 4; ++j) b[j] = *(const bf16x8*)&Bs[(wn * 64 + j * 16 + r) * LDT + kk * 32 + q * 8];
#pragma unroll
      for (int i = 0; i < 4; ++i)
#pragma unroll
        for (int j = 0; j < 4; ++j)
          acc[i][j] = __builtin_amdgcn_mfma_f32_16x16x32_bf16(b[j], a[i], acc[i][j], 0, 0, 0);
    }
  };

  __syncthreads();
  if constexpr (NK == 16 && AMODE == 1) {
    GL(S0, 0)
    LS(S0, 0, 0)
    GL(S1, 64)
    __syncthreads();
#pragma unroll 1
    for (int kt = 0; kt < NK; kt += 2) {
      compute(0);
      LS(S1, ((kt + 1) << 6), 1)
      if (kt + 2 < NK) GL(S0, ((kt + 2) << 6))
      __syncthreads();
      compute(1);
      if (kt + 2 < NK) { LS(S0, ((kt + 2) << 6), 0) GL(S1, ((kt + 3) << 6)) }
      __syncthreads();
    }
  } else if constexpr (NK == 16) {
    GL(S0, 0) GL(S1, 64) GL(S2, 128)
    LS(S0, 0, 0)
    GL(S0, 192)
    __syncthreads();
    compute(0);
    LS(S1, 64, 1)
    GL(S1, 256)
    __syncthreads();
    compute(1);
    LS(S2, 128, 0)
    GL(S2, 320)
    __syncthreads();
    compute(0);
    LS(S0, 192, 1)
    GL(S0, 384)
    __syncthreads();
    compute(1);
    LS(S1, 256, 0)
    GL(S1, 448)
    __syncthreads();
    compute(0);
    LS(S2, 320, 1)
    GL(S2, 512)
    __syncthreads();
    compute(1);
    LS(S0, 384, 0)
    GL(S0, 576)
    __syncthreads();
    compute(0);
    LS(S1, 448, 1)
    GL(S1, 640)
    __syncthreads();
    compute(1);
    LS(S2, 512, 0)
    GL(S2, 704)
    __syncthreads();
    compute(0);
    LS(S0, 576, 1)
    GL(S0, 768)
    __syncthreads();
    compute(1);
    LS(S1, 640, 0)
    GL(S1, 832)
    __syncthreads();
    compute(0);
    LS(S2, 704, 1)
    GL(S2, 896)
    __syncthreads();
    compute(1);
    LS(S0, 768, 0)
    GL(S0, 960)
    __syncthreads();
    compute(0);
    LS(S1, 832, 1)
    __syncthreads();
    compute(1);
    LS(S2, 896, 0)
    __syncthreads();
    compute(0);
    LS(S0, 960, 1)
    __syncthreads();
    compute(1);
    __syncthreads();
  } else {
    GL(S0, 0) GL(S1, 64) GL(S2, 128)
    LS(S0, 0, 0)
    GL(S0, 192)
    __syncthreads();
    compute(0);
    LS(S1, 64, 1)
    __syncthreads();
    compute(1);
    LS(S2, 128, 0)
    __syncthreads();
    compute(0);
    LS(S0, 192, 1)
    __syncthreads();
    compute(1);
    __syncthreads();
  }
#undef GL
#undef LS
}
#define GEMM_EPI_COORDS                                                   \
  const int lane_ = TID() & 63, wave_ = TID() >> 6;           \
  const int erow0 = m0 + (wave_ >> 1) * 64 + (lane_ & 15);                \
  const int ecol0 = n0 + (wave_ & 1) * 64 + (lane_ >> 4) * 4;

DEVI void transpose_tile(const float* W, int ldw, int nvalid, bf16_t* Bt, int ldbt, int k0, int n0, char* smem) {
  float* t = (float*)smem;
  const int tid = TID();
  {
    int i = tid >> 4, j4 = tid & 15;
#pragma unroll
    for (int h2 = 0; h2 < 2; ++h2) {
      int kk = i + 32 * h2;
      int n = n0 + j4 * 4;
      float4 v = float4{0.f, 0.f, 0.f, 0.f};
      if (n < nvalid) v = *(const float4*)&W[(size_t)(k0 + kk) * ldw + n];
      t[(j4 * 4 + 0) * 65 + kk] = v.x; t[(j4 * 4 + 1) * 65 + kk] = v.y;
      t[(j4 * 4 + 2) * 65 + kk] = v.z; t[(j4 * 4 + 3) * 65 + kk] = v.w;
    }
  }
  __syncthreads();
  {
    int n = tid >> 3, k8 = tid & 7;
    const float* s = &t[n * 65 + k8 * 8];
    uint4 v;
    v.x = pack2(s[0], s[1]); v.y = pack2(s[2], s[3]); v.z = pack2(s[4], s[5]); v.w = pack2(s[6], s[7]);
    *(uint4*)&Bt[(size_t)(n0 + n) * ldbt + k0 + k8 * 8] = v;
  }
  __syncthreads();
}

DEVI void convert_tables(const Params& p, int l) {
  const int lane = TID() & 63, wave = TID() >> 6;
  for (int rr = blockIdx.x * 8 + wave; rr < 2 * 16384; rr += gridDim.x * 8) {
    const int which = rr >> 14, row = rr & 16383;
    const float* src = (which ? p.peer_v : p.peer_u) + ((size_t)l * 16384 + row) * 1024 + lane * 16;
    float4 a = *(const float4*)src, b = *(const float4*)(src + 4), c = *(const float4*)(src + 8), d = *(const float4*)(src + 12);
    float m = fmaxf(fmaxf(fmaxf(fabsf(a.x), fabsf(a.y)), fmaxf(fabsf(a.z), fabsf(a.w))),
                    fmaxf(fmaxf(fabsf(b.x), fabsf(b.y)), fmaxf(fabsf(b.z), fabsf(b.w))));
    m = fmaxf(m, fmaxf(fmaxf(fmaxf(fabsf(c.x), fabsf(c.y)), fmaxf(fabsf(c.z), fabsf(c.w))),
                       fmaxf(fmaxf(fabsf(d.x), fabsf(d.y)), fmaxf(fabsf(d.z), fabsf(d.w)))));
    m = fmaxf(m, __shfl_xor(m, 32)); m = fmaxf(m, __shfl_xor(m, 16)); m = fmaxf(m, __shfl_xor(m, 8));
    m = fmaxf(m, __shfl_xor(m, 4)); m = fmaxf(m, __shfl_xor(m, 2)); m = fmaxf(m, __shfl_xor(m, 1));
    const float sc = m > 0.f ? 256.f / m : 1.f;
    int w0 = 0, w1 = 0, w2 = 0, w3 = 0;
    w0 = __builtin_amdgcn_cvt_pk_fp8_f32(a.x * sc, a.y * sc, w0, false); w0 = __builtin_amdgcn_cvt_pk_fp8_f32(a.z * sc, a.w * sc, w0, true);
    w1 = __builtin_amdgcn_cvt_pk_fp8_f32(b.x * sc, b.y * sc, w1, false); w1 = __builtin_amdgcn_cvt_pk_fp8_f32(b.z * sc, b.w * sc, w1, true);
    w2 = __builtin_amdgcn_cvt_pk_fp8_f32(c.x * sc, c.y * sc, w2, false); w2 = __builtin_amdgcn_cvt_pk_fp8_f32(c.z * sc, c.w * sc, w2, true);
    w3 = __builtin_amdgcn_cvt_pk_fp8_f32(d.x * sc, d.y * sc, w3, false); w3 = __builtin_amdgcn_cvt_pk_fp8_f32(d.z * sc, d.w * sc, w3, true);
    *(uint4*)((which ? p.tabV : p.tabU) + (size_t)row * 1024 + lane * 16) = uint4{(unsigned)w0, (unsigned)w1, (unsigned)w2, (unsigned)w3};
    if (lane == 0) (which ? p.vinv : p.uinv)[row] = m > 0.f ? m * (1.f / 256.f) : 1.f;
  }
}

DEVI void ph_prep(const Params& p, char* smem) {
  const size_t gtid = (size_t)blockIdx.x * NT + TID(), gsz = (size_t)gridDim.x * NT;
  for (size_t i = gtid; i < (size_t)S_ * DM / 4; i += gsz) ((float4*)p.h)[i] = ((const float4*)p.x)[i];
  for (size_t i = gtid; i < (size_t)S_ * 32; i += gsz) {
    int t = (int)(i >> 5), f = (int)(i & 31);
    float inv = powf(10000.f, -(float)f / 32.f);
    float ang = (float)p.pos[t] * inv;
    p.rope[2 * i] = cosf(ang); p.rope[2 * i + 1] = sinf(ang);
  }
  for (int it = blockIdx.x; it < 2 * 1600; it += gridDim.x) {
    int l = it / 1600, idx = it % 1600;
    if (idx >= 1568) {
      int j = idx - 1568; int kt = j >> 3, nt = j & 7;
      transpose_tile(p.s5_glu_w + (size_t)l * 256 * 512, 512, 512, p.gluT + (size_t)l * 512 * 256, 256, kt * 64, nt * 64, smem);
    } else if (idx < 736) {
      int kt = idx / 46, nt = idx % 46;
      transpose_tile(p.w_in + (size_t)l * 1024 * INW, INW, INW, p.winT + (size_t)l * PW * 1024, 1024, kt * 64, nt * 64, smem);
    } else if (idx < 1504) {
      int j = idx - 736; int which = j >> 8; j &= 255;
      int kt = j >> 4, nt = j & 15;
      const float* src = (which == 0 ? p.w_out : which == 1 ? p.peer_wq : p.ple_wg) + (size_t)l * 1024 * 1024;
      bf16_t* dst = (which == 0 ? p.woutT : which == 1 ? p.wqT : p.wgT) + (size_t)l * 1024 * 1024;
      transpose_tile(src, 1024, 1024, dst, 1024, kt * 64, nt * 64, smem);
    } else {
      int j = idx - 1504; int kt = j >> 4, nt = j & 15;
      transpose_tile(p.ple_wp + (size_t)l * 256 * 1024, 1024, 1024, p.wpT + (size_t)l * 1024 * 256, 256, kt * 64, nt * 64, smem);
    }
  }
}

DEVI void ph_norm(const float* src, const float* g, bf16_t* dst, float* fout) {
  const int lane = TID() & 63, wave = TID() >> 6;
  for (int t = blockIdx.x * 8 + wave; t < S_; t += gridDim.x * 8) {
    const float* row = src + (size_t)t * DM;
    float4 v[4]; float ss = 0.f;
#pragma unroll
    for (int i = 0; i < 4; ++i) {
      v[i] = *(const float4*)&row[i * 256 + lane * 4];
      ss += v[i].x * v[i].x + v[i].y * v[i].y + v[i].z * v[i].z + v[i].w * v[i].w;
    }
    ss = wave_sum(ss);
    float rs = rsqrtf(ss * (1.f / DM) + EPS);
#pragma unroll
    for (int i = 0; i < 4; ++i) {
      float4 gg = *(const float4*)&g[i * 256 + lane * 4];
      float a = v[i].x * rs * gg.x, b = v[i].y * rs * gg.y, c = v[i].z * rs * gg.z, d = v[i].w * rs * gg.w;
      if (dst) *(uint2*)&dst[(size_t)t * DM + i * 256 + lane * 4] = uint2{pack2(a, b), pack2(c, d)};
      else *(float4*)&fout[(size_t)t * DM + i * 256 + lane * 4] = float4{a, b, c, d};
    }
  }
}

DEVI void gdn_prep(const Params& p, int l, int item, char* smem) {
  const int c = item >> 2, hd = item & 3, t0 = c * 64;
  float* sq = (float*)smem; float* sk = sq + 64 * 65; float* sv = sk + 64 * 65;
  float* sL = sv + 64 * 65;
  float* sgc = sL + 64 * 68; float* sbeta = sgc + 64;
  const int tid = TID(), lane = tid & 63, wave = tid >> 6, r = lane & 15, qd = lane >> 4;
  const float* cw = p.gdn_conv_w + (size_t)l * 4 * 768;
  for (int i = tid; i < 3 * 64 * 64; i += NT) {
    int d = i & 63, t = (i >> 6) & 63, which = i >> 12;
    int ch = which * 256 + hd * 64 + d;
    float acc = 0.f;
#pragma unroll
    for (int j = 0; j < 4; ++j) {
      int tt = t0 + t - 3 + j;
      if (tt >= 0) acc += cw[j * 768 + ch] * p.proj[(size_t)tt * PW + DQ + ch];
    }
    float v = siluf_(acc);
    (which == 0 ? sq : which == 1 ? sk : sv)[t * 65 + d] = v;
  }
  __syncthreads();
  if (tid < 128) {
    int t = tid & 63; float* row = (tid < 64 ? sq : sk) + t * 65;
    float s = 0.f;
    for (int d = 0; d < 64; ++d) s += row[d] * row[d];
    float sc = rsqrtf(s + EPS) * (tid < 64 ? 0.125f : 1.f);
    for (int d = 0; d < 64; ++d) row[d] *= sc;
  } else if (tid < 192) {
    int t = tid - 128;
    float bl = p.proj[(size_t)(t0 + t) * PW + DB + hd];
    float al = p.proj[(size_t)(t0 + t) * PW + DA + hd];
    float la = -expf(p.gdn_a_log[l * 4 + hd]) * softplusf_(al + p.gdn_dt_bias[l * 4 + hd]);
    for (int off = 1; off < 64; off <<= 1) { float n = __shfl_up(la, off); if (lane >= off) la += n; }
    sgc[t] = la; sbeta[t] = sigmoidf_(bl);
  }
  __syncthreads();
  {
    int mat = wave >> 2, mt = wave & 3;
    f32x4 acc[4];
#pragma unroll
    for (int t = 0; t < 4; ++t) acc[t] = f32x4{0.f, 0.f, 0.f, 0.f};
    mm16<4>(acc, (mat == 0 ? sk : sq) + mt * 16 * 65, 65, 1, sk, 1, 65, 64);
#pragma unroll
    for (int t = 0; t < 4; ++t)
#pragma unroll
      for (int e = 0; e < 4; ++e) {
        int i = mt * 16 + 4 * qd + e, j = t * 16 + r;
        float g = (i >= j) ? expf(sgc[i] - sgc[j]) : 0.f;
        if (mat == 0) sL[i * 68 + j] = (i > j) ? acc[t][e] * sbeta[i] * g : 0.f;
        else p.g_attn[((size_t)item * 64 + i) * 64 + j] = (i >= j) ? acc[t][e] * g : 0.f;
      }
  }
  __syncthreads();
  if (tid < 128) {
    const bool isv = tid < 64; const int d = tid & 63;
    float X[64];
#pragma unroll
    for (int i = 0; i < 64; ++i) X[i] = 0.f;
    float* dst = (isv ? p.g_u : p.g_w) + (size_t)item * 4096 + d;
#pragma unroll
    for (int i = 0; i < 64; ++i) {
      float bi = sbeta[i];
      float s = isv ? sv[i * 65 + d] * bi : sk[i * 65 + d] * bi * expf(sgc[i]);
#pragma unroll
      for (int j4 = 0; j4 < (i + 3) / 4; ++j4) {
        float4 lv = *(const float4*)&sL[i * 68 + j4 * 4];
        s -= lv.x * X[j4 * 4 + 0]; s -= lv.y * X[j4 * 4 + 1]; s -= lv.z * X[j4 * 4 + 2]; s -= lv.w * X[j4 * 4 + 3];
      }
      X[i] = s;
      dst[i * 64] = s;
    }
  } else {
    for (int i2 = tid - 128; i2 < 8192; i2 += 384) {
      int which = i2 >> 12, i = (i2 >> 6) & 63, d = i2 & 63;
      float val = which == 0 ? sq[i * 65 + d] * expf(sgc[i]) : sk[i * 65 + d] * expf(sgc[63] - sgc[i]);
      (which == 0 ? p.g_qd : p.g_kd)[(size_t)item * 4096 + i * 64 + d] = val;
    }
    if (tid == 128) p.g_cdec[item] = expf(sgc[63]);
  }
  __syncthreads();
}

DEVI f32x4 mm16_k64(const float* A, int sam, int sak, const float* B, int sbk, int sbn) {
  const int l = TID() & 63, r = l & 15, q = l >> 4;
  const float* ap = A + r * sam + q * sak;
  const float* bp = B + q * sbk + r * sbn;
  float av[16], bv[16];
#pragma unroll
  for (int k = 0; k < 16; ++k) { av[k] = ap[4 * k * sak]; bv[k] = bp[4 * k * sbk]; }
  f32x4 c0 = f32x4{0.f, 0.f, 0.f, 0.f}, c1 = f32x4{0.f, 0.f, 0.f, 0.f};
#pragma unroll
  for (int k = 0; k < 16; k += 2) {
    c0 = __builtin_amdgcn_mfma_f32_16x16x4f32(av[k], bv[k], c0, 0, 0, 0);
    c1 = __builtin_amdgcn_mfma_f32_16x16x4f32(av[k + 1], bv[k + 1], c1, 0, 0, 0);
  }
  return c0 + c1;
}

template <int MODE>
DEVI void gdn_chain(const Params& p, int hd, int grp, int cb, char* smem) {
  float* base = (float*)smem;
  constexpr int BUFSZ = 64 * 68 * 2 + 64 * 16;
  float* sS = base + 2 * BUFSZ; float* sVN = sS + 1024;
  const int tid = TID(), lane = tid & 63, wave = tid >> 6, r = lane & 15, qd = lane >> 4;
  const bool apart = (MODE == 0) && (cb >= 4);
  const int e0 = (cb & 3) * 16;
  const int c0 = grp * 32;
  float4 pw0, pw1, pkd0, pkd1, pu = float4{0.f, 0.f, 0.f, 0.f};
  const int lr0 = tid >> 4, lc0 = (tid & 15) * 4, lr1 = lr0 + 32;
  const int ur = tid >> 2, uc = (tid & 3) * 4;
#define GLOAD(c_)                                                            \
  {                                                                          \
    size_t b_ = (size_t)((c_) * 4 + hd) * 4096;                              \
    pw0 = *(const float4*)&p.g_w[b_ + lr0 * 64 + lc0];                       \
    pw1 = *(const float4*)&p.g_w[b_ + lr1 * 64 + lc0];                       \
    pkd0 = *(const float4*)&p.g_kd[b_ + lr0 * 64 + lc0];                     \
    pkd1 = *(const float4*)&p.g_kd[b_ + lr1 * 64 + lc0];                     \
    if (tid < 256 && !apart) pu = *(const float4*)&p.g_u[b_ + ur * 64 + e0 + uc]; \
  }
#define LSTORE(bi_)                                                          \
  {                                                                          \
    float* W_ = base + (bi_) * BUFSZ; float* KD_ = W_ + 64 * 68; float* U_ = KD_ + 64 * 68; \
    *(float4*)&W_[lr0 * 68 + lc0] = pw0; *(float4*)&W_[lr1 * 68 + lc0] = pw1;       \
    *(float4*)&KD_[lr0 * 68 + lc0] = pkd0; *(float4*)&KD_[lr1 * 68 + lc0] = pkd1;   \
    if (tid < 256) *(float4*)&U_[ur * 16 + uc] = pu;                         \
  }
  f32x4 sreg = f32x4{0.f, 0.f, 0.f, 0.f};
  if (MODE == 0) {
    for (int i = tid; i < 1024; i += NT) sS[i] = (apart && ((i >> 4) == e0 + (i & 15))) ? 1.f : 0.f;
    if (apart) {
#pragma unroll
      for (int e = 0; e < 4; ++e) sreg[e] = ((wave & 3) * 16 + 4 * qd + e == e0 + r) ? 1.f : 0.f;
    }
  } else {
    for (int i = tid; i < 1024; i += NT) sS[i] = 0.f;
    float* W = base;
    for (int g2 = 0; g2 < grp; ++g2) {
      const float* Ag = p.g_comp + ((size_t)(hd * 8 + g2) * 2 + 1) * 4096;
      const float* Bg = p.g_comp + ((size_t)(hd * 8 + g2) * 2 + 0) * 4096;
      __syncthreads();
      *(float4*)&W[lr0 * 68 + lc0] = *(const float4*)&Ag[lr0 * 64 + lc0];
      *(float4*)&W[lr1 * 68 + lc0] = *(const float4*)&Ag[lr1 * 64 + lc0];
      __syncthreads();
      f32x4 a = f32x4{0.f, 0.f, 0.f, 0.f};
      if (wave < 4) a = mm16_k64(W + wave * 16 * 68, 68, 1, sS, 16, 1);
      __syncthreads();
      if (wave < 4) {
#pragma unroll
        for (int e = 0; e < 4; ++e) {
          int d = wave * 16 + 4 * qd + e;
          sreg[e] = a[e] + Bg[d * 64 + e0 + r];
          sS[d * 16 + r] = sreg[e];
        }
      }
    }
    __syncthreads();
    if (wave < 4) {
#pragma unroll
      for (int e = 0; e < 4; ++e) {
        int d = wave * 16 + 4 * qd + e;
        p.g_sst[(size_t)(c0 * 4 + hd) * 4096 + d * 64 + e0 + r] = sreg[e];
      }
    }
  }
  GLOAD(c0) LSTORE(0)
  __syncthreads();
  for (int cc = 0; cc < 32; ++cc) {
    const int c = c0 + cc;
    if (cc + 1 < 32) GLOAD(c + 1)
    const float cd = p.g_cdec[c * 4 + hd];
    float* W = base + (cc & 1) * BUFSZ; float* KD = W + 64 * 68; float* U = KD + 64 * 68;
    const size_t it = (size_t)(c * 4 + hd);
    if (wave < 4) {
      f32x4 a1 = mm16_k64(W + wave * 16 * 68, 68, 1, sS, 16, 1);
#pragma unroll
      for (int e = 0; e < 4; ++e) {
        int i = wave * 16 + 4 * qd + e;
        float vn = (apart ? 0.f : U[i * 16 + r]) - a1[e];
        sVN[i * 16 + r] = vn;
        if (MODE == 1) p.g_u[it * 4096 + i * 64 + e0 + r] = vn;
      }
    }
    __syncthreads();
    if (wave < 4) {
      f32x4 a2 = mm16_k64(KD + wave * 16, 1, 68, sVN, 16, 1);
#pragma unroll
      for (int e = 0; e < 4; ++e) {
        int d = wave * 16 + 4 * qd + e;
        sreg[e] = sreg[e] * cd + a2[e];
        sS[d * 16 + r] = sreg[e];
        if (MODE == 1 && cc + 1 < 32) p.g_sst[(size_t)((c + 1) * 4 + hd) * 4096 + d * 64 + e0 + r] = sreg[e];
      }
    }
    if (cc + 1 < 32) LSTORE((cc + 1) & 1)
    __syncthreads();
  }
  if (MODE == 0 && wave < 4) {
    float* dst = p.g_comp + ((size_t)(hd * 8 + grp) * 2 + (apart ? 1 : 0)) * 4096;
#pragma unroll
    for (int e = 0; e < 4; ++e) {
      int d = wave * 16 + 4 * qd + e;
      dst[d * 64 + e0 + r] = sreg[e];
    }
  }
  __syncthreads();
}

DEVI void gdn_out(const Params& p, int l, int item, char* smem) {
  const int c = item >> 2, hd = item & 3, t0 = c * 64;
  float* sQD = (float*)smem; float* sS = sQD + 64 * 68; float* sAT = sS + 64 * 68; float* sVN = sAT + 64 * 68;
  const int tid = TID(), lane = tid & 63, wave = tid >> 6, r = lane & 15, qd = lane >> 4;
  const size_t b = (size_t)item * 4096;
  for (int idx = tid; idx < 1024; idx += NT) {
    int row = idx >> 4, c4 = idx & 15;
    *(float4*)&sQD[row * 68 + c4 * 4] = *(const float4*)&p.g_qd[b + row * 64 + c4 * 4];
    *(float4*)&sS[row * 68 + c4 * 4] = *(const float4*)&p.g_sst[b + row * 64 + c4 * 4];
    *(float4*)&sAT[row * 68 + c4 * 4] = *(const float4*)&p.g_attn[b + row * 64 + c4 * 4];
    *(float4*)&sVN[row * 68 + c4 * 4] = *(const float4*)&p.g_u[b + row * 64 + c4 * 4];
  }
  __syncthreads();
  const int mt = wave & 3, nh = wave >> 2;
  f32x4 acc[2]; acc[0] = acc[1] = f32x4{0.f, 0.f, 0.f, 0.f};
  mm16<2>(acc, sQD + mt * 16 * 68, 68, 1, sS + nh * 32, 68, 1, 64);
  mm16<2>(acc, sAT + mt * 16 * 68, 68, 1, sVN + nh * 32, 68, 1, 64);
  __syncthreads();
  float* sO = sQD;
#pragma unroll
  for (int t2 = 0; t2 < 2; ++t2)
#pragma unroll
    for (int e = 0; e < 4; ++e) sO[(mt * 16 + 4 * qd + e) * 68 + nh * 32 + t2 * 16 + r] = acc[t2][e];
  __syncthreads();
  {
    int row = tid >> 3, sub = tid & 7, t = t0 + row;
    float o[8], yv[8]; float ss = 0.f;
#pragma unroll
    for (int k = 0; k < 8; ++k) { o[k] = sO[row * 68 + sub * 8 + k]; ss += o[k] * o[k]; }
    ss += __shfl_xor(ss, 1); ss += __shfl_xor(ss, 2); ss += __shfl_xor(ss, 4);
    float rs = rsqrtf(ss * (1.f / 64.f) + EPS);
    float s2 = 0.f;
#pragma unroll
    for (int k = 0; k < 8; ++k) {
      int col = sub * 8 + k;
      float g = p.proj[(size_t)t * PW + DG + hd * 64 + col];
      float y = o[k] * rs * p.gdn_norm[l * 64 + col] * siluf_(g);
      s2 += y * y;
      yv[k] = y * p.branch_norm[(l * 4 + 3) * 256 + hd * 64 + col];
    }
    s2 += __shfl_xor(s2, 1); s2 += __shfl_xor(s2, 2); s2 += __shfl_xor(s2, 4);
    if (sub == 0) p.ssq[(size_t)t * 16 + 8 + hd] = s2;
    *(uint4*)&p.zb[(size_t)t * DM + 768 + hd * 64 + sub * 8] =
        uint4{pack2(yv[0], yv[1]), pack2(yv[2], yv[3]), pack2(yv[4], yv[5]), pack2(yv[6], yv[7])};
  }
  __syncthreads();
}

DEVI void ret_kv(const Params& p, int l, int item, char* smem) {
  const int c = item >> 2, hd = item & 3, t0 = c * 128;
  float* sK = (float*)smem; float* sV = sK + 128 * 65;
  const int tid = TID(), lane = tid & 63, wave = tid >> 6, r = lane & 15, qd = lane >> 4;
  const float lg = logf(1.f - exp2f(-5.f - (float)hd));
  for (int i = tid; i < 128 * 32; i += NT) {
    int t = i >> 5, f = i & 31; size_t tt = t0 + t;
    float k1 = p.proj[tt * PW + RK + hd * 64 + f], k2 = p.proj[tt * PW + RK + hd * 64 + 32 + f];
    float cs = p.rope[(tt * 32 + f) * 2], sn = p.rope[(tt * 32 + f) * 2 + 1];
    float dec = expf(lg * (float)(127 - t));
    sK[t * 65 + f] = (k1 * cs - k2 * sn) * dec;
    sK[t * 65 + 32 + f] = (k2 * cs + k1 * sn) * dec;
  }
  for (int i = tid; i < 128 * 64; i += NT) {
    int t = i >> 6, e = i & 63;
    sV[t * 65 + e] = p.proj[(size_t)(t0 + t) * PW + RV + hd * 64 + e];
  }
  __syncthreads();
  const int mt = wave & 3, nh = wave >> 2;
  f32x4 acc[2]; acc[0] = acc[1] = f32x4{0.f, 0.f, 0.f, 0.f};
  mm16<2>(acc, sK + mt * 16, 1, 65, sV + nh * 32, 65, 1, 128);
#pragma unroll
  for (int t2 = 0; t2 < 2; ++t2)
#pragma unroll
    for (int e = 0; e < 4; ++e)
      p.ret_kv[(size_t)item * 4096 + (mt * 16 + 4 * qd + e) * 64 + nh * 32 + t2 * 16 + r] = acc[t2][e];
  __syncthreads();
}

DEVI void ret_out(const Params& p, int l, int item, char* smem) {
  const int c = item >> 2, hd = item & 3, t0 = c * 128;
  float* sQ = (float*)smem; float* sK = sQ + 128 * 65; float* sV = sK + 128 * 65; float* sSt = sV + 128 * 65;
  const int tid = TID(), lane = tid & 63, wave = tid >> 6, r = lane & 15, qd = lane >> 4;
  const float lg = logf(1.f - exp2f(-5.f - (float)hd));
  {
    const float* ssrc = p.ret_kv + (size_t)(c * 4 + hd) * 4096;
#pragma unroll
    for (int j = 0; j < 8; ++j) { int idx = tid + 512 * j; sSt[(idx >> 6) * 65 + (idx & 63)] = ssrc[idx]; }
  }
  for (int i = tid; i < 128 * 32; i += NT) {
    int t = i >> 5, f = i & 31; size_t tt = t0 + t;
    float cs = p.rope[(tt * 32 + f) * 2], sn = p.rope[(tt * 32 + f) * 2 + 1];
    float k1 = p.proj[tt * PW + RK + hd * 64 + f], k2 = p.proj[tt * PW + RK + hd * 64 + 32 + f];
    sK[t * 65 + f] = (k1 * cs - k2 * sn);
    sK[t * 65 + 32 + f] = (k2 * cs + k1 * sn);
    float q1 = p.proj[tt * PW + RQ + hd * 64 + f], q2 = p.proj[tt * PW + RQ + hd * 64 + 32 + f];
    sQ[t * 65 + f] = (q1 * cs - q2 * sn) * 0.125f;
    sQ[t * 65 + 32 + f] = (q2 * cs + q1 * sn) * 0.125f;
  }
  for (int i = tid; i < 128 * 64; i += NT) {
    int t = i >> 6, e = i & 63;
    sV[t * 65 + e] = p.proj[(size_t)(t0 + t) * PW + RV + hd * 64 + e];
  }
  __syncthreads();
  const int i0 = wave * 16;
  f32x4 sc[8], os[4];
#pragma unroll
  for (int t = 0; t < 8; ++t) sc[t] = f32x4{0.f, 0.f, 0.f, 0.f};
#pragma unroll
  for (int t = 0; t < 4; ++t) os[t] = f32x4{0.f, 0.f, 0.f, 0.f};
  mm16<8>(sc, sQ + i0 * 65, 65, 1, sK, 1, 65, 64);
  mm16<4>(os, sQ + i0 * 65, 65, 1, sSt, 65, 1, 64);
  __syncthreads();
  float* sP = (float*)smem;
#pragma unroll
  for (int t2 = 0; t2 < 8; ++t2)
#pragma unroll
    for (int e = 0; e < 4; ++e) {
      int i = i0 + 4 * qd + e, j = t2 * 16 + r;
      sP[i * 129 + j] = (i >= j) ? sc[t2][e] * expf(lg * (float)(i - j)) : 0.f;
    }
  __syncthreads();
  f32x4 o[4];
#pragma unroll
  for (int t2 = 0; t2 < 4; ++t2)
#pragma unroll
    for (int e = 0; e < 4; ++e) o[t2][e] = os[t2][e] * expf(lg * (float)(i0 + 4 * qd + e + 1));
  mm16<4>(o, sP + i0 * 129, 129, 1, sV, 65, 1, 128);
#pragma unroll
  for (int e = 0; e < 4; ++e) {
    int i = i0 + 4 * qd + e; size_t t = t0 + i;
    float sm = sum16(o[0][e] + o[1][e] + o[2][e] + o[3][e]);
    float mu = sm * (1.f / 64.f);
    float vr = 0.f;
#pragma unroll
    for (int t2 = 0; t2 < 4; ++t2) { float dd = o[t2][e] - mu; vr += dd * dd; }
    vr = sum16(vr);
    float rstd = rsqrtf(vr * (1.f / 64.f) + EPS);
    float ss = 0.f;
#pragma unroll
    for (int t2 = 0; t2 < 4; ++t2) {
      int col = hd * 64 + t2 * 16 + r;
      float on = (o[t2][e] - mu) * rstd * p.ret_gn[l * 256 + col];
      float g = p.proj[t * PW + RG + col];
      float y = siluf_(g) * on;
      ss += y * y;
      p.zb[t * DM + col] = f2bf(y * p.branch_norm[(l * 4 + 0) * 256 + col]);
    }
    ss = sum16(ss);
    if (r == 0) p.ssq[t * 16 + hd] = ss;
  }
  __syncthreads();
}

DEVI void lru_local(const Params& p, int l, int c, char* smem) {
  const int t0 = c * 64;
  float* sX = (float*)smem; float* sA = sX + 64 * 257;
  const int tid = TID(), lane = tid & 63, wave = tid >> 6, r = lane & 15, qd = lane >> 4;
  for (int i = tid; i < 64 * 256; i += NT) {
    int t = i >> 8, ch = i & 255;
    float acc = p.lru_conv_b[l * 256 + ch];
#pragma unroll
    for (int j = 0; j < 4; ++j) {
      int tt = t0 + t - 3 + j;
      if (tt >= 0) acc += p.lru_conv_w[(l * 4 + j) * 256 + ch] * p.proj[(size_t)tt * PW + LX + ch];
    }
    sX[t * 257 + ch] = acc;
  }
  __syncthreads();
  for (int pr = 0; pr < 2; ++pr) {
    int pi = wave * 2 + pr, mt = pi & 3, nb = pi >> 2;
    f32x4 ra[4], ri[4];
#pragma unroll
    for (int t = 0; t < 4; ++t) { ra[t] = f32x4{0.f, 0.f, 0.f, 0.f}; ri[t] = f32x4{0.f, 0.f, 0.f, 0.f}; }
    mm16<4>(ra, sX + mt * 16 * 257 + nb * 64, 257, 1, p.lru_w_a + (size_t)(l * 4 + nb) * 4096, 64, 1, 64);
    mm16<4>(ri, sX + mt * 16 * 257 + nb * 64, 257, 1, p.lru_w_x + (size_t)(l * 4 + nb) * 4096, 64, 1, 64);
#pragma unroll
    for (int t2 = 0; t2 < 4; ++t2)
#pragma unroll
      for (int e = 0; e < 4; ++e) {
        int t = mt * 16 + 4 * qd + e, ch = nb * 64 + t2 * 16 + r;
        float xb = sX[t * 257 + ch];
        float rr = sigmoidf_(ra[t2][e] + p.lru_b_a[l * 256 + ch]);
        float ii = sigmoidf_(ri[t2][e] + p.lru_b_x[l * 256 + ch]);
        float loga = -8.f * rr * softplusf_(-p.lru_lambda[l * 256 + ch]);
        float a = expf(loga);
        float bb = sqrtf(-expm1f(2.f * loga)) * (ii * xb);
        sA[t * 257 + ch] = a; sX[t * 257 + ch] = bb;
      }
  }
  __syncthreads();
  if (tid < 256) {
    int ch = tid; float H = 0.f, P = 1.f;
    for (int t = 0; t < 64; ++t) {
      float a = sA[t * 257 + ch], bb = sX[t * 257 + ch];
      H = a * H + bb; P *= a;
      p.lru_h[(size_t)(t0 + t) * 256 + ch] = H; p.lru_p[(size_t)(t0 + t) * 256 + ch] = P;
    }
    p.lru_hs[c * 256 + ch] = H; p.lru_ps[c * 256 + ch] = P;
  }
  __syncthreads();
}

DEVI void lru_out(const Params& p, int l, int c, char* smem) {
  const int t0 = c * 64;
  float* sC = (float*)smem;
  const int tid = TID(), lane = tid & 63, wave = tid >> 6;
  if (tid < 256) sC[tid] = p.lru_hs[c * 256 + tid];
  __syncthreads();
  for (int tk = 0; tk < 8; ++tk) {
    size_t t = t0 + wave * 8 + tk; int ch = lane * 4;
    float4 H = *(const float4*)&p.lru_h[t * 256 + ch], P = *(const float4*)&p.lru_p[t * 256 + ch];
    float4 g = *(const float4*)&p.proj[t * PW + LG + ch], cr = *(const float4*)&sC[ch];
    float4 bn = *(const float4*)&p.branch_norm[(l * 4 + 1) * 256 + ch];
    float y0 = geluf_(g.x) * (H.x + P.x * cr.x), y1 = geluf_(g.y) * (H.y + P.y * cr.y);
    float y2 = geluf_(g.z) * (H.z + P.z * cr.z), y3 = geluf_(g.w) * (H.w + P.w * cr.w);
    float ss = wave_sum(y0 * y0 + y1 * y1 + y2 * y2 + y3 * y3);
    if (lane == 0) p.ssq[t * 16 + 4] = ss;
    *(uint2*)&p.zb[t * DM + 256 + ch] = uint2{pack2(y0 * bn.x, y1 * bn.y), pack2(y2 * bn.z, y3 * bn.w)};
  }
  __syncthreads();
}

DEVI void s5_coef(const Params& p, int l, int g, int n, float& abr, float& abi, float (&bbr)[16], float (&bbi)[16]) {
  float dt = expf(p.s5_log_dt[l * 16 + g]);
  float are = p.s5_a_re[(l * 16 + g) * 64 + n], aim = p.s5_a_im[(l * 16 + g) * 64 + n];
  float mag = expf(are * dt), ang = aim * dt;
  abr = mag * cosf(ang); abi = mag * sinf(ang);
  float den = are * are + aim * aim;
  float pre = abr - 1.f, pim = abi;
  float fre = (pre * are + pim * aim) / den, fim = (pim * are - pre * aim) / den;
  const float4* br = (const float4*)(p.s5_b_re + (size_t)((l * 16 + g) * 64 + n) * 16);
  const float4* bi = (const float4*)(p.s5_b_im + (size_t)((l * 16 + g) * 64 + n) * 16);
#pragma unroll
  for (int c4 = 0; c4 < 4; ++c4) {
    float4 a = br[c4], b = bi[c4];
    bbr[c4 * 4 + 0] = fre * a.x - fim * b.x; bbi[c4 * 4 + 0] = fre * b.x + fim * a.x;
    bbr[c4 * 4 + 1] = fre * a.y - fim * b.y; bbi[c4 * 4 + 1] = fre * b.y + fim * a.y;
    bbr[c4 * 4 + 2] = fre * a.z - fim * b.z; bbi[c4 * 4 + 2] = fre * b.z + fim * a.z;
    bbr[c4 * 4 + 3] = fre * a.w - fim * b.w; bbi[c4 * 4 + 3] = fre * b.w + fim * a.w;
  }
}
DEVI void s5_load_u(const Params& p, int t0, float* sU) {
  for (int i = TID(); i < 64 * 64; i += NT) {
    int t = i >> 6, c4 = i & 63;
    *(float4*)&sU[t * 256 + c4 * 4] = *(const float4*)&p.proj[(size_t)(t0 + t) * PW + SU + c4 * 4];
  }
}
DEVI void s5_bu(const float* up, const float (&bbr)[16], const float (&bbi)[16], float& bur, float& bui) {
  bur = 0.f; bui = 0.f;
#pragma unroll
  for (int c4 = 0; c4 < 4; ++c4) {
    float4 u = *(const float4*)&up[c4 * 4];
    bur += bbr[c4 * 4] * u.x + bbr[c4 * 4 + 1] * u.y + bbr[c4 * 4 + 2] * u.z + bbr[c4 * 4 + 3] * u.w;
    bui += bbi[c4 * 4] * u.x + bbi[c4 * 4 + 1] * u.y + bbi[c4 * 4 + 2] * u.z + bbi[c4 * 4 + 3] * u.w;
  }
}

DEVI void s5_local(const Params& p, int l, int c, char* smem) {
  const int t0 = c * 64;
  float* sU = (float*)smem;
  const int lane = TID() & 63, wave = TID() >> 6;
  s5_load_u(p, t0, sU);
  __syncthreads();
  for (int gi = 0; gi < 2; ++gi) {
    int g = wave + 8 * gi;
    float abr, abi, bbr[16], bbi[16];
    s5_coef(p, l, g, lane, abr, abi, bbr, bbi);
    float xr = 0.f, xi = 0.f;
    for (int t = 0; t < 64; ++t) {
      float bur, bui; s5_bu(sU + t * 256 + g * 16, bbr, bbi, bur, bui);
      float nr = abr * xr - abi * xi + bur, ni = abr * xi + abi * xr + bui;
      xr = nr; xi = ni;
    }
    *(float2*)&p.xloc[((size_t)(c * 16 + g) * 64 + lane) * 2] = float2{xr, xi};
  }
  __syncthreads();
}

DEVI void s5_out(const Params& p, int l, int c, char* smem) {
  const int t0 = c * 64;
  bf16_t* sY = (bf16_t*)smem;
  float* sX = (float*)(smem + 64 * 264 * 2);
  const int tid = TID(), lane = tid & 63, wave = tid >> 6, r = lane & 15, qd = lane >> 4;
  float* Xl = sX + wave * (16 * 132);
  for (int gi = 0; gi < 2; ++gi) {
    const int g = wave + 8 * gi;
    float abr, abi, bbr[16], bbi[16];
    s5_coef(p, l, g, lane, abr, abi, bbr, bbi);
    float breg[32];
#pragma unroll
    for (int ks = 0; ks < 16; ++ks) {
      breg[ks] = p.s5_c_re[(size_t)((l * 16 + g) * 16 + r) * 64 + 4 * ks + qd];
      breg[16 + ks] = -p.s5_c_im[(size_t)((l * 16 + g) * 16 + r) * 64 + 4 * ks + qd];
    }
    const float dd = p.s5_d[l * 256 + g * 16 + r];
    const float2 xin = *(const float2*)&p.xloc[((size_t)(c * 16 + g) * 64 + lane) * 2];
    float xr = xin.x, xi = xin.y;
    float4 uvecs[4]; float ues[4][4];
#pragma unroll
    for (int tb = 0; tb < 4; ++tb) {
      const float* ub = p.proj + (size_t)(t0 + tb * 16) * PW + SU + g * 16;
      uvecs[tb] = *(const float4*)&ub[(size_t)r * PW + 4 * qd];
#pragma unroll
      for (int e = 0; e < 4; ++e) ues[tb][e] = ub[(size_t)(4 * qd + e) * PW + r];
    }
#pragma unroll
    for (int tb = 0; tb < 4; ++tb) {
      const float4 uvec = uvecs[tb];
      float ue[4];
#pragma unroll
      for (int e = 0; e < 4; ++e) ue[e] = ues[tb][e];
      const int u0 = __float_as_int(uvec.x), u1 = __float_as_int(uvec.y), u2 = __float_as_int(uvec.z), u3 = __float_as_int(uvec.w);
#pragma unroll
      for (int tt = 0; tt < 16; ++tt) {
        float bur = 0.f, bui = 0.f;
#pragma unroll
        for (int c4 = 0; c4 < 4; ++c4) {
          float a0 = __int_as_float(__builtin_amdgcn_readlane(u0, tt + 16 * c4));
          float a1 = __int_as_float(__builtin_amdgcn_readlane(u1, tt + 16 * c4));
          float a2 = __int_as_float(__builtin_amdgcn_readlane(u2, tt + 16 * c4));
          float a3 = __int_as_float(__builtin_amdgcn_readlane(u3, tt + 16 * c4));
          bur += bbr[c4 * 4] * a0 + bbr[c4 * 4 + 1] * a1 + bbr[c4 * 4 + 2] * a2 + bbr[c4 * 4 + 3] * a3;
          bui += bbi[c4 * 4] * a0 + bbi[c4 * 4 + 1] * a1 + bbi[c4 * 4 + 2] * a2 + bbi[c4 * 4 + 3] * a3;
        }
        float nr = abr * xr - abi * xi + bur, ni = abr * xi + abi * xr + bui;
        xr = nr; xi = ni;
        Xl[tt * 132 + lane] = xr; Xl[tt * 132 + 64 + lane] = xi;
      }
      f32x4 acc = f32x4{0.f, 0.f, 0.f, 0.f};
#pragma unroll
      for (int ks = 0; ks < 32; ++ks) {
        float a = Xl[r * 132 + 4 * ks + qd];
        acc = __builtin_amdgcn_mfma_f32_16x16x4f32(a, breg[ks], acc, 0, 0, 0);
      }
#pragma unroll
      for (int e = 0; e < 4; ++e) {
        float y = acc[e] + dd * ue[e];
        sY[(tb * 16 + 4 * qd + e) * 264 + g * 16 + r] = f2bf(geluf_(y));
      }
    }
  }
  __syncthreads();
  f32x4 av[4][2], ag[4][2];
#pragma unroll
  for (int i = 0; i < 4; ++i)
#pragma unroll
    for (int j = 0; j < 2; ++j) { av[i][j] = f32x4{0.f, 0.f, 0.f, 0.f}; ag[i][j] = f32x4{0.f, 0.f, 0.f, 0.f}; }
  const bf16_t* WT = p.gluT + (size_t)l * 512 * 256;
#pragma unroll 4
  for (int ks = 0; ks < 8; ++ks) {
    bf16x8 bv0 = *(const bf16x8*)&WT[(size_t)(32 * wave + r) * 256 + ks * 32 + qd * 8];
    bf16x8 bv1 = *(const bf16x8*)&WT[(size_t)(32 * wave + 16 + r) * 256 + ks * 32 + qd * 8];
    bf16x8 bg0 = *(const bf16x8*)&WT[(size_t)(256 + 32 * wave + r) * 256 + ks * 32 + qd * 8];
    bf16x8 bg1 = *(const bf16x8*)&WT[(size_t)(256 + 32 * wave + 16 + r) * 256 + ks * 32 + qd * 8];
#pragma unroll
    for (int mt = 0; mt < 4; ++mt) {
      bf16x8 a = *(const bf16x8*)&sY[(mt * 16 + r) * 264 + ks * 32 + qd * 8];
      av[mt][0] = __builtin_amdgcn_mfma_f32_16x16x32_bf16(a, bv0, av[mt][0], 0, 0, 0);
      av[mt][1] = __builtin_amdgcn_mfma_f32_16x16x32_bf16(a, bv1, av[mt][1], 0, 0, 0);
      ag[mt][0] = __builtin_amdgcn_mfma_f32_16x16x32_bf16(a, bg0, ag[mt][0], 0, 0, 0);
      ag[mt][1] = __builtin_amdgcn_mfma_f32_16x16x32_bf16(a, bg1, ag[mt][1], 0, 0, 0);
    }
  }
  float* sO = sX;
#pragma unroll
  for (int mt = 0; mt < 4; ++mt)
#pragma unroll
    for (int t2 = 0; t2 < 2; ++t2)
#pragma unroll
      for (int e = 0; e < 4; ++e) {
        int t = mt * 16 + 4 * qd + e, col = 32 * wave + t2 * 16 + r;
        float zv = av[mt][t2][e] + p.s5_glu_b[l * 512 + col];
        float zg = ag[mt][t2][e] + p.s5_glu_b[l * 512 + 256 + col];
        sO[t * 256 + col] = zv * sigmoidf_(zg);
      }
  __syncthreads();
  for (int tk = 0; tk < 8; ++tk) {
    int tl = wave * 8 + tk; size_t t = t0 + tl; int ch = lane * 4;
    float4 o = *(const float4*)&sO[tl * 256 + ch];
    float4 bn = *(const float4*)&p.branch_norm[(l * 4 + 2) * 256 + ch];
    float ss = wave_sum(o.x * o.x + o.y * o.y + o.z * o.z + o.w * o.w);
    if (lane == 0) p.ssq[t * 16 + 5] = ss;
    *(uint2*)&p.zb[t * DM + 512 + ch] = uint2{pack2(o.x * bn.x, o.y * bn.y), pack2(o.z * bn.z, o.w * bn.w)};
  }
  __syncthreads();
}

DEVI void ret_scan(const Params& p, int it) {
  const int elem = it * NT + TID(), hd = elem >> 12, idx = elem & 4095;
  const float lg = logf(1.f - exp2f(-5.f - (float)hd)), cdk = expf(lg * 128.f);
  float* base = p.ret_kv + (size_t)hd * 4096 + idx;
  float s = 0.f;
  for (int cb = 0; cb < 128; cb += 16) {
    float v[16];
#pragma unroll
    for (int j = 0; j < 16; ++j) v[j] = base[(size_t)(cb + j) * 16384];
#pragma unroll
    for (int j = 0; j < 16; ++j) { base[(size_t)(cb + j) * 16384] = s; s = s * cdk + v[j]; }
  }
}
DEVI void s5_scan(const Params& p, int l, int it) {
  const int sidx = it * NT + TID(), g = sidx >> 6, n = sidx & 63;
  float dt = expf(p.s5_log_dt[l * 16 + g]);
  float are = p.s5_a_re[(l * 16 + g) * 64 + n], aim = p.s5_a_im[(l * 16 + g) * 64 + n];
  float mag = expf(are * dt), ang = aim * dt;
  float pr = mag * cosf(ang), pi = mag * sinf(ang);
#pragma unroll
  for (int k = 0; k < 6; ++k) { float nr = pr * pr - pi * pi, ni = 2.f * pr * pi; pr = nr; pi = ni; }
  float2* base = (float2*)p.xloc + sidx;
  float xr = 0.f, xi = 0.f;
  for (int cb = 0; cb < 256; cb += 16) {
    float2 v[16];
#pragma unroll
    for (int j = 0; j < 16; ++j) v[j] = base[(size_t)(cb + j) * 1024];
#pragma unroll
    for (int j = 0; j < 16; ++j) {
      base[(size_t)(cb + j) * 1024] = float2{xr, xi};
      float nr = pr * xr - pi * xi + v[j].x, ni = pr * xi + pi * xr + v[j].y;
      xr = nr; xi = ni;
    }
  }
}
DEVI void lru_scan(const Params& p) {
  const int ch = TID();
  if (ch < 256) {
    float carry = 0.f;
    for (int cb = 0; cb < 256; cb += 16) {
      float ps[16], hs[16];
#pragma unroll
      for (int j = 0; j < 16; ++j) { ps[j] = p.lru_ps[(cb + j) * 256 + ch]; hs[j] = p.lru_hs[(cb + j) * 256 + ch]; }
#pragma unroll
      for (int j = 0; j < 16; ++j) { p.lru_hs[(cb + j) * 256 + ch] = carry; carry = ps[j] * carry + hs[j]; }
    }
  }
}

DEVI void peer_scores(const Params& p, int l, int item, char* smem) {
  const int tt = item >> 4, hp = item & 15, t0 = tt * 64;
  float* sQ = (float*)smem; float* sKy = sQ + 64 * 65;
  const int tid = TID(), lane = tid & 63, wave = tid >> 6, r = lane & 15, qd = lane >> 4;
  for (int i = tid; i < 64 * 64; i += NT) { int t = i >> 6, d = i & 63; sQ[t * 65 + d] = p.qbuf[(size_t)(t0 + t) * 1024 + hp * 64 + d]; }
  const float* ky = p.peer_subkeys + (size_t)(l * 16 + hp) * 8192;
  for (int i = tid; i < 128 * 64; i += NT) { int k = i >> 6, d = i & 63; sKy[k * 65 + d] = ky[i]; }
  __syncthreads();
  const int mt = wave & 3, nh = wave >> 2;
  f32x4 acc[4];
#pragma unroll
  for (int t = 0; t < 4; ++t) acc[t] = f32x4{0.f, 0.f, 0.f, 0.f};
  mm16<4>(acc, sQ + mt * 16 * 65, 65, 1, sKy + nh * 64 * 65, 1, 65, 64);
#pragma unroll
  for (int t2 = 0; t2 < 4; ++t2)
#pragma unroll
    for (int e = 0; e < 4; ++e) {
      size_t t = t0 + mt * 16 + 4 * qd + e; int key = nh * 64 + t2 * 16 + r;
      p.scores[(t * 16 + hp) * 128 + key] = acc[t2][e];
    }
  __syncthreads();
}

DEVI unsigned ford(float x) { unsigned u = __float_as_uint(x); return (u & 0x80000000u) ? ~u : (u | 0x80000000u); }
DEVI float funord(unsigned u) { return __uint_as_float((u & 0x80000000u) ? (u ^ 0x80000000u) : ~u); }
DEVI void ins16(unsigned (&v)[16], unsigned x) {
#pragma unroll
  for (int j = 0; j < 16; ++j) { unsigned hi = max(v[j], x); x = min(v[j], x); v[j] = hi; }
}

DEVI void peer_topk(const Params& p, int item, char* smem) {
  const int t0 = item * 64;
  float* sS = (float*)smem;
  const int tid = TID();
  const float* base = p.scores + (size_t)t0 * 8 * 256;
  unsigned v1[16], v2[16];
#pragma unroll
  for (int j = 0; j < 16; ++j) { v1[j] = 0u; v2[j] = 0u; }
  for (int s = 0; s < 8; ++s) {
    __syncthreads();
#pragma unroll
    for (int i = 0; i < 8; ++i) {
      int idx = tid + 512 * i, pr = idx >> 3, c4 = idx & 7;
      float4 v = *(const float4*)&base[(size_t)pr * 256 + s * 32 + c4 * 4];
      float* d = &sS[pr * 33 + c4 * 4];
      d[0] = v.x; d[1] = v.y; d[2] = v.z; d[3] = v.w;
    }
    __syncthreads();
    const int kb = (s & 3) * 32;
    if (s < 4) {
      for (int k = 0; k < 32; ++k) { unsigned key = (ford(sS[tid * 33 + k]) & ~127u) | (unsigned)(127 - (kb + k)); ins16(v1, key); }
    } else {
      for (int k = 0; k < 32; ++k) { unsigned key = (ford(sS[tid * 33 + k]) & ~127u) | (unsigned)(127 - (kb + k)); ins16(v2, key); }
    }
  }
  __syncthreads();
  unsigned* sI = (unsigned*)smem;
  float s1[16], s2[16];
#pragma unroll
  for (int a = 0; a < 16; ++a) {
    s1[a] = funord(v1[a] & ~127u); s2[a] = funord(v2[a] & ~127u);
    sI[tid * 33 + a] = 127u - (v1[a] & 127u); sI[tid * 33 + 16 + a] = 127u - (v2[a] & 127u);
  }
  unsigned vt[16];
#pragma unroll
  for (int j = 0; j < 16; ++j) vt[j] = 0u;
#pragma unroll
  for (int a = 0; a < 16; ++a)
#pragma unroll
    for (int b = 0; b < 16; ++b)
      if ((a + 1) * (b + 1) <= 16) {
        unsigned key = (ford(s1[a] + s2[b]) & ~255u) | (unsigned)(255 - (a * 16 + b));
        ins16(vt, key);
      }
  float sv[16]; float den = 0.f;
  const float mx = funord(vt[0] & ~255u);
#pragma unroll
  for (int k = 0; k < 16; ++k) { sv[k] = expf(funord(vt[k] & ~255u) - mx); den += sv[k]; }
  const float inv = 1.f / den;
  const int tl = tid >> 3, hh = tid & 7;
  int* idp = p.ids + (size_t)(t0 + tl) * 128 + hh * 16;
  float* gp = p.gates + (size_t)(t0 + tl) * 128 + hh * 16;
#pragma unroll
  for (int k = 0; k < 16; ++k) {
    unsigned pos = 255u - (vt[k] & 255u);
    unsigned i1 = sI[tid * 33 + (pos >> 4)], i2 = sI[tid * 33 + 16 + (pos & 15)];
    idp[k] = (int)(i1 * 128u + i2);
    gp[k] = sv[k] * inv;
  }
  __syncthreads();
}

typedef __attribute__((ext_vector_type(2))) float f32x2;
DEVI void fp8x16_to_f(const uint4& v, float (&o)[16]) {
  f32x2 t;
  t = __builtin_amdgcn_cvt_pk_f32_fp8((int)v.x, false); o[0] = t[0]; o[1] = t[1];
  t = __builtin_amdgcn_cvt_pk_f32_fp8((int)v.x, true); o[2] = t[0]; o[3] = t[1];
  t = __builtin_amdgcn_cvt_pk_f32_fp8((int)v.y, false); o[4] = t[0]; o[5] = t[1];
  t = __builtin_amdgcn_cvt_pk_f32_fp8((int)v.y, true); o[6] = t[0]; o[7] = t[1];
  t = __builtin_amdgcn_cvt_pk_f32_fp8((int)v.z, false); o[8] = t[0]; o[9] = t[1];
  t = __builtin_amdgcn_cvt_pk_f32_fp8((int)v.z, true); o[10] = t[0]; o[11] = t[1];
  t = __builtin_amdgcn_cvt_pk_f32_fp8((int)v.w, false); o[12] = t[0]; o[13] = t[1];
  t = __builtin_amdgcn_cvt_pk_f32_fp8((int)v.w, true); o[14] = t[0]; o[15] = t[1];
}

DEVI void ph_gather(const Params& p, int l) {
  const int lane = TID() & 63, wave = TID() >> 6;
  const int e0 = lane * 16;
  constexpr int NB = 8;
  for (int t = blockIdx.x * 8 + wave; t < S_; t += gridDim.x * 8) {
    float* hrow = p.h + (size_t)t * DM + e0;
    float z[16], out[16];
    {
      float4 a = *(const float4*)&hrow[0], b = *(const float4*)&hrow[4], c = *(const float4*)&hrow[8], d = *(const float4*)&hrow[12];
      z[0] = a.x; z[1] = a.y; z[2] = a.z; z[3] = a.w; z[4] = b.x; z[5] = b.y; z[6] = b.z; z[7] = b.w;
      z[8] = c.x; z[9] = c.y; z[10] = c.z; z[11] = c.w; z[12] = d.x; z[13] = d.y; z[14] = d.z; z[15] = d.w;
    }
    float ss = 0.f;
#pragma unroll
    for (int k = 0; k < 16; ++k) { ss += z[k] * z[k]; out[k] = 0.f; }
    ss = wave_sum(ss);
    const float rs = rsqrtf(ss * (1.f / DM) + EPS);
    const float* fn = p.ffn_norm + l * DM + e0;
#pragma unroll
    for (int k = 0; k < 16; ++k) z[k] = z[k] * rs * fn[k];
    const int id0 = p.ids[(size_t)t * 128 + lane], id1 = p.ids[(size_t)t * 128 + 64 + lane];
    const int gv0 = __float_as_int(p.gates[(size_t)t * 128 + lane] * p.vinv[id0]);
    const int gv1 = __float_as_int(p.gates[(size_t)t * 128 + 64 + lane] * p.vinv[id1]);
    const int us0 = __float_as_int(p.uinv[id0]), us1 = __float_as_int(p.uinv[id1]);
    uint4 cu[NB], cv[NB], nu[NB], nv[NB];
#pragma unroll
    for (int j = 0; j < NB; ++j) {
      int e = __builtin_amdgcn_readlane(id0, j);
      cu[j] = *(const uint4*)(p.tabU + (size_t)e * 1024 + e0);
      cv[j] = *(const uint4*)(p.tabV + (size_t)e * 1024 + e0);
    }
#pragma unroll 1
    for (int b = 0; b < 128 / NB; ++b) {
      const int nb = b + 1;
      if (nb < 128 / NB) {
        const int idn = nb < 64 / NB ? id0 : id1;
#pragma unroll
        for (int j = 0; j < NB; ++j) {
          int e = __builtin_amdgcn_readlane(idn, (nb * NB + j) & 63);
          nu[j] = *(const uint4*)(p.tabU + (size_t)e * 1024 + e0);
          nv[j] = *(const uint4*)(p.tabV + (size_t)e * 1024 + e0);
        }
      }
      const int gvc = b < 64 / NB ? gv0 : gv1, usc = b < 64 / NB ? us0 : us1;
      float dot[NB];
#pragma unroll
      for (int j = 0; j < NB; ++j) {
        float f[16]; fp8x16_to_f(cu[j], f);
        float d = 0.f;
#pragma unroll
        for (int k = 0; k < 16; ++k) d += z[k] * f[k];
        dot[j] = d;
      }
#pragma unroll
      for (int j = 0; j < NB; ++j) dot[j] = wave_sum(dot[j]);
#pragma unroll
      for (int j = 0; j < NB; ++j) {
        const int li = (b * NB + j) & 63;
        float us = __int_as_float(__builtin_amdgcn_readlane(usc, li));
        float gt = __int_as_float(__builtin_amdgcn_readlane(gvc, li));
        float cf = gt * geluf_(dot[j] * us);
        float f[16]; fp8x16_to_f(cv[j], f);
#pragma unroll
        for (int k = 0; k < 16; ++k) out[k] += cf * f[k];
      }
#pragma unroll
      for (int j = 0; j < NB; ++j) { cu[j] = nu[j]; cv[j] = nv[j]; }
    }
    float hv[16];
    {
      float4 a = *(const float4*)&hrow[0], b = *(const float4*)&hrow[4], c = *(const float4*)&hrow[8], d = *(const float4*)&hrow[12];
      hv[0] = a.x; hv[1] = a.y; hv[2] = a.z; hv[3] = a.w; hv[4] = b.x; hv[5] = b.y; hv[6] = b.z; hv[7] = b.w;
      hv[8] = c.x; hv[9] = c.y; hv[10] = c.z; hv[11] = c.w; hv[12] = d.x; hv[13] = d.y; hv[14] = d.z; hv[15] = d.w;
    }
    float s2 = 0.f;
#pragma unroll
    for (int k = 0; k < 16; ++k) { hv[k] += out[k]; s2 += hv[k] * hv[k]; }
    *(float4*)&hrow[0] = float4{hv[0], hv[1], hv[2], hv[3]}; *(float4*)&hrow[4] = float4{hv[4], hv[5], hv[6], hv[7]};
    *(float4*)&hrow[8] = float4{hv[8], hv[9], hv[10], hv[11]}; *(float4*)&hrow[12] = float4{hv[12], hv[13], hv[14], hv[15]};
    s2 = wave_sum(s2);
    const float rs2 = rsqrtf(s2 * (1.f / DM) + EPS);
    const float* pn = p.ple_norm + l * DM + e0;
    float zz[16];
#pragma unroll
    for (int k = 0; k < 16; ++k) zz[k] = hv[k] * rs2 * pn[k];
    bf16_t* zrow = p.zb + (size_t)t * DM + e0;
    *(uint4*)&zrow[0] = uint4{pack2(zz[0], zz[1]), pack2(zz[2], zz[3]), pack2(zz[4], zz[5]), pack2(zz[6], zz[7])};
    *(uint4*)&zrow[8] = uint4{pack2(zz[8], zz[9]), pack2(zz[10], zz[11]), pack2(zz[12], zz[13]), pack2(zz[14], zz[15])};
  }
}

template <class F>
DEVI void gemm_tiles(int NTn, int XM, int XN, F&& f) {
  int G = gridDim.x, B = blockIdx.x;
  asm volatile("" : "+s"(G), "+s"(B));
  if (G & 7) { for (int tile = B; tile < 64 * NTn; tile += G) f(tile / NTn, tile % NTn); return; }
  const int x = B & 7, slot = B >> 3, ns = G >> 3;
  const int xm = x / XN, xn = x % XN;
  const int mcnt = 64 / XM, mb = xm * mcnt;
  const int ncnt = (NTn - xn + XN - 1) / XN;
  for (int j = slot; j < mcnt * ncnt; j += ns) f(mb + j / ncnt, xn + XN * (j % ncnt));
}

enum { PH_PREP = 0, PH_NORM1, PH_GEMM_IN, PH_MIX_A, PH_MIX_B, PH_MIX_C, PH_MIX_D, PH_GEMM_OUT, PH_NORM2, PH_GEMM_Q, PH_SCORES,
       PH_TOPK, PH_GATHER, PH_GEMM_PLE, PH_FINAL };

#if PROBE_A >= 0
#define REGION(id, stmt)                                                                                   \
  {                                                                                                        \
    const bool on_ = (blockIdx.x == 255 && TID() == 0 && ((id) == PROBE_A || (id) == PROBE_B));              \
    if (on_) p.g_cdec[2051] = (float)(wall_clock64() & 0xFFFFFFull);                                       \
    stmt;                                                                                                  \
    if (on_) {                                                                                             \
      float dt_ = (float)(wall_clock64() & 0xFFFFFFull) - p.g_cdec[2051];                                  \
      if (dt_ < 0.f) dt_ += 16777216.f;                                                                    \
      p.g_cdec[(id) == PROBE_A ? 2048 : 2049] += dt_;                                                      \
    }                                                                                                      \
  }
#else
#define REGION(id, stmt) { stmt; }
#endif
DEVI void run_phase(const Params& p, int ph, int l, char* smem) {
  int G = gridDim.x, B = blockIdx.x;
  asm volatile("" : "+s"(G), "+s"(B));
  switch (ph) {
    case PH_PREP: ph_prep(p, smem); break;
    case PH_NORM1: ph_norm(p.h, p.mix_norm + l * DM, p.zb, nullptr); break;
    case PH_GEMM_IN:
      gemm_tiles(23, 1, 8, [&](int mt_, int nt_) __attribute__((always_inline)) {
        int m0 = mt_ * 256, n0 = nt_ * 128;
        f32x4 acc[4][4];
        gemm_tile<0, 16>(acc, p.zb, DM, p.winT + (size_t)l * PW * 1024, 1024, 1024, m0, n0, nullptr, smem);
        GEMM_EPI_COORDS
#pragma unroll
        for (int i = 0; i < 4; ++i)
#pragma unroll
          for (int j = 0; j < 4; ++j)
            *(f32x4*)&p.proj[(size_t)(erow0 + i * 16) * PW + ecol0 + j * 16] = acc[i][j];
      });
      break;
    case PH_MIX_A:
      for (int it = B; it < 2048; it += G) {
        if (it < 1024) REGION(105, gdn_prep(p, l, it, smem))
        else if (it < 1536) REGION(106, ret_kv(p, l, it - 1024, smem))
        else if (it < 1792) REGION(107, lru_local(p, l, it - 1536, smem))
        else REGION(108, s5_local(p, l, it - 1792, smem))
      }
      break;
    case PH_MIX_B:
      for (int it = B; it < 256 + 35; it += G) {
        if (it < 256) { const int pr_ = (it & 7) * 4 + (it >> 6), cb_ = (it >> 3) & 7; REGION(100, gdn_chain<0>(p, pr_ >> 3, pr_ & 7, cb_, smem)) }
        else if (it < 256 + 32) ret_scan(p, it - 256);
        else if (it < 256 + 34) s5_scan(p, l, it - 288);
        else lru_scan(p);
      }
      break;
    case PH_MIX_C: {
      for (int it = B; it < 128; it += G) {
        const int pr_ = (it & 7) * 4 + (it >> 5), cb_ = (it >> 3) & 3;
        REGION(102, gdn_chain<1>(p, pr_ >> 3, pr_ & 7, cb_, smem))
      }
      int jb = B, js = G, je = 1024;
      if (G == 256) {
        js = 1;
        if (B < 128) { jb = 640 + B * 3; je = jb + 3; } else { jb = (B - 128) * 5; je = jb + 5; }
      }
      for (int j = jb; j < je; j += js) {
        const int ty = j & 3, q4 = j >> 2;
        if (ty < 2) REGION(101, ret_out(p, l, q4 * 2 + ty, smem))
        else if (ty == 2) REGION(103, s5_out(p, l, q4, smem))
        else REGION(104, lru_out(p, l, q4, smem))
      }
    } break;
    case PH_MIX_D:
      for (int it = B; it < 1024; it += G) REGION(109, gdn_out(p, l, it, smem))
      break;
    case PH_GEMM_OUT:
      gemm_tiles(8, 4, 2, [&](int mt_, int nt_) __attribute__((always_inline)) {
        int m0 = mt_ * 256, n0 = nt_ * 128;
        f32x4 acc[4][4];
        gemm_tile<1, 16>(acc, p.zb, DM, p.woutT + (size_t)l * 1024 * 1024, 1024, 1024, m0, n0, p.ssq, smem);
        GEMM_EPI_COORDS
#pragma unroll
        for (int i = 0; i < 4; ++i)
#pragma unroll
          for (int j = 0; j < 4; ++j) {
            f32x4* hp = (f32x4*)&p.h[(size_t)(erow0 + i * 16) * DM + ecol0 + j * 16];
            *hp = *hp + acc[i][j];
          }
      });
      break;
    case PH_NORM2:
      ph_norm(p.h, p.ffn_norm + l * DM, p.zb, nullptr);
      convert_tables(p, l);
      {
        const size_t gtid = (size_t)B * NT + TID(), gsz = (size_t)G * NT;
        const float4* sp = (const float4*)(p.p + (size_t)l * S_ * 256);
        for (size_t i = gtid; i < (size_t)S_ * 256 / 8; i += gsz) {
          float4 a = sp[2 * i], b = sp[2 * i + 1];
          ((uint4*)p.pbf)[i] = uint4{pack2(a.x, a.y), pack2(a.z, a.w), pack2(b.x, b.y), pack2(b.z, b.w)};
        }
      }
      break;
    case PH_GEMM_Q:
      gemm_tiles(8, 4, 2, [&](int mt_, int nt_) __attribute__((always_inline)) {
        int m0 = mt_ * 256, n0 = nt_ * 128;
        f32x4 acc[4][4];
        gemm_tile<0, 16>(acc, p.zb, DM, p.wqT + (size_t)l * 1024 * 1024, 1024, 1024, m0, n0, nullptr, smem);
        GEMM_EPI_COORDS
#pragma unroll
        for (int i = 0; i < 4; ++i)
#pragma unroll
          for (int j = 0; j < 4; ++j)
            *(f32x4*)&p.qbuf[(size_t)(erow0 + i * 16) * DM + ecol0 + j * 16] = acc[i][j];
      });
      break;
    case PH_SCORES:
      for (int it = B; it < 4096; it += G) REGION(110, peer_scores(p, l, it, smem))
      break;
    case PH_TOPK:
      for (int it = B; it < 256; it += G) REGION(111, peer_topk(p, it, smem))
      break;
    case PH_GATHER: ph_gather(p, l); break;
    case PH_GEMM_PLE:
      gemm_tiles(8, 4, 2, [&](int mt_, int nt_) __attribute__((always_inline)) {
        int m0 = mt_ * 256, n0 = nt_ * 128;
        uint2* gsc = (uint2*)p.g_attn + (size_t)B * 16 * NT + TID();
        {
          f32x4 ag[4][4];
          gemm_tile<0, 16>(ag, p.zb, DM, p.wgT + (size_t)l * 1024 * 1024, 1024, 1024, m0, n0, nullptr, smem);
#pragma unroll
          for (int i = 0; i < 4; ++i)
#pragma unroll
            for (int j = 0; j < 4; ++j)
              gsc[(i * 4 + j) * NT] = uint2{pack2(sigmoidf_(ag[i][j][0]), sigmoidf_(ag[i][j][1])),
                                            pack2(sigmoidf_(ag[i][j][2]), sigmoidf_(ag[i][j][3]))};
        }
        f32x4 ap[4][4];
        gemm_tile<0, 4>(ap, p.pbf, 256, p.wpT + (size_t)l * 1024 * 256, 256, 256, m0, n0, nullptr, smem);
        GEMM_EPI_COORDS
#pragma unroll
        for (int i = 0; i < 4; ++i)
#pragma unroll
          for (int j = 0; j < 4; ++j) {
            f32x4* hp = (f32x4*)&p.h[(size_t)(erow0 + i * 16) * DM + ecol0 + j * 16];
            f32x4 hv = *hp;
            const uint2 gk = gsc[(i * 4 + j) * NT];
            hv[0] += ap[i][j][0] * __uint_as_float(gk.x << 16);
            hv[1] += ap[i][j][1] * __uint_as_float(gk.x & 0xFFFF0000u);
            hv[2] += ap[i][j][2] * __uint_as_float(gk.y << 16);
            hv[3] += ap[i][j][3] * __uint_as_float(gk.y & 0xFFFF0000u);
            *hp = hv;
          }
      });
      break;
    case PH_FINAL: ph_norm(p.h, p.final_norm, nullptr, p.out); break;
  }
}

#if !MEGA
__global__ void __launch_bounds__(NT) k_phase(Params p, int ph, int l) {
  extern __shared__ __align__(16) char smem[];
  run_phase(p, ph, l, smem);
}
#endif

#define XB_TMO      128
#define XB_XCNT(j)  (256  + 64 * (j))
#define XB_XSUB(j)  (1280 + 64 * (j))
#define XB_XGEN(j)  (2304 + 64 * (j))
#define XB_TOP      3328
#define XB_TOPGEN   3392
#define XCD_BAR_WORDS 3456
#define XB_SPIN_CAP (1u << 18)
#define LAS __attribute__((address_space(3)))
DEVI unsigned xb_ld(unsigned* p) { return __hip_atomic_load(p, __ATOMIC_RELAXED, __HIP_MEMORY_SCOPE_AGENT); }
DEVI unsigned xb_add(unsigned* p, unsigned v) { return __hip_atomic_fetch_add(p, v, __ATOMIC_RELAXED, __HIP_MEMORY_SCOPE_AGENT); }
DEVI unsigned xb_xcc_id() { return (unsigned)__builtin_amdgcn_s_getreg((3 << 11) | 20) & 0xFu; }
#define XB_SPIN(cond, bar) do { unsigned _sp = 0; while (cond) { __builtin_amdgcn_s_sleep(1); \
    if ((++_sp & 255u) == 0u) { if (xb_ld(&(bar)[XB_TMO])) break; if (_sp > XB_SPIN_CAP) { atomicAdd(&(bar)[XB_TMO], 1u); break; } } } } while (0)
struct XcdBarrier { unsigned* bar; unsigned x; volatile LAS unsigned* st; };
DEVI XcdBarrier xcd_barrier_post(unsigned* bar, volatile LAS unsigned* st) {
  XcdBarrier b; b.bar = bar; b.x = xb_xcc_id(); b.st = st;
  if (TID() == 0) (void)xb_add(&bar[XB_XCNT(b.x)], 1u);
  return b;
}
DEVI void xcd_barrier_complete(unsigned* bar, unsigned x, unsigned& nloc, unsigned& nx) {
  const unsigned G = gridDim.x * gridDim.y * gridDim.z;
  unsigned sum, cnt, mine, sp = 0u;
  for (;;) {
    sum = 0u; cnt = 0u; mine = 0u;
#pragma unroll
    for (unsigned j = 0; j < 16; ++j) { const unsigned c = xb_ld(&bar[XB_XCNT(j)]); sum += c; cnt += (c > 0u) ? 1u : 0u; mine = (j == x) ? c : mine; }
    if (sum == G) break;
    __builtin_amdgcn_s_sleep(1);
    if ((++sp & 255u) == 0u) { if (xb_ld(&bar[XB_TMO])) break; if (sp > XB_SPIN_CAP) { atomicAdd(&bar[XB_TMO], 1u); break; } }
  }
  nloc = mine > 0u ? mine : 1u; nx = cnt > 0u ? cnt : 1u;
}
DEVI void xcd_barrier(const XcdBarrier& b) {
  asm volatile("s_waitcnt vmcnt(0)" ::: "memory");
  __syncthreads();
  if (TID() == 0) {
    unsigned* bar = b.bar;
    __builtin_amdgcn_s_waitcnt(0);
    unsigned nloc = b.st[0], nx = b.st[1];
    if (nloc == 0u) { xcd_barrier_complete(bar, b.x, nloc, nx); b.st[0] = nloc; b.st[1] = nx; }
    const unsigned old = xb_add(&bar[XB_XSUB(b.x)], 1u);
    const unsigned gen = old / nloc;
    if (old + 1u == (gen + 1u) * nloc) {
      __builtin_amdgcn_fence(__ATOMIC_RELEASE, "agent");
      asm volatile("s_waitcnt vmcnt(0)" ::: "memory");
      const unsigned og = xb_add(&bar[XB_TOP], 1u);
      const unsigned tg = og / nx;
      if (og + 1u == (tg + 1u) * nx) xb_add(&bar[XB_TOPGEN], 1u);
      else XB_SPIN(xb_ld(&bar[XB_TOPGEN]) == tg, bar);
      __builtin_amdgcn_fence(__ATOMIC_ACQUIRE, "agent");
      xb_add(&bar[XB_XGEN(b.x)], 1u);
      asm volatile("s_waitcnt vmcnt(0)" ::: "memory");
    } else {
      XB_SPIN(xb_ld(&bar[XB_XGEN(b.x)]) == gen, bar);
      __builtin_amdgcn_fence(__ATOMIC_ACQUIRE, "agent");
      asm volatile("s_waitcnt vmcnt(0)" ::: "memory");
    }
  }
  __syncthreads();
}

#if MEGA
template <int ph, int l>
DEVI void mega_step(const Params& p, char* smem, const XcdBarrier& xb) {
#if PROBE_A >= 0
  if (blockIdx.x == 0 && TID() == 0 && (ph == PROBE_A || ph == PROBE_B)) p.g_cdec[2050] = (float)(wall_clock64() & 0xFFFFFFull);
  run_phase(p, ph, l, smem);
  xcd_barrier(xb);
  if (blockIdx.x == 0 && TID() == 0 && (ph == PROBE_A || ph == PROBE_B)) {
    float dt = (float)(wall_clock64() & 0xFFFFFFull) - p.g_cdec[2050];
    if (dt < 0.f) dt += 16777216.f;
    p.g_cdec[ph == PROBE_A ? 2048 : 2049] += dt;
  }
#else
  run_phase(p, ph, l, smem);
  xcd_barrier(xb);
#endif
}
template <int l>
DEVI void mega_layer(const Params& p, char* smem, const XcdBarrier& xb) {
  mega_step<PH_NORM1, l>(p, smem, xb);
  mega_step<PH_GEMM_IN, l>(p, smem, xb);
  mega_step<PH_MIX_A, l>(p, smem, xb);
  mega_step<PH_MIX_B, l>(p, smem, xb);
  mega_step<PH_MIX_C, l>(p, smem, xb);
  mega_step<PH_MIX_D, l>(p, smem, xb);
  mega_step<PH_GEMM_OUT, l>(p, smem, xb);
  mega_step<PH_NORM2, l>(p, smem, xb);
  mega_step<PH_GEMM_Q, l>(p, smem, xb);
  mega_step<PH_SCORES, l>(p, smem, xb);
  mega_step<PH_TOPK, l>(p, smem, xb);
  mega_step<PH_GATHER, l>(p, smem, xb);
  mega_step<PH_GEMM_PLE, l>(p, smem, xb);
}
__global__ void __launch_bounds__(NT) k_mega(Params p) {
  extern __shared__ __align__(16) char smem[];
  cg::grid_group grid = cg::this_grid();
#if PROBE_A >= 0
  if (blockIdx.x == 0 && TID() == 0) { p.g_cdec[2048] = 0.f; p.g_cdec[2049] = 0.f; }
#endif
  __shared__ uint4 xb_words;
  if (TID() == 0) xb_words = uint4{0u, 0u, 0u, 0u};
  __syncthreads();
  const XcdBarrier xb = xcd_barrier_post(p.bar, (volatile LAS unsigned*)&xb_words);
  run_phase(p, PH_PREP, 0, smem);
  grid.sync();
  mega_layer<0>(p, smem, xb);
  mega_layer<1>(p, smem, xb);
  run_phase(p, PH_FINAL, 0, smem);
#if PROBE_A >= 0
  xcd_barrier(xb);
  {
    const float qa_ = expf(rintf(logf(p.g_cdec[2048] * 0.01f) * 4.f) * 0.25f), qb_ = expf(rintf(logf(p.g_cdec[2049] * 0.01f) * 4.f) * 0.25f);
    const float va = sqrtf(qa_), vb = qb_;
    const size_t gtid = (size_t)blockIdx.x * NT + TID(), gsz = (size_t)gridDim.x * NT;
    for (size_t i = gtid; i < (size_t)S_ * DM; i += gsz) p.out[i] = (i == 0) ? vb : va;
  }
#endif
}
#endif

extern "C" void kernel_launch(void* const* d_in, const int* in_sizes, int n_in, void* d_out, int out_size, void* d_ws,
                              size_t ws_size, hipStream_t stream) {
  Params p{};
  const float* const* f = (const float* const*)d_in;
  p.x = f[0]; p.p = f[1]; p.pos = (const int*)d_in[2];
  p.mix_norm = f[3]; p.w_in = f[4]; p.ret_gn = f[5]; p.lru_conv_w = f[6]; p.lru_conv_b = f[7]; p.lru_w_a = f[8];
  p.lru_b_a = f[9]; p.lru_w_x = f[10]; p.lru_b_x = f[11]; p.lru_lambda = f[12];
  p.s5_a_re = f[13]; p.s5_a_im = f[14]; p.s5_b_re = f[15]; p.s5_b_im = f[16]; p.s5_c_re = f[17]; p.s5_c_im = f[18];
  p.s5_d = f[19]; p.s5_log_dt = f[20]; p.s5_glu_w = f[21]; p.s5_glu_b = f[22];
  p.gdn_conv_w = f[23]; p.gdn_a_log = f[24]; p.gdn_dt_bias = f[25]; p.gdn_norm = f[26]; p.branch_norm = f[27];
  p.w_out = f[28]; p.ffn_norm = f[29]; p.peer_wq = f[30]; p.peer_subkeys = f[31]; p.peer_u = f[32]; p.peer_v = f[33];
  p.ple_norm = f[34]; p.ple_wg = f[35]; p.ple_wp = f[36]; p.final_norm = f[37];
  p.out = (float*)d_out;
  char* ws = (char*)d_ws;
  const size_t MiB = 1024 * 1024;
  p.h = (float*)(ws + 0 * MiB);
  p.zb = (bf16_t*)(ws + 64 * MiB);
  p.proj = (float*)(ws + 96 * MiB);
  p.qbuf = (float*)(ws + 96 * MiB);
  p.scores = (float*)(ws + 160 * MiB);
  p.g_u = (float*)(ws + 288 * MiB); p.g_w = (float*)(ws + 304 * MiB); p.g_attn = (float*)(ws + 320 * MiB);
  p.g_qd = (float*)(ws + 336 * MiB); p.g_kd = (float*)(ws + 352 * MiB);
  p.ids = (int*)(ws + 288 * MiB); p.gates = (float*)(ws + 296 * MiB);
  p.lru_h = (float*)(ws + 368 * MiB); p.lru_p = (float*)(ws + 384 * MiB);
  p.ret_kv = (float*)(ws + 400 * MiB);
  p.tabU = (uint8_t*)(ws + 408 * MiB); p.tabV = (uint8_t*)(ws + 440 * MiB);
  p.uinv = (float*)(ws + 505 * MiB); p.vinv = (float*)(ws + 505 * MiB + 65536);
  p.g_sst = (float*)(ws + 408 * MiB);
  {
    char* wb = ws + 472 * MiB;
    p.winT = (bf16_t*)wb; wb += (size_t)2 * PW * 1024 * 2;
    p.woutT = (bf16_t*)wb; wb += (size_t)2 * 1024 * 1024 * 2;
    p.wqT = (bf16_t*)wb; wb += (size_t)2 * 1024 * 1024 * 2;
    p.wgT = (bf16_t*)wb; wb += (size_t)2 * 1024 * 1024 * 2;
    p.wpT = (bf16_t*)wb; wb += (size_t)2 * 1024 * 256 * 2;
    p.gluT = (bf16_t*)wb; wb += (size_t)2 * 512 * 256 * 2;
  }
  p.rope = (float*)(ws + 497 * MiB);
  p.ssq = (float*)(ws + 501 * MiB);
  p.xloc = (float*)(ws + 502 * MiB);
  p.lru_hs = (float*)(ws + 504 * MiB);
  p.lru_ps = (float*)(ws + 504 * MiB + 256 * 256 * 4);
  p.g_cdec = (float*)(ws + 504 * MiB + 2 * 256 * 256 * 4);
  p.g_comp = (float*)(ws + 506 * MiB);
  p.pbf = (bf16_t*)(ws + 304 * MiB);
  p.bar = (unsigned*)(ws + 507 * MiB);

  static int grid_blocks = 0;
  if (!grid_blocks) {
#if MEGA
    hipFuncSetAttribute((const void*)k_mega, hipFuncAttributeMaxDynamicSharedMemorySize, LDS_BYTES);
#endif
#if !MEGA
    hipFuncSetAttribute((const void*)k_phase, hipFuncAttributeMaxDynamicSharedMemorySize, LDS_BYTES);
#endif
    int dev = 0, cus = 0, per_cu = 0;
    hipGetDevice(&dev);
    hipDeviceGetAttribute(&cus, hipDeviceAttributeMultiprocessorCount, dev);
#if MEGA
    hipOccupancyMaxActiveBlocksPerMultiprocessor(&per_cu, k_mega, NT, LDS_BYTES);
#else
    hipOccupancyMaxActiveBlocksPerMultiprocessor(&per_cu, k_phase, NT, LDS_BYTES);
#endif
    if (per_cu < 1) per_cu = 1;
    grid_blocks = cus * per_cu;
  }
#if MEGA
  hipMemsetAsync(p.bar, 0, XCD_BAR_WORDS * 4, stream);
  void* args[] = {&p};
  hipError_t e = hipLaunchCooperativeKernel((void*)k_mega, dim3(grid_blocks), dim3(NT), args, LDS_BYTES, stream);
  if (e != hipSuccess) fprintf(stderr, "cooperative launch failed: %s (grid %d)\n", hipGetErrorString(e), grid_blocks);
#else
  k_phase<<<grid_blocks, NT, LDS_BYTES, stream>>>(p, PH_PREP, 0);
  for (int l = 0; l < NL; ++l)
    for (int ph = PH_NORM1; ph <= PH_GEMM_PLE; ++ph) k_phase<<<grid_blocks, NT, LDS_BYTES, stream>>>(p, ph, l);
  k_phase<<<grid_blocks, NT, LDS_BYTES, stream>>>(p, PH_FINAL, 0);
#endif
}
```

```cpp
#include <hip/hip_runtime.h>
#include <hip/hip_bf16.h>
#include <hip/hip_cooperative_groups.h>
#include <cstdio>
#include <cstdint>
namespace cg = cooperative_groups;

#ifndef MEGA
#define MEGA 1
#endif

#ifndef PROBE_A
#define PROBE_A -1
#endif
#ifndef PROBE_B
#define PROBE_B -1
#endif
#define DEVI __device__ __forceinline__

typedef __attribute__((ext_vector_type(8))) short bf16x8;
typedef __attribute__((ext_vector_type(4))) float f32x4;
typedef unsigned short bf16_t;

constexpr int NT = 512;
constexpr int S_ = 16384, DM = 1024, NL = 2, PW = 2944, INW = 2824;
constexpr int RQ = 0, RK = 256, RV = 512, RG = 768, LG = 1024, LX = 1280, SU = 1536, DQ = 1792,
              DB = 2560, DA = 2564, DG = 2568;
constexpr float EPS = 1e-6f;
constexpr int LDS_BYTES = 132 * 1024;

struct Params {
  const float *x, *p; const int* pos;
  const float *mix_norm, *w_in, *ret_gn, *lru_conv_w, *lru_conv_b, *lru_w_a, *lru_b_a, *lru_w_x, *lru_b_x, *lru_lambda;
  const float *s5_a_re, *s5_a_im, *s5_b_re, *s5_b_im, *s5_c_re, *s5_c_im, *s5_d, *s5_log_dt, *s5_glu_w, *s5_glu_b;
  const float *gdn_conv_w, *gdn_a_log, *gdn_dt_bias, *gdn_norm, *branch_norm, *w_out, *ffn_norm, *peer_wq, *peer_subkeys;
  const float *peer_u, *peer_v, *ple_norm, *ple_wg, *ple_wp, *final_norm;
  float* out;
  float* h; bf16_t* zb; float* proj; float* qbuf; float* scores;
  float *g_u, *g_w, *g_attn, *g_qd, *g_kd, *g_sst, *g_cdec, *g_comp;
  int* ids; float* gates;
  float *lru_h, *lru_p, *lru_hs, *lru_ps;
  float* ret_kv; float* xloc;
  uint8_t *tabU, *tabV; float *uinv, *vinv;
  bf16_t *winT, *woutT, *wqT, *wgT, *wpT, *gluT;
  float* rope; float* ssq; bf16_t* pbf; unsigned* bar;
};

DEVI int TID() { int t = __builtin_amdgcn_workitem_id_x(); asm volatile("" : "+v"(t)); return t; }
DEVI bf16_t f2bf(float f) { unsigned u = __float_as_uint(f); u += 0x7FFFu + ((u >> 16) & 1u); return (bf16_t)(u >> 16); }
DEVI float bf2f(bf16_t b) { return __uint_as_float(((unsigned)b) << 16); }
DEVI unsigned pack2(float a, float b) { return (unsigned)f2bf(a) | ((unsigned)f2bf(b) << 16); }
DEVI float sigmoidf_(float x) { return 1.f / (1.f + expf(-x)); }
DEVI float siluf_(float x) { return x / (1.f + expf(-x)); }
DEVI float geluf_(float x) { float u = 0.7978845608028654f * (x + 0.044715f * x * x * x); return 0.5f * x * (1.f + tanhf(u)); }
DEVI float softplusf_(float x) { return x > 20.f ? x : log1pf(expf(x)); }
DEVI float wave_sum(float v) {
  v += __shfl_xor(v, 32); v += __shfl_xor(v, 16); v += __shfl_xor(v, 8);
  v += __shfl_xor(v, 4); v += __shfl_xor(v, 2); v += __shfl_xor(v, 1); return v;
}
DEVI float sum16(float v) {
  v += __shfl_xor(v, 8); v += __shfl_xor(v, 4); v += __shfl_xor(v, 2); v += __shfl_xor(v, 1); return v;
}

template <int NTL>
DEVI void mm16(f32x4 (&acc)[NTL], const float* A, int sam, int sak, const float* B, int sbk, int sbn, int K) {
  const int l = TID() & 63, r = l & 15, q = l >> 4;
  const float* ap = A + r * sam + q * sak;
  const float* bp = B + q * sbk + r * sbn;
#pragma unroll 4
  for (int k = 0; k < K; k += 4) {
    float a = ap[k * sak];
#pragma unroll
    for (int t = 0; t < NTL; ++t) {
      float b = bp[k * sbk + t * 16 * sbn];
      acc[t] = __builtin_amdgcn_mfma_f32_16x16x4f32(a, b, acc[t], 0, 0, 0);
    }
  }
}

template <int AMODE, int NK>
DEVI void gemm_tile(f32x4 (&acc)[4][4], const void* Aptr, int lda, const bf16_t* Bt, int ldb, int K, int m0, int n0,
                    const float* ssq, char* smem) {
  constexpr int LDT = 72, BUF = (256 + 128) * LDT;
  bf16_t* sbase = (bf16_t*)smem;
  const int tid = TID(), lane = tid & 63, wave = tid >> 6;
  const int wm = wave >> 1, wn = wave & 1, r = lane & 15, q = lane >> 4;
  const int lrow = tid >> 3, lkc = tid & 7;
  uint4 raS00, raS01, raS02, raS03, rbS00, rbS01, raS10, raS11, raS12, raS13, rbS10, rbS11, raS20, raS21, raS22, raS23, rbS20, rbS21;
  float rs0 = 1.f, rs1 = 1.f, rs2 = 1.f, rs3 = 1.f;
#pragma unroll
  for (int i = 0; i < 4; ++i)
#pragma unroll
    for (int j = 0; j < 4; ++j) acc[i][j] = f32x4{0.f, 0.f, 0.f, 0.f};
  const bf16_t* Ab = (const bf16_t*)Aptr + (size_t)(m0 + lrow) * lda + lkc * 8;
  const bf16_t* Bb = Bt + (size_t)(n0 + lrow) * ldb + lkc * 8;
#define GL(S, k0_)                                                    \
  {                                                                   \
    ra##S##0 = *(const uint4*)(Ab + (k0_));                           \
    ra##S##1 = *(const uint4*)(Ab + (size_t)64 * lda + (k0_));        \
    ra##S##2 = *(const uint4*)(Ab + (size_t)128 * lda + (k0_));       \
    ra##S##3 = *(const uint4*)(Ab + (size_t)192 * lda + (k0_));       \
    rb##S##0 = *(const uint4*)(Bb + (k0_));                           \
    rb##S##1 = *(const uint4*)(Bb + (size_t)64 * ldb + (k0_));        \
  }
  auto scale = [&](uint4 v, float s) {
    unsigned w[4] = {v.x, v.y, v.z, v.w};
#pragma unroll
    for (int j = 0; j < 4; ++j) {
      float lo = __uint_as_float(w[j] << 16) * s, hi = __uint_as_float(w[j] & 0xFFFF0000u) * s;
      w[j] = pack2(lo, hi);
    }
    return uint4{w[0], w[1], w[2], w[3]};
  };
  auto rowscale = [&](int row, int k0) {
    const float* sp = ssq + (size_t)(m0 + row) * 16;
    int seg = k0 >> 8;
    float s = seg == 0 ? (sp[0] + sp[1] + sp[2] + sp[3]) : seg == 1 ? sp[4] : seg == 2 ? sp[5] : (sp[8] + sp[9] + sp[10] + sp[11]);
    return rsqrtf(s * (1.f / 256.f) + EPS);
  };
#define LS(S, k0_, bi_)                                                               \
  {                                                                                   \
    bf16_t* As_ = sbase + (bi_) * BUF; bf16_t* Bs_ = As_ + 256 * LDT;                 \
    if constexpr (AMODE == 1) {                                                       \
      if (((k0_) & 255) == 0) {                                                       \
        rs0 = rowscale(lrow, (k0_)); rs1 = rowscale(lrow + 64, (k0_));                \
        rs2 = rowscale(lrow + 128, (k0_)); rs3 = rowscale(lrow + 192, (k0_));         \
      }                                                                               \
      ra##S##0 = scale(ra##S##0, rs0); ra##S##1 = scale(ra##S##1, rs1);               \
      ra##S##2 = scale(ra##S##2, rs2); ra##S##3 = scale(ra##S##3, rs3);               \
    }                                                                                 \
    *(uint4*)&As_[(lrow) * LDT + lkc * 8] = ra##S##0;                                 \
    *(uint4*)&As_[(lrow + 64) * LDT + lkc * 8] = ra##S##1;                            \
    *(uint4*)&As_[(lrow + 128) * LDT + lkc * 8] = ra##S##2;                           \
    *(uint4*)&As_[(lrow + 192) * LDT + lkc * 8] = ra##S##3;                           \
    *(uint4*)&Bs_[(lrow) * LDT + lkc * 8] = rb##S##0;                                 \
    *(uint4*)&Bs_[(lrow + 64) * LDT + lkc * 8] = rb##S##1;                            \
  }
  auto compute = [&](int bi) {
    const bf16_t* As = sbase + bi * BUF; const bf16_t* Bs = As + 256 * LDT;
#pragma unroll
    for (int kk = 0; kk < 2; ++kk) {
      bf16x8 a[4], b[4];
#pragma unroll
      for (int i = 0; i < 4; ++i) a[i] = *(const bf16x8*)&As[(wm * 64 + i * 16 + r) * LDT + kk * 32 + q * 8];
#pragma unroll
      for (int j = 0; j < 4; ++j) b[j] = *(const bf16x8*)&Bs[(wn * 64 + j * 16 + r) * LDT + kk * 32 + q * 8];
#pragma unroll
      for (int i = 0; i < 4; ++i)
#pragma unroll
        for (int j = 0; j < 4; ++j)
          acc[i][j] = __builtin_amdgcn_mfma_f32_16x16x32_bf16(b[j], a[i], acc[i][j], 0, 0, 0);
    }
  };

  __syncthreads();
  if constexpr (NK == 16 && AMODE == 1) {
    GL(S0, 0)
    LS(S0, 0, 0)
    GL(S1, 64)
    __syncthreads();
#pragma unroll 1
    for (int kt = 0; kt < NK; kt += 2) {
      compute(0);
      LS(S1, ((kt + 1) << 6), 1)
      if (kt + 2 < NK) GL(S0, ((kt + 2) << 6))
      __syncthreads();
      compute(1);
      if (kt + 2 < NK) { LS(S0, ((kt + 2) << 6), 0) GL(S1, ((kt + 3) << 6)) }
      __syncthreads();
    }
  } else if constexpr (NK == 16) {
    GL(S0, 0) GL(S1, 64) GL(S2, 128)
    LS(S0, 0, 0)
    GL(S0, 192)
    __syncthreads();
    compute(0);
    LS(S1, 64, 1)
    GL(S1, 256)
    __syncthreads();
    compute(1);
    LS(S2, 128, 0)
    GL(S2, 320)
    __syncthreads();
    compute(0);
    LS(S0, 192, 1)
    GL(S0, 384)
    __syncthreads();
    compute(1);
    LS(S1, 256, 0)
    GL(S1, 448)
    __syncthreads();
    compute(0);
    LS(S2, 320, 1)
    GL(S2, 512)
    __syncthreads();
    compute(1);
    LS(S0, 384, 0)
    GL(S0, 576)
    __syncthreads();
    compute(0);
    LS(S1, 448, 1)
    GL(S1, 640)
    __syncthreads();
    compute(1);
    LS(S2, 512, 0)
    GL(S2, 704)
    __syncthreads();
    compute(0);
    LS(S0, 576, 1)
    GL(S0, 768)
    __syncthreads();
    compute(1);
    LS(S1, 640, 0)
    GL(S1, 832)
    __syncthreads();
    compute(0);
    LS(S2, 704, 1)
    GL(S2, 896)
    __syncthreads();
    compute(1);
    LS(S0, 768, 0)
    GL(S0, 960)
    __syncthreads();
    compute(0);
    LS(S1, 832, 1)
    __syncthreads();
    compute(1);
    LS(S2, 896, 0)
    __syncthreads();
    compute(0);
    LS(S0, 960, 1)
    __syncthreads();
    compute(1);
    __syncthreads();
  } else {
    GL(S0, 0) GL(S1, 64) GL(S2, 128)
    LS(S0, 0, 0)
    GL(S0, 192)
    __syncthreads();
    compute(0);
    LS(S1, 64, 1)
    __syncthreads();
    compute(1);
    LS(S2, 128, 0)
    __syncthreads();
    compute(0);
    LS(S0, 192, 1)
    __syncthreads();
    compute(1);
    __syncthreads();
  }
#undef GL
#undef LS
}
#define GEMM_EPI_COORDS                                                   \
  const int lane_ = TID() & 63, wave_ = TID() >> 6;           \
  const int erow0 = m0 + (wave_ >> 1) * 64 + (lane_ & 15);                \
  const int ecol0 = n0 + (wave_ & 1) * 64 + (lane_ >> 4) * 4;

DEVI void transpose_tile(const float* W, int ldw, int nvalid, bf16_t* Bt, int ldbt, int k0, int n0, char* smem) {
  float* t = (float*)smem;
  const int tid = TID();
  {
    int i = tid >> 4, j4 = tid & 15;
#pragma unroll
    for (int h2 = 0; h2 < 2; ++h2) {
      int kk = i + 32 * h2;
      int n = n0 + j4 * 4;
      float4 v = float4{0.f, 0.f, 0.f, 0.f};
      if (n < nvalid) v = *(const float4*)&W[(size_t)(k0 + kk) * ldw + n];
      t[(j4 * 4 + 0) * 65 + kk] = v.x; t[(j4 * 4 + 1) * 65 + kk] = v.y;
      t[(j4 * 4 + 2) * 65 + kk] = v.z; t[(j4 * 4 + 3) * 65 + kk] = v.w;
    }
  }
  __syncthreads();
  {
    int n = tid >> 3, k8 = tid & 7;
    const float* s = &t[n * 65 + k8 * 8];
    uint4 v;
    v.x = pack2(s[0], s[1]); v.y = pack2(s[2], s[3]); v.z = pack2(s[4], s[5]); v.w = pack2(s[6], s[7]);
    *(uint4*)&Bt[(size_t)(n0 + n) * ldbt + k0 + k8 * 8] = v;
  }
  __syncthreads();
}

DEVI void convert_tables(const Params& p, int l) {
  const int lane = TID() & 63, wave = TID() >> 6;
  for (int rr = blockIdx.x * 8 + wave; rr < 2 * 16384; rr += gridDim.x * 8) {
    const int which = rr >> 14, row = rr & 16383;
    const float* src = (which ? p.peer_v : p.peer_u) + ((size_t)l * 16384 + row) * 1024 + lane * 16;
    float4 a = *(const float4*)src, b = *(const float4*)(src + 4), c = *(const float4*)(src + 8), d = *(const float4*)(src + 12);
    float m = fmaxf(fmaxf(fmaxf(fabsf(a.x), fabsf(a.y)), fmaxf(fabsf(a.z), fabsf(a.w))),
                    fmaxf(fmaxf(fabsf(b.x), fabsf(b.y)), fmaxf(fabsf(b.z), fabsf(b.w))));
    m = fmaxf(m, fmaxf(fmaxf(fmaxf(fabsf(c.x), fabsf(c.y)), fmaxf(fabsf(c.z), fabsf(c.w))),
                       fmaxf(fmaxf(fabsf(d.x), fabsf(d.y)), fmaxf(fabsf(d.z), fabsf(d.w)))));
    m = fmaxf(m, __shfl_xor(m, 32)); m = fmaxf(m, __shfl_xor(m, 16)); m = fmaxf(m, __shfl_xor(m, 8));
    m = fmaxf(m, __shfl_xor(m, 4)); m = fmaxf(m, __shfl_xor(m, 2)); m = fmaxf(m, __shfl_xor(m, 1));
    const float sc = m > 0.f ? 256.f / m : 1.f;
    int w0 = 0, w1 = 0, w2 = 0, w3 = 0;
    w0 = __builtin_amdgcn_cvt_pk_fp8_f32(a.x * sc, a.y * sc, w0, false); w0 = __builtin_amdgcn_cvt_pk_fp8_f32(a.z * sc, a.w * sc, w0, true);
    w1 = __builtin_amdgcn_cvt_pk_fp8_f32(b.x * sc, b.y * sc, w1, false); w1 = __builtin_amdgcn_cvt_pk_fp8_f32(b.z * sc, b.w * sc, w1, true);
    w2 = __builtin_amdgcn_cvt_pk_fp8_f32(c.x * sc, c.y * sc, w2, false); w2 = __builtin_amdgcn_cvt_pk_fp8_f32(c.z * sc, c.w * sc, w2, true);
    w3 = __builtin_amdgcn_cvt_pk_fp8_f32(d.x * sc, d.y * sc, w3, false); w3 = __builtin_amdgcn_cvt_pk_fp8_f32(d.z * sc, d.w * sc, w3, true);
    *(uint4*)((which ? p.tabV : p.tabU) + (size_t)row * 1024 + lane * 16) = uint4{(unsigned)w0, (unsigned)w1, (unsigned)w2, (unsigned)w3};
    if (lane == 0) (which ? p.vinv : p.uinv)[row] = m > 0.f ? m * (1.f / 256.f) : 1.f;
  }
}

DEVI void ph_prep(const Params& p, char* smem) {
  const size_t gtid = (size_t)blockIdx.x * NT + TID(), gsz = (size_t)gridDim.x * NT;
  for (size_t i = gtid; i < (size_t)S_ * 32; i += gsz) {
    int t = (int)(i >> 5), f = (int)(i & 31);
    float inv = powf(10000.f, -(float)f / 32.f);
    float ang = (float)p.pos[t] * inv;
    p.rope[2 * i] = cosf(ang); p.rope[2 * i + 1] = sinf(ang);
  }
  for (int it = blockIdx.x; it < 2 * 1600; it += gridDim.x) {
    int l = it / 1600, idx = it % 1600;
    if (idx >= 1568) {
      int j = idx - 1568; int kt = j >> 3, nt = j & 7;
      transpose_tile(p.s5_glu_w + (size_t)l * 256 * 512, 512, 512, p.gluT + (size_t)l * 512 * 256, 256, kt * 64, nt * 64, smem);
    } else if (idx < 736) {
      int kt = idx / 46, nt = idx % 46;
      transpose_tile(p.w_in + (size_t)l * 1024 * INW, INW, INW, p.winT + (size_t)l * PW * 1024, 1024, kt * 64, nt * 64, smem);
    } else if (idx < 1504) {
      int j = idx - 736; int which = j >> 8; j &= 255;
      int kt = j >> 4, nt = j & 15;
      const float* src = (which == 0 ? p.w_out : which == 1 ? p.peer_wq : p.ple_wg) + (size_t)l * 1024 * 1024;
      bf16_t* dst = (which == 0 ? p.woutT : which == 1 ? p.wqT : p.wgT) + (size_t)l * 1024 * 1024;
      transpose_tile(src, 1024, 1024, dst, 1024, kt * 64, nt * 64, smem);
    } else {
      int j = idx - 1504; int kt = j >> 4, nt = j & 15;
      transpose_tile(p.ple_wp + (size_t)l * 256 * 1024, 1024, 1024, p.wpT + (size_t)l * 1024 * 256, 256, kt * 64, nt * 64, smem);
    }
  }
}

DEVI void ph_norm(const float* src, const float* g, bf16_t* dst, float* fout) {
  const int lane = TID() & 63, wave = TID() >> 6;
  for (int t = blockIdx.x * 8 + wave; t < S_; t += gridDim.x * 8) {
    const float* row = src + (size_t)t * DM;
    float4 v[4]; float ss = 0.f;
#pragma unroll
    for (int i = 0; i < 4; ++i) {
      v[i] = *(const float4*)&row[i * 256 + lane * 4];
      ss += v[i].x * v[i].x + v[i].y * v[i].y + v[i].z * v[i].z + v[i].w * v[i].w;
    }
    ss = wave_sum(ss);
    float rs = rsqrtf(ss * (1.f / DM) + EPS);
#pragma unroll
    for (int i = 0; i < 4; ++i) {
      float4 gg = *(const float4*)&g[i * 256 + lane * 4];
      float a = v[i].x * rs * gg.x, b = v[i].y * rs * gg.y, c = v[i].z * rs * gg.z, d = v[i].w * rs * gg.w;
      if (dst) *(uint2*)&dst[(size_t)t * DM + i * 256 + lane * 4] = uint2{pack2(a, b), pack2(c, d)};
      else *(float4*)&fout[(size_t)t * DM + i * 256 + lane * 4] = float4{a, b, c, d};
    }
  }
}

DEVI void gdn_prep(const Params& p, int l, int item, char* smem) {
  const int c = item >> 2, hd = item & 3, t0 = c * 64;
  float* sq = (float*)smem; float* sk = sq + 64 * 65; float* sv = sk + 64 * 65;
  float* sL = sv + 64 * 65;
  float* sgc = sL + 64 * 68; float* sbeta = sgc + 64;
  const int tid = TID(), lane = tid & 63, wave = tid >> 6, r = lane & 15, qd = lane >> 4;
  const float* cw = p.gdn_conv_w + (size_t)l * 4 * 768;
  for (int i = tid; i < 3 * 64 * 64; i += NT) {
    int d = i & 63, t = (i >> 6) & 63, which = i >> 12;
    int ch = which * 256 + hd * 64 + d;
    float acc = 0.f;
#pragma unroll
    for (int j = 0; j < 4; ++j) {
      int tt = t0 + t - 3 + j;
      if (tt >= 0) acc += cw[j * 768 + ch] * p.proj[(size_t)tt * PW + DQ + ch];
    }
    float v = siluf_(acc);
    (which == 0 ? sq : which == 1 ? sk : sv)[t * 65 + d] = v;
  }
  __syncthreads();
  {
    const int rw = tid >> 2, part = tid & 3, t = rw & 63;
    float* row = (rw < 64 ? sq : sk) + t * 65 + part * 16;
    float s = 0.f;
#pragma unroll
    for (int d = 0; d < 16; ++d) s += row[d] * row[d];
    s += __shfl_xor(s, 1); s += __shfl_xor(s, 2);
    float sc = rsqrtf(s + EPS) * (rw < 64 ? 0.125f : 1.f);
#pragma unroll
    for (int d = 0; d < 16; ++d) row[d] *= sc;
  }
  if (wave == 2) {
    int t = tid - 128;
    float bl = p.proj[(size_t)(t0 + t) * PW + DB + hd];
    float al = p.proj[(size_t)(t0 + t) * PW + DA + hd];
    float la = -expf(p.gdn_a_log[l * 4 + hd]) * softplusf_(al + p.gdn_dt_bias[l * 4 + hd]);
    for (int off = 1; off < 64; off <<= 1) { float n = __shfl_up(la, off); if (lane >= off) la += n; }
    sgc[t] = la; sbeta[t] = sigmoidf_(bl);
  }
  __syncthreads();
  {
    int mat = wave >> 2, mt = wave & 3;
    f32x4 acc[4];
#pragma unroll
    for (int t = 0; t < 4; ++t) acc[t] = f32x4{0.f, 0.f, 0.f, 0.f};
    mm16<4>(acc, (mat == 0 ? sk : sq) + mt * 16 * 65, 65, 1, sk, 1, 65, 64);
#pragma unroll
    for (int t = 0; t < 4; ++t)
#pragma unroll
      for (int e = 0; e < 4; ++e) {
        int i = mt * 16 + 4 * qd + e, j = t * 16 + r;
        float g = (i >= j) ? expf(sgc[i] - sgc[j]) : 0.f;
        if (mat == 0) sL[i * 68 + j] = (i > j) ? acc[t][e] * sbeta[i] * g : 0.f;
        else p.g_attn[((size_t)item * 64 + i) * 64 + j] = (i >= j) ? acc[t][e] * g : 0.f;
      }
  }
  __syncthreads();
  if (tid < 128) {
    const bool isv = tid < 64; const int d = tid & 63;
    float X[64];
#pragma unroll
    for (int i = 0; i < 64; ++i) X[i] = 0.f;
    float* dst = (isv ? p.g_u : p.g_w) + (size_t)item * 4096 + d;
#pragma unroll
    for (int i = 0; i < 64; ++i) {
      float bi = sbeta[i];
      float s = isv ? sv[i * 65 + d] * bi : sk[i * 65 + d] * bi * expf(sgc[i]);
      float s1 = 0.f, s2 = 0.f, s3 = 0.f;
#pragma unroll
      for (int j4 = 0; j4 < (i + 3) / 4; ++j4) {
        float4 lv = *(const float4*)&sL[i * 68 + j4 * 4];
        s -= lv.x * X[j4 * 4 + 0]; s1 -= lv.y * X[j4 * 4 + 1]; s2 -= lv.z * X[j4 * 4 + 2]; s3 -= lv.w * X[j4 * 4 + 3];
      }
      s = (s + s1) + (s2 + s3);
      X[i] = s;
      dst[i * 64] = s;
    }
  } else {
    for (int i2 = tid - 128; i2 < 8192; i2 += 384) {
      int which = i2 >> 12, i = (i2 >> 6) & 63, d = i2 & 63;
      float val = which == 0 ? sq[i * 65 + d] * expf(sgc[i]) : sk[i * 65 + d] * expf(sgc[63] - sgc[i]);
      (which == 0 ? p.g_qd : p.g_kd)[(size_t)item * 4096 + i * 64 + d] = val;
    }
    if (tid == 128) p.g_cdec[item] = expf(sgc[63]);
  }
  __syncthreads();
}

DEVI f32x4 mm16_k64(const float* A, int sam, int sak, const float* B, int sbk, int sbn) {
  const int l = TID() & 63, r = l & 15, q = l >> 4;
  const float* ap = A + r * sam + q * sak;
  const float* bp = B + q * sbk + r * sbn;
  float av[16], bv[16];
#pragma unroll
  for (int k = 0; k < 16; ++k) { av[k] = ap[4 * k * sak]; bv[k] = bp[4 * k * sbk]; }
  f32x4 c0 = f32x4{0.f, 0.f, 0.f, 0.f}, c1 = f32x4{0.f, 0.f, 0.f, 0.f};
#pragma unroll
  for (int k = 0; k < 16; k += 2) {
    c0 = __builtin_amdgcn_mfma_f32_16x16x4f32(av[k], bv[k], c0, 0, 0, 0);
    c1 = __builtin_amdgcn_mfma_f32_16x16x4f32(av[k + 1], bv[k + 1], c1, 0, 0, 0);
  }
  return c0 + c1;
}

template <int MODE>
DEVI void gdn_chain(const Params& p, int hd, int grp, int cb, char* smem) {
  float* base = (float*)smem;
  constexpr int BUFSZ = 64 * 68 * 2 + 64 * 16;
  float* sS = base + 2 * BUFSZ; float* sVN = sS + 1024;
  const int tid = TID(), lane = tid & 63, wave = tid >> 6, r = lane & 15, qd = lane >> 4;
  const bool apart = (MODE == 0) && (cb >= 4);
  const int e0 = (cb & 3) * 16;
  const int c0 = grp * 32;
  float4 pw0, pw1, pkd0, pkd1, pu = float4{0.f, 0.f, 0.f, 0.f};
  const int lr0 = tid >> 4, lc0 = (tid & 15) * 4, lr1 = lr0 + 32;
  const int ur = tid >> 2, uc = (tid & 3) * 4;
#define GLOAD(c_)                                                            \
  {                                                                          \
    size_t b_ = (size_t)((c_) * 4 + hd) * 4096;                              \
    pw0 = *(const float4*)&p.g_w[b_ + lr0 * 64 + lc0];                       \
    pw1 = *(const float4*)&p.g_w[b_ + lr1 * 64 + lc0];                       \
    pkd0 = *(const float4*)&p.g_kd[b_ + lr0 * 64 + lc0];                     \
    pkd1 = *(const float4*)&p.g_kd[b_ + lr1 * 64 + lc0];                     \
    if (tid < 256 && !apart) pu = *(const float4*)&p.g_u[b_ + ur * 64 + e0 + uc]; \
  }
#define LSTORE(bi_)                                                          \
  {                                                                          \
    float* W_ = base + (bi_) * BUFSZ; float* KD_ = W_ + 64 * 68; float* U_ = KD_ + 64 * 68; \
    *(float4*)&W_[lr0 * 68 + lc0] = pw0; *(float4*)&W_[lr1 * 68 + lc0] = pw1;       \
    *(float4*)&KD_[lr0 * 68 + lc0] = pkd0; *(float4*)&KD_[lr1 * 68 + lc0] = pkd1;   \
    if (tid < 256) *(float4*)&U_[ur * 16 + uc] = pu;                         \
  }
  f32x4 sreg = f32x4{0.f, 0.f, 0.f, 0.f};
  if (MODE == 0) {
    for (int i = tid; i < 1024; i += NT) sS[i] = (apart && ((i >> 4) == e0 + (i & 15))) ? 1.f : 0.f;
    if (apart) {
#pragma unroll
      for (int e = 0; e < 4; ++e) sreg[e] = ((wave & 3) * 16 + 4 * qd + e == e0 + r) ? 1.f : 0.f;
    }
  } else {
    for (int i = tid; i < 1024; i += NT) sS[i] = 0.f;
    float* W = base;
    for (int g2 = 0; g2 < grp; ++g2) {
      const float* Ag = p.g_comp + ((size_t)(hd * 8 + g2) * 2 + 1) * 4096;
      const float* Bg = p.g_comp + ((size_t)(hd * 8 + g2) * 2 + 0) * 4096;
      __syncthreads();
      *(float4*)&W[lr0 * 68 + lc0] = *(const float4*)&Ag[lr0 * 64 + lc0];
      *(float4*)&W[lr1 * 68 + lc0] = *(const float4*)&Ag[lr1 * 64 + lc0];
      __syncthreads();
      f32x4 a = f32x4{0.f, 0.f, 0.f, 0.f};
      if (wave < 4) a = mm16_k64(W + wave * 16 * 68, 68, 1, sS, 16, 1);
      __syncthreads();
      if (wave < 4) {
#pragma unroll
        for (int e = 0; e < 4; ++e) {
          int d = wave * 16 + 4 * qd + e;
          sreg[e] = a[e] + Bg[d * 64 + e0 + r];
          sS[d * 16 + r] = sreg[e];
        }
      }
    }
    __syncthreads();
    if (wave < 4) {
#pragma unroll
      for (int e = 0; e < 4; ++e) {
        int d = wave * 16 + 4 * qd + e;
        p.g_sst[(size_t)(c0 * 4 + hd) * 4096 + d * 64 + e0 + r] = sreg[e];
      }
    }
  }
  GLOAD(c0) LSTORE(0)
  __syncthreads();
  for (int cc = 0; cc < 32; ++cc) {
    const int c = c0 + cc;
    if (cc + 1 < 32) GLOAD(c + 1)
    const float cd = p.g_cdec[c * 4 + hd];
    float* W = base + (cc & 1) * BUFSZ; float* KD = W + 64 * 68; float* U = KD + 64 * 68;
    const size_t it = (size_t)(c * 4 + hd);
    if (wave < 4) {
      f32x4 a1 = mm16_k64(W + wave * 16 * 68, 68, 1, sS, 16, 1);
#pragma unroll
      for (int e = 0; e < 4; ++e) {
        int i = wave * 16 + 4 * qd + e;
        float vn = (apart ? 0.f : U[i * 16 + r]) - a1[e];
        sVN[i * 16 + r] = vn;
        if (MODE == 1) p.g_u[it * 4096 + i * 64 + e0 + r] = vn;
      }
    }
    __syncthreads();
    if (wave < 4) {
      f32x4 a2 = mm16_k64(KD + wave * 16, 1, 68, sVN, 16, 1);
#pragma unroll
      for (int e = 0; e < 4; ++e) {
        int d = wave * 16 + 4 * qd + e;
        sreg[e] = sreg[e] * cd + a2[e];
        sS[d * 16 + r] = sreg[e];
        if (MODE == 1 && cc + 1 < 32) p.g_sst[(size_t)((c + 1) * 4 + hd) * 4096 + d * 64 + e0 + r] = sreg[e];
      }
    }
    if (cc + 1 < 32) LSTORE((cc + 1) & 1)
    __syncthreads();
  }
  if (MODE == 0 && wave < 4) {
    float* dst = p.g_comp + ((size_t)(hd * 8 + grp) * 2 + (apart ? 1 : 0)) * 4096;
#pragma unroll
    for (int e = 0; e < 4; ++e) {
      int d = wave * 16 + 4 * qd + e;
      dst[d * 64 + e0 + r] = sreg[e];
    }
  }
  __syncthreads();
}

DEVI void gdn_out(const Params& p, int l, int item, char* smem) {
  const int c = item >> 2, hd = item & 3, t0 = c * 64;
  float* sQD = (float*)smem; float* sS = sQD + 64 * 68; float* sAT = sS + 64 * 68; float* sVN = sAT + 64 * 68;
  const int tid = TID(), lane = tid & 63, wave = tid >> 6, r = lane & 15, qd = lane >> 4;
  const size_t b = (size_t)item * 4096;
  for (int idx = tid; idx < 1024; idx += NT) {
    int row = idx >> 4, c4 = idx & 15;
    *(float4*)&sQD[row * 68 + c4 * 4] = *(const float4*)&p.g_qd[b + row * 64 + c4 * 4];
    *(float4*)&sS[row * 68 + c4 * 4] = *(const float4*)&p.g_sst[b + row * 64 + c4 * 4];
    *(float4*)&sAT[row * 68 + c4 * 4] = *(const float4*)&p.g_attn[b + row * 64 + c4 * 4];
    *(float4*)&sVN[row * 68 + c4 * 4] = *(const float4*)&p.g_u[b + row * 64 + c4 * 4];
  }
  __syncthreads();
  const int mt = wave & 3, nh = wave >> 2;
  f32x4 acc[2]; acc[0] = acc[1] = f32x4{0.f, 0.f, 0.f, 0.f};
  mm16<2>(acc, sQD + mt * 16 * 68, 68, 1, sS + nh * 32, 68, 1, 64);
  mm16<2>(acc, sAT + mt * 16 * 68, 68, 1, sVN + nh * 32, 68, 1, 64);
  __syncthreads();
  float* sO = sQD;
#pragma unroll
  for (int t2 = 0; t2 < 2; ++t2)
#pragma unroll
    for (int e = 0; e < 4; ++e) sO[(mt * 16 + 4 * qd + e) * 68 + nh * 32 + t2 * 16 + r] = acc[t2][e];
  __syncthreads();
  {
    int row = tid >> 3, sub = tid & 7, t = t0 + row;
    float o[8], yv[8]; float ss = 0.f;
#pragma unroll
    for (int k = 0; k < 8; ++k) { o[k] = sO[row * 68 + sub * 8 + k]; ss += o[k] * o[k]; }
    ss += __shfl_xor(ss, 1); ss += __shfl_xor(ss, 2); ss += __shfl_xor(ss, 4);
    float rs = rsqrtf(ss * (1.f / 64.f) + EPS);
    float s2 = 0.f;
#pragma unroll
    for (int k = 0; k < 8; ++k) {
      int col = sub * 8 + k;
      float g = p.proj[(size_t)t * PW + DG + hd * 64 + col];
      float y = o[k] * rs * p.gdn_norm[l * 64 + col] * siluf_(g);
      s2 += y * y;
      yv[k] = y * p.branch_norm[(l * 4 + 3) * 256 + hd * 64 + col];
    }
    s2 += __shfl_xor(s2, 1); s2 += __shfl_xor(s2, 2); s2 += __shfl_xor(s2, 4);
    if (sub == 0) p.ssq[(size_t)t * 16 + 8 + hd] = s2;
    *(uint4*)&p.zb[(size_t)t * DM + 768 + hd * 64 + sub * 8] =
        uint4{pack2(yv[0], yv[1]), pack2(yv[2], yv[3]), pack2(yv[4], yv[5]), pack2(yv[6], yv[7])};
  }
  __syncthreads();
}

DEVI void ret_kv(const Params& p, int l, int item, char* smem) {
  const int c = item >> 2, hd = item & 3, t0 = c * 128;
  float* sK = (float*)smem; float* sV = sK + 128 * 65;
  const int tid = TID(), lane = tid & 63, wave = tid >> 6, r = lane & 15, qd = lane >> 4;
  const float lg = logf(1.f - exp2f(-5.f - (float)hd));
  for (int i = tid; i < 128 * 32; i += NT) {
    int t = i >> 5, f = i & 31; size_t tt = t0 + t;
    float k1 = p.proj[tt * PW + RK + hd * 64 + f], k2 = p.proj[tt * PW + RK + hd * 64 + 32 + f];
    float cs = p.rope[(tt * 32 + f) * 2], sn = p.rope[(tt * 32 + f) * 2 + 1];
    float dec = expf(lg * (float)(127 - t));
    sK[t * 65 + f] = (k1 * cs - k2 * sn) * dec;
    sK[t * 65 + 32 + f] = (k2 * cs + k1 * sn) * dec;
  }
  for (int i = tid; i < 128 * 64; i += NT) {
    int t = i >> 6, e = i & 63;
    sV[t * 65 + e] = p.proj[(size_t)(t0 + t) * PW + RV + hd * 64 + e];
  }
  __syncthreads();
  const int mt = wave & 3, nh = wave >> 2;
  f32x4 acc[2]; acc[0] = acc[1] = f32x4{0.f, 0.f, 0.f, 0.f};
  mm16<2>(acc, sK + mt * 16, 1, 65, sV + nh * 32, 65, 1, 128);
#pragma unroll
  for (int t2 = 0; t2 < 2; ++t2)
#pragma unroll
    for (int e = 0; e < 4; ++e)
      p.ret_kv[(size_t)item * 4096 + (mt * 16 + 4 * qd + e) * 64 + nh * 32 + t2 * 16 + r] = acc[t2][e];
  __syncthreads();
}

DEVI void ret_out(const Params& p, int l, int item, char* smem) {
  const int c = item >> 2, hd = item & 3, t0 = c * 128;
  float* sQ = (float*)smem; float* sK = sQ + 128 * 65; float* sV = sK + 128 * 65; float* sSt = sV + 128 * 65;
  const int tid = TID(), lane = tid & 63, wave = tid >> 6, r = lane & 15, qd = lane >> 4;
  const float lg = logf(1.f - exp2f(-5.f - (float)hd));
  {
    const float* ssrc = p.ret_kv + (size_t)(c * 4 + hd) * 4096;
#pragma unroll
    for (int j = 0; j < 8; ++j) { int idx = tid + 512 * j; sSt[(idx >> 6) * 65 + (idx & 63)] = ssrc[idx]; }
  }
  for (int i = tid; i < 128 * 32; i += NT) {
    int t = i >> 5, f = i & 31; size_t tt = t0 + t;
    float cs = p.rope[(tt * 32 + f) * 2], sn = p.rope[(tt * 32 + f) * 2 + 1];
    float k1 = p.proj[tt * PW + RK + hd * 64 + f], k2 = p.proj[tt * PW + RK + hd * 64 + 32 + f];
    sK[t * 65 + f] = (k1 * cs - k2 * sn);
    sK[t * 65 + 32 + f] = (k2 * cs + k1 * sn);
    float q1 = p.proj[tt * PW + RQ + hd * 64 + f], q2 = p.proj[tt * PW + RQ + hd * 64 + 32 + f];
    sQ[t * 65 + f] = (q1 * cs - q2 * sn) * 0.125f;
    sQ[t * 65 + 32 + f] = (q2 * cs + q1 * sn) * 0.125f;
  }
  for (int i = tid; i < 128 * 64; i += NT) {
    int t = i >> 6, e = i & 63;
    sV[t * 65 + e] = p.proj[(size_t)(t0 + t) * PW + RV + hd * 64 + e];
  }
  __syncthreads();
  const int i0 = wave * 16;
  f32x4 sc[8], os[4];
#pragma unroll
  for (int t = 0; t < 8; ++t) sc[t] = f32x4{0.f, 0.f, 0.f, 0.f};
#pragma unroll
  for (int t = 0; t < 4; ++t) os[t] = f32x4{0.f, 0.f, 0.f, 0.f};
  mm16<8>(sc, sQ + i0 * 65, 65, 1, sK, 1, 65, 64);
  mm16<4>(os, sQ + i0 * 65, 65, 1, sSt, 65, 1, 64);
  __syncthreads();
  float* sP = (float*)smem;
#pragma unroll
  for (int t2 = 0; t2 < 8; ++t2)
#pragma unroll
    for (int e = 0; e < 4; ++e) {
      int i = i0 + 4 * qd + e, j = t2 * 16 + r;
      sP[i * 129 + j] = (i >= j) ? sc[t2][e] * expf(lg * (float)(i - j)) : 0.f;
    }
  __syncthreads();
  f32x4 o[4];
#pragma unroll
  for (int t2 = 0; t2 < 4; ++t2)
#pragma unroll
    for (int e = 0; e < 4; ++e) o[t2][e] = os[t2][e] * expf(lg * (float)(i0 + 4 * qd + e + 1));
  mm16<4>(o, sP + i0 * 129, 129, 1, sV, 65, 1, 128);
#pragma unroll
  for (int e = 0; e < 4; ++e) {
    int i = i0 + 4 * qd + e; size_t t = t0 + i;
    float sm = sum16(o[0][e] + o[1][e] + o[2][e] + o[3][e]);
    float mu = sm * (1.f / 64.f);
    float vr = 0.f;
#pragma unroll
    for (int t2 = 0; t2 < 4; ++t2) { float dd = o[t2][e] - mu; vr += dd * dd; }
    vr = sum16(vr);
    float rstd = rsqrtf(vr * (1.f / 64.f) + EPS);
    float ss = 0.f;
#pragma unroll
    for (int t2 = 0; t2 < 4; ++t2) {
      int col = hd * 64 + t2 * 16 + r;
      float on = (o[t2][e] - mu) * rstd * p.ret_gn[l * 256 + col];
      float g = p.proj[t * PW + RG + col];
      float y = siluf_(g) * on;
      ss += y * y;
      p.zb[t * DM + col] = f2bf(y * p.branch_norm[(l * 4 + 0) * 256 + col]);
    }
    ss = sum16(ss);
    if (r == 0) p.ssq[t * 16 + hd] = ss;
  }
  __syncthreads();
}

DEVI void lru_local(const Params& p, int l, int c, char* smem) {
  const int t0 = c * 64;
  float* sX = (float*)smem; float* sA = sX + 64 * 257;
  const int tid = TID(), lane = tid & 63, wave = tid >> 6, r = lane & 15, qd = lane >> 4;
  for (int i = tid; i < 64 * 256; i += NT) {
    int t = i >> 8, ch = i & 255;
    float acc = p.lru_conv_b[l * 256 + ch];
#pragma unroll
    for (int j = 0; j < 4; ++j) {
      int tt = t0 + t - 3 + j;
      if (tt >= 0) acc += p.lru_conv_w[(l * 4 + j) * 256 + ch] * p.proj[(size_t)tt * PW + LX + ch];
    }
    sX[t * 257 + ch] = acc;
  }
  __syncthreads();
  for (int pr = 0; pr < 2; ++pr) {
    int pi = wave * 2 + pr, mt = pi & 3, nb = pi >> 2;
    f32x4 ra[4], ri[4];
#pragma unroll
    for (int t = 0; t < 4; ++t) { ra[t] = f32x4{0.f, 0.f, 0.f, 0.f}; ri[t] = f32x4{0.f, 0.f, 0.f, 0.f}; }
    mm16<4>(ra, sX + mt * 16 * 257 + nb * 64, 257, 1, p.lru_w_a + (size_t)(l * 4 + nb) * 4096, 64, 1, 64);
    mm16<4>(ri, sX + mt * 16 * 257 + nb * 64, 257, 1, p.lru_w_x + (size_t)(l * 4 + nb) * 4096, 64, 1, 64);
#pragma unroll
    for (int t2 = 0; t2 < 4; ++t2)
#pragma unroll
      for (int e = 0; e < 4; ++e) {
        int t = mt * 16 + 4 * qd + e, ch = nb * 64 + t2 * 16 + r;
        float xb = sX[t * 257 + ch];
        float rr = sigmoidf_(ra[t2][e] + p.lru_b_a[l * 256 + ch]);
        float ii = sigmoidf_(ri[t2][e] + p.lru_b_x[l * 256 + ch]);
        float loga = -8.f * rr * softplusf_(-p.lru_lambda[l * 256 + ch]);
        float a = expf(loga);
        float bb = sqrtf(-expm1f(2.f * loga)) * (ii * xb);
        sA[t * 257 + ch] = a; sX[t * 257 + ch] = bb;
      }
  }
  __syncthreads();
  if (tid < 256) {
    int ch = tid; float H = 0.f, P = 1.f;
    for (int t = 0; t < 64; ++t) {
      float a = sA[t * 257 + ch], bb = sX[t * 257 + ch];
      H = a * H + bb; P *= a;
      p.lru_h[(size_t)(t0 + t) * 256 + ch] = H; p.lru_p[(size_t)(t0 + t) * 256 + ch] = P;
    }
    p.lru_hs[c * 256 + ch] = H; p.lru_ps[c * 256 + ch] = P;
  }
  __syncthreads();
}

DEVI void lru_out(const Params& p, int l, int c, char* smem) {
  const int t0 = c * 64;
  float* sC = (float*)smem;
  const int tid = TID(), lane = tid & 63, wave = tid >> 6;
  if (tid < 256) sC[tid] = p.lru_hs[c * 256 + tid];
  __syncthreads();
  for (int tk = 0; tk < 8; ++tk) {
    size_t t = t0 + wave * 8 + tk; int ch = lane * 4;
    float4 H = *(const float4*)&p.lru_h[t * 256 + ch], P = *(const float4*)&p.lru_p[t * 256 + ch];
    float4 g = *(const float4*)&p.proj[t * PW + LG + ch], cr = *(const float4*)&sC[ch];
    float4 bn = *(const float4*)&p.branch_norm[(l * 4 + 1) * 256 + ch];
    float y0 = geluf_(g.x) * (H.x + P.x * cr.x), y1 = geluf_(g.y) * (H.y + P.y * cr.y);
    float y2 = geluf_(g.z) * (H.z + P.z * cr.z), y3 = geluf_(g.w) * (H.w + P.w * cr.w);
    float ss = wave_sum(y0 * y0 + y1 * y1 + y2 * y2 + y3 * y3);
    if (lane == 0) p.ssq[t * 16 + 4] = ss;
    *(uint2*)&p.zb[t * DM + 256 + ch] = uint2{pack2(y0 * bn.x, y1 * bn.y), pack2(y2 * bn.z, y3 * bn.w)};
  }
  __syncthreads();
}

DEVI void s5_coef(const Params& p, int l, int g, int n, float& abr, float& abi, float (&bbr)[16], float (&bbi)[16]) {
  float dt = expf(p.s5_log_dt[l * 16 + g]);
  float are = p.s5_a_re[(l * 16 + g) * 64 + n], aim = p.s5_a_im[(l * 16 + g) * 64 + n];
  float mag = expf(are * dt), ang = aim * dt;
  abr = mag * cosf(ang); abi = mag * sinf(ang);
  float den = are * are + aim * aim;
  float pre = abr - 1.f, pim = abi;
  float fre = (pre * are + pim * aim) / den, fim = (pim * are - pre * aim) / den;
  const float4* br = (const float4*)(p.s5_b_re + (size_t)((l * 16 + g) * 64 + n) * 16);
  const float4* bi = (const float4*)(p.s5_b_im + (size_t)((l * 16 + g) * 64 + n) * 16);
#pragma unroll
  for (int c4 = 0; c4 < 4; ++c4) {
    float4 a = br[c4], b = bi[c4];
    bbr[c4 * 4 + 0] = fre * a.x - fim * b.x; bbi[c4 * 4 + 0] = fre * b.x + fim * a.x;
    bbr[c4 * 4 + 1] = fre * a.y - fim * b.y; bbi[c4 * 4 + 1] = fre * b.y + fim * a.y;
    bbr[c4 * 4 + 2] = fre * a.z - fim * b.z; bbi[c4 * 4 + 2] = fre * b.z + fim * a.z;
    bbr[c4 * 4 + 3] = fre * a.w - fim * b.w; bbi[c4 * 4 + 3] = fre * b.w + fim * a.w;
  }
}
DEVI void s5_load_u(const Params& p, int t0, float* sU) {
  for (int i = TID(); i < 64 * 64; i += NT) {
    int t = i >> 6, c4 = i & 63;
    *(float4*)&sU[t * 256 + c4 * 4] = *(const float4*)&p.proj[(size_t)(t0 + t) * PW + SU + c4 * 4];
  }
}
DEVI void s5_bu(const float* up, const float (&bbr)[16], const float (&bbi)[16], float& bur, float& bui) {
  bur = 0.f; bui = 0.f;
#pragma unroll
  for (int c4 = 0; c4 < 4; ++c4) {
    float4 u = *(const float4*)&up[c4 * 4];
    bur += bbr[c4 * 4] * u.x + bbr[c4 * 4 + 1] * u.y + bbr[c4 * 4 + 2] * u.z + bbr[c4 * 4 + 3] * u.w;
    bui += bbi[c4 * 4] * u.x + bbi[c4 * 4 + 1] * u.y + bbi[c4 * 4 + 2] * u.z + bbi[c4 * 4 + 3] * u.w;
  }
}

DEVI void s5_local(const Params& p, int l, int c, char* smem) {
  const int t0 = c * 64;
  float* sU = (float*)smem;
  const int lane = TID() & 63, wave = TID() >> 6;
  s5_load_u(p, t0, sU);
  __syncthreads();
  for (int gi = 0; gi < 2; ++gi) {
    int g = wave + 8 * gi;
    float abr, abi, bbr[16], bbi[16];
    s5_coef(p, l, g, lane, abr, abi, bbr, bbi);
    float xr = 0.f, xi = 0.f;
    for (int t = 0; t < 64; ++t) {
      float bur, bui; s5_bu(sU + t * 256 + g * 16, bbr, bbi, bur, bui);
      float nr = abr * xr - abi * xi + bur, ni = abr * xi + abi * xr + bui;
      xr = nr; xi = ni;
    }
    *(float2*)&p.xloc[((size_t)(c * 16 + g) * 64 + lane) * 2] = float2{xr, xi};
  }
  __syncthreads();
}

DEVI void s5_out(const Params& p, int l, int c, char* smem) {
  const int t0 = c * 64;
  bf16_t* sY = (bf16_t*)smem;
  float* sX = (float*)(smem + 64 * 264 * 2);
  const int tid = TID(), lane = tid & 63, wave = tid >> 6, r = lane & 15, qd = lane >> 4;
  float* Xl = sX + wave * (16 * 132);
  for (int gi = 0; gi < 2; ++gi) {
    const int g = wave + 8 * gi;
    float abr, abi, bbr[16], bbi[16];
    s5_coef(p, l, g, lane, abr, abi, bbr, bbi);
    float breg[32];
#pragma unroll
    for (int ks = 0; ks < 16; ++ks) {
      breg[ks] = p.s5_c_re[(size_t)((l * 16 + g) * 16 + r) * 64 + 4 * ks + qd];
      breg[16 + ks] = -p.s5_c_im[(size_t)((l * 16 + g) * 16 + r) * 64 + 4 * ks + qd];
    }
    const float dd = p.s5_d[l * 256 + g * 16 + r];
    const float2 xin = *(const float2*)&p.xloc[((size_t)(c * 16 + g) * 64 + lane) * 2];
    float xr = xin.x, xi = xin.y;
    float4 uvecs[4]; float ues[4][4];
#pragma unroll
    for (int tb = 0; tb < 4; ++tb) {
      const float* ub = p.proj + (size_t)(t0 + tb * 16) * PW + SU + g * 16;
      uvecs[tb] = *(const float4*)&ub[(size_t)r * PW + 4 * qd];
#pragma unroll
      for (int e = 0; e < 4; ++e) ues[tb][e] = ub[(size_t)(4 * qd + e) * PW + r];
    }
#pragma unroll
    for (int tb = 0; tb < 4; ++tb) {
      const float4 uvec = uvecs[tb];
      float ue[4];
#pragma unroll
      for (int e = 0; e < 4; ++e) ue[e] = ues[tb][e];
      const int u0 = __float_as_int(uvec.x), u1 = __float_as_int(uvec.y), u2 = __float_as_int(uvec.z), u3 = __float_as_int(uvec.w);
#pragma unroll
      for (int tt = 0; tt < 16; ++tt) {
        float bur = 0.f, bui = 0.f;
#pragma unroll
        for (int c4 = 0; c4 < 4; ++c4) {
          float a0 = __int_as_float(__builtin_amdgcn_readlane(u0, tt + 16 * c4));
          float a1 = __int_as_float(__builtin_amdgcn_readlane(u1, tt + 16 * c4));
          float a2 = __int_as_float(__builtin_amdgcn_readlane(u2, tt + 16 * c4));
          float a3 = __int_as_float(__builtin_amdgcn_readlane(u3, tt + 16 * c4));
          bur += bbr[c4 * 4] * a0 + bbr[c4 * 4 + 1] * a1 + bbr[c4 * 4 + 2] * a2 + bbr[c4 * 4 + 3] * a3;
          bui += bbi[c4 * 4] * a0 + bbi[c4 * 4 + 1] * a1 + bbi[c4 * 4 + 2] * a2 + bbi[c4 * 4 + 3] * a3;
        }
        float nr = abr * xr - abi * xi + bur, ni = abr * xi + abi * xr + bui;
        xr = nr; xi = ni;
        Xl[tt * 132 + lane] = xr; Xl[tt * 132 + 64 + lane] = xi;
      }
      f32x4 acc = f32x4{0.f, 0.f, 0.f, 0.f};
#pragma unroll
      for (int ks = 0; ks < 32; ++ks) {
        float a = Xl[r * 132 + 4 * ks + qd];
        acc = __builtin_amdgcn_mfma_f32_16x16x4f32(a, breg[ks], acc, 0, 0, 0);
      }
#pragma unroll
      for (int e = 0; e < 4; ++e) {
        float y = acc[e] + dd * ue[e];
        sY[(tb * 16 + 4 * qd + e) * 264 + g * 16 + r] = f2bf(geluf_(y));
      }
    }
  }
  __syncthreads();
  f32x4 av[4][2], ag[4][2];
#pragma unroll
  for (int i = 0; i < 4; ++i)
#pragma unroll
    for (int j = 0; j < 2; ++j) { av[i][j] = f32x4{0.f, 0.f, 0.f, 0.f}; ag[i][j] = f32x4{0.f, 0.f, 0.f, 0.f}; }
  const bf16_t* WT = p.gluT + (size_t)l * 512 * 256;
#pragma unroll 4
  for (int ks = 0; ks < 8; ++ks) {
    bf16x8 bv0 = *(const bf16x8*)&WT[(size_t)(32 * wave + r) * 256 + ks * 32 + qd * 8];
    bf16x8 bv1 = *(const bf16x8*)&WT[(size_t)(32 * wave + 16 + r) * 256 + ks * 32 + qd * 8];
    bf16x8 bg0 = *(const bf16x8*)&WT[(size_t)(256 + 32 * wave + r) * 256 + ks * 32 + qd * 8];
    bf16x8 bg1 = *(const bf16x8*)&WT[(size_t)(256 + 32 * wave + 16 + r) * 256 + ks * 32 + qd * 8];
#pragma unroll
    for (int mt = 0; mt < 4; ++mt) {
      bf16x8 a = *(const bf16x8*)&sY[(mt * 16 + r) * 264 + ks * 32 + qd * 8];
      av[mt][0] = __builtin_amdgcn_mfma_f32_16x16x32_bf16(a, bv0, av[mt][0], 0, 0, 0);
      av[mt][1] = __builtin_amdgcn_mfma_f32_16x16x32_bf16(a, bv1, av[mt][1], 0, 0, 0);
      ag[mt][0] = __builtin_amdgcn_mfma_f32_16x16x32_bf16(a, bg0, ag[mt][0], 0, 0, 0);
      ag[mt][1] = __builtin_amdgcn_mfma_f32_16x16x32_bf16(a, bg1, ag[mt][1], 0, 0, 0);
    }
  }
  float* sO = sX;
#pragma unroll
  for (int mt = 0; mt < 4; ++mt)
#pragma unroll
    for (int t2 = 0; t2 < 2; ++t2)
#pragma unroll
      for (int e = 0; e < 4; ++e) {
        int t = mt * 16 + 4 * qd + e, col = 32 * wave + t2 * 16 + r;
        float zv = av[mt][t2][e] + p.s5_glu_b[l * 512 + col];
        float zg = ag[mt][t2][e] + p.s5_glu_b[l * 512 + 256 + col];
        sO[t * 256 + col] = zv * sigmoidf_(zg);
      }
  __syncthreads();
  for (int tk = 0; tk < 8; ++tk) {
    int tl = wave * 8 + tk; size_t t = t0 + tl; int ch = lane * 4;
    float4 o = *(const float4*)&sO[tl * 256 + ch];
    float4 bn = *(const float4*)&p.branch_norm[(l * 4 + 2) * 256 + ch];
    float ss = wave_sum(o.x * o.x + o.y * o.y + o.z * o.z + o.w * o.w);
    if (lane == 0) p.ssq[t * 16 + 5] = ss;
    *(uint2*)&p.zb[t * DM + 512 + ch] = uint2{pack2(o.x * bn.x, o.y * bn.y), pack2(o.z * bn.z, o.w * bn.w)};
  }
  __syncthreads();
}

DEVI void ret_scan(const Params& p, int it) {
  const int elem = it * NT + TID(), hd = elem >> 12, idx = elem & 4095;
  const float lg = logf(1.f - exp2f(-5.f - (float)hd)), cdk = expf(lg * 128.f);
  float* base = p.ret_kv + (size_t)hd * 4096 + idx;
  float s = 0.f;
  for (int cb = 0; cb < 128; cb += 16) {
    float v[16];
#pragma unroll
    for (int j = 0; j < 16; ++j) v[j] = base[(size_t)(cb + j) * 16384];
#pragma unroll
    for (int j = 0; j < 16; ++j) { base[(size_t)(cb + j) * 16384] = s; s = s * cdk + v[j]; }
  }
}
DEVI void s5_scan(const Params& p, int l, int it) {
  const int sidx = it * NT + TID(), g = sidx >> 6, n = sidx & 63;
  float dt = expf(p.s5_log_dt[l * 16 + g]);
  float are = p.s5_a_re[(l * 16 + g) * 64 + n], aim = p.s5_a_im[(l * 16 + g) * 64 + n];
  float mag = expf(are * dt), ang = aim * dt;
  float pr = mag * cosf(ang), pi = mag * sinf(ang);
#pragma unroll
  for (int k = 0; k < 6; ++k) { float nr = pr * pr - pi * pi, ni = 2.f * pr * pi; pr = nr; pi = ni; }
  float2* base = (float2*)p.xloc + sidx;
  float xr = 0.f, xi = 0.f;
  for (int cb = 0; cb < 256; cb += 16) {
    float2 v[16];
#pragma unroll
    for (int j = 0; j < 16; ++j) v[j] = base[(size_t)(cb + j) * 1024];
#pragma unroll
    for (int j = 0; j < 16; ++j) {
      base[(size_t)(cb + j) * 1024] = float2{xr, xi};
      float nr = pr * xr - pi * xi + v[j].x, ni = pr * xi + pi * xr + v[j].y;
      xr = nr; xi = ni;
    }
  }
}
DEVI void lru_scan(const Params& p) {
  const int ch = TID();
  if (ch < 256) {
    float carry = 0.f;
    for (int cb = 0; cb < 256; cb += 16) {
      float ps[16], hs[16];
#pragma unroll
      for (int j = 0; j < 16; ++j) { ps[j] = p.lru_ps[(cb + j) * 256 + ch]; hs[j] = p.lru_hs[(cb + j) * 256 + ch]; }
#pragma unroll
      for (int j = 0; j < 16; ++j) { p.lru_hs[(cb + j) * 256 + ch] = carry; carry = ps[j] * carry + hs[j]; }
    }
  }
}

DEVI void peer_scores(const Params& p, int l, int item, char* smem) {
  const int tt = item >> 4, hp = item & 15, t0 = tt * 64;
  float* sQ = (float*)smem; float* sKy = sQ + 64 * 65;
  const int tid = TID(), lane = tid & 63, wave = tid >> 6, r = lane & 15, qd = lane >> 4;
  for (int i = tid; i < 64 * 64; i += NT) { int t = i >> 6, d = i & 63; sQ[t * 65 + d] = p.qbuf[(size_t)(t0 + t) * 1024 + hp * 64 + d]; }
  const float* ky = p.peer_subkeys + (size_t)(l * 16 + hp) * 8192;
  for (int i = tid; i < 128 * 64; i += NT) { int k = i >> 6, d = i & 63; sKy[k * 65 + d] = ky[i]; }
  __syncthreads();
  const int mt = wave & 3, nh = wave >> 2;
  f32x4 acc[4];
#pragma unroll
  for (int t = 0; t < 4; ++t) acc[t] = f32x4{0.f, 0.f, 0.f, 0.f};
  mm16<4>(acc, sQ + mt * 16 * 65, 65, 1, sKy + nh * 64 * 65, 1, 65, 64);
#pragma unroll
  for (int t2 = 0; t2 < 4; ++t2)
#pragma unroll
    for (int e = 0; e < 4; ++e) {
      size_t t = t0 + mt * 16 + 4 * qd + e; int key = nh * 64 + t2 * 16 + r;
      p.scores[(t * 16 + hp) * 128 + key] = acc[t2][e];
    }
  __syncthreads();
}

DEVI unsigned ford(float x) { unsigned u = __float_as_uint(x); return (u & 0x80000000u) ? ~u : (u | 0x80000000u); }
DEVI float funord(unsigned u) { return __uint_as_float((u & 0x80000000u) ? (u ^ 0x80000000u) : ~u); }
DEVI void ins16(unsigned (&v)[16], unsigned x) {
#pragma unroll
  for (int j = 0; j < 16; ++j) { unsigned hi = max(v[j], x); x = min(v[j], x); v[j] = hi; }
}

DEVI void peer_topk(const Params& p, int item, char* smem) {
  const int t0 = item * 64;
  float* sS = (float*)smem;
  const int tid = TID();
  const float* base = p.scores + (size_t)t0 * 8 * 256;
  unsigned v1[16], v2[16];
#pragma unroll
  for (int j = 0; j < 16; ++j) { v1[j] = 0u; v2[j] = 0u; }
  for (int s = 0; s < 8; ++s) {
    __syncthreads();
#pragma unroll
    for (int i = 0; i < 8; ++i) {
      int idx = tid + 512 * i, pr = idx >> 3, c4 = idx & 7;
      float4 v = *(const float4*)&base[(size_t)pr * 256 + s * 32 + c4 * 4];
      float* d = &sS[pr * 33 + c4 * 4];
      d[0] = v.x; d[1] = v.y; d[2] = v.z; d[3] = v.w;
    }
    __syncthreads();
    const int kb = (s & 3) * 32;
    if (s < 4) {
      for (int k = 0; k < 32; ++k) { unsigned key = (ford(sS[tid * 33 + k]) & ~127u) | (unsigned)(127 - (kb + k)); ins16(v1, key); }
    } else {
      for (int k = 0; k < 32; ++k) { unsigned key = (ford(sS[tid * 33 + k]) & ~127u) | (unsigned)(127 - (kb + k)); ins16(v2, key); }
    }
  }
  __syncthreads();
  unsigned* sI = (unsigned*)smem;
  float s1[16], s2[16];
#pragma unroll
  for (int a = 0; a < 16; ++a) {
    s1[a] = funord(v1[a] & ~127u); s2[a] = funord(v2[a] & ~127u);
    sI[tid * 33 + a] = 127u - (v1[a] & 127u); sI[tid * 33 + 16 + a] = 127u - (v2[a] & 127u);
  }
  unsigned vt[16];
#pragma unroll
  for (int j = 0; j < 16; ++j) vt[j] = 0u;
#pragma unroll
  for (int a = 0; a < 16; ++a)
#pragma unroll
    for (int b = 0; b < 16; ++b)
      if ((a + 1) * (b + 1) <= 16) {
        unsigned key = (ford(s1[a] + s2[b]) & ~255u) | (unsigned)(255 - (a * 16 + b));
        ins16(vt, key);
      }
  float sv[16]; float den = 0.f;
  const float mx = funord(vt[0] & ~255u);
#pragma unroll
  for (int k = 0; k < 16; ++k) { sv[k] = expf(funord(vt[k] & ~255u) - mx); den += sv[k]; }
  const float inv = 1.f / den;
  const int tl = tid >> 3, hh = tid & 7;
  int* idp = p.ids + (size_t)(t0 + tl) * 128 + hh * 16;
  float* gp = p.gates + (size_t)(t0 + tl) * 128 + hh * 16;
#pragma unroll
  for (int k = 0; k < 16; ++k) {
    unsigned pos = 255u - (vt[k] & 255u);
    unsigned i1 = sI[tid * 33 + (pos >> 4)], i2 = sI[tid * 33 + 16 + (pos & 15)];
    idp[k] = (int)(i1 * 128u + i2);
    gp[k] = sv[k] * inv;
  }
  __syncthreads();
}

typedef __attribute__((ext_vector_type(2))) float f32x2;
DEVI void fp8x16_to_f(const uint4& v, float (&o)[16]) {
  f32x2 t;
  t = __builtin_amdgcn_cvt_pk_f32_fp8((int)v.x, false); o[0] = t[0]; o[1] = t[1];
  t = __builtin_amdgcn_cvt_pk_f32_fp8((int)v.x, true); o[2] = t[0]; o[3] = t[1];
  t = __builtin_amdgcn_cvt_pk_f32_fp8((int)v.y, false); o[4] = t[0]; o[5] = t[1];
  t = __builtin_amdgcn_cvt_pk_f32_fp8((int)v.y, true); o[6] = t[0]; o[7] = t[1];
  t = __builtin_amdgcn_cvt_pk_f32_fp8((int)v.z, false); o[8] = t[0]; o[9] = t[1];
  t = __builtin_amdgcn_cvt_pk_f32_fp8((int)v.z, true); o[10] = t[0]; o[11] = t[1];
  t = __builtin_amdgcn_cvt_pk_f32_fp8((int)v.w, false); o[12] = t[0]; o[13] = t[1];
  t = __builtin_amdgcn_cvt_pk_f32_fp8((int)v.w, true); o[14] = t[0]; o[15] = t[1];
}

DEVI void ph_gather(const Params& p, int l) {
  const int lane = TID() & 63, wave = TID() >> 6;
  const int e0 = lane * 16;
  constexpr int NB = 8;
  for (int t = blockIdx.x * 8 + wave; t < S_; t += gridDim.x * 8) {
    float* hrow = p.h + (size_t)t * DM + e0;
    float z[16], out[16];
    {
      float4 a = *(const float4*)&hrow[0], b = *(const float4*)&hrow[4], c = *(const float4*)&hrow[8], d = *(const float4*)&hrow[12];
      z[0] = a.x; z[1] = a.y; z[2] = a.z; z[3] = a.w; z[4] = b.x; z[5] = b.y; z[6] = b.z; z[7] = b.w;
      z[8] = c.x; z[9] = c.y; z[10] = c.z; z[11] = c.w; z[12] = d.x; z[13] = d.y; z[14] = d.z; z[15] = d.w;
    }
    float ss = 0.f;
#pragma unroll
    for (int k = 0; k < 16; ++k) { ss += z[k] * z[k]; out[k] = 0.f; }
    ss = wave_sum(ss);
    const float rs = rsqrtf(ss * (1.f / DM) + EPS);
    const float* fn = p.ffn_norm + l * DM + e0;
#pragma unroll
    for (int k = 0; k < 16; ++k) z[k] = z[k] * rs * fn[k];
    const int id0 = p.ids[(size_t)t * 128 + lane], id1 = p.ids[(size_t)t * 128 + 64 + lane];
    const int gv0 = __float_as_int(p.gates[(size_t)t * 128 + lane] * p.vinv[id0]);
    const int gv1 = __float_as_int(p.gates[(size_t)t * 128 + 64 + lane] * p.vinv[id1]);
    const int us0 = __float_as_int(p.uinv[id0]), us1 = __float_as_int(p.uinv[id1]);
    uint4 cu[NB], cv[NB], nu[NB], nv[NB];
#pragma unroll
    for (int j = 0; j < NB; ++j) {
      int e = __builtin_amdgcn_readlane(id0, j);
      cu[j] = *(const uint4*)(p.tabU + (size_t)e * 1024 + e0);
      cv[j] = *(const uint4*)(p.tabV + (size_t)e * 1024 + e0);
    }
#pragma unroll 1
    for (int b = 0; b < 128 / NB; ++b) {
      const int nb = b + 1;
      if (nb < 128 / NB) {
        const int idn = nb < 64 / NB ? id0 : id1;
#pragma unroll
        for (int j = 0; j < NB; ++j) {
          int e = __builtin_amdgcn_readlane(idn, (nb * NB + j) & 63);
          nu[j] = *(const uint4*)(p.tabU + (size_t)e * 1024 + e0);
          nv[j] = *(const uint4*)(p.tabV + (size_t)e * 1024 + e0);
        }
      }
      const int gvc = b < 64 / NB ? gv0 : gv1, usc = b < 64 / NB ? us0 : us1;
      float dot[NB];
#pragma unroll
      for (int j = 0; j < NB; ++j) {
        float f[16]; fp8x16_to_f(cu[j], f);
        float d = 0.f;
#pragma unroll
        for (int k = 0; k < 16; ++k) d += z[k] * f[k];
        dot[j] = d;
      }
#pragma unroll
      for (int j = 0; j < NB; ++j) dot[j] = wave_sum(dot[j]);
#pragma unroll
      for (int j = 0; j < NB; ++j) {
        const int li = (b * NB + j) & 63;
        float us = __int_as_float(__builtin_amdgcn_readlane(usc, li));
        float gt = __int_as_float(__builtin_amdgcn_readlane(gvc, li));
        float cf = gt * geluf_(dot[j] * us);
        float f[16]; fp8x16_to_f(cv[j], f);
#pragma unroll
        for (int k = 0; k < 16; ++k) out[k] += cf * f[k];
      }
#pragma unroll
      for (int j = 0; j < NB; ++j) { cu[j] = nu[j]; cv[j] = nv[j]; }
    }
    float hv[16];
    {
      float4 a = *(const float4*)&hrow[0], b = *(const float4*)&hrow[4], c = *(const float4*)&hrow[8], d = *(const float4*)&hrow[12];
      hv[0] = a.x; hv[1] = a.y; hv[2] = a.z; hv[3] = a.w; hv[4] = b.x; hv[5] = b.y; hv[6] = b.z; hv[7] = b.w;
      hv[8] = c.x; hv[9] = c.y; hv[10] = c.z; hv[11] = c.w; hv[12] = d.x; hv[13] = d.y; hv[14] = d.z; hv[15] = d.w;
    }
    float s2 = 0.f;
#pragma unroll
    for (int k = 0; k < 16; ++k) { hv[k] += out[k]; s2 += hv[k] * hv[k]; }
    *(float4*)&hrow[0] = float4{hv[0], hv[1], hv[2], hv[3]}; *(float4*)&hrow[4] = float4{hv[4], hv[5], hv[6], hv[7]};
    *(float4*)&hrow[8] = float4{hv[8], hv[9], hv[10], hv[11]}; *(float4*)&hrow[12] = float4{hv[12], hv[13], hv[14], hv[15]};
    s2 = wave_sum(s2);
    const float rs2 = rsqrtf(s2 * (1.f / DM) + EPS);
    const float* pn = p.ple_norm + l * DM + e0;
    float zz[16];
#pragma unroll
    for (int k = 0; k < 16; ++k) zz[k] = hv[k] * rs2 * pn[k];
    bf16_t* zrow = p.zb + (size_t)t * DM + e0;
    *(uint4*)&zrow[0] = uint4{pack2(zz[0], zz[1]), pack2(zz[2], zz[3]), pack2(zz[4], zz[5]), pack2(zz[6], zz[7])};
    *(uint4*)&zrow[8] = uint4{pack2(zz[8], zz[9]), pack2(zz[10], zz[11]), pack2(zz[12], zz[13]), pack2(zz[14], zz[15])};
  }
}

template <class F>
DEVI void gemm_tiles(int NTn, int XM, int XN, F&& f) {
  int G = gridDim.x, B = blockIdx.x;
  asm volatile("" : "+s"(G), "+s"(B));
  if (G & 7) { for (int tile = B; tile < 64 * NTn; tile += G) f(tile / NTn, tile % NTn); return; }
  const int x = B & 7, slot = B >> 3, ns = G >> 3;
  const int xm = x / XN, xn = x % XN;
  const int mcnt = 64 / XM, mb = xm * mcnt;
  const int ncnt = (NTn - xn + XN - 1) / XN;
  for (int j = slot; j < mcnt * ncnt; j += ns) f(mb + j / ncnt, xn + XN * (j % ncnt));
}

enum { PH_PREP = 0, PH_NORM1, PH_GEMM_IN, PH_MIX_A, PH_MIX_B, PH_MIX_C, PH_MIX_D, PH_GEMM_OUT, PH_NORM2, PH_GEMM_Q, PH_SCORES,
       PH_TOPK, PH_GATHER, PH_GEMM_PLE, PH_FINAL };

#if PROBE_A >= 0
#define REGION(id, stmt)                                                                                   \
  {                                                                                                        \
    const bool on_ = (blockIdx.x == 255 && TID() == 0 && ((id) == PROBE_A || (id) == PROBE_B));              \
    if (on_) p.g_cdec[2051] = (float)(wall_clock64() & 0xFFFFFFull);                                       \
    stmt;                                                                                                  \
    if (on_) {                                                                                             \
      float dt_ = (float)(wall_clock64() & 0xFFFFFFull) - p.g_cdec[2051];                                  \
      if (dt_ < 0.f) dt_ += 16777216.f;                                                                    \
      p.g_cdec[(id) == PROBE_A ? 2048 : 2049] += dt_;                                                      \
    }                                                                                                      \
  }
#else
#define REGION(id, stmt) { stmt; }
#endif
DEVI void run_phase(const Params& p, int ph, int l, char* smem) {
  int G = gridDim.x, B = blockIdx.x;
  asm volatile("" : "+s"(G), "+s"(B));
  switch (ph) {
    case PH_PREP: ph_prep(p, smem); break;
    case PH_NORM1: ph_norm(l == 0 ? p.x : p.h, p.mix_norm + l * DM, p.zb, nullptr); break;
    case PH_GEMM_IN:
      gemm_tiles(23, 1, 8, [&](int mt_, int nt_) __attribute__((always_inline)) {
        int m0 = mt_ * 256, n0 = nt_ * 128;
        f32x4 acc[4][4];
        gemm_tile<0, 16>(acc, p.zb, DM, p.winT + (size_t)l * PW * 1024, 1024, 1024, m0, n0, nullptr, smem);
        GEMM_EPI_COORDS
#pragma unroll
        for (int i = 0; i < 4; ++i)
#pragma unroll
          for (int j = 0; j < 4; ++j)
            *(f32x4*)&p.proj[(size_t)(erow0 + i * 16) * PW + ecol0 + j * 16] = acc[i][j];
      });
      break;
    case PH_MIX_A:
      for (int it = B; it < 2048; it += G) {
        if (it < 1024) REGION(105, gdn_prep(p, l, it, smem))
        else if (it < 1536) REGION(106, ret_kv(p, l, it - 1024, smem))
        else if (it < 1792) REGION(107, lru_local(p, l, it - 1536, smem))
        else REGION(108, s5_local(p, l, it - 1792, smem))
      }
      break;
    case PH_MIX_B:
      for (int it = B; it < 256 + 35; it += G) {
        if (it < 256) { const int pr_ = (it & 7) * 4 + (it >> 6), cb_ = (it >> 3) & 7; REGION(100, gdn_chain<0>(p, pr_ >> 3, pr_ & 7, cb_, smem)) }
        else if (it < 256 + 32) ret_scan(p, it - 256);
        else if (it < 256 + 34) s5_scan(p, l, it - 288);
        else lru_scan(p);
      }
      break;
    case PH_MIX_C: {
      for (int it = B; it < 128; it += G) {
        const int pr_ = (it & 7) * 4 + (it >> 5), cb_ = (it >> 3) & 3;
        REGION(102, gdn_chain<1>(p, pr_ >> 3, pr_ & 7, cb_, smem))
      }
      int jb = B, js = G, je = 1024;
      if (G == 256) {
        js = 1;
        if (B < 128) { jb = 640 + B * 3; je = jb + 3; } else { jb = (B - 128) * 5; je = jb + 5; }
      }
      for (int j = jb; j < je; j += js) {
        const int ty = j & 3, q4 = j >> 2;
        if (ty < 2) REGION(101, ret_out(p, l, q4 * 2 + ty, smem))
        else if (ty == 2) REGION(103, s5_out(p, l, q4, smem))
        else REGION(104, lru_out(p, l, q4, smem))
      }
    } break;
    case PH_MIX_D:
      for (int it = B; it < 1024; it += G) REGION(109, gdn_out(p, l, it, smem))
      break;
    case PH_GEMM_OUT:
      gemm_tiles(8, 4, 2, [&](int mt_, int nt_) __attribute__((always_inline)) {
        int m0 = mt_ * 256, n0 = nt_ * 128;
        f32x4 acc[4][4];
        gemm_tile<1, 16>(acc, p.zb, DM, p.woutT + (size_t)l * 1024 * 1024, 1024, 1024, m0, n0, p.ssq, smem);
        GEMM_EPI_COORDS
#pragma unroll
        for (int i = 0; i < 4; ++i)
#pragma unroll
          for (int j = 0; j < 4; ++j) {
            const size_t ho = (size_t)(erow0 + i * 16) * DM + ecol0 + j * 16;
            *(f32x4*)&p.h[ho] = *(const f32x4*)&(l == 0 ? p.x : p.h)[ho] + acc[i][j];
          }
      });
      break;
    case PH_NORM2:
      ph_norm(p.h, p.ffn_norm + l * DM, p.zb, nullptr);
      convert_tables(p, l);
      {
        const size_t gtid = (size_t)B * NT + TID(), gsz = (size_t)G * NT;
        const float4* sp = (const float4*)(p.p + (size_t)l * S_ * 256);
        for (size_t i = gtid; i < (size_t)S_ * 256 / 8; i += gsz) {
          float4 a = sp[2 * i], b = sp[2 * i + 1];
          ((uint4*)p.pbf)[i] = uint4{pack2(a.x, a.y), pack2(a.z, a.w), pack2(b.x, b.y), pack2(b.z, b.w)};
        }
      }
      break;
    case PH_GEMM_Q:
      gemm_tiles(8, 4, 2, [&](int mt_, int nt_) __attribute__((always_inline)) {
        int m0 = mt_ * 256, n0 = nt_ * 128;
        f32x4 acc[4][4];
        gemm_tile<0, 16>(acc, p.zb, DM, p.wqT + (size_t)l * 1024 * 1024, 1024, 1024, m0, n0, nullptr, smem);
        GEMM_EPI_COORDS
#pragma unroll
        for (int i = 0; i < 4; ++i)
#pragma unroll
          for (int j = 0; j < 4; ++j)
            *(f32x4*)&p.qbuf[(size_t)(erow0 + i * 16) * DM + ecol0 + j * 16] = acc[i][j];
      });
      break;
    case PH_SCORES:
      for (int it = B; it < 4096; it += G) REGION(110, peer_scores(p, l, it, smem))
      break;
    case PH_TOPK:
      for (int it = B; it < 256; it += G) REGION(111, peer_topk(p, it, smem))
      break;
    case PH_GATHER: ph_gather(p, l); break;
    case PH_GEMM_PLE:
      gemm_tiles(8, 4, 2, [&](int mt_, int nt_) __attribute__((always_inline)) {
        int m0 = mt_ * 256, n0 = nt_ * 128;
        uint2* gsc = (uint2*)p.g_attn + (size_t)B * 16 * NT + TID();
        {
          f32x4 ag[4][4];
          gemm_tile<0, 16>(ag, p.zb, DM, p.wgT + (size_t)l * 1024 * 1024, 1024, 1024, m0, n0, nullptr, smem);
#pragma unroll
          for (int i = 0; i < 4; ++i)
#pragma unroll
            for (int j = 0; j < 4; ++j)
              gsc[(i * 4 + j) * NT] = uint2{pack2(sigmoidf_(ag[i][j][0]), sigmoidf_(ag[i][j][1])),
                                            pack2(sigmoidf_(ag[i][j][2]), sigmoidf_(ag[i][j][3]))};
        }
        f32x4 ap[4][4];
        gemm_tile<0, 4>(ap, p.pbf, 256, p.wpT + (size_t)l * 1024 * 256, 256, 256, m0, n0, nullptr, smem);
        GEMM_EPI_COORDS
#pragma unroll
        for (int i = 0; i < 4; ++i)
#pragma unroll
          for (int j = 0; j < 4; ++j) {
            f32x4* hp = (f32x4*)&p.h[(size_t)(erow0 + i * 16) * DM + ecol0 + j * 16];
            f32x4 hv = *hp;
            const uint2 gk = gsc[(i * 4 + j) * NT];
            hv[0] += ap[i][j][0] * __uint_as_float(gk.x << 16);
            hv[1] += ap[i][j][1] * __uint_as_float(gk.x & 0xFFFF0000u);
            hv[2] += ap[i][j][2] * __uint_as_float(gk.y << 16);
            hv[3] += ap[i][j][3] * __uint_as_float(gk.y & 0xFFFF0000u);
            *hp = hv;
          }
      });
      break;
    case PH_FINAL: ph_norm(p.h, p.final_norm, nullptr, p.out); break;
  }
}

#if !MEGA
__global__ void __launch_bounds__(NT) k_phase(Params p, int ph, int l) {
  extern __shared__ __align__(16) char smem[];
  run_phase(p, ph, l, smem);
}
#endif

#define XB_TMO      128
#define XB_XCNT(j)  (256  + 64 * (j))
#define XB_XSUB(j)  (1280 + 64 * (j))
#define XB_XGEN(j)  (2304 + 64 * (j))
#define XB_TOP      3328
#define XB_TOPGEN   3392
#define XCD_BAR_WORDS 3456
#define XB_SPIN_CAP (1u << 18)
#define LAS __attribute__((address_space(3)))
DEVI unsigned xb_ld(unsigned* p) { return __hip_atomic_load(p, __ATOMIC_RELAXED, __HIP_MEMORY_SCOPE_AGENT); }
DEVI unsigned xb_add(unsigned* p, unsigned v) { return __hip_atomic_fetch_add(p, v, __ATOMIC_RELAXED, __HIP_MEMORY_SCOPE_AGENT); }
DEVI unsigned xb_xcc_id() { return (unsigned)__builtin_amdgcn_s_getreg((3 << 11) | 20) & 0xFu; }
#define XB_SPIN(cond, bar) do { unsigned _sp = 0; while (cond) { __builtin_amdgcn_s_sleep(1); \
    if ((++_sp & 255u) == 0u) { if (xb_ld(&(bar)[XB_TMO])) break; if (_sp > XB_SPIN_CAP) { atomicAdd(&(bar)[XB_TMO], 1u); break; } } } } while (0)
struct XcdBarrier { unsigned* bar; unsigned x; volatile LAS unsigned* st; };
DEVI XcdBarrier xcd_barrier_post(unsigned* bar, volatile LAS unsigned* st) {
  XcdBarrier b; b.bar = bar; b.x = xb_xcc_id(); b.st = st;
  if (TID() == 0) (void)xb_add(&bar[XB_XCNT(b.x)], 1u);
  return b;
}
DEVI void xcd_barrier_complete(unsigned* bar, unsigned x, unsigned& nloc, unsigned& nx) {
  const unsigned G = gridDim.x * gridDim.y * gridDim.z;
  unsigned sum, cnt, mine, sp = 0u;
  for (;;) {
    sum = 0u; cnt = 0u; mine = 0u;
#pragma unroll
    for (unsigned j = 0; j < 16; ++j) { const unsigned c = xb_ld(&bar[XB_XCNT(j)]); sum += c; cnt += (c > 0u) ? 1u : 0u; mine = (j == x) ? c : mine; }
    if (sum == G) break;
    __builtin_amdgcn_s_sleep(1);
    if ((++sp & 255u) == 0u) { if (xb_ld(&bar[XB_TMO])) break; if (sp > XB_SPIN_CAP) { atomicAdd(&bar[XB_TMO], 1u); break; } }
  }
  nloc = mine > 0u ? mine : 1u; nx = cnt > 0u ? cnt : 1u;
}
DEVI void xcd_barrier(const XcdBarrier& b) {
  asm volatile("s_waitcnt vmcnt(0)" ::: "memory");
  __syncthreads();
  if (TID() == 0) {
    unsigned* bar = b.bar;
    __builtin_amdgcn_s_waitcnt(0);
    unsigned nloc = b.st[0], nx = b.st[1];
    if (nloc == 0u) { xcd_barrier_complete(bar, b.x, nloc, nx); b.st[0] = nloc; b.st[1] = nx; }
    const unsigned old = xb_add(&bar[XB_XSUB(b.x)], 1u);
    const unsigned gen = old / nloc;
    if (old + 1u == (gen + 1u) * nloc) {
      __builtin_amdgcn_fence(__ATOMIC_RELEASE, "agent");
      asm volatile("s_waitcnt vmcnt(0)" ::: "memory");
      const unsigned og = xb_add(&bar[XB_TOP], 1u);
      const unsigned tg = og / nx;
      if (og + 1u == (tg + 1u) * nx) xb_add(&bar[XB_TOPGEN], 1u);
      else XB_SPIN(xb_ld(&bar[XB_TOPGEN]) == tg, bar);
      __builtin_amdgcn_fence(__ATOMIC_ACQUIRE, "agent");
      xb_add(&bar[XB_XGEN(b.x)], 1u);
      asm volatile("s_waitcnt vmcnt(0)" ::: "memory");
    } else {
      XB_SPIN(xb_ld(&bar[XB_XGEN(b.x)]) == gen, bar);
      __builtin_amdgcn_fence(__ATOMIC_ACQUIRE, "agent");
      asm volatile("s_waitcnt vmcnt(0)" ::: "memory");
    }
  }
  __syncthreads();
}

#if MEGA
template <int ph, int l>
DEVI void mega_step(const Params& p, char* smem, const XcdBarrier& xb) {
#if PROBE_A >= 0
  if (blockIdx.x == 0 && TID() == 0 && (ph == PROBE_A || ph == PROBE_B)) p.g_cdec[2050] = (float)(wall_clock64() & 0xFFFFFFull);
  run_phase(p, ph, l, smem);
  xcd_barrier(xb);
  if (blockIdx.x == 0 && TID() == 0 && (ph == PROBE_A || ph == PROBE_B)) {
    float dt = (float)(wall_clock64() & 0xFFFFFFull) - p.g_cdec[2050];
    if (dt < 0.f) dt += 16777216.f;
    p.g_cdec[ph == PROBE_A ? 2048 : 2049] += dt;
  }
#else
  run_phase(p, ph, l, smem);
  xcd_barrier(xb);
#endif
}
template <int l>
DEVI void mega_layer(const Params& p, char* smem, const XcdBarrier& xb) {
  mega_step<PH_NORM1, l>(p, smem, xb);
  mega_step<PH_GEMM_IN, l>(p, smem, xb);
  mega_step<PH_MIX_A, l>(p, smem, xb);
  mega_step<PH_MIX_B, l>(p, smem, xb);
  mega_step<PH_MIX_C, l>(p, smem, xb);
  mega_step<PH_MIX_D, l>(p, smem, xb);
  mega_step<PH_GEMM_OUT, l>(p, smem, xb);
  mega_step<PH_NORM2, l>(p, smem, xb);
  mega_step<PH_GEMM_Q, l>(p, smem, xb);
  mega_step<PH_SCORES, l>(p, smem, xb);
  mega_step<PH_TOPK, l>(p, smem, xb);
  mega_step<PH_GATHER, l>(p, smem, xb);
  mega_step<PH_GEMM_PLE, l>(p, smem, xb);
}
__global__ void __launch_bounds__(NT) k_mega(Params p) {
  extern __shared__ __align__(16) char smem[];
  cg::grid_group grid = cg::this_grid();
#if PROBE_A >= 0
  if (blockIdx.x == 0 && TID() == 0) { p.g_cdec[2048] = 0.f; p.g_cdec[2049] = 0.f; }
#endif
  __shared__ uint4 xb_words;
  if (TID() == 0) xb_words = uint4{0u, 0u, 0u, 0u};
  __syncthreads();
  const XcdBarrier xb = xcd_barrier_post(p.bar, (volatile LAS unsigned*)&xb_words);
  run_phase(p, PH_PREP, 0, smem);
  grid.sync();
  mega_layer<0>(p, smem, xb);
  mega_layer<1>(p, smem, xb);
  run_phase(p, PH_FINAL, 0, smem);
#if PROBE_A >= 0
  xcd_barrier(xb);
  {
    const float qa_ = expf(rintf(logf(p.g_cdec[2048] * 0.01f) * 4.f) * 0.25f), qb_ = expf(rintf(logf(p.g_cdec[2049] * 0.01f) * 4.f) * 0.25f);
    const float va = sqrtf(qa_), vb = qb_;
    const size_t gtid = (size_t)blockIdx.x * NT + TID(), gsz = (size_t)gridDim.x * NT;
    for (size_t i = gtid; i < (size_t)S_ * DM; i += gsz) p.out[i] = (i == 0) ? vb : va;
  }
#endif
}
#endif

extern "C" void kernel_launch(void* const* d_in, const int* in_sizes, int n_in, void* d_out, int out_size, void* d_ws,
                              size_t ws_size, hipStream_t stream) {
  Params p{};
  const float* const* f = (const float* const*)d_in;
  p.x = f[0]; p.p = f[1]; p.pos = (const int*)d_in[2];
  p.mix_norm = f[3]; p.w_in = f[4]; p.ret_gn = f[5]; p.lru_conv_w = f[6]; p.lru_conv_b = f[7]; p.lru_w_a = f[8];
  p.lru_b_a = f[9]; p.lru_w_x = f[10]; p.lru_b_x = f[11]; p.lru_lambda = f[12];
  p.s5_a_re = f[13]; p.s5_a_im = f[14]; p.s5_b_re = f[15]; p.s5_b_im = f[16]; p.s5_c_re = f[17]; p.s5_c_im = f[18];
  p.s5_d = f[19]; p.s5_log_dt = f[20]; p.s5_glu_w = f[21]; p.s5_glu_b = f[22];
  p.gdn_conv_w = f[23]; p.gdn_a_log = f[24]; p.gdn_dt_bias = f[25]; p.gdn_norm = f[26]; p.branch_norm = f[27];
  p.w_out = f[28]; p.ffn_norm = f[29]; p.peer_wq = f[30]; p.peer_subkeys = f[31]; p.peer_u = f[32]; p.peer_v = f[33];
  p.ple_norm = f[34]; p.ple_wg = f[35]; p.ple_wp = f[36]; p.final_norm = f[37];
  p.out = (float*)d_out;
  char* ws = (char*)d_ws;
  const size_t MiB = 1024 * 1024;
  p.h = (float*)(ws + 0 * MiB);
  p.zb = (bf16_t*)(ws + 64 * MiB);
  p.proj = (float*)(ws + 96 * MiB);
  p.qbuf = (float*)(ws + 96 * MiB);
  p.scores = (float*)(ws + 160 * MiB);
  p.g_u = (float*)(ws + 288 * MiB); p.g_w = (float*)(ws + 304 * MiB); p.g_attn = (float*)(ws + 320 * MiB);
  p.g_qd = (float*)(ws + 336 * MiB); p.g_kd = (float*)(ws + 352 * MiB);
  p.ids = (int*)(ws + 288 * MiB); p.gates = (float*)(ws + 296 * MiB);
  p.lru_h = (float*)(ws + 368 * MiB); p.lru_p = (float*)(ws + 384 * MiB);
  p.ret_kv = (float*)(ws + 400 * MiB);
  p.tabU = (uint8_t*)(ws + 408 * MiB); p.tabV = (uint8_t*)(ws + 440 * MiB);
  p.uinv = (float*)(ws + 505 * MiB); p.vinv = (float*)(ws + 505 * MiB + 65536);
  p.g_sst = (float*)(ws + 408 * MiB);
  {
    char* wb = ws + 472 * MiB;
    p.winT = (bf16_t*)wb; wb += (size_t)2 * PW * 1024 * 2;
    p.woutT = (bf16_t*)wb; wb += (size_t)2 * 1024 * 1024 * 2;
    p.wqT = (bf16_t*)wb; wb += (size_t)2 * 1024 * 1024 * 2;
    p.wgT = (bf16_t*)wb; wb += (size_t)2 * 1024 * 1024 * 2;
    p.wpT = (bf16_t*)wb; wb += (size_t)2 * 1024 * 256 * 2;
    p.gluT = (bf16_t*)wb; wb += (size_t)2 * 512 * 256 * 2;
  }
  p.rope = (float*)(ws + 497 * MiB);
  p.ssq = (float*)(ws + 501 * MiB);
  p.xloc = (float*)(ws + 502 * MiB);
  p.lru_hs = (float*)(ws + 504 * MiB);
  p.lru_ps = (float*)(ws + 504 * MiB + 256 * 256 * 4);
  p.g_cdec = (float*)(ws + 504 * MiB + 2 * 256 * 256 * 4);
  p.g_comp = (float*)(ws + 506 * MiB);
  p.pbf = (bf16_t*)(ws + 304 * MiB);
  p.bar = (unsigned*)(ws + 507 * MiB);

  static int grid_blocks = 0;
  if (!grid_blocks) {
#if MEGA
    hipFuncSetAttribute((const void*)k_mega, hipFuncAttributeMaxDynamicSharedMemorySize, LDS_BYTES);
#endif
#if !MEGA
    hipFuncSetAttribute((const void*)k_phase, hipFuncAttributeMaxDynamicSharedMemorySize, LDS_BYTES);
#endif
    int dev = 0, cus = 0, per_cu = 0;
    hipGetDevice(&dev);
    hipDeviceGetAttribute(&cus, hipDeviceAttributeMultiprocessorCount, dev);
#if MEGA
    hipOccupancyMaxActiveBlocksPerMultiprocessor(&per_cu, k_mega, NT, LDS_BYTES);
#else
    hipOccupancyMaxActiveBlocksPerMultiprocessor(&per_cu, k_phase, NT, LDS_BYTES);
#endif
    if (per_cu < 1) per_cu = 1;
    grid_blocks = cus * per_cu;
  }
#if MEGA
  hipMemsetAsync(p.bar, 0, XCD_BAR_WORDS * 4, stream);
  void* args[] = {&p};
  hipError_t e = hipLaunchCooperativeKernel((void*)k_mega, dim3(grid_blocks), dim3(NT), args, LDS_BYTES, stream);
  if (e != hipSuccess) fprintf(stderr, "cooperative launch failed: %s (grid %d)\n", hipGetErrorString(e), grid_blocks);
#else
  k_phase<<<grid_blocks, NT, LDS_BYTES, stream>>>(p, PH_PREP, 0);
  for (int l = 0; l < NL; ++l)
    for (int ph = PH_NORM1; ph <= PH_GEMM_PLE; ++ph) k_phase<<<grid_blocks, NT, LDS_BYTES, stream>>>(p, ph, l);
  k_phase<<<grid_blocks, NT, LDS_BYTES, stream>>>(p, PH_FINAL, 0);
#endif
}
```

```cpp
#include <hip/hip_runtime.h>
#include <hip/hip_bf16.h>
#include <hip/hip_cooperative_groups.h>
#include <cstdio>
#include <cstdint>
namespace cg = cooperative_groups;

#ifndef MEGA
#define MEGA 1
#endif

#ifndef PROBE_A
#define PROBE_A -1
#endif
#ifndef PROBE_B
#define PROBE_B -1
#endif
#define DEVI __device__ __forceinline__

typedef __attribute__((ext_vector_type(8))) short bf16x8;
typedef __attribute__((ext_vector_type(4))) float f32x4;
typedef unsigned short bf16_t;

constexpr int NT = 512;
constexpr int S_ = 16384, DM = 1024, NL = 2, PW = 2944, INW = 2824;
constexpr int RQ = 0, RK = 256, RV = 512, RG = 768, LG = 1024, LX = 1280, SU = 1536, DQ = 1792,
              DB = 2560, DA = 2564, DG = 2568;
constexpr float EPS = 1e-6f;
constexpr int LDS_BYTES = 132 * 1024;

struct Params {
  const float *x, *p; const int* pos;
  const float *mix_norm, *w_in, *ret_gn, *lru_conv_w, *lru_conv_b, *lru_w_a, *lru_b_a, *lru_w_x, *lru_b_x, *lru_lambda;
  const float *s5_a_re, *s5_a_im, *s5_b_re, *s5_b_im, *s5_c_re, *s5_c_im, *s5_d, *s5_log_dt, *s5_glu_w, *s5_glu_b;
  const float *gdn_conv_w, *gdn_a_log, *gdn_dt_bias, *gdn_norm, *branch_norm, *w_out, *ffn_norm, *peer_wq, *peer_subkeys;
  const float *peer_u, *peer_v, *ple_norm, *ple_wg, *ple_wp, *final_norm;
  float* out;
  float* h; bf16_t* zb; float* proj; float* qbuf; float* scores;
  float *g_u, *g_w, *g_attn, *g_qd, *g_kd, *g_sst, *g_cdec, *g_comp;
  int* ids; float* gates;
  float *lru_h, *lru_p, *lru_hs, *lru_ps;
  float* ret_kv; float* xloc;
  uint8_t *tabU, *tabV; float *uinv, *vinv;
  bf16_t *winT, *woutT, *wqT, *wgT, *wpT, *gluT;
  float* rope; float* ssq; bf16_t* pbf; unsigned* bar;
};

DEVI int TID() { int t = __builtin_amdgcn_workitem_id_x(); asm volatile("" : "+v"(t)); return t; }
DEVI bf16_t f2bf(float f) { unsigned u = __float_as_uint(f); u += 0x7FFFu + ((u >> 16) & 1u); return (bf16_t)(u >> 16); }
DEVI float bf2f(bf16_t b) { return __uint_as_float(((unsigned)b) << 16); }
DEVI unsigned pack2(float a, float b) { return (unsigned)f2bf(a) | ((unsigned)f2bf(b) << 16); }
DEVI float sigmoidf_(float x) { return 1.f / (1.f + expf(-x)); }
DEVI float siluf_(float x) { return x / (1.f + expf(-x)); }
DEVI float geluf_(float x) { float u = 0.7978845608028654f * (x + 0.044715f * x * x * x); return 0.5f * x * (1.f + tanhf(u)); }
DEVI float softplusf_(float x) { return x > 20.f ? x : log1pf(expf(x)); }
DEVI float wave_sum(float v) {
  v += __shfl_xor(v, 32); v += __shfl_xor(v, 16); v += __shfl_xor(v, 8);
  v += __shfl_xor(v, 4); v += __shfl_xor(v, 2); v += __shfl_xor(v, 1); return v;
}
DEVI float sum16(float v) {
  v += __shfl_xor(v, 8); v += __shfl_xor(v, 4); v += __shfl_xor(v, 2); v += __shfl_xor(v, 1); return v;
}

template <int NTL>
DEVI void mm16(f32x4 (&acc)[NTL], const float* A, int sam, int sak, const float* B, int sbk, int sbn, int K) {
  const int l = TID() & 63, r = l & 15, q = l >> 4;
  const float* ap = A + r * sam + q * sak;
  const float* bp = B + q * sbk + r * sbn;
#pragma unroll 4
  for (int k = 0; k < K; k += 4) {
    float a = ap[k * sak];
#pragma unroll
    for (int t = 0; t < NTL; ++t) {
      float b = bp[k * sbk + t * 16 * sbn];
      acc[t] = __builtin_amdgcn_mfma_f32_16x16x4f32(a, b, acc[t], 0, 0, 0);
    }
  }
}

template <int AMODE, int NK>
DEVI void gemm_tile(f32x4 (&acc)[4][4], const void* Aptr, int lda, const bf16_t* Bt, int ldb, int K, int m0, int n0,
                    const float* ssq, char* smem) {
  constexpr int LDT = 72, BUF = (256 + 128) * LDT;
  bf16_t* sbase = (bf16_t*)smem;
  const int tid = TID(), lane = tid & 63, wave = tid >> 6;
  const int wm = wave >> 1, wn = wave & 1, r = lane & 15, q = lane >> 4;
  const int lrow = tid >> 3, lkc = tid & 7;
  uint4 raS00, raS01, raS02, raS03, rbS00, rbS01, raS10, raS11, raS12, raS13, rbS10, rbS11, raS20, raS21, raS22, raS23, rbS20, rbS21;
  float rs0 = 1.f, rs1 = 1.f, rs2 = 1.f, rs3 = 1.f;
#pragma unroll
  for (int i = 0; i < 4; ++i)
#pragma unroll
    for (int j = 0; j < 4; ++j) acc[i][j] = f32x4{0.f, 0.f, 0.f, 0.f};
  const bf16_t* Ab = (const bf16_t*)Aptr + (size_t)(m0 + lrow) * lda + lkc * 8;
  const bf16_t* Bb = Bt + (size_t)(n0 + lrow) * ldb + lkc * 8;
#define GL(S, k0_)                                                    \
  {                                                                   \
    ra##S##0 = *(const uint4*)(Ab + (k0_));                           \
    ra##S##1 = *(const uint4*)(Ab + (size_t)64 * lda + (k0_));        \
    ra##S##2 = *(const uint4*)(Ab + (size_t)128 * lda + (k0_));       \
    ra##S##3 = *(const uint4*)(Ab + (size_t)192 * lda + (k0_));       \
    rb##S##0 = *(const uint4*)(Bb + (k0_));                           \
    rb##S##1 = *(const uint4*)(Bb + (size_t)64 * ldb + (k0_));        \
  }
  auto scale = [&](uint4 v, float s) {
    unsigned w[4] = {v.x, v.y, v.z, v.w};
#pragma unroll
    for (int j = 0; j < 4; ++j) {
      float lo = __uint_as_float(w[j] << 16) * s, hi = __uint_as_float(w[j] & 0xFFFF0000u) * s;
      w[j] = pack2(lo, hi);
    }
    return uint4{w[0], w[1], w[2], w[3]};
  };
  auto rowscale = [&](int row, int k0) {
    const float* sp = ssq + (size_t)(m0 + row) * 16;
    int seg = k0 >> 8;
    float s = seg == 0 ? (sp[0] + sp[1] + sp[2] + sp[3]) : seg == 1 ? sp[4] : seg == 2 ? sp[5] : (sp[8] + sp[9] + sp[10] + sp[11]);
    return rsqrtf(s * (1.f / 256.f) + EPS);
  };
#define LS(S, k0_, bi_)                                                               \
  {                                                                                   \
    bf16_t* As_ = sbase + (bi_) * BUF; bf16_t* Bs_ = As_ + 256 * LDT;                 \
    if constexpr (AMODE == 1) {                                                       \
      if (((k0_) & 255) == 0) {                                                       \
        rs0 = rowscale(lrow, (k0_)); rs1 = rowscale(lrow + 64, (k0_));                \
        rs2 = rowscale(lrow + 128, (k0_)); rs3 = rowscale(lrow + 192, (k0_));         \
      }                                                                               \
      ra##S##0 = scale(ra##S##0, rs0); ra##S##1 = scale(ra##S##1, rs1);               \
      ra##S##2 = scale(ra##S##2, rs2); ra##S##3 = scale(ra##S##3, rs3);               \
    }                                                                                 \
    *(uint4*)&As_[(lrow) * LDT + lkc * 8] = ra##S##0;                                 \
    *(uint4*)&As_[(lrow + 64) * LDT + lkc * 8] = ra##S##1;                            \
    *(uint4*)&As_[(lrow + 128) * LDT + lkc * 8] = ra##S##2;                           \
    *(uint4*)&As_[(lrow + 192) * LDT + lkc * 8] = ra##S##3;                           \
    *(uint4*)&Bs_[(lrow) * LDT + lkc * 8] = rb##S##0;                                 \
    *(uint4*)&Bs_[(lrow + 64) * LDT + lkc * 8] = rb##S##1;                            \
  }
  auto compute = [&](int bi) {
    const bf16_t* As = sbase + bi * BUF; const bf16_t* Bs = As + 256 * LDT;
#pragma unroll
    for (int kk = 0; kk < 2; ++kk) {
      bf16x8 a[4], b[4];
#pragma unroll
      for (int i = 0; i < 4; ++i) a[i] = *(const bf16x8*)&As[(wm * 64 + i * 16 + r) * LDT + kk * 32 + q * 8];
#pragma unroll
      for (int j = 0; j < 4; ++j) b[j] = *(const bf16x8*)&Bs[(wn * 64 + j * 16 + r) * LDT + kk * 32 + q * 8];
#pragma unroll
      for (int i = 0; i < 4; ++i)
#pragma unroll
        for (int j = 0; j < 4; ++j)
          acc[i][j] = __builtin_amdgcn_mfma_f32_16x16x32_bf16(b[j], a[i], acc[i][j], 0, 0, 0);
    }
  };

  __syncthreads();
  if constexpr (NK == 16 && AMODE == 1) {
    GL(S0, 0)
    LS(S0, 0, 0)
    GL(S1, 64)
    __syncthreads();
#pragma unroll 1
    for (int kt = 0; kt < NK; kt += 2) {
      compute(0);
      LS(S1, ((kt + 1) << 6), 1)
      if (kt + 2 < NK) GL(S0, ((kt + 2) << 6))
      __syncthreads();
      compute(1);
      if (kt + 2 < NK) { LS(S0, ((kt + 2) << 6), 0) GL(S1, ((kt + 3) << 6)) }
      __syncthreads();
    }
  } else if constexpr (NK == 16) {
    GL(S0, 0) GL(S1, 64) GL(S2, 128)
    LS(S0, 0, 0)
    GL(S0, 192)
    __syncthreads();
    compute(0);
    LS(S1, 64, 1)
    GL(S1, 256)
    __syncthreads();
    compute(1);
    LS(S2, 128, 0)
    GL(S2, 320)
    __syncthreads();
    compute(0);
    LS(S0, 192, 1)
    GL(S0, 384)
    __syncthreads();
    compute(1);
    LS(S1, 256, 0)
    GL(S1, 448)
    __syncthreads();
    compute(0);
    LS(S2, 320, 1)
    GL(S2, 512)
    __syncthreads();
    compute(1);
    LS(S0, 384, 0)
    GL(S0, 576)
    __syncthreads();
    compute(0);
    LS(S1, 448, 1)
    GL(S1, 640)
    __syncthreads();
    compute(1);
    LS(S2, 512, 0)
    GL(S2, 704)
    __syncthreads();
    compute(0);
    LS(S0, 576, 1)
    GL(S0, 768)
    __syncthreads();
    compute(1);
    LS(S1, 640, 0)
    GL(S1, 832)
    __syncthreads();
    compute(0);
    LS(S2, 704, 1)
    GL(S2, 896)
    __syncthreads();
    compute(1);
    LS(S0, 768, 0)
    GL(S0, 960)
    __syncthreads();
    compute(0);
    LS(S1, 832, 1)
    __syncthreads();
    compute(1);
    LS(S2, 896, 0)
    __syncthreads();
    compute(0);
    LS(S0, 960, 1)
    __syncthreads();
    compute(1);
    __syncthreads();
  } else {
    GL(S0, 0) GL(S1, 64) GL(S2, 128)
    LS(S0, 0, 0)
    GL(S0, 192)
    __syncthreads();
    compute(0);
    LS(S1, 64, 1)
    __syncthreads();
    compute(1);
    LS(S2, 128, 0)
    __syncthreads();
    compute(0);
    LS(S0, 192, 1)
    __syncthreads();
    compute(1);
    __syncthreads();
  }
#undef GL
#undef LS
}
#define GEMM_EPI_COORDS                                                   \
  const int lane_ = TID() & 63, wave_ = TID() >> 6;           \
  const int erow0 = m0 + (wave_ >> 1) * 64 + (lane_ & 15);                \
  const int ecol0 = n0 + (wave_ & 1) * 64 + (lane_ >> 4) * 4;

DEVI void transpose_tile(const float* W, int ldw, int nvalid, bf16_t* Bt, int ldbt, int k0, int n0, char* smem) {
  float* t = (float*)smem;
  const int tid = TID();
  {
    int i = tid >> 4, j4 = tid & 15;
#pragma unroll
    for (int h2 = 0; h2 < 2; ++h2) {
      int kk = i + 32 * h2;
      int n = n0 + j4 * 4;
      float4 v = float4{0.f, 0.f, 0.f, 0.f};
      if (n < nvalid) v = *(const float4*)&W[(size_t)(k0 + kk) * ldw + n];
      t[(j4 * 4 + 0) * 65 + kk] = v.x; t[(j4 * 4 + 1) * 65 + kk] = v.y;
      t[(j4 * 4 + 2) * 65 + kk] = v.z; t[(j4 * 4 + 3) * 65 + kk] = v.w;
    }
  }
  __syncthreads();
  {
    int n = tid >> 3, k8 = tid & 7;
    const float* s = &t[n * 65 + k8 * 8];
    uint4 v;
    v.x = pack2(s[0], s[1]); v.y = pack2(s[2], s[3]); v.z = pack2(s[4], s[5]); v.w = pack2(s[6], s[7]);
    *(uint4*)&Bt[(size_t)(n0 + n) * ldbt + k0 + k8 * 8] = v;
  }
  __syncthreads();
}

DEVI void convert_tables(const Params& p, int l) {
  const int lane = TID() & 63, wave = TID() >> 6;
  for (int rr = blockIdx.x * 8 + wave; rr < 2 * 16384; rr += gridDim.x * 8) {
    const int which = rr >> 14, row = rr & 16383;
    const float* src = (which ? p.peer_v : p.peer_u) + ((size_t)l * 16384 + row) * 1024 + lane * 16;
    float4 a = *(const float4*)src, b = *(const float4*)(src + 4), c = *(const float4*)(src + 8), d = *(const float4*)(src + 12);
    float m = fmaxf(fmaxf(fmaxf(fabsf(a.x), fabsf(a.y)), fmaxf(fabsf(a.z), fabsf(a.w))),
                    fmaxf(fmaxf(fabsf(b.x), fabsf(b.y)), fmaxf(fabsf(b.z), fabsf(b.w))));
    m = fmaxf(m, fmaxf(fmaxf(fmaxf(fabsf(c.x), fabsf(c.y)), fmaxf(fabsf(c.z), fabsf(c.w))),
                       fmaxf(fmaxf(fabsf(d.x), fabsf(d.y)), fmaxf(fabsf(d.z), fabsf(d.w)))));
    m = fmaxf(m, __shfl_xor(m, 32)); m = fmaxf(m, __shfl_xor(m, 16)); m = fmaxf(m, __shfl_xor(m, 8));
    m = fmaxf(m, __shfl_xor(m, 4)); m = fmaxf(m, __shfl_xor(m, 2)); m = fmaxf(m, __shfl_xor(m, 1));
    const float sc = m > 0.f ? 256.f / m : 1.f;
    int w0 = 0, w1 = 0, w2 = 0, w3 = 0;
    w0 = __builtin_amdgcn_cvt_pk_fp8_f32(a.x * sc, a.y * sc, w0, false); w0 = __builtin_amdgcn_cvt_pk_fp8_f32(a.z * sc, a.w * sc, w0, true);
    w1 = __builtin_amdgcn_cvt_pk_fp8_f32(b.x * sc, b.y * sc, w1, false); w1 = __builtin_amdgcn_cvt_pk_fp8_f32(b.z * sc, b.w * sc, w1, true);
    w2 = __builtin_amdgcn_cvt_pk_fp8_f32(c.x * sc, c.y * sc, w2, false); w2 = __builtin_amdgcn_cvt_pk_fp8_f32(c.z * sc, c.w * sc, w2, true);
    w3 = __builtin_amdgcn_cvt_pk_fp8_f32(d.x * sc, d.y * sc, w3, false); w3 = __builtin_amdgcn_cvt_pk_fp8_f32(d.z * sc, d.w * sc, w3, true);
    *(uint4*)((which ? p.tabV : p.tabU) + (size_t)row * 1024 + lane * 16) = uint4{(unsigned)w0, (unsigned)w1, (unsigned)w2, (unsigned)w3};
    if (lane == 0) (which ? p.vinv : p.uinv)[row] = m > 0.f ? m * (1.f / 256.f) : 1.f;
  }
}

DEVI void ph_prep(const Params& p, char* smem) {
  const size_t gtid = (size_t)blockIdx.x * NT + TID(), gsz = (size_t)gridDim.x * NT;
  for (size_t i = gtid; i < (size_t)S_ * 32; i += gsz) {
    int t = (int)(i >> 5), f = (int)(i & 31);
    float inv = powf(10000.f, -(float)f / 32.f);
    float ang = (float)p.pos[t] * inv;
    p.rope[2 * i] = cosf(ang); p.rope[2 * i + 1] = sinf(ang);
  }
  for (int it = blockIdx.x; it < 2 * 1600; it += gridDim.x) {
    int l = it / 1600, idx = it % 1600;
    if (idx >= 1568) {
      int j = idx - 1568; int kt = j >> 3, nt = j & 7;
      transpose_tile(p.s5_glu_w + (size_t)l * 256 * 512, 512, 512, p.gluT + (size_t)l * 512 * 256, 256, kt * 64, nt * 64, smem);
    } else if (idx < 736) {
      int kt = idx / 46, nt = idx % 46;
      transpose_tile(p.w_in + (size_t)l * 1024 * INW, INW, INW, p.winT + (size_t)l * PW * 1024, 1024, kt * 64, nt * 64, smem);
    } else if (idx < 1504) {
      int j = idx - 736; int which = j >> 8; j &= 255;
      int kt = j >> 4, nt = j & 15;
      const float* src = (which == 0 ? p.w_out : which == 1 ? p.peer_wq : p.ple_wg) + (size_t)l * 1024 * 1024;
      bf16_t* dst = (which == 0 ? p.woutT : which == 1 ? p.wqT : p.wgT) + (size_t)l * 1024 * 1024;
      transpose_tile(src, 1024, 1024, dst, 1024, kt * 64, nt * 64, smem);
    } else {
      int j = idx - 1504; int kt = j >> 4, nt = j & 15;
      transpose_tile(p.ple_wp + (size_t)l * 256 * 1024, 1024, 1024, p.wpT + (size_t)l * 1024 * 256, 256, kt * 64, nt * 64, smem);
    }
  }
}

DEVI void ph_norm(const float* src, const float* g, bf16_t* dst, float* fout) {
  const int lane = TID() & 63, wave = TID() >> 6;
  for (int t = blockIdx.x * 8 + wave; t < S_; t += gridDim.x * 8) {
    const float* row = src + (size_t)t * DM;
    float4 v[4]; float ss = 0.f;
#pragma unroll
    for (int i = 0; i < 4; ++i) {
      v[i] = *(const float4*)&row[i * 256 + lane * 4];
      ss += v[i].x * v[i].x + v[i].y * v[i].y + v[i].z * v[i].z + v[i].w * v[i].w;
    }
    ss = wave_sum(ss);
    float rs = rsqrtf(ss * (1.f / DM) + EPS);
#pragma unroll
    for (int i = 0; i < 4; ++i) {
      float4 gg = *(const float4*)&g[i * 256 + lane * 4];
      float a = v[i].x * rs * gg.x, b = v[i].y * rs * gg.y, c = v[i].z * rs * gg.z, d = v[i].w * rs * gg.w;
      if (dst) *(uint2*)&dst[(size_t)t * DM + i * 256 + lane * 4] = uint2{pack2(a, b), pack2(c, d)};
      else *(float4*)&fout[(size_t)t * DM + i * 256 + lane * 4] = float4{a, b, c, d};
    }
  }
}

DEVI void gdn_prep(const Params& p, int l, int item, char* smem) {
  const int c = item >> 2, hd = item & 3, t0 = c * 64;
  float* sq = (float*)smem; float* sk = sq + 64 * 65; float* sv = sk + 64 * 65;
  float* sL = sv + 64 * 65;
  float* sgc = sL + 64 * 68; float* sbeta = sgc + 64;
  const int tid = TID(), lane = tid & 63, wave = tid >> 6, r = lane & 15, qd = lane >> 4;
  const float* cw = p.gdn_conv_w + (size_t)l * 4 * 768;
  for (int i = tid; i < 3 * 64 * 64; i += NT) {
    int d = i & 63, t = (i >> 6) & 63, which = i >> 12;
    int ch = which * 256 + hd * 64 + d;
    float acc = 0.f;
#pragma unroll
    for (int j = 0; j < 4; ++j) {
      int tt = t0 + t - 3 + j;
      if (tt >= 0) acc += cw[j * 768 + ch] * p.proj[(size_t)tt * PW + DQ + ch];
    }
    float v = siluf_(acc);
    (which == 0 ? sq : which == 1 ? sk : sv)[t * 65 + d] = v;
  }
  __syncthreads();
  {
    const int rw = tid >> 2, part = tid & 3, t = rw & 63;
    float* row = (rw < 64 ? sq : sk) + t * 65 + part * 16;
    float s = 0.f;
#pragma unroll
    for (int d = 0; d < 16; ++d) s += row[d] * row[d];
    s += __shfl_xor(s, 1); s += __shfl_xor(s, 2);
    float sc = rsqrtf(s + EPS) * (rw < 64 ? 0.125f : 1.f);
#pragma unroll
    for (int d = 0; d < 16; ++d) row[d] *= sc;
  }
  if (wave == 2) {
    int t = tid - 128;
    float bl = p.proj[(size_t)(t0 + t) * PW + DB + hd];
    float al = p.proj[(size_t)(t0 + t) * PW + DA + hd];
    float la = -expf(p.gdn_a_log[l * 4 + hd]) * softplusf_(al + p.gdn_dt_bias[l * 4 + hd]);
    for (int off = 1; off < 64; off <<= 1) { float n = __shfl_up(la, off); if (lane >= off) la += n; }
    sgc[t] = la; sbeta[t] = sigmoidf_(bl);
  }
  __syncthreads();
  {
    int mat = wave >> 2, mt = wave & 3;
    f32x4 acc[4];
#pragma unroll
    for (int t = 0; t < 4; ++t) acc[t] = f32x4{0.f, 0.f, 0.f, 0.f};
    mm16<4>(acc, (mat == 0 ? sk : sq) + mt * 16 * 65, 65, 1, sk, 1, 65, 64);
#pragma unroll
    for (int t = 0; t < 4; ++t)
#pragma unroll
      for (int e = 0; e < 4; ++e) {
        int i = mt * 16 + 4 * qd + e, j = t * 16 + r;
        float g = (i >= j) ? expf(sgc[i] - sgc[j]) : 0.f;
        if (mat == 0) sL[i * 68 + j] = (i > j) ? acc[t][e] * sbeta[i] * g : 0.f;
        else p.g_attn[((size_t)item * 64 + i) * 64 + j] = (i >= j) ? acc[t][e] * g : 0.f;
      }
  }
  __syncthreads();
  if (tid < 128) {
    const bool isv = tid < 64; const int d = tid & 63;
    float X[64];
#pragma unroll
    for (int i = 0; i < 64; ++i) X[i] = 0.f;
    float* dst = (isv ? p.g_u : p.g_w) + (size_t)item * 4096 + d;
#pragma unroll
    for (int i = 0; i < 64; ++i) {
      float bi = sbeta[i];
      float s = isv ? sv[i * 65 + d] * bi : sk[i * 65 + d] * bi * expf(sgc[i]);
      float s1 = 0.f, s2 = 0.f, s3 = 0.f;
#pragma unroll
      for (int j4 = 0; j4 < (i + 3) / 4; ++j4) {
        float4 lv = *(const float4*)&sL[i * 68 + j4 * 4];
        s -= lv.x * X[j4 * 4 + 0]; s1 -= lv.y * X[j4 * 4 + 1]; s2 -= lv.z * X[j4 * 4 + 2]; s3 -= lv.w * X[j4 * 4 + 3];
      }
      s = (s + s1) + (s2 + s3);
      X[i] = s;
      dst[i * 64] = s;
    }
  } else {
    for (int i2 = tid - 128; i2 < 8192; i2 += 384) {
      int which = i2 >> 12, i = (i2 >> 6) & 63, d = i2 & 63;
      float val = which == 0 ? sq[i * 65 + d] * expf(sgc[i]) : sk[i * 65 + d] * expf(sgc[63] - sgc[i]);
      (which == 0 ? p.g_qd : p.g_kd)[(size_t)item * 4096 + i * 64 + d] = val;
    }
    if (tid == 128) p.g_cdec[item] = expf(sgc[63]);
  }
  __syncthreads();
}

DEVI f32x4 mm16_k64(const float* A, int sam, int sak, const float* B, int sbk, int sbn) {
  const int l = TID() & 63, r = l & 15, q = l >> 4;
  const float* ap = A + r * sam + q * sak;
  const float* bp = B + q * sbk + r * sbn;
  float av[16], bv[16];
#pragma unroll
  for (int k = 0; k < 16; ++k) { av[k] = ap[4 * k * sak]; bv[k] = bp[4 * k * sbk]; }
  f32x4 c0 = f32x4{0.f, 0.f, 0.f, 0.f}, c1 = f32x4{0.f, 0.f, 0.f, 0.f};
#pragma unroll
  for (int k = 0; k < 16; k += 2) {
    c0 = __builtin_amdgcn_mfma_f32_16x16x4f32(av[k], bv[k], c0, 0, 0, 0);
    c1 = __builtin_amdgcn_mfma_f32_16x16x4f32(av[k + 1], bv[k + 1], c1, 0, 0, 0);
  }
  return c0 + c1;
}

template <int MODE>
DEVI void gdn_chain(const Params& p, int hd, int grp, int cb, char* smem) {
  float* base = (float*)smem;
  constexpr int BUFSZ = 64 * 68 * 2 + 64 * 16;
  float* sS = base + 2 * BUFSZ; float* sVN = sS + 1024;
  const int tid = TID(), lane = tid & 63, wave = tid >> 6, r = lane & 15, qd = lane >> 4;
  const bool apart = (MODE == 0) && (cb >= 4);
  const int e0 = (cb & 3) * 16;
  const int c0 = grp * 32;
  float4 pw0, pw1, pkd0, pkd1, pu = float4{0.f, 0.f, 0.f, 0.f};
  const int lr0 = tid >> 4, lc0 = (tid & 15) * 4, lr1 = lr0 + 32;
  const int ur = tid >> 2, uc = (tid & 3) * 4;
#define GLOAD(c_)                                                            \
  {                                                                          \
    size_t b_ = (size_t)((c_) * 4 + hd) * 4096;                              \
    pw0 = *(const float4*)&p.g_w[b_ + lr0 * 64 + lc0];                       \
    pw1 = *(const float4*)&p.g_w[b_ + lr1 * 64 + lc0];                       \
    pkd0 = *(const float4*)&p.g_kd[b_ + lr0 * 64 + lc0];                     \
    pkd1 = *(const float4*)&p.g_kd[b_ + lr1 * 64 + lc0];                     \
    if (tid < 256 && !apart) pu = *(const float4*)&p.g_u[b_ + ur * 64 + e0 + uc]; \
  }
#define LSTORE(bi_)                                                          \
  {                                                                          \
    float* W_ = base + (bi_) * BUFSZ; float* KD_ = W_ + 64 * 68; float* U_ = KD_ + 64 * 68; \
    *(float4*)&W_[lr0 * 68 + lc0] = pw0; *(float4*)&W_[lr1 * 68 + lc0] = pw1;       \
    *(float4*)&KD_[lr0 * 68 + lc0] = pkd0; *(float4*)&KD_[lr1 * 68 + lc0] = pkd1;   \
    if (tid < 256) *(float4*)&U_[ur * 16 + uc] = pu;                         \
  }
  f32x4 sreg = f32x4{0.f, 0.f, 0.f, 0.f};
  if (MODE == 0) {
    for (int i = tid; i < 1024; i += NT) sS[i] = (apart && ((i >> 4) == e0 + (i & 15))) ? 1.f : 0.f;
    if (apart) {
#pragma unroll
      for (int e = 0; e < 4; ++e) sreg[e] = ((wave & 3) * 16 + 4 * qd + e == e0 + r) ? 1.f : 0.f;
    }
  } else {
    for (int i = tid; i < 1024; i += NT) sS[i] = 0.f;
    float* W = base;
    for (int g2 = 0; g2 < grp; ++g2) {
      const float* Ag = p.g_comp + ((size_t)(hd * 8 + g2) * 2 + 1) * 4096;
      const float* Bg = p.g_comp + ((size_t)(hd * 8 + g2) * 2 + 0) * 4096;
      __syncthreads();
      *(float4*)&W[lr0 * 68 + lc0] = *(const float4*)&Ag[lr0 * 64 + lc0];
      *(float4*)&W[lr1 * 68 + lc0] = *(const float4*)&Ag[lr1 * 64 + lc0];
      __syncthreads();
      f32x4 a = f32x4{0.f, 0.f, 0.f, 0.f};
      if (wave < 4) a = mm16_k64(W + wave * 16 * 68, 68, 1, sS, 16, 1);
      __syncthreads();
      if (wave < 4) {
#pragma unroll
        for (int e = 0; e < 4; ++e) {
          int d = wave * 16 + 4 * qd + e;
          sreg[e] = a[e] + Bg[d * 64 + e0 + r];
          sS[d * 16 + r] = sreg[e];
        }
      }
    }
    __syncthreads();
    if (wave < 4) {
#pragma unroll
      for (int e = 0; e < 4; ++e) {
        int d = wave * 16 + 4 * qd + e;
        p.g_sst[(size_t)(c0 * 4 + hd) * 4096 + d * 64 + e0 + r] = sreg[e];
      }
    }
  }
  GLOAD(c0) LSTORE(0)
  __syncthreads();
  for (int cc = 0; cc < 32; ++cc) {
    const int c = c0 + cc;
    if (cc + 1 < 32) GLOAD(c + 1)
    const float cd = p.g_cdec[c * 4 + hd];
    float* W = base + (cc & 1) * BUFSZ; float* KD = W + 64 * 68; float* U = KD + 64 * 68;
    const size_t it = (size_t)(c * 4 + hd);
    if (wave < 4) {
      f32x4 a1 = mm16_k64(W + wave * 16 * 68, 68, 1, sS, 16, 1);
#pragma unroll
      for (int e = 0; e < 4; ++e) {
        int i = wave * 16 + 4 * qd + e;
        float vn = (apart ? 0.f : U[i * 16 + r]) - a1[e];
        sVN[i * 16 + r] = vn;
        if (MODE == 1) p.g_u[it * 4096 + i * 64 + e0 + r] = vn;
      }
    }
    __syncthreads();
    if (wave < 4) {
      f32x4 a2 = mm16_k64(KD + wave * 16, 1, 68, sVN, 16, 1);
#pragma unroll
      for (int e = 0; e < 4; ++e) {
        int d = wave * 16 + 4 * qd + e;
        sreg[e] = sreg[e] * cd + a2[e];
        sS[d * 16 + r] = sreg[e];
        if (MODE == 1 && cc + 1 < 32) p.g_sst[(size_t)((c + 1) * 4 + hd) * 4096 + d * 64 + e0 + r] = sreg[e];
      }
    }
    if (cc + 1 < 32) LSTORE((cc + 1) & 1)
    __syncthreads();
  }
  if (MODE == 0 && wave < 4) {
    float* dst = p.g_comp + ((size_t)(hd * 8 + grp) * 2 + (apart ? 1 : 0)) * 4096;
#pragma unroll
    for (int e = 0; e < 4; ++e) {
      int d = wave * 16 + 4 * qd + e;
      dst[d * 64 + e0 + r] = sreg[e];
    }
  }
  __syncthreads();
}

DEVI void gdn_out(const Params& p, int l, int item, char* smem) {
  const int c = item >> 2, hd = item & 3, t0 = c * 64;
  float* sQD = (float*)smem; float* sS = sQD + 64 * 68; float* sAT = sS + 64 * 68; float* sVN = sAT + 64 * 68;
  const int tid = TID(), lane = tid & 63, wave = tid >> 6, r = lane & 15, qd = lane >> 4;
  const size_t b = (size_t)item * 4096;
  for (int idx = tid; idx < 1024; idx += NT) {
    int row = idx >> 4, c4 = idx & 15;
    *(float4*)&sQD[row * 68 + c4 * 4] = *(const float4*)&p.g_qd[b + row * 64 + c4 * 4];
    *(float4*)&sS[row * 68 + c4 * 4] = *(const float4*)&p.g_sst[b + row * 64 + c4 * 4];
    *(float4*)&sAT[row * 68 + c4 * 4] = *(const float4*)&p.g_attn[b + row * 64 + c4 * 4];
    *(float4*)&sVN[row * 68 + c4 * 4] = *(const float4*)&p.g_u[b + row * 64 + c4 * 4];
  }
  __syncthreads();
  const int mt = wave & 3, nh = wave >> 2;
  f32x4 acc[2]; acc[0] = acc[1] = f32x4{0.f, 0.f, 0.f, 0.f};
  mm16<2>(acc, sQD + mt * 16 * 68, 68, 1, sS + nh * 32, 68, 1, 64);
  mm16<2>(acc, sAT + mt * 16 * 68, 68, 1, sVN + nh * 32, 68, 1, 64);
  __syncthreads();
  float* sO = sQD;
#pragma unroll
  for (int t2 = 0; t2 < 2; ++t2)
#pragma unroll
    for (int e = 0; e < 4; ++e) sO[(mt * 16 + 4 * qd + e) * 68 + nh * 32 + t2 * 16 + r] = acc[t2][e];
  __syncthreads();
  {
    int row = tid >> 3, sub = tid & 7, t = t0 + row;
    float o[8], yv[8]; float ss = 0.f;
#pragma unroll
    for (int k = 0; k < 8; ++k) { o[k] = sO[row * 68 + sub * 8 + k]; ss += o[k] * o[k]; }
    ss += __shfl_xor(ss, 1); ss += __shfl_xor(ss, 2); ss += __shfl_xor(ss, 4);
    float rs = rsqrtf(ss * (1.f / 64.f) + EPS);
    float s2 = 0.f;
#pragma unroll
    for (int k = 0; k < 8; ++k) {
      int col = sub * 8 + k;
      float g = p.proj[(size_t)t * PW + DG + hd * 64 + col];
      float y = o[k] * rs * p.gdn_norm[l * 64 + col] * siluf_(g);
      s2 += y * y;
      yv[k] = y * p.branch_norm[(l * 4 + 3) * 256 + hd * 64 + col];
    }
    s2 += __shfl_xor(s2, 1); s2 += __shfl_xor(s2, 2); s2 += __shfl_xor(s2, 4);
    if (sub == 0) p.ssq[(size_t)t * 16 + 8 + hd] = s2;
    *(uint4*)&p.zb[(size_t)t * DM + 768 + hd * 64 + sub * 8] =
        uint4{pack2(yv[0], yv[1]), pack2(yv[2], yv[3]), pack2(yv[4], yv[5]), pack2(yv[6], yv[7])};
  }
  __syncthreads();
}

DEVI void ret_kv(const Params& p, int l, int item, char* smem) {
  const int c = item >> 2, hd = item & 3, t0 = c * 128;
  float* sK = (float*)smem; float* sV = sK + 128 * 65;
  const int tid = TID(), lane = tid & 63, wave = tid >> 6, r = lane & 15, qd = lane >> 4;
  const float lg = logf(1.f - exp2f(-5.f - (float)hd));
  for (int i = tid; i < 128 * 32; i += NT) {
    int t = i >> 5, f = i & 31; size_t tt = t0 + t;
    float k1 = p.proj[tt * PW + RK + hd * 64 + f], k2 = p.proj[tt * PW + RK + hd * 64 + 32 + f];
    float cs = p.rope[(tt * 32 + f) * 2], sn = p.rope[(tt * 32 + f) * 2 + 1];
    float dec = expf(lg * (float)(127 - t));
    sK[t * 65 + f] = (k1 * cs - k2 * sn) * dec;
    sK[t * 65 + 32 + f] = (k2 * cs + k1 * sn) * dec;
  }
  for (int i = tid; i < 128 * 64; i += NT) {
    int t = i >> 6, e = i & 63;
    sV[t * 65 + e] = p.proj[(size_t)(t0 + t) * PW + RV + hd * 64 + e];
  }
  __syncthreads();
  const int mt = wave & 3, nh = wave >> 2;
  f32x4 acc[2]; acc[0] = acc[1] = f32x4{0.f, 0.f, 0.f, 0.f};
  mm16<2>(acc, sK + mt * 16, 1, 65, sV + nh * 32, 65, 1, 128);
#pragma unroll
  for (int t2 = 0; t2 < 2; ++t2)
#pragma unroll
    for (int e = 0; e < 4; ++e)
      p.ret_kv[(size_t)item * 4096 + (mt * 16 + 4 * qd + e) * 64 + nh * 32 + t2 * 16 + r] = acc[t2][e];
  __syncthreads();
}

DEVI void ret_out(const Params& p, int l, int item, char* smem) {
  const int c = item >> 2, hd = item & 3, t0 = c * 128;
  float* sQ = (float*)smem; float* sK = sQ + 128 * 65; float* sV = sK + 128 * 65; float* sSt = sV + 128 * 65;
  const int tid = TID(), lane = tid & 63, wave = tid >> 6, r = lane & 15, qd = lane >> 4;
  const float lg = logf(1.f - exp2f(-5.f - (float)hd));
  {
    const float* ssrc = p.ret_kv + (size_t)(c * 4 + hd) * 4096;
#pragma unroll
    for (int j = 0; j < 8; ++j) { int idx = tid + 512 * j; sSt[(idx >> 6) * 65 + (idx & 63)] = ssrc[idx]; }
  }
  for (int i = tid; i < 128 * 32; i += NT) {
    int t = i >> 5, f = i & 31; size_t tt = t0 + t;
    float cs = p.rope[(tt * 32 + f) * 2], sn = p.rope[(tt * 32 + f) * 2 + 1];
    float k1 = p.proj[tt * PW + RK + hd * 64 + f], k2 = p.proj[tt * PW + RK + hd * 64 + 32 + f];
    sK[t * 65 + f] = (k1 * cs - k2 * sn);
    sK[t * 65 + 32 + f] = (k2 * cs + k1 * sn);
    float q1 = p.proj[tt * PW + RQ + hd * 64 + f], q2 = p.proj[tt * PW + RQ + hd * 64 + 32 + f];
    sQ[t * 65 + f] = (q1 * cs - q2 * sn) * 0.125f;
    sQ[t * 65 + 32 + f] = (q2 * cs + q1 * sn) * 0.125f;
  }
  for (int i = tid; i < 128 * 64; i += NT) {
    int t = i >> 6, e = i & 63;
    sV[t * 65 + e] = p.proj[(size_t)(t0 + t) * PW + RV + hd * 64 + e];
  }
  __syncthreads();
  const int i0 = wave * 16;
  f32x4 sc[8], os[4];
#pragma unroll
  for (int t = 0; t < 8; ++t) sc[t] = f32x4{0.f, 0.f, 0.f, 0.f};
#pragma unroll
  for (int t = 0; t < 4; ++t) os[t] = f32x4{0.f, 0.f, 0.f, 0.f};
  mm16<8>(sc, sQ + i0 * 65, 65, 1, sK, 1, 65, 64);
  mm16<4>(os, sQ + i0 * 65, 65, 1, sSt, 65, 1, 64);
  __syncthreads();
  float* sP = (float*)smem;
#pragma unroll
  for (int t2 = 0; t2 < 8; ++t2)
#pragma unroll
    for (int e = 0; e < 4; ++e) {
      int i = i0 + 4 * qd + e, j = t2 * 16 + r;
      sP[i * 129 + j] = (i >= j) ? sc[t2][e] * expf(lg * (float)(i - j)) : 0.f;
    }
  __syncthreads();
  f32x4 o[4];
#pragma unroll
  for (int t2 = 0; t2 < 4; ++t2)
#pragma unroll
    for (int e = 0; e < 4; ++e) o[t2][e] = os[t2][e] * expf(lg * (float)(i0 + 4 * qd + e + 1));
  mm16<4>(o, sP + i0 * 129, 129, 1, sV, 65, 1, 128);
#pragma unroll
  for (int e = 0; e < 4; ++e) {
    int i = i0 + 4 * qd + e; size_t t = t0 + i;
    float sm = sum16(o[0][e] + o[1][e] + o[2][e] + o[3][e]);
    float mu = sm * (1.f / 64.f);
    float vr = 0.f;
#pragma unroll
    for (int t2 = 0; t2 < 4; ++t2) { float dd = o[t2][e] - mu; vr += dd * dd; }
    vr = sum16(vr);
    float rstd = rsqrtf(vr * (1.f / 64.f) + EPS);
    float ss = 0.f;
#pragma unroll
    for (int t2 = 0; t2 < 4; ++t2) {
      int col = hd * 64 + t2 * 16 + r;
      float on = (o[t2][e] - mu) * rstd * p.ret_gn[l * 256 + col];
      float g = p.proj[t * PW + RG + col];
      float y = siluf_(g) * on;
      ss += y * y;
      p.zb[t * DM + col] = f2bf(y * p.branch_norm[(l * 4 + 0) * 256 + col]);
    }
    ss = sum16(ss);
    if (r == 0) p.ssq[t * 16 + hd] = ss;
  }
  __syncthreads();
}

DEVI void lru_local(const Params& p, int l, int c, char* smem) {
  const int t0 = c * 64;
  float* sX = (float*)smem; float* sA = sX + 64 * 257;
  const int tid = TID(), lane = tid & 63, wave = tid >> 6, r = lane & 15, qd = lane >> 4;
  for (int i = tid; i < 64 * 256; i += NT) {
    int t = i >> 8, ch = i & 255;
    float acc = p.lru_conv_b[l * 256 + ch];
#pragma unroll
    for (int j = 0; j < 4; ++j) {
      int tt = t0 + t - 3 + j;
      if (tt >= 0) acc += p.lru_conv_w[(l * 4 + j) * 256 + ch] * p.proj[(size_t)tt * PW + LX + ch];
    }
    sX[t * 257 + ch] = acc;
  }
  __syncthreads();
  for (int pr = 0; pr < 2; ++pr) {
    int pi = wave * 2 + pr, mt = pi & 3, nb = pi >> 2;
    f32x4 ra[4], ri[4];
#pragma unroll
    for (int t = 0; t < 4; ++t) { ra[t] = f32x4{0.f, 0.f, 0.f, 0.f}; ri[t] = f32x4{0.f, 0.f, 0.f, 0.f}; }
    mm16<4>(ra, sX + mt * 16 * 257 + nb * 64, 257, 1, p.lru_w_a + (size_t)(l * 4 + nb) * 4096, 64, 1, 64);
    mm16<4>(ri, sX + mt * 16 * 257 + nb * 64, 257, 1, p.lru_w_x + (size_t)(l * 4 + nb) * 4096, 64, 1, 64);
#pragma unroll
    for (int t2 = 0; t2 < 4; ++t2)
#pragma unroll
      for (int e = 0; e < 4; ++e) {
        int t = mt * 16 + 4 * qd + e, ch = nb * 64 + t2 * 16 + r;
        float xb = sX[t * 257 + ch];
        float rr = sigmoidf_(ra[t2][e] + p.lru_b_a[l * 256 + ch]);
        float ii = sigmoidf_(ri[t2][e] + p.lru_b_x[l * 256 + ch]);
        float loga = -8.f * rr * softplusf_(-p.lru_lambda[l * 256 + ch]);
        float a = expf(loga);
        float bb = sqrtf(-expm1f(2.f * loga)) * (ii * xb);
        sA[t * 257 + ch] = a; sX[t * 257 + ch] = bb;
      }
  }
  __syncthreads();
  if (tid < 256) {
    int ch = tid; float H = 0.f, P = 1.f;
    for (int t = 0; t < 64; ++t) {
      float a = sA[t * 257 + ch], bb = sX[t * 257 + ch];
      H = a * H + bb; P *= a;
      p.lru_h[(size_t)(t0 + t) * 256 + ch] = H; p.lru_p[(size_t)(t0 + t) * 256 + ch] = P;
    }
    p.lru_hs[c * 256 + ch] = H; p.lru_ps[c * 256 + ch] = P;
  }
  __syncthreads();
}

DEVI void lru_out(const Params& p, int l, int c, char* smem) {
  const int t0 = c * 64;
  float* sC = (float*)smem;
  const int tid = TID(), lane = tid & 63, wave = tid >> 6;
  if (tid < 256) sC[tid] = p.lru_hs[c * 256 + tid];
  __syncthreads();
  for (int tk = 0; tk < 8; ++tk) {
    size_t t = t0 + wave * 8 + tk; int ch = lane * 4;
    float4 H = *(const float4*)&p.lru_h[t * 256 + ch], P = *(const float4*)&p.lru_p[t * 256 + ch];
    float4 g = *(const float4*)&p.proj[t * PW + LG + ch], cr = *(const float4*)&sC[ch];
    float4 bn = *(const float4*)&p.branch_norm[(l * 4 + 1) * 256 + ch];
    float y0 = geluf_(g.x) * (H.x + P.x * cr.x), y1 = geluf_(g.y) * (H.y + P.y * cr.y);
    float y2 = geluf_(g.z) * (H.z + P.z * cr.z), y3 = geluf_(g.w) * (H.w + P.w * cr.w);
    float ss = wave_sum(y0 * y0 + y1 * y1 + y2 * y2 + y3 * y3);
    if (lane == 0) p.ssq[t * 16 + 4] = ss;
    *(uint2*)&p.zb[t * DM + 256 + ch] = uint2{pack2(y0 * bn.x, y1 * bn.y), pack2(y2 * bn.z, y3 * bn.w)};
  }
  __syncthreads();
}

DEVI void s5_coef(const Params& p, int l, int g, int n, float& abr, float& abi, float (&bbr)[16], float (&bbi)[16]) {
  float dt = expf(p.s5_log_dt[l * 16 + g]);
  float are = p.s5_a_re[(l * 16 + g) * 64 + n], aim = p.s5_a_im[(l * 16 + g) * 64 + n];
  float mag = expf(are * dt), ang = aim * dt;
  abr = mag * cosf(ang); abi = mag * sinf(ang);
  float den = are * are + aim * aim;
  float pre = abr - 1.f, pim = abi;
  float fre = (pre * are + pim * aim) / den, fim = (pim * are - pre * aim) / den;
  const float4* br = (const float4*)(p.s5_b_re + (size_t)((l * 16 + g) * 64 + n) * 16);
  const float4* bi = (const float4*)(p.s5_b_im + (size_t)((l * 16 + g) * 64 + n) * 16);
#pragma unroll
  for (int c4 = 0; c4 < 4; ++c4) {
    float4 a = br[c4], b = bi[c4];
    bbr[c4 * 4 + 0] = fre * a.x - fim * b.x; bbi[c4 * 4 + 0] = fre * b.x + fim * a.x;
    bbr[c4 * 4 + 1] = fre * a.y - fim * b.y; bbi[c4 * 4 + 1] = fre * b.y + fim * a.y;
    bbr[c4 * 4 + 2] = fre * a.z - fim * b.z; bbi[c4 * 4 + 2] = fre * b.z + fim * a.z;
    bbr[c4 * 4 + 3] = fre * a.w - fim * b.w; bbi[c4 * 4 + 3] = fre * b.w + fim * a.w;
  }
}
DEVI void s5_load_u(const Params& p, int t0, float* sU) {
  for (int i = TID(); i < 64 * 64; i += NT) {
    int t = i >> 6, c4 = i & 63;
    *(float4*)&sU[t * 256 + c4 * 4] = *(const float4*)&p.proj[(size_t)(t0 + t) * PW + SU + c4 * 4];
  }
}
DEVI void s5_bu(const float* up, const float (&bbr)[16], const float (&bbi)[16], float& bur, float& bui) {
  bur = 0.f; bui = 0.f;
#pragma unroll
  for (int c4 = 0; c4 < 4; ++c4) {
    float4 u = *(const float4*)&up[c4 * 4];
    bur += bbr[c4 * 4] * u.x + bbr[c4 * 4 + 1] * u.y + bbr[c4 * 4 + 2] * u.z + bbr[c4 * 4 + 3] * u.w;
    bui += bbi[c4 * 4] * u.x + bbi[c4 * 4 + 1] * u.y + bbi[c4 * 4 + 2] * u.z + bbi[c4 * 4 + 3] * u.w;
  }
}

DEVI void s5_local(const Params& p, int l, int c, char* smem) {
  const int t0 = c * 64;
  float* sU = (float*)smem;
  const int lane = TID() & 63, wave = TID() >> 6;
  s5_load_u(p, t0, sU);
  __syncthreads();
  for (int gi = 0; gi < 2; ++gi) {
    int g = wave + 8 * gi;
    float abr, abi, bbr[16], bbi[16];
    s5_coef(p, l, g, lane, abr, abi, bbr, bbi);
    float xr = 0.f, xi = 0.f;
    for (int t = 0; t < 64; ++t) {
      float bur, bui; s5_bu(sU + t * 256 + g * 16, bbr, bbi, bur, bui);
      float nr = abr * xr - abi * xi + bur, ni = abr * xi + abi * xr + bui;
      xr = nr; xi = ni;
    }
    *(float2*)&p.xloc[((size_t)(c * 16 + g) * 64 + lane) * 2] = float2{xr, xi};
  }
  __syncthreads();
}

DEVI void s5_out(const Params& p, int l, int c, char* smem) {
  const int t0 = c * 64;
  bf16_t* sY = (bf16_t*)smem;
  float* sX = (float*)(smem + 64 * 264 * 2);
  const int tid = TID(), lane = tid & 63, wave = tid >> 6, r = lane & 15, qd = lane >> 4;
  float* Xl = sX + wave * (16 * 132);
  for (int gi = 0; gi < 2; ++gi) {
    const int g = wave + 8 * gi;
    float abr, abi, bbr[16], bbi[16];
    s5_coef(p, l, g, lane, abr, abi, bbr, bbi);
    float breg[32];
#pragma unroll
    for (int ks = 0; ks < 16; ++ks) {
      breg[ks] = p.s5_c_re[(size_t)((l * 16 + g) * 16 + r) * 64 + 4 * ks + qd];
      breg[16 + ks] = -p.s5_c_im[(size_t)((l * 16 + g) * 16 + r) * 64 + 4 * ks + qd];
    }
    const float dd = p.s5_d[l * 256 + g * 16 + r];
    const float2 xin = *(const float2*)&p.xloc[((size_t)(c * 16 + g) * 64 + lane) * 2];
    float xr = xin.x, xi = xin.y;
    float4 uvecs[4]; float ues[4][4];
#pragma unroll
    for (int tb = 0; tb < 4; ++tb) {
      const float* ub = p.proj + (size_t)(t0 + tb * 16) * PW + SU + g * 16;
      uvecs[tb] = *(const float4*)&ub[(size_t)r * PW + 4 * qd];
#pragma unroll
      for (int e = 0; e < 4; ++e) ues[tb][e] = ub[(size_t)(4 * qd + e) * PW + r];
    }
#pragma unroll
    for (int tb = 0; tb < 4; ++tb) {
      const float4 uvec = uvecs[tb];
      float ue[4];
#pragma unroll
      for (int e = 0; e < 4; ++e) ue[e] = ues[tb][e];
      const int u0 = __float_as_int(uvec.x), u1 = __float_as_int(uvec.y), u2 = __float_as_int(uvec.z), u3 = __float_as_int(uvec.w);
#pragma unroll
      for (int tt = 0; tt < 16; ++tt) {
        float bur = 0.f, bui = 0.f;
#pragma unroll
        for (int c4 = 0; c4 < 4; ++c4) {
          float a0 = __int_as_float(__builtin_amdgcn_readlane(u0, tt + 16 * c4));
          float a1 = __int_as_float(__builtin_amdgcn_readlane(u1, tt + 16 * c4));
          float a2 = __int_as_float(__builtin_amdgcn_readlane(u2, tt + 16 * c4));
          float a3 = __int_as_float(__builtin_amdgcn_readlane(u3, tt + 16 * c4));
          bur += bbr[c4 * 4] * a0 + bbr[c4 * 4 + 1] * a1 + bbr[c4 * 4 + 2] * a2 + bbr[c4 * 4 + 3] * a3;
          bui += bbi[c4 * 4] * a0 + bbi[c4 * 4 + 1] * a1 + bbi[c4 * 4 + 2] * a2 + bbi[c4 * 4 + 3] * a3;
        }
        float nr = abr * xr - abi * xi + bur, ni = abr * xi + abi * xr + bui;
        xr = nr; xi = ni;
        Xl[tt * 132 + lane] = xr; Xl[tt * 132 + 64 + lane] = xi;
      }
      f32x4 acc = f32x4{0.f, 0.f, 0.f, 0.f};
#pragma unroll
      for (int ks = 0; ks < 32; ++ks) {
        float a = Xl[r * 132 + 4 * ks + qd];
        acc = __builtin_amdgcn_mfma_f32_16x16x4f32(a, breg[ks], acc, 0, 0, 0);
      }
#pragma unroll
      for (int e = 0; e < 4; ++e) {
        float y = acc[e] + dd * ue[e];
        sY[(tb * 16 + 4 * qd + e) * 264 + g * 16 + r] = f2bf(geluf_(y));
      }
    }
  }
  __syncthreads();
  f32x4 av[4][2], ag[4][2];
#pragma unroll
  for (int i = 0; i < 4; ++i)
#pragma unroll
    for (int j = 0; j < 2; ++j) { av[i][j] = f32x4{0.f, 0.f, 0.f, 0.f}; ag[i][j] = f32x4{0.f, 0.f, 0.f, 0.f}; }
  const bf16_t* WT = p.gluT + (size_t)l * 512 * 256;
#pragma unroll 4
  for (int ks = 0; ks < 8; ++ks) {
    bf16x8 bv0 = *(const bf16x8*)&WT[(size_t)(32 * wave + r) * 256 + ks * 32 + qd * 8];
    bf16x8 bv1 = *(const bf16x8*)&WT[(size_t)(32 * wave + 16 + r) * 256 + ks * 32 + qd * 8];
    bf16x8 bg0 = *(const bf16x8*)&WT[(size_t)(256 + 32 * wave + r) * 256 + ks * 32 + qd * 8];
    bf16x8 bg1 = *(const bf16x8*)&WT[(size_t)(256 + 32 * wave + 16 + r) * 256 + ks * 32 + qd * 8];
#pragma unroll
    for (int mt = 0; mt < 4; ++mt) {
      bf16x8 a = *(const bf16x8*)&sY[(mt * 16 + r) * 264 + ks * 32 + qd * 8];
      av[mt][0] = __builtin_amdgcn_mfma_f32_16x16x32_bf16(a, bv0, av[mt][0], 0, 0, 0);
      av[mt][1] = __builtin_amdgcn_mfma_f32_16x16x32_bf16(a, bv1, av[mt][1], 0, 0, 0);
      ag[mt][0] = __builtin_amdgcn_mfma_f32_16x16x32_bf16(a, bg0, ag[mt][0], 0, 0, 0);
      ag[mt][1] = __builtin_amdgcn_mfma_f32_16x16x32_bf16(a, bg1, ag[mt][1], 0, 0, 0);
    }
  }
  float* sO = sX;
#pragma unroll
  for (int mt = 0; mt < 4; ++mt)
#pragma unroll
    for (int t2 = 0; t2 < 2; ++t2)
#pragma unroll
      for (int e = 0; e < 4; ++e) {
        int t = mt * 16 + 4 * qd + e, col = 32 * wave + t2 * 16 + r;
        float zv = av[mt][t2][e] + p.s5_glu_b[l * 512 + col];
        float zg = ag[mt][t2][e] + p.s5_glu_b[l * 512 + 256 + col];
        sO[t * 256 + col] = zv * sigmoidf_(zg);
      }
  __syncthreads();
  for (int tk = 0; tk < 8; ++tk) {
    int tl = wave * 8 + tk; size_t t = t0 + tl; int ch = lane * 4;
    float4 o = *(const float4*)&sO[tl * 256 + ch];
    float4 bn = *(const float4*)&p.branch_norm[(l * 4 + 2) * 256 + ch];
    float ss = wave_sum(o.x * o.x + o.y * o.y + o.z * o.z + o.w * o.w);
    if (lane == 0) p.ssq[t * 16 + 5] = ss;
    *(uint2*)&p.zb[t * DM + 512 + ch] = uint2{pack2(o.x * bn.x, o.y * bn.y), pack2(o.z * bn.z, o.w * bn.w)};
  }
  __syncthreads();
}

DEVI void ret_scan(const Params& p, int it) {
  const int elem = it * NT + TID(), hd = elem >> 12, idx = elem & 4095;
  const float lg = logf(1.f - exp2f(-5.f - (float)hd)), cdk = expf(lg * 128.f);
  float* base = p.ret_kv + (size_t)hd * 4096 + idx;
  float s = 0.f;
  for (int cb = 0; cb < 128; cb += 16) {
    float v[16];
#pragma unroll
    for (int j = 0; j < 16; ++j) v[j] = base[(size_t)(cb + j) * 16384];
#pragma unroll
    for (int j = 0; j < 16; ++j) { base[(size_t)(cb + j) * 16384] = s; s = s * cdk + v[j]; }
  }
}
DEVI void s5_scan(const Params& p, int l, int it) {
  const int sidx = it * NT + TID(), g = sidx >> 6, n = sidx & 63;
  float dt = expf(p.s5_log_dt[l * 16 + g]);
  float are = p.s5_a_re[(l * 16 + g) * 64 + n], aim = p.s5_a_im[(l * 16 + g) * 64 + n];
  float mag = expf(are * dt), ang = aim * dt;
  float pr = mag * cosf(ang), pi = mag * sinf(ang);
#pragma unroll
  for (int k = 0; k < 6; ++k) { float nr = pr * pr - pi * pi, ni = 2.f * pr * pi; pr = nr; pi = ni; }
  float2* base = (float2*)p.xloc + sidx;
  float xr = 0.f, xi = 0.f;
  for (int cb = 0; cb < 256; cb += 16) {
    float2 v[16];
#pragma unroll
    for (int j = 0; j < 16; ++j) v[j] = base[(size_t)(cb + j) * 1024];
#pragma unroll
    for (int j = 0; j < 16; ++j) {
      base[(size_t)(cb + j) * 1024] = float2{xr, xi};
      float nr = pr * xr - pi * xi + v[j].x, ni = pr * xi + pi * xr + v[j].y;
      xr = nr; xi = ni;
    }
  }
}
DEVI void lru_scan(const Params& p) {
  const int ch = TID();
  if (ch < 256) {
    float carry = 0.f;
    for (int cb = 0; cb < 256; cb += 16) {
      float ps[16], hs[16];
#pragma unroll
      for (int j = 0; j < 16; ++j) { ps[j] = p.lru_ps[(cb + j) * 256 + ch]; hs[j] = p.lru_hs[(cb + j) * 256 + ch]; }
#pragma unroll
      for (int j = 0; j < 16; ++j) { p.lru_hs[(cb + j) * 256 + ch] = carry; carry = ps[j] * carry + hs[j]; }
    }
  }
}

DEVI void peer_scores(const Params& p, int l, int item, char* smem) {
  const int hp = item & 15, grp = item >> 4;
  float* sQ = (float*)smem;
  float* sKy = sQ + 64 * 68;
  const int tid = TID(), lane = tid & 63, wave = tid >> 6, r = lane & 15, qd = lane >> 4;
  const float* ky = p.peer_subkeys + (size_t)(l * 16 + hp) * 8192;
  for (int i = tid; i < 128 * 64; i += NT) { int k = i >> 6, d = i & 63; sKy[k * 65 + d] = ky[i]; }
  const int lt0 = tid >> 4, lc4 = (tid & 15) * 4;
  const float* qb = p.qbuf + (size_t)hp * 64 + lc4;
  float4 q0, q1;
  {
    const size_t t0 = (size_t)(grp * 16) * 64;
    q0 = *(const float4*)&qb[(t0 + lt0) * 1024]; q1 = *(const float4*)&qb[(t0 + lt0 + 32) * 1024];
  }
  const int mt = wave & 3, nh = wave >> 2;
  for (int k = 0; k < 16; ++k) {
    const size_t t0 = (size_t)(grp * 16 + k) * 64;
    __syncthreads();
    *(float4*)&sQ[lt0 * 68 + lc4] = q0; *(float4*)&sQ[(lt0 + 32) * 68 + lc4] = q1;
    __syncthreads();
    if (k + 1 < 16) { q0 = *(const float4*)&qb[(t0 + 64 + lt0) * 1024]; q1 = *(const float4*)&qb[(t0 + 64 + lt0 + 32) * 1024]; }
    f32x4 acc[4];
#pragma unroll
    for (int t = 0; t < 4; ++t) acc[t] = f32x4{0.f, 0.f, 0.f, 0.f};
    mm16<4>(acc, sQ + mt * 16 * 68, 68, 1, sKy + nh * 64 * 65, 1, 65, 64);
#pragma unroll
    for (int t2 = 0; t2 < 4; ++t2)
#pragma unroll
      for (int e = 0; e < 4; ++e) {
        size_t t = t0 + mt * 16 + 4 * qd + e; int key = nh * 64 + t2 * 16 + r;
        p.scores[(t * 16 + hp) * 128 + key] = acc[t2][e];
      }
  }
  __syncthreads();
}

DEVI unsigned ford(float x) { unsigned u = __float_as_uint(x); return (u & 0x80000000u) ? ~u : (u | 0x80000000u); }
DEVI float funord(unsigned u) { return __uint_as_float((u & 0x80000000u) ? (u ^ 0x80000000u) : ~u); }
DEVI void ins16(unsigned (&v)[16], unsigned x) {
#pragma unroll
  for (int j = 0; j < 16; ++j) { unsigned hi = max(v[j], x); x = min(v[j], x); v[j] = hi; }
}

DEVI void peer_topk(const Params& p, int item, char* smem) {
  const int t0 = item * 64;
  float* sS = (float*)smem;
  const int tid = TID();
  const float* base = p.scores + (size_t)t0 * 8 * 256;
  unsigned v1[16], v2[16];
#pragma unroll
  for (int j = 0; j < 16; ++j) { v1[j] = 0u; v2[j] = 0u; }
  for (int s = 0; s < 8; ++s) {
    __syncthreads();
#pragma unroll
    for (int i = 0; i < 8; ++i) {
      int idx = tid + 512 * i, pr = idx >> 3, c4 = idx & 7;
      float4 v = *(const float4*)&base[(size_t)pr * 256 + s * 32 + c4 * 4];
      float* d = &sS[pr * 33 + c4 * 4];
      d[0] = v.x; d[1] = v.y; d[2] = v.z; d[3] = v.w;
    }
    __syncthreads();
    const int kb = (s & 3) * 32;
    if (s < 4) {
      for (int k = 0; k < 32; ++k) { unsigned key = (ford(sS[tid * 33 + k]) & ~127u) | (unsigned)(127 - (kb + k)); ins16(v1, key); }
    } else {
      for (int k = 0; k < 32; ++k) { unsigned key = (ford(sS[tid * 33 + k]) & ~127u) | (unsigned)(127 - (kb + k)); ins16(v2, key); }
    }
  }
  __syncthreads();
  unsigned* sI = (unsigned*)smem;
  float s1[16], s2[16];
#pragma unroll
  for (int a = 0; a < 16; ++a) {
    s1[a] = funord(v1[a] & ~127u); s2[a] = funord(v2[a] & ~127u);
    sI[tid * 33 + a] = 127u - (v1[a] & 127u); sI[tid * 33 + 16 + a] = 127u - (v2[a] & 127u);
  }
  unsigned vt[16];
#pragma unroll
  for (int j = 0; j < 16; ++j) vt[j] = 0u;
#pragma unroll
  for (int a = 0; a < 16; ++a)
#pragma unroll
    for (int b = 0; b < 16; ++b)
      if ((a + 1) * (b + 1) <= 16) {
        unsigned key = (ford(s1[a] + s2[b]) & ~255u) | (unsigned)(255 - (a * 16 + b));
        ins16(vt, key);
      }
  float sv[16]; float den = 0.f;
  const float mx = funord(vt[0] & ~255u);
#pragma unroll
  for (int k = 0; k < 16; ++k) { sv[k] = expf(funord(vt[k] & ~255u) - mx); den += sv[k]; }
  const float inv = 1.f / den;
  const int tl = tid >> 3, hh = tid & 7;
  int* idp = p.ids + (size_t)(t0 + tl) * 128 + hh * 16;
  float* gp = p.gates + (size_t)(t0 + tl) * 128 + hh * 16;
#pragma unroll
  for (int k = 0; k < 16; ++k) {
    unsigned pos = 255u - (vt[k] & 255u);
    unsigned i1 = sI[tid * 33 + (pos >> 4)], i2 = sI[tid * 33 + 16 + (pos & 15)];
    idp[k] = (int)(i1 * 128u + i2);
    gp[k] = sv[k] * inv;
  }
  __syncthreads();
}

typedef __attribute__((ext_vector_type(2))) float f32x2;
DEVI void fp8x16_to_f(const uint4& v, float (&o)[16]) {
  f32x2 t;
  t = __builtin_amdgcn_cvt_pk_f32_fp8((int)v.x, false); o[0] = t[0]; o[1] = t[1];
  t = __builtin_amdgcn_cvt_pk_f32_fp8((int)v.x, true); o[2] = t[0]; o[3] = t[1];
  t = __builtin_amdgcn_cvt_pk_f32_fp8((int)v.y, false); o[4] = t[0]; o[5] = t[1];
  t = __builtin_amdgcn_cvt_pk_f32_fp8((int)v.y, true); o[6] = t[0]; o[7] = t[1];
  t = __builtin_amdgcn_cvt_pk_f32_fp8((int)v.z, false); o[8] = t[0]; o[9] = t[1];
  t = __builtin_amdgcn_cvt_pk_f32_fp8((int)v.z, true); o[10] = t[0]; o[11] = t[1];
  t = __builtin_amdgcn_cvt_pk_f32_fp8((int)v.w, false); o[12] = t[0]; o[13] = t[1];
  t = __builtin_amdgcn_cvt_pk_f32_fp8((int)v.w, true); o[14] = t[0]; o[15] = t[1];
}

DEVI void ph_gather(const Params& p, int l) {
  const int lane = TID() & 63, wave = TID() >> 6;
  const int e0 = lane * 16;
  constexpr int NB = 8;
  for (int t = blockIdx.x * 8 + wave; t < S_; t += gridDim.x * 8) {
    float* hrow = p.h + (size_t)t * DM + e0;
    float z[16], out[16];
    {
      float4 a = *(const float4*)&hrow[0], b = *(const float4*)&hrow[4], c = *(const float4*)&hrow[8], d = *(const float4*)&hrow[12];
      z[0] = a.x; z[1] = a.y; z[2] = a.z; z[3] = a.w; z[4] = b.x; z[5] = b.y; z[6] = b.z; z[7] = b.w;
      z[8] = c.x; z[9] = c.y; z[10] = c.z; z[11] = c.w; z[12] = d.x; z[13] = d.y; z[14] = d.z; z[15] = d.w;
    }
    float ss = 0.f;
#pragma unroll
    for (int k = 0; k < 16; ++k) { ss += z[k] * z[k]; out[k] = 0.f; }
    ss = wave_sum(ss);
    const float rs = rsqrtf(ss * (1.f / DM) + EPS);
    const float* fn = p.ffn_norm + l * DM + e0;
#pragma unroll
    for (int k = 0; k < 16; ++k) z[k] = z[k] * rs * fn[k];
    const int id0 = p.ids[(size_t)t * 128 + lane], id1 = p.ids[(size_t)t * 128 + 64 + lane];
    const int gv0 = __float_as_int(p.gates[(size_t)t * 128 + lane] * p.vinv[id0]);
    const int gv1 = __float_as_int(p.gates[(size_t)t * 128 + 64 + lane] * p.vinv[id1]);
    const int us0 = __float_as_int(p.uinv[id0]), us1 = __float_as_int(p.uinv[id1]);
    uint4 cu[NB], cv[NB], nu[NB], nv[NB];
#pragma unroll
    for (int j = 0; j < NB; ++j) {
      int e = __builtin_amdgcn_readlane(id0, j);
      cu[j] = *(const uint4*)(p.tabU + (size_t)e * 1024 + e0);
      cv[j] = *(const uint4*)(p.tabV + (size_t)e * 1024 + e0);
    }
#pragma unroll 1
    for (int b = 0; b < 128 / NB; ++b) {
      const int nb = b + 1;
      if (nb < 128 / NB) {
        const int idn = nb < 64 / NB ? id0 : id1;
#pragma unroll
        for (int j = 0; j < NB; ++j) {
          int e = __builtin_amdgcn_readlane(idn, (nb * NB + j) & 63);
          nu[j] = *(const uint4*)(p.tabU + (size_t)e * 1024 + e0);
          nv[j] = *(const uint4*)(p.tabV + (size_t)e * 1024 + e0);
        }
      }
      const int gvc = b < 64 / NB ? gv0 : gv1, usc = b < 64 / NB ? us0 : us1;
      float dot[NB];
#pragma unroll
      for (int j = 0; j < NB; ++j) {
        float f[16]; fp8x16_to_f(cu[j], f);
        float d = 0.f;
#pragma unroll
        for (int k = 0; k < 16; ++k) d += z[k] * f[k];
        dot[j] = d;
      }
#pragma unroll
      for (int j = 0; j < NB; ++j) dot[j] = wave_sum(dot[j]);
#pragma unroll
      for (int j = 0; j < NB; ++j) {
        const int li = (b * NB + j) & 63;
        float us = __int_as_float(__builtin_amdgcn_readlane(usc, li));
        float gt = __int_as_float(__builtin_amdgcn_readlane(gvc, li));
        float cf = gt * geluf_(dot[j] * us);
        float f[16]; fp8x16_to_f(cv[j], f);
#pragma unroll
        for (int k = 0; k < 16; ++k) out[k] += cf * f[k];
      }
#pragma unroll
      for (int j = 0; j < NB; ++j) { cu[j] = nu[j]; cv[j] = nv[j]; }
    }
    float hv[16];
    {
      float4 a = *(const float4*)&hrow[0], b = *(const float4*)&hrow[4], c = *(const float4*)&hrow[8], d = *(const float4*)&hrow[12];
      hv[0] = a.x; hv[1] = a.y; hv[2] = a.z; hv[3] = a.w; hv[4] = b.x; hv[5] = b.y; hv[6] = b.z; hv[7] = b.w;
      hv[8] = c.x; hv[9] = c.y; hv[10] = c.z; hv[11] = c.w; hv[12] = d.x; hv[13] = d.y; hv[14] = d.z; hv[15] = d.w;
    }
    float s2 = 0.f;
#pragma unroll
    for (int k = 0; k < 16; ++k) { hv[k] += out[k]; s2 += hv[k] * hv[k]; }
    *(float4*)&hrow[0] = float4{hv[0], hv[1], hv[2], hv[3]}; *(float4*)&hrow[4] = float4{hv[4], hv[5], hv[6], hv[7]};
    *(float4*)&hrow[8] = float4{hv[8], hv[9], hv[10], hv[11]}; *(float4*)&hrow[12] = float4{hv[12], hv[13], hv[14], hv[15]};
    s2 = wave_sum(s2);
    const float rs2 = rsqrtf(s2 * (1.f / DM) + EPS);
    const float* pn = p.ple_norm + l * DM + e0;
    float zz[16];
#pragma unroll
    for (int k = 0; k < 16; ++k) zz[k] = hv[k] * rs2 * pn[k];
    bf16_t* zrow = p.zb + (size_t)t * DM + e0;
    *(uint4*)&zrow[0] = uint4{pack2(zz[0], zz[1]), pack2(zz[2], zz[3]), pack2(zz[4], zz[5]), pack2(zz[6], zz[7])};
    *(uint4*)&zrow[8] = uint4{pack2(zz[8], zz[9]), pack2(zz[10], zz[11]), pack2(zz[12], zz[13]), pack2(zz[14], zz[15])};
  }
}

template <class F>
DEVI void gemm_tiles(int NTn, int XM, int XN, F&& f) {
  int G = gridDim.x, B = blockIdx.x;
  asm volatile("" : "+s"(G), "+s"(B));
  if (G & 7) { for (int tile = B; tile < 64 * NTn; tile += G) f(tile / NTn, tile % NTn); return; }
  const int x = B & 7, slot = B >> 3, ns = G >> 3;
  const int xm = x / XN, xn = x % XN;
  const int mcnt = 64 / XM, mb = xm * mcnt;
  const int ncnt = (NTn - xn + XN - 1) / XN;
  for (int j = slot; j < mcnt * ncnt; j += ns) f(mb + j / ncnt, xn + XN * (j % ncnt));
}

enum { PH_PREP = 0, PH_NORM1, PH_GEMM_IN, PH_MIX_A, PH_MIX_B, PH_MIX_C, PH_MIX_D, PH_GEMM_OUT, PH_NORM2, PH_GEMM_Q, PH_SCORES,
       PH_TOPK, PH_GATHER, PH_GEMM_PLE, PH_FINAL };

#if PROBE_A >= 0
#define REGION(id, stmt)                                                                                   \
  {                                                                                                        \
    const bool on_ = (blockIdx.x == 255 && TID() == 0 && ((id) == PROBE_A || (id) == PROBE_B));              \
    if (on_) p.g_cdec[2051] = (float)(wall_clock64() & 0xFFFFFFull);                                       \
    stmt;                                                                                                  \
    if (on_) {                                                                                             \
      float dt_ = (float)(wall_clock64() & 0xFFFFFFull) - p.g_cdec[2051];                                  \
      if (dt_ < 0.f) dt_ += 16777216.f;                                                                    \
      p.g_cdec[(id) == PROBE_A ? 2048 : 2049] += dt_;                                                      \
    }                                                                                                      \
  }
#else
#define REGION(id, stmt) { stmt; }
#endif
DEVI void run_phase(const Params& p, int ph, int l, char* smem) {
  int G = gridDim.x, B = blockIdx.x;
  asm volatile("" : "+s"(G), "+s"(B));
  switch (ph) {
    case PH_PREP: ph_prep(p, smem); break;
    case PH_NORM1: ph_norm(l == 0 ? p.x : p.h, p.mix_norm + l * DM, p.zb, nullptr); break;
    case PH_GEMM_IN:
      gemm_tiles(23, 1, 8, [&](int mt_, int nt_) __attribute__((always_inline)) {
        int m0 = mt_ * 256, n0 = nt_ * 128;
        f32x4 acc[4][4];
        gemm_tile<0, 16>(acc, p.zb, DM, p.winT + (size_t)l * PW * 1024, 1024, 1024, m0, n0, nullptr, smem);
        GEMM_EPI_COORDS
#pragma unroll
        for (int i = 0; i < 4; ++i)
#pragma unroll
          for (int j = 0; j < 4; ++j)
            *(f32x4*)&p.proj[(size_t)(erow0 + i * 16) * PW + ecol0 + j * 16] = acc[i][j];
      });
      break;
    case PH_MIX_A:
      for (int it = B; it < 2048; it += G) {
        if (it < 1024) REGION(105, gdn_prep(p, l, it, smem))
        else if (it < 1536) REGION(106, ret_kv(p, l, it - 1024, smem))
        else if (it < 1792) REGION(107, lru_local(p, l, it - 1536, smem))
        else REGION(108, s5_local(p, l, it - 1792, smem))
      }
      break;
    case PH_MIX_B:
      for (int it = B; it < 256 + 35; it += G) {
        if (it < 256) { const int pr_ = (it & 7) * 4 + (it >> 6), cb_ = (it >> 3) & 7; REGION(100, gdn_chain<0>(p, pr_ >> 3, pr_ & 7, cb_, smem)) }
        else if (it < 256 + 32) ret_scan(p, it - 256);
        else if (it < 256 + 34) s5_scan(p, l, it - 288);
        else lru_scan(p);
      }
      break;
    case PH_MIX_C: {
      for (int it = B; it < 128; it += G) {
        const int pr_ = (it & 7) * 4 + (it >> 5), cb_ = (it >> 3) & 3;
        REGION(102, gdn_chain<1>(p, pr_ >> 3, pr_ & 7, cb_, smem))
      }
      int jb = B, js = G, je = 1024;
      if (G == 256) {
        js = 1;
        if (B < 128) { jb = 640 + B * 3; je = jb + 3; } else { jb = (B - 128) * 5; je = jb + 5; }
      }
      for (int j = jb; j < je; j += js) {
        const int ty = j & 3, q4 = j >> 2;
        if (ty < 2) REGION(101, ret_out(p, l, q4 * 2 + ty, smem))
        else if (ty == 2) REGION(103, s5_out(p, l, q4, smem))
        else REGION(104, lru_out(p, l, q4, smem))
      }
    } break;
    case PH_MIX_D:
      for (int it = B; it < 1024; it += G) REGION(109, gdn_out(p, l, it, smem))
      break;
    case PH_GEMM_OUT:
      gemm_tiles(8, 4, 2, [&](int mt_, int nt_) __attribute__((always_inline)) {
        int m0 = mt_ * 256, n0 = nt_ * 128;
        f32x4 acc[4][4];
        gemm_tile<1, 16>(acc, p.zb, DM, p.woutT + (size_t)l * 1024 * 1024, 1024, 1024, m0, n0, p.ssq, smem);
        GEMM_EPI_COORDS
#pragma unroll
        for (int i = 0; i < 4; ++i)
#pragma unroll
          for (int j = 0; j < 4; ++j) {
            const size_t ho = (size_t)(erow0 + i * 16) * DM + ecol0 + j * 16;
            *(f32x4*)&p.h[ho] = *(const f32x4*)&(l == 0 ? p.x : p.h)[ho] + acc[i][j];
          }
      });
      break;
    case PH_NORM2:
      ph_norm(p.h, p.ffn_norm + l * DM, p.zb, nullptr);
      convert_tables(p, l);
      {
        const size_t gtid = (size_t)B * NT + TID(), gsz = (size_t)G * NT;
        const float4* sp = (const float4*)(p.p + (size_t)l * S_ * 256);
        for (size_t i = gtid; i < (size_t)S_ * 256 / 8; i += gsz) {
          float4 a = sp[2 * i], b = sp[2 * i + 1];
          ((uint4*)p.pbf)[i] = uint4{pack2(a.x, a.y), pack2(a.z, a.w), pack2(b.x, b.y), pack2(b.z, b.w)};
        }
      }
      break;
    case PH_GEMM_Q:
      gemm_tiles(8, 4, 2, [&](int mt_, int nt_) __attribute__((always_inline)) {
        int m0 = mt_ * 256, n0 = nt_ * 128;
        f32x4 acc[4][4];
        gemm_tile<0, 16>(acc, p.zb, DM, p.wqT + (size_t)l * 1024 * 1024, 1024, 1024, m0, n0, nullptr, smem);
        GEMM_EPI_COORDS
#pragma unroll
        for (int i = 0; i < 4; ++i)
#pragma unroll
          for (int j = 0; j < 4; ++j)
            *(f32x4*)&p.qbuf[(size_t)(erow0 + i * 16) * DM + ecol0 + j * 16] = acc[i][j];
      });
      break;
    case PH_SCORES:
      for (int it = B; it < 256; it += G) REGION(110, peer_scores(p, l, it, smem))
      break;
    case PH_TOPK:
      for (int it = B; it < 256; it += G) REGION(111, peer_topk(p, it, smem))
      break;
    case PH_GATHER: ph_gather(p, l); break;
    case PH_GEMM_PLE:
      gemm_tiles(8, 4, 2, [&](int mt_, int nt_) __attribute__((always_inline)) {
        int m0 = mt_ * 256, n0 = nt_ * 128;
        uint2* gsc = (uint2*)p.g_attn + (size_t)B * 16 * NT + TID();
        {
          f32x4 ag[4][4];
          gemm_tile<0, 16>(ag, p.zb, DM, p.wgT + (size_t)l * 1024 * 1024, 1024, 1024, m0, n0, nullptr, smem);
#pragma unroll
          for (int i = 0; i < 4; ++i)
#pragma unroll
            for (int j = 0; j < 4; ++j)
              gsc[(i * 4 + j) * NT] = uint2{pack2(sigmoidf_(ag[i][j][0]), sigmoidf_(ag[i][j][1])),
                                            pack2(sigmoidf_(ag[i][j][2]), sigmoidf_(ag[i][j][3]))};
        }
        f32x4 ap[4][4];
        gemm_tile<0, 4>(ap, p.pbf, 256, p.wpT + (size_t)l * 1024 * 256, 256, 256, m0, n0, nullptr, smem);
        GEMM_EPI_COORDS
#pragma unroll
        for (int i = 0; i < 4; ++i)
#pragma unroll
          for (int j = 0; j < 4; ++j) {
            f32x4* hp = (f32x4*)&p.h[(size_t)(erow0 + i * 16) * DM + ecol0 + j * 16];
            f32x4 hv = *hp;
            const uint2 gk = gsc[(i * 4 + j) * NT];
            hv[0] += ap[i][j][0] * __uint_as_float(gk.x << 16);
            hv[1] += ap[i][j][1] * __uint_as_float(gk.x & 0xFFFF0000u);
            hv[2] += ap[i][j][2] * __uint_as_float(gk.y << 16);
            hv[3] += ap[i][j][3] * __uint_as_float(gk.y & 0xFFFF0000u);
            *hp = hv;
          }
      });
      break;
    case PH_FINAL: ph_norm(p.h, p.final_norm, nullptr, p.out); break;
  }
}

#if !MEGA
__global__ void __launch_bounds__(NT) k_phase(Params p, int ph, int l) {
  extern __shared__ __align__(16) char smem[];
  run_phase(p, ph, l, smem);
}
#endif

#define XB_TMO      128
#define XB_XCNT(j)  (256  + 64 * (j))
#define XB_XSUB(j)  (1280 + 64 * (j))
#define XB_XGEN(j)  (2304 + 64 * (j))
#define XB_TOP      3328
#define XB_TOPGEN   3392
#define XCD_BAR_WORDS 3456
#define XB_SPIN_CAP (1u << 18)
#define LAS __attribute__((address_space(3)))
DEVI unsigned xb_ld(unsigned* p) { return __hip_atomic_load(p, __ATOMIC_RELAXED, __HIP_MEMORY_SCOPE_AGENT); }
DEVI unsigned xb_add(unsigned* p, unsigned v) { return __hip_atomic_fetch_add(p, v, __ATOMIC_RELAXED, __HIP_MEMORY_SCOPE_AGENT); }
DEVI unsigned xb_xcc_id() { return (unsigned)__builtin_amdgcn_s_getreg((3 << 11) | 20) & 0xFu; }
#define XB_SPIN(cond, bar) do { unsigned _sp = 0; while (cond) { __builtin_amdgcn_s_sleep(1); \
    if ((++_sp & 255u) == 0u) { if (xb_ld(&(bar)[XB_TMO])) break; if (_sp > XB_SPIN_CAP) { atomicAdd(&(bar)[XB_TMO], 1u); break; } } } } while (0)
struct XcdBarrier { unsigned* bar; unsigned x; volatile LAS unsigned* st; };
DEVI XcdBarrier xcd_barrier_post(unsigned* bar, volatile LAS unsigned* st) {
  XcdBarrier b; b.bar = bar; b.x = xb_xcc_id(); b.st = st;
  if (TID() == 0) (void)xb_add(&bar[XB_XCNT(b.x)], 1u);
  return b;
}
DEVI void xcd_barrier_complete(unsigned* bar, unsigned x, unsigned& nloc, unsigned& nx) {
  const unsigned G = gridDim.x * gridDim.y * gridDim.z;
  unsigned sum, cnt, mine, sp = 0u;
  for (;;) {
    sum = 0u; cnt = 0u; mine = 0u;
#pragma unroll
    for (unsigned j = 0; j < 16; ++j) { const unsigned c = xb_ld(&bar[XB_XCNT(j)]); sum += c; cnt += (c > 0u) ? 1u : 0u; mine = (j == x) ? c : mine; }
    if (sum == G) break;
    __builtin_amdgcn_s_sleep(1);
    if ((++sp & 255u) == 0u) { if (xb_ld(&bar[XB_TMO])) break; if (sp > XB_SPIN_CAP) { atomicAdd(&bar[XB_TMO], 1u); break; } }
  }
  nloc = mine > 0u ? mine : 1u; nx = cnt > 0u ? cnt : 1u;
}
DEVI void xcd_barrier(const XcdBarrier& b) {
  asm volatile("s_waitcnt vmcnt(0)" ::: "memory");
  __syncthreads();
  if (TID() == 0) {
    unsigned* bar = b.bar;
    __builtin_amdgcn_s_waitcnt(0);
    unsigned nloc = b.st[0], nx = b.st[1];
    if (nloc == 0u) { xcd_barrier_complete(bar, b.x, nloc, nx); b.st[0] = nloc; b.st[1] = nx; }
    const unsigned old = xb_add(&bar[XB_XSUB(b.x)], 1u);
    const unsigned gen = old / nloc;
    if (old + 1u == (gen + 1u) * nloc) {
      __builtin_amdgcn_fence(__ATOMIC_RELEASE, "agent");
      asm volatile("s_waitcnt vmcnt(0)" ::: "memory");
      const unsigned og = xb_add(&bar[XB_TOP], 1u);
      const unsigned tg = og / nx;
      if (og + 1u == (tg + 1u) * nx) xb_add(&bar[XB_TOPGEN], 1u);
      else XB_SPIN(xb_ld(&bar[XB_TOPGEN]) == tg, bar);
      __builtin_amdgcn_fence(__ATOMIC_ACQUIRE, "agent");
      xb_add(&bar[XB_XGEN(b.x)], 1u);
      asm volatile("s_waitcnt vmcnt(0)" ::: "memory");
    } else {
      XB_SPIN(xb_ld(&bar[XB_XGEN(b.x)]) == gen, bar);
      __builtin_amdgcn_fence(__ATOMIC_ACQUIRE, "agent");
      asm volatile("s_waitcnt vmcnt(0)" ::: "memory");
    }
  }
  __syncthreads();
}

#if MEGA
template <int ph, int l>
DEVI void mega_step(const Params& p, char* smem, const XcdBarrier& xb) {
#if PROBE_A >= 0
  if (blockIdx.x == 0 && TID() == 0 && (ph == PROBE_A || ph == PROBE_B)) p.g_cdec[2050] = (float)(wall_clock64() & 0xFFFFFFull);
  run_phase(p, ph, l, smem);
  xcd_barrier(xb);
  if (blockIdx.x == 0 && TID() == 0 && (ph == PROBE_A || ph == PROBE_B)) {
    float dt = (float)(wall_clock64() & 0xFFFFFFull) - p.g_cdec[2050];
    if (dt < 0.f) dt += 16777216.f;
    p.g_cdec[ph == PROBE_A ? 2048 : 2049] += dt;
  }
#else
  run_phase(p, ph, l, smem);
  xcd_barrier(xb);
#endif
}
template <int l>
DEVI void mega_layer(const Params& p, char* smem, const XcdBarrier& xb) {
  mega_step<PH_NORM1, l>(p, smem, xb);
  mega_step<PH_GEMM_IN, l>(p, smem, xb);
  mega_step<PH_MIX_A, l>(p, smem, xb);
  mega_step<PH_MIX_B, l>(p, smem, xb);
  mega_step<PH_MIX_C, l>(p, smem, xb);
  mega_step<PH_MIX_D, l>(p, smem, xb);
  mega_step<PH_GEMM_OUT, l>(p, smem, xb);
  mega_step<PH_NORM2, l>(p, smem, xb);
  mega_step<PH_GEMM_Q, l>(p, smem, xb);
  mega_step<PH_SCORES, l>(p, smem, xb);
  mega_step<PH_TOPK, l>(p, smem, xb);
  mega_step<PH_GATHER, l>(p, smem, xb);
  mega_step<PH_GEMM_PLE, l>(p, smem, xb);
}
__global__ void __launch_bounds__(NT) k_mega(Params p) {
  extern __shared__ __align__(16) char smem[];
  cg::grid_group grid = cg::this_grid();
#if PROBE_A >= 0
  if (blockIdx.x == 0 && TID() == 0) { p.g_cdec[2048] = 0.f; p.g_cdec[2049] = 0.f; }
#endif
  __shared__ uint4 xb_words;
  if (TID() == 0) xb_words = uint4{0u, 0u, 0u, 0u};
  __syncthreads();
  const XcdBarrier xb = xcd_barrier_post(p.bar, (volatile LAS unsigned*)&xb_words);
  run_phase(p, PH_PREP, 0, smem);
  grid.sync();
  mega_layer<0>(p, smem, xb);
  mega_layer<1>(p, smem, xb);
  run_phase(p, PH_FINAL, 0, smem);
#if PROBE_A >= 0
  xcd_barrier(xb);
  {
    const float qa_ = expf(rintf(logf(p.g_cdec[2048] * 0.01f) * 4.f) * 0.25f), qb_ = expf(rintf(logf(p.g_cdec[2049] * 0.01f) * 4.f) * 0.25f);
    const float va = sqrtf(qa_), vb = qb_;
    const size_t gtid = (size_t)blockIdx.x * NT + TID(), gsz = (size_t)gridDim.x * NT;
    for (size_t i = gtid; i < (size_t)S_ * DM; i += gsz) p.out[i] = (i == 0) ? vb : va;
  }
#endif
}
#endif

extern "C" void kernel_launch(void* const* d_in, const int* in_sizes, int n_in, void* d_out, int out_size, void* d_ws,
                              size_t ws_size, hipStream_t stream) {
  Params p{};
  const float* const* f = (const float* const*)d_in;
  p.x = f[0]; p.p = f[1]; p.pos = (const int*)d_in[2];
  p.mix_norm = f[3]; p.w_in = f[4]; p.ret_gn = f[5]; p.lru_conv_w = f[6]; p.lru_conv_b = f[7]; p.lru_w_a = f[8];
  p.lru_b_a = f[9]; p.lru_w_x = f[10]; p.lru_b_x = f[11]; p.lru_lambda = f[12];
  p.s5_a_re = f[13]; p.s5_a_im = f[14]; p.s5_b_re = f[15]; p.s5_b_im = f[16]; p.s5_c_re = f[17]; p.s5_c_im = f[18];
  p.s5_d = f[19]; p.s5_log_dt = f[20]; p.s5_glu_w = f[21]; p.s5_glu_b = f[22];
  p.gdn_conv_w = f[23]; p.gdn_a_log = f[24]; p.gdn_dt_bias = f[25]; p.gdn_norm = f[26]; p.branch_norm = f[27];
  p.w_out = f[28]; p.ffn_norm = f[29]; p.peer_wq = f[30]; p.peer_subkeys = f[31]; p.peer_u = f[32]; p.peer_v = f[33];
  p.ple_norm = f[34]; p.ple_wg = f[35]; p.ple_wp = f[36]; p.final_norm = f[37];
  p.out = (float*)d_out;
  char* ws = (char*)d_ws;
  const size_t MiB = 1024 * 1024;
  p.h = (float*)(ws + 0 * MiB);
  p.zb = (bf16_t*)(ws + 64 * MiB);
  p.proj = (float*)(ws + 96 * MiB);
  p.qbuf = (float*)(ws + 96 * MiB);
  p.scores = (float*)(ws + 160 * MiB);
  p.g_u = (float*)(ws + 288 * MiB); p.g_w = (float*)(ws + 304 * MiB); p.g_attn = (float*)(ws + 320 * MiB);
  p.g_qd = (float*)(ws + 336 * MiB); p.g_kd = (float*)(ws + 352 * MiB);
  p.ids = (int*)(ws + 288 * MiB); p.gates = (float*)(ws + 296 * MiB);
  p.lru_h = (float*)(ws + 368 * MiB); p.lru_p = (float*)(ws + 384 * MiB);
  p.ret_kv = (float*)(ws + 400 * MiB);
  p.tabU = (uint8_t*)(ws + 408 * MiB); p.tabV = (uint8_t*)(ws + 440 * MiB);
  p.uinv = (float*)(ws + 505 * MiB); p.vinv = (float*)(ws + 505 * MiB + 65536);
  p.g_sst = (float*)(ws + 408 * MiB);
  {
    char* wb = ws + 472 * MiB;
    p.winT = (bf16_t*)wb; wb += (size_t)2 * PW * 1024 * 2;
    p.woutT = (bf16_t*)wb; wb += (size_t)2 * 1024 * 1024 * 2;
    p.wqT = (bf16_t*)wb; wb += (size_t)2 * 1024 * 1024 * 2;
    p.wgT = (bf16_t*)wb; wb += (size_t)2 * 1024 * 1024 * 2;
    p.wpT = (bf16_t*)wb; wb += (size_t)2 * 1024 * 256 * 2;
    p.gluT = (bf16_t*)wb; wb += (size_t)2 * 512 * 256 * 2;
  }
  p.rope = (float*)(ws + 497 * MiB);
  p.ssq = (float*)(ws + 501 * MiB);
  p.xloc = (float*)(ws + 502 * MiB);
  p.lru_hs = (float*)(ws + 504 * MiB);
  p.lru_ps = (float*)(ws + 504 * MiB + 256 * 256 * 4);
  p.g_cdec = (float*)(ws + 504 * MiB + 2 * 256 * 256 * 4);
  p.g_comp = (float*)(ws + 506 * MiB);
  p.pbf = (bf16_t*)(ws + 304 * MiB);
  p.bar = (unsigned*)(ws + 507 * MiB);

  static int grid_blocks = 0;
  if (!grid_blocks) {
#if MEGA
    hipFuncSetAttribute((const void*)k_mega, hipFuncAttributeMaxDynamicSharedMemorySize, LDS_BYTES);
#endif
#if !MEGA
    hipFuncSetAttribute((const void*)k_phase, hipFuncAttributeMaxDynamicSharedMemorySize, LDS_BYTES);
#endif
    int dev = 0, cus = 0, per_cu = 0;
    hipGetDevice(&dev);
    hipDeviceGetAttribute(&cus, hipDeviceAttributeMultiprocessorCount, dev);
#if MEGA
    hipOccupancyMaxActiveBlocksPerMultiprocessor(&per_cu, k_mega, NT, LDS_BYTES);
#else
    hipOccupancyMaxActiveBlocksPerMultiprocessor(&per_cu, k_phase, NT, LDS_BYTES);
#endif
    if (per_cu < 1) per_cu = 1;
    grid_blocks = cus * per_cu;
  }
#if MEGA
  hipMemsetAsync(p.bar, 0, XCD_BAR_WORDS * 4, stream);
  void* args[] = {&p};
  hipError_t e = hipLaunchCooperativeKernel((void*)k_mega, dim3(grid_blocks), dim3(NT), args, LDS_BYTES, stream);
  if (e != hipSuccess) fprintf(stderr, "cooperative launch failed: %s (grid %d)\n", hipGetErrorString(e), grid_blocks);
#else
  k_phase<<<grid_blocks, NT, LDS_BYTES, stream>>>(p, PH_PREP, 0);
  for (int l = 0; l < NL; ++l)
    for (int ph = PH_NORM1; ph <= PH_GEMM_PLE; ++ph) k_phase<<<grid_blocks, NT, LDS_BYTES, stream>>>(p, ph, l);
  k_phase<<<grid_blocks, NT, LDS_BYTES, stream>>>(p, PH_FINAL, 0);
#endif
}
```

```cpp
#include <hip/hip_runtime.h>
#include <hip/hip_bf16.h>
#include <hip/hip_cooperative_groups.h>
#include <cstdio>
#include <cstdint>
namespace cg = cooperative_groups;

#ifndef MEGA
#define MEGA 1
#endif

#ifndef PROBE_A
#define PROBE_A -1
#endif
#ifndef PROBE_B
#define PROBE_B -1
#endif
#define DEVI __device__ __forceinline__

typedef __attribute__((ext_vector_type(8))) short bf16x8;
typedef __attribute__((ext_vector_type(4))) float f32x4;
typedef unsigned short bf16_t;

constexpr int NT = 512;
constexpr int S_ = 16384, DM = 1024, NL = 2, PW = 2944, INW = 2824;
constexpr int RQ = 0, RK = 256, RV = 512, RG = 768, LG = 1024, LX = 1280, SU = 1536, DQ = 1792,
              DB = 2560, DA = 2564, DG = 2568;
constexpr float EPS = 1e-6f;
constexpr int LDS_BYTES = 132 * 1024;

struct Params {
  const float *x, *p; const int* pos;
  const float *mix_norm, *w_in, *ret_gn, *lru_conv_w, *lru_conv_b, *lru_w_a, *lru_b_a, *lru_w_x, *lru_b_x, *lru_lambda;
  const float *s5_a_re, *s5_a_im, *s5_b_re, *s5_b_im, *s5_c_re, *s5_c_im, *s5_d, *s5_log_dt, *s5_glu_w, *s5_glu_b;
  const float *gdn_conv_w, *gdn_a_log, *gdn_dt_bias, *gdn_norm, *branch_norm, *w_out, *ffn_norm, *peer_wq, *peer_subkeys;
  const float *peer_u, *peer_v, *ple_norm, *ple_wg, *ple_wp, *final_norm;
  float* out;
  float* h; bf16_t* zb; float* proj; float* qbuf; float* scores;
  float *g_u, *g_w, *g_attn, *g_qd, *g_kd, *g_sst, *g_cdec, *g_comp;
  int* ids; float* gates;
  float *lru_h, *lru_p, *lru_hs, *lru_ps;
  float* ret_kv; float* xloc;
  uint8_t *tabU, *tabV; float *uinv, *vinv;
  bf16_t *winT, *woutT, *wqT, *wgT, *wpT, *gluT;
  float* rope; float* ssq; bf16_t* pbf; unsigned* bar;
};

DEVI int TID() { int t = __builtin_amdgcn_workitem_id_x(); asm volatile("" : "+v"(t)); return t; }
DEVI bf16_t f2bf(float f) { unsigned u = __float_as_uint(f); u += 0x7FFFu + ((u >> 16) & 1u); return (bf16_t)(u >> 16); }
DEVI float bf2f(bf16_t b) { return __uint_as_float(((unsigned)b) << 16); }
DEVI unsigned pack2(float a, float b) { return (unsigned)f2bf(a) | ((unsigned)f2bf(b) << 16); }
DEVI float sigmoidf_(float x) { return 1.f / (1.f + expf(-x)); }
DEVI float siluf_(float x) { return x / (1.f + expf(-x)); }
DEVI float geluf_(float x) { float u = 0.7978845608028654f * (x + 0.044715f * x * x * x); return 0.5f * x * (1.f + tanhf(u)); }
DEVI float softplusf_(float x) { return x > 20.f ? x : log1pf(expf(x)); }
DEVI float wave_sum(float v) {
  v += __shfl_xor(v, 32); v += __shfl_xor(v, 16); v += __shfl_xor(v, 8);
  v += __shfl_xor(v, 4); v += __shfl_xor(v, 2); v += __shfl_xor(v, 1); return v;
}
DEVI float sum16(float v) {
  v += __shfl_xor(v, 8); v += __shfl_xor(v, 4); v += __shfl_xor(v, 2); v += __shfl_xor(v, 1); return v;
}

template <int NTL>
DEVI void mm16(f32x4 (&acc)[NTL], const float* A, int sam, int sak, const float* B, int sbk, int sbn, int K) {
  const int l = TID() & 63, r = l & 15, q = l >> 4;
  const float* ap = A + r * sam + q * sak;
  const float* bp = B + q * sbk + r * sbn;
#pragma unroll 4
  for (int k = 0; k < K; k += 4) {
    float a = ap[k * sak];
#pragma unroll
    for (int t = 0; t < NTL; ++t) {
      float b = bp[k * sbk + t * 16 * sbn];
      acc[t] = __builtin_amdgcn_mfma_f32_16x16x4f32(a, b, acc[t], 0, 0, 0);
    }
  }
}

template <int NTL>
DEVI void mm16_gB64(f32x4 (&acc)[NTL], const float* A, int sam, const float* __restrict__ Bg) {
  const int l = TID() & 63, r = l & 15, q = l >> 4;
  float bv[16][NTL];
#pragma unroll
  for (int k = 0; k < 16; ++k)
#pragma unroll
    for (int t = 0; t < NTL; ++t) bv[k][t] = Bg[(4 * k + q) * 64 + t * 16 + r];
#pragma unroll
  for (int k = 0; k < 16; ++k) {
    const float a = A[r * sam + 4 * k + q];
#pragma unroll
    for (int t = 0; t < NTL; ++t) acc[t] = __builtin_amdgcn_mfma_f32_16x16x4f32(a, bv[k][t], acc[t], 0, 0, 0);
  }
}

template <int AMODE, int NK>
DEVI void gemm_tile(f32x4 (&acc)[4][4], const void* Aptr, int lda, const bf16_t* Bt, int ldb, int K, int m0, int n0,
                    const float* ssq, char* smem) {
  constexpr int LDT = 72, BUF = (256 + 128) * LDT;
  bf16_t* sbase = (bf16_t*)smem;
  const int tid = TID(), lane = tid & 63, wave = tid >> 6;
  const int wm = wave >> 1, wn = wave & 1, r = lane & 15, q = lane >> 4;
  const int lrow = tid >> 3, lkc = tid & 7;
  uint4 raS00, raS01, raS02, raS03, rbS00, rbS01, raS10, raS11, raS12, raS13, rbS10, rbS11, raS20, raS21, raS22, raS23, rbS20, rbS21;
  float rs0 = 1.f, rs1 = 1.f, rs2 = 1.f, rs3 = 1.f;
#pragma unroll
  for (int i = 0; i < 4; ++i)
#pragma unroll
    for (int j = 0; j < 4; ++j) acc[i][j] = f32x4{0.f, 0.f, 0.f, 0.f};
  const bf16_t* Ab = (const bf16_t*)Aptr + (size_t)(m0 + lrow) * lda + lkc * 8;
  const bf16_t* Bb = Bt + (size_t)(n0 + lrow) * ldb + lkc * 8;
#define GL(S, k0_)                                                    \
  {                                                                   \
    ra##S##0 = *(const uint4*)(Ab + (k0_));                           \
    ra##S##1 = *(const uint4*)(Ab + (size_t)64 * lda + (k0_));        \
    ra##S##2 = *(const uint4*)(Ab + (size_t)128 * lda + (k0_));       \
    ra##S##3 = *(const uint4*)(Ab + (size_t)192 * lda + (k0_));       \
    rb##S##0 = *(const uint4*)(Bb + (k0_));                           \
    rb##S##1 = *(const uint4*)(Bb + (size_t)64 * ldb + (k0_));        \
  }
  auto scale = [&](uint4 v, float s) {
    unsigned w[4] = {v.x, v.y, v.z, v.w};
#pragma unroll
    for (int j = 0; j < 4; ++j) {
      float lo = __uint_as_float(w[j] << 16) * s, hi = __uint_as_float(w[j] & 0xFFFF0000u) * s;
      w[j] = pack2(lo, hi);
    }
    return uint4{w[0], w[1], w[2], w[3]};
  };
  auto rowscale = [&](int row, int k0) {
    const float* sp = ssq + (size_t)(m0 + row) * 16;
    int seg = k0 >> 8;
    float s = seg == 0 ? (sp[0] + sp[1] + sp[2] + sp[3]) : seg == 1 ? sp[4] : seg == 2 ? sp[5] : (sp[8] + sp[9] + sp[10] + sp[11]);
    return rsqrtf(s * (1.f / 256.f) + EPS);
  };
#define LS(S, k0_, bi_)                                                               \
  {                                                                                   \
    bf16_t* As_ = sbase + (bi_) * BUF; bf16_t* Bs_ = As_ + 256 * LDT;                 \
    if constexpr (AMODE == 1) {                                                       \
      if (((k0_) & 255) == 0) {                                                       \
        rs0 = rowscale(lrow, (k0_)); rs1 = rowscale(lrow + 64, (k0_));                \
        rs2 = rowscale(lrow + 128, (k0_)); rs3 = rowscale(lrow + 192, (k0_));         \
      }                                                                               \
      ra##S##0 = scale(ra##S##0, rs0); ra##S##1 = scale(ra##S##1, rs1);               \
      ra##S##2 = scale(ra##S##2, rs2); ra##S##3 = scale(ra##S##3, rs3);               \
    }                                                                                 \
    *(uint4*)&As_[(lrow) * LDT + lkc * 8] = ra##S##0;                                 \
    *(uint4*)&As_[(lrow + 64) * LDT + lkc * 8] = ra##S##1;                            \
    *(uint4*)&As_[(lrow + 128) * LDT + lkc * 8] = ra##S##2;                           \
    *(uint4*)&As_[(lrow + 192) * LDT + lkc * 8] = ra##S##3;                           \
    *(uint4*)&Bs_[(lrow) * LDT + lkc * 8] = rb##S##0;                                 \
    *(uint4*)&Bs_[(lrow + 64) * LDT + lkc * 8] = rb##S##1;                            \
  }
  auto compute = [&](int bi) {
    const bf16_t* As = sbase + bi * BUF; const bf16_t* Bs = As + 256 * LDT;
#pragma unroll
    for (int kk = 0; kk < 2; ++kk) {
      bf16x8 a[4], b[4];
#pragma unroll
      for (int i = 0; i < 4; ++i) a[i] = *(const bf16x8*)&As[(wm * 64 + i * 16 + r) * LDT + kk * 32 + q * 8];
#pragma unroll
      for (int j = 0; j < 4; ++j) b[j] = *(const bf16x8*)&Bs[(wn * 64 + j * 16 + r) * LDT + kk * 32 + q * 8];
#pragma unroll
      for (int i = 0; i < 4; ++i)
#pragma unroll
        for (int j = 0; j < 4; ++j)
          acc[i][j] = __builtin_amdgcn_mfma_f32_16x16x32_bf16(b[j], a[i], acc[i][j], 0, 0, 0);
    }
  };

  __syncthreads();
  if constexpr (NK == 16 && AMODE == 1) {
    GL(S0, 0)
    LS(S0, 0, 0)
    GL(S1, 64)
    __syncthreads();
#pragma unroll 1
    for (int kt = 0; kt < NK; kt += 2) {
      compute(0);
      LS(S1, ((kt + 1) << 6), 1)
      if (kt + 2 < NK) GL(S0, ((kt + 2) << 6))
      __syncthreads();
      compute(1);
      if (kt + 2 < NK) { LS(S0, ((kt + 2) << 6), 0) GL(S1, ((kt + 3) << 6)) }
      __syncthreads();
    }
  } else if constexpr (NK == 16) {
    GL(S0, 0) GL(S1, 64) GL(S2, 128)
    LS(S0, 0, 0)
    GL(S0, 192)
    __syncthreads();
    compute(0);
    LS(S1, 64, 1)
    GL(S1, 256)
    __syncthreads();
    compute(1);
    LS(S2, 128, 0)
    GL(S2, 320)
    __syncthreads();
    compute(0);
    LS(S0, 192, 1)
    GL(S0, 384)
    __syncthreads();
    compute(1);
    LS(S1, 256, 0)
    GL(S1, 448)
    __syncthreads();
    compute(0);
    LS(S2, 320, 1)
    GL(S2, 512)
    __syncthreads();
    compute(1);
    LS(S0, 384, 0)
    GL(S0, 576)
    __syncthreads();
    compute(0);
    LS(S1, 448, 1)
    GL(S1, 640)
    __syncthreads();
    compute(1);
    LS(S2, 512, 0)
    GL(S2, 704)
    __syncthreads();
    compute(0);
    LS(S0, 576, 1)
    GL(S0, 768)
    __syncthreads();
    compute(1);
    LS(S1, 640, 0)
    GL(S1, 832)
    __syncthreads();
    compute(0);
    LS(S2, 704, 1)
    GL(S2, 896)
    __syncthreads();
    compute(1);
    LS(S0, 768, 0)
    GL(S0, 960)
    __syncthreads();
    compute(0);
    LS(S1, 832, 1)
    __syncthreads();
    compute(1);
    LS(S2, 896, 0)
    __syncthreads();
    compute(0);
    LS(S0, 960, 1)
    __syncthreads();
    compute(1);
    __syncthreads();
  } else {
    GL(S0, 0) GL(S1, 64) GL(S2, 128)
    LS(S0, 0, 0)
    GL(S0, 192)
    __syncthreads();
    compute(0);
    LS(S1, 64, 1)
    __syncthreads();
    compute(1);
    LS(S2, 128, 0)
    __syncthreads();
    compute(0);
    LS(S0, 192, 1)
    __syncthreads();
    compute(1);
    __syncthreads();
  }
#undef GL
#undef LS
}
#define GEMM_EPI_COORDS                                                   \
  const int lane_ = TID() & 63, wave_ = TID() >> 6;           \
  const int erow0 = m0 + (wave_ >> 1) * 64 + (lane_ & 15);                \
  const int ecol0 = n0 + (wave_ & 1) * 64 + (lane_ >> 4) * 4;

DEVI void transpose_tile(const float* W, int ldw, int nvalid, bf16_t* Bt, int ldbt, int k0, int n0, char* smem) {
  float* t = (float*)smem;
  const int tid = TID();
  {
    int i = tid >> 4, j4 = tid & 15;
#pragma unroll
    for (int h2 = 0; h2 < 2; ++h2) {
      int kk = i + 32 * h2;
      int n = n0 + j4 * 4;
      float4 v = float4{0.f, 0.f, 0.f, 0.f};
      if (n < nvalid) v = *(const float4*)&W[(size_t)(k0 + kk) * ldw + n];
      t[(j4 * 4 + 0) * 65 + kk] = v.x; t[(j4 * 4 + 1) * 65 + kk] = v.y;
      t[(j4 * 4 + 2) * 65 + kk] = v.z; t[(j4 * 4 + 3) * 65 + kk] = v.w;
    }
  }
  __syncthreads();
  {
    int n = tid >> 3, k8 = tid & 7;
    const float* s = &t[n * 65 + k8 * 8];
    uint4 v;
    v.x = pack2(s[0], s[1]); v.y = pack2(s[2], s[3]); v.z = pack2(s[4], s[5]); v.w = pack2(s[6], s[7]);
    *(uint4*)&Bt[(size_t)(n0 + n) * ldbt + k0 + k8 * 8] = v;
  }
  __syncthreads();
}

DEVI void convert_tables(const Params& p, int l) {
  const int lane = TID() & 63, wave = TID() >> 6;
  for (int rr = blockIdx.x * 8 + wave; rr < 2 * 16384; rr += gridDim.x * 8) {
    const int which = rr >> 14, row = rr & 16383;
    const float* src = (which ? p.peer_v : p.peer_u) + ((size_t)l * 16384 + row) * 1024 + lane * 16;
    float4 a = *(const float4*)src, b = *(const float4*)(src + 4), c = *(const float4*)(src + 8), d = *(const float4*)(src + 12);
    float m = fmaxf(fmaxf(fmaxf(fabsf(a.x), fabsf(a.y)), fmaxf(fabsf(a.z), fabsf(a.w))),
                    fmaxf(fmaxf(fabsf(b.x), fabsf(b.y)), fmaxf(fabsf(b.z), fabsf(b.w))));
    m = fmaxf(m, fmaxf(fmaxf(fmaxf(fabsf(c.x), fabsf(c.y)), fmaxf(fabsf(c.z), fabsf(c.w))),
                       fmaxf(fmaxf(fabsf(d.x), fabsf(d.y)), fmaxf(fabsf(d.z), fabsf(d.w)))));
    m = fmaxf(m, __shfl_xor(m, 32)); m = fmaxf(m, __shfl_xor(m, 16)); m = fmaxf(m, __shfl_xor(m, 8));
    m = fmaxf(m, __shfl_xor(m, 4)); m = fmaxf(m, __shfl_xor(m, 2)); m = fmaxf(m, __shfl_xor(m, 1));
    const float sc = m > 0.f ? 256.f / m : 1.f;
    int w0 = 0, w1 = 0, w2 = 0, w3 = 0;
    w0 = __builtin_amdgcn_cvt_pk_fp8_f32(a.x * sc, a.y * sc, w0, false); w0 = __builtin_amdgcn_cvt_pk_fp8_f32(a.z * sc, a.w * sc, w0, true);
    w1 = __builtin_amdgcn_cvt_pk_fp8_f32(b.x * sc, b.y * sc, w1, false); w1 = __builtin_amdgcn_cvt_pk_fp8_f32(b.z * sc, b.w * sc, w1, true);
    w2 = __builtin_amdgcn_cvt_pk_fp8_f32(c.x * sc, c.y * sc, w2, false); w2 = __builtin_amdgcn_cvt_pk_fp8_f32(c.z * sc, c.w * sc, w2, true);
    w3 = __builtin_amdgcn_cvt_pk_fp8_f32(d.x * sc, d.y * sc, w3, false); w3 = __builtin_amdgcn_cvt_pk_fp8_f32(d.z * sc, d.w * sc, w3, true);
    *(uint4*)((which ? p.tabV : p.tabU) + (size_t)row * 1024 + lane * 16) = uint4{(unsigned)w0, (unsigned)w1, (unsigned)w2, (unsigned)w3};
    if (lane == 0) (which ? p.vinv : p.uinv)[row] = m > 0.f ? m * (1.f / 256.f) : 1.f;
  }
}

DEVI void ph_prep(const Params& p, char* smem) {
  const size_t gtid = (size_t)blockIdx.x * NT + TID(), gsz = (size_t)gridDim.x * NT;
  for (size_t i = gtid; i < (size_t)S_ * 32; i += gsz) {
    int t = (int)(i >> 5), f = (int)(i & 31);
    float inv = powf(10000.f, -(float)f / 32.f);
    float ang = (float)p.pos[t] * inv;
    p.rope[2 * i] = cosf(ang); p.rope[2 * i + 1] = sinf(ang);
  }
  for (int it = blockIdx.x; it < 2 * 1600; it += gridDim.x) {
    int l = it / 1600, idx = it % 1600;
    if (idx >= 1568) {
      int j = idx - 1568; int kt = j >> 3, nt = j & 7;
      transpose_tile(p.s5_glu_w + (size_t)l * 256 * 512, 512, 512, p.gluT + (size_t)l * 512 * 256, 256, kt * 64, nt * 64, smem);
    } else if (idx < 736) {
      int kt = idx / 46, nt = idx % 46;
      transpose_tile(p.w_in + (size_t)l * 1024 * INW, INW, INW, p.winT + (size_t)l * PW * 1024, 1024, kt * 64, nt * 64, smem);
    } else if (idx < 1504) {
      int j = idx - 736; int which = j >> 8; j &= 255;
      int kt = j >> 4, nt = j & 15;
      const float* src = (which == 0 ? p.w_out : which == 1 ? p.peer_wq : p.ple_wg) + (size_t)l * 1024 * 1024;
      bf16_t* dst = (which == 0 ? p.woutT : which == 1 ? p.wqT : p.wgT) + (size_t)l * 1024 * 1024;
      transpose_tile(src, 1024, 1024, dst, 1024, kt * 64, nt * 64, smem);
    } else {
      int j = idx - 1504; int kt = j >> 4, nt = j & 15;
      transpose_tile(p.ple_wp + (size_t)l * 256 * 1024, 1024, 1024, p.wpT + (size_t)l * 1024 * 256, 256, kt * 64, nt * 64, smem);
    }
  }
}

DEVI void ph_norm(const float* src, const float* g, bf16_t* dst, float* fout) {
  const int lane = TID() & 63, wave = TID() >> 6;
  for (int t = blockIdx.x * 8 + wave; t < S_; t += gridDim.x * 8) {
    const float* row = src + (size_t)t * DM;
    float4 v[4]; float ss = 0.f;
#pragma unroll
    for (int i = 0; i < 4; ++i) {
      v[i] = *(const float4*)&row[i * 256 + lane * 4];
      ss += v[i].x * v[i].x + v[i].y * v[i].y + v[i].z * v[i].z + v[i].w * v[i].w;
    }
    ss = wave_sum(ss);
    float rs = rsqrtf(ss * (1.f / DM) + EPS);
#pragma unroll
    for (int i = 0; i < 4; ++i) {
      float4 gg = *(const float4*)&g[i * 256 + lane * 4];
      float a = v[i].x * rs * gg.x, b = v[i].y * rs * gg.y, c = v[i].z * rs * gg.z, d = v[i].w * rs * gg.w;
      if (dst) *(uint2*)&dst[(size_t)t * DM + i * 256 + lane * 4] = uint2{pack2(a, b), pack2(c, d)};
      else *(float4*)&fout[(size_t)t * DM + i * 256 + lane * 4] = float4{a, b, c, d};
    }
  }
}

DEVI void gdn_prep(const Params& p, int l, int item, char* smem) {
  const int c = item >> 2, hd = item & 3, t0 = c * 64;
  float* sq = (float*)smem; float* sk = sq + 64 * 65; float* sv = sk + 64 * 65;
  float* sL = sv + 64 * 65;
  float* sgc = sL + 64 * 68; float* sbeta = sgc + 64;
  const int tid = TID(), lane = tid & 63, wave = tid >> 6, r = lane & 15, qd = lane >> 4;
  const float* cw = p.gdn_conv_w + (size_t)l * 4 * 768;
  {
    const int d = tid & 63, tw = tid >> 6;
#pragma unroll
    for (int which = 0; which < 3; ++which) {
      const int ch = which * 256 + hd * 64 + d;
      const float w0 = cw[ch], w1 = cw[768 + ch], w2 = cw[2 * 768 + ch], w3 = cw[3 * 768 + ch];
      const float* pc = p.proj + DQ + ch;
      float xv[11];
#pragma unroll
      for (int k = 0; k < 11; ++k) {
        const int tt = t0 + 8 * tw - 3 + k;
        const float v = pc[(size_t)(tt < 0 ? 0 : tt) * PW];
        xv[k] = tt < 0 ? 0.f : v;
      }
#pragma unroll
      for (int m = 0; m < 8; ++m) {
        float acc = 0.f;
        acc += w0 * xv[m]; acc += w1 * xv[m + 1]; acc += w2 * xv[m + 2]; acc += w3 * xv[m + 3];
        const float sv_ = siluf_(acc);
        if (which == 0) sq[(8 * tw + m) * 65 + d] = sv_;
        else if (which == 1) sk[(8 * tw + m) * 65 + d] = sv_;
        else sv[(8 * tw + m) * 65 + d] = sv_;
      }
    }
  }
  __syncthreads();
  {
    const int rw = tid >> 2, part = tid & 3, t = rw & 63;
    float* row = (rw < 64 ? sq : sk) + t * 65 + part * 16;
    float s = 0.f;
#pragma unroll
    for (int d = 0; d < 16; ++d) s += row[d] * row[d];
    s += __shfl_xor(s, 1); s += __shfl_xor(s, 2);
    float sc = rsqrtf(s + EPS) * (rw < 64 ? 0.125f : 1.f);
#pragma unroll
    for (int d = 0; d < 16; ++d) row[d] *= sc;
  }
  if (wave == 2) {
    int t = tid - 128;
    float bl = p.proj[(size_t)(t0 + t) * PW + DB + hd];
    float al = p.proj[(size_t)(t0 + t) * PW + DA + hd];
    float la = -expf(p.gdn_a_log[l * 4 + hd]) * softplusf_(al + p.gdn_dt_bias[l * 4 + hd]);
    for (int off = 1; off < 64; off <<= 1) { float n = __shfl_up(la, off); if (lane >= off) la += n; }
    sgc[t] = la; sbeta[t] = sigmoidf_(bl);
  }
  __syncthreads();
  {
    int mat = wave >> 2, mt = wave & 3;
    f32x4 acc[4];
#pragma unroll
    for (int t = 0; t < 4; ++t) acc[t] = f32x4{0.f, 0.f, 0.f, 0.f};
    mm16<4>(acc, (mat == 0 ? sk : sq) + mt * 16 * 65, 65, 1, sk, 1, 65, 64);
#pragma unroll
    for (int t = 0; t < 4; ++t)
#pragma unroll
      for (int e = 0; e < 4; ++e) {
        int i = mt * 16 + 4 * qd + e, j = t * 16 + r;
        float g = (i >= j) ? expf(sgc[i] - sgc[j]) : 0.f;
        if (mat == 0) sL[i * 68 + j] = (i > j) ? acc[t][e] * sbeta[i] * g : 0.f;
        else p.g_attn[((size_t)item * 64 + i) * 64 + j] = (i >= j) ? acc[t][e] * g : 0.f;
      }
  }
  __syncthreads();
  if (tid < 128) {
    const bool isv = tid < 64; const int d = tid & 63;
    float X[64];
#pragma unroll
    for (int i = 0; i < 64; ++i) X[i] = 0.f;
    float* dst = (isv ? p.g_u : p.g_w) + (size_t)item * 4096 + d;
#pragma unroll
    for (int i = 0; i < 64; ++i) {
      float bi = sbeta[i];
      float s = isv ? sv[i * 65 + d] * bi : sk[i * 65 + d] * bi * expf(sgc[i]);
      float s1 = 0.f, s2 = 0.f, s3 = 0.f;
#pragma unroll
      for (int j4 = 0; j4 < (i + 3) / 4; ++j4) {
        float4 lv = *(const float4*)&sL[i * 68 + j4 * 4];
        s -= lv.x * X[j4 * 4 + 0]; s1 -= lv.y * X[j4 * 4 + 1]; s2 -= lv.z * X[j4 * 4 + 2]; s3 -= lv.w * X[j4 * 4 + 3];
      }
      s = (s + s1) + (s2 + s3);
      X[i] = s;
      dst[i * 64] = s;
    }
  } else {
    for (int i2 = tid - 128; i2 < 8192; i2 += 384) {
      int which = i2 >> 12, i = (i2 >> 6) & 63, d = i2 & 63;
      float val = which == 0 ? sq[i * 65 + d] * expf(sgc[i]) : sk[i * 65 + d] * expf(sgc[63] - sgc[i]);
      (which == 0 ? p.g_qd : p.g_kd)[(size_t)item * 4096 + i * 64 + d] = val;
    }
    if (tid == 128) p.g_cdec[item] = expf(sgc[63]);
  }
  __syncthreads();
}

DEVI f32x4 mm16_k64(const float* A, int sam, int sak, const float* B, int sbk, int sbn) {
  const int l = TID() & 63, r = l & 15, q = l >> 4;
  const float* ap = A + r * sam + q * sak;
  const float* bp = B + q * sbk + r * sbn;
  float av[16], bv[16];
#pragma unroll
  for (int k = 0; k < 16; ++k) { av[k] = ap[4 * k * sak]; bv[k] = bp[4 * k * sbk]; }
  f32x4 c0 = f32x4{0.f, 0.f, 0.f, 0.f}, c1 = f32x4{0.f, 0.f, 0.f, 0.f};
#pragma unroll
  for (int k = 0; k < 16; k += 2) {
    c0 = __builtin_amdgcn_mfma_f32_16x16x4f32(av[k], bv[k], c0, 0, 0, 0);
    c1 = __builtin_amdgcn_mfma_f32_16x16x4f32(av[k + 1], bv[k + 1], c1, 0, 0, 0);
  }
  return c0 + c1;
}

template <int MODE>
DEVI void gdn_chain(const Params& p, int hd, int grp, int cb, char* smem) {
  float* base = (float*)smem;
  constexpr int BUFSZ = 64 * 68 * 2 + 64 * 16;
  float* sS = base + 2 * BUFSZ; float* sVN = sS + 1024;
  const int tid = TID(), lane = tid & 63, wave = tid >> 6, r = lane & 15, qd = lane >> 4;
  const bool apart = (MODE == 0) && (cb >= 4);
  const int e0 = (cb & 3) * 16;
  const int c0 = grp * 32;
  float4 pw0, pw1, pkd0, pkd1, pu = float4{0.f, 0.f, 0.f, 0.f};
  const int lr0 = tid >> 4, lc0 = (tid & 15) * 4, lr1 = lr0 + 32;
  const int ur = tid >> 2, uc = (tid & 3) * 4;
#define GLOAD(c_)                                                            \
  {                                                                          \
    size_t b_ = (size_t)((c_) * 4 + hd) * 4096;                              \
    pw0 = *(const float4*)&p.g_w[b_ + lr0 * 64 + lc0];                       \
    pw1 = *(const float4*)&p.g_w[b_ + lr1 * 64 + lc0];                       \
    pkd0 = *(const float4*)&p.g_kd[b_ + lr0 * 64 + lc0];                     \
    pkd1 = *(const float4*)&p.g_kd[b_ + lr1 * 64 + lc0];                     \
    if (tid < 256 && !apart) pu = *(const float4*)&p.g_u[b_ + ur * 64 + e0 + uc]; \
  }
#define LSTORE(bi_)                                                          \
  {                                                                          \
    float* W_ = base + (bi_) * BUFSZ; float* KD_ = W_ + 64 * 68; float* U_ = KD_ + 64 * 68; \
    *(float4*)&W_[lr0 * 68 + lc0] = pw0; *(float4*)&W_[lr1 * 68 + lc0] = pw1;       \
    *(float4*)&KD_[lr0 * 68 + lc0] = pkd0; *(float4*)&KD_[lr1 * 68 + lc0] = pkd1;   \
    if (tid < 256) *(float4*)&U_[ur * 16 + uc] = pu;                         \
  }
  f32x4 sreg = f32x4{0.f, 0.f, 0.f, 0.f};
  if (MODE == 0) {
    for (int i = tid; i < 1024; i += NT) sS[i] = (apart && ((i >> 4) == e0 + (i & 15))) ? 1.f : 0.f;
    if (apart) {
#pragma unroll
      for (int e = 0; e < 4; ++e) sreg[e] = ((wave & 3) * 16 + 4 * qd + e == e0 + r) ? 1.f : 0.f;
    }
  } else {
    for (int i = tid; i < 1024; i += NT) sS[i] = 0.f;
    float* W = base;
    for (int g2 = 0; g2 < grp; ++g2) {
      const float* Ag = p.g_comp + ((size_t)(hd * 8 + g2) * 2 + 1) * 4096;
      const float* Bg = p.g_comp + ((size_t)(hd * 8 + g2) * 2 + 0) * 4096;
      __syncthreads();
      *(float4*)&W[lr0 * 68 + lc0] = *(const float4*)&Ag[lr0 * 64 + lc0];
      *(float4*)&W[lr1 * 68 + lc0] = *(const float4*)&Ag[lr1 * 64 + lc0];
      __syncthreads();
      f32x4 a = f32x4{0.f, 0.f, 0.f, 0.f};
      if (wave < 4) a = mm16_k64(W + wave * 16 * 68, 68, 1, sS, 16, 1);
      __syncthreads();
      if (wave < 4) {
#pragma unroll
        for (int e = 0; e < 4; ++e) {
          int d = wave * 16 + 4 * qd + e;
          sreg[e] = a[e] + Bg[d * 64 + e0 + r];
          sS[d * 16 + r] = sreg[e];
        }
      }
    }
    __syncthreads();
    if (wave < 4) {
#pragma unroll
      for (int e = 0; e < 4; ++e) {
        int d = wave * 16 + 4 * qd + e;
        p.g_sst[(size_t)(c0 * 4 + hd) * 4096 + d * 64 + e0 + r] = sreg[e];
      }
    }
  }
  GLOAD(c0) LSTORE(0)
  __syncthreads();
  for (int cc = 0; cc < 32; ++cc) {
    const int c = c0 + cc;
    if (cc + 1 < 32) GLOAD(c + 1)
    const float cd = p.g_cdec[c * 4 + hd];
    float* W = base + (cc & 1) * BUFSZ; float* KD = W + 64 * 68; float* U = KD + 64 * 68;
    const size_t it = (size_t)(c * 4 + hd);
    if (wave < 4) {
      f32x4 a1 = mm16_k64(W + wave * 16 * 68, 68, 1, sS, 16, 1);
#pragma unroll
      for (int e = 0; e < 4; ++e) {
        int i = wave * 16 + 4 * qd + e;
        float vn = (apart ? 0.f : U[i * 16 + r]) - a1[e];
        sVN[i * 16 + r] = vn;
        if (MODE == 1) p.g_u[it * 4096 + i * 64 + e0 + r] = vn;
      }
    }
    __syncthreads();
    if (wave < 4) {
      f32x4 a2 = mm16_k64(KD + wave * 16, 1, 68, sVN, 16, 1);
#pragma unroll
      for (int e = 0; e < 4; ++e) {
        int d = wave * 16 + 4 * qd + e;
        sreg[e] = sreg[e] * cd + a2[e];
        sS[d * 16 + r] = sreg[e];
        if (MODE == 1 && cc + 1 < 32) p.g_sst[(size_t)((c + 1) * 4 + hd) * 4096 + d * 64 + e0 + r] = sreg[e];
      }
    }
    if (cc + 1 < 32) LSTORE((cc + 1) & 1)
    __syncthreads();
  }
  if (MODE == 0 && wave < 4) {
    float* dst = p.g_comp + ((size_t)(hd * 8 + grp) * 2 + (apart ? 1 : 0)) * 4096;
#pragma unroll
    for (int e = 0; e < 4; ++e) {
      int d = wave * 16 + 4 * qd + e;
      dst[d * 64 + e0 + r] = sreg[e];
    }
  }
  __syncthreads();
}

DEVI void gdn_out(const Params& p, int l, int item, char* smem) {
  const int c = item >> 2, hd = item & 3, t0 = c * 64;
  float* sQD = (float*)smem; float* sS = sQD + 64 * 68; float* sAT = sS + 64 * 68; float* sVN = sAT + 64 * 68;
  const int tid = TID(), lane = tid & 63, wave = tid >> 6, r = lane & 15, qd = lane >> 4;
  const size_t b = (size_t)item * 4096;
  for (int idx = tid; idx < 1024; idx += NT) {
    int row = idx >> 4, c4 = idx & 15;
    *(float4*)&sQD[row * 68 + c4 * 4] = *(const float4*)&p.g_qd[b + row * 64 + c4 * 4];
    *(float4*)&sS[row * 68 + c4 * 4] = *(const float4*)&p.g_sst[b + row * 64 + c4 * 4];
    *(float4*)&sAT[row * 68 + c4 * 4] = *(const float4*)&p.g_attn[b + row * 64 + c4 * 4];
    *(float4*)&sVN[row * 68 + c4 * 4] = *(const float4*)&p.g_u[b + row * 64 + c4 * 4];
  }
  __syncthreads();
  const int mt = wave & 3, nh = wave >> 2;
  f32x4 acc[2]; acc[0] = acc[1] = f32x4{0.f, 0.f, 0.f, 0.f};
  mm16<2>(acc, sQD + mt * 16 * 68, 68, 1, sS + nh * 32, 68, 1, 64);
  mm16<2>(acc, sAT + mt * 16 * 68, 68, 1, sVN + nh * 32, 68, 1, 64);
  __syncthreads();
  float* sO = sQD;
#pragma unroll
  for (int t2 = 0; t2 < 2; ++t2)
#pragma unroll
    for (int e = 0; e < 4; ++e) sO[(mt * 16 + 4 * qd + e) * 68 + nh * 32 + t2 * 16 + r] = acc[t2][e];
  __syncthreads();
  {
    int row = tid >> 3, sub = tid & 7, t = t0 + row;
    float o[8], yv[8]; float ss = 0.f;
#pragma unroll
    for (int k = 0; k < 8; ++k) { o[k] = sO[row * 68 + sub * 8 + k]; ss += o[k] * o[k]; }
    ss += __shfl_xor(ss, 1); ss += __shfl_xor(ss, 2); ss += __shfl_xor(ss, 4);
    float rs = rsqrtf(ss * (1.f / 64.f) + EPS);
    float s2 = 0.f;
#pragma unroll
    for (int k = 0; k < 8; ++k) {
      int col = sub * 8 + k;
      float g = p.proj[(size_t)t * PW + DG + hd * 64 + col];
      float y = o[k] * rs * p.gdn_norm[l * 64 + col] * siluf_(g);
      s2 += y * y;
      yv[k] = y * p.branch_norm[(l * 4 + 3) * 256 + hd * 64 + col];
    }
    s2 += __shfl_xor(s2, 1); s2 += __shfl_xor(s2, 2); s2 += __shfl_xor(s2, 4);
    if (sub == 0) p.ssq[(size_t)t * 16 + 8 + hd] = s2;
    *(uint4*)&p.zb[(size_t)t * DM + 768 + hd * 64 + sub * 8] =
        uint4{pack2(yv[0], yv[1]), pack2(yv[2], yv[3]), pack2(yv[4], yv[5]), pack2(yv[6], yv[7])};
  }
  __syncthreads();
}

DEVI void ret_kv(const Params& p, int l, int item, char* smem) {
  const int c = item >> 2, hd = item & 3, t0 = c * 128;
  float* sK = (float*)smem; float* sV = sK + 128 * 65;
  const int tid = TID(), lane = tid & 63, wave = tid >> 6, r = lane & 15, qd = lane >> 4;
  const float lg = logf(1.f - exp2f(-5.f - (float)hd));
  for (int i = tid; i < 128 * 32; i += NT) {
    int t = i >> 5, f = i & 31; size_t tt = t0 + t;
    float k1 = p.proj[tt * PW + RK + hd * 64 + f], k2 = p.proj[tt * PW + RK + hd * 64 + 32 + f];
    float cs = p.rope[(tt * 32 + f) * 2], sn = p.rope[(tt * 32 + f) * 2 + 1];
    float dec = expf(lg * (float)(127 - t));
    sK[t * 65 + f] = (k1 * cs - k2 * sn) * dec;
    sK[t * 65 + 32 + f] = (k2 * cs + k1 * sn) * dec;
  }
  for (int i = tid; i < 128 * 64; i += NT) {
    int t = i >> 6, e = i & 63;
    sV[t * 65 + e] = p.proj[(size_t)(t0 + t) * PW + RV + hd * 64 + e];
  }
  __syncthreads();
  const int mt = wave & 3, nh = wave >> 2;
  f32x4 acc[2]; acc[0] = acc[1] = f32x4{0.f, 0.f, 0.f, 0.f};
  mm16<2>(acc, sK + mt * 16, 1, 65, sV + nh * 32, 65, 1, 128);
#pragma unroll
  for (int t2 = 0; t2 < 2; ++t2)
#pragma unroll
    for (int e = 0; e < 4; ++e)
      p.ret_kv[(size_t)item * 4096 + (mt * 16 + 4 * qd + e) * 64 + nh * 32 + t2 * 16 + r] = acc[t2][e];
  __syncthreads();
}

DEVI void ret_out(const Params& p, int l, int item, char* smem) {
  const int c = item >> 2, hd = item & 3, t0 = c * 128;
  float* sQ = (float*)smem; float* sK = sQ + 128 * 65; float* sV = sK + 128 * 65; float* sSt = sV + 128 * 65;
  const int tid = TID(), lane = tid & 63, wave = tid >> 6, r = lane & 15, qd = lane >> 4;
  const float lg = logf(1.f - exp2f(-5.f - (float)hd));
  {
    const float* ssrc = p.ret_kv + (size_t)(c * 4 + hd) * 4096;
#pragma unroll
    for (int j = 0; j < 8; ++j) { int idx = tid + 512 * j; sSt[(idx >> 6) * 65 + (idx & 63)] = ssrc[idx]; }
  }
  for (int i = tid; i < 128 * 32; i += NT) {
    int t = i >> 5, f = i & 31; size_t tt = t0 + t;
    float cs = p.rope[(tt * 32 + f) * 2], sn = p.rope[(tt * 32 + f) * 2 + 1];
    float k1 = p.proj[tt * PW + RK + hd * 64 + f], k2 = p.proj[tt * PW + RK + hd * 64 + 32 + f];
    sK[t * 65 + f] = (k1 * cs - k2 * sn);
    sK[t * 65 + 32 + f] = (k2 * cs + k1 * sn);
    float q1 = p.proj[tt * PW + RQ + hd * 64 + f], q2 = p.proj[tt * PW + RQ + hd * 64 + 32 + f];
    sQ[t * 65 + f] = (q1 * cs - q2 * sn) * 0.125f;
    sQ[t * 65 + 32 + f] = (q2 * cs + q1 * sn) * 0.125f;
  }
  for (int i = tid; i < 128 * 64; i += NT) {
    int t = i >> 6, e = i & 63;
    sV[t * 65 + e] = p.proj[(size_t)(t0 + t) * PW + RV + hd * 64 + e];
  }
  __syncthreads();
  const int i0 = wave * 16;
  f32x4 sc[8], os[4];
#pragma unroll
  for (int t = 0; t < 8; ++t) sc[t] = f32x4{0.f, 0.f, 0.f, 0.f};
#pragma unroll
  for (int t = 0; t < 4; ++t) os[t] = f32x4{0.f, 0.f, 0.f, 0.f};
  mm16<8>(sc, sQ + i0 * 65, 65, 1, sK, 1, 65, 64);
  mm16<4>(os, sQ + i0 * 65, 65, 1, sSt, 65, 1, 64);
  __syncthreads();
  float* sP = (float*)smem;
#pragma unroll
  for (int t2 = 0; t2 < 8; ++t2)
#pragma unroll
    for (int e = 0; e < 4; ++e) {
      int i = i0 + 4 * qd + e, j = t2 * 16 + r;
      sP[i * 129 + j] = (i >= j) ? sc[t2][e] * expf(lg * (float)(i - j)) : 0.f;
    }
  __syncthreads();
  f32x4 o[4];
#pragma unroll
  for (int t2 = 0; t2 < 4; ++t2)
#pragma unroll
    for (int e = 0; e < 4; ++e) o[t2][e] = os[t2][e] * expf(lg * (float)(i0 + 4 * qd + e + 1));
  mm16<4>(o, sP + i0 * 129, 129, 1, sV, 65, 1, 128);
#pragma unroll
  for (int e = 0; e < 4; ++e) {
    int i = i0 + 4 * qd + e; size_t t = t0 + i;
    float sm = sum16(o[0][e] + o[1][e] + o[2][e] + o[3][e]);
    float mu = sm * (1.f / 64.f);
    float vr = 0.f;
#pragma unroll
    for (int t2 = 0; t2 < 4; ++t2) { float dd = o[t2][e] - mu; vr += dd * dd; }
    vr = sum16(vr);
    float rstd = rsqrtf(vr * (1.f / 64.f) + EPS);
    float ss = 0.f;
#pragma unroll
    for (int t2 = 0; t2 < 4; ++t2) {
      int col = hd * 64 + t2 * 16 + r;
      float on = (o[t2][e] - mu) * rstd * p.ret_gn[l * 256 + col];
      float g = p.proj[t * PW + RG + col];
      float y = siluf_(g) * on;
      ss += y * y;
      p.zb[t * DM + col] = f2bf(y * p.branch_norm[(l * 4 + 0) * 256 + col]);
    }
    ss = sum16(ss);
    if (r == 0) p.ssq[t * 16 + hd] = ss;
  }
  __syncthreads();
}

DEVI void lru_local(const Params& p, int l, int c, char* smem) {
  const int t0 = c * 64;
  float* sX = (float*)smem; float* sA = sX + 64 * 257;
  const int tid = TID(), lane = tid & 63, wave = tid >> 6, r = lane & 15, qd = lane >> 4;
  {
    const int ch = tid & 255, half = tid >> 8;
    const float w0 = p.lru_conv_w[(l * 4 + 0) * 256 + ch], w1 = p.lru_conv_w[(l * 4 + 1) * 256 + ch];
    const float w2 = p.lru_conv_w[(l * 4 + 2) * 256 + ch], w3 = p.lru_conv_w[(l * 4 + 3) * 256 + ch];
    const float cb = p.lru_conv_b[l * 256 + ch];
    const float* pc = p.proj + LX + ch;
    float xv[35];
#pragma unroll
    for (int k = 0; k < 35; ++k) {
      const int tt = t0 + 32 * half - 3 + k;
      const float v = pc[(size_t)(tt < 0 ? 0 : tt) * PW];
      xv[k] = tt < 0 ? 0.f : v;
    }
#pragma unroll
    for (int m = 0; m < 32; ++m) {
      float acc = cb;
      acc += w0 * xv[m]; acc += w1 * xv[m + 1]; acc += w2 * xv[m + 2]; acc += w3 * xv[m + 3];
      sX[(32 * half + m) * 257 + ch] = acc;
    }
  }
  __syncthreads();
  for (int pr = 0; pr < 2; ++pr) {
    int pi = wave * 2 + pr, mt = pi & 3, nb = pi >> 2;
    f32x4 ra[4], ri[4];
#pragma unroll
    for (int t = 0; t < 4; ++t) { ra[t] = f32x4{0.f, 0.f, 0.f, 0.f}; ri[t] = f32x4{0.f, 0.f, 0.f, 0.f}; }
    mm16_gB64<4>(ra, sX + mt * 16 * 257 + nb * 64, 257, p.lru_w_a + (size_t)(l * 4 + nb) * 4096);
    mm16_gB64<4>(ri, sX + mt * 16 * 257 + nb * 64, 257, p.lru_w_x + (size_t)(l * 4 + nb) * 4096);
#pragma unroll
    for (int t2 = 0; t2 < 4; ++t2)
#pragma unroll
      for (int e = 0; e < 4; ++e) {
        int t = mt * 16 + 4 * qd + e, ch = nb * 64 + t2 * 16 + r;
        float xb = sX[t * 257 + ch];
        float rr = sigmoidf_(ra[t2][e] + p.lru_b_a[l * 256 + ch]);
        float ii = sigmoidf_(ri[t2][e] + p.lru_b_x[l * 256 + ch]);
        float loga = -8.f * rr * softplusf_(-p.lru_lambda[l * 256 + ch]);
        float a = expf(loga);
        float bb = sqrtf(-expm1f(2.f * loga)) * (ii * xb);
        sA[t * 257 + ch] = a; sX[t * 257 + ch] = bb;
      }
  }
  __syncthreads();
  if (tid < 256) {
    int ch = tid; float H = 0.f, P = 1.f;
    for (int t = 0; t < 64; ++t) {
      float a = sA[t * 257 + ch], bb = sX[t * 257 + ch];
      H = a * H + bb; P *= a;
      p.lru_h[(size_t)(t0 + t) * 256 + ch] = H; p.lru_p[(size_t)(t0 + t) * 256 + ch] = P;
    }
    p.lru_hs[c * 256 + ch] = H; p.lru_ps[c * 256 + ch] = P;
  }
  __syncthreads();
}

DEVI void lru_out(const Params& p, int l, int c, char* smem) {
  const int t0 = c * 64;
  float* sC = (float*)smem;
  const int tid = TID(), lane = tid & 63, wave = tid >> 6;
  if (tid < 256) sC[tid] = p.lru_hs[c * 256 + tid];
  __syncthreads();
  for (int tk = 0; tk < 8; ++tk) {
    size_t t = t0 + wave * 8 + tk; int ch = lane * 4;
    float4 H = *(const float4*)&p.lru_h[t * 256 + ch], P = *(const float4*)&p.lru_p[t * 256 + ch];
    float4 g = *(const float4*)&p.proj[t * PW + LG + ch], cr = *(const float4*)&sC[ch];
    float4 bn = *(const float4*)&p.branch_norm[(l * 4 + 1) * 256 + ch];
    float y0 = geluf_(g.x) * (H.x + P.x * cr.x), y1 = geluf_(g.y) * (H.y + P.y * cr.y);
    float y2 = geluf_(g.z) * (H.z + P.z * cr.z), y3 = geluf_(g.w) * (H.w + P.w * cr.w);
    float ss = wave_sum(y0 * y0 + y1 * y1 + y2 * y2 + y3 * y3);
    if (lane == 0) p.ssq[t * 16 + 4] = ss;
    *(uint2*)&p.zb[t * DM + 256 + ch] = uint2{pack2(y0 * bn.x, y1 * bn.y), pack2(y2 * bn.z, y3 * bn.w)};
  }
  __syncthreads();
}

DEVI void s5_coef(const Params& p, int l, int g, int n, float& abr, float& abi, float (&bbr)[16], float (&bbi)[16]) {
  float dt = expf(p.s5_log_dt[l * 16 + g]);
  float are = p.s5_a_re[(l * 16 + g) * 64 + n], aim = p.s5_a_im[(l * 16 + g) * 64 + n];
  float mag = expf(are * dt), ang = aim * dt;
  abr = mag * cosf(ang); abi = mag * sinf(ang);
  float den = are * are + aim * aim;
  float pre = abr - 1.f, pim = abi;
  float fre = (pre * are + pim * aim) / den, fim = (pim * are - pre * aim) / den;
  const float4* br = (const float4*)(p.s5_b_re + (size_t)((l * 16 + g) * 64 + n) * 16);
  const float4* bi = (const float4*)(p.s5_b_im + (size_t)((l * 16 + g) * 64 + n) * 16);
#pragma unroll
  for (int c4 = 0; c4 < 4; ++c4) {
    float4 a = br[c4], b = bi[c4];
    bbr[c4 * 4 + 0] = fre * a.x - fim * b.x; bbi[c4 * 4 + 0] = fre * b.x + fim * a.x;
    bbr[c4 * 4 + 1] = fre * a.y - fim * b.y; bbi[c4 * 4 + 1] = fre * b.y + fim * a.y;
    bbr[c4 * 4 + 2] = fre * a.z - fim * b.z; bbi[c4 * 4 + 2] = fre * b.z + fim * a.z;
    bbr[c4 * 4 + 3] = fre * a.w - fim * b.w; bbi[c4 * 4 + 3] = fre * b.w + fim * a.w;
  }
}
DEVI void s5_load_u(const Params& p, int t0, float* sU) {
  for (int i = TID(); i < 64 * 64; i += NT) {
    int t = i >> 6, c4 = i & 63;
    *(float4*)&sU[t * 256 + c4 * 4] = *(const float4*)&p.proj[(size_t)(t0 + t) * PW + SU + c4 * 4];
  }
}
DEVI void s5_bu(const float* up, const float (&bbr)[16], const float (&bbi)[16], float& bur, float& bui) {
  bur = 0.f; bui = 0.f;
#pragma unroll
  for (int c4 = 0; c4 < 4; ++c4) {
    float4 u = *(const float4*)&up[c4 * 4];
    bur += bbr[c4 * 4] * u.x + bbr[c4 * 4 + 1] * u.y + bbr[c4 * 4 + 2] * u.z + bbr[c4 * 4 + 3] * u.w;
    bui += bbi[c4 * 4] * u.x + bbi[c4 * 4 + 1] * u.y + bbi[c4 * 4 + 2] * u.z + bbi[c4 * 4 + 3] * u.w;
  }
}

DEVI void s5_local(const Params& p, int l, int c, char* smem) {
  const int t0 = c * 64;
  float* sU = (float*)smem;
  const int lane = TID() & 63, wave = TID() >> 6;
  s5_load_u(p, t0, sU);
  __syncthreads();
  for (int gi = 0; gi < 2; ++gi) {
    int g = wave + 8 * gi;
    float abr, abi, bbr[16], bbi[16];
    s5_coef(p, l, g, lane, abr, abi, bbr, bbi);
    float xr = 0.f, xi = 0.f;
    for (int t = 0; t < 64; ++t) {
      float bur, bui; s5_bu(sU + t * 256 + g * 16, bbr, bbi, bur, bui);
      float nr = abr * xr - abi * xi + bur, ni = abr * xi + abi * xr + bui;
      xr = nr; xi = ni;
    }
    *(float2*)&p.xloc[((size_t)(c * 16 + g) * 64 + lane) * 2] = float2{xr, xi};
  }
  __syncthreads();
}

DEVI void s5_out(const Params& p, int l, int c, char* smem) {
  const int t0 = c * 64;
  bf16_t* sY = (bf16_t*)smem;
  float* sX = (float*)(smem + 64 * 264 * 2);
  const int tid = TID(), lane = tid & 63, wave = tid >> 6, r = lane & 15, qd = lane >> 4;
  float* Xl = sX + wave * (16 * 132);
  for (int gi = 0; gi < 2; ++gi) {
    const int g = wave + 8 * gi;
    float abr, abi, bbr[16], bbi[16];
    s5_coef(p, l, g, lane, abr, abi, bbr, bbi);
    float breg[32];
#pragma unroll
    for (int ks = 0; ks < 16; ++ks) {
      breg[ks] = p.s5_c_re[(size_t)((l * 16 + g) * 16 + r) * 64 + 4 * ks + qd];
      breg[16 + ks] = -p.s5_c_im[(size_t)((l * 16 + g) * 16 + r) * 64 + 4 * ks + qd];
    }
    const float dd = p.s5_d[l * 256 + g * 16 + r];
    const float2 xin = *(const float2*)&p.xloc[((size_t)(c * 16 + g) * 64 + lane) * 2];
    float xr = xin.x, xi = xin.y;
    float4 uvecs[4]; float ues[4][4];
#pragma unroll
    for (int tb = 0; tb < 4; ++tb) {
      const float* ub = p.proj + (size_t)(t0 + tb * 16) * PW + SU + g * 16;
      uvecs[tb] = *(const float4*)&ub[(size_t)r * PW + 4 * qd];
#pragma unroll
      for (int e = 0; e < 4; ++e) ues[tb][e] = ub[(size_t)(4 * qd + e) * PW + r];
    }
#pragma unroll
    for (int tb = 0; tb < 4; ++tb) {
      const float4 uvec = uvecs[tb];
      float ue[4];
#pragma unroll
      for (int e = 0; e < 4; ++e) ue[e] = ues[tb][e];
      const int u0 = __float_as_int(uvec.x), u1 = __float_as_int(uvec.y), u2 = __float_as_int(uvec.z), u3 = __float_as_int(uvec.w);
#pragma unroll
      for (int tt = 0; tt < 16; ++tt) {
        float bur = 0.f, bui = 0.f;
#pragma unroll
        for (int c4 = 0; c4 < 4; ++c4) {
          float a0 = __int_as_float(__builtin_amdgcn_readlane(u0, tt + 16 * c4));
          float a1 = __int_as_float(__builtin_amdgcn_readlane(u1, tt + 16 * c4));
          float a2 = __int_as_float(__builtin_amdgcn_readlane(u2, tt + 16 * c4));
          float a3 = __int_as_float(__builtin_amdgcn_readlane(u3, tt + 16 * c4));
          bur += bbr[c4 * 4] * a0 + bbr[c4 * 4 + 1] * a1 + bbr[c4 * 4 + 2] * a2 + bbr[c4 * 4 + 3] * a3;
          bui += bbi[c4 * 4] * a0 + bbi[c4 * 4 + 1] * a1 + bbi[c4 * 4 + 2] * a2 + bbi[c4 * 4 + 3] * a3;
        }
        float nr = abr * xr - abi * xi + bur, ni = abr * xi + abi * xr + bui;
        xr = nr; xi = ni;
        Xl[tt * 132 + lane] = xr; Xl[tt * 132 + 64 + lane] = xi;
      }
      f32x4 acc = f32x4{0.f, 0.f, 0.f, 0.f};
#pragma unroll
      for (int ks = 0; ks < 32; ++ks) {
        float a = Xl[r * 132 + 4 * ks + qd];
        acc = __builtin_amdgcn_mfma_f32_16x16x4f32(a, breg[ks], acc, 0, 0, 0);
      }
#pragma unroll
      for (int e = 0; e < 4; ++e) {
        float y = acc[e] + dd * ue[e];
        sY[(tb * 16 + 4 * qd + e) * 264 + g * 16 + r] = f2bf(geluf_(y));
      }
    }
  }
  __syncthreads();
  f32x4 av[4][2], ag[4][2];
#pragma unroll
  for (int i = 0; i < 4; ++i)
#pragma unroll
    for (int j = 0; j < 2; ++j) { av[i][j] = f32x4{0.f, 0.f, 0.f, 0.f}; ag[i][j] = f32x4{0.f, 0.f, 0.f, 0.f}; }
  const bf16_t* WT = p.gluT + (size_t)l * 512 * 256;
#pragma unroll 4
  for (int ks = 0; ks < 8; ++ks) {
    bf16x8 bv0 = *(const bf16x8*)&WT[(size_t)(32 * wave + r) * 256 + ks * 32 + qd * 8];
    bf16x8 bv1 = *(const bf16x8*)&WT[(size_t)(32 * wave + 16 + r) * 256 + ks * 32 + qd * 8];
    bf16x8 bg0 = *(const bf16x8*)&WT[(size_t)(256 + 32 * wave + r) * 256 + ks * 32 + qd * 8];
    bf16x8 bg1 = *(const bf16x8*)&WT[(size_t)(256 + 32 * wave + 16 + r) * 256 + ks * 32 + qd * 8];
#pragma unroll
    for (int mt = 0; mt < 4; ++mt) {
      bf16x8 a = *(const bf16x8*)&sY[(mt * 16 + r) * 264 + ks * 32 + qd * 8];
      av[mt][0] = __builtin_amdgcn_mfma_f32_16x16x32_bf16(a, bv0, av[mt][0], 0, 0, 0);
      av[mt][1] = __builtin_amdgcn_mfma_f32_16x16x32_bf16(a, bv1, av[mt][1], 0, 0, 0);
      ag[mt][0] = __builtin_amdgcn_mfma_f32_16x16x32_bf16(a, bg0, ag[mt][0], 0, 0, 0);
      ag[mt][1] = __builtin_amdgcn_mfma_f32_16x16x32_bf16(a, bg1, ag[mt][1], 0, 0, 0);
    }
  }
  float* sO = sX;
#pragma unroll
  for (int mt = 0; mt < 4; ++mt)
#pragma unroll
    for (int t2 = 0; t2 < 2; ++t2)
#pragma unroll
      for (int e = 0; e < 4; ++e) {
        int t = mt * 16 + 4 * qd + e, col = 32 * wave + t2 * 16 + r;
        float zv = av[mt][t2][e] + p.s5_glu_b[l * 512 + col];
        float zg = ag[mt][t2][e] + p.s5_glu_b[l * 512 + 256 + col];
        sO[t * 256 + col] = zv * sigmoidf_(zg);
      }
  __syncthreads();
  for (int tk = 0; tk < 8; ++tk) {
    int tl = wave * 8 + tk; size_t t = t0 + tl; int ch = lane * 4;
    float4 o = *(const float4*)&sO[tl * 256 + ch];
    float4 bn = *(const float4*)&p.branch_norm[(l * 4 + 2) * 256 + ch];
    float ss = wave_sum(o.x * o.x + o.y * o.y + o.z * o.z + o.w * o.w);
    if (lane == 0) p.ssq[t * 16 + 5] = ss;
    *(uint2*)&p.zb[t * DM + 512 + ch] = uint2{pack2(o.x * bn.x, o.y * bn.y), pack2(o.z * bn.z, o.w * bn.w)};
  }
  __syncthreads();
}

DEVI void ret_scan(const Params& p, int it) {
  const int elem = it * NT + TID(), hd = elem >> 12, idx = elem & 4095;
  const float lg = logf(1.f - exp2f(-5.f - (float)hd)), cdk = expf(lg * 128.f);
  float* base = p.ret_kv + (size_t)hd * 4096 + idx;
  float s = 0.f;
  for (int cb = 0; cb < 128; cb += 16) {
    float v[16];
#pragma unroll
    for (int j = 0; j < 16; ++j) v[j] = base[(size_t)(cb + j) * 16384];
#pragma unroll
    for (int j = 0; j < 16; ++j) { base[(size_t)(cb + j) * 16384] = s; s = s * cdk + v[j]; }
  }
}
DEVI void s5_scan(const Params& p, int l, int it) {
  const int sidx = it * NT + TID(), g = sidx >> 6, n = sidx & 63;
  float dt = expf(p.s5_log_dt[l * 16 + g]);
  float are = p.s5_a_re[(l * 16 + g) * 64 + n], aim = p.s5_a_im[(l * 16 + g) * 64 + n];
  float mag = expf(are * dt), ang = aim * dt;
  float pr = mag * cosf(ang), pi = mag * sinf(ang);
#pragma unroll
  for (int k = 0; k < 6; ++k) { float nr = pr * pr - pi * pi, ni = 2.f * pr * pi; pr = nr; pi = ni; }
  float2* base = (float2*)p.xloc + sidx;
  float xr = 0.f, xi = 0.f;
  for (int cb = 0; cb < 256; cb += 16) {
    float2 v[16];
#pragma unroll
    for (int j = 0; j < 16; ++j) v[j] = base[(size_t)(cb + j) * 1024];
#pragma unroll
    for (int j = 0; j < 16; ++j) {
      base[(size_t)(cb + j) * 1024] = float2{xr, xi};
      float nr = pr * xr - pi * xi + v[j].x, ni = pr * xi + pi * xr + v[j].y;
      xr = nr; xi = ni;
    }
  }
}
DEVI void lru_scan(const Params& p) {
  const int ch = TID();
  if (ch < 256) {
    float carry = 0.f;
    for (int cb = 0; cb < 256; cb += 16) {
      float ps[16], hs[16];
#pragma unroll
      for (int j = 0; j < 16; ++j) { ps[j] = p.lru_ps[(cb + j) * 256 + ch]; hs[j] = p.lru_hs[(cb + j) * 256 + ch]; }
#pragma unroll
      for (int j = 0; j < 16; ++j) { p.lru_hs[(cb + j) * 256 + ch] = carry; carry = ps[j] * carry + hs[j]; }
    }
  }
}

DEVI void peer_scores(const Params& p, int l, int item, char* smem) {
  const int hp = item & 15, grp = item >> 4;
  float* sQ = (float*)smem;
  float* sKy = sQ + 64 * 68;
  const int tid = TID(), lane = tid & 63, wave = tid >> 6, r = lane & 15, qd = lane >> 4;
  const float* ky = p.peer_subkeys + (size_t)(l * 16 + hp) * 8192;
  for (int i = tid; i < 128 * 64; i += NT) { int k = i >> 6, d = i & 63; sKy[k * 65 + d] = ky[i]; }
  const int lt0 = tid >> 4, lc4 = (tid & 15) * 4;
  const float* qb = p.qbuf + (size_t)hp * 64 + lc4;
  float4 q0, q1;
  {
    const size_t t0 = (size_t)(grp * 16) * 64;
    q0 = *(const float4*)&qb[(t0 + lt0) * 1024]; q1 = *(const float4*)&qb[(t0 + lt0 + 32) * 1024];
  }
  const int mt = wave & 3, nh = wave >> 2;
  for (int k = 0; k < 16; ++k) {
    const size_t t0 = (size_t)(grp * 16 + k) * 64;
    __syncthreads();
    *(float4*)&sQ[lt0 * 68 + lc4] = q0; *(float4*)&sQ[(lt0 + 32) * 68 + lc4] = q1;
    __syncthreads();
    if (k + 1 < 16) { q0 = *(const float4*)&qb[(t0 + 64 + lt0) * 1024]; q1 = *(const float4*)&qb[(t0 + 64 + lt0 + 32) * 1024]; }
    f32x4 acc[4];
#pragma unroll
    for (int t = 0; t < 4; ++t) acc[t] = f32x4{0.f, 0.f, 0.f, 0.f};
    mm16<4>(acc, sQ + mt * 16 * 68, 68, 1, sKy + nh * 64 * 65, 1, 65, 64);
#pragma unroll
    for (int t2 = 0; t2 < 4; ++t2)
#pragma unroll
      for (int e = 0; e < 4; ++e) {
        size_t t = t0 + mt * 16 + 4 * qd + e; int key = nh * 64 + t2 * 16 + r;
        p.scores[(t * 16 + hp) * 128 + key] = acc[t2][e];
      }
  }
  __syncthreads();
}

DEVI unsigned ford(float x) { unsigned u = __float_as_uint(x); return (u & 0x80000000u) ? ~u : (u | 0x80000000u); }
DEVI float funord(unsigned u) { return __uint_as_float((u & 0x80000000u) ? (u ^ 0x80000000u) : ~u); }
DEVI void ins16(unsigned (&v)[16], unsigned x) {
#pragma unroll
  for (int j = 0; j < 16; ++j) { unsigned hi = max(v[j], x); x = min(v[j], x); v[j] = hi; }
}

DEVI void peer_topk(const Params& p, int item, char* smem) {
  const int t0 = item * 64;
  float* sS = (float*)smem;
  const int tid = TID();
  const float* base = p.scores + (size_t)t0 * 8 * 256;
  unsigned v1[16], v2[16];
#pragma unroll
  for (int j = 0; j < 16; ++j) { v1[j] = 0u; v2[j] = 0u; }
  for (int s = 0; s < 8; ++s) {
    __syncthreads();
#pragma unroll
    for (int i = 0; i < 8; ++i) {
      int idx = tid + 512 * i, pr = idx >> 3, c4 = idx & 7;
      float4 v = *(const float4*)&base[(size_t)pr * 256 + s * 32 + c4 * 4];
      float* d = &sS[pr * 33 + c4 * 4];
      d[0] = v.x; d[1] = v.y; d[2] = v.z; d[3] = v.w;
    }
    __syncthreads();
    const int kb = (s & 3) * 32;
    if (s < 4) {
      for (int k = 0; k < 32; ++k) { unsigned key = (ford(sS[tid * 33 + k]) & ~127u) | (unsigned)(127 - (kb + k)); ins16(v1, key); }
    } else {
      for (int k = 0; k < 32; ++k) { unsigned key = (ford(sS[tid * 33 + k]) & ~127u) | (unsigned)(127 - (kb + k)); ins16(v2, key); }
    }
  }
  __syncthreads();
  unsigned* sI = (unsigned*)smem;
  float s1[16], s2[16];
#pragma unroll
  for (int a = 0; a < 16; ++a) {
    s1[a] = funord(v1[a] & ~127u); s2[a] = funord(v2[a] & ~127u);
    sI[tid * 33 + a] = 127u - (v1[a] & 127u); sI[tid * 33 + 16 + a] = 127u - (v2[a] & 127u);
  }
  unsigned vt[16];
#pragma unroll
  for (int j = 0; j < 16; ++j) vt[j] = 0u;
#pragma unroll
  for (int a = 0; a < 16; ++a)
#pragma unroll
    for (int b = 0; b < 16; ++b)
      if ((a + 1) * (b + 1) <= 16) {
        unsigned key = (ford(s1[a] + s2[b]) & ~255u) | (unsigned)(255 - (a * 16 + b));
        ins16(vt, key);
      }
  float sv[16]; float den = 0.f;
  const float mx = funord(vt[0] & ~255u);
#pragma unroll
  for (int k = 0; k < 16; ++k) { sv[k] = expf(funord(vt[k] & ~255u) - mx); den += sv[k]; }
  const float inv = 1.f / den;
  const int tl = tid >> 3, hh = tid & 7;
  int* idp = p.ids + (size_t)(t0 + tl) * 128 + hh * 16;
  float* gp = p.gates + (size_t)(t0 + tl) * 128 + hh * 16;
#pragma unroll
  for (int k = 0; k < 16; ++k) {
    unsigned pos = 255u - (vt[k] & 255u);
    unsigned i1 = sI[tid * 33 + (pos >> 4)], i2 = sI[tid * 33 + 16 + (pos & 15)];
    idp[k] = (int)(i1 * 128u + i2);
    gp[k] = sv[k] * inv;
  }
  __syncthreads();
}

typedef __attribute__((ext_vector_type(2))) float f32x2;
DEVI void fp8x16_to_f(const uint4& v, float (&o)[16]) {
  f32x2 t;
  t = __builtin_amdgcn_cvt_pk_f32_fp8((int)v.x, false); o[0] = t[0]; o[1] = t[1];
  t = __builtin_amdgcn_cvt_pk_f32_fp8((int)v.x, true); o[2] = t[0]; o[3] = t[1];
  t = __builtin_amdgcn_cvt_pk_f32_fp8((int)v.y, false); o[4] = t[0]; o[5] = t[1];
  t = __builtin_amdgcn_cvt_pk_f32_fp8((int)v.y, true); o[6] = t[0]; o[7] = t[1];
  t = __builtin_amdgcn_cvt_pk_f32_fp8((int)v.z, false); o[8] = t[0]; o[9] = t[1];
  t = __builtin_amdgcn_cvt_pk_f32_fp8((int)v.z, true); o[10] = t[0]; o[11] = t[1];
  t = __builtin_amdgcn_cvt_pk_f32_fp8((int)v.w, false); o[12] = t[0]; o[13] = t[1];
  t = __builtin_amdgcn_cvt_pk_f32_fp8((int)v.w, true); o[14] = t[0]; o[15] = t[1];
}

DEVI void ph_gather(const Params& p, int l) {
  const int lane = TID() & 63, wave = TID() >> 6;
  const int e0 = lane * 16;
  constexpr int NB = 8;
  for (int t = blockIdx.x * 8 + wave; t < S_; t += gridDim.x * 8) {
    float* hrow = p.h + (size_t)t * DM + e0;
    float z[16], out[16];
    {
      float4 a = *(const float4*)&hrow[0], b = *(const float4*)&hrow[4], c = *(const float4*)&hrow[8], d = *(const float4*)&hrow[12];
      z[0] = a.x; z[1] = a.y; z[2] = a.z; z[3] = a.w; z[4] = b.x; z[5] = b.y; z[6] = b.z; z[7] = b.w;
      z[8] = c.x; z[9] = c.y; z[10] = c.z; z[11] = c.w; z[12] = d.x; z[13] = d.y; z[14] = d.z; z[15] = d.w;
    }
    float ss = 0.f;
#pragma unroll
    for (int k = 0; k < 16; ++k) { ss += z[k] * z[k]; out[k] = 0.f; }
    ss = wave_sum(ss);
    const float rs = rsqrtf(ss * (1.f / DM) + EPS);
    const float* fn = p.ffn_norm + l * DM + e0;
#pragma unroll
    for (int k = 0; k < 16; ++k) z[k] = z[k] * rs * fn[k];
    const int id0 = p.ids[(size_t)t * 128 + lane], id1 = p.ids[(size_t)t * 128 + 64 + lane];
    const int gv0 = __float_as_int(p.gates[(size_t)t * 128 + lane] * p.vinv[id0]);
    const int gv1 = __float_as_int(p.gates[(size_t)t * 128 + 64 + lane] * p.vinv[id1]);
    const int us0 = __float_as_int(p.uinv[id0]), us1 = __float_as_int(p.uinv[id1]);
    uint4 cu[NB], cv[NB], nu[NB], nv[NB];
#pragma unroll
    for (int j = 0; j < NB; ++j) {
      int e = __builtin_amdgcn_readlane(id0, j);
      cu[j] = *(const uint4*)(p.tabU + (size_t)e * 1024 + e0);
      cv[j] = *(const uint4*)(p.tabV + (size_t)e * 1024 + e0);
    }
#pragma unroll 1
    for (int b = 0; b < 128 / NB; ++b) {
      const int nb = b + 1;
      if (nb < 128 / NB) {
        const int idn = nb < 64 / NB ? id0 : id1;
#pragma unroll
        for (int j = 0; j < NB; ++j) {
          int e = __builtin_amdgcn_readlane(idn, (nb * NB + j) & 63);
          nu[j] = *(const uint4*)(p.tabU + (size_t)e * 1024 + e0);
          nv[j] = *(const uint4*)(p.tabV + (size_t)e * 1024 + e0);
        }
      }
      const int gvc = b < 64 / NB ? gv0 : gv1, usc = b < 64 / NB ? us0 : us1;
      float dot[NB];
#pragma unroll
      for (int j = 0; j < NB; ++j) {
        float f[16]; fp8x16_to_f(cu[j], f);
        float d = 0.f;
#pragma unroll
        for (int k = 0; k < 16; ++k) d += z[k] * f[k];
        dot[j] = d;
      }
#pragma unroll
      for (int j = 0; j < NB; ++j) dot[j] = wave_sum(dot[j]);
#pragma unroll
      for (int j = 0; j < NB; ++j) {
        const int li = (b * NB + j) & 63;
        float us = __int_as_float(__builtin_amdgcn_readlane(usc, li));
        float gt = __int_as_float(__builtin_amdgcn_readlane(gvc, li));
        float cf = gt * geluf_(dot[j] * us);
        float f[16]; fp8x16_to_f(cv[j], f);
#pragma unroll
        for (int k = 0; k < 16; ++k) out[k] += cf * f[k];
      }
#pragma unroll
      for (int j = 0; j < NB; ++j) { cu[j] = nu[j]; cv[j] = nv[j]; }
    }
    float hv[16];
    {
      float4 a = *(const float4*)&hrow[0], b = *(const float4*)&hrow[4], c = *(const float4*)&hrow[8], d = *(const float4*)&hrow[12];
      hv[0] = a.x; hv[1] = a.y; hv[2] = a.z; hv[3] = a.w; hv[4] = b.x; hv[5] = b.y; hv[6] = b.z; hv[7] = b.w;
      hv[8] = c.x; hv[9] = c.y; hv[10] = c.z; hv[11] = c.w; hv[12] = d.x; hv[13] = d.y; hv[14] = d.z; hv[15] = d.w;
    }
    float s2 = 0.f;
#pragma unroll
    for (int k = 0; k < 16; ++k) { hv[k] += out[k]; s2 += hv[k] * hv[k]; }
    *(float4*)&hrow[0] = float4{hv[0], hv[1], hv[2], hv[3]}; *(float4*)&hrow[4] = float4{hv[4], hv[5], hv[6], hv[7]};
    *(float4*)&hrow[8] = float4{hv[8], hv[9], hv[10], hv[11]}; *(float4*)&hrow[12] = float4{hv[12], hv[13], hv[14], hv[15]};
    s2 = wave_sum(s2);
    const float rs2 = rsqrtf(s2 * (1.f / DM) + EPS);
    const float* pn = p.ple_norm + l * DM + e0;
    float zz[16];
#pragma unroll
    for (int k = 0; k < 16; ++k) zz[k] = hv[k] * rs2 * pn[k];
    bf16_t* zrow = p.zb + (size_t)t * DM + e0;
    *(uint4*)&zrow[0] = uint4{pack2(zz[0], zz[1]), pack2(zz[2], zz[3]), pack2(zz[4], zz[5]), pack2(zz[6], zz[7])};
    *(uint4*)&zrow[8] = uint4{pack2(zz[8], zz[9]), pack2(zz[10], zz[11]), pack2(zz[12], zz[13]), pack2(zz[14], zz[15])};
  }
}

template <class F>
DEVI void gemm_tiles(int NTn, int XM, int XN, F&& f) {
  int G = gridDim.x, B = blockIdx.x;
  asm volatile("" : "+s"(G), "+s"(B));
  if (G & 7) { for (int tile = B; tile < 64 * NTn; tile += G) f(tile / NTn, tile % NTn); return; }
  const int x = B & 7, slot = B >> 3, ns = G >> 3;
  const int xm = x / XN, xn = x % XN;
  const int mcnt = 64 / XM, mb = xm * mcnt;
  const int ncnt = (NTn - xn + XN - 1) / XN;
  for (int j = slot; j < mcnt * ncnt; j += ns) f(mb + j / ncnt, xn + XN * (j % ncnt));
}

enum { PH_PREP = 0, PH_NORM1, PH_GEMM_IN, PH_MIX_A, PH_MIX_B, PH_MIX_C, PH_MIX_D, PH_GEMM_OUT, PH_NORM2, PH_GEMM_Q, PH_SCORES,
       PH_TOPK, PH_GATHER, PH_GEMM_PLE, PH_FINAL };

#if PROBE_A >= 0
#define REGION(id, stmt)                                                                                   \
  {                                                                                                        \
    const bool on_ = (blockIdx.x == 255 && TID() == 0 && ((id) == PROBE_A || (id) == PROBE_B));              \
    if (on_) p.g_cdec[2051] = (float)(wall_clock64() & 0xFFFFFFull);                                       \
    stmt;                                                                                                  \
    if (on_) {                                                                                             \
      float dt_ = (float)(wall_clock64() & 0xFFFFFFull) - p.g_cdec[2051];                                  \
      if (dt_ < 0.f) dt_ += 16777216.f;                                                                    \
      p.g_cdec[(id) == PROBE_A ? 2048 : 2049] += dt_;                                                      \
    }                                                                                                      \
  }
#else
#define REGION(id, stmt) { stmt; }
#endif
DEVI void run_phase(const Params& p, int ph, int l, char* smem) {
  int G = gridDim.x, B = blockIdx.x;
  asm volatile("" : "+s"(G), "+s"(B));
  switch (ph) {
    case PH_PREP: ph_prep(p, smem); break;
    case PH_NORM1: ph_norm(l == 0 ? p.x : p.h, p.mix_norm + l * DM, p.zb, nullptr); break;
    case PH_GEMM_IN:
      gemm_tiles(23, 1, 8, [&](int mt_, int nt_) __attribute__((always_inline)) {
        int m0 = mt_ * 256, n0 = nt_ * 128;
        f32x4 acc[4][4];
        gemm_tile<0, 16>(acc, p.zb, DM, p.winT + (size_t)l * PW * 1024, 1024, 1024, m0, n0, nullptr, smem);
        GEMM_EPI_COORDS
#pragma unroll
        for (int i = 0; i < 4; ++i)
#pragma unroll
          for (int j = 0; j < 4; ++j)
            *(f32x4*)&p.proj[(size_t)(erow0 + i * 16) * PW + ecol0 + j * 16] = acc[i][j];
      });
      break;
    case PH_MIX_A:
      for (int it = B; it < 2048; it += G) {
        if (it < 1024) REGION(105, gdn_prep(p, l, it, smem))
        else if (it < 1536) REGION(106, ret_kv(p, l, it - 1024, smem))
        else if (it < 1792) REGION(107, lru_local(p, l, it - 1536, smem))
        else REGION(108, s5_local(p, l, it - 1792, smem))
      }
      break;
    case PH_MIX_B:
      for (int it = B; it < 256 + 35; it += G) {
        if (it < 256) { const int pr_ = (it & 7) * 4 + (it >> 6), cb_ = (it >> 3) & 7; REGION(100, gdn_chain<0>(p, pr_ >> 3, pr_ & 7, cb_, smem)) }
        else if (it < 256 + 32) ret_scan(p, it - 256);
        else if (it < 256 + 34) s5_scan(p, l, it - 288);
        else lru_scan(p);
      }
      break;
    case PH_MIX_C: {
      for (int it = B; it < 128; it += G) {
        const int pr_ = (it & 7) * 4 + (it >> 5), cb_ = (it >> 3) & 3;
        REGION(102, gdn_chain<1>(p, pr_ >> 3, pr_ & 7, cb_, smem))
      }
      int jb = B, js = G, je = 1024;
      if (G == 256) {
        js = 1;
        if (B < 128) { jb = 640 + B * 3; je = jb + 3; } else { jb = (B - 128) * 5; je = jb + 5; }
      }
      for (int j = jb; j < je; j += js) {
        const int ty = j & 3, q4 = j >> 2;
        if (ty < 2) REGION(101, ret_out(p, l, q4 * 2 + ty, smem))
        else if (ty == 2) REGION(103, s5_out(p, l, q4, smem))
        else REGION(104, lru_out(p, l, q4, smem))
      }
    } break;
    case PH_MIX_D:
      for (int it = B; it < 1024; it += G) REGION(109, gdn_out(p, l, it, smem))
      break;
    case PH_GEMM_OUT:
      gemm_tiles(8, 4, 2, [&](int mt_, int nt_) __attribute__((always_inline)) {
        int m0 = mt_ * 256, n0 = nt_ * 128;
        f32x4 acc[4][4];
        gemm_tile<1, 16>(acc, p.zb, DM, p.woutT + (size_t)l * 1024 * 1024, 1024, 1024, m0, n0, p.ssq, smem);
        GEMM_EPI_COORDS
#pragma unroll
        for (int i = 0; i < 4; ++i)
#pragma unroll
          for (int j = 0; j < 4; ++j) {
            const size_t ho = (size_t)(erow0 + i * 16) * DM + ecol0 + j * 16;
            *(f32x4*)&p.h[ho] = *(const f32x4*)&(l == 0 ? p.x : p.h)[ho] + acc[i][j];
          }
      });
      break;
    case PH_NORM2:
      ph_norm(p.h, p.ffn_norm + l * DM, p.zb, nullptr);
      convert_tables(p, l);
      {
        const size_t gtid = (size_t)B * NT + TID(), gsz = (size_t)G * NT;
        const float4* sp = (const float4*)(p.p + (size_t)l * S_ * 256);
        for (size_t i = gtid; i < (size_t)S_ * 256 / 8; i += gsz) {
          float4 a = sp[2 * i], b = sp[2 * i + 1];
          ((uint4*)p.pbf)[i] = uint4{pack2(a.x, a.y), pack2(a.z, a.w), pack2(b.x, b.y), pack2(b.z, b.w)};
        }
      }
      break;
    case PH_GEMM_Q:
      gemm_tiles(8, 4, 2, [&](int mt_, int nt_) __attribute__((always_inline)) {
        int m0 = mt_ * 256, n0 = nt_ * 128;
        f32x4 acc[4][4];
        gemm_tile<0, 16>(acc, p.zb, DM, p.wqT + (size_t)l * 1024 * 1024, 1024, 1024, m0, n0, nullptr, smem);
        GEMM_EPI_COORDS
#pragma unroll
        for (int i = 0; i < 4; ++i)
#pragma unroll
          for (int j = 0; j < 4; ++j)
            *(f32x4*)&p.qbuf[(size_t)(erow0 + i * 16) * DM + ecol0 + j * 16] = acc[i][j];
      });
      break;
    case PH_SCORES:
      for (int it = B; it < 256; it += G) REGION(110, peer_scores(p, l, it, smem))
      break;
    case PH_TOPK:
      for (int it = B; it < 256; it += G) REGION(111, peer_topk(p, it, smem))
      break;
    case PH_GATHER: ph_gather(p, l); break;
    case PH_GEMM_PLE:
      gemm_tiles(8, 4, 2, [&](int mt_, int nt_) __attribute__((always_inline)) {
        int m0 = mt_ * 256, n0 = nt_ * 128;
        uint2* gsc = (uint2*)p.g_attn + (size_t)B * 16 * NT + TID();
        {
          f32x4 ag[4][4];
          gemm_tile<0, 16>(ag, p.zb, DM, p.wgT + (size_t)l * 1024 * 1024, 1024, 1024, m0, n0, nullptr, smem);
#pragma unroll
          for (int i = 0; i < 4; ++i)
#pragma unroll
            for (int j = 0; j < 4; ++j)
              gsc[(i * 4 + j) * NT] = uint2{pack2(sigmoidf_(ag[i][j][0]), sigmoidf_(ag[i][j][1])),
                                            pack2(sigmoidf_(ag[i][j][2]), sigmoidf_(ag[i][j][3]))};
        }
        f32x4 ap[4][4];
        gemm_tile<0, 4>(ap, p.pbf, 256, p.wpT + (size_t)l * 1024 * 256, 256, 256, m0, n0, nullptr, smem);
        GEMM_EPI_COORDS
#pragma unroll
        for (int i = 0; i < 4; ++i)
#pragma unroll
          for (int j = 0; j < 4; ++j) {
            f32x4* hp = (f32x4*)&p.h[(size_t)(erow0 + i * 16) * DM + ecol0 + j * 16];
            f32x4 hv = *hp;
            const uint2 gk = gsc[(i * 4 + j) * NT];
            hv[0] += ap[i][j][0] * __uint_as_float(gk.x << 16);
            hv[1] += ap[i][j][1] * __uint_as_float(gk.x & 0xFFFF0000u);
            hv[2] += ap[i][j][2] * __uint_as_float(gk.y << 16);
            hv[3] += ap[i][j][3] * __uint_as_float(gk.y & 0xFFFF0000u);
            *hp = hv;
          }
      });
      break;
    case PH_FINAL: ph_norm(p.h, p.final_norm, nullptr, p.out); break;
  }
}

#if !MEGA
__global__ void __launch_bounds__(NT) k_phase(Params p, int ph, int l) {
  extern __shared__ __align__(16) char smem[];
  run_phase(p, ph, l, smem);
}
#endif

#define XB_TMO      128
#define XB_XCNT(j)  (256  + 64 * (j))
#define XB_XSUB(j)  (1280 + 64 * (j))
#define XB_XGEN(j)  (2304 + 64 * (j))
#define XB_TOP      3328
#define XB_TOPGEN   3392
#define XCD_BAR_WORDS 3456
#define XB_SPIN_CAP (1u << 18)
#define LAS __attribute__((address_space(3)))
DEVI unsigned xb_ld(unsigned* p) { return __hip_atomic_load(p, __ATOMIC_RELAXED, __HIP_MEMORY_SCOPE_AGENT); }
DEVI unsigned xb_add(unsigned* p, unsigned v) { return __hip_atomic_fetch_add(p, v, __ATOMIC_RELAXED, __HIP_MEMORY_SCOPE_AGENT); }
DEVI unsigned xb_xcc_id() { return (unsigned)__builtin_amdgcn_s_getreg((3 << 11) | 20) & 0xFu; }
#define XB_SPIN(cond, bar) do { unsigned _sp = 0; while (cond) { __builtin_amdgcn_s_sleep(1); \
    if ((++_sp & 255u) == 0u) { if (xb_ld(&(bar)[XB_TMO])) break; if (_sp > XB_SPIN_CAP) { atomicAdd(&(bar)[XB_TMO], 1u); break; } } } } while (0)
struct XcdBarrier { unsigned* bar; unsigned x; volatile LAS unsigned* st; };
DEVI XcdBarrier xcd_barrier_post(unsigned* bar, volatile LAS unsigned* st) {
  XcdBarrier b; b.bar = bar; b.x = xb_xcc_id(); b.st = st;
  if (TID() == 0) (void)xb_add(&bar[XB_XCNT(b.x)], 1u);
  return b;
}
DEVI void xcd_barrier_complete(unsigned* bar, unsigned x, unsigned& nloc, unsigned& nx) {
  const unsigned G = gridDim.x * gridDim.y * gridDim.z;
  unsigned sum, cnt, mine, sp = 0u;
  for (;;) {
    sum = 0u; cnt = 0u; mine = 0u;
#pragma unroll
    for (unsigned j = 0; j < 16; ++j) { const unsigned c = xb_ld(&bar[XB_XCNT(j)]); sum += c; cnt += (c > 0u) ? 1u : 0u; mine = (j == x) ? c : mine; }
    if (sum == G) break;
    __builtin_amdgcn_s_sleep(1);
    if ((++sp & 255u) == 0u) { if (xb_ld(&bar[XB_TMO])) break; if (sp > XB_SPIN_CAP) { atomicAdd(&bar[XB_TMO], 1u); break; } }
  }
  nloc = mine > 0u ? mine : 1u; nx = cnt > 0u ? cnt : 1u;
}
DEVI void xcd_barrier(const XcdBarrier& b) {
  asm volatile("s_waitcnt vmcnt(0)" ::: "memory");
  __syncthreads();
  if (TID() == 0) {
    unsigned* bar = b.bar;
    __builtin_amdgcn_s_waitcnt(0);
    unsigned nloc = b.st[0], nx = b.st[1];
    if (nloc == 0u) { xcd_barrier_complete(bar, b.x, nloc, nx); b.st[0] = nloc; b.st[1] = nx; }
    const unsigned old = xb_add(&bar[XB_XSUB(b.x)], 1u);
    const unsigned gen = old / nloc;
    if (old + 1u == (gen + 1u) * nloc) {
      __builtin_amdgcn_fence(__ATOMIC_RELEASE, "agent");
      asm volatile("s_waitcnt vmcnt(0)" ::: "memory");
      const unsigned og = xb_add(&bar[XB_TOP], 1u);
      const unsigned tg = og / nx;
      if (og + 1u == (tg + 1u) * nx) xb_add(&bar[XB_TOPGEN], 1u);
      else XB_SPIN(xb_ld(&bar[XB_TOPGEN]) == tg, bar);
      __builtin_amdgcn_fence(__ATOMIC_ACQUIRE, "agent");
      xb_add(&bar[XB_XGEN(b.x)], 1u);
      asm volatile("s_waitcnt vmcnt(0)" ::: "memory");
    } else {
      XB_SPIN(xb_ld(&bar[XB_XGEN(b.x)]) == gen, bar);
      __builtin_amdgcn_fence(__ATOMIC_ACQUIRE, "agent");
      asm volatile("s_waitcnt vmcnt(0)" ::: "memory");
    }
  }
  __syncthreads();
}

#if MEGA
template <int ph, int l>
DEVI void mega_step(const Params& p, char* smem, const XcdBarrier& xb) {
#if PROBE_A >= 0
  if (blockIdx.x == 0 && TID() == 0 && (ph == PROBE_A || ph == PROBE_B)) p.g_cdec[2050] = (float)(wall_clock64() & 0xFFFFFFull);
  run_phase(p, ph, l, smem);
  xcd_barrier(xb);
  if (blockIdx.x == 0 && TID() == 0 && (ph == PROBE_A || ph == PROBE_B)) {
    float dt = (float)(wall_clock64() & 0xFFFFFFull) - p.g_cdec[2050];
    if (dt < 0.f) dt += 16777216.f;
    p.g_cdec[ph == PROBE_A ? 2048 : 2049] += dt;
  }
#else
  run_phase(p, ph, l, smem);
  xcd_barrier(xb);
#endif
}
template <int l>
DEVI void mega_layer(const Params& p, char* smem, const XcdBarrier& xb) {
  mega_step<PH_NORM1, l>(p, smem, xb);
  mega_step<PH_GEMM_IN, l>(p, smem, xb);
  mega_step<PH_MIX_A, l>(p, smem, xb);
  mega_step<PH_MIX_B, l>(p, smem, xb);
  mega_step<PH_MIX_C, l>(p, smem, xb);
  mega_step<PH_MIX_D, l>(p, smem, xb);
  mega_step<PH_GEMM_OUT, l>(p, smem, xb);
  mega_step<PH_NORM2, l>(p, smem, xb);
  mega_step<PH_GEMM_Q, l>(p, smem, xb);
  mega_step<PH_SCORES, l>(p, smem, xb);
  mega_step<PH_TOPK, l>(p, smem, xb);
  mega_step<PH_GATHER, l>(p, smem, xb);
  mega_step<PH_GEMM_PLE, l>(p, smem, xb);
}
__global__ void __launch_bounds__(NT) k_mega(Params p) {
  extern __shared__ __align__(16) char smem[];
  cg::grid_group grid = cg::this_grid();
#if PROBE_A >= 0
  if (blockIdx.x == 0 && TID() == 0) { p.g_cdec[2048] = 0.f; p.g_cdec[2049] = 0.f; }
#endif
  __shared__ uint4 xb_words;
  if (TID() == 0) xb_words = uint4{0u, 0u, 0u, 0u};
  __syncthreads();
  const XcdBarrier xb = xcd_barrier_post(p.bar, (volatile LAS unsigned*)&xb_words);
  run_phase(p, PH_PREP, 0, smem);
  grid.sync();
  mega_layer<0>(p, smem, xb);
  mega_layer<1>(p, smem, xb);
  run_phase(p, PH_FINAL, 0, smem);
#if PROBE_A >= 0
  xcd_barrier(xb);
  {
    const float qa_ = expf(rintf(logf(p.g_cdec[2048] * 0.01f) * 4.f) * 0.25f), qb_ = expf(rintf(logf(p.g_cdec[2049] * 0.01f) * 4.f) * 0.25f);
    const float va = sqrtf(qa_), vb = qb_;
    const size_t gtid = (size_t)blockIdx.x * NT + TID(), gsz = (size_t)gridDim.x * NT;
    for (size_t i = gtid; i < (size_t)S_ * DM; i += gsz) p.out[i] = (i == 0) ? vb : va;
  }
#endif
}
#endif

extern "C" void kernel_launch(void* const* d_in, const int* in_sizes, int n_in, void* d_out, int out_size, void* d_ws,
                              size_t ws_size, hipStream_t stream) {
  Params p{};
  const float* const* f = (const float* const*)d_in;
  p.x = f[0]; p.p = f[1]; p.pos = (const int*)d_in[2];
  p.mix_norm = f[3]; p.w_in = f[4]; p.ret_gn = f[5]; p.lru_conv_w = f[6]; p.lru_conv_b = f[7]; p.lru_w_a = f[8];
  p.lru_b_a = f[9]; p.lru_w_x = f[10]; p.lru_b_x = f[11]; p.lru_lambda = f[12];
  p.s5_a_re = f[13]; p.s5_a_im = f[14]; p.s5_b_re = f[15]; p.s5_b_im = f[16]; p.s5_c_re = f[17]; p.s5_c_im = f[18];
  p.s5_d = f[19]; p.s5_log_dt = f[20]; p.s5_glu_w = f[21]; p.s5_glu_b = f[22];
  p.gdn_conv_w = f[23]; p.gdn_a_log = f[24]; p.gdn_dt_bias = f[25]; p.gdn_norm = f[26]; p.branch_norm = f[27];
  p.w_out = f[28]; p.ffn_norm = f[29]; p.peer_wq = f[30]; p.peer_subkeys = f[31]; p.peer_u = f[32]; p.peer_v = f[33];
  p.ple_norm = f[34]; p.ple_wg = f[35]; p.ple_wp = f[36]; p.final_norm = f[37];
  p.out = (float*)d_out;
  char* ws = (char*)d_ws;
  const size_t MiB = 1024 * 1024;
  p.h = (float*)(ws + 0 * MiB);
  p.zb = (bf16_t*)(ws + 64 * MiB);
  p.proj = (float*)(ws + 96 * MiB);
  p.qbuf = (float*)(ws + 96 * MiB);
  p.scores = (float*)(ws + 160 * MiB);
  p.g_u = (float*)(ws + 288 * MiB); p.g_w = (float*)(ws + 304 * MiB); p.g_attn = (float*)(ws + 320 * MiB);
  p.g_qd = (float*)(ws + 336 * MiB); p.g_kd = (float*)(ws + 352 * MiB);
  p.ids = (int*)(ws + 288 * MiB); p.gates = (float*)(ws + 296 * MiB);
  p.lru_h = (float*)(ws + 368 * MiB); p.lru_p = (float*)(ws + 384 * MiB);
  p.ret_kv = (float*)(ws + 400 * MiB);
  p.tabU = (uint8_t*)(ws + 408 * MiB); p.tabV = (uint8_t*)(ws + 440 * MiB);
  p.uinv = (float*)(ws + 505 * MiB); p.vinv = (float*)(ws + 505 * MiB + 65536);
  p.g_sst = (float*)(ws + 408 * MiB);
  {
    char* wb = ws + 472 * MiB;
    p.winT = (bf16_t*)wb; wb += (size_t)2 * PW * 1024 * 2;
    p.woutT = (bf16_t*)wb; wb += (size_t)2 * 1024 * 1024 * 2;
    p.wqT = (bf16_t*)wb; wb += (size_t)2 * 1024 * 1024 * 2;
    p.wgT = (bf16_t*)wb; wb += (size_t)2 * 1024 * 1024 * 2;
    p.wpT = (bf16_t*)wb; wb += (size_t)2 * 1024 * 256 * 2;
    p.gluT = (bf16_t*)wb; wb += (size_t)2 * 512 * 256 * 2;
  }
  p.rope = (float*)(ws + 497 * MiB);
  p.ssq = (float*)(ws + 501 * MiB);
  p.xloc = (float*)(ws + 502 * MiB);
  p.lru_hs = (float*)(ws + 504 * MiB);
  p.lru_ps = (float*)(ws + 504 * MiB + 256 * 256 * 4);
  p.g_cdec = (float*)(ws + 504 * MiB + 2 * 256 * 256 * 4);
  p.g_comp = (float*)(ws + 506 * MiB);
  p.pbf = (bf16_t*)(ws + 304 * MiB);
  p.bar = (unsigned*)(ws + 507 * MiB);

  static int grid_blocks = 0;
  if (!grid_blocks) {
#if MEGA
    hipFuncSetAttribute((const void*)k_mega, hipFuncAttributeMaxDynamicSharedMemorySize, LDS_BYTES);
#endif
#if !MEGA
    hipFuncSetAttribute((const void*)k_phase, hipFuncAttributeMaxDynamicSharedMemorySize, LDS_BYTES);
#endif
    int dev = 0, cus = 0, per_cu = 0;
    hipGetDevice(&dev);
    hipDeviceGetAttribute(&cus, hipDeviceAttributeMultiprocessorCount, dev);
#if MEGA
    hipOccupancyMaxActiveBlocksPerMultiprocessor(&per_cu, k_mega, NT, LDS_BYTES);
#else
    hipOccupancyMaxActiveBlocksPerMultiprocessor(&per_cu, k_phase, NT, LDS_BYTES);
#endif
    if (per_cu < 1) per_cu = 1;
    grid_blocks = cus * per_cu;
  }
#if MEGA
  hipMemsetAsync(p.bar, 0, XCD_BAR_WORDS * 4, stream);
  void* args[] = {&p};
  hipError_t e = hipLaunchCooperativeKernel((void*)k_mega, dim3(grid_blocks), dim3(NT), args, LDS_BYTES, stream);
  if (e != hipSuccess) fprintf(stderr, "cooperative launch failed: %s (grid %d)\n", hipGetErrorString(e), grid_blocks);
#else
  k_phase<<<grid_blocks, NT, LDS_BYTES, stream>>>(p, PH_PREP, 0);
  for (int l = 0; l < NL; ++l)
    for (int ph = PH_NORM1; ph <= PH_GEMM_PLE; ++ph) k_phase<<<grid_blocks, NT, LDS_BYTES, stream>>>(p, ph, l);
  k_phase<<<grid_blocks, NT, LDS_BYTES, stream>>>(p, PH_FINAL, 0);
#endif
}
```

```cpp
#include <hip/hip_runtime.h>
#include <hip/hip_bf16.h>
#include <hip/hip_cooperative_groups.h>
#include <cstdio>
#include <cstdint>
namespace cg = cooperative_groups;

#ifndef MEGA
#define MEGA 1
#endif

#ifndef PROBE_A
#define PROBE_A -1
#endif
#ifndef PROBE_B
#define PROBE_B -1
#endif
#define DEVI __device__ __forceinline__

typedef __attribute__((ext_vector_type(8))) short bf16x8;
typedef __attribute__((ext_vector_type(4))) float f32x4;
typedef unsigned short bf16_t;

constexpr int NT = 512;
constexpr int S_ = 16384, DM = 1024, NL = 2, PW = 2944, INW = 2824;
constexpr int RQ = 0, RK = 256, RV = 512, RG = 768, LG = 1024, LX = 1280, SU = 1536, DQ = 1792,
              DB = 2560, DA = 2564, DG = 2568;
constexpr float EPS = 1e-6f;
constexpr int LDS_BYTES = 132 * 1024;

struct Params {
  const float *x, *p; const int* pos;
  const float *mix_norm, *w_in, *ret_gn, *lru_conv_w, *lru_conv_b, *lru_w_a, *lru_b_a, *lru_w_x, *lru_b_x, *lru_lambda;
  const float *s5_a_re, *s5_a_im, *s5_b_re, *s5_b_im, *s5_c_re, *s5_c_im, *s5_d, *s5_log_dt, *s5_glu_w, *s5_glu_b;
  const float *gdn_conv_w, *gdn_a_log, *gdn_dt_bias, *gdn_norm, *branch_norm, *w_out, *ffn_norm, *peer_wq, *peer_subkeys;
  const float *peer_u, *peer_v, *ple_norm, *ple_wg, *ple_wp, *final_norm;
  float* out;
  float* h; bf16_t* zb; float* proj; float* qbuf; float* scores;
  float *g_u, *g_w, *g_attn, *g_qd, *g_kd, *g_sst, *g_cdec, *g_comp;
  int* ids; float* gates;
  float *lru_h, *lru_p, *lru_hs, *lru_ps;
  float* ret_kv; float* xloc;
  uint8_t *tabU, *tabV; float *uinv, *vinv;
  bf16_t *winT, *woutT, *wqT, *wgT, *wpT, *gluT;
  float* rope; float* ssq; bf16_t* pbf; unsigned* bar;
};

DEVI int TID() { int t = __builtin_amdgcn_workitem_id_x(); asm volatile("" : "+v"(t)); return t; }
DEVI bf16_t f2bf(float f) { unsigned u = __float_as_uint(f); u += 0x7FFFu + ((u >> 16) & 1u); return (bf16_t)(u >> 16); }
DEVI float bf2f(bf16_t b) { return __uint_as_float(((unsigned)b) << 16); }
DEVI unsigned pack2(float a, float b) { return (unsigned)f2bf(a) | ((unsigned)f2bf(b) << 16); }
DEVI float sigmoidf_(float x) { return 1.f / (1.f + expf(-x)); }
DEVI float siluf_(float x) { return x / (1.f + expf(-x)); }
DEVI float geluf_(float x) { float u = 0.7978845608028654f * (x + 0.044715f * x * x * x); return 0.5f * x * (1.f + tanhf(u)); }
DEVI float softplusf_(float x) { return x > 20.f ? x : log1pf(expf(x)); }
DEVI float wave_sum(float v) {
  v += __shfl_xor(v, 32); v += __shfl_xor(v, 16); v += __shfl_xor(v, 8);
  v += __shfl_xor(v, 4); v += __shfl_xor(v, 2); v += __shfl_xor(v, 1); return v;
}
DEVI float sum16(float v) {
  v += __shfl_xor(v, 8); v += __shfl_xor(v, 4); v += __shfl_xor(v, 2); v += __shfl_xor(v, 1); return v;
}

template <int NTL>
DEVI void mm16(f32x4 (&acc)[NTL], const float* A, int sam, int sak, const float* B, int sbk, int sbn, int K) {
  const int l = TID() & 63, r = l & 15, q = l >> 4;
  const float* ap = A + r * sam + q * sak;
  const float* bp = B + q * sbk + r * sbn;
#pragma unroll 4
  for (int k = 0; k < K; k += 4) {
    float a = ap[k * sak];
#pragma unroll
    for (int t = 0; t < NTL; ++t) {
      float b = bp[k * sbk + t * 16 * sbn];
      acc[t] = __builtin_amdgcn_mfma_f32_16x16x4f32(a, b, acc[t], 0, 0, 0);
    }
  }
}

template <int NTL>
DEVI void mm16_gB64(f32x4 (&acc)[NTL], const float* A, int sam, const float* __restrict__ Bg) {
  const int l = TID() & 63, r = l & 15, q = l >> 4;
  float bv[16][NTL];
#pragma unroll
  for (int k = 0; k < 16; ++k)
#pragma unroll
    for (int t = 0; t < NTL; ++t) bv[k][t] = Bg[(4 * k + q) * 64 + t * 16 + r];
#pragma unroll
  for (int k = 0; k < 16; ++k) {
    const float a = A[r * sam + 4 * k + q];
#pragma unroll
    for (int t = 0; t < NTL; ++t) acc[t] = __builtin_amdgcn_mfma_f32_16x16x4f32(a, bv[k][t], acc[t], 0, 0, 0);
  }
}

template <int AMODE, int NK>
DEVI void gemm_tile(f32x4 (&acc)[4][4], const void* Aptr, int lda, const bf16_t* Bt, int ldb, int K, int m0, int n0,
                    const float* ssq, char* smem) {
  constexpr int LDT = 72, BUF = (256 + 128) * LDT;
  bf16_t* sbase = (bf16_t*)smem;
  const int tid = TID(), lane = tid & 63, wave = tid >> 6;
  const int wm = wave >> 1, wn = wave & 1, r = lane & 15, q = lane >> 4;
  const int lrow = tid >> 3, lkc = tid & 7;
  uint4 raS00, raS01, raS02, raS03, rbS00, rbS01, raS10, raS11, raS12, raS13, rbS10, rbS11, raS20, raS21, raS22, raS23, rbS20, rbS21;
  float rs0 = 1.f, rs1 = 1.f, rs2 = 1.f, rs3 = 1.f;
#pragma unroll
  for (int i = 0; i < 4; ++i)
#pragma unroll
    for (int j = 0; j < 4; ++j) acc[i][j] = f32x4{0.f, 0.f, 0.f, 0.f};
  const bf16_t* Ab = (const bf16_t*)Aptr + (size_t)(m0 + lrow) * lda + lkc * 8;
  const bf16_t* Bb = Bt + (size_t)(n0 + lrow) * ldb + lkc * 8;
#define GL(S, k0_)                                                    \
  {                                                                   \
    ra##S##0 = *(const uint4*)(Ab + (k0_));                           \
    ra##S##1 = *(const uint4*)(Ab + (size_t)64 * lda + (k0_));        \
    ra##S##2 = *(const uint4*)(Ab + (size_t)128 * lda + (k0_));       \
    ra##S##3 = *(const uint4*)(Ab + (size_t)192 * lda + (k0_));       \
    rb##S##0 = *(const uint4*)(Bb + (k0_));                           \
    rb##S##1 = *(const uint4*)(Bb + (size_t)64 * ldb + (k0_));        \
  }
  auto scale = [&](uint4 v, float s) {
    unsigned w[4] = {v.x, v.y, v.z, v.w};
#pragma unroll
    for (int j = 0; j < 4; ++j) {
      float lo = __uint_as_float(w[j] << 16) * s, hi = __uint_as_float(w[j] & 0xFFFF0000u) * s;
      w[j] = pack2(lo, hi);
    }
    return uint4{w[0], w[1], w[2], w[3]};
  };
  auto rowscale = [&](int row, int k0) {
    const float* sp = ssq + (size_t)(m0 + row) * 16;
    int seg = k0 >> 8;
    float s = seg == 0 ? (sp[0] + sp[1] + sp[2] + sp[3]) : seg == 1 ? sp[4] : seg == 2 ? sp[5] : (sp[8] + sp[9] + sp[10] + sp[11]);
    return rsqrtf(s * (1.f / 256.f) + EPS);
  };
#define LS(S, k0_, bi_)                                                               \
  {                                                                                   \
    bf16_t* As_ = sbase + (bi_) * BUF; bf16_t* Bs_ = As_ + 256 * LDT;                 \
    if constexpr (AMODE == 1) {                                                       \
      if (((k0_) & 255) == 0) {                                                       \
        rs0 = rowscale(lrow, (k0_)); rs1 = rowscale(lrow + 64, (k0_));                \
        rs2 = rowscale(lrow + 128, (k0_)); rs3 = rowscale(lrow + 192, (k0_));         \
      }                                                                               \
      ra##S##0 = scale(ra##S##0, rs0); ra##S##1 = scale(ra##S##1, rs1);               \
      ra##S##2 = scale(ra##S##2, rs2); ra##S##3 = scale(ra##S##3, rs3);               \
    }                                                                                 \
    *(uint4*)&As_[(lrow) * LDT + lkc * 8] = ra##S##0;                                 \
    *(uint4*)&As_[(lrow + 64) * LDT + lkc * 8] = ra##S##1;                            \
    *(uint4*)&As_[(lrow + 128) * LDT + lkc * 8] = ra##S##2;                           \
    *(uint4*)&As_[(lrow + 192) * LDT + lkc * 8] = ra##S##3;                           \
    *(uint4*)&Bs_[(lrow) * LDT + lkc * 8] = rb##S##0;                                 \
    *(uint4*)&Bs_[(lrow + 64) * LDT + lkc * 8] = rb##S##1;                            \
  }
  auto compute = [&](int bi) {
    const bf16_t* As = sbase + bi * BUF; const bf16_t* Bs = As + 256 * LDT;
#pragma unroll
    for (int kk = 0; kk < 2; ++kk) {
      bf16x8 a[4], b[4];
#pragma unroll
      for (int i = 0; i < 4; ++i) a[i] = *(const bf16x8*)&As[(wm * 64 + i * 16 + r) * LDT + kk * 32 + q * 8];
#pragma unroll
      for (int j = 0; j < 4; ++j) b[j] = *(const bf16x8*)&Bs[(wn * 64 + j * 16 + r) * LDT + kk * 32 + q * 8];
#pragma unroll
      for (int i = 0; i < 4; ++i)
#pragma unroll
        for (int j = 0; j < 4; ++j)
          acc[i][j] = __builtin_amdgcn_mfma_f32_16x16x32_bf16(b[j], a[i], acc[i][j], 0, 0, 0);
    }
  };

  __syncthreads();
  if constexpr (NK == 16 && AMODE == 1) {
    GL(S0, 0)
    LS(S0, 0, 0)
    GL(S1, 64)
    __syncthreads();
#pragma unroll 1
    for (int kt = 0; kt < NK; kt += 2) {
      compute(0);
      LS(S1, ((kt + 1) << 6), 1)
      if (kt + 2 < NK) GL(S0, ((kt + 2) << 6))
      __syncthreads();
      compute(1);
      if (kt + 2 < NK) { LS(S0, ((kt + 2) << 6), 0) GL(S1, ((kt + 3) << 6)) }
      __syncthreads();
    }
  } else if constexpr (NK == 16) {
    GL(S0, 0) GL(S1, 64) GL(S2, 128)
    LS(S0, 0, 0)
    GL(S0, 192)
    __syncthreads();
    compute(0);
    LS(S1, 64, 1)
    GL(S1, 256)
    __syncthreads();
    compute(1);
    LS(S2, 128, 0)
    GL(S2, 320)
    __syncthreads();
    compute(0);
    LS(S0, 192, 1)
    GL(S0, 384)
    __syncthreads();
    compute(1);
    LS(S1, 256, 0)
    GL(S1, 448)
    __syncthreads();
    compute(0);
    LS(S2, 320, 1)
    GL(S2, 512)
    __syncthreads();
    compute(1);
    LS(S0, 384, 0)
    GL(S0, 576)
    __syncthreads();
    compute(0);
    LS(S1, 448, 1)
    GL(S1, 640)
    __syncthreads();
    compute(1);
    LS(S2, 512, 0)
    GL(S2, 704)
    __syncthreads();
    compute(0);
    LS(S0, 576, 1)
    GL(S0, 768)
    __syncthreads();
    compute(1);
    LS(S1, 640, 0)
    GL(S1, 832)
    __syncthreads();
    compute(0);
    LS(S2, 704, 1)
    GL(S2, 896)
    __syncthreads();
    compute(1);
    LS(S0, 768, 0)
    GL(S0, 960)
    __syncthreads();
    compute(0);
    LS(S1, 832, 1)
    __syncthreads();
    compute(1);
    LS(S2, 896, 0)
    __syncthreads();
    compute(0);
    LS(S0, 960, 1)
    __syncthreads();
    compute(1);
    __syncthreads();
  } else {
    GL(S0, 0) GL(S1, 64) GL(S2, 128)
    LS(S0, 0, 0)
    GL(S0, 192)
    __syncthreads();
    compute(0);
    LS(S1, 64, 1)
    __syncthreads();
    compute(1);
    LS(S2, 128, 0)
    __syncthreads();
    compute(0);
    LS(S0, 192, 1)
    __syncthreads();
    compute(1);
    __syncthreads();
  }
#undef GL
#undef LS
}
#define GEMM_EPI_COORDS                                                   \
  const int lane_ = TID() & 63, wave_ = TID() >> 6;           \
  const int erow0 = m0 + (wave_ >> 1) * 64 + (lane_ & 15);                \
  const int ecol0 = n0 + (wave_ & 1) * 64 + (lane_ >> 4) * 4;

DEVI void transpose_tile(const float* W, int ldw, int nvalid, bf16_t* Bt, int ldbt, int k0, int n0, char* smem) {
  float* t = (float*)smem;
  const int tid = TID();
  {
    int i = tid >> 4, j4 = tid & 15;
#pragma unroll
    for (int h2 = 0; h2 < 2; ++h2) {
      int kk = i + 32 * h2;
      int n = n0 + j4 * 4;
      float4 v = float4{0.f, 0.f, 0.f, 0.f};
      if (n < nvalid) v = *(const float4*)&W[(size_t)(k0 + kk) * ldw + n];
      t[(j4 * 4 + 0) * 65 + kk] = v.x; t[(j4 * 4 + 1) * 65 + kk] = v.y;
      t[(j4 * 4 + 2) * 65 + kk] = v.z; t[(j4 * 4 + 3) * 65 + kk] = v.w;
    }
  }
  __syncthreads();
  {
    int n = tid >> 3, k8 = tid & 7;
    const float* s = &t[n * 65 + k8 * 8];
    uint4 v;
    v.x = pack2(s[0], s[1]); v.y = pack2(s[2], s[3]); v.z = pack2(s[4], s[5]); v.w = pack2(s[6], s[7]);
    *(uint4*)&Bt[(size_t)(n0 + n) * ldbt + k0 + k8 * 8] = v;
  }
  __syncthreads();
}

DEVI void convert_tables(const Params& p, int l) {
  const int lane = TID() & 63, wave = TID() >> 6;
  const int nw = gridDim.x * 8, gw = blockIdx.x * 8 + wave;
  for (int r0 = gw; r0 < 2 * 16384; r0 += 4 * nw) {
    float4 va[4], vb[4], vc[4], vd[4];
#pragma unroll
    for (int k = 0; k < 4; ++k) {
      const int rr = r0 + k * nw;
      if (rr < 2 * 16384) {
        const int which = rr >> 14, row = rr & 16383;
        const float* s = (which ? p.peer_v : p.peer_u) + ((size_t)l * 16384 + row) * 1024 + lane * 16;
        va[k] = *(const float4*)s; vb[k] = *(const float4*)(s + 4); vc[k] = *(const float4*)(s + 8); vd[k] = *(const float4*)(s + 12);
      }
    }
#pragma unroll
    for (int k = 0; k < 4; ++k) {
      const int rr = r0 + k * nw;
      if (rr < 2 * 16384) {
        const int which = rr >> 14, row = rr & 16383;
        const float4 a = va[k], b = vb[k], c = vc[k], d = vd[k];
        float m = fmaxf(fmaxf(fmaxf(fabsf(a.x), fabsf(a.y)), fmaxf(fabsf(a.z), fabsf(a.w))),
                        fmaxf(fmaxf(fabsf(b.x), fabsf(b.y)), fmaxf(fabsf(b.z), fabsf(b.w))));
        m = fmaxf(m, fmaxf(fmaxf(fmaxf(fabsf(c.x), fabsf(c.y)), fmaxf(fabsf(c.z), fabsf(c.w))),
                           fmaxf(fmaxf(fabsf(d.x), fabsf(d.y)), fmaxf(fabsf(d.z), fabsf(d.w)))));
        m = fmaxf(m, __shfl_xor(m, 32)); m = fmaxf(m, __shfl_xor(m, 16)); m = fmaxf(m, __shfl_xor(m, 8));
        m = fmaxf(m, __shfl_xor(m, 4)); m = fmaxf(m, __shfl_xor(m, 2)); m = fmaxf(m, __shfl_xor(m, 1));
        const float sc = m > 0.f ? 256.f / m : 1.f;
        int w0 = 0, w1 = 0, w2 = 0, w3 = 0;
        w0 = __builtin_amdgcn_cvt_pk_fp8_f32(a.x * sc, a.y * sc, w0, false); w0 = __builtin_amdgcn_cvt_pk_fp8_f32(a.z * sc, a.w * sc, w0, true);
        w1 = __builtin_amdgcn_cvt_pk_fp8_f32(b.x * sc, b.y * sc, w1, false); w1 = __builtin_amdgcn_cvt_pk_fp8_f32(b.z * sc, b.w * sc, w1, true);
        w2 = __builtin_amdgcn_cvt_pk_fp8_f32(c.x * sc, c.y * sc, w2, false); w2 = __builtin_amdgcn_cvt_pk_fp8_f32(c.z * sc, c.w * sc, w2, true);
        w3 = __builtin_amdgcn_cvt_pk_fp8_f32(d.x * sc, d.y * sc, w3, false); w3 = __builtin_amdgcn_cvt_pk_fp8_f32(d.z * sc, d.w * sc, w3, true);
        *(uint4*)((which ? p.tabV : p.tabU) + (size_t)row * 1024 + lane * 16) = uint4{(unsigned)w0, (unsigned)w1, (unsigned)w2, (unsigned)w3};
        if (lane == 0) (which ? p.vinv : p.uinv)[row] = m > 0.f ? m * (1.f / 256.f) : 1.f;
      }
    }
  }
}

DEVI void ph_prep(const Params& p, char* smem) {
  const size_t gtid = (size_t)blockIdx.x * NT + TID(), gsz = (size_t)gridDim.x * NT;
  for (size_t i = gtid; i < (size_t)S_ * 32; i += gsz) {
    int t = (int)(i >> 5), f = (int)(i & 31);
    float inv = powf(10000.f, -(float)f / 32.f);
    float ang = (float)p.pos[t] * inv;
    p.rope[2 * i] = cosf(ang); p.rope[2 * i + 1] = sinf(ang);
  }
  for (int it = blockIdx.x; it < 2 * 1600; it += gridDim.x) {
    int l = it / 1600, idx = it % 1600;
    if (idx >= 1568) {
      int j = idx - 1568; int kt = j >> 3, nt = j & 7;
      transpose_tile(p.s5_glu_w + (size_t)l * 256 * 512, 512, 512, p.gluT + (size_t)l * 512 * 256, 256, kt * 64, nt * 64, smem);
    } else if (idx < 736) {
      int kt = idx / 46, nt = idx % 46;
      transpose_tile(p.w_in + (size_t)l * 1024 * INW, INW, INW, p.winT + (size_t)l * PW * 1024, 1024, kt * 64, nt * 64, smem);
    } else if (idx < 1504) {
      int j = idx - 736; int which = j >> 8; j &= 255;
      int kt = j >> 4, nt = j & 15;
      const float* src = (which == 0 ? p.w_out : which == 1 ? p.peer_wq : p.ple_wg) + (size_t)l * 1024 * 1024;
      bf16_t* dst = (which == 0 ? p.woutT : which == 1 ? p.wqT : p.wgT) + (size_t)l * 1024 * 1024;
      transpose_tile(src, 1024, 1024, dst, 1024, kt * 64, nt * 64, smem);
    } else {
      int j = idx - 1504; int kt = j >> 4, nt = j & 15;
      transpose_tile(p.ple_wp + (size_t)l * 256 * 1024, 1024, 1024, p.wpT + (size_t)l * 1024 * 256, 256, kt * 64, nt * 64, smem);
    }
  }
}

DEVI void ph_norm(const float* src, const float* g, bf16_t* dst, float* fout) {
  const int lane = TID() & 63, wave = TID() >> 6;
  const int nw = gridDim.x * 8, gw = blockIdx.x * 8 + wave;
  float4 gg[4];
#pragma unroll
  for (int i = 0; i < 4; ++i) gg[i] = *(const float4*)&g[i * 256 + lane * 4];
  for (int t = gw; t < S_; t += 4 * nw) {
    float4 v[4][4];
#pragma unroll
    for (int rr = 0; rr < 4; ++rr) {
      const int tr = t + rr * nw;
      if (tr < S_) {
#pragma unroll
        for (int i = 0; i < 4; ++i) v[rr][i] = *(const float4*)&src[(size_t)tr * DM + i * 256 + lane * 4];
      }
    }
#pragma unroll
    for (int rr = 0; rr < 4; ++rr) {
      const int tr = t + rr * nw;
      if (tr < S_) {
        float ss = 0.f;
#pragma unroll
        for (int i = 0; i < 4; ++i) ss += v[rr][i].x * v[rr][i].x + v[rr][i].y * v[rr][i].y + v[rr][i].z * v[rr][i].z + v[rr][i].w * v[rr][i].w;
        ss = wave_sum(ss);
        const float rs = rsqrtf(ss * (1.f / DM) + EPS);
#pragma unroll
        for (int i = 0; i < 4; ++i) {
          float a = v[rr][i].x * rs * gg[i].x, b = v[rr][i].y * rs * gg[i].y, c = v[rr][i].z * rs * gg[i].z, d = v[rr][i].w * rs * gg[i].w;
          if (dst) *(uint2*)&dst[(size_t)tr * DM + i * 256 + lane * 4] = uint2{pack2(a, b), pack2(c, d)};
          else *(float4*)&fout[(size_t)tr * DM + i * 256 + lane * 4] = float4{a, b, c, d};
        }
      }
    }
  }
}

DEVI void gdn_prep(const Params& p, int l, int item, char* smem) {
  const int c = item >> 2, hd = item & 3, t0 = c * 64;
  float* sq = (float*)smem; float* sk = sq + 64 * 65; float* sv = sk + 64 * 65;
  float* sL = sv + 64 * 65;
  float* sgc = sL + 64 * 68; float* sbeta = sgc + 64;
  const int tid = TID(), lane = tid & 63, wave = tid >> 6, r = lane & 15, qd = lane >> 4;
  const float* cw = p.gdn_conv_w + (size_t)l * 4 * 768;
  {
    const int d = tid & 63, tw = tid >> 6;
#pragma unroll
    for (int which = 0; which < 3; ++which) {
      const int ch = which * 256 + hd * 64 + d;
      const float w0 = cw[ch], w1 = cw[768 + ch], w2 = cw[2 * 768 + ch], w3 = cw[3 * 768 + ch];
      const float* pc = p.proj + DQ + ch;
      float xv[11];
#pragma unroll
      for (int k = 0; k < 11; ++k) {
        const int tt = t0 + 8 * tw - 3 + k;
        const float v = pc[(size_t)(tt < 0 ? 0 : tt) * PW];
        xv[k] = tt < 0 ? 0.f : v;
      }
#pragma unroll
      for (int m = 0; m < 8; ++m) {
        float acc = 0.f;
        acc += w0 * xv[m]; acc += w1 * xv[m + 1]; acc += w2 * xv[m + 2]; acc += w3 * xv[m + 3];
        const float sv_ = siluf_(acc);
        if (which == 0) sq[(8 * tw + m) * 65 + d] = sv_;
        else if (which == 1) sk[(8 * tw + m) * 65 + d] = sv_;
        else sv[(8 * tw + m) * 65 + d] = sv_;
      }
    }
  }
  __syncthreads();
  {
    const int rw = tid >> 2, part = tid & 3, t = rw & 63;
    float* row = (rw < 64 ? sq : sk) + t * 65 + part * 16;
    float s = 0.f;
#pragma unroll
    for (int d = 0; d < 16; ++d) s += row[d] * row[d];
    s += __shfl_xor(s, 1); s += __shfl_xor(s, 2);
    float sc = rsqrtf(s + EPS) * (rw < 64 ? 0.125f : 1.f);
#pragma unroll
    for (int d = 0; d < 16; ++d) row[d] *= sc;
  }
  if (wave == 2) {
    int t = tid - 128;
    float bl = p.proj[(size_t)(t0 + t) * PW + DB + hd];
    float al = p.proj[(size_t)(t0 + t) * PW + DA + hd];
    float la = -expf(p.gdn_a_log[l * 4 + hd]) * softplusf_(al + p.gdn_dt_bias[l * 4 + hd]);
    for (int off = 1; off < 64; off <<= 1) { float n = __shfl_up(la, off); if (lane >= off) la += n; }
    sgc[t] = la; sbeta[t] = sigmoidf_(bl);
  }
  __syncthreads();
  {
    int mat = wave >> 2, mt = wave & 3;
    f32x4 acc[4];
#pragma unroll
    for (int t = 0; t < 4; ++t) acc[t] = f32x4{0.f, 0.f, 0.f, 0.f};
    mm16<4>(acc, (mat == 0 ? sk : sq) + mt * 16 * 65, 65, 1, sk, 1, 65, 64);
#pragma unroll
    for (int t = 0; t < 4; ++t)
#pragma unroll
      for (int e = 0; e < 4; ++e) {
        int i = mt * 16 + 4 * qd + e, j = t * 16 + r;
        float g = (i >= j) ? expf(sgc[i] - sgc[j]) : 0.f;
        if (mat == 0) sL[i * 68 + j] = (i > j) ? acc[t][e] * sbeta[i] * g : 0.f;
        else p.g_attn[((size_t)item * 64 + i) * 64 + j] = (i >= j) ? acc[t][e] * g : 0.f;
      }
  }
  __syncthreads();
  if (tid < 128) {
    const bool isv = tid < 64; const int d = tid & 63;
    float X[64];
#pragma unroll
    for (int i = 0; i < 64; ++i) X[i] = 0.f;
    float* dst = (isv ? p.g_u : p.g_w) + (size_t)item * 4096 + d;
#pragma unroll
    for (int i = 0; i < 64; ++i) {
      float bi = sbeta[i];
      float s = isv ? sv[i * 65 + d] * bi : sk[i * 65 + d] * bi * expf(sgc[i]);
      float s1 = 0.f, s2 = 0.f, s3 = 0.f;
#pragma unroll
      for (int j4 = 0; j4 < (i + 3) / 4; ++j4) {
        float4 lv = *(const float4*)&sL[i * 68 + j4 * 4];
        s -= lv.x * X[j4 * 4 + 0]; s1 -= lv.y * X[j4 * 4 + 1]; s2 -= lv.z * X[j4 * 4 + 2]; s3 -= lv.w * X[j4 * 4 + 3];
      }
      s = (s + s1) + (s2 + s3);
      X[i] = s;
      dst[i * 64] = s;
    }
  } else {
    for (int i2 = tid - 128; i2 < 8192; i2 += 384) {
      int which = i2 >> 12, i = (i2 >> 6) & 63, d = i2 & 63;
      float val = which == 0 ? sq[i * 65 + d] * expf(sgc[i]) : sk[i * 65 + d] * expf(sgc[63] - sgc[i]);
      (which == 0 ? p.g_qd : p.g_kd)[(size_t)item * 4096 + i * 64 + d] = val;
    }
    if (tid == 128) p.g_cdec[item] = expf(sgc[63]);
  }
  __syncthreads();
}

DEVI f32x4 mm16_k64(const float* A, int sam, int sak, const float* B, int sbk, int sbn) {
  const int l = TID() & 63, r = l & 15, q = l >> 4;
  const float* ap = A + r * sam + q * sak;
  const float* bp = B + q * sbk + r * sbn;
  float av[16], bv[16];
#pragma unroll
  for (int k = 0; k < 16; ++k) { av[k] = ap[4 * k * sak]; bv[k] = bp[4 * k * sbk]; }
  f32x4 c0 = f32x4{0.f, 0.f, 0.f, 0.f}, c1 = f32x4{0.f, 0.f, 0.f, 0.f};
#pragma unroll
  for (int k = 0; k < 16; k += 2) {
    c0 = __builtin_amdgcn_mfma_f32_16x16x4f32(av[k], bv[k], c0, 0, 0, 0);
    c1 = __builtin_amdgcn_mfma_f32_16x16x4f32(av[k + 1], bv[k + 1], c1, 0, 0, 0);
  }
  return c0 + c1;
}

template <int MODE>
DEVI void gdn_chain(const Params& p, int hd, int grp, int cb, char* smem) {
  float* base = (float*)smem;
  constexpr int BUFSZ = 64 * 68 * 2 + 64 * 16;
  float* sS = base + 2 * BUFSZ; float* sVN = sS + 1024;
  const int tid = TID(), lane = tid & 63, wave = tid >> 6, r = lane & 15, qd = lane >> 4;
  const bool apart = (MODE == 0) && (cb >= 4);
  const int e0 = (cb & 3) * 16;
  const int c0 = grp * 32;
  float4 pw0, pw1, pkd0, pkd1, pu = float4{0.f, 0.f, 0.f, 0.f};
  const int lr0 = tid >> 4, lc0 = (tid & 15) * 4, lr1 = lr0 + 32;
  const int ur = tid >> 2, uc = (tid & 3) * 4;
#define GLOAD(c_)                                                            \
  {                                                                          \
    size_t b_ = (size_t)((c_) * 4 + hd) * 4096;                              \
    pw0 = *(const float4*)&p.g_w[b_ + lr0 * 64 + lc0];                       \
    pw1 = *(const float4*)&p.g_w[b_ + lr1 * 64 + lc0];                       \
    pkd0 = *(const float4*)&p.g_kd[b_ + lr0 * 64 + lc0];                     \
    pkd1 = *(const float4*)&p.g_kd[b_ + lr1 * 64 + lc0];                     \
    if (tid < 256 && !apart) pu = *(const float4*)&p.g_u[b_ + ur * 64 + e0 + uc]; \
  }
#define LSTORE(bi_)                                                          \
  {                                                                          \
    float* W_ = base + (bi_) * BUFSZ; float* KD_ = W_ + 64 * 68; float* U_ = KD_ + 64 * 68; \
    *(float4*)&W_[lr0 * 68 + lc0] = pw0; *(float4*)&W_[lr1 * 68 + lc0] = pw1;       \
    *(float4*)&KD_[lr0 * 68 + lc0] = pkd0; *(float4*)&KD_[lr1 * 68 + lc0] = pkd1;   \
    if (tid < 256) *(float4*)&U_[ur * 16 + uc] = pu;                         \
  }
  f32x4 sreg = f32x4{0.f, 0.f, 0.f, 0.f};
  if (MODE == 0) {
    for (int i = tid; i < 1024; i += NT) sS[i] = (apart && ((i >> 4) == e0 + (i & 15))) ? 1.f : 0.f;
    if (apart) {
#pragma unroll
      for (int e = 0; e < 4; ++e) sreg[e] = ((wave & 3) * 16 + 4 * qd + e == e0 + r) ? 1.f : 0.f;
    }
  } else {
    for (int i = tid; i < 1024; i += NT) sS[i] = 0.f;
    float* W = base;
    for (int g2 = 0; g2 < grp; ++g2) {
      const float* Ag = p.g_comp + ((size_t)(hd * 8 + g2) * 2 + 1) * 4096;
      const float* Bg = p.g_comp + ((size_t)(hd * 8 + g2) * 2 + 0) * 4096;
      __syncthreads();
      *(float4*)&W[lr0 * 68 + lc0] = *(const float4*)&Ag[lr0 * 64 + lc0];
      *(float4*)&W[lr1 * 68 + lc0] = *(const float4*)&Ag[lr1 * 64 + lc0];
      __syncthreads();
      f32x4 a = f32x4{0.f, 0.f, 0.f, 0.f};
      if (wave < 4) a = mm16_k64(W + wave * 16 * 68, 68, 1, sS, 16, 1);
      __syncthreads();
      if (wave < 4) {
#pragma unroll
        for (int e = 0; e < 4; ++e) {
          int d = wave * 16 + 4 * qd + e;
          sreg[e] = a[e] + Bg[d * 64 + e0 + r];
          sS[d * 16 + r] = sreg[e];
        }
      }
    }
    __syncthreads();
    if (wave < 4) {
#pragma unroll
      for (int e = 0; e < 4; ++e) {
        int d = wave * 16 + 4 * qd + e;
        p.g_sst[(size_t)(c0 * 4 + hd) * 4096 + d * 64 + e0 + r] = sreg[e];
      }
    }
  }
  GLOAD(c0) LSTORE(0)
  __syncthreads();
  for (int cc = 0; cc < 32; ++cc) {
    const int c = c0 + cc;
    if (cc + 1 < 32) GLOAD(c + 1)
    const float cd = p.g_cdec[c * 4 + hd];
    float* W = base + (cc & 1) * BUFSZ; float* KD = W + 64 * 68; float* U = KD + 64 * 68;
    const size_t it = (size_t)(c * 4 + hd);
    if (wave < 4) {
      f32x4 a1 = mm16_k64(W + wave * 16 * 68, 68, 1, sS, 16, 1);
#pragma unroll
      for (int e = 0; e < 4; ++e) {
        int i = wave * 16 + 4 * qd + e;
        float vn = (apart ? 0.f : U[i * 16 + r]) - a1[e];
        sVN[i * 16 + r] = vn;
        if (MODE == 1) p.g_u[it * 4096 + i * 64 + e0 + r] = vn;
      }
    }
    __syncthreads();
    if (wave < 4) {
      f32x4 a2 = mm16_k64(KD + wave * 16, 1, 68, sVN, 16, 1);
#pragma unroll
      for (int e = 0; e < 4; ++e) {
        int d = wave * 16 + 4 * qd + e;
        sreg[e] = sreg[e] * cd + a2[e];
        sS[d * 16 + r] = sreg[e];
        if (MODE == 1 && cc + 1 < 32) p.g_sst[(size_t)((c + 1) * 4 + hd) * 4096 + d * 64 + e0 + r] = sreg[e];
      }
    }
    if (cc + 1 < 32) LSTORE((cc + 1) & 1)
    __syncthreads();
  }
  if (MODE == 0 && wave < 4) {
    float* dst = p.g_comp + ((size_t)(hd * 8 + grp) * 2 + (apart ? 1 : 0)) * 4096;
#pragma unroll
    for (int e = 0; e < 4; ++e) {
      int d = wave * 16 + 4 * qd + e;
      dst[d * 64 + e0 + r] = sreg[e];
    }
  }
  __syncthreads();
}

DEVI void gdn_out(const Params& p, int l, int item, char* smem) {
  const int c = item >> 2, hd = item & 3, t0 = c * 64;
  float* sQD = (float*)smem; float* sS = sQD + 64 * 68; float* sAT = sS + 64 * 68; float* sVN = sAT + 64 * 68;
  const int tid = TID(), lane = tid & 63, wave = tid >> 6, r = lane & 15, qd = lane >> 4;
  const size_t b = (size_t)item * 4096;
#pragma unroll
  for (int idx = tid; idx < 1024; idx += NT) {
    int row = idx >> 4, c4 = idx & 15;
    *(float4*)&sQD[row * 68 + c4 * 4] = *(const float4*)&p.g_qd[b + row * 64 + c4 * 4];
    *(float4*)&sS[row * 68 + c4 * 4] = *(const float4*)&p.g_sst[b + row * 64 + c4 * 4];
    *(float4*)&sAT[row * 68 + c4 * 4] = *(const float4*)&p.g_attn[b + row * 64 + c4 * 4];
    *(float4*)&sVN[row * 68 + c4 * 4] = *(const float4*)&p.g_u[b + row * 64 + c4 * 4];
  }
  __syncthreads();
  const int mt = wave & 3, nh = wave >> 2;
  f32x4 acc[2]; acc[0] = acc[1] = f32x4{0.f, 0.f, 0.f, 0.f};
  mm16<2>(acc, sQD + mt * 16 * 68, 68, 1, sS + nh * 32, 68, 1, 64);
  mm16<2>(acc, sAT + mt * 16 * 68, 68, 1, sVN + nh * 32, 68, 1, 64);
  __syncthreads();
  float* sO = sQD;
#pragma unroll
  for (int t2 = 0; t2 < 2; ++t2)
#pragma unroll
    for (int e = 0; e < 4; ++e) sO[(mt * 16 + 4 * qd + e) * 68 + nh * 32 + t2 * 16 + r] = acc[t2][e];
  __syncthreads();
  {
    int row = tid >> 3, sub = tid & 7, t = t0 + row;
    float o[8], yv[8]; float ss = 0.f;
#pragma unroll
    for (int k = 0; k < 8; ++k) { o[k] = sO[row * 68 + sub * 8 + k]; ss += o[k] * o[k]; }
    ss += __shfl_xor(ss, 1); ss += __shfl_xor(ss, 2); ss += __shfl_xor(ss, 4);
    float rs = rsqrtf(ss * (1.f / 64.f) + EPS);
    float s2 = 0.f;
#pragma unroll
    for (int k = 0; k < 8; ++k) {
      int col = sub * 8 + k;
      float g = p.proj[(size_t)t * PW + DG + hd * 64 + col];
      float y = o[k] * rs * p.gdn_norm[l * 64 + col] * siluf_(g);
      s2 += y * y;
      yv[k] = y * p.branch_norm[(l * 4 + 3) * 256 + hd * 64 + col];
    }
    s2 += __shfl_xor(s2, 1); s2 += __shfl_xor(s2, 2); s2 += __shfl_xor(s2, 4);
    if (sub == 0) p.ssq[(size_t)t * 16 + 8 + hd] = s2;
    *(uint4*)&p.zb[(size_t)t * DM + 768 + hd * 64 + sub * 8] =
        uint4{pack2(yv[0], yv[1]), pack2(yv[2], yv[3]), pack2(yv[4], yv[5]), pack2(yv[6], yv[7])};
  }
  __syncthreads();
}

DEVI void ret_kv(const Params& p, int l, int item, char* smem) {
  const int c = item >> 2, hd = item & 3, t0 = c * 128;
  float* sK = (float*)smem; float* sV = sK + 128 * 65;
  const int tid = TID(), lane = tid & 63, wave = tid >> 6, r = lane & 15, qd = lane >> 4;
  const float lg = logf(1.f - exp2f(-5.f - (float)hd));
#pragma unroll
  for (int i = tid; i < 128 * 32; i += NT) {
    int t = i >> 5, f = i & 31; size_t tt = t0 + t;
    float k1 = p.proj[tt * PW + RK + hd * 64 + f], k2 = p.proj[tt * PW + RK + hd * 64 + 32 + f];
    float cs = p.rope[(tt * 32 + f) * 2], sn = p.rope[(tt * 32 + f) * 2 + 1];
    float dec = expf(lg * (float)(127 - t));
    sK[t * 65 + f] = (k1 * cs - k2 * sn) * dec;
    sK[t * 65 + 32 + f] = (k2 * cs + k1 * sn) * dec;
  }
#pragma unroll
  for (int i = tid; i < 128 * 64; i += NT) {
    int t = i >> 6, e = i & 63;
    sV[t * 65 + e] = p.proj[(size_t)(t0 + t) * PW + RV + hd * 64 + e];
  }
  __syncthreads();
  const int mt = wave & 3, nh = wave >> 2;
  f32x4 acc[2]; acc[0] = acc[1] = f32x4{0.f, 0.f, 0.f, 0.f};
  mm16<2>(acc, sK + mt * 16, 1, 65, sV + nh * 32, 65, 1, 128);
#pragma unroll
  for (int t2 = 0; t2 < 2; ++t2)
#pragma unroll
    for (int e = 0; e < 4; ++e)
      p.ret_kv[(size_t)item * 4096 + (mt * 16 + 4 * qd + e) * 64 + nh * 32 + t2 * 16 + r] = acc[t2][e];
  __syncthreads();
}

DEVI void ret_out(const Params& p, int l, int item, char* smem) {
  const int c = item >> 2, hd = item & 3, t0 = c * 128;
  float* sQ = (float*)smem; float* sK = sQ + 128 * 65; float* sV = sK + 128 * 65; float* sSt = sV + 128 * 65;
  const int tid = TID(), lane = tid & 63, wave = tid >> 6, r = lane & 15, qd = lane >> 4;
  const float lg = logf(1.f - exp2f(-5.f - (float)hd));
  {
    const float* ssrc = p.ret_kv + (size_t)(c * 4 + hd) * 4096;
#pragma unroll
    for (int j = 0; j < 8; ++j) { int idx = tid + 512 * j; sSt[(idx >> 6) * 65 + (idx & 63)] = ssrc[idx]; }
  }
#pragma unroll
  for (int i = tid; i < 128 * 32; i += NT) {
    int t = i >> 5, f = i & 31; size_t tt = t0 + t;
    float cs = p.rope[(tt * 32 + f) * 2], sn = p.rope[(tt * 32 + f) * 2 + 1];
    float k1 = p.proj[tt * PW + RK + hd * 64 + f], k2 = p.proj[tt * PW + RK + hd * 64 + 32 + f];
    sK[t * 65 + f] = (k1 * cs - k2 * sn);
    sK[t * 65 + 32 + f] = (k2 * cs + k1 * sn);
    float q1 = p.proj[tt * PW + RQ + hd * 64 + f], q2 = p.proj[tt * PW + RQ + hd * 64 + 32 + f];
    sQ[t * 65 + f] = (q1 * cs - q2 * sn) * 0.125f;
    sQ[t * 65 + 32 + f] = (q2 * cs + q1 * sn) * 0.125f;
  }
#pragma unroll
  for (int i = tid; i < 128 * 64; i += NT) {
    int t = i >> 6, e = i & 63;
    sV[t * 65 + e] = p.proj[(size_t)(t0 + t) * PW + RV + hd * 64 + e];
  }
  __syncthreads();
  const int i0 = wave * 16;
  f32x4 sc[8], os[4];
#pragma unroll
  for (int t = 0; t < 8; ++t) sc[t] = f32x4{0.f, 0.f, 0.f, 0.f};
#pragma unroll
  for (int t = 0; t < 4; ++t) os[t] = f32x4{0.f, 0.f, 0.f, 0.f};
  mm16<8>(sc, sQ + i0 * 65, 65, 1, sK, 1, 65, 64);
  mm16<4>(os, sQ + i0 * 65, 65, 1, sSt, 65, 1, 64);
  __syncthreads();
  float* sP = (float*)smem;
#pragma unroll
  for (int t2 = 0; t2 < 8; ++t2)
#pragma unroll
    for (int e = 0; e < 4; ++e) {
      int i = i0 + 4 * qd + e, j = t2 * 16 + r;
      sP[i * 129 + j] = (i >= j) ? sc[t2][e] * expf(lg * (float)(i - j)) : 0.f;
    }
  __syncthreads();
  f32x4 o[4];
#pragma unroll
  for (int t2 = 0; t2 < 4; ++t2)
#pragma unroll
    for (int e = 0; e < 4; ++e) o[t2][e] = os[t2][e] * expf(lg * (float)(i0 + 4 * qd + e + 1));
  mm16<4>(o, sP + i0 * 129, 129, 1, sV, 65, 1, 128);
#pragma unroll
  for (int e = 0; e < 4; ++e) {
    int i = i0 + 4 * qd + e; size_t t = t0 + i;
    float sm = sum16(o[0][e] + o[1][e] + o[2][e] + o[3][e]);
    float mu = sm * (1.f / 64.f);
    float vr = 0.f;
#pragma unroll
    for (int t2 = 0; t2 < 4; ++t2) { float dd = o[t2][e] - mu; vr += dd * dd; }
    vr = sum16(vr);
    float rstd = rsqrtf(vr * (1.f / 64.f) + EPS);
    float ss = 0.f;
#pragma unroll
    for (int t2 = 0; t2 < 4; ++t2) {
      int col = hd * 64 + t2 * 16 + r;
      float on = (o[t2][e] - mu) * rstd * p.ret_gn[l * 256 + col];
      float g = p.proj[t * PW + RG + col];
      float y = siluf_(g) * on;
      ss += y * y;
      p.zb[t * DM + col] = f2bf(y * p.branch_norm[(l * 4 + 0) * 256 + col]);
    }
    ss = sum16(ss);
    if (r == 0) p.ssq[t * 16 + hd] = ss;
  }
  __syncthreads();
}

DEVI void lru_local(const Params& p, int l, int c, char* smem) {
  const int t0 = c * 64;
  float* sX = (float*)smem; float* sA = sX + 64 * 257;
  const int tid = TID(), lane = tid & 63, wave = tid >> 6, r = lane & 15, qd = lane >> 4;
  {
    const int ch = tid & 255, half = tid >> 8;
    const float w0 = p.lru_conv_w[(l * 4 + 0) * 256 + ch], w1 = p.lru_conv_w[(l * 4 + 1) * 256 + ch];
    const float w2 = p.lru_conv_w[(l * 4 + 2) * 256 + ch], w3 = p.lru_conv_w[(l * 4 + 3) * 256 + ch];
    const float cb = p.lru_conv_b[l * 256 + ch];
    const float* pc = p.proj + LX + ch;
    float xv[35];
#pragma unroll
    for (int k = 0; k < 35; ++k) {
      const int tt = t0 + 32 * half - 3 + k;
      const float v = pc[(size_t)(tt < 0 ? 0 : tt) * PW];
      xv[k] = tt < 0 ? 0.f : v;
    }
#pragma unroll
    for (int m = 0; m < 32; ++m) {
      float acc = cb;
      acc += w0 * xv[m]; acc += w1 * xv[m + 1]; acc += w2 * xv[m + 2]; acc += w3 * xv[m + 3];
      sX[(32 * half + m) * 257 + ch] = acc;
    }
  }
  __syncthreads();
  for (int pr = 0; pr < 2; ++pr) {
    int pi = wave * 2 + pr, mt = pi & 3, nb = pi >> 2;
    f32x4 ra[4], ri[4];
#pragma unroll
    for (int t = 0; t < 4; ++t) { ra[t] = f32x4{0.f, 0.f, 0.f, 0.f}; ri[t] = f32x4{0.f, 0.f, 0.f, 0.f}; }
    mm16_gB64<4>(ra, sX + mt * 16 * 257 + nb * 64, 257, p.lru_w_a + (size_t)(l * 4 + nb) * 4096);
    mm16_gB64<4>(ri, sX + mt * 16 * 257 + nb * 64, 257, p.lru_w_x + (size_t)(l * 4 + nb) * 4096);
#pragma unroll
    for (int t2 = 0; t2 < 4; ++t2)
#pragma unroll
      for (int e = 0; e < 4; ++e) {
        int t = mt * 16 + 4 * qd + e, ch = nb * 64 + t2 * 16 + r;
        float xb = sX[t * 257 + ch];
        float rr = sigmoidf_(ra[t2][e] + p.lru_b_a[l * 256 + ch]);
        float ii = sigmoidf_(ri[t2][e] + p.lru_b_x[l * 256 + ch]);
        float loga = -8.f * rr * softplusf_(-p.lru_lambda[l * 256 + ch]);
        float a = expf(loga);
        float bb = sqrtf(-expm1f(2.f * loga)) * (ii * xb);
        sA[t * 257 + ch] = a; sX[t * 257 + ch] = bb;
      }
  }
  __syncthreads();
  if (tid < 256) {
    int ch = tid; float H = 0.f, P = 1.f;
    for (int t = 0; t < 64; ++t) {
      float a = sA[t * 257 + ch], bb = sX[t * 257 + ch];
      H = a * H + bb; P *= a;
      p.lru_h[(size_t)(t0 + t) * 256 + ch] = H; p.lru_p[(size_t)(t0 + t) * 256 + ch] = P;
    }
    p.lru_hs[c * 256 + ch] = H; p.lru_ps[c * 256 + ch] = P;
  }
  __syncthreads();
}

DEVI void lru_out(const Params& p, int l, int c, char* smem) {
  const int t0 = c * 64;
  float* sC = (float*)smem;
  const int tid = TID(), lane = tid & 63, wave = tid >> 6;
  if (tid < 256) sC[tid] = p.lru_hs[c * 256 + tid];
  __syncthreads();
  {
    const int ch = lane * 4;
    float4 Hs[8], Ps[8], gs[8];
#pragma unroll
    for (int tk = 0; tk < 8; ++tk) {
      const size_t t = t0 + wave * 8 + tk;
      Hs[tk] = *(const float4*)&p.lru_h[t * 256 + ch]; Ps[tk] = *(const float4*)&p.lru_p[t * 256 + ch];
      gs[tk] = *(const float4*)&p.proj[t * PW + LG + ch];
    }
    const float4 cr = *(const float4*)&sC[ch];
    const float4 bn = *(const float4*)&p.branch_norm[(l * 4 + 1) * 256 + ch];
#pragma unroll
    for (int tk = 0; tk < 8; ++tk) {
      const size_t t = t0 + wave * 8 + tk;
      const float4 H = Hs[tk], P = Ps[tk], g = gs[tk];
      float y0 = geluf_(g.x) * (H.x + P.x * cr.x), y1 = geluf_(g.y) * (H.y + P.y * cr.y);
      float y2 = geluf_(g.z) * (H.z + P.z * cr.z), y3 = geluf_(g.w) * (H.w + P.w * cr.w);
      float ss = wave_sum(y0 * y0 + y1 * y1 + y2 * y2 + y3 * y3);
      if (lane == 0) p.ssq[t * 16 + 4] = ss;
      *(uint2*)&p.zb[t * DM + 256 + ch] = uint2{pack2(y0 * bn.x, y1 * bn.y), pack2(y2 * bn.z, y3 * bn.w)};
    }
  }
  __syncthreads();
}

DEVI void s5_coef(const Params& p, int l, int g, int n, float& abr, float& abi, float (&bbr)[16], float (&bbi)[16]) {
  float dt = expf(p.s5_log_dt[l * 16 + g]);
  float are = p.s5_a_re[(l * 16 + g) * 64 + n], aim = p.s5_a_im[(l * 16 + g) * 64 + n];
  float mag = expf(are * dt), ang = aim * dt;
  abr = mag * cosf(ang); abi = mag * sinf(ang);
  float den = are * are + aim * aim;
  float pre = abr - 1.f, pim = abi;
  float fre = (pre * are + pim * aim) / den, fim = (pim * are - pre * aim) / den;
  const float4* br = (const float4*)(p.s5_b_re + (size_t)((l * 16 + g) * 64 + n) * 16);
  const float4* bi = (const float4*)(p.s5_b_im + (size_t)((l * 16 + g) * 64 + n) * 16);
#pragma unroll
  for (int c4 = 0; c4 < 4; ++c4) {
    float4 a = br[c4], b = bi[c4];
    bbr[c4 * 4 + 0] = fre * a.x - fim * b.x; bbi[c4 * 4 + 0] = fre * b.x + fim * a.x;
    bbr[c4 * 4 + 1] = fre * a.y - fim * b.y; bbi[c4 * 4 + 1] = fre * b.y + fim * a.y;
    bbr[c4 * 4 + 2] = fre * a.z - fim * b.z; bbi[c4 * 4 + 2] = fre * b.z + fim * a.z;
    bbr[c4 * 4 + 3] = fre * a.w - fim * b.w; bbi[c4 * 4 + 3] = fre * b.w + fim * a.w;
  }
}
DEVI void s5_load_u(const Params& p, int t0, float* sU) {
#pragma unroll
  for (int i = TID(); i < 64 * 64; i += NT) {
    int t = i >> 6, c4 = i & 63;
    *(float4*)&sU[t * 256 + c4 * 4] = *(const float4*)&p.proj[(size_t)(t0 + t) * PW + SU + c4 * 4];
  }
}
DEVI void s5_bu(const float* up, const float (&bbr)[16], const float (&bbi)[16], float& bur, float& bui) {
  bur = 0.f; bui = 0.f;
#pragma unroll
  for (int c4 = 0; c4 < 4; ++c4) {
    float4 u = *(const float4*)&up[c4 * 4];
    bur += bbr[c4 * 4] * u.x + bbr[c4 * 4 + 1] * u.y + bbr[c4 * 4 + 2] * u.z + bbr[c4 * 4 + 3] * u.w;
    bui += bbi[c4 * 4] * u.x + bbi[c4 * 4 + 1] * u.y + bbi[c4 * 4 + 2] * u.z + bbi[c4 * 4 + 3] * u.w;
  }
}

DEVI void s5_local(const Params& p, int l, int c, char* smem) {
  const int t0 = c * 64;
  float* sU = (float*)smem;
  const int lane = TID() & 63, wave = TID() >> 6;
  s5_load_u(p, t0, sU);
  __syncthreads();
  for (int gi = 0; gi < 2; ++gi) {
    int g = wave + 8 * gi;
    float abr, abi, bbr[16], bbi[16];
    s5_coef(p, l, g, lane, abr, abi, bbr, bbi);
    float xr = 0.f, xi = 0.f;
    for (int t = 0; t < 64; ++t) {
      float bur, bui; s5_bu(sU + t * 256 + g * 16, bbr, bbi, bur, bui);
      float nr = abr * xr - abi * xi + bur, ni = abr * xi + abi * xr + bui;
      xr = nr; xi = ni;
    }
    *(float2*)&p.xloc[((size_t)(c * 16 + g) * 64 + lane) * 2] = float2{xr, xi};
  }
  __syncthreads();
}

DEVI void s5_out(const Params& p, int l, int c, char* smem) {
  const int t0 = c * 64;
  bf16_t* sY = (bf16_t*)smem;
  float* sX = (float*)(smem + 64 * 264 * 2);
  const int tid = TID(), lane = tid & 63, wave = tid >> 6, r = lane & 15, qd = lane >> 4;
  float* Xl = sX + wave * (16 * 132);
  for (int gi = 0; gi < 2; ++gi) {
    const int g = wave + 8 * gi;
    float abr, abi, bbr[16], bbi[16];
    s5_coef(p, l, g, lane, abr, abi, bbr, bbi);
    float breg[32];
#pragma unroll
    for (int ks = 0; ks < 16; ++ks) {
      breg[ks] = p.s5_c_re[(size_t)((l * 16 + g) * 16 + r) * 64 + 4 * ks + qd];
      breg[16 + ks] = -p.s5_c_im[(size_t)((l * 16 + g) * 16 + r) * 64 + 4 * ks + qd];
    }
    const float dd = p.s5_d[l * 256 + g * 16 + r];
    const float2 xin = *(const float2*)&p.xloc[((size_t)(c * 16 + g) * 64 + lane) * 2];
    float xr = xin.x, xi = xin.y;
    float4 uvecs[4]; float ues[4][4];
#pragma unroll
    for (int tb = 0; tb < 4; ++tb) {
      const float* ub = p.proj + (size_t)(t0 + tb * 16) * PW + SU + g * 16;
      uvecs[tb] = *(const float4*)&ub[(size_t)r * PW + 4 * qd];
#pragma unroll
      for (int e = 0; e < 4; ++e) ues[tb][e] = ub[(size_t)(4 * qd + e) * PW + r];
    }
#pragma unroll
    for (int tb = 0; tb < 4; ++tb) {
      const float4 uvec = uvecs[tb];
      float ue[4];
#pragma unroll
      for (int e = 0; e < 4; ++e) ue[e] = ues[tb][e];
      const int u0 = __float_as_int(uvec.x), u1 = __float_as_int(uvec.y), u2 = __float_as_int(uvec.z), u3 = __float_as_int(uvec.w);
#pragma unroll
      for (int tt = 0; tt < 16; ++tt) {
        float bur = 0.f, bui = 0.f;
#pragma unroll
        for (int c4 = 0; c4 < 4; ++c4) {
          float a0 = __int_as_float(__builtin_amdgcn_readlane(u0, tt + 16 * c4));
          float a1 = __int_as_float(__builtin_amdgcn_readlane(u1, tt + 16 * c4));
          float a2 = __int_as_float(__builtin_amdgcn_readlane(u2, tt + 16 * c4));
          float a3 = __int_as_float(__builtin_amdgcn_readlane(u3, tt + 16 * c4));
          bur += bbr[c4 * 4] * a0 + bbr[c4 * 4 + 1] * a1 + bbr[c4 * 4 + 2] * a2 + bbr[c4 * 4 + 3] * a3;
          bui += bbi[c4 * 4] * a0 + bbi[c4 * 4 + 1] * a1 + bbi[c4 * 4 + 2] * a2 + bbi[c4 * 4 + 3] * a3;
        }
        float nr = abr * xr - abi * xi + bur, ni = abr * xi + abi * xr + bui;
        xr = nr; xi = ni;
        Xl[tt * 132 + lane] = xr; Xl[tt * 132 + 64 + lane] = xi;
      }
      f32x4 acc = f32x4{0.f, 0.f, 0.f, 0.f};
#pragma unroll
      for (int ks = 0; ks < 32; ++ks) {
        float a = Xl[r * 132 + 4 * ks + qd];
        acc = __builtin_amdgcn_mfma_f32_16x16x4f32(a, breg[ks], acc, 0, 0, 0);
      }
#pragma unroll
      for (int e = 0; e < 4; ++e) {
        float y = acc[e] + dd * ue[e];
        sY[(tb * 16 + 4 * qd + e) * 264 + g * 16 + r] = f2bf(geluf_(y));
      }
    }
  }
  __syncthreads();
  f32x4 av[4][2], ag[4][2];
#pragma unroll
  for (int i = 0; i < 4; ++i)
#pragma unroll
    for (int j = 0; j < 2; ++j) { av[i][j] = f32x4{0.f, 0.f, 0.f, 0.f}; ag[i][j] = f32x4{0.f, 0.f, 0.f, 0.f}; }
  const bf16_t* WT = p.gluT + (size_t)l * 512 * 256;
#pragma unroll 4
  for (int ks = 0; ks < 8; ++ks) {
    bf16x8 bv0 = *(const bf16x8*)&WT[(size_t)(32 * wave + r) * 256 + ks * 32 + qd * 8];
    bf16x8 bv1 = *(const bf16x8*)&WT[(size_t)(32 * wave + 16 + r) * 256 + ks * 32 + qd * 8];
    bf16x8 bg0 = *(const bf16x8*)&WT[(size_t)(256 + 32 * wave + r) * 256 + ks * 32 + qd * 8];
    bf16x8 bg1 = *(const bf16x8*)&WT[(size_t)(256 + 32 * wave + 16 + r) * 256 + ks * 32 + qd * 8];
#pragma unroll
    for (int mt = 0; mt < 4; ++mt) {
      bf16x8 a = *(const bf16x8*)&sY[(mt * 16 + r) * 264 + ks * 32 + qd * 8];
      av[mt][0] = __builtin_amdgcn_mfma_f32_16x16x32_bf16(a, bv0, av[mt][0], 0, 0, 0);
      av[mt][1] = __builtin_amdgcn_mfma_f32_16x16x32_bf16(a, bv1, av[mt][1], 0, 0, 0);
      ag[mt][0] = __builtin_amdgcn_mfma_f32_16x16x32_bf16(a, bg0, ag[mt][0], 0, 0, 0);
      ag[mt][1] = __builtin_amdgcn_mfma_f32_16x16x32_bf16(a, bg1, ag[mt][1], 0, 0, 0);
    }
  }
  float* sO = sX;
#pragma unroll
  for (int mt = 0; mt < 4; ++mt)
#pragma unroll
    for (int t2 = 0; t2 < 2; ++t2)
#pragma unroll
      for (int e = 0; e < 4; ++e) {
        int t = mt * 16 + 4 * qd + e, col = 32 * wave + t2 * 16 + r;
        float zv = av[mt][t2][e] + p.s5_glu_b[l * 512 + col];
        float zg = ag[mt][t2][e] + p.s5_glu_b[l * 512 + 256 + col];
        sO[t * 256 + col] = zv * sigmoidf_(zg);
      }
  __syncthreads();
  for (int tk = 0; tk < 8; ++tk) {
    int tl = wave * 8 + tk; size_t t = t0 + tl; int ch = lane * 4;
    float4 o = *(const float4*)&sO[tl * 256 + ch];
    float4 bn = *(const float4*)&p.branch_norm[(l * 4 + 2) * 256 + ch];
    float ss = wave_sum(o.x * o.x + o.y * o.y + o.z * o.z + o.w * o.w);
    if (lane == 0) p.ssq[t * 16 + 5] = ss;
    *(uint2*)&p.zb[t * DM + 512 + ch] = uint2{pack2(o.x * bn.x, o.y * bn.y), pack2(o.z * bn.z, o.w * bn.w)};
  }
  __syncthreads();
}

DEVI void ret_scan(const Params& p, int it) {
  const int elem = it * NT + TID(), hd = elem >> 12, idx = elem & 4095;
  const float lg = logf(1.f - exp2f(-5.f - (float)hd)), cdk = expf(lg * 128.f);
  float* base = p.ret_kv + (size_t)hd * 4096 + idx;
  float s = 0.f;
  for (int cb = 0; cb < 128; cb += 16) {
    float v[16];
#pragma unroll
    for (int j = 0; j < 16; ++j) v[j] = base[(size_t)(cb + j) * 16384];
#pragma unroll
    for (int j = 0; j < 16; ++j) { base[(size_t)(cb + j) * 16384] = s; s = s * cdk + v[j]; }
  }
}
DEVI void s5_scan(const Params& p, int l, int it) {
  const int sidx = it * NT + TID(), g = sidx >> 6, n = sidx & 63;
  float dt = expf(p.s5_log_dt[l * 16 + g]);
  float are = p.s5_a_re[(l * 16 + g) * 64 + n], aim = p.s5_a_im[(l * 16 + g) * 64 + n];
  float mag = expf(are * dt), ang = aim * dt;
  float pr = mag * cosf(ang), pi = mag * sinf(ang);
#pragma unroll
  for (int k = 0; k < 6; ++k) { float nr = pr * pr - pi * pi, ni = 2.f * pr * pi; pr = nr; pi = ni; }
  float2* base = (float2*)p.xloc + sidx;
  float xr = 0.f, xi = 0.f;
  for (int cb = 0; cb < 256; cb += 16) {
    float2 v[16];
#pragma unroll
    for (int j = 0; j < 16; ++j) v[j] = base[(size_t)(cb + j) * 1024];
#pragma unroll
    for (int j = 0; j < 16; ++j) {
      base[(size_t)(cb + j) * 1024] = float2{xr, xi};
      float nr = pr * xr - pi * xi + v[j].x, ni = pr * xi + pi * xr + v[j].y;
      xr = nr; xi = ni;
    }
  }
}
DEVI void lru_scan(const Params& p) {
  const int ch = TID();
  if (ch < 256) {
    float carry = 0.f;
    for (int cb = 0; cb < 256; cb += 16) {
      float ps[16], hs[16];
#pragma unroll
      for (int j = 0; j < 16; ++j) { ps[j] = p.lru_ps[(cb + j) * 256 + ch]; hs[j] = p.lru_hs[(cb + j) * 256 + ch]; }
#pragma unroll
      for (int j = 0; j < 16; ++j) { p.lru_hs[(cb + j) * 256 + ch] = carry; carry = ps[j] * carry + hs[j]; }
    }
  }
}

DEVI void peer_scores(const Params& p, int l, int item, char* smem) {
  const int hp = item & 15, grp = item >> 4;
  float* sQ = (float*)smem;
  float* sKy = sQ + 64 * 68;
  const int tid = TID(), lane = tid & 63, wave = tid >> 6, r = lane & 15, qd = lane >> 4;
  const float* ky = p.peer_subkeys + (size_t)(l * 16 + hp) * 8192;
#pragma unroll
  for (int i = tid; i < 128 * 64; i += NT) { int k = i >> 6, d = i & 63; sKy[k * 65 + d] = ky[i]; }
  const int lt0 = tid >> 4, lc4 = (tid & 15) * 4;
  const float* qb = p.qbuf + (size_t)hp * 64 + lc4;
  float4 q0, q1;
  {
    const size_t t0 = (size_t)(grp * 16) * 64;
    q0 = *(const float4*)&qb[(t0 + lt0) * 1024]; q1 = *(const float4*)&qb[(t0 + lt0 + 32) * 1024];
  }
  const int mt = wave & 3, nh = wave >> 2;
  for (int k = 0; k < 16; ++k) {
    const size_t t0 = (size_t)(grp * 16 + k) * 64;
    __syncthreads();
    *(float4*)&sQ[lt0 * 68 + lc4] = q0; *(float4*)&sQ[(lt0 + 32) * 68 + lc4] = q1;
    __syncthreads();
    if (k + 1 < 16) { q0 = *(const float4*)&qb[(t0 + 64 + lt0) * 1024]; q1 = *(const float4*)&qb[(t0 + 64 + lt0 + 32) * 1024]; }
    f32x4 acc[4];
#pragma unroll
    for (int t = 0; t < 4; ++t) acc[t] = f32x4{0.f, 0.f, 0.f, 0.f};
    mm16<4>(acc, sQ + mt * 16 * 68, 68, 1, sKy + nh * 64 * 65, 1, 65, 64);
#pragma unroll
    for (int t2 = 0; t2 < 4; ++t2)
#pragma unroll
      for (int e = 0; e < 4; ++e) {
        size_t t = t0 + mt * 16 + 4 * qd + e; int key = nh * 64 + t2 * 16 + r;
        p.scores[(t * 16 + hp) * 128 + key] = acc[t2][e];
      }
  }
  __syncthreads();
}

DEVI unsigned ford(float x) { unsigned u = __float_as_uint(x); return (u & 0x80000000u) ? ~u : (u | 0x80000000u); }
DEVI float funord(unsigned u) { return __uint_as_float((u & 0x80000000u) ? (u ^ 0x80000000u) : ~u); }
DEVI void ins16(unsigned (&v)[16], unsigned x) {
#pragma unroll
  for (int j = 0; j < 16; ++j) { unsigned hi = max(v[j], x); x = min(v[j], x); v[j] = hi; }
}

DEVI void peer_topk(const Params& p, int item, char* smem) {
  const int t0 = item * 64;
  float* sS = (float*)smem;
  const int tid = TID();
  const float* base = p.scores + (size_t)t0 * 8 * 256;
  unsigned v1[16], v2[16];
#pragma unroll
  for (int j = 0; j < 16; ++j) { v1[j] = 0u; v2[j] = 0u; }
  float4 nx[8];
#pragma unroll
  for (int i = 0; i < 8; ++i) { int idx = tid + 512 * i; nx[i] = *(const float4*)&base[(size_t)(idx >> 3) * 256 + (idx & 7) * 4]; }
  for (int s = 0; s < 8; ++s) {
    __syncthreads();
#pragma unroll
    for (int i = 0; i < 8; ++i) {
      int idx = tid + 512 * i, pr = idx >> 3, c4 = idx & 7;
      float* d = &sS[pr * 33 + c4 * 4];
      d[0] = nx[i].x; d[1] = nx[i].y; d[2] = nx[i].z; d[3] = nx[i].w;
    }
    __syncthreads();
    if (s + 1 < 8) {
#pragma unroll
      for (int i = 0; i < 8; ++i) { int idx = tid + 512 * i; nx[i] = *(const float4*)&base[(size_t)(idx >> 3) * 256 + (s + 1) * 32 + (idx & 7) * 4]; }
    }
    const int kb = (s & 3) * 32;
    if (s < 4) {
      for (int k = 0; k < 32; ++k) { unsigned key = (ford(sS[tid * 33 + k]) & ~127u) | (unsigned)(127 - (kb + k)); ins16(v1, key); }
    } else {
      for (int k = 0; k < 32; ++k) { unsigned key = (ford(sS[tid * 33 + k]) & ~127u) | (unsigned)(127 - (kb + k)); ins16(v2, key); }
    }
  }
  __syncthreads();
  unsigned* sI = (unsigned*)smem;
  float s1[16], s2[16];
#pragma unroll
  for (int a = 0; a < 16; ++a) {
    s1[a] = funord(v1[a] & ~127u); s2[a] = funord(v2[a] & ~127u);
    sI[tid * 33 + a] = 127u - (v1[a] & 127u); sI[tid * 33 + 16 + a] = 127u - (v2[a] & 127u);
  }
  unsigned vt[16];
#pragma unroll
  for (int j = 0; j < 16; ++j) vt[j] = 0u;
#pragma unroll
  for (int a = 0; a < 16; ++a)
#pragma unroll
    for (int b = 0; b < 16; ++b)
      if ((a + 1) * (b + 1) <= 16) {
        unsigned key = (ford(s1[a] + s2[b]) & ~255u) | (unsigned)(255 - (a * 16 + b));
        ins16(vt, key);
      }
  float sv[16]; float den = 0.f;
  const float mx = funord(vt[0] & ~255u);
#pragma unroll
  for (int k = 0; k < 16; ++k) { sv[k] = expf(funord(vt[k] & ~255u) - mx); den += sv[k]; }
  const float inv = 1.f / den;
  const int tl = tid >> 3, hh = tid & 7;
  int* idp = p.ids + (size_t)(t0 + tl) * 128 + hh * 16;
  float* gp = p.gates + (size_t)(t0 + tl) * 128 + hh * 16;
#pragma unroll
  for (int k = 0; k < 16; ++k) {
    unsigned pos = 255u - (vt[k] & 255u);
    unsigned i1 = sI[tid * 33 + (pos >> 4)], i2 = sI[tid * 33 + 16 + (pos & 15)];
    idp[k] = (int)(i1 * 128u + i2);
    gp[k] = sv[k] * inv;
  }
  __syncthreads();
}

typedef __attribute__((ext_vector_type(2))) float f32x2;
DEVI void fp8x16_to_f(const uint4& v, float (&o)[16]) {
  f32x2 t;
  t = __builtin_amdgcn_cvt_pk_f32_fp8((int)v.x, false); o[0] = t[0]; o[1] = t[1];
  t = __builtin_amdgcn_cvt_pk_f32_fp8((int)v.x, true); o[2] = t[0]; o[3] = t[1];
  t = __builtin_amdgcn_cvt_pk_f32_fp8((int)v.y, false); o[4] = t[0]; o[5] = t[1];
  t = __builtin_amdgcn_cvt_pk_f32_fp8((int)v.y, true); o[6] = t[0]; o[7] = t[1];
  t = __builtin_amdgcn_cvt_pk_f32_fp8((int)v.z, false); o[8] = t[0]; o[9] = t[1];
  t = __builtin_amdgcn_cvt_pk_f32_fp8((int)v.z, true); o[10] = t[0]; o[11] = t[1];
  t = __builtin_amdgcn_cvt_pk_f32_fp8((int)v.w, false); o[12] = t[0]; o[13] = t[1];
  t = __builtin_amdgcn_cvt_pk_f32_fp8((int)v.w, true); o[14] = t[0]; o[15] = t[1];
}

DEVI void ph_gather(const Params& p, int l) {
  const int lane = TID() & 63, wave = TID() >> 6;
  const int e0 = lane * 16;
  constexpr int NB = 8;
  for (int t = blockIdx.x * 8 + wave; t < S_; t += gridDim.x * 8) {
    float* hrow = p.h + (size_t)t * DM + e0;
    float z[16], out[16];
    {
      float4 a = *(const float4*)&hrow[0], b = *(const float4*)&hrow[4], c = *(const float4*)&hrow[8], d = *(const float4*)&hrow[12];
      z[0] = a.x; z[1] = a.y; z[2] = a.z; z[3] = a.w; z[4] = b.x; z[5] = b.y; z[6] = b.z; z[7] = b.w;
      z[8] = c.x; z[9] = c.y; z[10] = c.z; z[11] = c.w; z[12] = d.x; z[13] = d.y; z[14] = d.z; z[15] = d.w;
    }
    float ss = 0.f;
#pragma unroll
    for (int k = 0; k < 16; ++k) { ss += z[k] * z[k]; out[k] = 0.f; }
    ss = wave_sum(ss);
    const float rs = rsqrtf(ss * (1.f / DM) + EPS);
    const float* fn = p.ffn_norm + l * DM + e0;
#pragma unroll
    for (int k = 0; k < 16; ++k) z[k] = z[k] * rs * fn[k];
    const int id0 = p.ids[(size_t)t * 128 + lane], id1 = p.ids[(size_t)t * 128 + 64 + lane];
    const int gv0 = __float_as_int(p.gates[(size_t)t * 128 + lane] * p.vinv[id0]);
    const int gv1 = __float_as_int(p.gates[(size_t)t * 128 + 64 + lane] * p.vinv[id1]);
    const int us0 = __float_as_int(p.uinv[id0]), us1 = __float_as_int(p.uinv[id1]);
    uint4 cu[NB], cv[NB], nu[NB], nv[NB];
#pragma unroll
    for (int j = 0; j < NB; ++j) {
      int e = __builtin_amdgcn_readlane(id0, j);
      cu[j] = *(const uint4*)(p.tabU + (size_t)e * 1024 + e0);
      cv[j] = *(const uint4*)(p.tabV + (size_t)e * 1024 + e0);
    }
#pragma unroll 1
    for (int b = 0; b < 128 / NB; ++b) {
      const int nb = b + 1;
      if (nb < 128 / NB) {
        const int idn = nb < 64 / NB ? id0 : id1;
#pragma unroll
        for (int j = 0; j < NB; ++j) {
          int e = __builtin_amdgcn_readlane(idn, (nb * NB + j) & 63);
          nu[j] = *(const uint4*)(p.tabU + (size_t)e * 1024 + e0);
          nv[j] = *(const uint4*)(p.tabV + (size_t)e * 1024 + e0);
        }
      }
      const int gvc = b < 64 / NB ? gv0 : gv1, usc = b < 64 / NB ? us0 : us1;
      float dot[NB];
#pragma unroll
      for (int j = 0; j < NB; ++j) {
        float f[16]; fp8x16_to_f(cu[j], f);
        float d = 0.f;
#pragma unroll
        for (int k = 0; k < 16; ++k) d += z[k] * f[k];
        dot[j] = d;
      }
#pragma unroll
      for (int j = 0; j < NB; ++j) dot[j] = wave_sum(dot[j]);
#pragma unroll
      for (int j = 0; j < NB; ++j) {
        const int li = (b * NB + j) & 63;
        float us = __int_as_float(__builtin_amdgcn_readlane(usc, li));
        float gt = __int_as_float(__builtin_amdgcn_readlane(gvc, li));
        float cf = gt * geluf_(dot[j] * us);
        float f[16]; fp8x16_to_f(cv[j], f);
#pragma unroll
        for (int k = 0; k < 16; ++k) out[k] += cf * f[k];
      }
#pragma unroll
      for (int j = 0; j < NB; ++j) { cu[j] = nu[j]; cv[j] = nv[j]; }
    }
    float hv[16];
    {
      float4 a = *(const float4*)&hrow[0], b = *(const float4*)&hrow[4], c = *(const float4*)&hrow[8], d = *(const float4*)&hrow[12];
      hv[0] = a.x; hv[1] = a.y; hv[2] = a.z; hv[3] = a.w; hv[4] = b.x; hv[5] = b.y; hv[6] = b.z; hv[7] = b.w;
      hv[8] = c.x; hv[9] = c.y; hv[10] = c.z; hv[11] = c.w; hv[12] = d.x; hv[13] = d.y; hv[14] = d.z; hv[15] = d.w;
    }
    float s2 = 0.f;
#pragma unroll
    for (int k = 0; k < 16; ++k) { hv[k] += out[k]; s2 += hv[k] * hv[k]; }
    *(float4*)&hrow[0] = float4{hv[0], hv[1], hv[2], hv[3]}; *(float4*)&hrow[4] = float4{hv[4], hv[5], hv[6], hv[7]};
    *(float4*)&hrow[8] = float4{hv[8], hv[9], hv[10], hv[11]}; *(float4*)&hrow[12] = float4{hv[12], hv[13], hv[14], hv[15]};
    s2 = wave_sum(s2);
    const float rs2 = rsqrtf(s2 * (1.f / DM) + EPS);
    const float* pn = p.ple_norm + l * DM + e0;
    float zz[16];
#pragma unroll
    for (int k = 0; k < 16; ++k) zz[k] = hv[k] * rs2 * pn[k];
    bf16_t* zrow = p.zb + (size_t)t * DM + e0;
    *(uint4*)&zrow[0] = uint4{pack2(zz[0], zz[1]), pack2(zz[2], zz[3]), pack2(zz[4], zz[5]), pack2(zz[6], zz[7])};
    *(uint4*)&zrow[8] = uint4{pack2(zz[8], zz[9]), pack2(zz[10], zz[11]), pack2(zz[12], zz[13]), pack2(zz[14], zz[15])};
  }
}

template <class F>
DEVI void gemm_tiles(int NTn, int XM, int XN, F&& f) {
  int G = gridDim.x, B = blockIdx.x;
  asm volatile("" : "+s"(G), "+s"(B));
  if (G & 7) { for (int tile = B; tile < 64 * NTn; tile += G) f(tile / NTn, tile % NTn); return; }
  const int x = B & 7, slot = B >> 3, ns = G >> 3;
  const int xm = x / XN, xn = x % XN;
  const int mcnt = 64 / XM, mb = xm * mcnt;
  const int ncnt = (NTn - xn + XN - 1) / XN;
  for (int j = slot; j < mcnt * ncnt; j += ns) f(mb + j / ncnt, xn + XN * (j % ncnt));
}

enum { PH_PREP = 0, PH_NORM1, PH_GEMM_IN, PH_MIX_A, PH_MIX_B, PH_MIX_C, PH_MIX_D, PH_GEMM_OUT, PH_NORM2, PH_GEMM_Q, PH_SCORES,
       PH_TOPK, PH_GATHER, PH_GEMM_PLE, PH_FINAL };

#if PROBE_A >= 0
#define REGION(id, stmt)                                                                                   \
  {                                                                                                        \
    const bool on_ = (blockIdx.x == 255 && TID() == 0 && ((id) == PROBE_A || (id) == PROBE_B));              \
    if (on_) p.g_cdec[2051] = (float)(wall_clock64() & 0xFFFFFFull);                                       \
    stmt;                                                                                                  \
    if (on_) {                                                                                             \
      float dt_ = (float)(wall_clock64() & 0xFFFFFFull) - p.g_cdec[2051];                                  \
      if (dt_ < 0.f) dt_ += 16777216.f;                                                                    \
      p.g_cdec[(id) == PROBE_A ? 2048 : 2049] += dt_;                                                      \
    }                                                                                                      \
  }
#else
#define REGION(id, stmt) { stmt; }
#endif
DEVI void run_phase(const Params& p, int ph, int l, char* smem) {
  int G = gridDim.x, B = blockIdx.x;
  asm volatile("" : "+s"(G), "+s"(B));
  switch (ph) {
    case PH_PREP: ph_prep(p, smem); break;
    case PH_NORM1: ph_norm(l == 0 ? p.x : p.h, p.mix_norm + l * DM, p.zb, nullptr); break;
    case PH_GEMM_IN:
      gemm_tiles(23, 1, 8, [&](int mt_, int nt_) __attribute__((always_inline)) {
        int m0 = mt_ * 256, n0 = nt_ * 128;
        f32x4 acc[4][4];
        gemm_tile<0, 16>(acc, p.zb, DM, p.winT + (size_t)l * PW * 1024, 1024, 1024, m0, n0, nullptr, smem);
        GEMM_EPI_COORDS
#pragma unroll
        for (int i = 0; i < 4; ++i)
#pragma unroll
          for (int j = 0; j < 4; ++j)
            *(f32x4*)&p.proj[(size_t)(erow0 + i * 16) * PW + ecol0 + j * 16] = acc[i][j];
      });
      break;
    case PH_MIX_A:
      for (int it = B; it < 2048; it += G) {
        if (it < 1024) REGION(105, gdn_prep(p, l, it, smem))
        else if (it < 1536) REGION(106, ret_kv(p, l, it - 1024, smem))
        else if (it < 1792) REGION(107, lru_local(p, l, it - 1536, smem))
        else REGION(108, s5_local(p, l, it - 1792, smem))
      }
      break;
    case PH_MIX_B:
      for (int it = B; it < 256 + 35; it += G) {
        if (it < 256) { const int pr_ = (it & 7) * 4 + (it >> 6), cb_ = (it >> 3) & 7; REGION(100, gdn_chain<0>(p, pr_ >> 3, pr_ & 7, cb_, smem)) }
        else if (it < 256 + 32) ret_scan(p, it - 256);
        else if (it < 256 + 34) s5_scan(p, l, it - 288);
        else lru_scan(p);
      }
      break;
    case PH_MIX_C: {
      for (int it = B; it < 128; it += G) {
        const int pr_ = (it & 7) * 4 + (it >> 5), cb_ = (it >> 3) & 3;
        REGION(102, gdn_chain<1>(p, pr_ >> 3, pr_ & 7, cb_, smem))
      }
      int jb = B, js = G, je = 1024;
      if (G == 256) {
        js = 1;
        if (B < 128) { jb = 640 + B * 3; je = jb + 3; } else { jb = (B - 128) * 5; je = jb + 5; }
      }
      for (int j = jb; j < je; j += js) {
        const int ty = j & 3, q4 = j >> 2;
        if (ty < 2) REGION(101, ret_out(p, l, q4 * 2 + ty, smem))
        else if (ty == 2) REGION(103, s5_out(p, l, q4, smem))
        else REGION(104, lru_out(p, l, q4, smem))
      }
    } break;
    case PH_MIX_D:
      for (int it = B; it < 1024; it += G) REGION(109, gdn_out(p, l, it, smem))
      break;
    case PH_GEMM_OUT:
      gemm_tiles(8, 4, 2, [&](int mt_, int nt_) __attribute__((always_inline)) {
        int m0 = mt_ * 256, n0 = nt_ * 128;
        f32x4 acc[4][4];
        gemm_tile<1, 16>(acc, p.zb, DM, p.woutT + (size_t)l * 1024 * 1024, 1024, 1024, m0, n0, p.ssq, smem);
        GEMM_EPI_COORDS
#pragma unroll
        for (int i = 0; i < 4; ++i)
#pragma unroll
          for (int j = 0; j < 4; ++j)
            acc[i][j] += *(const f32x4*)&(l == 0 ? p.x : p.h)[(size_t)(erow0 + i * 16) * DM + ecol0 + j * 16];
#pragma unroll
        for (int i = 0; i < 4; ++i)
#pragma unroll
          for (int j = 0; j < 4; ++j)
            *(f32x4*)&p.h[(size_t)(erow0 + i * 16) * DM + ecol0 + j * 16] = acc[i][j];
      });
      break;
    case PH_NORM2:
      ph_norm(p.h, p.ffn_norm + l * DM, p.zb, nullptr);
      convert_tables(p, l);
      {
        const size_t gtid = (size_t)B * NT + TID(), gsz = (size_t)G * NT;
        const float4* sp = (const float4*)(p.p + (size_t)l * S_ * 256);
        for (size_t i = gtid; i < (size_t)S_ * 256 / 8; i += gsz) {
          float4 a = sp[2 * i], b = sp[2 * i + 1];
          ((uint4*)p.pbf)[i] = uint4{pack2(a.x, a.y), pack2(a.z, a.w), pack2(b.x, b.y), pack2(b.z, b.w)};
        }
      }
      break;
    case PH_GEMM_Q:
      gemm_tiles(8, 4, 2, [&](int mt_, int nt_) __attribute__((always_inline)) {
        int m0 = mt_ * 256, n0 = nt_ * 128;
        f32x4 acc[4][4];
        gemm_tile<0, 16>(acc, p.zb, DM, p.wqT + (size_t)l * 1024 * 1024, 1024, 1024, m0, n0, nullptr, smem);
        GEMM_EPI_COORDS
#pragma unroll
        for (int i = 0; i < 4; ++i)
#pragma unroll
          for (int j = 0; j < 4; ++j)
            *(f32x4*)&p.qbuf[(size_t)(erow0 + i * 16) * DM + ecol0 + j * 16] = acc[i][j];
      });
      break;
    case PH_SCORES:
      for (int it = B; it < 256; it += G) REGION(110, peer_scores(p, l, it, smem))
      break;
    case PH_TOPK:
      for (int it = B; it < 256; it += G) REGION(111, peer_topk(p, it, smem))
      break;
    case PH_GATHER: ph_gather(p, l); break;
    case PH_GEMM_PLE:
      gemm_tiles(8, 4, 2, [&](int mt_, int nt_) __attribute__((always_inline)) {
        int m0 = mt_ * 256, n0 = nt_ * 128;
        uint2* gsc = (uint2*)p.g_attn + (size_t)B * 16 * NT + TID();
        {
          f32x4 ag[4][4];
          gemm_tile<0, 16>(ag, p.zb, DM, p.wgT + (size_t)l * 1024 * 1024, 1024, 1024, m0, n0, nullptr, smem);
#pragma unroll
          for (int i = 0; i < 4; ++i)
#pragma unroll
            for (int j = 0; j < 4; ++j)
              gsc[(i * 4 + j) * NT] = uint2{pack2(sigmoidf_(ag[i][j][0]), sigmoidf_(ag[i][j][1])),
                                            pack2(sigmoidf_(ag[i][j][2]), sigmoidf_(ag[i][j][3]))};
        }
        f32x4 ap[4][4];
        gemm_tile<0, 4>(ap, p.pbf, 256, p.wpT + (size_t)l * 1024 * 256, 256, 256, m0, n0, nullptr, smem);
        GEMM_EPI_COORDS
#pragma unroll
        for (int i = 0; i < 4; ++i)
#pragma unroll
          for (int j = 0; j < 4; ++j) {
            const f32x4 hv = *(const f32x4*)&p.h[(size_t)(erow0 + i * 16) * DM + ecol0 + j * 16];
            const uint2 gk = gsc[(i * 4 + j) * NT];
            ap[i][j][0] = hv[0] + ap[i][j][0] * __uint_as_float(gk.x << 16);
            ap[i][j][1] = hv[1] + ap[i][j][1] * __uint_as_float(gk.x & 0xFFFF0000u);
            ap[i][j][2] = hv[2] + ap[i][j][2] * __uint_as_float(gk.y << 16);
            ap[i][j][3] = hv[3] + ap[i][j][3] * __uint_as_float(gk.y & 0xFFFF0000u);
          }
#pragma unroll
        for (int i = 0; i < 4; ++i)
#pragma unroll
          for (int j = 0; j < 4; ++j)
            *(f32x4*)&p.h[(size_t)(erow0 + i * 16) * DM + ecol0 + j * 16] = ap[i][j];
      });
      break;
    case PH_FINAL: ph_norm(p.h, p.final_norm, nullptr, p.out); break;
  }
}

#if !MEGA
__global__ void __launch_bounds__(NT) k_phase(Params p, int ph, int l) {
  extern __shared__ __align__(16) char smem[];
  run_phase(p, ph, l, smem);
}
#endif

#define XB_TMO      128
#define XB_XCNT(j)  (256  + 64 * (j))
#define XB_XSUB(j)  (1280 + 64 * (j))
#define XB_XGEN(j)  (2304 + 64 * (j))
#define XB_TOP      3328
#define XB_TOPGEN   3392
#define XCD_BAR_WORDS 3456
#define XB_SPIN_CAP (1u << 18)
#define LAS __attribute__((address_space(3)))
DEVI unsigned xb_ld(unsigned* p) { return __hip_atomic_load(p, __ATOMIC_RELAXED, __HIP_MEMORY_SCOPE_AGENT); }
DEVI unsigned xb_add(unsigned* p, unsigned v) { return __hip_atomic_fetch_add(p, v, __ATOMIC_RELAXED, __HIP_MEMORY_SCOPE_AGENT); }
DEVI unsigned xb_xcc_id() { return (unsigned)__builtin_amdgcn_s_getreg((3 << 11) | 20) & 0xFu; }
#define XB_SPIN(cond, bar) do { unsigned _sp = 0; while (cond) { __builtin_amdgcn_s_sleep(1); \
    if ((++_sp & 255u) == 0u) { if (xb_ld(&(bar)[XB_TMO])) break; if (_sp > XB_SPIN_CAP) { atomicAdd(&(bar)[XB_TMO], 1u); break; } } } } while (0)
struct XcdBarrier { unsigned* bar; unsigned x; volatile LAS unsigned* st; };
DEVI XcdBarrier xcd_barrier_post(unsigned* bar, volatile LAS unsigned* st) {
  XcdBarrier b; b.bar = bar; b.x = xb_xcc_id(); b.st = st;
  if (TID() == 0) (void)xb_add(&bar[XB_XCNT(b.x)], 1u);
  return b;
}
DEVI void xcd_barrier_complete(unsigned* bar, unsigned x, unsigned& nloc, unsigned& nx) {
  const unsigned G = gridDim.x * gridDim.y * gridDim.z;
  unsigned sum, cnt, mine, sp = 0u;
  for (;;) {
    sum = 0u; cnt = 0u; mine = 0u;
#pragma unroll
    for (unsigned j = 0; j < 16; ++j) { const unsigned c = xb_ld(&bar[XB_XCNT(j)]); sum += c; cnt += (c > 0u) ? 1u : 0u; mine = (j == x) ? c : mine; }
    if (sum == G) break;
    __builtin_amdgcn_s_sleep(1);
    if ((++sp & 255u) == 0u) { if (xb_ld(&bar[XB_TMO])) break; if (sp > XB_SPIN_CAP) { atomicAdd(&bar[XB_TMO], 1u); break; } }
  }
  nloc = mine > 0u ? mine : 1u; nx = cnt > 0u ? cnt : 1u;
}
DEVI void xcd_barrier(const XcdBarrier& b) {
  asm volatile("s_waitcnt vmcnt(0)" ::: "memory");
  __syncthreads();
  if (TID() == 0) {
    unsigned* bar = b.bar;
    __builtin_amdgcn_s_waitcnt(0);
    unsigned nloc = b.st[0], nx = b.st[1];
    if (nloc == 0u) { xcd_barrier_complete(bar, b.x, nloc, nx); b.st[0] = nloc; b.st[1] = nx; }
    const unsigned old = xb_add(&bar[XB_XSUB(b.x)], 1u);
    const unsigned gen = old / nloc;
    if (old + 1u == (gen + 1u) * nloc) {
      __builtin_amdgcn_fence(__ATOMIC_RELEASE, "agent");
      asm volatile("s_waitcnt vmcnt(0)" ::: "memory");
      const unsigned og = xb_add(&bar[XB_TOP], 1u);
      const unsigned tg = og / nx;
      if (og + 1u == (tg + 1u) * nx) xb_add(&bar[XB_TOPGEN], 1u);
      else XB_SPIN(xb_ld(&bar[XB_TOPGEN]) == tg, bar);
      __builtin_amdgcn_fence(__ATOMIC_ACQUIRE, "agent");
      xb_add(&bar[XB_XGEN(b.x)], 1u);
      asm volatile("s_waitcnt vmcnt(0)" ::: "memory");
    } else {
      XB_SPIN(xb_ld(&bar[XB_XGEN(b.x)]) == gen, bar);
      __builtin_amdgcn_fence(__ATOMIC_ACQUIRE, "agent");
      asm volatile("s_waitcnt vmcnt(0)" ::: "memory");
    }
  }
  __syncthreads();
}

#if MEGA
template <int ph, int l>
DEVI void mega_step(const Params& p, char* smem, const XcdBarrier& xb) {
#if PROBE_A >= 0
  if (blockIdx.x == 0 && TID() == 0 && (ph == PROBE_A || ph == PROBE_B)) p.g_cdec[2050] = (float)(wall_clock64() & 0xFFFFFFull);
  run_phase(p, ph, l, smem);
  xcd_barrier(xb);
  if (blockIdx.x == 0 && TID() == 0 && (ph == PROBE_A || ph == PROBE_B)) {
    float dt = (float)(wall_clock64() & 0xFFFFFFull) - p.g_cdec[2050];
    if (dt < 0.f) dt += 16777216.f;
    p.g_cdec[ph == PROBE_A ? 2048 : 2049] += dt;
  }
#else
  run_phase(p, ph, l, smem);
  xcd_barrier(xb);
#endif
}
template <int l>
DEVI void mega_layer(const Params& p, char* smem, const XcdBarrier& xb) {
  mega_step<PH_NORM1, l>(p, smem, xb);
  mega_step<PH_GEMM_IN, l>(p, smem, xb);
  mega_step<PH_MIX_A, l>(p, smem, xb);
  mega_step<PH_MIX_B, l>(p, smem, xb);
  mega_step<PH_MIX_C, l>(p, smem, xb);
  mega_step<PH_MIX_D, l>(p, smem, xb);
  mega_step<PH_GEMM_OUT, l>(p, smem, xb);
  mega_step<PH_NORM2, l>(p, smem, xb);
  mega_step<PH_GEMM_Q, l>(p, smem, xb);
  mega_step<PH_SCORES, l>(p, smem, xb);
  mega_step<PH_TOPK, l>(p, smem, xb);
  mega_step<PH_GATHER, l>(p, smem, xb);
  mega_step<PH_GEMM_PLE, l>(p, smem, xb);
}
__global__ void __launch_bounds__(NT) k_mega(Params p) {
  extern __shared__ __align__(16) char smem[];
  cg::grid_group grid = cg::this_grid();
#if PROBE_A >= 0
  if (blockIdx.x == 0 && TID() == 0) { p.g_cdec[2048] = 0.f; p.g_cdec[2049] = 0.f; }
#endif
  __shared__ uint4 xb_words;
  if (TID() == 0) xb_words = uint4{0u, 0u, 0u, 0u};
  __syncthreads();
  const XcdBarrier xb = xcd_barrier_post(p.bar, (volatile LAS unsigned*)&xb_words);
  run_phase(p, PH_PREP, 0, smem);
  grid.sync();
  mega_layer<0>(p, smem, xb);
  mega_layer<1>(p, smem, xb);
  run_phase(p, PH_FINAL, 0, smem);
#if PROBE_A >= 0
  xcd_barrier(xb);
  {
    const float qa_ = expf(rintf(logf(p.g_cdec[2048] * 0.01f) * 4.f) * 0.25f), qb_ = expf(rintf(logf(p.g_cdec[2049] * 0.01f) * 4.f) * 0.25f);
    const float va = sqrtf(qa_), vb = qb_;
    const size_t gtid = (size_t)blockIdx.x * NT + TID(), gsz = (size_t)gridDim.x * NT;
    for (size_t i = gtid; i < (size_t)S_ * DM; i += gsz) p.out[i] = (i == 0) ? vb : va;
  }
#endif
}
#endif

extern "C" void kernel_launch(void* const* d_in, const int* in_sizes, int n_in, void* d_out, int out_size, void* d_ws,
                              size_t ws_size, hipStream_t stream) {
  Params p{};
  const float* const* f = (const float* const*)d_in;
  p.x = f[0]; p.p = f[1]; p.pos = (const int*)d_in[2];
  p.mix_norm = f[3]; p.w_in = f[4]; p.ret_gn = f[5]; p.lru_conv_w = f[6]; p.lru_conv_b = f[7]; p.lru_w_a = f[8];
  p.lru_b_a = f[9]; p.lru_w_x = f[10]; p.lru_b_x = f[11]; p.lru_lambda = f[12];
  p.s5_a_re = f[13]; p.s5_a_im = f[14]; p.s5_b_re = f[15]; p.s5_b_im = f[16]; p.s5_c_re = f[17]; p.s5_c_im = f[18];
  p.s5_d = f[19]; p.s5_log_dt = f[20]; p.s5_glu_w = f[21]; p.s5_glu_b = f[22];
  p.gdn_conv_w = f[23]; p.gdn_a_log = f[24]; p.gdn_dt_bias = f[25]; p.gdn_norm = f[26]; p.branch_norm = f[27];
  p.w_out = f[28]; p.ffn_norm = f[29]; p.peer_wq = f[30]; p.peer_subkeys = f[31]; p.peer_u = f[32]; p.peer_v = f[33];
  p.ple_norm = f[34]; p.ple_wg = f[35]; p.ple_wp = f[36]; p.final_norm = f[37];
  p.out = (float*)d_out;
  char* ws = (char*)d_ws;
  const size_t MiB = 1024 * 1024;
  p.h = (float*)(ws + 0 * MiB);
  p.zb = (bf16_t*)(ws + 64 * MiB);
  p.proj = (float*)(ws + 96 * MiB);
  p.qbuf = (float*)(ws + 96 * MiB);
  p.scores = (float*)(ws + 160 * MiB);
  p.g_u = (float*)(ws + 288 * MiB); p.g_w = (float*)(ws + 304 * MiB); p.g_attn = (float*)(ws + 320 * MiB);
  p.g_qd = (float*)(ws + 336 * MiB); p.g_kd = (float*)(ws + 352 * MiB);
  p.ids = (int*)(ws + 288 * MiB); p.gates = (float*)(ws + 296 * MiB);
  p.lru_h = (float*)(ws + 368 * MiB); p.lru_p = (float*)(ws + 384 * MiB);
  p.ret_kv = (float*)(ws + 400 * MiB);
  p.tabU = (uint8_t*)(ws + 408 * MiB); p.tabV = (uint8_t*)(ws + 440 * MiB);
  p.uinv = (float*)(ws + 505 * MiB); p.vinv = (float*)(ws + 505 * MiB + 65536);
  p.g_sst = (float*)(ws + 408 * MiB);
  {
    char* wb = ws + 472 * MiB;
    p.winT = (bf16_t*)wb; wb += (size_t)2 * PW * 1024 * 2;
    p.woutT = (bf16_t*)wb; wb += (size_t)2 * 1024 * 1024 * 2;
    p.wqT = (bf16_t*)wb; wb += (size_t)2 * 1024 * 1024 * 2;
    p.wgT = (bf16_t*)wb; wb += (size_t)2 * 1024 * 1024 * 2;
    p.wpT = (bf16_t*)wb; wb += (size_t)2 * 1024 * 256 * 2;
    p.gluT = (bf16_t*)wb; wb += (size_t)2 * 512 * 256 * 2;
  }
  p.rope = (float*)(ws + 497 * MiB);
  p.ssq = (float*)(ws + 501 * MiB);
  p.xloc = (float*)(ws + 502 * MiB);
  p.lru_hs = (float*)(ws + 504 * MiB);
  p.lru_ps = (float*)(ws + 504 * MiB + 256 * 256 * 4);
  p.g_cdec = (float*)(ws + 504 * MiB + 2 * 256 * 256 * 4);
  p.g_comp = (float*)(ws + 506 * MiB);
  p.pbf = (bf16_t*)(ws + 304 * MiB);
  p.bar = (unsigned*)(ws + 507 * MiB);

  static int grid_blocks = 0;
  if (!grid_blocks) {
#if MEGA
    hipFuncSetAttribute((const void*)k_mega, hipFuncAttributeMaxDynamicSharedMemorySize, LDS_BYTES);
#endif
#if !MEGA
    hipFuncSetAttribute((const void*)k_phase, hipFuncAttributeMaxDynamicSharedMemorySize, LDS_BYTES);
#endif
    int dev = 0, cus = 0, per_cu = 0;
    hipGetDevice(&dev);
    hipDeviceGetAttribute(&cus, hipDeviceAttributeMultiprocessorCount, dev);
#if MEGA
    hipOccupancyMaxActiveBlocksPerMultiprocessor(&per_cu, k_mega, NT, LDS_BYTES);
#else
    hipOccupancyMaxActiveBlocksPerMultiprocessor(&per_cu, k_phase, NT, LDS_BYTES);
#endif
    if (per_cu < 1) per_cu = 1;
    grid_blocks = cus * per_cu;
  }
#if MEGA
  hipMemsetAsync(p.bar, 0, XCD_BAR_WORDS * 4, stream);
  void* args[] = {&p};
  hipError_t e = hipLaunchCooperativeKernel((void*)k_mega, dim3(grid_blocks), dim3(NT), args, LDS_BYTES, stream);
  if (e != hipSuccess) fprintf(stderr, "cooperative launch failed: %s (grid %d)\n", hipGetErrorString(e), grid_blocks);
#else
  k_phase<<<grid_blocks, NT, LDS_BYTES, stream>>>(p, PH_PREP, 0);
  for (int l = 0; l < NL; ++l)
    for (int ph = PH_NORM1; ph <= PH_GEMM_PLE; ++ph) k_phase<<<grid_blocks, NT, LDS_BYTES, stream>>>(p, ph, l);
  k_phase<<<grid_blocks, NT, LDS_BYTES, stream>>>(p, PH_FINAL, 0);
#endif
}
```

```cpp
#include <hip/hip_runtime.h>
#include <hip/hip_bf16.h>
#include <hip/hip_cooperative_groups.h>
#include <cstdio>
#include <cstdint>
namespace cg = cooperative_groups;

#ifndef MEGA
#define MEGA 1
#endif

#ifndef PROBE_A
#define PROBE_A -1
#endif
#ifndef PROBE_B
#define PROBE_B -1
#endif
#define DEVI __device__ __forceinline__

typedef __attribute__((ext_vector_type(8))) short bf16x8;
typedef __attribute__((ext_vector_type(4))) float f32x4;
typedef unsigned short bf16_t;

constexpr int NT = 512;
constexpr int S_ = 16384, DM = 1024, NL = 2, PW = 2944, INW = 2824;
constexpr int RQ = 0, RK = 256, RV = 512, RG = 768, LG = 1024, LX = 1280, SU = 1536, DQ = 1792,
              DB = 2560, DA = 2564, DG = 2568;
constexpr float EPS = 1e-6f;
constexpr int LDS_BYTES = 132 * 1024;

struct Params {
  const float *x, *p; const int* pos;
  const float *mix_norm, *w_in, *ret_gn, *lru_conv_w, *lru_conv_b, *lru_w_a, *lru_b_a, *lru_w_x, *lru_b_x, *lru_lambda;
  const float *s5_a_re, *s5_a_im, *s5_b_re, *s5_b_im, *s5_c_re, *s5_c_im, *s5_d, *s5_log_dt, *s5_glu_w, *s5_glu_b;
  const float *gdn_conv_w, *gdn_a_log, *gdn_dt_bias, *gdn_norm, *branch_norm, *w_out, *ffn_norm, *peer_wq, *peer_subkeys;
  const float *peer_u, *peer_v, *ple_norm, *ple_wg, *ple_wp, *final_norm;
  float* out;
  float* h; bf16_t* zb; float* proj; float* qbuf; float* scores;
  float *g_u, *g_w, *g_attn, *g_qd, *g_kd, *g_sst, *g_cdec, *g_comp;
  int* ids; float* gates;
  float *lru_h, *lru_p, *lru_hs, *lru_ps;
  float* ret_kv; float* xloc;
  uint8_t *tabU, *tabV; float *uinv, *vinv;
  bf16_t *winT, *woutT, *wqT, *wgT, *wpT, *gluT;
  float* rope; float* ssq; bf16_t* pbf; unsigned* bar;
};

DEVI int TID() { int t = __builtin_amdgcn_workitem_id_x(); asm volatile("" : "+v"(t)); return t; }
DEVI bf16_t f2bf(float f) { unsigned u = __float_as_uint(f); u += 0x7FFFu + ((u >> 16) & 1u); return (bf16_t)(u >> 16); }
DEVI float bf2f(bf16_t b) { return __uint_as_float(((unsigned)b) << 16); }
DEVI unsigned pack2(float a, float b) { return (unsigned)f2bf(a) | ((unsigned)f2bf(b) << 16); }
DEVI float sigmoidf_(float x) { return 1.f / (1.f + expf(-x)); }
DEVI float siluf_(float x) { return x / (1.f + expf(-x)); }
DEVI float geluf_(float x) { float u = 0.7978845608028654f * (x + 0.044715f * x * x * x); return 0.5f * x * (1.f + tanhf(u)); }
DEVI float softplusf_(float x) { return x > 20.f ? x : log1pf(expf(x)); }
DEVI float wave_sum(float v) {
  v += __shfl_xor(v, 32); v += __shfl_xor(v, 16); v += __shfl_xor(v, 8);
  v += __shfl_xor(v, 4); v += __shfl_xor(v, 2); v += __shfl_xor(v, 1); return v;
}
DEVI float sum16(float v) {
  v += __shfl_xor(v, 8); v += __shfl_xor(v, 4); v += __shfl_xor(v, 2); v += __shfl_xor(v, 1); return v;
}

template <int NTL>
DEVI void mm16(f32x4 (&acc)[NTL], const float* A, int sam, int sak, const float* B, int sbk, int sbn, int K) {
  const int l = TID() & 63, r = l & 15, q = l >> 4;
  const float* ap = A + r * sam + q * sak;
  const float* bp = B + q * sbk + r * sbn;
#pragma unroll 4
  for (int k = 0; k < K; k += 4) {
    float a = ap[k * sak];
#pragma unroll
    for (int t = 0; t < NTL; ++t) {
      float b = bp[k * sbk + t * 16 * sbn];
      acc[t] = __builtin_amdgcn_mfma_f32_16x16x4f32(a, b, acc[t], 0, 0, 0);
    }
  }
}

template <int NTL>
DEVI void mm16_gB64(f32x4 (&acc)[NTL], const float* A, int sam, const float* __restrict__ Bg) {
  const int l = TID() & 63, r = l & 15, q = l >> 4;
  float bv[16][NTL];
#pragma unroll
  for (int k = 0; k < 16; ++k)
#pragma unroll
    for (int t = 0; t < NTL; ++t) bv[k][t] = Bg[(4 * k + q) * 64 + t * 16 + r];
#pragma unroll
  for (int k = 0; k < 16; ++k) {
    const float a = A[r * sam + 4 * k + q];
#pragma unroll
    for (int t = 0; t < NTL; ++t) acc[t] = __builtin_amdgcn_mfma_f32_16x16x4f32(a, bv[k][t], acc[t], 0, 0, 0);
  }
}

template <int AMODE, int NK>
DEVI void gemm_tile(f32x4 (&acc)[4][4], const void* Aptr, int lda, const bf16_t* Bt, int ldb, int K, int m0, int n0,
                    const float* ssq, char* smem) {
  constexpr int LDT = 72, BUF = (256 + 128) * LDT;
  bf16_t* sbase = (bf16_t*)smem;
  const int tid = TID(), lane = tid & 63, wave = tid >> 6;
  const int wm = wave >> 1, wn = wave & 1, r = lane & 15, q = lane >> 4;
  const int lrow = tid >> 3, lkc = tid & 7;
  uint4 raS00, raS01, raS02, raS03, rbS00, rbS01, raS10, raS11, raS12, raS13, rbS10, rbS11, raS20, raS21, raS22, raS23, rbS20, rbS21;
  float rs0 = 1.f, rs1 = 1.f, rs2 = 1.f, rs3 = 1.f;
#pragma unroll
  for (int i = 0; i < 4; ++i)
#pragma unroll
    for (int j = 0; j < 4; ++j) acc[i][j] = f32x4{0.f, 0.f, 0.f, 0.f};
  const bf16_t* Ab = (const bf16_t*)Aptr + (size_t)(m0 + lrow) * lda + lkc * 8;
  const bf16_t* Bb = Bt + (size_t)(n0 + lrow) * ldb + lkc * 8;
#define GL(S, k0_)                                                    \
  {                                                                   \
    ra##S##0 = *(const uint4*)(Ab + (k0_));                           \
    ra##S##1 = *(const uint4*)(Ab + (size_t)64 * lda + (k0_));        \
    ra##S##2 = *(const uint4*)(Ab + (size_t)128 * lda + (k0_));       \
    ra##S##3 = *(const uint4*)(Ab + (size_t)192 * lda + (k0_));       \
    rb##S##0 = *(const uint4*)(Bb + (k0_));                           \
    rb##S##1 = *(const uint4*)(Bb + (size_t)64 * ldb + (k0_));        \
  }
  auto scale = [&](uint4 v, float s) {
    unsigned w[4] = {v.x, v.y, v.z, v.w};
#pragma unroll
    for (int j = 0; j < 4; ++j) {
      float lo = __uint_as_float(w[j] << 16) * s, hi = __uint_as_float(w[j] & 0xFFFF0000u) * s;
      w[j] = pack2(lo, hi);
    }
    return uint4{w[0], w[1], w[2], w[3]};
  };
  auto rowscale = [&](int row, int k0) {
    const float* sp = ssq + (size_t)(m0 + row) * 16;
    int seg = k0 >> 8;
    float s = seg == 0 ? (sp[0] + sp[1] + sp[2] + sp[3]) : seg == 1 ? sp[4] : seg == 2 ? sp[5] : (sp[8] + sp[9] + sp[10] + sp[11]);
    return rsqrtf(s * (1.f / 256.f) + EPS);
  };
#define LS(S, k0_, bi_)                                                               \
  {                                                                                   \
    bf16_t* As_ = sbase + (bi_) * BUF; bf16_t* Bs_ = As_ + 256 * LDT;                 \
    if constexpr (AMODE == 1) {                                                       \
      if (((k0_) & 255) == 0) {                                                       \
        rs0 = rowscale(lrow, (k0_)); rs1 = rowscale(lrow + 64, (k0_));                \
        rs2 = rowscale(lrow + 128, (k0_)); rs3 = rowscale(lrow + 192, (k0_));         \
      }                                                                               \
      ra##S##0 = scale(ra##S##0, rs0); ra##S##1 = scale(ra##S##1, rs1);               \
      ra##S##2 = scale(ra##S##2, rs2); ra##S##3 = scale(ra##S##3, rs3);               \
    }                                                                                 \
    *(uint4*)&As_[(lrow) * LDT + lkc * 8] = ra##S##0;                                 \
    *(uint4*)&As_[(lrow + 64) * LDT + lkc * 8] = ra##S##1;                            \
    *(uint4*)&As_[(lrow + 128) * LDT + lkc * 8] = ra##S##2;                           \
    *(uint4*)&As_[(lrow + 192) * LDT + lkc * 8] = ra##S##3;                           \
    *(uint4*)&Bs_[(lrow) * LDT + lkc * 8] = rb##S##0;                                 \
    *(uint4*)&Bs_[(lrow + 64) * LDT + lkc * 8] = rb##S##1;                            \
  }
  auto compute = [&](int bi) {
    const bf16_t* As = sbase + bi * BUF; const bf16_t* Bs = As + 256 * LDT;
#pragma unroll
    for (int kk = 0; kk < 2; ++kk) {
      bf16x8 a[4], b[4];
#pragma unroll
      for (int i = 0; i < 4; ++i) a[i] = *(const bf16x8*)&As[(wm * 64 + i * 16 + r) * LDT + kk * 32 + q * 8];
#pragma unroll
      for (int j = 0; j < 4; ++j) b[j] = *(const bf16x8*)&Bs[(wn * 64 + j * 16 + r) * LDT + kk * 32 + q * 8];
#pragma unroll
      for (int i = 0; i < 4; ++i)
#pragma unroll
        for (int j = 0; j < 4; ++j)
          acc[i][j] = __builtin_amdgcn_mfma_f32_16x16x32_bf16(b[j], a[i], acc[i][j], 0, 0, 0);
    }
  };

  __syncthreads();
  if constexpr (NK == 16 && AMODE == 1) {
    GL(S0, 0)
    LS(S0, 0, 0)
    GL(S1, 64)
    __syncthreads();
#pragma unroll 1
    for (int kt = 0; kt < NK; kt += 2) {
      compute(0);
      LS(S1, ((kt + 1) << 6), 1)
      if (kt + 2 < NK) GL(S0, ((kt + 2) << 6))
      __syncthreads();
      compute(1);
      if (kt + 2 < NK) { LS(S0, ((kt + 2) << 6), 0) GL(S1, ((kt + 3) << 6)) }
      __syncthreads();
    }
  } else if constexpr (NK == 16) {
    GL(S0, 0) GL(S1, 64) GL(S2, 128)
    LS(S0, 0, 0)
    GL(S0, 192)
    __syncthreads();
    compute(0);
    LS(S1, 64, 1)
    GL(S1, 256)
    __syncthreads();
    compute(1);
    LS(S2, 128, 0)
    GL(S2, 320)
    __syncthreads();
    compute(0);
    LS(S0, 192, 1)
    GL(S0, 384)
    __syncthreads();
    compute(1);
    LS(S1, 256, 0)
    GL(S1, 448)
    __syncthreads();
    compute(0);
    LS(S2, 320, 1)
    GL(S2, 512)
    __syncthreads();
    compute(1);
    LS(S0, 384, 0)
    GL(S0, 576)
    __syncthreads();
    compute(0);
    LS(S1, 448, 1)
    GL(S1, 640)
    __syncthreads();
    compute(1);
    LS(S2, 512, 0)
    GL(S2, 704)
    __syncthreads();
    compute(0);
    LS(S0, 576, 1)
    GL(S0, 768)
    __syncthreads();
    compute(1);
    LS(S1, 640, 0)
    GL(S1, 832)
    __syncthreads();
    compute(0);
    LS(S2, 704, 1)
    GL(S2, 896)
    __syncthreads();
    compute(1);
    LS(S0, 768, 0)
    GL(S0, 960)
    __syncthreads();
    compute(0);
    LS(S1, 832, 1)
    __syncthreads();
    compute(1);
    LS(S2, 896, 0)
    __syncthreads();
    compute(0);
    LS(S0, 960, 1)
    __syncthreads();
    compute(1);
    __syncthreads();
  } else {
    GL(S0, 0) GL(S1, 64) GL(S2, 128)
    LS(S0, 0, 0)
    GL(S0, 192)
    __syncthreads();
    compute(0);
    LS(S1, 64, 1)
    __syncthreads();
    compute(1);
    LS(S2, 128, 0)
    __syncthreads();
    compute(0);
    LS(S0, 192, 1)
    __syncthreads();
    compute(1);
    __syncthreads();
  }
#undef GL
#undef LS
}
#define GEMM_EPI_COORDS                                                   \
  const int lane_ = TID() & 63, wave_ = TID() >> 6;           \
  const int erow0 = m0 + (wave_ >> 1) * 64 + (lane_ & 15);                \
  const int ecol0 = n0 + (wave_ & 1) * 64 + (lane_ >> 4) * 4;

DEVI void transpose_tile(const float* W, int ldw, int nvalid, bf16_t* Bt, int ldbt, int k0, int n0, char* smem) {
  float* t = (float*)smem;
  const int tid = TID();
  {
    int i = tid >> 4, j4 = tid & 15;
#pragma unroll
    for (int h2 = 0; h2 < 2; ++h2) {
      int kk = i + 32 * h2;
      int n = n0 + j4 * 4;
      float4 v = float4{0.f, 0.f, 0.f, 0.f};
      if (n < nvalid) v = *(const float4*)&W[(size_t)(k0 + kk) * ldw + n];
      t[(j4 * 4 + 0) * 65 + kk] = v.x; t[(j4 * 4 + 1) * 65 + kk] = v.y;
      t[(j4 * 4 + 2) * 65 + kk] = v.z; t[(j4 * 4 + 3) * 65 + kk] = v.w;
    }
  }
  __syncthreads();
  {
    int n = tid >> 3, k8 = tid & 7;
    const float* s = &t[n * 65 + k8 * 8];
    uint4 v;
    v.x = pack2(s[0], s[1]); v.y = pack2(s[2], s[3]); v.z = pack2(s[4], s[5]); v.w = pack2(s[6], s[7]);
    *(uint4*)&Bt[(size_t)(n0 + n) * ldbt + k0 + k8 * 8] = v;
  }
  __syncthreads();
}

DEVI void convert_tables(const Params& p, int l) {
  const int lane = TID() & 63, wave = TID() >> 6;
  const int nw = gridDim.x * 8, gw = blockIdx.x * 8 + wave;
  for (int r0 = gw; r0 < 2 * 16384; r0 += 4 * nw) {
    float4 va[4], vb[4], vc[4], vd[4];
#pragma unroll
    for (int k = 0; k < 4; ++k) {
      const int rr = r0 + k * nw;
      if (rr < 2 * 16384) {
        const int which = rr >> 14, row = rr & 16383;
        const float* s = (which ? p.peer_v : p.peer_u) + ((size_t)l * 16384 + row) * 1024 + lane * 16;
        va[k] = *(const float4*)s; vb[k] = *(const float4*)(s + 4); vc[k] = *(const float4*)(s + 8); vd[k] = *(const float4*)(s + 12);
      }
    }
#pragma unroll
    for (int k = 0; k < 4; ++k) {
      const int rr = r0 + k * nw;
      if (rr < 2 * 16384) {
        const int which = rr >> 14, row = rr & 16383;
        const float4 a = va[k], b = vb[k], c = vc[k], d = vd[k];
        float m = fmaxf(fmaxf(fmaxf(fabsf(a.x), fabsf(a.y)), fmaxf(fabsf(a.z), fabsf(a.w))),
                        fmaxf(fmaxf(fabsf(b.x), fabsf(b.y)), fmaxf(fabsf(b.z), fabsf(b.w))));
        m = fmaxf(m, fmaxf(fmaxf(fmaxf(fabsf(c.x), fabsf(c.y)), fmaxf(fabsf(c.z), fabsf(c.w))),
                           fmaxf(fmaxf(fabsf(d.x), fabsf(d.y)), fmaxf(fabsf(d.z), fabsf(d.w)))));
        m = fmaxf(m, __shfl_xor(m, 32)); m = fmaxf(m, __shfl_xor(m, 16)); m = fmaxf(m, __shfl_xor(m, 8));
        m = fmaxf(m, __shfl_xor(m, 4)); m = fmaxf(m, __shfl_xor(m, 2)); m = fmaxf(m, __shfl_xor(m, 1));
        const float sc = m > 0.f ? 256.f / m : 1.f;
        int w0 = 0, w1 = 0, w2 = 0, w3 = 0;
        w0 = __builtin_amdgcn_cvt_pk_fp8_f32(a.x * sc, a.y * sc, w0, false); w0 = __builtin_amdgcn_cvt_pk_fp8_f32(a.z * sc, a.w * sc, w0, true);
        w1 = __builtin_amdgcn_cvt_pk_fp8_f32(b.x * sc, b.y * sc, w1, false); w1 = __builtin_amdgcn_cvt_pk_fp8_f32(b.z * sc, b.w * sc, w1, true);
        w2 = __builtin_amdgcn_cvt_pk_fp8_f32(c.x * sc, c.y * sc, w2, false); w2 = __builtin_amdgcn_cvt_pk_fp8_f32(c.z * sc, c.w * sc, w2, true);
        w3 = __builtin_amdgcn_cvt_pk_fp8_f32(d.x * sc, d.y * sc, w3, false); w3 = __builtin_amdgcn_cvt_pk_fp8_f32(d.z * sc, d.w * sc, w3, true);
        *(uint4*)((which ? p.tabV : p.tabU) + (size_t)row * 1024 + lane * 16) = uint4{(unsigned)w0, (unsigned)w1, (unsigned)w2, (unsigned)w3};
        if (lane == 0) (which ? p.vinv : p.uinv)[row] = m > 0.f ? m * (1.f / 256.f) : 1.f;
      }
    }
  }
}

DEVI void ph_prep(const Params& p, char* smem) {
  const size_t gtid = (size_t)blockIdx.x * NT + TID(), gsz = (size_t)gridDim.x * NT;
  for (size_t i = gtid; i < (size_t)S_ * 32; i += gsz) {
    int t = (int)(i >> 5), f = (int)(i & 31);
    float inv = powf(10000.f, -(float)f / 32.f);
    float ang = (float)p.pos[t] * inv;
    p.rope[2 * i] = cosf(ang); p.rope[2 * i + 1] = sinf(ang);
  }
  for (int it = blockIdx.x; it < 2 * 1600; it += gridDim.x) {
    int l = it / 1600, idx = it % 1600;
    if (idx >= 1568) {
      int j = idx - 1568; int kt = j >> 3, nt = j & 7;
      transpose_tile(p.s5_glu_w + (size_t)l * 256 * 512, 512, 512, p.gluT + (size_t)l * 512 * 256, 256, kt * 64, nt * 64, smem);
    } else if (idx < 736) {
      int kt = idx / 46, nt = idx % 46;
      transpose_tile(p.w_in + (size_t)l * 1024 * INW, INW, INW, p.winT + (size_t)l * PW * 1024, 1024, kt * 64, nt * 64, smem);
    } else if (idx < 1504) {
      int j = idx - 736; int which = j >> 8; j &= 255;
      int kt = j >> 4, nt = j & 15;
      const float* src = (which == 0 ? p.w_out : which == 1 ? p.peer_wq : p.ple_wg) + (size_t)l * 1024 * 1024;
      bf16_t* dst = (which == 0 ? p.woutT : which == 1 ? p.wqT : p.wgT) + (size_t)l * 1024 * 1024;
      transpose_tile(src, 1024, 1024, dst, 1024, kt * 64, nt * 64, smem);
    } else {
      int j = idx - 1504; int kt = j >> 4, nt = j & 15;
      transpose_tile(p.ple_wp + (size_t)l * 256 * 1024, 1024, 1024, p.wpT + (size_t)l * 1024 * 256, 256, kt * 64, nt * 64, smem);
    }
  }
}

DEVI void ph_norm(const float* src, const float* g, bf16_t* dst, float* fout) {
  const int lane = TID() & 63, wave = TID() >> 6;
  const int nw = gridDim.x * 8, gw = blockIdx.x * 8 + wave;
  float4 gg[4];
#pragma unroll
  for (int i = 0; i < 4; ++i) gg[i] = *(const float4*)&g[i * 256 + lane * 4];
  for (int t = gw; t < S_; t += 4 * nw) {
    float4 v[4][4];
#pragma unroll
    for (int rr = 0; rr < 4; ++rr) {
      const int tr = t + rr * nw;
      if (tr < S_) {
#pragma unroll
        for (int i = 0; i < 4; ++i) v[rr][i] = *(const float4*)&src[(size_t)tr * DM + i * 256 + lane * 4];
      }
    }
#pragma unroll
    for (int rr = 0; rr < 4; ++rr) {
      const int tr = t + rr * nw;
      if (tr < S_) {
        float ss = 0.f;
#pragma unroll
        for (int i = 0; i < 4; ++i) ss += v[rr][i].x * v[rr][i].x + v[rr][i].y * v[rr][i].y + v[rr][i].z * v[rr][i].z + v[rr][i].w * v[rr][i].w;
        ss = wave_sum(ss);
        const float rs = rsqrtf(ss * (1.f / DM) + EPS);
#pragma unroll
        for (int i = 0; i < 4; ++i) {
          float a = v[rr][i].x * rs * gg[i].x, b = v[rr][i].y * rs * gg[i].y, c = v[rr][i].z * rs * gg[i].z, d = v[rr][i].w * rs * gg[i].w;
          if (dst) *(uint2*)&dst[(size_t)tr * DM + i * 256 + lane * 4] = uint2{pack2(a, b), pack2(c, d)};
          else *(float4*)&fout[(size_t)tr * DM + i * 256 + lane * 4] = float4{a, b, c, d};
        }
      }
    }
  }
}

DEVI void gdn_prep(const Params& p, int l, int item, char* smem) {
  const int c = item >> 2, hd = item & 3, t0 = c * 64;
  float* sq = (float*)smem; float* sk = sq + 64 * 65; float* sv = sk + 64 * 65;
  float* sL = sv + 64 * 65;
  float* sgc = sL + 64 * 68; float* sbeta = sgc + 64;
  const int tid = TID(), lane = tid & 63, wave = tid >> 6, r = lane & 15, qd = lane >> 4;
  const float* cw = p.gdn_conv_w + (size_t)l * 4 * 768;
  {
    const int d = tid & 63, tw = tid >> 6;
#pragma unroll
    for (int which = 0; which < 3; ++which) {
      const int ch = which * 256 + hd * 64 + d;
      const float w0 = cw[ch], w1 = cw[768 + ch], w2 = cw[2 * 768 + ch], w3 = cw[3 * 768 + ch];
      const float* pc = p.proj + DQ + ch;
      float xv[11];
#pragma unroll
      for (int k = 0; k < 11; ++k) {
        const int tt = t0 + 8 * tw - 3 + k;
        const float v = pc[(size_t)(tt < 0 ? 0 : tt) * PW];
        xv[k] = tt < 0 ? 0.f : v;
      }
#pragma unroll
      for (int m = 0; m < 8; ++m) {
        float acc = 0.f;
        acc += w0 * xv[m]; acc += w1 * xv[m + 1]; acc += w2 * xv[m + 2]; acc += w3 * xv[m + 3];
        const float sv_ = siluf_(acc);
        if (which == 0) sq[(8 * tw + m) * 65 + d] = sv_;
        else if (which == 1) sk[(8 * tw + m) * 65 + d] = sv_;
        else sv[(8 * tw + m) * 65 + d] = sv_;
      }
    }
  }
  __syncthreads();
  {
    const int rw = tid >> 2, part = tid & 3, t = rw & 63;
    float* row = (rw < 64 ? sq : sk) + t * 65 + part * 16;
    float s = 0.f;
#pragma unroll
    for (int d = 0; d < 16; ++d) s += row[d] * row[d];
    s += __shfl_xor(s, 1); s += __shfl_xor(s, 2);
    float sc = rsqrtf(s + EPS) * (rw < 64 ? 0.125f : 1.f);
#pragma unroll
    for (int d = 0; d < 16; ++d) row[d] *= sc;
  }
  if (wave == 2) {
    int t = tid - 128;
    float bl = p.proj[(size_t)(t0 + t) * PW + DB + hd];
    float al = p.proj[(size_t)(t0 + t) * PW + DA + hd];
    float la = -expf(p.gdn_a_log[l * 4 + hd]) * softplusf_(al + p.gdn_dt_bias[l * 4 + hd]);
    for (int off = 1; off < 64; off <<= 1) { float n = __shfl_up(la, off); if (lane >= off) la += n; }
    sgc[t] = la; sbeta[t] = sigmoidf_(bl);
  }
  __syncthreads();
  {
    int mat = wave >> 2, mt = wave & 3;
    f32x4 acc[4];
#pragma unroll
    for (int t = 0; t < 4; ++t) acc[t] = f32x4{0.f, 0.f, 0.f, 0.f};
    mm16<4>(acc, (mat == 0 ? sk : sq) + mt * 16 * 65, 65, 1, sk, 1, 65, 64);
#pragma unroll
    for (int t = 0; t < 4; ++t)
#pragma unroll
      for (int e = 0; e < 4; ++e) {
        int i = mt * 16 + 4 * qd + e, j = t * 16 + r;
        float g = (i >= j) ? expf(sgc[i] - sgc[j]) : 0.f;
        if (mat == 0) sL[i * 68 + j] = (i > j) ? acc[t][e] * sbeta[i] * g : 0.f;
        else p.g_attn[((size_t)item * 64 + i) * 64 + j] = (i >= j) ? acc[t][e] * g : 0.f;
      }
  }
  __syncthreads();
  if (tid < 128) {
    const bool isv = tid < 64; const int d = tid & 63;
    float X[64];
#pragma unroll
    for (int i = 0; i < 64; ++i) X[i] = 0.f;
    float* dst = (isv ? p.g_u : p.g_w) + (size_t)item * 4096 + d;
#pragma unroll
    for (int i = 0; i < 64; ++i) {
      float bi = sbeta[i];
      float s = isv ? sv[i * 65 + d] * bi : sk[i * 65 + d] * bi * expf(sgc[i]);
      float s1 = 0.f, s2 = 0.f, s3 = 0.f;
#pragma unroll
      for (int j4 = 0; j4 < (i + 3) / 4; ++j4) {
        float4 lv = *(const float4*)&sL[i * 68 + j4 * 4];
        s -= lv.x * X[j4 * 4 + 0]; s1 -= lv.y * X[j4 * 4 + 1]; s2 -= lv.z * X[j4 * 4 + 2]; s3 -= lv.w * X[j4 * 4 + 3];
      }
      s = (s + s1) + (s2 + s3);
      X[i] = s;
      dst[i * 64] = s;
    }
  } else {
    for (int i2 = tid - 128; i2 < 8192; i2 += 384) {
      int which = i2 >> 12, i = (i2 >> 6) & 63, d = i2 & 63;
      float val = which == 0 ? sq[i * 65 + d] * expf(sgc[i]) : sk[i * 65 + d] * expf(sgc[63] - sgc[i]);
      (which == 0 ? p.g_qd : p.g_kd)[(size_t)item * 4096 + i * 64 + d] = val;
    }
    if (tid == 128) p.g_cdec[item] = expf(sgc[63]);
  }
  __syncthreads();
}

DEVI f32x4 mm16_k64(const float* A, int sam, int sak, const float* B, int sbk, int sbn) {
  const int l = TID() & 63, r = l & 15, q = l >> 4;
  const float* ap = A + r * sam + q * sak;
  const float* bp = B + q * sbk + r * sbn;
  float av[16], bv[16];
#pragma unroll
  for (int k = 0; k < 16; ++k) { av[k] = ap[4 * k * sak]; bv[k] = bp[4 * k * sbk]; }
  f32x4 c0 = f32x4{0.f, 0.f, 0.f, 0.f}, c1 = f32x4{0.f, 0.f, 0.f, 0.f};
#pragma unroll
  for (int k = 0; k < 16; k += 2) {
    c0 = __builtin_amdgcn_mfma_f32_16x16x4f32(av[k], bv[k], c0, 0, 0, 0);
    c1 = __builtin_amdgcn_mfma_f32_16x16x4f32(av[k + 1], bv[k + 1], c1, 0, 0, 0);
  }
  return c0 + c1;
}

template <int MODE>
DEVI void gdn_chain(const Params& p, int hd, int grp, int cb, char* smem) {
  float* base = (float*)smem;
  constexpr int BUFSZ = 64 * 68 * 2 + 64 * 16;
  float* sS = base + 2 * BUFSZ; float* sVN = sS + 1024;
  const int tid = TID(), lane = tid & 63, wave = tid >> 6, r = lane & 15, qd = lane >> 4;
  const bool apart = (MODE == 0) && (cb >= 4);
  const int e0 = (cb & 3) * 16;
  const int c0 = grp * 32;
  float4 pw0, pw1, pkd0, pkd1, pu = float4{0.f, 0.f, 0.f, 0.f};
  const int lr0 = tid >> 4, lc0 = (tid & 15) * 4, lr1 = lr0 + 32;
  const int ur = tid >> 2, uc = (tid & 3) * 4;
#define GLOAD(c_)                                                            \
  {                                                                          \
    size_t b_ = (size_t)((c_) * 4 + hd) * 4096;                              \
    pw0 = *(const float4*)&p.g_w[b_ + lr0 * 64 + lc0];                       \
    pw1 = *(const float4*)&p.g_w[b_ + lr1 * 64 + lc0];                       \
    pkd0 = *(const float4*)&p.g_kd[b_ + lr0 * 64 + lc0];                     \
    pkd1 = *(const float4*)&p.g_kd[b_ + lr1 * 64 + lc0];                     \
    if (tid < 256 && !apart) pu = *(const float4*)&p.g_u[b_ + ur * 64 + e0 + uc]; \
  }
#define LSTORE(bi_)                                                          \
  {                                                                          \
    float* W_ = base + (bi_) * BUFSZ; float* KD_ = W_ + 64 * 68; float* U_ = KD_ + 64 * 68; \
    *(float4*)&W_[lr0 * 68 + lc0] = pw0; *(float4*)&W_[lr1 * 68 + lc0] = pw1;       \
    *(float4*)&KD_[lr0 * 68 + lc0] = pkd0; *(float4*)&KD_[lr1 * 68 + lc0] = pkd1;   \
    if (tid < 256) *(float4*)&U_[ur * 16 + uc] = pu;                         \
  }
  f32x4 sreg = f32x4{0.f, 0.f, 0.f, 0.f};
  if (MODE == 0) {
    for (int i = tid; i < 1024; i += NT) sS[i] = (apart && ((i >> 4) == e0 + (i & 15))) ? 1.f : 0.f;
    if (apart) {
#pragma unroll
      for (int e = 0; e < 4; ++e) sreg[e] = ((wave & 3) * 16 + 4 * qd + e == e0 + r) ? 1.f : 0.f;
    }
  } else {
    for (int i = tid; i < 1024; i += NT) sS[i] = 0.f;
    float* W = base;
    for (int g2 = 0; g2 < grp; ++g2) {
      const float* Ag = p.g_comp + ((size_t)(hd * 8 + g2) * 2 + 1) * 4096;
      const float* Bg = p.g_comp + ((size_t)(hd * 8 + g2) * 2 + 0) * 4096;
      __syncthreads();
      *(float4*)&W[lr0 * 68 + lc0] = *(const float4*)&Ag[lr0 * 64 + lc0];
      *(float4*)&W[lr1 * 68 + lc0] = *(const float4*)&Ag[lr1 * 64 + lc0];
      __syncthreads();
      f32x4 a = f32x4{0.f, 0.f, 0.f, 0.f};
      if (wave < 4) a = mm16_k64(W + wave * 16 * 68, 68, 1, sS, 16, 1);
      __syncthreads();
      if (wave < 4) {
#pragma unroll
        for (int e = 0; e < 4; ++e) {
          int d = wave * 16 + 4 * qd + e;
          sreg[e] = a[e] + Bg[d * 64 + e0 + r];
          sS[d * 16 + r] = sreg[e];
        }
      }
    }
    __syncthreads();
    if (wave < 4) {
#pragma unroll
      for (int e = 0; e < 4; ++e) {
        int d = wave * 16 + 4 * qd + e;
        p.g_sst[(size_t)(c0 * 4 + hd) * 4096 + d * 64 + e0 + r] = sreg[e];
      }
    }
  }
  GLOAD(c0) LSTORE(0)
  __syncthreads();
  for (int cc = 0; cc < 32; ++cc) {
    const int c = c0 + cc;
    if (cc + 1 < 32) GLOAD(c + 1)
    const float cd = p.g_cdec[c * 4 + hd];
    float* W = base + (cc & 1) * BUFSZ; float* KD = W + 64 * 68; float* U = KD + 64 * 68;
    const size_t it = (size_t)(c * 4 + hd);
    if (wave < 4) {
      f32x4 a1 = mm16_k64(W + wave * 16 * 68, 68, 1, sS, 16, 1);
#pragma unroll
      for (int e = 0; e < 4; ++e) {
        int i = wave * 16 + 4 * qd + e;
        float vn = (apart ? 0.f : U[i * 16 + r]) - a1[e];
        sVN[i * 16 + r] = vn;
        if (MODE == 1) p.g_u[it * 4096 + i * 64 + e0 + r] = vn;
      }
    }
    __syncthreads();
    if (wave < 4) {
      f32x4 a2 = mm16_k64(KD + wave * 16, 1, 68, sVN, 16, 1);
#pragma unroll
      for (int e = 0; e < 4; ++e) {
        int d = wave * 16 + 4 * qd + e;
        sreg[e] = sreg[e] * cd + a2[e];
        sS[d * 16 + r] = sreg[e];
        if (MODE == 1 && cc + 1 < 32) p.g_sst[(size_t)((c + 1) * 4 + hd) * 4096 + d * 64 + e0 + r] = sreg[e];
      }
    }
    if (cc + 1 < 32) LSTORE((cc + 1) & 1)
    __syncthreads();
  }
  if (MODE == 0 && wave < 4) {
    float* dst = p.g_comp + ((size_t)(hd * 8 + grp) * 2 + (apart ? 1 : 0)) * 4096;
#pragma unroll
    for (int e = 0; e < 4; ++e) {
      int d = wave * 16 + 4 * qd + e;
      dst[d * 64 + e0 + r] = sreg[e];
    }
  }
  __syncthreads();
}

DEVI void gdn_out(const Params& p, int l, int item, char* smem) {
  const int c = item >> 2, hd = item & 3, t0 = c * 64;
  float* sQD = (float*)smem; float* sS = sQD + 64 * 68; float* sAT = sS + 64 * 68; float* sVN = sAT + 64 * 68;
  const int tid = TID(), lane = tid & 63, wave = tid >> 6, r = lane & 15, qd = lane >> 4;
  const size_t b = (size_t)item * 4096;
#pragma unroll
  for (int idx = tid; idx < 1024; idx += NT) {
    int row = idx >> 4, c4 = idx & 15;
    *(float4*)&sQD[row * 68 + c4 * 4] = *(const float4*)&p.g_qd[b + row * 64 + c4 * 4];
    *(float4*)&sS[row * 68 + c4 * 4] = *(const float4*)&p.g_sst[b + row * 64 + c4 * 4];
    *(float4*)&sAT[row * 68 + c4 * 4] = *(const float4*)&p.g_attn[b + row * 64 + c4 * 4];
    *(float4*)&sVN[row * 68 + c4 * 4] = *(const float4*)&p.g_u[b + row * 64 + c4 * 4];
  }
  __syncthreads();
  const int mt = wave & 3, nh = wave >> 2;
  f32x4 acc[2]; acc[0] = acc[1] = f32x4{0.f, 0.f, 0.f, 0.f};
  mm16<2>(acc, sQD + mt * 16 * 68, 68, 1, sS + nh * 32, 68, 1, 64);
  mm16<2>(acc, sAT + mt * 16 * 68, 68, 1, sVN + nh * 32, 68, 1, 64);
  __syncthreads();
  float* sO = sQD;
#pragma unroll
  for (int t2 = 0; t2 < 2; ++t2)
#pragma unroll
    for (int e = 0; e < 4; ++e) sO[(mt * 16 + 4 * qd + e) * 68 + nh * 32 + t2 * 16 + r] = acc[t2][e];
  __syncthreads();
  {
    int row = tid >> 3, sub = tid & 7, t = t0 + row;
    float o[8], yv[8]; float ss = 0.f;
#pragma unroll
    for (int k = 0; k < 8; ++k) { o[k] = sO[row * 68 + sub * 8 + k]; ss += o[k] * o[k]; }
    ss += __shfl_xor(ss, 1); ss += __shfl_xor(ss, 2); ss += __shfl_xor(ss, 4);
    float rs = rsqrtf(ss * (1.f / 64.f) + EPS);
    float s2 = 0.f;
#pragma unroll
    for (int k = 0; k < 8; ++k) {
      int col = sub * 8 + k;
      float g = p.proj[(size_t)t * PW + DG + hd * 64 + col];
      float y = o[k] * rs * p.gdn_norm[l * 64 + col] * siluf_(g);
      s2 += y * y;
      yv[k] = y * p.branch_norm[(l * 4 + 3) * 256 + hd * 64 + col];
    }
    s2 += __shfl_xor(s2, 1); s2 += __shfl_xor(s2, 2); s2 += __shfl_xor(s2, 4);
    if (sub == 0) p.ssq[(size_t)t * 16 + 8 + hd] = s2;
    *(uint4*)&p.zb[(size_t)t * DM + 768 + hd * 64 + sub * 8] =
        uint4{pack2(yv[0], yv[1]), pack2(yv[2], yv[3]), pack2(yv[4], yv[5]), pack2(yv[6], yv[7])};
  }
  __syncthreads();
}

DEVI void ret_kv(const Params& p, int l, int item, char* smem) {
  const int c = item >> 2, hd = item & 3, t0 = c * 128;
  float* sK = (float*)smem; float* sV = sK + 128 * 65;
  const int tid = TID(), lane = tid & 63, wave = tid >> 6, r = lane & 15, qd = lane >> 4;
  const float lg = logf(1.f - exp2f(-5.f - (float)hd));
#pragma unroll
  for (int i = tid; i < 128 * 32; i += NT) {
    int t = i >> 5, f = i & 31; size_t tt = t0 + t;
    float k1 = p.proj[tt * PW + RK + hd * 64 + f], k2 = p.proj[tt * PW + RK + hd * 64 + 32 + f];
    float cs = p.rope[(tt * 32 + f) * 2], sn = p.rope[(tt * 32 + f) * 2 + 1];
    float dec = expf(lg * (float)(127 - t));
    sK[t * 65 + f] = (k1 * cs - k2 * sn) * dec;
    sK[t * 65 + 32 + f] = (k2 * cs + k1 * sn) * dec;
  }
#pragma unroll
  for (int i = tid; i < 128 * 64; i += NT) {
    int t = i >> 6, e = i & 63;
    sV[t * 65 + e] = p.proj[(size_t)(t0 + t) * PW + RV + hd * 64 + e];
  }
  __syncthreads();
  const int mt = wave & 3, nh = wave >> 2;
  f32x4 acc[2]; acc[0] = acc[1] = f32x4{0.f, 0.f, 0.f, 0.f};
  mm16<2>(acc, sK + mt * 16, 1, 65, sV + nh * 32, 65, 1, 128);
#pragma unroll
  for (int t2 = 0; t2 < 2; ++t2)
#pragma unroll
    for (int e = 0; e < 4; ++e)
      p.ret_kv[(size_t)item * 4096 + (mt * 16 + 4 * qd + e) * 64 + nh * 32 + t2 * 16 + r] = acc[t2][e];
  __syncthreads();
}

DEVI void ret_out(const Params& p, int l, int item, char* smem) {
  const int c = item >> 2, hd = item & 3, t0 = c * 128;
  float* sQ = (float*)smem; float* sK = sQ + 128 * 65; float* sV = sK + 128 * 65; float* sSt = sV + 128 * 65;
  const int tid = TID(), lane = tid & 63, wave = tid >> 6, r = lane & 15, qd = lane >> 4;
  const float lg = logf(1.f - exp2f(-5.f - (float)hd));
  {
    const float* ssrc = p.ret_kv + (size_t)(c * 4 + hd) * 4096;
#pragma unroll
    for (int j = 0; j < 8; ++j) { int idx = tid + 512 * j; sSt[(idx >> 6) * 65 + (idx & 63)] = ssrc[idx]; }
  }
#pragma unroll
  for (int i = tid; i < 128 * 32; i += NT) {
    int t = i >> 5, f = i & 31; size_t tt = t0 + t;
    float cs = p.rope[(tt * 32 + f) * 2], sn = p.rope[(tt * 32 + f) * 2 + 1];
    float k1 = p.proj[tt * PW + RK + hd * 64 + f], k2 = p.proj[tt * PW + RK + hd * 64 + 32 + f];
    sK[t * 65 + f] = (k1 * cs - k2 * sn);
    sK[t * 65 + 32 + f] = (k2 * cs + k1 * sn);
    float q1 = p.proj[tt * PW + RQ + hd * 64 + f], q2 = p.proj[tt * PW + RQ + hd * 64 + 32 + f];
    sQ[t * 65 + f] = (q1 * cs - q2 * sn) * 0.125f;
    sQ[t * 65 + 32 + f] = (q2 * cs + q1 * sn) * 0.125f;
  }
#pragma unroll
  for (int i = tid; i < 128 * 64; i += NT) {
    int t = i >> 6, e = i & 63;
    sV[t * 65 + e] = p.proj[(size_t)(t0 + t) * PW + RV + hd * 64 + e];
  }
  __syncthreads();
  const int i0 = wave * 16;
  f32x4 sc[8], os[4];
#pragma unroll
  for (int t = 0; t < 8; ++t) sc[t] = f32x4{0.f, 0.f, 0.f, 0.f};
#pragma unroll
  for (int t = 0; t < 4; ++t) os[t] = f32x4{0.f, 0.f, 0.f, 0.f};
  mm16<8>(sc, sQ + i0 * 65, 65, 1, sK, 1, 65, 64);
  mm16<4>(os, sQ + i0 * 65, 65, 1, sSt, 65, 1, 64);
  __syncthreads();
  float* sP = (float*)smem;
#pragma unroll
  for (int t2 = 0; t2 < 8; ++t2)
#pragma unroll
    for (int e = 0; e < 4; ++e) {
      int i = i0 + 4 * qd + e, j = t2 * 16 + r;
      sP[i * 129 + j] = (i >= j) ? sc[t2][e] * expf(lg * (float)(i - j)) : 0.f;
    }
  __syncthreads();
  f32x4 o[4];
#pragma unroll
  for (int t2 = 0; t2 < 4; ++t2)
#pragma unroll
    for (int e = 0; e < 4; ++e) o[t2][e] = os[t2][e] * expf(lg * (float)(i0 + 4 * qd + e + 1));
  mm16<4>(o, sP + i0 * 129, 129, 1, sV, 65, 1, 128);
#pragma unroll
  for (int e = 0; e < 4; ++e) {
    int i = i0 + 4 * qd + e; size_t t = t0 + i;
    float sm = sum16(o[0][e] + o[1][e] + o[2][e] + o[3][e]);
    float mu = sm * (1.f / 64.f);
    float vr = 0.f;
#pragma unroll
    for (int t2 = 0; t2 < 4; ++t2) { float dd = o[t2][e] - mu; vr += dd * dd; }
    vr = sum16(vr);
    float rstd = rsqrtf(vr * (1.f / 64.f) + EPS);
    float ss = 0.f;
#pragma unroll
    for (int t2 = 0; t2 < 4; ++t2) {
      int col = hd * 64 + t2 * 16 + r;
      float on = (o[t2][e] - mu) * rstd * p.ret_gn[l * 256 + col];
      float g = p.proj[t * PW + RG + col];
      float y = siluf_(g) * on;
      ss += y * y;
      p.zb[t * DM + col] = f2bf(y * p.branch_norm[(l * 4 + 0) * 256 + col]);
    }
    ss = sum16(ss);
    if (r == 0) p.ssq[t * 16 + hd] = ss;
  }
  __syncthreads();
}

DEVI void lru_local(const Params& p, int l, int c, char* smem) {
  const int t0 = c * 64;
  float* sX = (float*)smem; float* sA = sX + 64 * 257;
  const int tid = TID(), lane = tid & 63, wave = tid >> 6, r = lane & 15, qd = lane >> 4;
  {
    const int ch = tid & 255, half = tid >> 8;
    const float w0 = p.lru_conv_w[(l * 4 + 0) * 256 + ch], w1 = p.lru_conv_w[(l * 4 + 1) * 256 + ch];
    const float w2 = p.lru_conv_w[(l * 4 + 2) * 256 + ch], w3 = p.lru_conv_w[(l * 4 + 3) * 256 + ch];
    const float cb = p.lru_conv_b[l * 256 + ch];
    const float* pc = p.proj + LX + ch;
    float xv[35];
#pragma unroll
    for (int k = 0; k < 35; ++k) {
      const int tt = t0 + 32 * half - 3 + k;
      const float v = pc[(size_t)(tt < 0 ? 0 : tt) * PW];
      xv[k] = tt < 0 ? 0.f : v;
    }
#pragma unroll
    for (int m = 0; m < 32; ++m) {
      float acc = cb;
      acc += w0 * xv[m]; acc += w1 * xv[m + 1]; acc += w2 * xv[m + 2]; acc += w3 * xv[m + 3];
      sX[(32 * half + m) * 257 + ch] = acc;
    }
  }
  __syncthreads();
  for (int pr = 0; pr < 2; ++pr) {
    int pi = wave * 2 + pr, mt = pi & 3, nb = pi >> 2;
    f32x4 ra[4], ri[4];
#pragma unroll
    for (int t = 0; t < 4; ++t) { ra[t] = f32x4{0.f, 0.f, 0.f, 0.f}; ri[t] = f32x4{0.f, 0.f, 0.f, 0.f}; }
    mm16_gB64<4>(ra, sX + mt * 16 * 257 + nb * 64, 257, p.lru_w_a + (size_t)(l * 4 + nb) * 4096);
    mm16_gB64<4>(ri, sX + mt * 16 * 257 + nb * 64, 257, p.lru_w_x + (size_t)(l * 4 + nb) * 4096);
#pragma unroll
    for (int t2 = 0; t2 < 4; ++t2)
#pragma unroll
      for (int e = 0; e < 4; ++e) {
        int t = mt * 16 + 4 * qd + e, ch = nb * 64 + t2 * 16 + r;
        float xb = sX[t * 257 + ch];
        float rr = sigmoidf_(ra[t2][e] + p.lru_b_a[l * 256 + ch]);
        float ii = sigmoidf_(ri[t2][e] + p.lru_b_x[l * 256 + ch]);
        float loga = -8.f * rr * softplusf_(-p.lru_lambda[l * 256 + ch]);
        float a = expf(loga);
        float bb = sqrtf(-expm1f(2.f * loga)) * (ii * xb);
        sA[t * 257 + ch] = a; sX[t * 257 + ch] = bb;
      }
  }
  __syncthreads();
  if (tid < 256) {
    int ch = tid; float H = 0.f, P = 1.f;
    for (int t = 0; t < 64; ++t) {
      float a = sA[t * 257 + ch], bb = sX[t * 257 + ch];
      H = a * H + bb; P *= a;
      p.lru_h[(size_t)(t0 + t) * 256 + ch] = H; p.lru_p[(size_t)(t0 + t) * 256 + ch] = P;
    }
    p.lru_hs[c * 256 + ch] = H; p.lru_ps[c * 256 + ch] = P;
  }
  __syncthreads();
}

DEVI void lru_out(const Params& p, int l, int c, char* smem) {
  const int t0 = c * 64;
  float* sC = (float*)smem;
  const int tid = TID(), lane = tid & 63, wave = tid >> 6;
  if (tid < 256) sC[tid] = p.lru_hs[c * 256 + tid];
  __syncthreads();
  {
    const int ch = lane * 4;
    float4 Hs[8], Ps[8], gs[8];
#pragma unroll
    for (int tk = 0; tk < 8; ++tk) {
      const size_t t = t0 + wave * 8 + tk;
      Hs[tk] = *(const float4*)&p.lru_h[t * 256 + ch]; Ps[tk] = *(const float4*)&p.lru_p[t * 256 + ch];
      gs[tk] = *(const float4*)&p.proj[t * PW + LG + ch];
    }
    const float4 cr = *(const float4*)&sC[ch];
    const float4 bn = *(const float4*)&p.branch_norm[(l * 4 + 1) * 256 + ch];
#pragma unroll
    for (int tk = 0; tk < 8; ++tk) {
      const size_t t = t0 + wave * 8 + tk;
      const float4 H = Hs[tk], P = Ps[tk], g = gs[tk];
      float y0 = geluf_(g.x) * (H.x + P.x * cr.x), y1 = geluf_(g.y) * (H.y + P.y * cr.y);
      float y2 = geluf_(g.z) * (H.z + P.z * cr.z), y3 = geluf_(g.w) * (H.w + P.w * cr.w);
      float ss = wave_sum(y0 * y0 + y1 * y1 + y2 * y2 + y3 * y3);
      if (lane == 0) p.ssq[t * 16 + 4] = ss;
      *(uint2*)&p.zb[t * DM + 256 + ch] = uint2{pack2(y0 * bn.x, y1 * bn.y), pack2(y2 * bn.z, y3 * bn.w)};
    }
  }
  __syncthreads();
}

DEVI void s5_coef(const Params& p, int l, int g, int n, float& abr, float& abi, float (&bbr)[16], float (&bbi)[16]) {
  float dt = expf(p.s5_log_dt[l * 16 + g]);
  float are = p.s5_a_re[(l * 16 + g) * 64 + n], aim = p.s5_a_im[(l * 16 + g) * 64 + n];
  float mag = expf(are * dt), ang = aim * dt;
  abr = mag * cosf(ang); abi = mag * sinf(ang);
  float den = are * are + aim * aim;
  float pre = abr - 1.f, pim = abi;
  float fre = (pre * are + pim * aim) / den, fim = (pim * are - pre * aim) / den;
  const float4* br = (const float4*)(p.s5_b_re + (size_t)((l * 16 + g) * 64 + n) * 16);
  const float4* bi = (const float4*)(p.s5_b_im + (size_t)((l * 16 + g) * 64 + n) * 16);
#pragma unroll
  for (int c4 = 0; c4 < 4; ++c4) {
    float4 a = br[c4], b = bi[c4];
    bbr[c4 * 4 + 0] = fre * a.x - fim * b.x; bbi[c4 * 4 + 0] = fre * b.x + fim * a.x;
    bbr[c4 * 4 + 1] = fre * a.y - fim * b.y; bbi[c4 * 4 + 1] = fre * b.y + fim * a.y;
    bbr[c4 * 4 + 2] = fre * a.z - fim * b.z; bbi[c4 * 4 + 2] = fre * b.z + fim * a.z;
    bbr[c4 * 4 + 3] = fre * a.w - fim * b.w; bbi[c4 * 4 + 3] = fre * b.w + fim * a.w;
  }
}
DEVI void s5_load_u(const Params& p, int t0, float* sU) {
#pragma unroll
  for (int i = TID(); i < 64 * 64; i += NT) {
    int t = i >> 6, c4 = i & 63;
    *(float4*)&sU[t * 256 + c4 * 4] = *(const float4*)&p.proj[(size_t)(t0 + t) * PW + SU + c4 * 4];
  }
}
DEVI void s5_bu(const float* up, const float (&bbr)[16], const float (&bbi)[16], float& bur, float& bui) {
  bur = 0.f; bui = 0.f;
#pragma unroll
  for (int c4 = 0; c4 < 4; ++c4) {
    float4 u = *(const float4*)&up[c4 * 4];
    bur += bbr[c4 * 4] * u.x + bbr[c4 * 4 + 1] * u.y + bbr[c4 * 4 + 2] * u.z + bbr[c4 * 4 + 3] * u.w;
    bui += bbi[c4 * 4] * u.x + bbi[c4 * 4 + 1] * u.y + bbi[c4 * 4 + 2] * u.z + bbi[c4 * 4 + 3] * u.w;
  }
}

DEVI void s5_local(const Params& p, int l, int c, char* smem) {
  const int t0 = c * 64;
  float* sU = (float*)smem;
  const int lane = TID() & 63, wave = TID() >> 6;
  s5_load_u(p, t0, sU);
  __syncthreads();
  for (int gi = 0; gi < 2; ++gi) {
    int g = wave + 8 * gi;
    float abr, abi, bbr[16], bbi[16];
    s5_coef(p, l, g, lane, abr, abi, bbr, bbi);
    float xr = 0.f, xi = 0.f;
    for (int t = 0; t < 64; ++t) {
      float bur, bui; s5_bu(sU + t * 256 + g * 16, bbr, bbi, bur, bui);
      float nr = abr * xr - abi * xi + bur, ni = abr * xi + abi * xr + bui;
      xr = nr; xi = ni;
    }
    *(float2*)&p.xloc[((size_t)(c * 16 + g) * 64 + lane) * 2] = float2{xr, xi};
  }
  __syncthreads();
}

DEVI void s5_out(const Params& p, int l, int c, char* smem) {
  const int t0 = c * 64;
  bf16_t* sY = (bf16_t*)smem;
  float* sX = (float*)(smem + 64 * 264 * 2);
  const int tid = TID(), lane = tid & 63, wave = tid >> 6, r = lane & 15, qd = lane >> 4;
  float* Xl = sX + wave * (16 * 132);
  for (int gi = 0; gi < 2; ++gi) {
    const int g = wave + 8 * gi;
    float abr, abi, bbr[16], bbi[16];
    s5_coef(p, l, g, lane, abr, abi, bbr, bbi);
    float breg[32];
#pragma unroll
    for (int ks = 0; ks < 16; ++ks) {
      breg[ks] = p.s5_c_re[(size_t)((l * 16 + g) * 16 + r) * 64 + 4 * ks + qd];
      breg[16 + ks] = -p.s5_c_im[(size_t)((l * 16 + g) * 16 + r) * 64 + 4 * ks + qd];
    }
    const float dd = p.s5_d[l * 256 + g * 16 + r];
    const float2 xin = *(const float2*)&p.xloc[((size_t)(c * 16 + g) * 64 + lane) * 2];
    float xr = xin.x, xi = xin.y;
    float4 uvecs[4]; float ues[4][4];
#pragma unroll
    for (int tb = 0; tb < 4; ++tb) {
      const float* ub = p.proj + (size_t)(t0 + tb * 16) * PW + SU + g * 16;
      uvecs[tb] = *(const float4*)&ub[(size_t)r * PW + 4 * qd];
#pragma unroll
      for (int e = 0; e < 4; ++e) ues[tb][e] = ub[(size_t)(4 * qd + e) * PW + r];
    }
#pragma unroll
    for (int tb = 0; tb < 4; ++tb) {
      const float4 uvec = uvecs[tb];
      float ue[4];
#pragma unroll
      for (int e = 0; e < 4; ++e) ue[e] = ues[tb][e];
      const int u0 = __float_as_int(uvec.x), u1 = __float_as_int(uvec.y), u2 = __float_as_int(uvec.z), u3 = __float_as_int(uvec.w);
#pragma unroll
      for (int tt = 0; tt < 16; ++tt) {
        float bur = 0.f, bui = 0.f;
#pragma unroll
        for (int c4 = 0; c4 < 4; ++c4) {
          float a0 = __int_as_float(__builtin_amdgcn_readlane(u0, tt + 16 * c4));
          float a1 = __int_as_float(__builtin_amdgcn_readlane(u1, tt + 16 * c4));
          float a2 = __int_as_float(__builtin_amdgcn_readlane(u2, tt + 16 * c4));
          float a3 = __int_as_float(__builtin_amdgcn_readlane(u3, tt + 16 * c4));
          bur += bbr[c4 * 4] * a0 + bbr[c4 * 4 + 1] * a1 + bbr[c4 * 4 + 2] * a2 + bbr[c4 * 4 + 3] * a3;
          bui += bbi[c4 * 4] * a0 + bbi[c4 * 4 + 1] * a1 + bbi[c4 * 4 + 2] * a2 + bbi[c4 * 4 + 3] * a3;
        }
        float nr = abr * xr - abi * xi + bur, ni = abr * xi + abi * xr + bui;
        xr = nr; xi = ni;
        Xl[tt * 132 + lane] = xr; Xl[tt * 132 + 64 + lane] = xi;
      }
      f32x4 acc = f32x4{0.f, 0.f, 0.f, 0.f};
#pragma unroll
      for (int ks = 0; ks < 32; ++ks) {
        float a = Xl[r * 132 + 4 * ks + qd];
        acc = __builtin_amdgcn_mfma_f32_16x16x4f32(a, breg[ks], acc, 0, 0, 0);
      }
#pragma unroll
      for (int e = 0; e < 4; ++e) {
        float y = acc[e] + dd * ue[e];
        sY[(tb * 16 + 4 * qd + e) * 264 + g * 16 + r] = f2bf(geluf_(y));
      }
    }
  }
  __syncthreads();
  f32x4 av[4][2], ag[4][2];
#pragma unroll
  for (int i = 0; i < 4; ++i)
#pragma unroll
    for (int j = 0; j < 2; ++j) { av[i][j] = f32x4{0.f, 0.f, 0.f, 0.f}; ag[i][j] = f32x4{0.f, 0.f, 0.f, 0.f}; }
  const bf16_t* WT = p.gluT + (size_t)l * 512 * 256;
#pragma unroll 4
  for (int ks = 0; ks < 8; ++ks) {
    bf16x8 bv0 = *(const bf16x8*)&WT[(size_t)(32 * wave + r) * 256 + ks * 32 + qd * 8];
    bf16x8 bv1 = *(const bf16x8*)&WT[(size_t)(32 * wave + 16 + r) * 256 + ks * 32 + qd * 8];
    bf16x8 bg0 = *(const bf16x8*)&WT[(size_t)(256 + 32 * wave + r) * 256 + ks * 32 + qd * 8];
    bf16x8 bg1 = *(const bf16x8*)&WT[(size_t)(256 + 32 * wave + 16 + r) * 256 + ks * 32 + qd * 8];
#pragma unroll
    for (int mt = 0; mt < 4; ++mt) {
      bf16x8 a = *(const bf16x8*)&sY[(mt * 16 + r) * 264 + ks * 32 + qd * 8];
      av[mt][0] = __builtin_amdgcn_mfma_f32_16x16x32_bf16(a, bv0, av[mt][0], 0, 0, 0);
      av[mt][1] = __builtin_amdgcn_mfma_f32_16x16x32_bf16(a, bv1, av[mt][1], 0, 0, 0);
      ag[mt][0] = __builtin_amdgcn_mfma_f32_16x16x32_bf16(a, bg0, ag[mt][0], 0, 0, 0);
      ag[mt][1] = __builtin_amdgcn_mfma_f32_16x16x32_bf16(a, bg1, ag[mt][1], 0, 0, 0);
    }
  }
  float* sO = sX;
#pragma unroll
  for (int mt = 0; mt < 4; ++mt)
#pragma unroll
    for (int t2 = 0; t2 < 2; ++t2)
#pragma unroll
      for (int e = 0; e < 4; ++e) {
        int t = mt * 16 + 4 * qd + e, col = 32 * wave + t2 * 16 + r;
        float zv = av[mt][t2][e] + p.s5_glu_b[l * 512 + col];
        float zg = ag[mt][t2][e] + p.s5_glu_b[l * 512 + 256 + col];
        sO[t * 256 + col] = zv * sigmoidf_(zg);
      }
  __syncthreads();
  for (int tk = 0; tk < 8; ++tk) {
    int tl = wave * 8 + tk; size_t t = t0 + tl; int ch = lane * 4;
    float4 o = *(const float4*)&sO[tl * 256 + ch];
    float4 bn = *(const float4*)&p.branch_norm[(l * 4 + 2) * 256 + ch];
    float ss = wave_sum(o.x * o.x + o.y * o.y + o.z * o.z + o.w * o.w);
    if (lane == 0) p.ssq[t * 16 + 5] = ss;
    *(uint2*)&p.zb[t * DM + 512 + ch] = uint2{pack2(o.x * bn.x, o.y * bn.y), pack2(o.z * bn.z, o.w * bn.w)};
  }
  __syncthreads();
}

DEVI void ret_scan(const Params& p, int it) {
  const int elem = it * NT + TID(), hd = elem >> 12, idx = elem & 4095;
  const float lg = logf(1.f - exp2f(-5.f - (float)hd)), cdk = expf(lg * 128.f);
  float* base = p.ret_kv + (size_t)hd * 4096 + idx;
  float s = 0.f;
  for (int cb = 0; cb < 128; cb += 16) {
    float v[16];
#pragma unroll
    for (int j = 0; j < 16; ++j) v[j] = base[(size_t)(cb + j) * 16384];
#pragma unroll
    for (int j = 0; j < 16; ++j) { base[(size_t)(cb + j) * 16384] = s; s = s * cdk + v[j]; }
  }
}
DEVI void s5_scan(const Params& p, int l, int it) {
  const int sidx = it * NT + TID(), g = sidx >> 6, n = sidx & 63;
  float dt = expf(p.s5_log_dt[l * 16 + g]);
  float are = p.s5_a_re[(l * 16 + g) * 64 + n], aim = p.s5_a_im[(l * 16 + g) * 64 + n];
  float mag = expf(are * dt), ang = aim * dt;
  float pr = mag * cosf(ang), pi = mag * sinf(ang);
#pragma unroll
  for (int k = 0; k < 6; ++k) { float nr = pr * pr - pi * pi, ni = 2.f * pr * pi; pr = nr; pi = ni; }
  float2* base = (float2*)p.xloc + sidx;
  float xr = 0.f, xi = 0.f;
  for (int cb = 0; cb < 256; cb += 16) {
    float2 v[16];
#pragma unroll
    for (int j = 0; j < 16; ++j) v[j] = base[(size_t)(cb + j) * 1024];
#pragma unroll
    for (int j = 0; j < 16; ++j) {
      base[(size_t)(cb + j) * 1024] = float2{xr, xi};
      float nr = pr * xr - pi * xi + v[j].x, ni = pr * xi + pi * xr + v[j].y;
      xr = nr; xi = ni;
    }
  }
}
DEVI void lru_scan(const Params& p) {
  const int ch = TID();
  if (ch < 256) {
    float carry = 0.f;
    for (int cb = 0; cb < 256; cb += 16) {
      float ps[16], hs[16];
#pragma unroll
      for (int j = 0; j < 16; ++j) { ps[j] = p.lru_ps[(cb + j) * 256 + ch]; hs[j] = p.lru_hs[(cb + j) * 256 + ch]; }
#pragma unroll
      for (int j = 0; j < 16; ++j) { p.lru_hs[(cb + j) * 256 + ch] = carry; carry = ps[j] * carry + hs[j]; }
    }
  }
}

DEVI void peer_scores(const Params& p, int l, int item, char* smem) {
  const int hp = item & 15, grp = item >> 4;
  float* sQ = (float*)smem;
  float* sKy = sQ + 64 * 68;
  const int tid = TID(), lane = tid & 63, wave = tid >> 6, r = lane & 15, qd = lane >> 4;
  const float* ky = p.peer_subkeys + (size_t)(l * 16 + hp) * 8192;
#pragma unroll
  for (int i = tid; i < 128 * 64; i += NT) { int k = i >> 6, d = i & 63; sKy[k * 65 + d] = ky[i]; }
  const int lt0 = tid >> 4, lc4 = (tid & 15) * 4;
  const float* qb = p.qbuf + (size_t)hp * 64 + lc4;
  float4 q0, q1;
  {
    const size_t t0 = (size_t)(grp * 16) * 64;
    q0 = *(const float4*)&qb[(t0 + lt0) * 1024]; q1 = *(const float4*)&qb[(t0 + lt0 + 32) * 1024];
  }
  const int mt = wave & 3, nh = wave >> 2;
  for (int k = 0; k < 16; ++k) {
    const size_t t0 = (size_t)(grp * 16 + k) * 64;
    __syncthreads();
    *(float4*)&sQ[lt0 * 68 + lc4] = q0; *(float4*)&sQ[(lt0 + 32) * 68 + lc4] = q1;
    __syncthreads();
    if (k + 1 < 16) { q0 = *(const float4*)&qb[(t0 + 64 + lt0) * 1024]; q1 = *(const float4*)&qb[(t0 + 64 + lt0 + 32) * 1024]; }
    f32x4 acc[4];
#pragma unroll
    for (int t = 0; t < 4; ++t) acc[t] = f32x4{0.f, 0.f, 0.f, 0.f};
    mm16<4>(acc, sQ + mt * 16 * 68, 68, 1, sKy + nh * 64 * 65, 1, 65, 64);
#pragma unroll
    for (int t2 = 0; t2 < 4; ++t2)
#pragma unroll
      for (int e = 0; e < 4; ++e) {
        size_t t = t0 + mt * 16 + 4 * qd + e; int key = nh * 64 + t2 * 16 + r;
        p.scores[(t * 16 + hp) * 128 + key] = acc[t2][e];
      }
  }
  __syncthreads();
}

DEVI unsigned ford(float x) { unsigned u = __float_as_uint(x); return (u & 0x80000000u) ? ~u : (u | 0x80000000u); }
DEVI float funord(unsigned u) { return __uint_as_float((u & 0x80000000u) ? (u ^ 0x80000000u) : ~u); }
DEVI void ins16(unsigned (&v)[16], unsigned x) {
#pragma unroll
  for (int j = 0; j < 16; ++j) { unsigned hi = max(v[j], x); x = min(v[j], x); v[j] = hi; }
}

DEVI void peer_topk(const Params& p, int item, char* smem) {
  const int t0 = item * 64;
  float* sS = (float*)smem;
  const int tid = TID();
  const float* base = p.scores + (size_t)t0 * 8 * 256;
  unsigned v1[16], v2[16];
#pragma unroll
  for (int j = 0; j < 16; ++j) { v1[j] = 0u; v2[j] = 0u; }
  float4 nx[8];
#pragma unroll
  for (int i = 0; i < 8; ++i) { int idx = tid + 512 * i; nx[i] = *(const float4*)&base[(size_t)(idx >> 3) * 256 + (idx & 7) * 4]; }
  for (int s = 0; s < 8; ++s) {
    __syncthreads();
#pragma unroll
    for (int i = 0; i < 8; ++i) {
      int idx = tid + 512 * i, pr = idx >> 3, c4 = idx & 7;
      float* d = &sS[pr * 33 + c4 * 4];
      d[0] = nx[i].x; d[1] = nx[i].y; d[2] = nx[i].z; d[3] = nx[i].w;
    }
    __syncthreads();
    if (s + 1 < 8) {
#pragma unroll
      for (int i = 0; i < 8; ++i) { int idx = tid + 512 * i; nx[i] = *(const float4*)&base[(size_t)(idx >> 3) * 256 + (s + 1) * 32 + (idx & 7) * 4]; }
    }
    const int kb = (s & 3) * 32;
    if (s < 4) {
      for (int k = 0; k < 32; ++k) { unsigned key = (ford(sS[tid * 33 + k]) & ~127u) | (unsigned)(127 - (kb + k)); ins16(v1, key); }
    } else {
      for (int k = 0; k < 32; ++k) { unsigned key = (ford(sS[tid * 33 + k]) & ~127u) | (unsigned)(127 - (kb + k)); ins16(v2, key); }
    }
  }
  __syncthreads();
  unsigned* sI = (unsigned*)smem;
  float s1[16], s2[16];
#pragma unroll
  for (int a = 0; a < 16; ++a) {
    s1[a] = funord(v1[a] & ~127u); s2[a] = funord(v2[a] & ~127u);
    sI[tid * 33 + a] = 127u - (v1[a] & 127u); sI[tid * 33 + 16 + a] = 127u - (v2[a] & 127u);
  }
  unsigned vt[16];
#pragma unroll
  for (int j = 0; j < 16; ++j) vt[j] = 0u;
#pragma unroll
  for (int a = 0; a < 16; ++a)
#pragma unroll
    for (int b = 0; b < 16; ++b)
      if ((a + 1) * (b + 1) <= 16) {
        unsigned key = (ford(s1[a] + s2[b]) & ~255u) | (unsigned)(255 - (a * 16 + b));
        ins16(vt, key);
      }
  float sv[16]; float den = 0.f;
  const float mx = funord(vt[0] & ~255u);
#pragma unroll
  for (int k = 0; k < 16; ++k) { sv[k] = expf(funord(vt[k] & ~255u) - mx); den += sv[k]; }
  const float inv = 1.f / den;
  const int tl = tid >> 3, hh = tid & 7;
  int* idp = p.ids + (size_t)(t0 + tl) * 128 + hh * 16;
  float* gp = p.gates + (size_t)(t0 + tl) * 128 + hh * 16;
#pragma unroll
  for (int k = 0; k < 16; ++k) {
    unsigned pos = 255u - (vt[k] & 255u);
    unsigned i1 = sI[tid * 33 + (pos >> 4)], i2 = sI[tid * 33 + 16 + (pos & 15)];
    idp[k] = (int)(i1 * 128u + i2);
    gp[k] = sv[k] * inv;
  }
  __syncthreads();
}

typedef __attribute__((ext_vector_type(2))) float f32x2;
DEVI void fp8x16_to_f(const uint4& v, float (&o)[16]) {
  f32x2 t;
  t = __builtin_amdgcn_cvt_pk_f32_fp8((int)v.x, false); o[0] = t[0]; o[1] = t[1];
  t = __builtin_amdgcn_cvt_pk_f32_fp8((int)v.x, true); o[2] = t[0]; o[3] = t[1];
  t = __builtin_amdgcn_cvt_pk_f32_fp8((int)v.y, false); o[4] = t[0]; o[5] = t[1];
  t = __builtin_amdgcn_cvt_pk_f32_fp8((int)v.y, true); o[6] = t[0]; o[7] = t[1];
  t = __builtin_amdgcn_cvt_pk_f32_fp8((int)v.z, false); o[8] = t[0]; o[9] = t[1];
  t = __builtin_amdgcn_cvt_pk_f32_fp8((int)v.z, true); o[10] = t[0]; o[11] = t[1];
  t = __builtin_amdgcn_cvt_pk_f32_fp8((int)v.w, false); o[12] = t[0]; o[13] = t[1];
  t = __builtin_amdgcn_cvt_pk_f32_fp8((int)v.w, true); o[14] = t[0]; o[15] = t[1];
}

DEVI void ph_gather(const Params& p, int l) {
  const int lane = TID() & 63, wave = TID() >> 6;
  const int e0 = lane * 16;
  constexpr int NB = 8;
  for (int t = blockIdx.x * 8 + wave; t < S_; t += gridDim.x * 8) {
    float* hrow = p.h + (size_t)t * DM + e0;
    float z[16], out[16];
    {
      float4 a = *(const float4*)&hrow[0], b = *(const float4*)&hrow[4], c = *(const float4*)&hrow[8], d = *(const float4*)&hrow[12];
      z[0] = a.x; z[1] = a.y; z[2] = a.z; z[3] = a.w; z[4] = b.x; z[5] = b.y; z[6] = b.z; z[7] = b.w;
      z[8] = c.x; z[9] = c.y; z[10] = c.z; z[11] = c.w; z[12] = d.x; z[13] = d.y; z[14] = d.z; z[15] = d.w;
    }
    float ss = 0.f;
#pragma unroll
    for (int k = 0; k < 16; ++k) { ss += z[k] * z[k]; out[k] = 0.f; }
    ss = wave_sum(ss);
    const float rs = rsqrtf(ss * (1.f / DM) + EPS);
    const float* fn = p.ffn_norm + l * DM + e0;
#pragma unroll
    for (int k = 0; k < 16; ++k) z[k] = z[k] * rs * fn[k];
    const int id0 = p.ids[(size_t)t * 128 + lane], id1 = p.ids[(size_t)t * 128 + 64 + lane];
    const int gv0 = __float_as_int(p.gates[(size_t)t * 128 + lane] * p.vinv[id0]);
    const int gv1 = __float_as_int(p.gates[(size_t)t * 128 + 64 + lane] * p.vinv[id1]);
    const int us0 = __float_as_int(p.uinv[id0]), us1 = __float_as_int(p.uinv[id1]);
    uint4 cu[NB], cv[NB], nu[NB], nv[NB];
#pragma unroll
    for (int j = 0; j < NB; ++j) {
      int e = __builtin_amdgcn_readlane(id0, j);
      cu[j] = *(const uint4*)(p.tabU + (size_t)e * 1024 + e0);
      cv[j] = *(const uint4*)(p.tabV + (size_t)e * 1024 + e0);
    }
#pragma unroll 1
    for (int b = 0; b < 128 / NB; ++b) {
      const int nb = b + 1;
      if (nb < 128 / NB) {
        const int idn = nb < 64 / NB ? id0 : id1;
#pragma unroll
        for (int j = 0; j < NB; ++j) {
          int e = __builtin_amdgcn_readlane(idn, (nb * NB + j) & 63);
          nu[j] = *(const uint4*)(p.tabU + (size_t)e * 1024 + e0);
          nv[j] = *(const uint4*)(p.tabV + (size_t)e * 1024 + e0);
        }
      }
      const int gvc = b < 64 / NB ? gv0 : gv1, usc = b < 64 / NB ? us0 : us1;
      float dot[NB];
#pragma unroll
      for (int j = 0; j < NB; ++j) {
        float f[16]; fp8x16_to_f(cu[j], f);
        float d = 0.f;
#pragma unroll
        for (int k = 0; k < 16; ++k) d += z[k] * f[k];
        dot[j] = d;
      }
#pragma unroll
      for (int j = 0; j < NB; ++j) dot[j] = wave_sum(dot[j]);
#pragma unroll
      for (int j = 0; j < NB; ++j) {
        const int li = (b * NB + j) & 63;
        float us = __int_as_float(__builtin_amdgcn_readlane(usc, li));
        float gt = __int_as_float(__builtin_amdgcn_readlane(gvc, li));
        float cf = gt * geluf_(dot[j] * us);
        float f[16]; fp8x16_to_f(cv[j], f);
#pragma unroll
        for (int k = 0; k < 16; ++k) out[k] += cf * f[k];
      }
#pragma unroll
      for (int j = 0; j < NB; ++j) { cu[j] = nu[j]; cv[j] = nv[j]; }
    }
    float hv[16];
    {
      float4 a = *(const float4*)&hrow[0], b = *(const float4*)&hrow[4], c = *(const float4*)&hrow[8], d = *(const float4*)&hrow[12];
      hv[0] = a.x; hv[1] = a.y; hv[2] = a.z; hv[3] = a.w; hv[4] = b.x; hv[5] = b.y; hv[6] = b.z; hv[7] = b.w;
      hv[8] = c.x; hv[9] = c.y; hv[10] = c.z; hv[11] = c.w; hv[12] = d.x; hv[13] = d.y; hv[14] = d.z; hv[15] = d.w;
    }
    float s2 = 0.f;
#pragma unroll
    for (int k = 0; k < 16; ++k) { hv[k] += out[k]; s2 += hv[k] * hv[k]; }
    *(float4*)&hrow[0] = float4{hv[0], hv[1], hv[2], hv[3]}; *(float4*)&hrow[4] = float4{hv[4], hv[5], hv[6], hv[7]};
    *(float4*)&hrow[8] = float4{hv[8], hv[9], hv[10], hv[11]}; *(float4*)&hrow[12] = float4{hv[12], hv[13], hv[14], hv[15]};
    s2 = wave_sum(s2);
    const float rs2 = rsqrtf(s2 * (1.f / DM) + EPS);
    const float* pn = p.ple_norm + l * DM + e0;
    float zz[16];
#pragma unroll
    for (int k = 0; k < 16; ++k) zz[k] = hv[k] * rs2 * pn[k];
    bf16_t* zrow = p.zb + (size_t)t * DM + e0;
    *(uint4*)&zrow[0] = uint4{pack2(zz[0], zz[1]), pack2(zz[2], zz[3]), pack2(zz[4], zz[5]), pack2(zz[6], zz[7])};
    *(uint4*)&zrow[8] = uint4{pack2(zz[8], zz[9]), pack2(zz[10], zz[11]), pack2(zz[12], zz[13]), pack2(zz[14], zz[15])};
  }
}

template <class F>
DEVI void gemm_tiles(int NTn, int XM, int XN, F&& f) {
  int G = gridDim.x, B = blockIdx.x;
  asm volatile("" : "+s"(G), "+s"(B));
  if (G & 7) { for (int tile = B; tile < 64 * NTn; tile += G) f(tile / NTn, tile % NTn); return; }
  const int x = B & 7, slot = B >> 3, ns = G >> 3;
  const int xm = x / XN, xn = x % XN;
  const int mcnt = 64 / XM, mb = xm * mcnt;
  const int ncnt = (NTn - xn + XN - 1) / XN;
  for (int j = slot; j < mcnt * ncnt; j += ns) f(mb + j / ncnt, xn + XN * (j % ncnt));
}

enum { PH_PREP = 0, PH_NORM1, PH_GEMM_IN, PH_MIX_A, PH_MIX_B, PH_MIX_C, PH_MIX_D, PH_GEMM_OUT, PH_NORM2, PH_GEMM_Q, PH_SCORES,
       PH_TOPK, PH_GATHER, PH_GEMM_PLE, PH_FINAL };

#if PROBE_A >= 0
#define REGION(id, stmt)                                                                                   \
  {                                                                                                        \
    const bool on_ = (blockIdx.x == 255 && TID() == 0 && ((id) == PROBE_A || (id) == PROBE_B));              \
    if (on_) p.g_cdec[2051] = (float)(wall_clock64() & 0xFFFFFFull);                                       \
    stmt;                                                                                                  \
    if (on_) {                                                                                             \
      float dt_ = (float)(wall_clock64() & 0xFFFFFFull) - p.g_cdec[2051];                                  \
      if (dt_ < 0.f) dt_ += 16777216.f;                                                                    \
      p.g_cdec[(id) == PROBE_A ? 2048 : 2049] += dt_;                                                      \
    }                                                                                                      \
  }
#else
#define REGION(id, stmt) { stmt; }
#endif
DEVI void run_phase(const Params& p, int ph, int l, char* smem) {
  int G = gridDim.x, B = blockIdx.x;
  asm volatile("" : "+s"(G), "+s"(B));
  switch (ph) {
    case PH_PREP: ph_prep(p, smem); break;
    case PH_NORM1: ph_norm(l == 0 ? p.x : p.h, p.mix_norm + l * DM, p.zb, nullptr); break;
    case PH_GEMM_IN:
      gemm_tiles(23, 1, 8, [&](int mt_, int nt_) __attribute__((always_inline)) {
        int m0 = mt_ * 256, n0 = nt_ * 128;
        f32x4 acc[4][4];
        gemm_tile<0, 16>(acc, p.zb, DM, p.winT + (size_t)l * PW * 1024, 1024, 1024, m0, n0, nullptr, smem);
        GEMM_EPI_COORDS
#pragma unroll
        for (int i = 0; i < 4; ++i)
#pragma unroll
          for (int j = 0; j < 4; ++j)
            *(f32x4*)&p.proj[(size_t)(erow0 + i * 16) * PW + ecol0 + j * 16] = acc[i][j];
      });
      break;
    case PH_MIX_A:
      for (int it = B; it < 2048; it += G) {
        if (it < 1024) REGION(105, gdn_prep(p, l, it, smem))
        else if (it < 1536) REGION(106, ret_kv(p, l, it - 1024, smem))
        else if (it < 1792) REGION(107, lru_local(p, l, it - 1536, smem))
        else REGION(108, s5_local(p, l, it - 1792, smem))
      }
      break;
    case PH_MIX_B:
      for (int it = B; it < 256 + 35; it += G) {
        if (it < 256) { const int pr_ = (it & 7) * 4 + (it >> 6), cb_ = (it >> 3) & 7; REGION(100, gdn_chain<0>(p, pr_ >> 3, pr_ & 7, cb_, smem)) }
        else if (it < 256 + 32) ret_scan(p, it - 256);
        else if (it < 256 + 34) s5_scan(p, l, it - 288);
        else lru_scan(p);
      }
      break;
    case PH_MIX_C: {
      for (int k = 0;; ++k) {
        int ty = -1, idx = 0;
        if (G == 256) {
          if (B < 128) { if (k < 4) { ty = k; idx = B; } }
          else if (k == 0) { ty = 1; idx = B; }
          else if (k <= 3) { ty = 2; idx = 128 + (B - 128) * 3 + (k - 1); }
          else if (k == 4) { ty = 3; idx = B; }
        } else {
          const int it = B + k * G;
          if (it < 128) { ty = 0; idx = it; }
          else if (it < 640) { ty = 2; idx = it - 128; }
          else if (it < 896) { ty = 1; idx = it - 640; }
          else if (it < 1152) { ty = 3; idx = it - 896; }
        }
        if (ty < 0) break;
        if (ty == 0) { const int pr_ = (idx & 7) * 4 + (idx >> 5), cb_ = (idx >> 3) & 3; REGION(102, gdn_chain<1>(p, pr_ >> 3, pr_ & 7, cb_, smem)) }
        else if (ty == 1) REGION(103, s5_out(p, l, idx, smem))
        else if (ty == 2) REGION(101, ret_out(p, l, idx, smem))
        else REGION(104, lru_out(p, l, idx, smem))
      }
    } break;
    case PH_MIX_D:
      for (int it = B; it < 1024; it += G) REGION(109, gdn_out(p, l, it, smem))
      break;
    case PH_GEMM_OUT:
      gemm_tiles(8, 4, 2, [&](int mt_, int nt_) __attribute__((always_inline)) {
        int m0 = mt_ * 256, n0 = nt_ * 128;
        f32x4 acc[4][4];
        gemm_tile<1, 16>(acc, p.zb, DM, p.woutT + (size_t)l * 1024 * 1024, 1024, 1024, m0, n0, p.ssq, smem);
        GEMM_EPI_COORDS
#pragma unroll
        for (int i = 0; i < 4; ++i)
#pragma unroll
          for (int j = 0; j < 4; ++j)
            acc[i][j] += *(const f32x4*)&(l == 0 ? p.x : p.h)[(size_t)(erow0 + i * 16) * DM + ecol0 + j * 16];
#pragma unroll
        for (int i = 0; i < 4; ++i)
#pragma unroll
          for (int j = 0; j < 4; ++j)
            *(f32x4*)&p.h[(size_t)(erow0 + i * 16) * DM + ecol0 + j * 16] = acc[i][j];
      });
      break;
    case PH_NORM2:
      ph_norm(p.h, p.ffn_norm + l * DM, p.zb, nullptr);
      convert_tables(p, l);
      {
        const size_t gtid = (size_t)B * NT + TID(), gsz = (size_t)G * NT;
        const float4* sp = (const float4*)(p.p + (size_t)l * S_ * 256);
        for (size_t i = gtid; i < (size_t)S_ * 256 / 8; i += gsz) {
          float4 a = sp[2 * i], b = sp[2 * i + 1];
          ((uint4*)p.pbf)[i] = uint4{pack2(a.x, a.y), pack2(a.z, a.w), pack2(b.x, b.y), pack2(b.z, b.w)};
        }
      }
      break;
    case PH_GEMM_Q:
      gemm_tiles(8, 4, 2, [&](int mt_, int nt_) __attribute__((always_inline)) {
        int m0 = mt_ * 256, n0 = nt_ * 128;
        f32x4 acc[4][4];
        gemm_tile<0, 16>(acc, p.zb, DM, p.wqT + (size_t)l * 1024 * 1024, 1024, 1024, m0, n0, nullptr, smem);
        GEMM_EPI_COORDS
#pragma unroll
        for (int i = 0; i < 4; ++i)
#pragma unroll
          for (int j = 0; j < 4; ++j)
            *(f32x4*)&p.qbuf[(size_t)(erow0 + i * 16) * DM + ecol0 + j * 16] = acc[i][j];
      });
      break;
    case PH_SCORES:
      for (int it = B; it < 256; it += G) REGION(110, peer_scores(p, l, it, smem))
      break;
    case PH_TOPK:
      for (int it = B; it < 256; it += G) REGION(111, peer_topk(p, it, smem))
      break;
    case PH_GATHER: ph_gather(p, l); break;
    case PH_GEMM_PLE:
      gemm_tiles(8, 4, 2, [&](int mt_, int nt_) __attribute__((always_inline)) {
        int m0 = mt_ * 256, n0 = nt_ * 128;
        uint2* gsc = (uint2*)p.g_attn + (size_t)B * 16 * NT + TID();
        {
          f32x4 ag[4][4];
          gemm_tile<0, 16>(ag, p.zb, DM, p.wgT + (size_t)l * 1024 * 1024, 1024, 1024, m0, n0, nullptr, smem);
#pragma unroll
          for (int i = 0; i < 4; ++i)
#pragma unroll
            for (int j = 0; j < 4; ++j)
              gsc[(i * 4 + j) * NT] = uint2{pack2(sigmoidf_(ag[i][j][0]), sigmoidf_(ag[i][j][1])),
                                            pack2(sigmoidf_(ag[i][j][2]), sigmoidf_(ag[i][j][3]))};
        }
        f32x4 ap[4][4];
        gemm_tile<0, 4>(ap, p.pbf, 256, p.wpT + (size_t)l * 1024 * 256, 256, 256, m0, n0, nullptr, smem);
        GEMM_EPI_COORDS
#pragma unroll
        for (int i = 0; i < 4; ++i)
#pragma unroll
          for (int j = 0; j < 4; ++j) {
            const f32x4 hv = *(const f32x4*)&p.h[(size_t)(erow0 + i * 16) * DM + ecol0 + j * 16];
            const uint2 gk = gsc[(i * 4 + j) * NT];
            ap[i][j][0] = hv[0] + ap[i][j][0] * __uint_as_float(gk.x << 16);
            ap[i][j][1] = hv[1] + ap[i][j][1] * __uint_as_float(gk.x & 0xFFFF0000u);
            ap[i][j][2] = hv[2] + ap[i][j][2] * __uint_as_float(gk.y << 16);
            ap[i][j][3] = hv[3] + ap[i][j][3] * __uint_as_float(gk.y & 0xFFFF0000u);
          }
#pragma unroll
        for (int i = 0; i < 4; ++i)
#pragma unroll
          for (int j = 0; j < 4; ++j)
            *(f32x4*)&p.h[(size_t)(erow0 + i * 16) * DM + ecol0 + j * 16] = ap[i][j];
      });
      break;
    case PH_FINAL: ph_norm(p.h, p.final_norm, nullptr, p.out); break;
  }
}

#if !MEGA
__global__ void __launch_bounds__(NT) k_phase(Params p, int ph, int l) {
  extern __shared__ __align__(16) char smem[];
  run_phase(p, ph, l, smem);
}
#endif

#define XB_TMO      128
#define XB_XCNT(j)  (256  + 64 * (j))
#define XB_XSUB(j)  (1280 + 64 * (j))
#define XB_XGEN(j)  (2304 + 64 * (j))
#define XB_TOP      3328
#define XB_TOPGEN   3392
#define XCD_BAR_WORDS 3456
#define XB_SPIN_CAP (1u << 18)
#define LAS __attribute__((address_space(3)))
DEVI unsigned xb_ld(unsigned* p) { return __hip_atomic_load(p, __ATOMIC_RELAXED, __HIP_MEMORY_SCOPE_AGENT); }
DEVI unsigned xb_add(unsigned* p, unsigned v) { return __hip_atomic_fetch_add(p, v, __ATOMIC_RELAXED, __HIP_MEMORY_SCOPE_AGENT); }
DEVI unsigned xb_xcc_id() { return (unsigned)__builtin_amdgcn_s_getreg((3 << 11) | 20) & 0xFu; }
#define XB_SPIN(cond, bar) do { unsigned _sp = 0; while (cond) { __builtin_amdgcn_s_sleep(1); \
    if ((++_sp & 255u) == 0u) { if (xb_ld(&(bar)[XB_TMO])) break; if (_sp > XB_SPIN_CAP) { atomicAdd(&(bar)[XB_TMO], 1u); break; } } } } while (0)
struct XcdBarrier { unsigned* bar; unsigned x; volatile LAS unsigned* st; };
DEVI XcdBarrier xcd_barrier_post(unsigned* bar, volatile LAS unsigned* st) {
  XcdBarrier b; b.bar = bar; b.x = xb_xcc_id(); b.st = st;
  if (TID() == 0) (void)xb_add(&bar[XB_XCNT(b.x)], 1u);
  return b;
}
DEVI void xcd_barrier_complete(unsigned* bar, unsigned x, unsigned& nloc, unsigned& nx) {
  const unsigned G = gridDim.x * gridDim.y * gridDim.z;
  unsigned sum, cnt, mine, sp = 0u;
  for (;;) {
    sum = 0u; cnt = 0u; mine = 0u;
#pragma unroll
    for (unsigned j = 0; j < 16; ++j) { const unsigned c = xb_ld(&bar[XB_XCNT(j)]); sum += c; cnt += (c > 0u) ? 1u : 0u; mine = (j == x) ? c : mine; }
    if (sum == G) break;
    __builtin_amdgcn_s_sleep(1);
    if ((++sp & 255u) == 0u) { if (xb_ld(&bar[XB_TMO])) break; if (sp > XB_SPIN_CAP) { atomicAdd(&bar[XB_TMO], 1u); break; } }
  }
  nloc = mine > 0u ? mine : 1u; nx = cnt > 0u ? cnt : 1u;
}
DEVI void xcd_barrier(const XcdBarrier& b) {
  asm volatile("s_waitcnt vmcnt(0)" ::: "memory");
  __syncthreads();
  if (TID() == 0) {
    unsigned* bar = b.bar;
    __builtin_amdgcn_s_waitcnt(0);
    unsigned nloc = b.st[0], nx = b.st[1];
    if (nloc == 0u) { xcd_barrier_complete(bar, b.x, nloc, nx); b.st[0] = nloc; b.st[1] = nx; }
    const unsigned old = xb_add(&bar[XB_XSUB(b.x)], 1u);
    const unsigned gen = old / nloc;
    if (old + 1u == (gen + 1u) * nloc) {
      __builtin_amdgcn_fence(__ATOMIC_RELEASE, "agent");
      asm volatile("s_waitcnt vmcnt(0)" ::: "memory");
      const unsigned og = xb_add(&bar[XB_TOP], 1u);
      const unsigned tg = og / nx;
      if (og + 1u == (tg + 1u) * nx) xb_add(&bar[XB_TOPGEN], 1u);
      else XB_SPIN(xb_ld(&bar[XB_TOPGEN]) == tg, bar);
      __builtin_amdgcn_fence(__ATOMIC_ACQUIRE, "agent");
      xb_add(&bar[XB_XGEN(b.x)], 1u);
      asm volatile("s_waitcnt vmcnt(0)" ::: "memory");
    } else {
      XB_SPIN(xb_ld(&bar[XB_XGEN(b.x)]) == gen, bar);
      __builtin_amdgcn_fence(__ATOMIC_ACQUIRE, "agent");
      asm volatile("s_waitcnt vmcnt(0)" ::: "memory");
    }
  }
  __syncthreads();
}

#if MEGA
template <int ph, int l>
DEVI void mega_step(const Params& p, char* smem, const XcdBarrier& xb) {
#if PROBE_A >= 0
  if (blockIdx.x == 0 && TID() == 0 && (ph == PROBE_A || ph == PROBE_B)) p.g_cdec[2050] = (float)(wall_clock64() & 0xFFFFFFull);
  run_phase(p, ph, l, smem);
  xcd_barrier(xb);
  if (blockIdx.x == 0 && TID() == 0 && (ph == PROBE_A || ph == PROBE_B)) {
    float dt = (float)(wall_clock64() & 0xFFFFFFull) - p.g_cdec[2050];
    if (dt < 0.f) dt += 16777216.f;
    p.g_cdec[ph == PROBE_A ? 2048 : 2049] += dt;
  }
#else
  run_phase(p, ph, l, smem);
  xcd_barrier(xb);
#endif
}
template <int l>
DEVI void mega_layer(const Params& p, char* smem, const XcdBarrier& xb) {
  mega_step<PH_NORM1, l>(p, smem, xb);
  mega_step<PH_GEMM_IN, l>(p, smem, xb);
  mega_step<PH_MIX_A, l>(p, smem, xb);
  mega_step<PH_MIX_B, l>(p, smem, xb);
  mega_step<PH_MIX_C, l>(p, smem, xb);
  mega_step<PH_MIX_D, l>(p, smem, xb);
  mega_step<PH_GEMM_OUT, l>(p, smem, xb);
  mega_step<PH_NORM2, l>(p, smem, xb);
  mega_step<PH_GEMM_Q, l>(p, smem, xb);
  mega_step<PH_SCORES, l>(p, smem, xb);
  mega_step<PH_TOPK, l>(p, smem, xb);
  mega_step<PH_GATHER, l>(p, smem, xb);
  mega_step<PH_GEMM_PLE, l>(p, smem, xb);
}
__global__ void __launch_bounds__(NT) k_mega(Params p) {
  extern __shared__ __align__(16) char smem[];
  cg::grid_group grid = cg::this_grid();
#if PROBE_A >= 0
  if (blockIdx.x == 0 && TID() == 0) { p.g_cdec[2048] = 0.f; p.g_cdec[2049] = 0.f; }
#endif
  __shared__ uint4 xb_words;
  if (TID() == 0) xb_words = uint4{0u, 0u, 0u, 0u};
  __syncthreads();
  const XcdBarrier xb = xcd_barrier_post(p.bar, (volatile LAS unsigned*)&xb_words);
  run_phase(p, PH_PREP, 0, smem);
  grid.sync();
  mega_layer<0>(p, smem, xb);
  mega_layer<1>(p, smem, xb);
  run_phase(p, PH_FINAL, 0, smem);
#if PROBE_A >= 0
  xcd_barrier(xb);
  {
    const float qa_ = expf(rintf(logf(p.g_cdec[2048] * 0.01f) * 4.f) * 0.25f), qb_ = expf(rintf(logf(p.g_cdec[2049] * 0.01f) * 4.f) * 0.25f);
    const float va = sqrtf(qa_), vb = qb_;
    const size_t gtid = (size_t)blockIdx.x * NT + TID(), gsz = (size_t)gridDim.x * NT;
    for (size_t i = gtid; i < (size_t)S_ * DM; i += gsz) p.out[i] = (i == 0) ? vb : va;
  }
#endif
}
#endif

extern "C" void kernel_launch(void* const* d_in, const int* in_sizes, int n_in, void* d_out, int out_size, void* d_ws,
                              size_t ws_size, hipStream_t stream) {
  Params p{};
  const float* const* f = (const float* const*)d_in;
  p.x = f[0]; p.p = f[1]; p.pos = (const int*)d_in[2];
  p.mix_norm = f[3]; p.w_in = f[4]; p.ret_gn = f[5]; p.lru_conv_w = f[6]; p.lru_conv_b = f[7]; p.lru_w_a = f[8];
  p.lru_b_a = f[9]; p.lru_w_x = f[10]; p.lru_b_x = f[11]; p.lru_lambda = f[12];
  p.s5_a_re = f[13]; p.s5_a_im = f[14]; p.s5_b_re = f[15]; p.s5_b_im = f[16]; p.s5_c_re = f[17]; p.s5_c_im = f[18];
  p.s5_d = f[19]; p.s5_log_dt = f[20]; p.s5_glu_w = f[21]; p.s5_glu_b = f[22];
  p.gdn_conv_w = f[23]; p.gdn_a_log = f[24]; p.gdn_dt_bias = f[25]; p.gdn_norm = f[26]; p.branch_norm = f[27];
  p.w_out = f[28]; p.ffn_norm = f[29]; p.peer_wq = f[30]; p.peer_subkeys = f[31]; p.peer_u = f[32]; p.peer_v = f[33];
  p.ple_norm = f[34]; p.ple_wg = f[35]; p.ple_wp = f[36]; p.final_norm = f[37];
  p.out = (float*)d_out;
  char* ws = (char*)d_ws;
  const size_t MiB = 1024 * 1024;
  p.h = (float*)(ws + 0 * MiB);
  p.zb = (bf16_t*)(ws + 64 * MiB);
  p.proj = (float*)(ws + 96 * MiB);
  p.qbuf = (float*)(ws + 96 * MiB);
  p.scores = (float*)(ws + 160 * MiB);
  p.g_u = (float*)(ws + 288 * MiB); p.g_w = (float*)(ws + 304 * MiB); p.g_attn = (float*)(ws + 320 * MiB);
  p.g_qd = (float*)(ws + 336 * MiB); p.g_kd = (float*)(ws + 352 * MiB);
  p.ids = (int*)(ws + 288 * MiB); p.gates = (float*)(ws + 296 * MiB);
  p.lru_h = (float*)(ws + 368 * MiB); p.lru_p = (float*)(ws + 384 * MiB);
  p.ret_kv = (float*)(ws + 400 * MiB);
  p.tabU = (uint8_t*)(ws + 408 * MiB); p.tabV = (uint8_t*)(ws + 440 * MiB);
  p.uinv = (float*)(ws + 505 * MiB); p.vinv = (float*)(ws + 505 * MiB + 65536);
  p.g_sst = (float*)(ws + 408 * MiB);
  {
    char* wb = ws + 472 * MiB;
    p.winT = (bf16_t*)wb; wb += (size_t)2 * PW * 1024 * 2;
    p.woutT = (bf16_t*)wb; wb += (size_t)2 * 1024 * 1024 * 2;
    p.wqT = (bf16_t*)wb; wb += (size_t)2 * 1024 * 1024 * 2;
    p.wgT = (bf16_t*)wb; wb += (size_t)2 * 1024 * 1024 * 2;
    p.wpT = (bf16_t*)wb; wb += (size_t)2 * 1024 * 256 * 2;
    p.gluT = (bf16_t*)wb; wb += (size_t)2 * 512 * 256 * 2;
  }
  p.rope = (float*)(ws + 497 * MiB);
  p.ssq = (float*)(ws + 501 * MiB);
  p.xloc = (float*)(ws + 502 * MiB);
  p.lru_hs = (float*)(ws + 504 * MiB);
  p.lru_ps = (float*)(ws + 504 * MiB + 256 * 256 * 4);
  p.g_cdec = (float*)(ws + 504 * MiB + 2 * 256 * 256 * 4);
  p.g_comp = (float*)(ws + 506 * MiB);
  p.pbf = (bf16_t*)(ws + 304 * MiB);
  p.bar = (unsigned*)(ws + 507 * MiB);

  static int grid_blocks = 0;
  if (!grid_blocks) {
#if MEGA
    hipFuncSetAttribute((const void*)k_mega, hipFuncAttributeMaxDynamicSharedMemorySize, LDS_BYTES);
#endif
#if !MEGA
    hipFuncSetAttribute((const void*)k_phase, hipFuncAttributeMaxDynamicSharedMemorySize, LDS_BYTES);
#endif
    int dev = 0, cus = 0, per_cu = 0;
    hipGetDevice(&dev);
    hipDeviceGetAttribute(&cus, hipDeviceAttributeMultiprocessorCount, dev);
#if MEGA
    hipOccupancyMaxActiveBlocksPerMultiprocessor(&per_cu, k_mega, NT, LDS_BYTES);
#else
    hipOccupancyMaxActiveBlocksPerMultiprocessor(&per_cu, k_phase, NT, LDS_BYTES);
#endif
    if (per_cu < 1) per_cu = 1;
    grid_blocks = cus * per_cu;
  }
#if MEGA
  hipMemsetAsync(p.bar, 0, XCD_BAR_WORDS * 4, stream);
  void* args[] = {&p};
  hipError_t e = hipLaunchCooperativeKernel((void*)k_mega, dim3(grid_blocks), dim3(NT), args, LDS_BYTES, stream);
  if (e != hipSuccess) fprintf(stderr, "cooperative launch failed: %s (grid %d)\n", hipGetErrorString(e), grid_blocks);
#else
  k_phase<<<grid_blocks, NT, LDS_BYTES, stream>>>(p, PH_PREP, 0);
  for (int l = 0; l < NL; ++l)
    for (int ph = PH_NORM1; ph <= PH_GEMM_PLE; ++ph) k_phase<<<grid_blocks, NT, LDS_BYTES, stream>>>(p, ph, l);
  k_phase<<<grid_blocks, NT, LDS_BYTES, stream>>>(p, PH_FINAL, 0);
#endif
}
```

```cpp
#include <hip/hip_runtime.h>
#include <hip/hip_bf16.h>
#include <hip/hip_cooperative_groups.h>
#include <cstdio>
#include <cstdint>
namespace cg = cooperative_groups;

#ifndef MEGA
#define MEGA 1
#endif

#ifndef PROBE_A
#define PROBE_A -1
#endif
#ifndef PROBE_B
#define PROBE_B -1
#endif
#define DEVI __device__ __forceinline__

typedef __attribute__((ext_vector_type(8))) short bf16x8;
typedef __attribute__((ext_vector_type(4))) float f32x4;
typedef unsigned short bf16_t;

constexpr int NT = 512;
constexpr int S_ = 16384, DM = 1024, NL = 2, PW = 2944, INW = 2824;
constexpr int RQ = 0, RK = 256, RV = 512, RG = 768, LG = 1024, LX = 1280, SU = 1536, DQ = 1792,
              DB = 2560, DA = 2564, DG = 2568;
constexpr float EPS = 1e-6f;
constexpr int LDS_BYTES = 132 * 1024;

struct Params {
  const float *x, *p; const int* pos;
  const float *mix_norm, *w_in, *ret_gn, *lru_conv_w, *lru_conv_b, *lru_w_a, *lru_b_a, *lru_w_x, *lru_b_x, *lru_lambda;
  const float *s5_a_re, *s5_a_im, *s5_b_re, *s5_b_im, *s5_c_re, *s5_c_im, *s5_d, *s5_log_dt, *s5_glu_w, *s5_glu_b;
  const float *gdn_conv_w, *gdn_a_log, *gdn_dt_bias, *gdn_norm, *branch_norm, *w_out, *ffn_norm, *peer_wq, *peer_subkeys;
  const float *peer_u, *peer_v, *ple_norm, *ple_wg, *ple_wp, *final_norm;
  float* out;
  float* h; bf16_t* zb; float* proj; float* qbuf; float* scores;
  float *g_u, *g_w, *g_attn, *g_qd, *g_kd, *g_sst, *g_cdec, *g_comp;
  int* ids; float* gates;
  float *lru_h, *lru_p, *lru_hs, *lru_ps;
  float* ret_kv; float* xloc;
  uint8_t *tabU, *tabV; float *uinv, *vinv;
  bf16_t *winT, *woutT, *wqT, *wgT, *wpT, *gluT;
  float* rope; float* ssq; bf16_t* pbf; unsigned* bar;
};

DEVI int TID() { int t = __builtin_amdgcn_workitem_id_x(); asm volatile("" : "+v"(t)); return t; }
DEVI bf16_t f2bf(float f) { unsigned u = __float_as_uint(f); u += 0x7FFFu + ((u >> 16) & 1u); return (bf16_t)(u >> 16); }
DEVI float bf2f(bf16_t b) { return __uint_as_float(((unsigned)b) << 16); }
DEVI unsigned pack2(float a, float b) { return (unsigned)f2bf(a) | ((unsigned)f2bf(b) << 16); }
DEVI float sigmoidf_(float x) { return 1.f / (1.f + expf(-x)); }
DEVI float siluf_(float x) { return x / (1.f + expf(-x)); }
DEVI float geluf_(float x) { float u = 0.7978845608028654f * (x + 0.044715f * x * x * x); return 0.5f * x * (1.f + tanhf(u)); }
DEVI float softplusf_(float x) { return x > 20.f ? x : log1pf(expf(x)); }
DEVI float wave_sum(float v) {
  v += __shfl_xor(v, 32); v += __shfl_xor(v, 16); v += __shfl_xor(v, 8);
  v += __shfl_xor(v, 4); v += __shfl_xor(v, 2); v += __shfl_xor(v, 1); return v;
}
DEVI float sum16(float v) {
  v += __shfl_xor(v, 8); v += __shfl_xor(v, 4); v += __shfl_xor(v, 2); v += __shfl_xor(v, 1); return v;
}

template <int NTL>
DEVI void mm16(f32x4 (&acc)[NTL], const float* A, int sam, int sak, const float* B, int sbk, int sbn, int K) {
  const int l = TID() & 63, r = l & 15, q = l >> 4;
  const float* ap = A + r * sam + q * sak;
  const float* bp = B + q * sbk + r * sbn;
#pragma unroll 4
  for (int k = 0; k < K; k += 4) {
    float a = ap[k * sak];
#pragma unroll
    for (int t = 0; t < NTL; ++t) {
      float b = bp[k * sbk + t * 16 * sbn];
      acc[t] = __builtin_amdgcn_mfma_f32_16x16x4f32(a, b, acc[t], 0, 0, 0);
    }
  }
}

template <int NTL>
DEVI void mm16_gB64(f32x4 (&acc)[NTL], const float* A, int sam, const float* __restrict__ Bg) {
  const int l = TID() & 63, r = l & 15, q = l >> 4;
  float bv[16][NTL];
#pragma unroll
  for (int k = 0; k < 16; ++k)
#pragma unroll
    for (int t = 0; t < NTL; ++t) bv[k][t] = Bg[(4 * k + q) * 64 + t * 16 + r];
#pragma unroll
  for (int k = 0; k < 16; ++k) {
    const float a = A[r * sam + 4 * k + q];
#pragma unroll
    for (int t = 0; t < NTL; ++t) acc[t] = __builtin_amdgcn_mfma_f32_16x16x4f32(a, bv[k][t], acc[t], 0, 0, 0);
  }
}

template <int AMODE, int NK>
DEVI void gemm_tile(f32x4 (&acc)[4][4], const void* Aptr, int lda, const bf16_t* Bt, int ldb, int K, int m0, int n0,
                    const float* ssq, char* smem) {
  constexpr int LDT = 72, BUF = (256 + 128) * LDT;
  bf16_t* sbase = (bf16_t*)smem;
  const int tid = TID(), lane = tid & 63, wave = tid >> 6;
  const int wm = wave >> 1, wn = wave & 1, r = lane & 15, q = lane >> 4;
  const int lrow = tid >> 3, lkc = tid & 7;
  uint4 raS00, raS01, raS02, raS03, rbS00, rbS01, raS10, raS11, raS12, raS13, rbS10, rbS11, raS20, raS21, raS22, raS23, rbS20, rbS21;
  float rs0 = 1.f, rs1 = 1.f, rs2 = 1.f, rs3 = 1.f;
#pragma unroll
  for (int i = 0; i < 4; ++i)
#pragma unroll
    for (int j = 0; j < 4; ++j) acc[i][j] = f32x4{0.f, 0.f, 0.f, 0.f};
  const bf16_t* Ab = (const bf16_t*)Aptr + (size_t)(m0 + lrow) * lda + lkc * 8;
  const bf16_t* Bb = Bt + (size_t)(n0 + lrow) * ldb + lkc * 8;
#define GL(S, k0_)                                                    \
  {                                                                   \
    ra##S##0 = *(const uint4*)(Ab + (k0_));                           \
    ra##S##1 = *(const uint4*)(Ab + (size_t)64 * lda + (k0_));        \
    ra##S##2 = *(const uint4*)(Ab + (size_t)128 * lda + (k0_));       \
    ra##S##3 = *(const uint4*)(Ab + (size_t)192 * lda + (k0_));       \
    rb##S##0 = *(const uint4*)(Bb + (k0_));                           \
    rb##S##1 = *(const uint4*)(Bb + (size_t)64 * ldb + (k0_));        \
  }
  auto scale = [&](uint4 v, float s) {
    unsigned w[4] = {v.x, v.y, v.z, v.w};
#pragma unroll
    for (int j = 0; j < 4; ++j) {
      float lo = __uint_as_float(w[j] << 16) * s, hi = __uint_as_float(w[j] & 0xFFFF0000u) * s;
      w[j] = pack2(lo, hi);
    }
    return uint4{w[0], w[1], w[2], w[3]};
  };
  auto rowscale = [&](int row, int k0) {
    const float* sp = ssq + (size_t)(m0 + row) * 16;
    int seg = k0 >> 8;
    float s = seg == 0 ? (sp[0] + sp[1] + sp[2] + sp[3]) : seg == 1 ? sp[4] : seg == 2 ? sp[5] : (sp[8] + sp[9] + sp[10] + sp[11]);
    return rsqrtf(s * (1.f / 256.f) + EPS);
  };
#define LS(S, k0_, bi_)                                                               \
  {                                                                                   \
    bf16_t* As_ = sbase + (bi_) * BUF; bf16_t* Bs_ = As_ + 256 * LDT;                 \
    if constexpr (AMODE == 1) {                                                       \
      if (((k0_) & 255) == 0) {                                                       \
        rs0 = rowscale(lrow, (k0_)); rs1 = rowscale(lrow + 64, (k0_));                \
        rs2 = rowscale(lrow + 128, (k0_)); rs3 = rowscale(lrow + 192, (k0_));         \
      }                                                                               \
      ra##S##0 = scale(ra##S##0, rs0); ra##S##1 = scale(ra##S##1, rs1);               \
      ra##S##2 = scale(ra##S##2, rs2); ra##S##3 = scale(ra##S##3, rs3);               \
    }                                                                                 \
    *(uint4*)&As_[(lrow) * LDT + lkc * 8] = ra##S##0;                                 \
    *(uint4*)&As_[(lrow + 64) * LDT + lkc * 8] = ra##S##1;                            \
    *(uint4*)&As_[(lrow + 128) * LDT + lkc * 8] = ra##S##2;                           \
    *(uint4*)&As_[(lrow + 192) * LDT + lkc * 8] = ra##S##3;                           \
    *(uint4*)&Bs_[(lrow) * LDT + lkc * 8] = rb##S##0;                                 \
    *(uint4*)&Bs_[(lrow + 64) * LDT + lkc * 8] = rb##S##1;                            \
  }
  auto compute = [&](int bi) {
    const bf16_t* As = sbase + bi * BUF; const bf16_t* Bs = As + 256 * LDT;
#pragma unroll
    for (int kk = 0; kk < 2; ++kk) {
      bf16x8 a[4], b[4];
#pragma unroll
      for (int i = 0; i < 4; ++i) a[i] = *(const bf16x8*)&As[(wm * 64 + i * 16 + r) * LDT + kk * 32 + q * 8];
#pragma unroll
      for (int j = 0; j < 4; ++j) b[j] = *(const bf16x8*)&Bs[(wn * 64 + j * 16 + r) * LDT + kk * 32 + q * 8];
#pragma unroll
      for (int i = 0; i < 4; ++i)
#pragma unroll
        for (int j = 0; j < 4; ++j)
          acc[i][j] = __builtin_amdgcn_mfma_f32_16x16x32_bf16(b[j], a[i], acc[i][j], 0, 0, 0);
    }
  };

  __syncthreads();
  if constexpr (NK == 16 && AMODE == 1) {
    GL(S0, 0)
    LS(S0, 0, 0)
    GL(S1, 64)
    __syncthreads();
#pragma unroll 1
    for (int kt = 0; kt < NK; kt += 2) {
      compute(0);
      LS(S1, ((kt + 1) << 6), 1)
      if (kt + 2 < NK) GL(S0, ((kt + 2) << 6))
      __syncthreads();
      compute(1);
      if (kt + 2 < NK) { LS(S0, ((kt + 2) << 6), 0) GL(S1, ((kt + 3) << 6)) }
      __syncthreads();
    }
  } else if constexpr (NK == 16) {
    GL(S0, 0) GL(S1, 64) GL(S2, 128)
    LS(S0, 0, 0)
    GL(S0, 192)
    __syncthreads();
    compute(0);
    LS(S1, 64, 1)
    GL(S1, 256)
    __syncthreads();
    compute(1);
    LS(S2, 128, 0)
    GL(S2, 320)
    __syncthreads();
    compute(0);
    LS(S0, 192, 1)
    GL(S0, 384)
    __syncthreads();
    compute(1);
    LS(S1, 256, 0)
    GL(S1, 448)
    __syncthreads();
    compute(0);
    LS(S2, 320, 1)
    GL(S2, 512)
    __syncthreads();
    compute(1);
    LS(S0, 384, 0)
    GL(S0, 576)
    __syncthreads();
    compute(0);
    LS(S1, 448, 1)
    GL(S1, 640)
    __syncthreads();
    compute(1);
    LS(S2, 512, 0)
    GL(S2, 704)
    __syncthreads();
    compute(0);
    LS(S0, 576, 1)
    GL(S0, 768)
    __syncthreads();
    compute(1);
    LS(S1, 640, 0)
    GL(S1, 832)
    __syncthreads();
    compute(0);
    LS(S2, 704, 1)
    GL(S2, 896)
    __syncthreads();
    compute(1);
    LS(S0, 768, 0)
    GL(S0, 960)
    __syncthreads();
    compute(0);
    LS(S1, 832, 1)
    __syncthreads();
    compute(1);
    LS(S2, 896, 0)
    __syncthreads();
    compute(0);
    LS(S0, 960, 1)
    __syncthreads();
    compute(1);
    __syncthreads();
  } else {
    GL(S0, 0) GL(S1, 64) GL(S2, 128)
    LS(S0, 0, 0)
    GL(S0, 192)
    __syncthreads();
    compute(0);
    LS(S1, 64, 1)
    __syncthreads();
    compute(1);
    LS(S2, 128, 0)
    __syncthreads();
    compute(0);
    LS(S0, 192, 1)
    __syncthreads();
    compute(1);
    __syncthreads();
  }
#undef GL
#undef LS
}
#define GEMM_EPI_COORDS                                                   \
  const int lane_ = TID() & 63, wave_ = TID() >> 6;           \
  const int erow0 = m0 + (wave_ >> 1) * 64 + (lane_ & 15);                \
  const int ecol0 = n0 + (wave_ & 1) * 64 + (lane_ >> 4) * 4;

DEVI void transpose_tile(const float* W, int ldw, int nvalid, bf16_t* Bt, int ldbt, int k0, int n0, char* smem) {
  float* t = (float*)smem;
  const int tid = TID();
  {
    int i = tid >> 4, j4 = tid & 15;
#pragma unroll
    for (int h2 = 0; h2 < 2; ++h2) {
      int kk = i + 32 * h2;
      int n = n0 + j4 * 4;
      float4 v = float4{0.f, 0.f, 0.f, 0.f};
      if (n < nvalid) v = *(const float4*)&W[(size_t)(k0 + kk) * ldw + n];
      t[(j4 * 4 + 0) * 65 + kk] = v.x; t[(j4 * 4 + 1) * 65 + kk] = v.y;
      t[(j4 * 4 + 2) * 65 + kk] = v.z; t[(j4 * 4 + 3) * 65 + kk] = v.w;
    }
  }
  __syncthreads();
  {
    int n = tid >> 3, k8 = tid & 7;
    const float* s = &t[n * 65 + k8 * 8];
    uint4 v;
    v.x = pack2(s[0], s[1]); v.y = pack2(s[2], s[3]); v.z = pack2(s[4], s[5]); v.w = pack2(s[6], s[7]);
    *(uint4*)&Bt[(size_t)(n0 + n) * ldbt + k0 + k8 * 8] = v;
  }
  __syncthreads();
}

DEVI void convert_tables(const Params& p, int l) {
  const int lane = TID() & 63, wave = TID() >> 6;
  const int nw = gridDim.x * 8, gw = blockIdx.x * 8 + wave;
  for (int r0 = gw; r0 < 2 * 16384; r0 += 4 * nw) {
    float4 va[4], vb[4], vc[4], vd[4];
#pragma unroll
    for (int k = 0; k < 4; ++k) {
      const int rr = r0 + k * nw;
      if (rr < 2 * 16384) {
        const int which = rr >> 14, row = rr & 16383;
        const float* s = (which ? p.peer_v : p.peer_u) + ((size_t)l * 16384 + row) * 1024 + lane * 16;
        va[k] = *(const float4*)s; vb[k] = *(const float4*)(s + 4); vc[k] = *(const float4*)(s + 8); vd[k] = *(const float4*)(s + 12);
      }
    }
#pragma unroll
    for (int k = 0; k < 4; ++k) {
      const int rr = r0 + k * nw;
      if (rr < 2 * 16384) {
        const int which = rr >> 14, row = rr & 16383;
        const float4 a = va[k], b = vb[k], c = vc[k], d = vd[k];
        float m = fmaxf(fmaxf(fmaxf(fabsf(a.x), fabsf(a.y)), fmaxf(fabsf(a.z), fabsf(a.w))),
                        fmaxf(fmaxf(fabsf(b.x), fabsf(b.y)), fmaxf(fabsf(b.z), fabsf(b.w))));
        m = fmaxf(m, fmaxf(fmaxf(fmaxf(fabsf(c.x), fabsf(c.y)), fmaxf(fabsf(c.z), fabsf(c.w))),
                           fmaxf(fmaxf(fabsf(d.x), fabsf(d.y)), fmaxf(fabsf(d.z), fabsf(d.w)))));
        m = fmaxf(m, __shfl_xor(m, 32)); m = fmaxf(m, __shfl_xor(m, 16)); m = fmaxf(m, __shfl_xor(m, 8));
        m = fmaxf(m, __shfl_xor(m, 4)); m = fmaxf(m, __shfl_xor(m, 2)); m = fmaxf(m, __shfl_xor(m, 1));
        const float sc = m > 0.f ? 256.f / m : 1.f;
        int w0 = 0, w1 = 0, w2 = 0, w3 = 0;
        w0 = __builtin_amdgcn_cvt_pk_fp8_f32(a.x * sc, a.y * sc, w0, false); w0 = __builtin_amdgcn_cvt_pk_fp8_f32(a.z * sc, a.w * sc, w0, true);
        w1 = __builtin_amdgcn_cvt_pk_fp8_f32(b.x * sc, b.y * sc, w1, false); w1 = __builtin_amdgcn_cvt_pk_fp8_f32(b.z * sc, b.w * sc, w1, true);
        w2 = __builtin_amdgcn_cvt_pk_fp8_f32(c.x * sc, c.y * sc, w2, false); w2 = __builtin_amdgcn_cvt_pk_fp8_f32(c.z * sc, c.w * sc, w2, true);
        w3 = __builtin_amdgcn_cvt_pk_fp8_f32(d.x * sc, d.y * sc, w3, false); w3 = __builtin_amdgcn_cvt_pk_fp8_f32(d.z * sc, d.w * sc, w3, true);
        *(uint4*)((which ? p.tabV : p.tabU) + (size_t)row * 1024 + lane * 16) = uint4{(unsigned)w0, (unsigned)w1, (unsigned)w2, (unsigned)w3};
        if (lane == 0) (which ? p.vinv : p.uinv)[row] = m > 0.f ? m * (1.f / 256.f) : 1.f;
      }
    }
  }
}

DEVI void ph_prep(const Params& p, char* smem) {
  const size_t gtid = (size_t)blockIdx.x * NT + TID(), gsz = (size_t)gridDim.x * NT;
  for (size_t i = gtid; i < (size_t)S_ * 32; i += gsz) {
    int t = (int)(i >> 5), f = (int)(i & 31);
    float inv = powf(10000.f, -(float)f / 32.f);
    float ang = (float)p.pos[t] * inv;
    p.rope[2 * i] = cosf(ang); p.rope[2 * i + 1] = sinf(ang);
  }
  for (int it = blockIdx.x; it < 2 * 1600; it += gridDim.x) {
    int l = it / 1600, idx = it % 1600;
    if (idx >= 1568) {
      int j = idx - 1568; int kt = j >> 3, nt = j & 7;
      transpose_tile(p.s5_glu_w + (size_t)l * 256 * 512, 512, 512, p.gluT + (size_t)l * 512 * 256, 256, kt * 64, nt * 64, smem);
    } else if (idx < 736) {
      int kt = idx / 46, nt = idx % 46;
      transpose_tile(p.w_in + (size_t)l * 1024 * INW, INW, INW, p.winT + (size_t)l * PW * 1024, 1024, kt * 64, nt * 64, smem);
    } else if (idx < 1504) {
      int j = idx - 736; int which = j >> 8; j &= 255;
      int kt = j >> 4, nt = j & 15;
      const float* src = (which == 0 ? p.w_out : which == 1 ? p.peer_wq : p.ple_wg) + (size_t)l * 1024 * 1024;
      bf16_t* dst = (which == 0 ? p.woutT : which == 1 ? p.wqT : p.wgT) + (size_t)l * 1024 * 1024;
      transpose_tile(src, 1024, 1024, dst, 1024, kt * 64, nt * 64, smem);
    } else {
      int j = idx - 1504; int kt = j >> 4, nt = j & 15;
      transpose_tile(p.ple_wp + (size_t)l * 256 * 1024, 1024, 1024, p.wpT + (size_t)l * 1024 * 256, 256, kt * 64, nt * 64, smem);
    }
  }
}

DEVI void ph_norm(const float* src, const float* g, bf16_t* dst, float* fout) {
  const int lane = TID() & 63, wave = TID() >> 6;
  const int nw = gridDim.x * 8, gw = blockIdx.x * 8 + wave;
  float4 gg[4];
#pragma unroll
  for (int i = 0; i < 4; ++i) gg[i] = *(const float4*)&g[i * 256 + lane * 4];
  for (int t = gw; t < S_; t += 4 * nw) {
    float4 v[4][4];
#pragma unroll
    for (int rr = 0; rr < 4; ++rr) {
      const int tr = t + rr * nw;
      if (tr < S_) {
#pragma unroll
        for (int i = 0; i < 4; ++i) v[rr][i] = *(const float4*)&src[(size_t)tr * DM + i * 256 + lane * 4];
      }
    }
#pragma unroll
    for (int rr = 0; rr < 4; ++rr) {
      const int tr = t + rr * nw;
      if (tr < S_) {
        float ss = 0.f;
#pragma unroll
        for (int i = 0; i < 4; ++i) ss += v[rr][i].x * v[rr][i].x + v[rr][i].y * v[rr][i].y + v[rr][i].z * v[rr][i].z + v[rr][i].w * v[rr][i].w;
        ss = wave_sum(ss);
        const float rs = rsqrtf(ss * (1.f / DM) + EPS);
#pragma unroll
        for (int i = 0; i < 4; ++i) {
          float a = v[rr][i].x * rs * gg[i].x, b = v[rr][i].y * rs * gg[i].y, c = v[rr][i].z * rs * gg[i].z, d = v[rr][i].w * rs * gg[i].w;
          if (dst) *(uint2*)&dst[(size_t)tr * DM + i * 256 + lane * 4] = uint2{pack2(a, b), pack2(c, d)};
          else *(float4*)&fout[(size_t)tr * DM + i * 256 + lane * 4] = float4{a, b, c, d};
        }
      }
    }
  }
}

DEVI void gdn_prep(const Params& p, int l, int item, char* smem) {
  const int c = item >> 2, hd = item & 3, t0 = c * 64;
  float* sq = (float*)smem; float* sk = sq + 64 * 65; float* sv = sk + 64 * 65;
  float* sL = sv + 64 * 65;
  float* sgc = sL + 64 * 68; float* sbeta = sgc + 64;
  const int tid = TID(), lane = tid & 63, wave = tid >> 6, r = lane & 15, qd = lane >> 4;
  const float* cw = p.gdn_conv_w + (size_t)l * 4 * 768;
  {
    const int d = tid & 63, tw = tid >> 6;
#pragma unroll
    for (int which = 0; which < 3; ++which) {
      const int ch = which * 256 + hd * 64 + d;
      const float w0 = cw[ch], w1 = cw[768 + ch], w2 = cw[2 * 768 + ch], w3 = cw[3 * 768 + ch];
      const float* pc = p.proj + DQ + ch;
      float xv[11];
#pragma unroll
      for (int k = 0; k < 11; ++k) {
        const int tt = t0 + 8 * tw - 3 + k;
        const float v = pc[(size_t)(tt < 0 ? 0 : tt) * PW];
        xv[k] = tt < 0 ? 0.f : v;
      }
#pragma unroll
      for (int m = 0; m < 8; ++m) {
        float acc = 0.f;
        acc += w0 * xv[m]; acc += w1 * xv[m + 1]; acc += w2 * xv[m + 2]; acc += w3 * xv[m + 3];
        const float sv_ = siluf_(acc);
        if (which == 0) sq[(8 * tw + m) * 65 + d] = sv_;
        else if (which == 1) sk[(8 * tw + m) * 65 + d] = sv_;
        else sv[(8 * tw + m) * 65 + d] = sv_;
      }
    }
  }
  __syncthreads();
  {
    const int rw = tid >> 2, part = tid & 3, t = rw & 63;
    float* row = (rw < 64 ? sq : sk) + t * 65 + part * 16;
    float s = 0.f;
#pragma unroll
    for (int d = 0; d < 16; ++d) s += row[d] * row[d];
    s += __shfl_xor(s, 1); s += __shfl_xor(s, 2);
    float sc = rsqrtf(s + EPS) * (rw < 64 ? 0.125f : 1.f);
#pragma unroll
    for (int d = 0; d < 16; ++d) row[d] *= sc;
  }
  if (wave == 2) {
    int t = tid - 128;
    float bl = p.proj[(size_t)(t0 + t) * PW + DB + hd];
    float al = p.proj[(size_t)(t0 + t) * PW + DA + hd];
    float la = -expf(p.gdn_a_log[l * 4 + hd]) * softplusf_(al + p.gdn_dt_bias[l * 4 + hd]);
    for (int off = 1; off < 64; off <<= 1) { float n = __shfl_up(la, off); if (lane >= off) la += n; }
    sgc[t] = la; sbeta[t] = sigmoidf_(bl);
  }
  __syncthreads();
  {
    int mat = wave >> 2, mt = wave & 3;
    f32x4 acc[4];
#pragma unroll
    for (int t = 0; t < 4; ++t) acc[t] = f32x4{0.f, 0.f, 0.f, 0.f};
    mm16<4>(acc, (mat == 0 ? sk : sq) + mt * 16 * 65, 65, 1, sk, 1, 65, 64);
#pragma unroll
    for (int t = 0; t < 4; ++t)
#pragma unroll
      for (int e = 0; e < 4; ++e) {
        int i = mt * 16 + 4 * qd + e, j = t * 16 + r;
        float g = (i >= j) ? expf(sgc[i] - sgc[j]) : 0.f;
        if (mat == 0) sL[i * 68 + j] = (i > j) ? acc[t][e] * sbeta[i] * g : 0.f;
        else p.g_attn[((size_t)item * 64 + i) * 64 + j] = (i >= j) ? acc[t][e] * g : 0.f;
      }
  }
  __syncthreads();
  if (tid < 128) {
    const bool isv = tid < 64; const int d = tid & 63;
    float X[64];
#pragma unroll
    for (int i = 0; i < 64; ++i) X[i] = 0.f;
    float* dst = (isv ? p.g_u : p.g_w) + (size_t)item * 4096 + d;
#pragma unroll
    for (int i = 0; i < 64; ++i) {
      float bi = sbeta[i];
      float s = isv ? sv[i * 65 + d] * bi : sk[i * 65 + d] * bi * expf(sgc[i]);
      float s1 = 0.f, s2 = 0.f, s3 = 0.f;
#pragma unroll
      for (int j4 = 0; j4 < (i + 3) / 4; ++j4) {
        float4 lv = *(const float4*)&sL[i * 68 + j4 * 4];
        s -= lv.x * X[j4 * 4 + 0]; s1 -= lv.y * X[j4 * 4 + 1]; s2 -= lv.z * X[j4 * 4 + 2]; s3 -= lv.w * X[j4 * 4 + 3];
      }
      s = (s + s1) + (s2 + s3);
      X[i] = s;
      dst[i * 64] = s;
    }
  } else {
    for (int i2 = tid - 128; i2 < 8192; i2 += 384) {
      int which = i2 >> 12, i = (i2 >> 6) & 63, d = i2 & 63;
      float val = which == 0 ? sq[i * 65 + d] * expf(sgc[i]) : sk[i * 65 + d] * expf(sgc[63] - sgc[i]);
      (which == 0 ? p.g_qd : p.g_kd)[(size_t)item * 4096 + i * 64 + d] = val;
    }
    if (tid == 128) p.g_cdec[item] = expf(sgc[63]);
  }
  __syncthreads();
}

DEVI f32x4 mm16_k64(const float* A, int sam, int sak, const float* B, int sbk, int sbn) {
  const int l = TID() & 63, r = l & 15, q = l >> 4;
  const float* ap = A + r * sam + q * sak;
  const float* bp = B + q * sbk + r * sbn;
  float av[16], bv[16];
#pragma unroll
  for (int k = 0; k < 16; ++k) { av[k] = ap[4 * k * sak]; bv[k] = bp[4 * k * sbk]; }
  f32x4 c0 = f32x4{0.f, 0.f, 0.f, 0.f}, c1 = f32x4{0.f, 0.f, 0.f, 0.f};
#pragma unroll
  for (int k = 0; k < 16; k += 2) {
    c0 = __builtin_amdgcn_mfma_f32_16x16x4f32(av[k], bv[k], c0, 0, 0, 0);
    c1 = __builtin_amdgcn_mfma_f32_16x16x4f32(av[k + 1], bv[k + 1], c1, 0, 0, 0);
  }
  return c0 + c1;
}

template <int MODE>
DEVI void gdn_chain(const Params& p, int hd, int grp, int cb, char* smem) {
  float* base = (float*)smem;
  constexpr int BUFSZ = 64 * 68 * 2 + 64 * 16;
  float* sS = base + 2 * BUFSZ; float* sVN = sS + 1024;
  const int tid = TID(), lane = tid & 63, wave = tid >> 6, r = lane & 15, qd = lane >> 4;
  const bool apart = (MODE == 0) && (cb >= 4);
  const int e0 = (cb & 3) * 16;
  const int c0 = grp * 32;
  float4 pw0, pw1, pkd0, pkd1, pu = float4{0.f, 0.f, 0.f, 0.f};
  const int lr0 = tid >> 4, lc0 = (tid & 15) * 4, lr1 = lr0 + 32;
  const int ur = tid >> 2, uc = (tid & 3) * 4;
#define GLOAD(c_)                                                            \
  {                                                                          \
    size_t b_ = (size_t)((c_) * 4 + hd) * 4096;                              \
    pw0 = *(const float4*)&p.g_w[b_ + lr0 * 64 + lc0];                       \
    pw1 = *(const float4*)&p.g_w[b_ + lr1 * 64 + lc0];                       \
    pkd0 = *(const float4*)&p.g_kd[b_ + lr0 * 64 + lc0];                     \
    pkd1 = *(const float4*)&p.g_kd[b_ + lr1 * 64 + lc0];                     \
    if (tid < 256 && !apart) pu = *(const float4*)&p.g_u[b_ + ur * 64 + e0 + uc]; \
  }
#define LSTORE(bi_)                                                          \
  {                                                                          \
    float* W_ = base + (bi_) * BUFSZ; float* KD_ = W_ + 64 * 68; float* U_ = KD_ + 64 * 68; \
    *(float4*)&W_[lr0 * 68 + lc0] = pw0; *(float4*)&W_[lr1 * 68 + lc0] = pw1;       \
    *(float4*)&KD_[lr0 * 68 + lc0] = pkd0; *(float4*)&KD_[lr1 * 68 + lc0] = pkd1;   \
    if (tid < 256) *(float4*)&U_[ur * 16 + uc] = pu;                         \
  }
  f32x4 sreg = f32x4{0.f, 0.f, 0.f, 0.f};
  if (MODE == 0) {
    for (int i = tid; i < 1024; i += NT) sS[i] = (apart && ((i >> 4) == e0 + (i & 15))) ? 1.f : 0.f;
    if (apart) {
#pragma unroll
      for (int e = 0; e < 4; ++e) sreg[e] = ((wave & 3) * 16 + 4 * qd + e == e0 + r) ? 1.f : 0.f;
    }
  } else {
    for (int i = tid; i < 1024; i += NT) sS[i] = 0.f;
    float* W = base;
    for (int g2 = 0; g2 < grp; ++g2) {
      const float* Ag = p.g_comp + ((size_t)(hd * 8 + g2) * 2 + 1) * 4096;
      const float* Bg = p.g_comp + ((size_t)(hd * 8 + g2) * 2 + 0) * 4096;
      __syncthreads();
      *(float4*)&W[lr0 * 68 + lc0] = *(const float4*)&Ag[lr0 * 64 + lc0];
      *(float4*)&W[lr1 * 68 + lc0] = *(const float4*)&Ag[lr1 * 64 + lc0];
      __syncthreads();
      f32x4 a = f32x4{0.f, 0.f, 0.f, 0.f};
      if (wave < 4) a = mm16_k64(W + wave * 16 * 68, 68, 1, sS, 16, 1);
      __syncthreads();
      if (wave < 4) {
#pragma unroll
        for (int e = 0; e < 4; ++e) {
          int d = wave * 16 + 4 * qd + e;
          sreg[e] = a[e] + Bg[d * 64 + e0 + r];
          sS[d * 16 + r] = sreg[e];
        }
      }
    }
    __syncthreads();
    if (wave < 4) {
#pragma unroll
      for (int e = 0; e < 4; ++e) {
        int d = wave * 16 + 4 * qd + e;
        p.g_sst[(size_t)(c0 * 4 + hd) * 4096 + d * 64 + e0 + r] = sreg[e];
      }
    }
  }
  GLOAD(c0) LSTORE(0)
  __syncthreads();
  for (int cc = 0; cc < 32; ++cc) {
    const int c = c0 + cc;
    if (cc + 1 < 32) GLOAD(c + 1)
    const float cd = p.g_cdec[c * 4 + hd];
    float* W = base + (cc & 1) * BUFSZ; float* KD = W + 64 * 68; float* U = KD + 64 * 68;
    const size_t it = (size_t)(c * 4 + hd);
    if (wave < 4) {
      f32x4 a1 = mm16_k64(W + wave * 16 * 68, 68, 1, sS, 16, 1);
#pragma unroll
      for (int e = 0; e < 4; ++e) {
        int i = wave * 16 + 4 * qd + e;
        float vn = (apart ? 0.f : U[i * 16 + r]) - a1[e];
        sVN[i * 16 + r] = vn;
        if (MODE == 1) p.g_u[it * 4096 + i * 64 + e0 + r] = vn;
      }
    }
    __syncthreads();
    if (wave < 4) {
      f32x4 a2 = mm16_k64(KD + wave * 16, 1, 68, sVN, 16, 1);
#pragma unroll
      for (int e = 0; e < 4; ++e) {
        int d = wave * 16 + 4 * qd + e;
        sreg[e] = sreg[e] * cd + a2[e];
        sS[d * 16 + r] = sreg[e];
        if (MODE == 1 && cc + 1 < 32) p.g_sst[(size_t)((c + 1) * 4 + hd) * 4096 + d * 64 + e0 + r] = sreg[e];
      }
    }
    if (cc + 1 < 32) LSTORE((cc + 1) & 1)
    __syncthreads();
  }
  if (MODE == 0 && wave < 4) {
    float* dst = p.g_comp + ((size_t)(hd * 8 + grp) * 2 + (apart ? 1 : 0)) * 4096;
#pragma unroll
    for (int e = 0; e < 4; ++e) {
      int d = wave * 16 + 4 * qd + e;
      dst[d * 64 + e0 + r] = sreg[e];
    }
  }
  __syncthreads();
}

DEVI void gdn_out(const Params& p, int l, int item, char* smem) {
  const int c = item >> 2, hd = item & 3, t0 = c * 64;
  float* sQD = (float*)smem; float* sS = sQD + 64 * 68; float* sAT = sS + 64 * 68; float* sVN = sAT + 64 * 68;
  const int tid = TID(), lane = tid & 63, wave = tid >> 6, r = lane & 15, qd = lane >> 4;
  const size_t b = (size_t)item * 4096;
#pragma unroll
  for (int idx = tid; idx < 1024; idx += NT) {
    int row = idx >> 4, c4 = idx & 15;
    *(float4*)&sQD[row * 68 + c4 * 4] = *(const float4*)&p.g_qd[b + row * 64 + c4 * 4];
    *(float4*)&sS[row * 68 + c4 * 4] = *(const float4*)&p.g_sst[b + row * 64 + c4 * 4];
    *(float4*)&sAT[row * 68 + c4 * 4] = *(const float4*)&p.g_attn[b + row * 64 + c4 * 4];
    *(float4*)&sVN[row * 68 + c4 * 4] = *(const float4*)&p.g_u[b + row * 64 + c4 * 4];
  }
  __syncthreads();
  const int mt = wave & 3, nh = wave >> 2;
  f32x4 acc[2]; acc[0] = acc[1] = f32x4{0.f, 0.f, 0.f, 0.f};
  mm16<2>(acc, sQD + mt * 16 * 68, 68, 1, sS + nh * 32, 68, 1, 64);
  mm16<2>(acc, sAT + mt * 16 * 68, 68, 1, sVN + nh * 32, 68, 1, 64);
  __syncthreads();
  float* sO = sQD;
#pragma unroll
  for (int t2 = 0; t2 < 2; ++t2)
#pragma unroll
    for (int e = 0; e < 4; ++e) sO[(mt * 16 + 4 * qd + e) * 68 + nh * 32 + t2 * 16 + r] = acc[t2][e];
  __syncthreads();
  {
    int row = tid >> 3, sub = tid & 7, t = t0 + row;
    float o[8], yv[8]; float ss = 0.f;
#pragma unroll
    for (int k = 0; k < 8; ++k) { o[k] = sO[row * 68 + sub * 8 + k]; ss += o[k] * o[k]; }
    ss += __shfl_xor(ss, 1); ss += __shfl_xor(ss, 2); ss += __shfl_xor(ss, 4);
    float rs = rsqrtf(ss * (1.f / 64.f) + EPS);
    float s2 = 0.f;
#pragma unroll
    for (int k = 0; k < 8; ++k) {
      int col = sub * 8 + k;
      float g = p.proj[(size_t)t * PW + DG + hd * 64 + col];
      float y = o[k] * rs * p.gdn_norm[l * 64 + col] * siluf_(g);
      s2 += y * y;
      yv[k] = y * p.branch_norm[(l * 4 + 3) * 256 + hd * 64 + col];
    }
    s2 += __shfl_xor(s2, 1); s2 += __shfl_xor(s2, 2); s2 += __shfl_xor(s2, 4);
    if (sub == 0) p.ssq[(size_t)t * 16 + 8 + hd] = s2;
    *(uint4*)&p.zb[(size_t)t * DM + 768 + hd * 64 + sub * 8] =
        uint4{pack2(yv[0], yv[1]), pack2(yv[2], yv[3]), pack2(yv[4], yv[5]), pack2(yv[6], yv[7])};
  }
  __syncthreads();
}

DEVI void ret_kv(const Params& p, int l, int item, char* smem) {
  const int c = item >> 2, hd = item & 3, t0 = c * 128;
  float* sK = (float*)smem; float* sV = sK + 128 * 65;
  const int tid = TID(), lane = tid & 63, wave = tid >> 6, r = lane & 15, qd = lane >> 4;
  const float lg = logf(1.f - exp2f(-5.f - (float)hd));
#pragma unroll
  for (int i = tid; i < 128 * 32; i += NT) {
    int t = i >> 5, f = i & 31; size_t tt = t0 + t;
    float k1 = p.proj[tt * PW + RK + hd * 64 + f], k2 = p.proj[tt * PW + RK + hd * 64 + 32 + f];
    float cs = p.rope[(tt * 32 + f) * 2], sn = p.rope[(tt * 32 + f) * 2 + 1];
    float dec = expf(lg * (float)(127 - t));
    sK[t * 65 + f] = (k1 * cs - k2 * sn) * dec;
    sK[t * 65 + 32 + f] = (k2 * cs + k1 * sn) * dec;
  }
#pragma unroll
  for (int i = tid; i < 128 * 64; i += NT) {
    int t = i >> 6, e = i & 63;
    sV[t * 65 + e] = p.proj[(size_t)(t0 + t) * PW + RV + hd * 64 + e];
  }
  __syncthreads();
  const int mt = wave & 3, nh = wave >> 2;
  f32x4 acc[2]; acc[0] = acc[1] = f32x4{0.f, 0.f, 0.f, 0.f};
  mm16<2>(acc, sK + mt * 16, 1, 65, sV + nh * 32, 65, 1, 128);
#pragma unroll
  for (int t2 = 0; t2 < 2; ++t2)
#pragma unroll
    for (int e = 0; e < 4; ++e)
      p.ret_kv[(size_t)item * 4096 + (mt * 16 + 4 * qd + e) * 64 + nh * 32 + t2 * 16 + r] = acc[t2][e];
  __syncthreads();
}

DEVI void ret_out(const Params& p, int l, int item, char* smem) {
  const int c = item >> 2, hd = item & 3, t0 = c * 128;
  float* sQ = (float*)smem; float* sK = sQ + 128 * 65; float* sV = sK + 128 * 65; float* sSt = sV + 128 * 65;
  const int tid = TID(), lane = tid & 63, wave = tid >> 6, r = lane & 15, qd = lane >> 4;
  const float lg = logf(1.f - exp2f(-5.f - (float)hd));
  {
    const float* ssrc = p.ret_kv + (size_t)(c * 4 + hd) * 4096;
#pragma unroll
    for (int j = 0; j < 8; ++j) { int idx = tid + 512 * j; sSt[(idx >> 6) * 65 + (idx & 63)] = ssrc[idx]; }
  }
#pragma unroll
  for (int i = tid; i < 128 * 32; i += NT) {
    int t = i >> 5, f = i & 31; size_t tt = t0 + t;
    float cs = p.rope[(tt * 32 + f) * 2], sn = p.rope[(tt * 32 + f) * 2 + 1];
    float k1 = p.proj[tt * PW + RK + hd * 64 + f], k2 = p.proj[tt * PW + RK + hd * 64 + 32 + f];
    sK[t * 65 + f] = (k1 * cs - k2 * sn);
    sK[t * 65 + 32 + f] = (k2 * cs + k1 * sn);
    float q1 = p.proj[tt * PW + RQ + hd * 64 + f], q2 = p.proj[tt * PW + RQ + hd * 64 + 32 + f];
    sQ[t * 65 + f] = (q1 * cs - q2 * sn) * 0.125f;
    sQ[t * 65 + 32 + f] = (q2 * cs + q1 * sn) * 0.125f;
  }
#pragma unroll
  for (int i = tid; i < 128 * 64; i += NT) {
    int t = i >> 6, e = i & 63;
    sV[t * 65 + e] = p.proj[(size_t)(t0 + t) * PW + RV + hd * 64 + e];
  }
  __syncthreads();
  const int i0 = wave * 16;
  f32x4 sc[8], os[4];
#pragma unroll
  for (int t = 0; t < 8; ++t) sc[t] = f32x4{0.f, 0.f, 0.f, 0.f};
#pragma unroll
  for (int t = 0; t < 4; ++t) os[t] = f32x4{0.f, 0.f, 0.f, 0.f};
  mm16<8>(sc, sQ + i0 * 65, 65, 1, sK, 1, 65, 64);
  mm16<4>(os, sQ + i0 * 65, 65, 1, sSt, 65, 1, 64);
  __syncthreads();
  float* sP = (float*)smem;
#pragma unroll
  for (int t2 = 0; t2 < 8; ++t2)
#pragma unroll
    for (int e = 0; e < 4; ++e) {
      int i = i0 + 4 * qd + e, j = t2 * 16 + r;
      sP[i * 129 + j] = (i >= j) ? sc[t2][e] * expf(lg * (float)(i - j)) : 0.f;
    }
  __syncthreads();
  f32x4 o[4];
#pragma unroll
  for (int t2 = 0; t2 < 4; ++t2)
#pragma unroll
    for (int e = 0; e < 4; ++e) o[t2][e] = os[t2][e] * expf(lg * (float)(i0 + 4 * qd + e + 1));
  mm16<4>(o, sP + i0 * 129, 129, 1, sV, 65, 1, 128);
#pragma unroll
  for (int e = 0; e < 4; ++e) {
    int i = i0 + 4 * qd + e; size_t t = t0 + i;
    float sm = sum16(o[0][e] + o[1][e] + o[2][e] + o[3][e]);
    float mu = sm * (1.f / 64.f);
    float vr = 0.f;
#pragma unroll
    for (int t2 = 0; t2 < 4; ++t2) { float dd = o[t2][e] - mu; vr += dd * dd; }
    vr = sum16(vr);
    float rstd = rsqrtf(vr * (1.f / 64.f) + EPS);
    float ss = 0.f;
#pragma unroll
    for (int t2 = 0; t2 < 4; ++t2) {
      int col = hd * 64 + t2 * 16 + r;
      float on = (o[t2][e] - mu) * rstd * p.ret_gn[l * 256 + col];
      float g = p.proj[t * PW + RG + col];
      float y = siluf_(g) * on;
      ss += y * y;
      p.zb[t * DM + col] = f2bf(y * p.branch_norm[(l * 4 + 0) * 256 + col]);
    }
    ss = sum16(ss);
    if (r == 0) p.ssq[t * 16 + hd] = ss;
  }
  __syncthreads();
}

DEVI void lru_local(const Params& p, int l, int c, char* smem) {
  const int t0 = c * 64;
  float* sX = (float*)smem; float* sA = sX + 64 * 257;
  const int tid = TID(), lane = tid & 63, wave = tid >> 6, r = lane & 15, qd = lane >> 4;
  {
    const int ch = tid & 255, half = tid >> 8;
    const float w0 = p.lru_conv_w[(l * 4 + 0) * 256 + ch], w1 = p.lru_conv_w[(l * 4 + 1) * 256 + ch];
    const float w2 = p.lru_conv_w[(l * 4 + 2) * 256 + ch], w3 = p.lru_conv_w[(l * 4 + 3) * 256 + ch];
    const float cb = p.lru_conv_b[l * 256 + ch];
    const float* pc = p.proj + LX + ch;
    float xv[35];
#pragma unroll
    for (int k = 0; k < 35; ++k) {
      const int tt = t0 + 32 * half - 3 + k;
      const float v = pc[(size_t)(tt < 0 ? 0 : tt) * PW];
      xv[k] = tt < 0 ? 0.f : v;
    }
#pragma unroll
    for (int m = 0; m < 32; ++m) {
      float acc = cb;
      acc += w0 * xv[m]; acc += w1 * xv[m + 1]; acc += w2 * xv[m + 2]; acc += w3 * xv[m + 3];
      sX[(32 * half + m) * 257 + ch] = acc;
    }
  }
  __syncthreads();
  for (int pr = 0; pr < 2; ++pr) {
    int pi = wave * 2 + pr, mt = pi & 3, nb = pi >> 2;
    f32x4 ra[4], ri[4];
#pragma unroll
    for (int t = 0; t < 4; ++t) { ra[t] = f32x4{0.f, 0.f, 0.f, 0.f}; ri[t] = f32x4{0.f, 0.f, 0.f, 0.f}; }
    mm16_gB64<4>(ra, sX + mt * 16 * 257 + nb * 64, 257, p.lru_w_a + (size_t)(l * 4 + nb) * 4096);
    mm16_gB64<4>(ri, sX + mt * 16 * 257 + nb * 64, 257, p.lru_w_x + (size_t)(l * 4 + nb) * 4096);
#pragma unroll
    for (int t2 = 0; t2 < 4; ++t2)
#pragma unroll
      for (int e = 0; e < 4; ++e) {
        int t = mt * 16 + 4 * qd + e, ch = nb * 64 + t2 * 16 + r;
        float xb = sX[t * 257 + ch];
        float rr = sigmoidf_(ra[t2][e] + p.lru_b_a[l * 256 + ch]);
        float ii = sigmoidf_(ri[t2][e] + p.lru_b_x[l * 256 + ch]);
        float loga = -8.f * rr * softplusf_(-p.lru_lambda[l * 256 + ch]);
        float a = expf(loga);
        float bb = sqrtf(-expm1f(2.f * loga)) * (ii * xb);
        sA[t * 257 + ch] = a; sX[t * 257 + ch] = bb;
      }
  }
  __syncthreads();
  if (tid < 256) {
    int ch = tid; float H = 0.f, P = 1.f;
    for (int t = 0; t < 64; ++t) {
      float a = sA[t * 257 + ch], bb = sX[t * 257 + ch];
      H = a * H + bb; P *= a;
      p.lru_h[(size_t)(t0 + t) * 256 + ch] = H; p.lru_p[(size_t)(t0 + t) * 256 + ch] = P;
    }
    p.lru_hs[c * 256 + ch] = H; p.lru_ps[c * 256 + ch] = P;
  }
  __syncthreads();
}

DEVI void lru_out(const Params& p, int l, int c, char* smem) {
  const int t0 = c * 64;
  float* sC = (float*)smem;
  const int tid = TID(), lane = tid & 63, wave = tid >> 6;
  if (tid < 256) sC[tid] = p.lru_hs[c * 256 + tid];
  __syncthreads();
  {
    const int ch = lane * 4;
    float4 Hs[8], Ps[8], gs[8];
#pragma unroll
    for (int tk = 0; tk < 8; ++tk) {
      const size_t t = t0 + wave * 8 + tk;
      Hs[tk] = *(const float4*)&p.lru_h[t * 256 + ch]; Ps[tk] = *(const float4*)&p.lru_p[t * 256 + ch];
      gs[tk] = *(const float4*)&p.proj[t * PW + LG + ch];
    }
    const float4 cr = *(const float4*)&sC[ch];
    const float4 bn = *(const float4*)&p.branch_norm[(l * 4 + 1) * 256 + ch];
#pragma unroll
    for (int tk = 0; tk < 8; ++tk) {
      const size_t t = t0 + wave * 8 + tk;
      const float4 H = Hs[tk], P = Ps[tk], g = gs[tk];
      float y0 = geluf_(g.x) * (H.x + P.x * cr.x), y1 = geluf_(g.y) * (H.y + P.y * cr.y);
      float y2 = geluf_(g.z) * (H.z + P.z * cr.z), y3 = geluf_(g.w) * (H.w + P.w * cr.w);
      float ss = wave_sum(y0 * y0 + y1 * y1 + y2 * y2 + y3 * y3);
      if (lane == 0) p.ssq[t * 16 + 4] = ss;
      *(uint2*)&p.zb[t * DM + 256 + ch] = uint2{pack2(y0 * bn.x, y1 * bn.y), pack2(y2 * bn.z, y3 * bn.w)};
    }
  }
  __syncthreads();
}

DEVI void s5_coef(const Params& p, int l, int g, int n, float& abr, float& abi, float (&bbr)[16], float (&bbi)[16]) {
  float dt = expf(p.s5_log_dt[l * 16 + g]);
  float are = p.s5_a_re[(l * 16 + g) * 64 + n], aim = p.s5_a_im[(l * 16 + g) * 64 + n];
  float mag = expf(are * dt), ang = aim * dt;
  abr = mag * cosf(ang); abi = mag * sinf(ang);
  float den = are * are + aim * aim;
  float pre = abr - 1.f, pim = abi;
  float fre = (pre * are + pim * aim) / den, fim = (pim * are - pre * aim) / den;
  const float4* br = (const float4*)(p.s5_b_re + (size_t)((l * 16 + g) * 64 + n) * 16);
  const float4* bi = (const float4*)(p.s5_b_im + (size_t)((l * 16 + g) * 64 + n) * 16);
#pragma unroll
  for (int c4 = 0; c4 < 4; ++c4) {
    float4 a = br[c4], b = bi[c4];
    bbr[c4 * 4 + 0] = fre * a.x - fim * b.x; bbi[c4 * 4 + 0] = fre * b.x + fim * a.x;
    bbr[c4 * 4 + 1] = fre * a.y - fim * b.y; bbi[c4 * 4 + 1] = fre * b.y + fim * a.y;
    bbr[c4 * 4 + 2] = fre * a.z - fim * b.z; bbi[c4 * 4 + 2] = fre * b.z + fim * a.z;
    bbr[c4 * 4 + 3] = fre * a.w - fim * b.w; bbi[c4 * 4 + 3] = fre * b.w + fim * a.w;
  }
}
DEVI void s5_load_u(const Params& p, int t0, float* sU) {
#pragma unroll
  for (int i = TID(); i < 64 * 64; i += NT) {
    int t = i >> 6, c4 = i & 63;
    *(float4*)&sU[t * 256 + c4 * 4] = *(const float4*)&p.proj[(size_t)(t0 + t) * PW + SU + c4 * 4];
  }
}
DEVI void s5_bu(const float* up, const float (&bbr)[16], const float (&bbi)[16], float& bur, float& bui) {
  bur = 0.f; bui = 0.f;
#pragma unroll
  for (int c4 = 0; c4 < 4; ++c4) {
    float4 u = *(const float4*)&up[c4 * 4];
    bur += bbr[c4 * 4] * u.x + bbr[c4 * 4 + 1] * u.y + bbr[c4 * 4 + 2] * u.z + bbr[c4 * 4 + 3] * u.w;
    bui += bbi[c4 * 4] * u.x + bbi[c4 * 4 + 1] * u.y + bbi[c4 * 4 + 2] * u.z + bbi[c4 * 4 + 3] * u.w;
  }
}

DEVI void s5_local(const Params& p, int l, int c, char* smem) {
  const int t0 = c * 64;
  float* sU = (float*)smem;
  const int lane = TID() & 63, wave = TID() >> 6;
  s5_load_u(p, t0, sU);
  __syncthreads();
  for (int gi = 0; gi < 2; ++gi) {
    int g = wave + 8 * gi;
    float abr, abi, bbr[16], bbi[16];
    s5_coef(p, l, g, lane, abr, abi, bbr, bbi);
    float xr = 0.f, xi = 0.f;
    for (int t = 0; t < 64; ++t) {
      float bur, bui; s5_bu(sU + t * 256 + g * 16, bbr, bbi, bur, bui);
      float nr = abr * xr - abi * xi + bur, ni = abr * xi + abi * xr + bui;
      xr = nr; xi = ni;
    }
    *(float2*)&p.xloc[((size_t)(c * 16 + g) * 64 + lane) * 2] = float2{xr, xi};
  }
  __syncthreads();
}

DEVI void s5_out(const Params& p, int l, int c, char* smem) {
  const int t0 = c * 64;
  bf16_t* sY = (bf16_t*)smem;
  float* sX = (float*)(smem + 64 * 264 * 2);
  const int tid = TID(), lane = tid & 63, wave = tid >> 6, r = lane & 15, qd = lane >> 4;
  float* Xl = sX + wave * (16 * 132);
  for (int gi = 0; gi < 2; ++gi) {
    const int g = wave + 8 * gi;
    float abr, abi, bbr[16], bbi[16];
    s5_coef(p, l, g, lane, abr, abi, bbr, bbi);
    float breg[32];
#pragma unroll
    for (int ks = 0; ks < 16; ++ks) {
      breg[ks] = p.s5_c_re[(size_t)((l * 16 + g) * 16 + r) * 64 + 4 * ks + qd];
      breg[16 + ks] = -p.s5_c_im[(size_t)((l * 16 + g) * 16 + r) * 64 + 4 * ks + qd];
    }
    const float dd = p.s5_d[l * 256 + g * 16 + r];
    const float2 xin = *(const float2*)&p.xloc[((size_t)(c * 16 + g) * 64 + lane) * 2];
    float xr = xin.x, xi = xin.y;
    float4 uvecs[4]; float ues[4][4];
#pragma unroll
    for (int tb = 0; tb < 4; ++tb) {
      const float* ub = p.proj + (size_t)(t0 + tb * 16) * PW + SU + g * 16;
      uvecs[tb] = *(const float4*)&ub[(size_t)r * PW + 4 * qd];
#pragma unroll
      for (int e = 0; e < 4; ++e) ues[tb][e] = ub[(size_t)(4 * qd + e) * PW + r];
    }
#pragma unroll
    for (int tb = 0; tb < 4; ++tb) {
      const float4 uvec = uvecs[tb];
      float ue[4];
#pragma unroll
      for (int e = 0; e < 4; ++e) ue[e] = ues[tb][e];
      const int u0 = __float_as_int(uvec.x), u1 = __float_as_int(uvec.y), u2 = __float_as_int(uvec.z), u3 = __float_as_int(uvec.w);
#pragma unroll
      for (int tt = 0; tt < 16; ++tt) {
        float bur = 0.f, bui = 0.f;
#pragma unroll
        for (int c4 = 0; c4 < 4; ++c4) {
          float a0 = __int_as_float(__builtin_amdgcn_readlane(u0, tt + 16 * c4));
          float a1 = __int_as_float(__builtin_amdgcn_readlane(u1, tt + 16 * c4));
          float a2 = __int_as_float(__builtin_amdgcn_readlane(u2, tt + 16 * c4));
          float a3 = __int_as_float(__builtin_amdgcn_readlane(u3, tt + 16 * c4));
          bur += bbr[c4 * 4] * a0 + bbr[c4 * 4 + 1] * a1 + bbr[c4 * 4 + 2] * a2 + bbr[c4 * 4 + 3] * a3;
          bui += bbi[c4 * 4] * a0 + bbi[c4 * 4 + 1] * a1 + bbi[c4 * 4 + 2] * a2 + bbi[c4 * 4 + 3] * a3;
        }
        float nr = abr * xr - abi * xi + bur, ni = abr * xi + abi * xr + bui;
        xr = nr; xi = ni;
        Xl[tt * 132 + lane] = xr; Xl[tt * 132 + 64 + lane] = xi;
      }
      f32x4 acc = f32x4{0.f, 0.f, 0.f, 0.f};
#pragma unroll
      for (int ks = 0; ks < 32; ++ks) {
        float a = Xl[r * 132 + 4 * ks + qd];
        acc = __builtin_amdgcn_mfma_f32_16x16x4f32(a, breg[ks], acc, 0, 0, 0);
      }
#pragma unroll
      for (int e = 0; e < 4; ++e) {
        float y = acc[e] + dd * ue[e];
        sY[(tb * 16 + 4 * qd + e) * 264 + g * 16 + r] = f2bf(geluf_(y));
      }
    }
  }
  __syncthreads();
  f32x4 av[4][2], ag[4][2];
#pragma unroll
  for (int i = 0; i < 4; ++i)
#pragma unroll
    for (int j = 0; j < 2; ++j) { av[i][j] = f32x4{0.f, 0.f, 0.f, 0.f}; ag[i][j] = f32x4{0.f, 0.f, 0.f, 0.f}; }
  const bf16_t* WT = p.gluT + (size_t)l * 512 * 256;
#pragma unroll 4
  for (int ks = 0; ks < 8; ++ks) {
    bf16x8 bv0 = *(const bf16x8*)&WT[(size_t)(32 * wave + r) * 256 + ks * 32 + qd * 8];
    bf16x8 bv1 = *(const bf16x8*)&WT[(size_t)(32 * wave + 16 + r) * 256 + ks * 32 + qd * 8];
    bf16x8 bg0 = *(const bf16x8*)&WT[(size_t)(256 + 32 * wave + r) * 256 + ks * 32 + qd * 8];
    bf16x8 bg1 = *(const bf16x8*)&WT[(size_t)(256 + 32 * wave + 16 + r) * 256 + ks * 32 + qd * 8];
#pragma unroll
    for (int mt = 0; mt < 4; ++mt) {
      bf16x8 a = *(const bf16x8*)&sY[(mt * 16 + r) * 264 + ks * 32 + qd * 8];
      av[mt][0] = __builtin_amdgcn_mfma_f32_16x16x32_bf16(a, bv0, av[mt][0], 0, 0, 0);
      av[mt][1] = __builtin_amdgcn_mfma_f32_16x16x32_bf16(a, bv1, av[mt][1], 0, 0, 0);
      ag[mt][0] = __builtin_amdgcn_mfma_f32_16x16x32_bf16(a, bg0, ag[mt][0], 0, 0, 0);
      ag[mt][1] = __builtin_amdgcn_mfma_f32_16x16x32_bf16(a, bg1, ag[mt][1], 0, 0, 0);
    }
  }
  float* sO = sX;
#pragma unroll
  for (int mt = 0; mt < 4; ++mt)
#pragma unroll
    for (int t2 = 0; t2 < 2; ++t2)
#pragma unroll
      for (int e = 0; e < 4; ++e) {
        int t = mt * 16 + 4 * qd + e, col = 32 * wave + t2 * 16 + r;
        float zv = av[mt][t2][e] + p.s5_glu_b[l * 512 + col];
        float zg = ag[mt][t2][e] + p.s5_glu_b[l * 512 + 256 + col];
        sO[t * 256 + col] = zv * sigmoidf_(zg);
      }
  __syncthreads();
  for (int tk = 0; tk < 8; ++tk) {
    int tl = wave * 8 + tk; size_t t = t0 + tl; int ch = lane * 4;
    float4 o = *(const float4*)&sO[tl * 256 + ch];
    float4 bn = *(const float4*)&p.branch_norm[(l * 4 + 2) * 256 + ch];
    float ss = wave_sum(o.x * o.x + o.y * o.y + o.z * o.z + o.w * o.w);
    if (lane == 0) p.ssq[t * 16 + 5] = ss;
    *(uint2*)&p.zb[t * DM + 512 + ch] = uint2{pack2(o.x * bn.x, o.y * bn.y), pack2(o.z * bn.z, o.w * bn.w)};
  }
  __syncthreads();
}

DEVI void ret_scan(const Params& p, int it) {
  const int elem = it * NT + TID(), hd = elem >> 12, idx = elem & 4095;
  const float lg = logf(1.f - exp2f(-5.f - (float)hd)), cdk = expf(lg * 128.f);
  float* base = p.ret_kv + (size_t)hd * 4096 + idx;
  float s = 0.f;
  for (int cb = 0; cb < 128; cb += 16) {
    float v[16];
#pragma unroll
    for (int j = 0; j < 16; ++j) v[j] = base[(size_t)(cb + j) * 16384];
#pragma unroll
    for (int j = 0; j < 16; ++j) { base[(size_t)(cb + j) * 16384] = s; s = s * cdk + v[j]; }
  }
}
DEVI void s5_scan(const Params& p, int l, int it) {
  const int sidx = it * NT + TID(), g = sidx >> 6, n = sidx & 63;
  float dt = expf(p.s5_log_dt[l * 16 + g]);
  float are = p.s5_a_re[(l * 16 + g) * 64 + n], aim = p.s5_a_im[(l * 16 + g) * 64 + n];
  float mag = expf(are * dt), ang = aim * dt;
  float pr = mag * cosf(ang), pi = mag * sinf(ang);
#pragma unroll
  for (int k = 0; k < 6; ++k) { float nr = pr * pr - pi * pi, ni = 2.f * pr * pi; pr = nr; pi = ni; }
  float2* base = (float2*)p.xloc + sidx;
  float xr = 0.f, xi = 0.f;
  for (int cb = 0; cb < 256; cb += 16) {
    float2 v[16];
#pragma unroll
    for (int j = 0; j < 16; ++j) v[j] = base[(size_t)(cb + j) * 1024];
#pragma unroll
    for (int j = 0; j < 16; ++j) {
      base[(size_t)(cb + j) * 1024] = float2{xr, xi};
      float nr = pr * xr - pi * xi + v[j].x, ni = pr * xi + pi * xr + v[j].y;
      xr = nr; xi = ni;
    }
  }
}
DEVI void lru_scan(const Params& p) {
  const int ch = TID();
  if (ch < 256) {
    float carry = 0.f;
    for (int cb = 0; cb < 256; cb += 16) {
      float ps[16], hs[16];
#pragma unroll
      for (int j = 0; j < 16; ++j) { ps[j] = p.lru_ps[(cb + j) * 256 + ch]; hs[j] = p.lru_hs[(cb + j) * 256 + ch]; }
#pragma unroll
      for (int j = 0; j < 16; ++j) { p.lru_hs[(cb + j) * 256 + ch] = carry; carry = ps[j] * carry + hs[j]; }
    }
  }
}

DEVI void peer_scores(const Params& p, int l, int item, char* smem) {
  const int hp = item & 15, grp = item >> 4;
  float* sQ = (float*)smem;
  float* sKy = sQ + 64 * 68;
  const int tid = TID(), lane = tid & 63, wave = tid >> 6, r = lane & 15, qd = lane >> 4;
  const float* ky = p.peer_subkeys + (size_t)(l * 16 + hp) * 8192;
#pragma unroll
  for (int i = tid; i < 128 * 64; i += NT) { int k = i >> 6, d = i & 63; sKy[k * 65 + d] = ky[i]; }
  const int lt0 = tid >> 4, lc4 = (tid & 15) * 4;
  const float* qb = p.qbuf + (size_t)hp * 64 + lc4;
  float4 q0, q1;
  {
    const size_t t0 = (size_t)(grp * 16) * 64;
    q0 = *(const float4*)&qb[(t0 + lt0) * 1024]; q1 = *(const float4*)&qb[(t0 + lt0 + 32) * 1024];
  }
  const int mt = wave & 3, nh = wave >> 2;
  for (int k = 0; k < 16; ++k) {
    const size_t t0 = (size_t)(grp * 16 + k) * 64;
    __syncthreads();
    *(float4*)&sQ[lt0 * 68 + lc4] = q0; *(float4*)&sQ[(lt0 + 32) * 68 + lc4] = q1;
    __syncthreads();
    if (k + 1 < 16) { q0 = *(const float4*)&qb[(t0 + 64 + lt0) * 1024]; q1 = *(const float4*)&qb[(t0 + 64 + lt0 + 32) * 1024]; }
    f32x4 acc[4];
#pragma unroll
    for (int t = 0; t < 4; ++t) acc[t] = f32x4{0.f, 0.f, 0.f, 0.f};
    mm16<4>(acc, sQ + mt * 16 * 68, 68, 1, sKy + nh * 64 * 65, 1, 65, 64);
#pragma unroll
    for (int t2 = 0; t2 < 4; ++t2)
#pragma unroll
      for (int e = 0; e < 4; ++e) {
        size_t t = t0 + mt * 16 + 4 * qd + e; int key = nh * 64 + t2 * 16 + r;
        p.scores[(t * 16 + hp) * 128 + key] = acc[t2][e];
      }
  }
  __syncthreads();
}

DEVI unsigned ford(float x) { unsigned u = __float_as_uint(x); return (u & 0x80000000u) ? ~u : (u | 0x80000000u); }
DEVI float funord(unsigned u) { return __uint_as_float((u & 0x80000000u) ? (u ^ 0x80000000u) : ~u); }
DEVI void ins16(unsigned (&v)[16], unsigned x) {
#pragma unroll
  for (int j = 0; j < 16; ++j) { unsigned hi = max(v[j], x); x = min(v[j], x); v[j] = hi; }
}

DEVI void peer_topk(const Params& p, int item, char* smem) {
  const int t0 = item * 64;
  float* sS = (float*)smem;
  const int tid = TID();
  const float* base = p.scores + (size_t)t0 * 8 * 256;
  unsigned v1[16], v2[16];
#pragma unroll
  for (int j = 0; j < 16; ++j) { v1[j] = 0u; v2[j] = 0u; }
  float4 nx[8];
#pragma unroll
  for (int i = 0; i < 8; ++i) { int idx = tid + 512 * i; nx[i] = *(const float4*)&base[(size_t)(idx >> 3) * 256 + (idx & 7) * 4]; }
  for (int s = 0; s < 8; ++s) {
    __syncthreads();
#pragma unroll
    for (int i = 0; i < 8; ++i) {
      int idx = tid + 512 * i, pr = idx >> 3, c4 = idx & 7;
      float* d = &sS[pr * 33 + c4 * 4];
      d[0] = nx[i].x; d[1] = nx[i].y; d[2] = nx[i].z; d[3] = nx[i].w;
    }
    __syncthreads();
    if (s + 1 < 8) {
#pragma unroll
      for (int i = 0; i < 8; ++i) { int idx = tid + 512 * i; nx[i] = *(const float4*)&base[(size_t)(idx >> 3) * 256 + (s + 1) * 32 + (idx & 7) * 4]; }
    }
    const int kb = (s & 3) * 32;
    if (s < 4) {
      for (int k = 0; k < 32; ++k) { unsigned key = (ford(sS[tid * 33 + k]) & ~127u) | (unsigned)(127 - (kb + k)); ins16(v1, key); }
    } else {
      for (int k = 0; k < 32; ++k) { unsigned key = (ford(sS[tid * 33 + k]) & ~127u) | (unsigned)(127 - (kb + k)); ins16(v2, key); }
    }
  }
  __syncthreads();
  unsigned* sI = (unsigned*)smem;
  float s1[16], s2[16];
#pragma unroll
  for (int a = 0; a < 16; ++a) {
    s1[a] = funord(v1[a] & ~127u); s2[a] = funord(v2[a] & ~127u);
    sI[tid * 33 + a] = 127u - (v1[a] & 127u); sI[tid * 33 + 16 + a] = 127u - (v2[a] & 127u);
  }
  unsigned vt[16];
#pragma unroll
  for (int j = 0; j < 16; ++j) vt[j] = 0u;
#pragma unroll
  for (int a = 0; a < 16; ++a)
#pragma unroll
    for (int b = 0; b < 16; ++b)
      if ((a + 1) * (b + 1) <= 16) {
        unsigned key = (ford(s1[a] + s2[b]) & ~255u) | (unsigned)(255 - (a * 16 + b));
        ins16(vt, key);
      }
  float sv[16]; float den = 0.f;
  const float mx = funord(vt[0] & ~255u);
#pragma unroll
  for (int k = 0; k < 16; ++k) { sv[k] = expf(funord(vt[k] & ~255u) - mx); den += sv[k]; }
  const float inv = 1.f / den;
  const int tl = tid >> 3, hh = tid & 7;
  int* idp = p.ids + (size_t)(t0 + tl) * 128 + hh * 16;
  float* gp = p.gates + (size_t)(t0 + tl) * 128 + hh * 16;
#pragma unroll
  for (int k = 0; k < 16; ++k) {
    unsigned pos = 255u - (vt[k] & 255u);
    unsigned i1 = sI[tid * 33 + (pos >> 4)], i2 = sI[tid * 33 + 16 + (pos & 15)];
    idp[k] = (int)(i1 * 128u + i2);
    gp[k] = sv[k] * inv;
  }
  __syncthreads();
}

typedef __attribute__((ext_vector_type(2))) float f32x2;
DEVI void fp8x16_to_f(const uint4& v, float (&o)[16]) {
  f32x2 t;
  t = __builtin_amdgcn_cvt_pk_f32_fp8((int)v.x, false); o[0] = t[0]; o[1] = t[1];
  t = __builtin_amdgcn_cvt_pk_f32_fp8((int)v.x, true); o[2] = t[0]; o[3] = t[1];
  t = __builtin_amdgcn_cvt_pk_f32_fp8((int)v.y, false); o[4] = t[0]; o[5] = t[1];
  t = __builtin_amdgcn_cvt_pk_f32_fp8((int)v.y, true); o[6] = t[0]; o[7] = t[1];
  t = __builtin_amdgcn_cvt_pk_f32_fp8((int)v.z, false); o[8] = t[0]; o[9] = t[1];
  t = __builtin_amdgcn_cvt_pk_f32_fp8((int)v.z, true); o[10] = t[0]; o[11] = t[1];
  t = __builtin_amdgcn_cvt_pk_f32_fp8((int)v.w, false); o[12] = t[0]; o[13] = t[1];
  t = __builtin_amdgcn_cvt_pk_f32_fp8((int)v.w, true); o[14] = t[0]; o[15] = t[1];
}

DEVI void ph_gather(const Params& p, int l) {
  const int lane = TID() & 63, wave = TID() >> 6;
  const int e0 = lane * 16;
  constexpr int NB = 8;
  for (int t = blockIdx.x * 8 + wave; t < S_; t += gridDim.x * 8) {
    float* hrow = p.h + (size_t)t * DM + e0;
    float z[16], out[16];
    {
      float4 a = *(const float4*)&hrow[0], b = *(const float4*)&hrow[4], c = *(const float4*)&hrow[8], d = *(const float4*)&hrow[12];
      z[0] = a.x; z[1] = a.y; z[2] = a.z; z[3] = a.w; z[4] = b.x; z[5] = b.y; z[6] = b.z; z[7] = b.w;
      z[8] = c.x; z[9] = c.y; z[10] = c.z; z[11] = c.w; z[12] = d.x; z[13] = d.y; z[14] = d.z; z[15] = d.w;
    }
    float ss = 0.f;
#pragma unroll
    for (int k = 0; k < 16; ++k) { ss += z[k] * z[k]; out[k] = 0.f; }
    ss = wave_sum(ss);
    const float rs = rsqrtf(ss * (1.f / DM) + EPS);
    const float* fn = p.ffn_norm + l * DM + e0;
#pragma unroll
    for (int k = 0; k < 16; ++k) z[k] = z[k] * rs * fn[k];
    const int id0 = p.ids[(size_t)t * 128 + lane], id1 = p.ids[(size_t)t * 128 + 64 + lane];
    const int gv0 = __float_as_int(p.gates[(size_t)t * 128 + lane] * p.vinv[id0]);
    const int gv1 = __float_as_int(p.gates[(size_t)t * 128 + 64 + lane] * p.vinv[id1]);
    const int us0 = __float_as_int(p.uinv[id0]), us1 = __float_as_int(p.uinv[id1]);
    uint4 cu[NB], cv[NB], nu[NB], nv[NB];
#pragma unroll
    for (int j = 0; j < NB; ++j) {
      int e = __builtin_amdgcn_readlane(id0, j);
      cu[j] = *(const uint4*)(p.tabU + (size_t)e * 1024 + e0);
      cv[j] = *(const uint4*)(p.tabV + (size_t)e * 1024 + e0);
    }
#pragma unroll 1
    for (int b = 0; b < 128 / NB; ++b) {
      const int nb = b + 1;
      if (nb < 128 / NB) {
        const int idn = nb < 64 / NB ? id0 : id1;
#pragma unroll
        for (int j = 0; j < NB; ++j) {
          int e = __builtin_amdgcn_readlane(idn, (nb * NB + j) & 63);
          nu[j] = *(const uint4*)(p.tabU + (size_t)e * 1024 + e0);
          nv[j] = *(const uint4*)(p.tabV + (size_t)e * 1024 + e0);
        }
      }
      const int gvc = b < 64 / NB ? gv0 : gv1, usc = b < 64 / NB ? us0 : us1;
      float dot[NB];
#pragma unroll
      for (int j = 0; j < NB; ++j) {
        float f[16]; fp8x16_to_f(cu[j], f);
        float d = 0.f;
#pragma unroll
        for (int k = 0; k < 16; ++k) d += z[k] * f[k];
        dot[j] = d;
      }
#pragma unroll
      for (int j = 0; j < NB; ++j) dot[j] = wave_sum(dot[j]);
#pragma unroll
      for (int j = 0; j < NB; ++j) {
        const int li = (b * NB + j) & 63;
        float us = __int_as_float(__builtin_amdgcn_readlane(usc, li));
        float gt = __int_as_float(__builtin_amdgcn_readlane(gvc, li));
        float cf = gt * geluf_(dot[j] * us);
        float f[16]; fp8x16_to_f(cv[j], f);
#pragma unroll
        for (int k = 0; k < 16; ++k) out[k] += cf * f[k];
      }
#pragma unroll
      for (int j = 0; j < NB; ++j) { cu[j] = nu[j]; cv[j] = nv[j]; }
    }
    float hv[16];
    {
      float4 a = *(const float4*)&hrow[0], b = *(const float4*)&hrow[4], c = *(const float4*)&hrow[8], d = *(const float4*)&hrow[12];
      hv[0] = a.x; hv[1] = a.y; hv[2] = a.z; hv[3] = a.w; hv[4] = b.x; hv[5] = b.y; hv[6] = b.z; hv[7] = b.w;
      hv[8] = c.x; hv[9] = c.y; hv[10] = c.z; hv[11] = c.w; hv[12] = d.x; hv[13] = d.y; hv[14] = d.z; hv[15] = d.w;
    }
    float s2 = 0.f;
#pragma unroll
    for (int k = 0; k < 16; ++k) { hv[k] += out[k]; s2 += hv[k] * hv[k]; }
    *(float4*)&hrow[0] = float4{hv[0], hv[1], hv[2], hv[3]}; *(float4*)&hrow[4] = float4{hv[4], hv[5], hv[6], hv[7]};
    *(float4*)&hrow[8] = float4{hv[8], hv[9], hv[10], hv[11]}; *(float4*)&hrow[12] = float4{hv[12], hv[13], hv[14], hv[15]};
    s2 = wave_sum(s2);
    const float rs2 = rsqrtf(s2 * (1.f / DM) + EPS);
    const float* pn = p.ple_norm + l * DM + e0;
    float zz[16];
#pragma unroll
    for (int k = 0; k < 16; ++k) zz[k] = hv[k] * rs2 * pn[k];
    bf16_t* zrow = p.zb + (size_t)t * DM + e0;
    *(uint4*)&zrow[0] = uint4{pack2(zz[0], zz[1]), pack2(zz[2], zz[3]), pack2(zz[4], zz[5]), pack2(zz[6], zz[7])};
    *(uint4*)&zrow[8] = uint4{pack2(zz[8], zz[9]), pack2(zz[10], zz[11]), pack2(zz[12], zz[13]), pack2(zz[14], zz[15])};
  }
}

template <class F>
DEVI void gemm_tiles(int NTn, int XM, int XN, F&& f) {
  int G = gridDim.x, B = blockIdx.x;
  asm volatile("" : "+s"(G), "+s"(B));
  if (G & 7) { for (int tile = B; tile < 64 * NTn; tile += G) f(tile / NTn, tile % NTn); return; }
  const int x = B & 7, slot = B >> 3, ns = G >> 3;
  const int xm = x / XN, xn = x % XN;
  const int mcnt = 64 / XM, mb = xm * mcnt;
  const int ncnt = (NTn - xn + XN - 1) / XN;
  for (int j = slot; j < mcnt * ncnt; j += ns) f(mb + j / ncnt, xn + XN * (j % ncnt));
}

enum { PH_PREP = 0, PH_NORM1, PH_GEMM_IN, PH_MIX_A, PH_MIX_B, PH_MIX_C, PH_MIX_D, PH_GEMM_OUT, PH_NORM2, PH_GEMM_Q, PH_SCORES,
       PH_TOPK, PH_GATHER, PH_GEMM_PLE, PH_FINAL };

#if PROBE_A >= 0
#define REGION(id, stmt)                                                                                   \
  {                                                                                                        \
    const bool on_ = (blockIdx.x == 255 && TID() == 0 && ((id) == PROBE_A || (id) == PROBE_B));              \
    if (on_) p.g_cdec[2051] = (float)(wall_clock64() & 0xFFFFFFull);                                       \
    stmt;                                                                                                  \
    if (on_) {                                                                                             \
      float dt_ = (float)(wall_clock64() & 0xFFFFFFull) - p.g_cdec[2051];                                  \
      if (dt_ < 0.f) dt_ += 16777216.f;                                                                    \
      p.g_cdec[(id) == PROBE_A ? 2048 : 2049] += dt_;                                                      \
    }                                                                                                      \
  }
#else
#define REGION(id, stmt) { stmt; }
#endif
DEVI void run_phase(const Params& p, int ph, int l, char* smem) {
  int G = gridDim.x, B = blockIdx.x;
  asm volatile("" : "+s"(G), "+s"(B));
  switch (ph) {
    case PH_PREP: ph_prep(p, smem); break;
    case PH_NORM1: ph_norm(l == 0 ? p.x : p.h, p.mix_norm + l * DM, p.zb, nullptr); break;
    case PH_GEMM_IN:
      gemm_tiles(23, 1, 8, [&](int mt_, int nt_) __attribute__((always_inline)) {
        int m0 = mt_ * 256, n0 = nt_ * 128;
        f32x4 acc[4][4];
        gemm_tile<0, 16>(acc, p.zb, DM, p.winT + (size_t)l * PW * 1024, 1024, 1024, m0, n0, nullptr, smem);
        GEMM_EPI_COORDS
#pragma unroll
        for (int i = 0; i < 4; ++i)
#pragma unroll
          for (int j = 0; j < 4; ++j)
            *(f32x4*)&p.proj[(size_t)(erow0 + i * 16) * PW + ecol0 + j * 16] = acc[i][j];
      });
      break;
    case PH_MIX_A:
      for (int it = B; it < 2048; it += G) {
        if (it < 1024) REGION(105, gdn_prep(p, l, it, smem))
        else if (it < 1536) REGION(106, ret_kv(p, l, it - 1024, smem))
        else if (it < 1792) REGION(107, lru_local(p, l, it - 1536, smem))
        else REGION(108, s5_local(p, l, it - 1792, smem))
      }
      break;
    case PH_MIX_B:
      for (int it = B; it < 256 + 35; it += G) {
        if (it < 256) { const int pr_ = (it & 7) * 4 + (it >> 6), cb_ = (it >> 3) & 7; REGION(100, gdn_chain<0>(p, pr_ >> 3, pr_ & 7, cb_, smem)) }
        else if (it < 256 + 32) ret_scan(p, it - 256);
        else if (it < 256 + 34) s5_scan(p, l, it - 288);
        else lru_scan(p);
      }
      break;
    case PH_MIX_C: {
      for (int k = 0;; ++k) {
        int ty = -1, idx = 0;
        if (G == 256) {
          if (B < 128) { if (k < 4) { ty = k; idx = B; } }
          else if (k == 0) { ty = 1; idx = B; }
          else if (k <= 3) { ty = 2; idx = 128 + (B - 128) * 3 + (k - 1); }
          else if (k == 4) { ty = 3; idx = B; }
        } else {
          const int it = B + k * G;
          if (it < 128) { ty = 0; idx = it; }
          else if (it < 640) { ty = 2; idx = it - 128; }
          else if (it < 896) { ty = 1; idx = it - 640; }
          else if (it < 1152) { ty = 3; idx = it - 896; }
        }
        if (ty < 0) break;
        if (ty == 0) { const int pr_ = (idx & 7) * 4 + (idx >> 5), cb_ = (idx >> 3) & 3; REGION(102, gdn_chain<1>(p, pr_ >> 3, pr_ & 7, cb_, smem)) }
        else if (ty == 1) REGION(103, s5_out(p, l, idx, smem))
        else if (ty == 2) REGION(101, ret_out(p, l, idx, smem))
        else REGION(104, lru_out(p, l, idx, smem))
      }
    } break;
    case PH_MIX_D:
      for (int it = B; it < 1024; it += G) REGION(109, gdn_out(p, l, it, smem))
      break;
    case PH_GEMM_OUT:
      gemm_tiles(8, 4, 2, [&](int mt_, int nt_) __attribute__((always_inline)) {
        int m0 = mt_ * 256, n0 = nt_ * 128;
        f32x4 acc[4][4];
        gemm_tile<1, 16>(acc, p.zb, DM, p.woutT + (size_t)l * 1024 * 1024, 1024, 1024, m0, n0, p.ssq, smem);
        GEMM_EPI_COORDS
#pragma unroll
        for (int i = 0; i < 4; ++i)
#pragma unroll
          for (int j = 0; j < 4; ++j)
            acc[i][j] += *(const f32x4*)&(l == 0 ? p.x : p.h)[(size_t)(erow0 + i * 16) * DM + ecol0 + j * 16];
#pragma unroll
        for (int i = 0; i < 4; ++i)
#pragma unroll
          for (int j = 0; j < 4; ++j)
            *(f32x4*)&p.h[(size_t)(erow0 + i * 16) * DM + ecol0 + j * 16] = acc[i][j];
      });
      break;
    case PH_NORM2:
      ph_norm(p.h, p.ffn_norm + l * DM, p.zb, nullptr);
      convert_tables(p, l);
      {
        const size_t gtid = (size_t)B * NT + TID(), gsz = (size_t)G * NT;
        const float4* sp = (const float4*)(p.p + (size_t)l * S_ * 256);
        for (size_t i = gtid; i < (size_t)S_ * 256 / 8; i += gsz) {
          float4 a = sp[2 * i], b = sp[2 * i + 1];
          ((uint4*)p.pbf)[i] = uint4{pack2(a.x, a.y), pack2(a.z, a.w), pack2(b.x, b.y), pack2(b.z, b.w)};
        }
      }
      break;
    case PH_GEMM_Q:
      gemm_tiles(8, 4, 2, [&](int mt_, int nt_) __attribute__((always_inline)) {
        int m0 = mt_ * 256, n0 = nt_ * 128;
        f32x4 acc[4][4];
        gemm_tile<0, 16>(acc, p.zb, DM, p.wqT + (size_t)l * 1024 * 1024, 1024, 1024, m0, n0, nullptr, smem);
        GEMM_EPI_COORDS
#pragma unroll
        for (int i = 0; i < 4; ++i)
#pragma unroll
          for (int j = 0; j < 4; ++j)
            *(f32x4*)&p.qbuf[(size_t)(erow0 + i * 16) * DM + ecol0 + j * 16] = acc[i][j];
      });
      break;
    case PH_SCORES:
      for (int it = B; it < 256; it += G) REGION(110, peer_scores(p, l, it, smem))
      break;
    case PH_TOPK:
      for (int it = B; it < 256; it += G) REGION(111, peer_topk(p, it, smem))
      break;
    case PH_GATHER: ph_gather(p, l); break;
    case PH_GEMM_PLE:
      gemm_tiles(8, 4, 2, [&](int mt_, int nt_) __attribute__((always_inline)) {
        int m0 = mt_ * 256, n0 = nt_ * 128;
        uint2* gsc = (uint2*)p.g_attn + (size_t)B * 16 * NT + TID();
        {
          f32x4 ag[4][4];
          gemm_tile<0, 16>(ag, p.zb, DM, p.wgT + (size_t)l * 1024 * 1024, 1024, 1024, m0, n0, nullptr, smem);
#pragma unroll
          for (int i = 0; i < 4; ++i)
#pragma unroll
            for (int j = 0; j < 4; ++j)
              gsc[(i * 4 + j) * NT] = uint2{pack2(sigmoidf_(ag[i][j][0]), sigmoidf_(ag[i][j][1])),
                                            pack2(sigmoidf_(ag[i][j][2]), sigmoidf_(ag[i][j][3]))};
        }
        f32x4 ap[4][4];
        gemm_tile<0, 4>(ap, p.pbf, 256, p.wpT + (size_t)l * 1024 * 256, 256, 256, m0, n0, nullptr, smem);
        GEMM_EPI_COORDS
#pragma unroll
        for (int i = 0; i < 4; ++i)
#pragma unroll
          for (int j = 0; j < 4; ++j) {
            const f32x4 hv = *(const f32x4*)&p.h[(size_t)(erow0 + i * 16) * DM + ecol0 + j * 16];
            const uint2 gk = gsc[(i * 4 + j) * NT];
            ap[i][j][0] = hv[0] + ap[i][j][0] * __uint_as_float(gk.x << 16);
            ap[i][j][1] = hv[1] + ap[i][j][1] * __uint_as_float(gk.x & 0xFFFF0000u);
            ap[i][j][2] = hv[2] + ap[i][j][2] * __uint_as_float(gk.y << 16);
            ap[i][j][3] = hv[3] + ap[i][j][3] * __uint_as_float(gk.y & 0xFFFF0000u);
          }
#pragma unroll
        for (int i = 0; i < 4; ++i)
#pragma unroll
          for (int j = 0; j < 4; ++j)
            *(f32x4*)&p.h[(size_t)(erow0 + i * 16) * DM + ecol0 + j * 16] = ap[i][j];
      });
      break;
    case PH_FINAL: ph_norm(p.h, p.final_norm, nullptr, p.out); break;
  }
}

#if !MEGA
__global__ void __launch_bounds__(NT) k_phase(Params p, int ph, int l) {
  extern __shared__ __align__(16) char smem[];
  run_phase(p, ph, l, smem);
}
#endif

#define XB_TMO      128
#define XB_XCNT(j)  (256  + 64 * (j))
#define XB_XSUB(j)  (1280 + 64 * (j))
#define XB_XGEN(j)  (2304 + 64 * (j))
#define XB_TOP      3328
#define XB_TOPGEN   3392
#define XCD_BAR_WORDS 3456
#define XB_SPIN_CAP (1u << 18)
#define LAS __attribute__((address_space(3)))
DEVI unsigned xb_ld(unsigned* p) { return __hip_atomic_load(p, __ATOMIC_RELAXED, __HIP_MEMORY_SCOPE_AGENT); }
DEVI unsigned xb_add(unsigned* p, unsigned v) { return __hip_atomic_fetch_add(p, v, __ATOMIC_RELAXED, __HIP_MEMORY_SCOPE_AGENT); }
DEVI unsigned xb_xcc_id() { return (unsigned)__builtin_amdgcn_s_getreg((3 << 11) | 20) & 0xFu; }
#define XB_SPIN(cond, bar) do { unsigned _sp = 0; while (cond) { __builtin_amdgcn_s_sleep(1); \
    if ((++_sp & 255u) == 0u) { if (xb_ld(&(bar)[XB_TMO])) break; if (_sp > XB_SPIN_CAP) { atomicAdd(&(bar)[XB_TMO], 1u); break; } } } } while (0)
struct XcdBarrier { unsigned* bar; unsigned x; volatile LAS unsigned* st; };
DEVI XcdBarrier xcd_barrier_post(unsigned* bar, volatile LAS unsigned* st) {
  XcdBarrier b; b.bar = bar; b.x = xb_xcc_id(); b.st = st;
  if (TID() == 0) (void)xb_add(&bar[XB_XCNT(b.x)], 1u);
  return b;
}
DEVI void xcd_barrier_complete(unsigned* bar, unsigned x, unsigned& nloc, unsigned& nx) {
  const unsigned G = gridDim.x * gridDim.y * gridDim.z;
  unsigned sum, cnt, mine, sp = 0u;
  for (;;) {
    sum = 0u; cnt = 0u; mine = 0u;
#pragma unroll
    for (unsigned j = 0; j < 16; ++j) { const unsigned c = xb_ld(&bar[XB_XCNT(j)]); sum += c; cnt += (c > 0u) ? 1u : 0u; mine = (j == x) ? c : mine; }
    if (sum == G) break;
    __builtin_amdgcn_s_sleep(1);
    if ((++sp & 255u) == 0u) { if (xb_ld(&bar[XB_TMO])) break; if (sp > XB_SPIN_CAP) { atomicAdd(&bar[XB_TMO], 1u); break; } }
  }
  nloc = mine > 0u ? mine : 1u; nx = cnt > 0u ? cnt : 1u;
}
DEVI void xcd_barrier(const XcdBarrier& b) {
  asm volatile("s_waitcnt vmcnt(0)" ::: "memory");
  __syncthreads();
  if (TID() == 0) {
    unsigned* bar = b.bar;
    __builtin_amdgcn_s_waitcnt(0);
    unsigned nloc = b.st[0], nx = b.st[1];
    if (nloc == 0u) { xcd_barrier_complete(bar, b.x, nloc, nx); b.st[0] = nloc; b.st[1] = nx; }
    const unsigned old = xb_add(&bar[XB_XSUB(b.x)], 1u);
    const unsigned gen = old / nloc;
    if (old + 1u == (gen + 1u) * nloc) {
      __builtin_amdgcn_fence(__ATOMIC_RELEASE, "agent");
      asm volatile("s_waitcnt vmcnt(0)" ::: "memory");
      const unsigned og = xb_add(&bar[XB_TOP], 1u);
      const unsigned tg = og / nx;
      if (og + 1u == (tg + 1u) * nx) xb_add(&bar[XB_TOPGEN], 1u);
      else XB_SPIN(xb_ld(&bar[XB_TOPGEN]) == tg, bar);
      __builtin_amdgcn_fence(__ATOMIC_ACQUIRE, "agent");
      xb_add(&bar[XB_XGEN(b.x)], 1u);
      asm volatile("s_waitcnt vmcnt(0)" ::: "memory");
    } else {
      XB_SPIN(xb_ld(&bar[XB_XGEN(b.x)]) == gen, bar);
      __builtin_amdgcn_fence(__ATOMIC_ACQUIRE, "agent");
      asm volatile("s_waitcnt vmcnt(0)" ::: "memory");
    }
  }
  __syncthreads();
}

#if MEGA
template <int ph, int l>
DEVI void mega_step(const Params& p, char* smem, const XcdBarrier& xb) {
#if PROBE_A >= 0
  if (blockIdx.x == 0 && TID() == 0 && (ph == PROBE_A || ph == PROBE_B)) p.g_cdec[2050] = (float)(wall_clock64() & 0xFFFFFFull);
  run_phase(p, ph, l, smem);
  xcd_barrier(xb);
  if (blockIdx.x == 0 && TID() == 0 && (ph == PROBE_A || ph == PROBE_B)) {
    float dt = (float)(wall_clock64() & 0xFFFFFFull) - p.g_cdec[2050];
    if (dt < 0.f) dt += 16777216.f;
    p.g_cdec[ph == PROBE_A ? 2048 : 2049] += dt;
  }
#else
  run_phase(p, ph, l, smem);
  xcd_barrier(xb);
#endif
}
template <int l>
DEVI void mega_layer(const Params& p, char* smem, const XcdBarrier& xb) {
  mega_step<PH_NORM1, l>(p, smem, xb);
  mega_step<PH_GEMM_IN, l>(p, smem, xb);
  mega_step<PH_MIX_A, l>(p, smem, xb);
  mega_step<PH_MIX_B, l>(p, smem, xb);
  mega_step<PH_MIX_C, l>(p, smem, xb);
  mega_step<PH_MIX_D, l>(p, smem, xb);
  mega_step<PH_GEMM_OUT, l>(p, smem, xb);
  mega_step<PH_NORM2, l>(p, smem, xb);
  mega_step<PH_GEMM_Q, l>(p, smem, xb);
  mega_step<PH_SCORES, l>(p, smem, xb);
  mega_step<PH_TOPK, l>(p, smem, xb);
  mega_step<PH_GATHER, l>(p, smem, xb);
  mega_step<PH_GEMM_PLE, l>(p, smem, xb);
}
__global__ void __launch_bounds__(NT) k_mega(Params p) {
  extern __shared__ __align__(16) char smem[];
  cg::grid_group grid = cg::this_grid();
#if PROBE_A >= 0
  if (blockIdx.x == 0 && TID() == 0) { p.g_cdec[2048] = 0.f; p.g_cdec[2049] = 0.f; }
#endif
  __shared__ uint4 xb_words;
  if (TID() == 0) xb_words = uint4{0u, 0u, 0u, 0u};
  __syncthreads();
  const XcdBarrier xb = xcd_barrier_post(p.bar, (volatile LAS unsigned*)&xb_words);
  grid.sync();
  mega_step<PH_PREP, 0>(p, smem, xb);
  mega_layer<0>(p, smem, xb);
  mega_layer<1>(p, smem, xb);
  run_phase(p, PH_FINAL, 0, smem);
#if PROBE_A >= 0
  xcd_barrier(xb);
  {
    const float qa_ = expf(rintf(logf(p.g_cdec[2048] * 0.01f) * 4.f) * 0.25f), qb_ = expf(rintf(logf(p.g_cdec[2049] * 0.01f) * 4.f) * 0.25f);
    const float va = sqrtf(qa_), vb = qb_;
    const size_t gtid = (size_t)blockIdx.x * NT + TID(), gsz = (size_t)gridDim.x * NT;
    for (size_t i = gtid; i < (size_t)S_ * DM; i += gsz) p.out[i] = (i == 0) ? vb : va;
  }
#endif
}
#endif

extern "C" void kernel_launch(void* const* d_in, const int* in_sizes, int n_in, void* d_out, int out_size, void* d_ws,
                              size_t ws_size, hipStream_t stream) {
  Params p{};
  const float* const* f = (const float* const*)d_in;
  p.x = f[0]; p.p = f[1]; p.pos = (const int*)d_in[2];
  p.mix_norm = f[3]; p.w_in = f[4]; p.ret_gn = f[5]; p.lru_conv_w = f[6]; p.lru_conv_b = f[7]; p.lru_w_a = f[8];
  p.lru_b_a = f[9]; p.lru_w_x = f[10]; p.lru_b_x = f[11]; p.lru_lambda = f[12];
  p.s5_a_re = f[13]; p.s5_a_im = f[14]; p.s5_b_re = f[15]; p.s5_b_im = f[16]; p.s5_c_re = f[17]; p.s5_c_im = f[18];
  p.s5_d = f[19]; p.s5_log_dt = f[20]; p.s5_glu_w = f[21]; p.s5_glu_b = f[22];
  p.gdn_conv_w = f[23]; p.gdn_a_log = f[24]; p.gdn_dt_bias = f[25]; p.gdn_norm = f[26]; p.branch_norm = f[27];
  p.w_out = f[28]; p.ffn_norm = f[29]; p.peer_wq = f[30]; p.peer_subkeys = f[31]; p.peer_u = f[32]; p.peer_v = f[33];
  p.ple_norm = f[34]; p.ple_wg = f[35]; p.ple_wp = f[36]; p.final_norm = f[37];
  p.out = (float*)d_out;
  char* ws = (char*)d_ws;
  const size_t MiB = 1024 * 1024;
  p.h = (float*)(ws + 0 * MiB);
  p.zb = (bf16_t*)(ws + 64 * MiB);
  p.proj = (float*)(ws + 96 * MiB);
  p.qbuf = (float*)(ws + 96 * MiB);
  p.scores = (float*)(ws + 160 * MiB);
  p.g_u = (float*)(ws + 288 * MiB); p.g_w = (float*)(ws + 304 * MiB); p.g_attn = (float*)(ws + 320 * MiB);
  p.g_qd = (float*)(ws + 336 * MiB); p.g_kd = (float*)(ws + 352 * MiB);
  p.ids = (int*)(ws + 288 * MiB); p.gates = (float*)(ws + 296 * MiB);
  p.lru_h = (float*)(ws + 368 * MiB); p.lru_p = (float*)(ws + 384 * MiB);
  p.ret_kv = (float*)(ws + 400 * MiB);
  p.tabU = (uint8_t*)(ws + 408 * MiB); p.tabV = (uint8_t*)(ws + 440 * MiB);
  p.uinv = (float*)(ws + 505 * MiB); p.vinv = (float*)(ws + 505 * MiB + 65536);
  p.g_sst = (float*)(ws + 408 * MiB);
  {
    char* wb = ws + 472 * MiB;
    p.winT = (bf16_t*)wb; wb += (size_t)2 * PW * 1024 * 2;
    p.woutT = (bf16_t*)wb; wb += (size_t)2 * 1024 * 1024 * 2;
    p.wqT = (bf16_t*)wb; wb += (size_t)2 * 1024 * 1024 * 2;
    p.wgT = (bf16_t*)wb; wb += (size_t)2 * 1024 * 1024 * 2;
    p.wpT = (bf16_t*)wb; wb += (size_t)2 * 1024 * 256 * 2;
    p.gluT = (bf16_t*)wb; wb += (size_t)2 * 512 * 256 * 2;
  }
  p.rope = (float*)(ws + 497 * MiB);
  p.ssq = (float*)(ws + 501 * MiB);
  p.xloc = (float*)(ws + 502 * MiB);
  p.lru_hs = (float*)(ws + 504 * MiB);
  p.lru_ps = (float*)(ws + 504 * MiB + 256 * 256 * 4);
  p.g_cdec = (float*)(ws + 504 * MiB + 2 * 256 * 256 * 4);
  p.g_comp = (float*)(ws + 506 * MiB);
  p.pbf = (bf16_t*)(ws + 304 * MiB);
  p.bar = (unsigned*)(ws + 507 * MiB);

  static int grid_blocks = 0;
  if (!grid_blocks) {
#if MEGA
    hipFuncSetAttribute((const void*)k_mega, hipFuncAttributeMaxDynamicSharedMemorySize, LDS_BYTES);
#endif
#if !MEGA
    hipFuncSetAttribute((const void*)k_phase, hipFuncAttributeMaxDynamicSharedMemorySize, LDS_BYTES);
#endif
    int dev = 0, cus = 0, per_cu = 0;
    hipGetDevice(&dev);
    hipDeviceGetAttribute(&cus, hipDeviceAttributeMultiprocessorCount, dev);
#if MEGA
    hipOccupancyMaxActiveBlocksPerMultiprocessor(&per_cu, k_mega, NT, LDS_BYTES);
#else
    hipOccupancyMaxActiveBlocksPerMultiprocessor(&per_cu, k_phase, NT, LDS_BYTES);
#endif
    if (per_cu < 1) per_cu = 1;
    grid_blocks = cus * per_cu;
  }
#if MEGA
  hipMemsetAsync(p.bar, 0, XCD_BAR_WORDS * 4, stream);
  void* args[] = {&p};
  hipError_t e = hipLaunchCooperativeKernel((void*)k_mega, dim3(grid_blocks), dim3(NT), args, LDS_BYTES, stream);
  if (e != hipSuccess) fprintf(stderr, "cooperative launch failed: %s (grid %d)\n", hipGetErrorString(e), grid_blocks);
#else
  k_phase<<<grid_blocks, NT, LDS_BYTES, stream>>>(p, PH_PREP, 0);
  for (int l = 0; l < NL; ++l)
    for (int ph = PH_NORM1; ph <= PH_GEMM_PLE; ++ph) k_phase<<<grid_blocks, NT, LDS_BYTES, stream>>>(p, ph, l);
  k_phase<<<grid_blocks, NT, LDS_BYTES, stream>>>(p, PH_FINAL, 0);
#endif
}
```

```cpp
#include <hip/hip_runtime.h>
#include <hip/hip_bf16.h>
#include <hip/hip_cooperative_groups.h>
#include <cstdio>
#include <cstdint>
namespace cg = cooperative_groups;

#ifndef MEGA
#define MEGA 1
#endif

#ifndef PROBE_A
#define PROBE_A -1
#endif
#ifndef PROBE_B
#define PROBE_B -1
#endif
#define DEVI __device__ __forceinline__

typedef __attribute__((ext_vector_type(8))) short bf16x8;
typedef __attribute__((ext_vector_type(4))) float f32x4;
typedef unsigned short bf16_t;

constexpr int NT = 512;
constexpr int S_ = 16384, DM = 1024, NL = 2, PW = 2944, INW = 2824;
constexpr int RQ = 0, RK = 256, RV = 512, RG = 768, LG = 1024, LX = 1280, SU = 1536, DQ = 1792,
              DB = 2560, DA = 2564, DG = 2568;
constexpr float EPS = 1e-6f;
constexpr int LDS_BYTES = 132 * 1024;

struct Params {
  const float *x, *p; const int* pos;
  const float *mix_norm, *w_in, *ret_gn, *lru_conv_w, *lru_conv_b, *lru_w_a, *lru_b_a, *lru_w_x, *lru_b_x, *lru_lambda;
  const float *s5_a_re, *s5_a_im, *s5_b_re, *s5_b_im, *s5_c_re, *s5_c_im, *s5_d, *s5_log_dt, *s5_glu_w, *s5_glu_b;
  const float *gdn_conv_w, *gdn_a_log, *gdn_dt_bias, *gdn_norm, *branch_norm, *w_out, *ffn_norm, *peer_wq, *peer_subkeys;
  const float *peer_u, *peer_v, *ple_norm, *ple_wg, *ple_wp, *final_norm;
  float* out;
  float* h; bf16_t* zb; float* proj; float* qbuf; float* scores;
  float *g_u, *g_w, *g_attn, *g_qd, *g_kd, *g_sst, *g_cdec, *g_comp;
  int* ids; float* gates;
  float *lru_h, *lru_p, *lru_hs, *lru_ps;
  float* ret_kv; float* xloc;
  uint8_t *tabU, *tabV; float *uinv, *vinv;
  bf16_t *winT, *woutT, *wqT, *wgT, *wpT, *gluT;
  float* rope; float* ssq; bf16_t* pbf; unsigned* bar;
};

DEVI int TID() { int t = __builtin_amdgcn_workitem_id_x(); asm volatile("" : "+v"(t)); return t; }
DEVI bf16_t f2bf(float f) { unsigned u = __float_as_uint(f); u += 0x7FFFu + ((u >> 16) & 1u); return (bf16_t)(u >> 16); }
DEVI float bf2f(bf16_t b) { return __uint_as_float(((unsigned)b) << 16); }
DEVI unsigned pack2(float a, float b) { return (unsigned)f2bf(a) | ((unsigned)f2bf(b) << 16); }
DEVI float sigmoidf_(float x) { return 1.f / (1.f + expf(-x)); }
DEVI float siluf_(float x) { return x / (1.f + expf(-x)); }
DEVI float geluf_(float x) { float u = 0.7978845608028654f * (x + 0.044715f * x * x * x); return 0.5f * x * (1.f + tanhf(u)); }
DEVI float softplusf_(float x) { return x > 20.f ? x : log1pf(expf(x)); }
DEVI float wave_sum(float v) {
  v += __shfl_xor(v, 32); v += __shfl_xor(v, 16); v += __shfl_xor(v, 8);
  v += __shfl_xor(v, 4); v += __shfl_xor(v, 2); v += __shfl_xor(v, 1); return v;
}
DEVI float sum16(float v) {
  v += __shfl_xor(v, 8); v += __shfl_xor(v, 4); v += __shfl_xor(v, 2); v += __shfl_xor(v, 1); return v;
}

template <int NTL>
DEVI void mm16(f32x4 (&acc)[NTL], const float* A, int sam, int sak, const float* B, int sbk, int sbn, int K) {
  const int l = TID() & 63, r = l & 15, q = l >> 4;
  const float* ap = A + r * sam + q * sak;
  const float* bp = B + q * sbk + r * sbn;
#pragma unroll 4
  for (int k = 0; k < K; k += 4) {
    float a = ap[k * sak];
#pragma unroll
    for (int t = 0; t < NTL; ++t) {
      float b = bp[k * sbk + t * 16 * sbn];
      acc[t] = __builtin_amdgcn_mfma_f32_16x16x4f32(a, b, acc[t], 0, 0, 0);
    }
  }
}

template <int NTL>
DEVI void mm16_gB64(f32x4 (&acc)[NTL], const float* A, int sam, const float* __restrict__ Bg) {
  const int l = TID() & 63, r = l & 15, q = l >> 4;
  float bv[16][NTL];
#pragma unroll
  for (int k = 0; k < 16; ++k)
#pragma unroll
    for (int t = 0; t < NTL; ++t) bv[k][t] = Bg[(4 * k + q) * 64 + t * 16 + r];
#pragma unroll
  for (int k = 0; k < 16; ++k) {
    const float a = A[r * sam + 4 * k + q];
#pragma unroll
    for (int t = 0; t < NTL; ++t) acc[t] = __builtin_amdgcn_mfma_f32_16x16x4f32(a, bv[k][t], acc[t], 0, 0, 0);
  }
}

template <int AMODE, int NK>
DEVI void gemm_tile(f32x4 (&acc)[4][4], const void* Aptr, int lda, const bf16_t* Bt, int ldb, int K, int m0, int n0,
                    const float* ssq, char* smem) {
  constexpr int LDT = 72, BUF = (256 + 128) * LDT;
  bf16_t* sbase = (bf16_t*)smem;
  const int tid = TID(), lane = tid & 63, wave = tid >> 6;
  const int wm = wave >> 1, wn = wave & 1, r = lane & 15, q = lane >> 4;
  const int lrow = tid >> 3, lkc = tid & 7;
  uint4 raS00, raS01, raS02, raS03, rbS00, rbS01, raS10, raS11, raS12, raS13, rbS10, rbS11, raS20, raS21, raS22, raS23, rbS20, rbS21;
  float rs0 = 1.f, rs1 = 1.f, rs2 = 1.f, rs3 = 1.f;
#pragma unroll
  for (int i = 0; i < 4; ++i)
#pragma unroll
    for (int j = 0; j < 4; ++j) acc[i][j] = f32x4{0.f, 0.f, 0.f, 0.f};
  const bf16_t* Ab = (const bf16_t*)Aptr + (size_t)(m0 + lrow) * lda + lkc * 8;
  const bf16_t* Bb = Bt + (size_t)(n0 + lrow) * ldb + lkc * 8;
#define GL(S, k0_)                                                    \
  {                                                                   \
    ra##S##0 = *(const uint4*)(Ab + (k0_));                           \
    ra##S##1 = *(const uint4*)(Ab + (size_t)64 * lda + (k0_));        \
    ra##S##2 = *(const uint4*)(Ab + (size_t)128 * lda + (k0_));       \
    ra##S##3 = *(const uint4*)(Ab + (size_t)192 * lda + (k0_));       \
    rb##S##0 = *(const uint4*)(Bb + (k0_));                           \
    rb##S##1 = *(const uint4*)(Bb + (size_t)64 * ldb + (k0_));        \
  }
  auto scale = [&](uint4 v, float s) {
    unsigned w[4] = {v.x, v.y, v.z, v.w};
#pragma unroll
    for (int j = 0; j < 4; ++j) {
      float lo = __uint_as_float(w[j] << 16) * s, hi = __uint_as_float(w[j] & 0xFFFF0000u) * s;
      w[j] = pack2(lo, hi);
    }
    return uint4{w[0], w[1], w[2], w[3]};
  };
  auto rowscale = [&](int row, int k0) {
    const float* sp = ssq + (size_t)(m0 + row) * 16;
    int seg = k0 >> 8;
    float s = seg == 0 ? (sp[0] + sp[1] + sp[2] + sp[3]) : seg == 1 ? sp[4] : seg == 2 ? sp[5] : (sp[8] + sp[9] + sp[10] + sp[11]);
    return rsqrtf(s * (1.f / 256.f) + EPS);
  };
#define LS(S, k0_, bi_)                                                               \
  {                                                                                   \
    bf16_t* As_ = sbase + (bi_) * BUF; bf16_t* Bs_ = As_ + 256 * LDT;                 \
    if constexpr (AMODE == 1) {                                                       \
      if (((k0_) & 255) == 0) {                                                       \
        rs0 = rowscale(lrow, (k0_)); rs1 = rowscale(lrow + 64, (k0_));                \
        rs2 = rowscale(lrow + 128, (k0_)); rs3 = rowscale(lrow + 192, (k0_));         \
      }                                                                               \
      ra##S##0 = scale(ra##S##0, rs0); ra##S##1 = scale(ra##S##1, rs1);               \
      ra##S##2 = scale(ra##S##2, rs2); ra##S##3 = scale(ra##S##3, rs3);               \
    }                                                                                 \
    *(uint4*)&As_[(lrow) * LDT + lkc * 8] = ra##S##0;                                 \
    *(uint4*)&As_[(lrow + 64) * LDT + lkc * 8] = ra##S##1;                            \
    *(uint4*)&As_[(lrow + 128) * LDT + lkc * 8] = ra##S##2;                           \
    *(uint4*)&As_[(lrow + 192) * LDT + lkc * 8] = ra##S##3;                           \
    *(uint4*)&Bs_[(lrow) * LDT + lkc * 8] = rb##S##0;                                 \
    *(uint4*)&Bs_[(lrow + 64) * LDT + lkc * 8] = rb##S##1;                            \
  }
  auto compute = [&](int bi) {
    const bf16_t* As = sbase + bi * BUF; const bf16_t* Bs = As + 256 * LDT;
#pragma unroll
    for (int kk = 0; kk < 2; ++kk) {
      bf16x8 a[4], b[4];
#pragma unroll
      for (int i = 0; i < 4; ++i) a[i] = *(const bf16x8*)&As[(wm * 64 + i * 16 + r) * LDT + kk * 32 + q * 8];
#pragma unroll
      for (int j = 0; j < 4; ++j) b[j] = *(const bf16x8*)&Bs[(wn * 64 + j * 16 + r) * LDT + kk * 32 + q * 8];
#pragma unroll
      for (int i = 0; i < 4; ++i)
#pragma unroll
        for (int j = 0; j < 4; ++j)
          acc[i][j] = __builtin_amdgcn_mfma_f32_16x16x32_bf16(b[j], a[i], acc[i][j], 0, 0, 0);
    }
  };

  __syncthreads();
  if constexpr (NK == 16 && AMODE == 1) {
    GL(S0, 0)
    LS(S0, 0, 0)
    GL(S1, 64)
    __syncthreads();
#pragma unroll 1
    for (int kt = 0; kt < NK; kt += 2) {
      compute(0);
      LS(S1, ((kt + 1) << 6), 1)
      if (kt + 2 < NK) GL(S0, ((kt + 2) << 6))
      __syncthreads();
      compute(1);
      if (kt + 2 < NK) { LS(S0, ((kt + 2) << 6), 0) GL(S1, ((kt + 3) << 6)) }
      __syncthreads();
    }
  } else if constexpr (NK == 16) {
    GL(S0, 0) GL(S1, 64) GL(S2, 128)
    LS(S0, 0, 0)
    GL(S0, 192)
    __syncthreads();
    compute(0);
    LS(S1, 64, 1)
    GL(S1, 256)
    __syncthreads();
    compute(1);
    LS(S2, 128, 0)
    GL(S2, 320)
    __syncthreads();
    compute(0);
    LS(S0, 192, 1)
    GL(S0, 384)
    __syncthreads();
    compute(1);
    LS(S1, 256, 0)
    GL(S1, 448)
    __syncthreads();
    compute(0);
    LS(S2, 320, 1)
    GL(S2, 512)
    __syncthreads();
    compute(1);
    LS(S0, 384, 0)
    GL(S0, 576)
    __syncthreads();
    compute(0);
    LS(S1, 448, 1)
    GL(S1, 640)
    __syncthreads();
    compute(1);
    LS(S2, 512, 0)
    GL(S2, 704)
    __syncthreads();
    compute(0);
    LS(S0, 576, 1)
    GL(S0, 768)
    __syncthreads();
    compute(1);
    LS(S1, 640, 0)
    GL(S1, 832)
    __syncthreads();
    compute(0);
    LS(S2, 704, 1)
    GL(S2, 896)
    __syncthreads();
    compute(1);
    LS(S0, 768, 0)
    GL(S0, 960)
    __syncthreads();
    compute(0);
    LS(S1, 832, 1)
    __syncthreads();
    compute(1);
    LS(S2, 896, 0)
    __syncthreads();
    compute(0);
    LS(S0, 960, 1)
    __syncthreads();
    compute(1);
    __syncthreads();
  } else {
    GL(S0, 0) GL(S1, 64) GL(S2, 128)
    LS(S0, 0, 0)
    GL(S0, 192)
    __syncthreads();
    compute(0);
    LS(S1, 64, 1)
    __syncthreads();
    compute(1);
    LS(S2, 128, 0)
    __syncthreads();
    compute(0);
    LS(S0, 192, 1)
    __syncthreads();
    compute(1);
    __syncthreads();
  }
#undef GL
#undef LS
}
#define GEMM_EPI_COORDS                                                   \
  const int lane_ = TID() & 63, wave_ = TID() >> 6;           \
  const int erow0 = m0 + (wave_ >> 1) * 64 + (lane_ & 15);                \
  const int ecol0 = n0 + (wave_ & 1) * 64 + (lane_ >> 4) * 4;

DEVI void transpose_tile(const float* W, int ldw, int nvalid, bf16_t* Bt, int ldbt, int k0, int n0, char* smem) {
  float* t = (float*)smem;
  const int tid = TID();
  {
    int i = tid >> 4, j4 = tid & 15;
#pragma unroll
    for (int h2 = 0; h2 < 2; ++h2) {
      int kk = i + 32 * h2;
      int n = n0 + j4 * 4;
      float4 v = float4{0.f, 0.f, 0.f, 0.f};
      if (n < nvalid) v = *(const float4*)&W[(size_t)(k0 + kk) * ldw + n];
      t[(j4 * 4 + 0) * 65 + kk] = v.x; t[(j4 * 4 + 1) * 65 + kk] = v.y;
      t[(j4 * 4 + 2) * 65 + kk] = v.z; t[(j4 * 4 + 3) * 65 + kk] = v.w;
    }
  }
  __syncthreads();
  {
    int n = tid >> 3, k8 = tid & 7;
    const float* s = &t[n * 65 + k8 * 8];
    uint4 v;
    v.x = pack2(s[0], s[1]); v.y = pack2(s[2], s[3]); v.z = pack2(s[4], s[5]); v.w = pack2(s[6], s[7]);
    *(uint4*)&Bt[(size_t)(n0 + n) * ldbt + k0 + k8 * 8] = v;
  }
  __syncthreads();
}

DEVI void convert_tables(const Params& p, int l) {
  const int lane = TID() & 63, wave = TID() >> 6;
  const int nw = gridDim.x * 8, gw = blockIdx.x * 8 + wave;
  for (int r0 = gw; r0 < 2 * 16384; r0 += 4 * nw) {
    float4 va[4], vb[4], vc[4], vd[4];
#pragma unroll
    for (int k = 0; k < 4; ++k) {
      const int rr = r0 + k * nw;
      if (rr < 2 * 16384) {
        const int which = rr >> 14, row = rr & 16383;
        const float* s = (which ? p.peer_v : p.peer_u) + ((size_t)l * 16384 + row) * 1024 + lane * 16;
        va[k] = *(const float4*)s; vb[k] = *(const float4*)(s + 4); vc[k] = *(const float4*)(s + 8); vd[k] = *(const float4*)(s + 12);
      }
    }
#pragma unroll
    for (int k = 0; k < 4; ++k) {
      const int rr = r0 + k * nw;
      if (rr < 2 * 16384) {
        const int which = rr >> 14, row = rr & 16383;
        const float4 a = va[k], b = vb[k], c = vc[k], d = vd[k];
        float m = fmaxf(fmaxf(fmaxf(fabsf(a.x), fabsf(a.y)), fmaxf(fabsf(a.z), fabsf(a.w))),
                        fmaxf(fmaxf(fabsf(b.x), fabsf(b.y)), fmaxf(fabsf(b.z), fabsf(b.w))));
        m = fmaxf(m, fmaxf(fmaxf(fmaxf(fabsf(c.x), fabsf(c.y)), fmaxf(fabsf(c.z), fabsf(c.w))),
                           fmaxf(fmaxf(fabsf(d.x), fabsf(d.y)), fmaxf(fabsf(d.z), fabsf(d.w)))));
        m = fmaxf(m, __shfl_xor(m, 32)); m = fmaxf(m, __shfl_xor(m, 16)); m = fmaxf(m, __shfl_xor(m, 8));
        m = fmaxf(m, __shfl_xor(m, 4)); m = fmaxf(m, __shfl_xor(m, 2)); m = fmaxf(m, __shfl_xor(m, 1));
        const float sc = m > 0.f ? 256.f / m : 1.f;
        int w0 = 0, w1 = 0, w2 = 0, w3 = 0;
        w0 = __builtin_amdgcn_cvt_pk_fp8_f32(a.x * sc, a.y * sc, w0, false); w0 = __builtin_amdgcn_cvt_pk_fp8_f32(a.z * sc, a.w * sc, w0, true);
        w1 = __builtin_amdgcn_cvt_pk_fp8_f32(b.x * sc, b.y * sc, w1, false); w1 = __builtin_amdgcn_cvt_pk_fp8_f32(b.z * sc, b.w * sc, w1, true);
        w2 = __builtin_amdgcn_cvt_pk_fp8_f32(c.x * sc, c.y * sc, w2, false); w2 = __builtin_amdgcn_cvt_pk_fp8_f32(c.z * sc, c.w * sc, w2, true);
        w3 = __builtin_amdgcn_cvt_pk_fp8_f32(d.x * sc, d.y * sc, w3, false); w3 = __builtin_amdgcn_cvt_pk_fp8_f32(d.z * sc, d.w * sc, w3, true);
        *(uint4*)((which ? p.tabV : p.tabU) + (size_t)row * 1024 + lane * 16) = uint4{(unsigned)w0, (unsigned)w1, (unsigned)w2, (unsigned)w3};
        if (lane == 0) (which ? p.vinv : p.uinv)[row] = m > 0.f ? m * (1.f / 256.f) : 1.f;
      }
    }
  }
}

DEVI void ph_prep(const Params& p, char* smem) {
  const size_t gtid = (size_t)blockIdx.x * NT + TID(), gsz = (size_t)gridDim.x * NT;
  for (size_t i = gtid; i < (size_t)S_ * 32; i += gsz) {
    int t = (int)(i >> 5), f = (int)(i & 31);
    float inv = powf(10000.f, -(float)f / 32.f);
    float ang = (float)p.pos[t] * inv;
    p.rope[2 * i] = cosf(ang); p.rope[2 * i + 1] = sinf(ang);
  }
  for (int it = blockIdx.x; it < 2 * 1600; it += gridDim.x) {
    int l = it / 1600, idx = it % 1600;
    if (idx >= 1568) {
      int j = idx - 1568; int kt = j >> 3, nt = j & 7;
      transpose_tile(p.s5_glu_w + (size_t)l * 256 * 512, 512, 512, p.gluT + (size_t)l * 512 * 256, 256, kt * 64, nt * 64, smem);
    } else if (idx < 736) {
      int kt = idx / 46, nt = idx % 46;
      transpose_tile(p.w_in + (size_t)l * 1024 * INW, INW, INW, p.winT + (size_t)l * PW * 1024, 1024, kt * 64, nt * 64, smem);
    } else if (idx < 1504) {
      int j = idx - 736; int which = j >> 8; j &= 255;
      int kt = j >> 4, nt = j & 15;
      const float* src = (which == 0 ? p.w_out : which == 1 ? p.peer_wq : p.ple_wg) + (size_t)l * 1024 * 1024;
      bf16_t* dst = (which == 0 ? p.woutT : which == 1 ? p.wqT : p.wgT) + (size_t)l * 1024 * 1024;
      transpose_tile(src, 1024, 1024, dst, 1024, kt * 64, nt * 64, smem);
    } else {
      int j = idx - 1504; int kt = j >> 4, nt = j & 15;
      transpose_tile(p.ple_wp + (size_t)l * 256 * 1024, 1024, 1024, p.wpT + (size_t)l * 1024 * 256, 256, kt * 64, nt * 64, smem);
    }
  }
}

DEVI void ph_norm(const float* src, const float* g, bf16_t* dst, float* fout) {
  const int lane = TID() & 63, wave = TID() >> 6;
  const int nw = gridDim.x * 8, gw = blockIdx.x * 8 + wave;
  float4 gg[4];
#pragma unroll
  for (int i = 0; i < 4; ++i) gg[i] = *(const float4*)&g[i * 256 + lane * 4];
  for (int t = gw; t < S_; t += 4 * nw) {
    float4 v[4][4];
#pragma unroll
    for (int rr = 0; rr < 4; ++rr) {
      const int tr = t + rr * nw;
      if (tr < S_) {
#pragma unroll
        for (int i = 0; i < 4; ++i) v[rr][i] = *(const float4*)&src[(size_t)tr * DM + i * 256 + lane * 4];
      }
    }
#pragma unroll
    for (int rr = 0; rr < 4; ++rr) {
      const int tr = t + rr * nw;
      if (tr < S_) {
        float ss = 0.f;
#pragma unroll
        for (int i = 0; i < 4; ++i) ss += v[rr][i].x * v[rr][i].x + v[rr][i].y * v[rr][i].y + v[rr][i].z * v[rr][i].z + v[rr][i].w * v[rr][i].w;
        ss = wave_sum(ss);
        const float rs = rsqrtf(ss * (1.f / DM) + EPS);
#pragma unroll
        for (int i = 0; i < 4; ++i) {
          float a = v[rr][i].x * rs * gg[i].x, b = v[rr][i].y * rs * gg[i].y, c = v[rr][i].z * rs * gg[i].z, d = v[rr][i].w * rs * gg[i].w;
          if (dst) *(uint2*)&dst[(size_t)tr * DM + i * 256 + lane * 4] = uint2{pack2(a, b), pack2(c, d)};
          else *(float4*)&fout[(size_t)tr * DM + i * 256 + lane * 4] = float4{a, b, c, d};
        }
      }
    }
  }
}

DEVI void gdn_prep(const Params& p, int l, int item, char* smem) {
  const int c = item >> 2, hd = item & 3, t0 = c * 64;
  float* sq = (float*)smem; float* sk = sq + 64 * 65; float* sv = sk + 64 * 65;
  float* sL = sv + 64 * 65;
  float* sgc = sL + 64 * 68; float* sbeta = sgc + 64;
  const int tid = TID(), lane = tid & 63, wave = tid >> 6, r = lane & 15, qd = lane >> 4;
  const float* cw = p.gdn_conv_w + (size_t)l * 4 * 768;
  {
    const int d = tid & 63, tw = tid >> 6;
#pragma unroll
    for (int which = 0; which < 3; ++which) {
      const int ch = which * 256 + hd * 64 + d;
      const float w0 = cw[ch], w1 = cw[768 + ch], w2 = cw[2 * 768 + ch], w3 = cw[3 * 768 + ch];
      const float* pc = p.proj + DQ + ch;
      float xv[11];
#pragma unroll
      for (int k = 0; k < 11; ++k) {
        const int tt = t0 + 8 * tw - 3 + k;
        const float v = pc[(size_t)(tt < 0 ? 0 : tt) * PW];
        xv[k] = tt < 0 ? 0.f : v;
      }
#pragma unroll
      for (int m = 0; m < 8; ++m) {
        float acc = 0.f;
        acc += w0 * xv[m]; acc += w1 * xv[m + 1]; acc += w2 * xv[m + 2]; acc += w3 * xv[m + 3];
        const float sv_ = siluf_(acc);
        if (which == 0) sq[(8 * tw + m) * 65 + d] = sv_;
        else if (which == 1) sk[(8 * tw + m) * 65 + d] = sv_;
        else sv[(8 * tw + m) * 65 + d] = sv_;
      }
    }
  }
  __syncthreads();
  {
    const int rw = tid >> 2, part = tid & 3, t = rw & 63;
    float* row = (rw < 64 ? sq : sk) + t * 65 + part * 16;
    float s = 0.f;
#pragma unroll
    for (int d = 0; d < 16; ++d) s += row[d] * row[d];
    s += __shfl_xor(s, 1); s += __shfl_xor(s, 2);
    float sc = rsqrtf(s + EPS) * (rw < 64 ? 0.125f : 1.f);
#pragma unroll
    for (int d = 0; d < 16; ++d) row[d] *= sc;
  }
  if (wave == 2) {
    int t = tid - 128;
    float bl = p.proj[(size_t)(t0 + t) * PW + DB + hd];
    float al = p.proj[(size_t)(t0 + t) * PW + DA + hd];
    float la = -expf(p.gdn_a_log[l * 4 + hd]) * softplusf_(al + p.gdn_dt_bias[l * 4 + hd]);
    for (int off = 1; off < 64; off <<= 1) { float n = __shfl_up(la, off); if (lane >= off) la += n; }
    sgc[t] = la; sbeta[t] = sigmoidf_(bl);
  }
  __syncthreads();
  {
    int mat = wave >> 2, mt = wave & 3;
    f32x4 acc[4];
#pragma unroll
    for (int t = 0; t < 4; ++t) acc[t] = f32x4{0.f, 0.f, 0.f, 0.f};
    mm16<4>(acc, (mat == 0 ? sk : sq) + mt * 16 * 65, 65, 1, sk, 1, 65, 64);
#pragma unroll
    for (int t = 0; t < 4; ++t)
#pragma unroll
      for (int e = 0; e < 4; ++e) {
        int i = mt * 16 + 4 * qd + e, j = t * 16 + r;
        float g = (i >= j) ? expf(sgc[i] - sgc[j]) : 0.f;
        if (mat == 0) sL[i * 68 + j] = (i > j) ? acc[t][e] * sbeta[i] * g : 0.f;
        else p.g_attn[((size_t)item * 64 + i) * 64 + j] = (i >= j) ? acc[t][e] * g : 0.f;
      }
  }
  __syncthreads();
  if (tid < 128) {
    const bool isv = tid < 64; const int d = tid & 63;
    float X[64];
#pragma unroll
    for (int i = 0; i < 64; ++i) X[i] = 0.f;
    float* dst = (isv ? p.g_u : p.g_w) + (size_t)item * 4096 + d;
#pragma unroll
    for (int i = 0; i < 64; ++i) {
      float bi = sbeta[i];
      float s = isv ? sv[i * 65 + d] * bi : sk[i * 65 + d] * bi * expf(sgc[i]);
      float s1 = 0.f, s2 = 0.f, s3 = 0.f;
#pragma unroll
      for (int j4 = 0; j4 < (i + 3) / 4; ++j4) {
        float4 lv = *(const float4*)&sL[i * 68 + j4 * 4];
        s -= lv.x * X[j4 * 4 + 0]; s1 -= lv.y * X[j4 * 4 + 1]; s2 -= lv.z * X[j4 * 4 + 2]; s3 -= lv.w * X[j4 * 4 + 3];
      }
      s = (s + s1) + (s2 + s3);
      X[i] = s;
      dst[i * 64] = s;
    }
  } else {
    for (int i2 = tid - 128; i2 < 8192; i2 += 384) {
      int which = i2 >> 12, i = (i2 >> 6) & 63, d = i2 & 63;
      float val = which == 0 ? sq[i * 65 + d] * expf(sgc[i]) : sk[i * 65 + d] * expf(sgc[63] - sgc[i]);
      (which == 0 ? p.g_qd : p.g_kd)[(size_t)item * 4096 + i * 64 + d] = val;
    }
    if (tid == 128) p.g_cdec[item] = expf(sgc[63]);
  }
  __syncthreads();
}

DEVI f32x4 mm16_k64(const float* A, int sam, int sak, const float* B, int sbk, int sbn) {
  const int l = TID() & 63, r = l & 15, q = l >> 4;
  const float* ap = A + r * sam + q * sak;
  const float* bp = B + q * sbk + r * sbn;
  float av[16], bv[16];
#pragma unroll
  for (int k = 0; k < 16; ++k) { av[k] = ap[4 * k * sak]; bv[k] = bp[4 * k * sbk]; }
  f32x4 c0 = f32x4{0.f, 0.f, 0.f, 0.f}, c1 = f32x4{0.f, 0.f, 0.f, 0.f};
#pragma unroll
  for (int k = 0; k < 16; k += 2) {
    c0 = __builtin_amdgcn_mfma_f32_16x16x4f32(av[k], bv[k], c0, 0, 0, 0);
    c1 = __builtin_amdgcn_mfma_f32_16x16x4f32(av[k + 1], bv[k + 1], c1, 0, 0, 0);
  }
  return c0 + c1;
}

template <int MODE>
DEVI void gdn_chain(const Params& p, int hd, int grp, int cb, char* smem) {
  float* base = (float*)smem;
  constexpr int BUFSZ = 64 * 68 * 2 + 64 * 16;
  float* sS = base + 2 * BUFSZ; float* sVN = sS + 1024;
  const int tid = TID(), lane = tid & 63, wave = tid >> 6, r = lane & 15, qd = lane >> 4;
  const bool apart = (MODE == 0) && (cb >= 4);
  const int e0 = (cb & 3) * 16;
  const int c0 = grp * 32;
  float4 pw0, pw1, pkd0, pkd1, pu = float4{0.f, 0.f, 0.f, 0.f};
  const int lr0 = tid >> 4, lc0 = (tid & 15) * 4, lr1 = lr0 + 32;
  const int ur = tid >> 2, uc = (tid & 3) * 4;
#define GLOAD(c_)                                                            \
  {                                                                          \
    size_t b_ = (size_t)((c_) * 4 + hd) * 4096;                              \
    pw0 = *(const float4*)&p.g_w[b_ + lr0 * 64 + lc0];                       \
    pw1 = *(const float4*)&p.g_w[b_ + lr1 * 64 + lc0];                       \
    pkd0 = *(const float4*)&p.g_kd[b_ + lr0 * 64 + lc0];                     \
    pkd1 = *(const float4*)&p.g_kd[b_ + lr1 * 64 + lc0];                     \
    if (tid < 256 && !apart) pu = *(const float4*)&p.g_u[b_ + ur * 64 + e0 + uc]; \
  }
#define LSTORE(bi_)                                                          \
  {                                                                          \
    float* W_ = base + (bi_) * BUFSZ; float* KD_ = W_ + 64 * 68; float* U_ = KD_ + 64 * 68; \
    *(float4*)&W_[lr0 * 68 + lc0] = pw0; *(float4*)&W_[lr1 * 68 + lc0] = pw1;       \
    *(float4*)&KD_[lr0 * 68 + lc0] = pkd0; *(float4*)&KD_[lr1 * 68 + lc0] = pkd1;   \
    if (tid < 256) *(float4*)&U_[ur * 16 + uc] = pu;                         \
  }
  f32x4 sreg = f32x4{0.f, 0.f, 0.f, 0.f};
  if (MODE == 0) {
    for (int i = tid; i < 1024; i += NT) sS[i] = (apart && ((i >> 4) == e0 + (i & 15))) ? 1.f : 0.f;
    if (apart) {
#pragma unroll
      for (int e = 0; e < 4; ++e) sreg[e] = ((wave & 3) * 16 + 4 * qd + e == e0 + r) ? 1.f : 0.f;
    }
  } else {
    for (int i = tid; i < 1024; i += NT) sS[i] = 0.f;
    float* W = base;
    for (int g2 = 0; g2 < grp; ++g2) {
      const float* Ag = p.g_comp + ((size_t)(hd * 8 + g2) * 2 + 1) * 4096;
      const float* Bg = p.g_comp + ((size_t)(hd * 8 + g2) * 2 + 0) * 4096;
      __syncthreads();
      *(float4*)&W[lr0 * 68 + lc0] = *(const float4*)&Ag[lr0 * 64 + lc0];
      *(float4*)&W[lr1 * 68 + lc0] = *(const float4*)&Ag[lr1 * 64 + lc0];
      __syncthreads();
      f32x4 a = f32x4{0.f, 0.f, 0.f, 0.f};
      if (wave < 4) a = mm16_k64(W + wave * 16 * 68, 68, 1, sS, 16, 1);
      __syncthreads();
      if (wave < 4) {
#pragma unroll
        for (int e = 0; e < 4; ++e) {
          int d = wave * 16 + 4 * qd + e;
          sreg[e] = a[e] + Bg[d * 64 + e0 + r];
          sS[d * 16 + r] = sreg[e];
        }
      }
    }
    __syncthreads();
    if (wave < 4) {
#pragma unroll
      for (int e = 0; e < 4; ++e) {
        int d = wave * 16 + 4 * qd + e;
        p.g_sst[(size_t)(c0 * 4 + hd) * 4096 + d * 64 + e0 + r] = sreg[e];
      }
    }
  }
  GLOAD(c0) LSTORE(0)
  __syncthreads();
  for (int cc = 0; cc < 32; ++cc) {
    const int c = c0 + cc;
    if (cc + 1 < 32) GLOAD(c + 1)
    const float cd = p.g_cdec[c * 4 + hd];
    float* W = base + (cc & 1) * BUFSZ; float* KD = W + 64 * 68; float* U = KD + 64 * 68;
    const size_t it = (size_t)(c * 4 + hd);
    if (wave < 4) {
      f32x4 a1 = mm16_k64(W + wave * 16 * 68, 68, 1, sS, 16, 1);
#pragma unroll
      for (int e = 0; e < 4; ++e) {
        int i = wave * 16 + 4 * qd + e;
        float vn = (apart ? 0.f : U[i * 16 + r]) - a1[e];
        sVN[i * 16 + r] = vn;
        if (MODE == 1) p.g_u[it * 4096 + i * 64 + e0 + r] = vn;
      }
    }
    __syncthreads();
    if (wave < 4) {
      f32x4 a2 = mm16_k64(KD + wave * 16, 1, 68, sVN, 16, 1);
#pragma unroll
      for (int e = 0; e < 4; ++e) {
        int d = wave * 16 + 4 * qd + e;
        sreg[e] = sreg[e] * cd + a2[e];
        sS[d * 16 + r] = sreg[e];
        if (MODE == 1 && cc + 1 < 32) p.g_sst[(size_t)((c + 1) * 4 + hd) * 4096 + d * 64 + e0 + r] = sreg[e];
      }
    }
    if (cc + 1 < 32) LSTORE((cc + 1) & 1)
    __syncthreads();
  }
  if (MODE == 0 && wave < 4) {
    float* dst = p.g_comp + ((size_t)(hd * 8 + grp) * 2 + (apart ? 1 : 0)) * 4096;
#pragma unroll
    for (int e = 0; e < 4; ++e) {
      int d = wave * 16 + 4 * qd + e;
      dst[d * 64 + e0 + r] = sreg[e];
    }
  }
  __syncthreads();
}

DEVI void gdn_out(const Params& p, int l, int item, char* smem) {
  const int c = item >> 2, hd = item & 3, t0 = c * 64;
  float* sQD = (float*)smem; float* sS = sQD + 64 * 68; float* sAT = sS + 64 * 68; float* sVN = sAT + 64 * 68;
  const int tid = TID(), lane = tid & 63, wave = tid >> 6, r = lane & 15, qd = lane >> 4;
  const size_t b = (size_t)item * 4096;
#pragma unroll
  for (int idx = tid; idx < 1024; idx += NT) {
    int row = idx >> 4, c4 = idx & 15;
    *(float4*)&sQD[row * 68 + c4 * 4] = *(const float4*)&p.g_qd[b + row * 64 + c4 * 4];
    *(float4*)&sS[row * 68 + c4 * 4] = *(const float4*)&p.g_sst[b + row * 64 + c4 * 4];
    *(float4*)&sAT[row * 68 + c4 * 4] = *(const float4*)&p.g_attn[b + row * 64 + c4 * 4];
    *(float4*)&sVN[row * 68 + c4 * 4] = *(const float4*)&p.g_u[b + row * 64 + c4 * 4];
  }
  __syncthreads();
  const int mt = wave & 3, nh = wave >> 2;
  f32x4 acc[2]; acc[0] = acc[1] = f32x4{0.f, 0.f, 0.f, 0.f};
  mm16<2>(acc, sQD + mt * 16 * 68, 68, 1, sS + nh * 32, 68, 1, 64);
  mm16<2>(acc, sAT + mt * 16 * 68, 68, 1, sVN + nh * 32, 68, 1, 64);
  __syncthreads();
  float* sO = sQD;
#pragma unroll
  for (int t2 = 0; t2 < 2; ++t2)
#pragma unroll
    for (int e = 0; e < 4; ++e) sO[(mt * 16 + 4 * qd + e) * 68 + nh * 32 + t2 * 16 + r] = acc[t2][e];
  __syncthreads();
  {
    int row = tid >> 3, sub = tid & 7, t = t0 + row;
    float o[8], yv[8]; float ss = 0.f;
#pragma unroll
    for (int k = 0; k < 8; ++k) { o[k] = sO[row * 68 + sub * 8 + k]; ss += o[k] * o[k]; }
    ss += __shfl_xor(ss, 1); ss += __shfl_xor(ss, 2); ss += __shfl_xor(ss, 4);
    float rs = rsqrtf(ss * (1.f / 64.f) + EPS);
    float s2 = 0.f;
#pragma unroll
    for (int k = 0; k < 8; ++k) {
      int col = sub * 8 + k;
      float g = p.proj[(size_t)t * PW + DG + hd * 64 + col];
      float y = o[k] * rs * p.gdn_norm[l * 64 + col] * siluf_(g);
      s2 += y * y;
      yv[k] = y * p.branch_norm[(l * 4 + 3) * 256 + hd * 64 + col];
    }
    s2 += __shfl_xor(s2, 1); s2 += __shfl_xor(s2, 2); s2 += __shfl_xor(s2, 4);
    if (sub == 0) p.ssq[(size_t)t * 16 + 8 + hd] = s2;
    *(uint4*)&p.zb[(size_t)t * DM + 768 + hd * 64 + sub * 8] =
        uint4{pack2(yv[0], yv[1]), pack2(yv[2], yv[3]), pack2(yv[4], yv[5]), pack2(yv[6], yv[7])};
  }
  __syncthreads();
}

DEVI void ret_kv(const Params& p, int l, int item, char* smem) {
  const int c = item >> 2, hd = item & 3, t0 = c * 128;
  float* sK = (float*)smem; float* sV = sK + 128 * 65;
  const int tid = TID(), lane = tid & 63, wave = tid >> 6, r = lane & 15, qd = lane >> 4;
  const float lg = logf(1.f - exp2f(-5.f - (float)hd));
#pragma unroll
  for (int i = tid; i < 128 * 32; i += NT) {
    int t = i >> 5, f = i & 31; size_t tt = t0 + t;
    float k1 = p.proj[tt * PW + RK + hd * 64 + f], k2 = p.proj[tt * PW + RK + hd * 64 + 32 + f];
    float cs = p.rope[(tt * 32 + f) * 2], sn = p.rope[(tt * 32 + f) * 2 + 1];
    float dec = expf(lg * (float)(127 - t));
    sK[t * 65 + f] = (k1 * cs - k2 * sn) * dec;
    sK[t * 65 + 32 + f] = (k2 * cs + k1 * sn) * dec;
  }
#pragma unroll
  for (int i = tid; i < 128 * 64; i += NT) {
    int t = i >> 6, e = i & 63;
    sV[t * 65 + e] = p.proj[(size_t)(t0 + t) * PW + RV + hd * 64 + e];
  }
  __syncthreads();
  const int mt = wave & 3, nh = wave >> 2;
  f32x4 acc[2]; acc[0] = acc[1] = f32x4{0.f, 0.f, 0.f, 0.f};
  mm16<2>(acc, sK + mt * 16, 1, 65, sV + nh * 32, 65, 1, 128);
#pragma unroll
  for (int t2 = 0; t2 < 2; ++t2)
#pragma unroll
    for (int e = 0; e < 4; ++e)
      p.ret_kv[(size_t)item * 4096 + (mt * 16 + 4 * qd + e) * 64 + nh * 32 + t2 * 16 + r] = acc[t2][e];
  __syncthreads();
}

DEVI void ret_out(const Params& p, int l, int item, char* smem) {
  const int c = item >> 2, hd = item & 3, t0 = c * 128;
  float* sQ = (float*)smem; float* sK = sQ + 128 * 65; float* sV = sK + 128 * 65; float* sSt = sV + 128 * 65;
  const int tid = TID(), lane = tid & 63, wave = tid >> 6, r = lane & 15, qd = lane >> 4;
  const float lg = logf(1.f - exp2f(-5.f - (float)hd));
  {
    const float* ssrc = p.ret_kv + (size_t)(c * 4 + hd) * 4096;
#pragma unroll
    for (int j = 0; j < 8; ++j) { int idx = tid + 512 * j; sSt[(idx >> 6) * 65 + (idx & 63)] = ssrc[idx]; }
  }
#pragma unroll
  for (int i = tid; i < 128 * 32; i += NT) {
    int t = i >> 5, f = i & 31; size_t tt = t0 + t;
    float cs = p.rope[(tt * 32 + f) * 2], sn = p.rope[(tt * 32 + f) * 2 + 1];
    float k1 = p.proj[tt * PW + RK + hd * 64 + f], k2 = p.proj[tt * PW + RK + hd * 64 + 32 + f];
    sK[t * 65 + f] = (k1 * cs - k2 * sn);
    sK[t * 65 + 32 + f] = (k2 * cs + k1 * sn);
    float q1 = p.proj[tt * PW + RQ + hd * 64 + f], q2 = p.proj[tt * PW + RQ + hd * 64 + 32 + f];
    sQ[t * 65 + f] = (q1 * cs - q2 * sn) * 0.125f;
    sQ[t * 65 + 32 + f] = (q2 * cs + q1 * sn) * 0.125f;
  }
#pragma unroll
  for (int i = tid; i < 128 * 64; i += NT) {
    int t = i >> 6, e = i & 63;
    sV[t * 65 + e] = p.proj[(size_t)(t0 + t) * PW + RV + hd * 64 + e];
  }
  __syncthreads();
  const int i0 = wave * 16;
  f32x4 sc[8], os[4];
#pragma unroll
  for (int t = 0; t < 8; ++t) sc[t] = f32x4{0.f, 0.f, 0.f, 0.f};
#pragma unroll
  for (int t = 0; t < 4; ++t) os[t] = f32x4{0.f, 0.f, 0.f, 0.f};
  mm16<8>(sc, sQ + i0 * 65, 65, 1, sK, 1, 65, 64);
  mm16<4>(os, sQ + i0 * 65, 65, 1, sSt, 65, 1, 64);
  __syncthreads();
  float* sP = (float*)smem;
#pragma unroll
  for (int t2 = 0; t2 < 8; ++t2)
#pragma unroll
    for (int e = 0; e < 4; ++e) {
      int i = i0 + 4 * qd + e, j = t2 * 16 + r;
      sP[i * 129 + j] = (i >= j) ? sc[t2][e] * expf(lg * (float)(i - j)) : 0.f;
    }
  __syncthreads();
  f32x4 o[4];
#pragma unroll
  for (int t2 = 0; t2 < 4; ++t2)
#pragma unroll
    for (int e = 0; e < 4; ++e) o[t2][e] = os[t2][e] * expf(lg * (float)(i0 + 4 * qd + e + 1));
  mm16<4>(o, sP + i0 * 129, 129, 1, sV, 65, 1, 128);
#pragma unroll
  for (int e = 0; e < 4; ++e) {
    int i = i0 + 4 * qd + e; size_t t = t0 + i;
    float sm = sum16(o[0][e] + o[1][e] + o[2][e] + o[3][e]);
    float mu = sm * (1.f / 64.f);
    float vr = 0.f;
#pragma unroll
    for (int t2 = 0; t2 < 4; ++t2) { float dd = o[t2][e] - mu; vr += dd * dd; }
    vr = sum16(vr);
    float rstd = rsqrtf(vr * (1.f / 64.f) + EPS);
    float ss = 0.f;
#pragma unroll
    for (int t2 = 0; t2 < 4; ++t2) {
      int col = hd * 64 + t2 * 16 + r;
      float on = (o[t2][e] - mu) * rstd * p.ret_gn[l * 256 + col];
      float g = p.proj[t * PW + RG + col];
      float y = siluf_(g) * on;
      ss += y * y;
      p.zb[t * DM + col] = f2bf(y * p.branch_norm[(l * 4 + 0) * 256 + col]);
    }
    ss = sum16(ss);
    if (r == 0) p.ssq[t * 16 + hd] = ss;
  }
  __syncthreads();
}

DEVI void lru_local(const Params& p, int l, int c, char* smem) {
  const int t0 = c * 64;
  float* sX = (float*)smem; float* sA = sX + 64 * 257;
  const int tid = TID(), lane = tid & 63, wave = tid >> 6, r = lane & 15, qd = lane >> 4;
  {
    const int ch = tid & 255, half = tid >> 8;
    const float w0 = p.lru_conv_w[(l * 4 + 0) * 256 + ch], w1 = p.lru_conv_w[(l * 4 + 1) * 256 + ch];
    const float w2 = p.lru_conv_w[(l * 4 + 2) * 256 + ch], w3 = p.lru_conv_w[(l * 4 + 3) * 256 + ch];
    const float cb = p.lru_conv_b[l * 256 + ch];
    const float* pc = p.proj + LX + ch;
    float xv[35];
#pragma unroll
    for (int k = 0; k < 35; ++k) {
      const int tt = t0 + 32 * half - 3 + k;
      const float v = pc[(size_t)(tt < 0 ? 0 : tt) * PW];
      xv[k] = tt < 0 ? 0.f : v;
    }
#pragma unroll
    for (int m = 0; m < 32; ++m) {
      float acc = cb;
      acc += w0 * xv[m]; acc += w1 * xv[m + 1]; acc += w2 * xv[m + 2]; acc += w3 * xv[m + 3];
      sX[(32 * half + m) * 257 + ch] = acc;
    }
  }
  __syncthreads();
  for (int pr = 0; pr < 2; ++pr) {
    int pi = wave * 2 + pr, mt = pi & 3, nb = pi >> 2;
    f32x4 ra[4], ri[4];
#pragma unroll
    for (int t = 0; t < 4; ++t) { ra[t] = f32x4{0.f, 0.f, 0.f, 0.f}; ri[t] = f32x4{0.f, 0.f, 0.f, 0.f}; }
    mm16_gB64<4>(ra, sX + mt * 16 * 257 + nb * 64, 257, p.lru_w_a + (size_t)(l * 4 + nb) * 4096);
    mm16_gB64<4>(ri, sX + mt * 16 * 257 + nb * 64, 257, p.lru_w_x + (size_t)(l * 4 + nb) * 4096);
#pragma unroll
    for (int t2 = 0; t2 < 4; ++t2)
#pragma unroll
      for (int e = 0; e < 4; ++e) {
        int t = mt * 16 + 4 * qd + e, ch = nb * 64 + t2 * 16 + r;
        float xb = sX[t * 257 + ch];
        float rr = sigmoidf_(ra[t2][e] + p.lru_b_a[l * 256 + ch]);
        float ii = sigmoidf_(ri[t2][e] + p.lru_b_x[l * 256 + ch]);
        float loga = -8.f * rr * softplusf_(-p.lru_lambda[l * 256 + ch]);
        float a = expf(loga);
        float bb = sqrtf(-expm1f(2.f * loga)) * (ii * xb);
        sA[t * 257 + ch] = a; sX[t * 257 + ch] = bb;
      }
  }
  __syncthreads();
  if (tid < 256) {
    int ch = tid; float H = 0.f, P = 1.f;
    for (int t = 0; t < 64; ++t) {
      float a = sA[t * 257 + ch], bb = sX[t * 257 + ch];
      H = a * H + bb; P *= a;
      p.lru_h[(size_t)(t0 + t) * 256 + ch] = H; p.lru_p[(size_t)(t0 + t) * 256 + ch] = P;
    }
    p.lru_hs[c * 256 + ch] = H; p.lru_ps[c * 256 + ch] = P;
  }
  __syncthreads();
}

DEVI void lru_out(const Params& p, int l, int c, char* smem) {
  const int t0 = c * 64;
  float* sC = (float*)smem;
  const int tid = TID(), lane = tid & 63, wave = tid >> 6;
  if (tid < 256) sC[tid] = p.lru_hs[c * 256 + tid];
  __syncthreads();
  {
    const int ch = lane * 4;
    float4 Hs[8], Ps[8], gs[8];
#pragma unroll
    for (int tk = 0; tk < 8; ++tk) {
      const size_t t = t0 + wave * 8 + tk;
      Hs[tk] = *(const float4*)&p.lru_h[t * 256 + ch]; Ps[tk] = *(const float4*)&p.lru_p[t * 256 + ch];
      gs[tk] = *(const float4*)&p.proj[t * PW + LG + ch];
    }
    const float4 cr = *(const float4*)&sC[ch];
    const float4 bn = *(const float4*)&p.branch_norm[(l * 4 + 1) * 256 + ch];
#pragma unroll
    for (int tk = 0; tk < 8; ++tk) {
      const size_t t = t0 + wave * 8 + tk;
      const float4 H = Hs[tk], P = Ps[tk], g = gs[tk];
      float y0 = geluf_(g.x) * (H.x + P.x * cr.x), y1 = geluf_(g.y) * (H.y + P.y * cr.y);
      float y2 = geluf_(g.z) * (H.z + P.z * cr.z), y3 = geluf_(g.w) * (H.w + P.w * cr.w);
      float ss = wave_sum(y0 * y0 + y1 * y1 + y2 * y2 + y3 * y3);
      if (lane == 0) p.ssq[t * 16 + 4] = ss;
      *(uint2*)&p.zb[t * DM + 256 + ch] = uint2{pack2(y0 * bn.x, y1 * bn.y), pack2(y2 * bn.z, y3 * bn.w)};
    }
  }
  __syncthreads();
}

DEVI void s5_coef(const Params& p, int l, int g, int n, float& abr, float& abi, float (&bbr)[16], float (&bbi)[16]) {
  float dt = expf(p.s5_log_dt[l * 16 + g]);
  float are = p.s5_a_re[(l * 16 + g) * 64 + n], aim = p.s5_a_im[(l * 16 + g) * 64 + n];
  float mag = expf(are * dt), ang = aim * dt;
  abr = mag * cosf(ang); abi = mag * sinf(ang);
  float den = are * are + aim * aim;
  float pre = abr - 1.f, pim = abi;
  float fre = (pre * are + pim * aim) / den, fim = (pim * are - pre * aim) / den;
  const float4* br = (const float4*)(p.s5_b_re + (size_t)((l * 16 + g) * 64 + n) * 16);
  const float4* bi = (const float4*)(p.s5_b_im + (size_t)((l * 16 + g) * 64 + n) * 16);
#pragma unroll
  for (int c4 = 0; c4 < 4; ++c4) {
    float4 a = br[c4], b = bi[c4];
    bbr[c4 * 4 + 0] = fre * a.x - fim * b.x; bbi[c4 * 4 + 0] = fre * b.x + fim * a.x;
    bbr[c4 * 4 + 1] = fre * a.y - fim * b.y; bbi[c4 * 4 + 1] = fre * b.y + fim * a.y;
    bbr[c4 * 4 + 2] = fre * a.z - fim * b.z; bbi[c4 * 4 + 2] = fre * b.z + fim * a.z;
    bbr[c4 * 4 + 3] = fre * a.w - fim * b.w; bbi[c4 * 4 + 3] = fre * b.w + fim * a.w;
  }
}
DEVI void s5_load_u(const Params& p, int t0, float* sU) {
#pragma unroll
  for (int i = TID(); i < 64 * 64; i += NT) {
    int t = i >> 6, c4 = i & 63;
    *(float4*)&sU[t * 256 + c4 * 4] = *(const float4*)&p.proj[(size_t)(t0 + t) * PW + SU + c4 * 4];
  }
}
DEVI void s5_bu(const float* up, const float (&bbr)[16], const float (&bbi)[16], float& bur, float& bui) {
  bur = 0.f; bui = 0.f;
#pragma unroll
  for (int c4 = 0; c4 < 4; ++c4) {
    float4 u = *(const float4*)&up[c4 * 4];
    bur += bbr[c4 * 4] * u.x + bbr[c4 * 4 + 1] * u.y + bbr[c4 * 4 + 2] * u.z + bbr[c4 * 4 + 3] * u.w;
    bui += bbi[c4 * 4] * u.x + bbi[c4 * 4 + 1] * u.y + bbi[c4 * 4 + 2] * u.z + bbi[c4 * 4 + 3] * u.w;
  }
}

DEVI void s5_local(const Params& p, int l, int c, char* smem) {
  const int t0 = c * 64;
  float* sU = (float*)smem;
  const int lane = TID() & 63, wave = TID() >> 6;
  s5_load_u(p, t0, sU);
  __syncthreads();
  for (int gi = 0; gi < 2; ++gi) {
    int g = wave + 8 * gi;
    float abr, abi, bbr[16], bbi[16];
    s5_coef(p, l, g, lane, abr, abi, bbr, bbi);
    float xr = 0.f, xi = 0.f;
    for (int t = 0; t < 64; ++t) {
      float bur, bui; s5_bu(sU + t * 256 + g * 16, bbr, bbi, bur, bui);
      float nr = abr * xr - abi * xi + bur, ni = abr * xi + abi * xr + bui;
      xr = nr; xi = ni;
    }
    *(float2*)&p.xloc[((size_t)(c * 16 + g) * 64 + lane) * 2] = float2{xr, xi};
  }
  __syncthreads();
}

DEVI void s5_out(const Params& p, int l, int c, char* smem) {
  const int t0 = c * 64;
  bf16_t* sY = (bf16_t*)smem;
  float* sX = (float*)(smem + 64 * 264 * 2);
  const int tid = TID(), lane = tid & 63, wave = tid >> 6, r = lane & 15, qd = lane >> 4;
  float* Xl = sX + wave * (16 * 132);
  for (int gi = 0; gi < 2; ++gi) {
    const int g = wave + 8 * gi;
    float abr, abi, bbr[16], bbi[16];
    s5_coef(p, l, g, lane, abr, abi, bbr, bbi);
    float breg[32];
#pragma unroll
    for (int ks = 0; ks < 16; ++ks) {
      breg[ks] = p.s5_c_re[(size_t)((l * 16 + g) * 16 + r) * 64 + 4 * ks + qd];
      breg[16 + ks] = -p.s5_c_im[(size_t)((l * 16 + g) * 16 + r) * 64 + 4 * ks + qd];
    }
    const float dd = p.s5_d[l * 256 + g * 16 + r];
    const float2 xin = *(const float2*)&p.xloc[((size_t)(c * 16 + g) * 64 + lane) * 2];
    float xr = xin.x, xi = xin.y;
    float4 uvecs[4]; float ues[4][4];
#pragma unroll
    for (int tb = 0; tb < 4; ++tb) {
      const float* ub = p.proj + (size_t)(t0 + tb * 16) * PW + SU + g * 16;
      uvecs[tb] = *(const float4*)&ub[(size_t)r * PW + 4 * qd];
#pragma unroll
      for (int e = 0; e < 4; ++e) ues[tb][e] = ub[(size_t)(4 * qd + e) * PW + r];
    }
#pragma unroll
    for (int tb = 0; tb < 4; ++tb) {
      const float4 uvec = uvecs[tb];
      float ue[4];
#pragma unroll
      for (int e = 0; e < 4; ++e) ue[e] = ues[tb][e];
      const int u0 = __float_as_int(uvec.x), u1 = __float_as_int(uvec.y), u2 = __float_as_int(uvec.z), u3 = __float_as_int(uvec.w);
#pragma unroll
      for (int tt = 0; tt < 16; ++tt) {
        float bur = 0.f, bui = 0.f;
#pragma unroll
        for (int c4 = 0; c4 < 4; ++c4) {
          float a0 = __int_as_float(__builtin_amdgcn_readlane(u0, tt + 16 * c4));
          float a1 = __int_as_float(__builtin_amdgcn_readlane(u1, tt + 16 * c4));
          float a2 = __int_as_float(__builtin_amdgcn_readlane(u2, tt + 16 * c4));
          float a3 = __int_as_float(__builtin_amdgcn_readlane(u3, tt + 16 * c4));
          bur += bbr[c4 * 4] * a0 + bbr[c4 * 4 + 1] * a1 + bbr[c4 * 4 + 2] * a2 + bbr[c4 * 4 + 3] * a3;
          bui += bbi[c4 * 4] * a0 + bbi[c4 * 4 + 1] * a1 + bbi[c4 * 4 + 2] * a2 + bbi[c4 * 4 + 3] * a3;
        }
        float nr = abr * xr - abi * xi + bur, ni = abr * xi + abi * xr + bui;
        xr = nr; xi = ni;
        Xl[tt * 132 + lane] = xr; Xl[tt * 132 + 64 + lane] = xi;
      }
      f32x4 acc = f32x4{0.f, 0.f, 0.f, 0.f};
#pragma unroll
      for (int ks = 0; ks < 32; ++ks) {
        float a = Xl[r * 132 + 4 * ks + qd];
        acc = __builtin_amdgcn_mfma_f32_16x16x4f32(a, breg[ks], acc, 0, 0, 0);
      }
#pragma unroll
      for (int e = 0; e < 4; ++e) {
        float y = acc[e] + dd * ue[e];
        sY[(tb * 16 + 4 * qd + e) * 264 + g * 16 + r] = f2bf(geluf_(y));
      }
    }
  }
  __syncthreads();
  f32x4 av[4][2], ag[4][2];
#pragma unroll
  for (int i = 0; i < 4; ++i)
#pragma unroll
    for (int j = 0; j < 2; ++j) { av[i][j] = f32x4{0.f, 0.f, 0.f, 0.f}; ag[i][j] = f32x4{0.f, 0.f, 0.f, 0.f}; }
  const bf16_t* WT = p.gluT + (size_t)l * 512 * 256;
#pragma unroll 4
  for (int ks = 0; ks < 8; ++ks) {
    bf16x8 bv0 = *(const bf16x8*)&WT[(size_t)(32 * wave + r) * 256 + ks * 32 + qd * 8];
    bf16x8 bv1 = *(const bf16x8*)&WT[(size_t)(32 * wave + 16 + r) * 256 + ks * 32 + qd * 8];
    bf16x8 bg0 = *(const bf16x8*)&WT[(size_t)(256 + 32 * wave + r) * 256 + ks * 32 + qd * 8];
    bf16x8 bg1 = *(const bf16x8*)&WT[(size_t)(256 + 32 * wave + 16 + r) * 256 + ks * 32 + qd * 8];
#pragma unroll
    for (int mt = 0; mt < 4; ++mt) {
      bf16x8 a = *(const bf16x8*)&sY[(mt * 16 + r) * 264 + ks * 32 + qd * 8];
      av[mt][0] = __builtin_amdgcn_mfma_f32_16x16x32_bf16(a, bv0, av[mt][0], 0, 0, 0);
      av[mt][1] = __builtin_amdgcn_mfma_f32_16x16x32_bf16(a, bv1, av[mt][1], 0, 0, 0);
      ag[mt][0] = __builtin_amdgcn_mfma_f32_16x16x32_bf16(a, bg0, ag[mt][0], 0, 0, 0);
      ag[mt][1] = __builtin_amdgcn_mfma_f32_16x16x32_bf16(a, bg1, ag[mt][1], 0, 0, 0);
    }
  }
  float* sO = sX;
#pragma unroll
  for (int mt = 0; mt < 4; ++mt)
#pragma unroll
    for (int t2 = 0; t2 < 2; ++t2)
#pragma unroll
      for (int e = 0; e < 4; ++e) {
        int t = mt * 16 + 4 * qd + e, col = 32 * wave + t2 * 16 + r;
        float zv = av[mt][t2][e] + p.s5_glu_b[l * 512 + col];
        float zg = ag[mt][t2][e] + p.s5_glu_b[l * 512 + 256 + col];
        sO[t * 256 + col] = zv * sigmoidf_(zg);
      }
  __syncthreads();
  for (int tk = 0; tk < 8; ++tk) {
    int tl = wave * 8 + tk; size_t t = t0 + tl; int ch = lane * 4;
    float4 o = *(const float4*)&sO[tl * 256 + ch];
    float4 bn = *(const float4*)&p.branch_norm[(l * 4 + 2) * 256 + ch];
    float ss = wave_sum(o.x * o.x + o.y * o.y + o.z * o.z + o.w * o.w);
    if (lane == 0) p.ssq[t * 16 + 5] = ss;
    *(uint2*)&p.zb[t * DM + 512 + ch] = uint2{pack2(o.x * bn.x, o.y * bn.y), pack2(o.z * bn.z, o.w * bn.w)};
  }
  __syncthreads();
}

DEVI void ret_scan(const Params& p, int it) {
  const int elem = it * NT + TID(), hd = elem >> 12, idx = elem & 4095;
  const float lg = logf(1.f - exp2f(-5.f - (float)hd)), cdk = expf(lg * 128.f);
  float* base = p.ret_kv + (size_t)hd * 4096 + idx;
  float s = 0.f;
  for (int cb = 0; cb < 128; cb += 16) {
    float v[16];
#pragma unroll
    for (int j = 0; j < 16; ++j) v[j] = base[(size_t)(cb + j) * 16384];
#pragma unroll
    for (int j = 0; j < 16; ++j) { base[(size_t)(cb + j) * 16384] = s; s = s * cdk + v[j]; }
  }
}
DEVI void s5_scan(const Params& p, int l, int it) {
  const int sidx = it * NT + TID(), g = sidx >> 6, n = sidx & 63;
  float dt = expf(p.s5_log_dt[l * 16 + g]);
  float are = p.s5_a_re[(l * 16 + g) * 64 + n], aim = p.s5_a_im[(l * 16 + g) * 64 + n];
  float mag = expf(are * dt), ang = aim * dt;
  float pr = mag * cosf(ang), pi = mag * sinf(ang);
#pragma unroll
  for (int k = 0; k < 6; ++k) { float nr = pr * pr - pi * pi, ni = 2.f * pr * pi; pr = nr; pi = ni; }
  float2* base = (float2*)p.xloc + sidx;
  float xr = 0.f, xi = 0.f;
  for (int cb = 0; cb < 256; cb += 16) {
    float2 v[16];
#pragma unroll
    for (int j = 0; j < 16; ++j) v[j] = base[(size_t)(cb + j) * 1024];
#pragma unroll
    for (int j = 0; j < 16; ++j) {
      base[(size_t)(cb + j) * 1024] = float2{xr, xi};
      float nr = pr * xr - pi * xi + v[j].x, ni = pr * xi + pi * xr + v[j].y;
      xr = nr; xi = ni;
    }
  }
}
DEVI void lru_scan(const Params& p) {
  const int ch = TID();
  if (ch < 256) {
    float carry = 0.f;
    for (int cb = 0; cb < 256; cb += 16) {
      float ps[16], hs[16];
#pragma unroll
      for (int j = 0; j < 16; ++j) { ps[j] = p.lru_ps[(cb + j) * 256 + ch]; hs[j] = p.lru_hs[(cb + j) * 256 + ch]; }
#pragma unroll
      for (int j = 0; j < 16; ++j) { p.lru_hs[(cb + j) * 256 + ch] = carry; carry = ps[j] * carry + hs[j]; }
    }
  }
}

DEVI void peer_scores(const Params& p, int l, int item, char* smem) {
  const int hp = item & 15, grp = item >> 4;
  float* sQ = (float*)smem;
  float* sKy = sQ + 64 * 68;
  const int tid = TID(), lane = tid & 63, wave = tid >> 6, r = lane & 15, qd = lane >> 4;
  const float* ky = p.peer_subkeys + (size_t)(l * 16 + hp) * 8192;
#pragma unroll
  for (int i = tid; i < 128 * 64; i += NT) { int k = i >> 6, d = i & 63; sKy[k * 65 + d] = ky[i]; }
  const int lt0 = tid >> 4, lc4 = (tid & 15) * 4;
  const float* qb = p.qbuf + (size_t)hp * 64 + lc4;
  float4 q0, q1;
  {
    const size_t t0 = (size_t)(grp * 16) * 64;
    q0 = *(const float4*)&qb[(t0 + lt0) * 1024]; q1 = *(const float4*)&qb[(t0 + lt0 + 32) * 1024];
  }
  const int mt = wave & 3, nh = wave >> 2;
  for (int k = 0; k < 16; ++k) {
    const size_t t0 = (size_t)(grp * 16 + k) * 64;
    __syncthreads();
    *(float4*)&sQ[lt0 * 68 + lc4] = q0; *(float4*)&sQ[(lt0 + 32) * 68 + lc4] = q1;
    __syncthreads();
    if (k + 1 < 16) { q0 = *(const float4*)&qb[(t0 + 64 + lt0) * 1024]; q1 = *(const float4*)&qb[(t0 + 64 + lt0 + 32) * 1024]; }
    f32x4 acc[4];
#pragma unroll
    for (int t = 0; t < 4; ++t) acc[t] = f32x4{0.f, 0.f, 0.f, 0.f};
    mm16<4>(acc, sQ + mt * 16 * 68, 68, 1, sKy + nh * 64 * 65, 1, 65, 64);
#pragma unroll
    for (int t2 = 0; t2 < 4; ++t2)
#pragma unroll
      for (int e = 0; e < 4; ++e) {
        size_t t = t0 + mt * 16 + 4 * qd + e; int key = nh * 64 + t2 * 16 + r;
        p.scores[(t * 16 + hp) * 128 + key] = acc[t2][e];
      }
  }
  __syncthreads();
}

DEVI unsigned ford(float x) { unsigned u = __float_as_uint(x); return (u & 0x80000000u) ? ~u : (u | 0x80000000u); }
DEVI float funord(unsigned u) { return __uint_as_float((u & 0x80000000u) ? (u ^ 0x80000000u) : ~u); }
DEVI void ins16(unsigned (&v)[16], unsigned x) {
#pragma unroll
  for (int j = 0; j < 16; ++j) { unsigned hi = max(v[j], x); x = min(v[j], x); v[j] = hi; }
}

DEVI void cv_issue(const Params& p, int l, int rr, int lane, float4& a, float4& b, float4& c, float4& d) {
  const int which = rr >> 14, row = rr & 16383;
  const float* s = (which ? p.peer_v : p.peer_u) + ((size_t)l * 16384 + row) * 1024 + lane * 16;
  a = *(const float4*)s; b = *(const float4*)(s + 4); c = *(const float4*)(s + 8); d = *(const float4*)(s + 12);
}
DEVI void cv_finish(const Params& p, int rr, int lane, const float4& a, const float4& b, const float4& c, const float4& d) {
  const int which = rr >> 14, row = rr & 16383;
  float m = fmaxf(fmaxf(fmaxf(fabsf(a.x), fabsf(a.y)), fmaxf(fabsf(a.z), fabsf(a.w))),
                  fmaxf(fmaxf(fabsf(b.x), fabsf(b.y)), fmaxf(fabsf(b.z), fabsf(b.w))));
  m = fmaxf(m, fmaxf(fmaxf(fmaxf(fabsf(c.x), fabsf(c.y)), fmaxf(fabsf(c.z), fabsf(c.w))),
                     fmaxf(fmaxf(fabsf(d.x), fabsf(d.y)), fmaxf(fabsf(d.z), fabsf(d.w)))));
  m = fmaxf(m, __shfl_xor(m, 32)); m = fmaxf(m, __shfl_xor(m, 16)); m = fmaxf(m, __shfl_xor(m, 8));
  m = fmaxf(m, __shfl_xor(m, 4)); m = fmaxf(m, __shfl_xor(m, 2)); m = fmaxf(m, __shfl_xor(m, 1));
  const float sc = m > 0.f ? 256.f / m : 1.f;
  int w0 = 0, w1 = 0, w2 = 0, w3 = 0;
  w0 = __builtin_amdgcn_cvt_pk_fp8_f32(a.x * sc, a.y * sc, w0, false); w0 = __builtin_amdgcn_cvt_pk_fp8_f32(a.z * sc, a.w * sc, w0, true);
  w1 = __builtin_amdgcn_cvt_pk_fp8_f32(b.x * sc, b.y * sc, w1, false); w1 = __builtin_amdgcn_cvt_pk_fp8_f32(b.z * sc, b.w * sc, w1, true);
  w2 = __builtin_amdgcn_cvt_pk_fp8_f32(c.x * sc, c.y * sc, w2, false); w2 = __builtin_amdgcn_cvt_pk_fp8_f32(c.z * sc, c.w * sc, w2, true);
  w3 = __builtin_amdgcn_cvt_pk_fp8_f32(d.x * sc, d.y * sc, w3, false); w3 = __builtin_amdgcn_cvt_pk_fp8_f32(d.z * sc, d.w * sc, w3, true);
  *(uint4*)((which ? p.tabV : p.tabU) + (size_t)row * 1024 + lane * 16) = uint4{(unsigned)w0, (unsigned)w1, (unsigned)w2, (unsigned)w3};
  if (lane == 0) (which ? p.vinv : p.uinv)[row] = m > 0.f ? m * (1.f / 256.f) : 1.f;
}

DEVI void peer_topk(const Params& p, int l, int item, int cvbase, char* smem) {
  const int t0 = item * 64;
  float* sS = (float*)smem;
  const int tid = TID();
  const float* base = p.scores + (size_t)t0 * 8 * 256;
  unsigned v1[16], v2[16];
#pragma unroll
  for (int j = 0; j < 16; ++j) { v1[j] = 0u; v2[j] = 0u; }
  float4 nx[8];
#pragma unroll
  for (int i = 0; i < 8; ++i) { int idx = tid + 512 * i; nx[i] = *(const float4*)&base[(size_t)(idx >> 3) * 256 + (idx & 7) * 4]; }
  for (int s = 0; s < 8; ++s) {
    __syncthreads();
#pragma unroll
    for (int i = 0; i < 8; ++i) {
      int idx = tid + 512 * i, pr = idx >> 3, c4 = idx & 7;
      float* d = &sS[pr * 33 + c4 * 4];
      d[0] = nx[i].x; d[1] = nx[i].y; d[2] = nx[i].z; d[3] = nx[i].w;
    }
    __syncthreads();
    if (s + 1 < 8) {
#pragma unroll
      for (int i = 0; i < 8; ++i) { int idx = tid + 512 * i; nx[i] = *(const float4*)&base[(size_t)(idx >> 3) * 256 + (s + 1) * 32 + (idx & 7) * 4]; }
    }
    float4 ca0, cb0, cc0, cd0, ca1, cb1, cc1, cd1;
    if (cvbase >= 0) {
      cv_issue(p, l, cvbase + 2 * s, tid & 63, ca0, cb0, cc0, cd0);
      cv_issue(p, l, cvbase + 2 * s + 1, tid & 63, ca1, cb1, cc1, cd1);
    }
    const int kb = (s & 3) * 32;
    if (s < 4) {
      for (int k = 0; k < 32; ++k) { unsigned key = (ford(sS[tid * 33 + k]) & ~127u) | (unsigned)(127 - (kb + k)); ins16(v1, key); }
    } else {
      for (int k = 0; k < 32; ++k) { unsigned key = (ford(sS[tid * 33 + k]) & ~127u) | (unsigned)(127 - (kb + k)); ins16(v2, key); }
    }
    if (cvbase >= 0) {
      cv_finish(p, cvbase + 2 * s, tid & 63, ca0, cb0, cc0, cd0);
      cv_finish(p, cvbase + 2 * s + 1, tid & 63, ca1, cb1, cc1, cd1);
    }
  }
  __syncthreads();
  unsigned* sI = (unsigned*)smem;
  float s1[16], s2[16];
#pragma unroll
  for (int a = 0; a < 16; ++a) {
    s1[a] = funord(v1[a] & ~127u); s2[a] = funord(v2[a] & ~127u);
    sI[tid * 33 + a] = 127u - (v1[a] & 127u); sI[tid * 33 + 16 + a] = 127u - (v2[a] & 127u);
  }
  unsigned vt[16];
#pragma unroll
  for (int j = 0; j < 16; ++j) vt[j] = 0u;
#pragma unroll
  for (int a = 0; a < 16; ++a)
#pragma unroll
    for (int b = 0; b < 16; ++b)
      if ((a + 1) * (b + 1) <= 16) {
        unsigned key = (ford(s1[a] + s2[b]) & ~255u) | (unsigned)(255 - (a * 16 + b));
        ins16(vt, key);
      }
  float sv[16]; float den = 0.f;
  const float mx = funord(vt[0] & ~255u);
#pragma unroll
  for (int k = 0; k < 16; ++k) { sv[k] = expf(funord(vt[k] & ~255u) - mx); den += sv[k]; }
  const float inv = 1.f / den;
  const int tl = tid >> 3, hh = tid & 7;
  int* idp = p.ids + (size_t)(t0 + tl) * 128 + hh * 16;
  float* gp = p.gates + (size_t)(t0 + tl) * 128 + hh * 16;
#pragma unroll
  for (int k = 0; k < 16; ++k) {
    unsigned pos = 255u - (vt[k] & 255u);
    unsigned i1 = sI[tid * 33 + (pos >> 4)], i2 = sI[tid * 33 + 16 + (pos & 15)];
    idp[k] = (int)(i1 * 128u + i2);
    gp[k] = sv[k] * inv;
  }
  __syncthreads();
}

typedef __attribute__((ext_vector_type(2))) float f32x2;
DEVI void fp8x16_to_f(const uint4& v, float (&o)[16]) {
  f32x2 t;
  t = __builtin_amdgcn_cvt_pk_f32_fp8((int)v.x, false); o[0] = t[0]; o[1] = t[1];
  t = __builtin_amdgcn_cvt_pk_f32_fp8((int)v.x, true); o[2] = t[0]; o[3] = t[1];
  t = __builtin_amdgcn_cvt_pk_f32_fp8((int)v.y, false); o[4] = t[0]; o[5] = t[1];
  t = __builtin_amdgcn_cvt_pk_f32_fp8((int)v.y, true); o[6] = t[0]; o[7] = t[1];
  t = __builtin_amdgcn_cvt_pk_f32_fp8((int)v.z, false); o[8] = t[0]; o[9] = t[1];
  t = __builtin_amdgcn_cvt_pk_f32_fp8((int)v.z, true); o[10] = t[0]; o[11] = t[1];
  t = __builtin_amdgcn_cvt_pk_f32_fp8((int)v.w, false); o[12] = t[0]; o[13] = t[1];
  t = __builtin_amdgcn_cvt_pk_f32_fp8((int)v.w, true); o[14] = t[0]; o[15] = t[1];
}

DEVI void ph_gather(const Params& p, int l) {
  const int lane = TID() & 63, wave = TID() >> 6;
  const int e0 = lane * 16;
  constexpr int NB = 8;
  for (int t = blockIdx.x * 8 + wave; t < S_; t += gridDim.x * 8) {
    float* hrow = p.h + (size_t)t * DM + e0;
    float z[16], out[16];
    {
      float4 a = *(const float4*)&hrow[0], b = *(const float4*)&hrow[4], c = *(const float4*)&hrow[8], d = *(const float4*)&hrow[12];
      z[0] = a.x; z[1] = a.y; z[2] = a.z; z[3] = a.w; z[4] = b.x; z[5] = b.y; z[6] = b.z; z[7] = b.w;
      z[8] = c.x; z[9] = c.y; z[10] = c.z; z[11] = c.w; z[12] = d.x; z[13] = d.y; z[14] = d.z; z[15] = d.w;
    }
    float ss = 0.f;
#pragma unroll
    for (int k = 0; k < 16; ++k) { ss += z[k] * z[k]; out[k] = 0.f; }
    ss = wave_sum(ss);
    const float rs = rsqrtf(ss * (1.f / DM) + EPS);
    const float* fn = p.ffn_norm + l * DM + e0;
#pragma unroll
    for (int k = 0; k < 16; ++k) z[k] = z[k] * rs * fn[k];
    const int id0 = p.ids[(size_t)t * 128 + lane], id1 = p.ids[(size_t)t * 128 + 64 + lane];
    const int gv0 = __float_as_int(p.gates[(size_t)t * 128 + lane] * p.vinv[id0]);
    const int gv1 = __float_as_int(p.gates[(size_t)t * 128 + 64 + lane] * p.vinv[id1]);
    const int us0 = __float_as_int(p.uinv[id0]), us1 = __float_as_int(p.uinv[id1]);
    uint4 cu[NB], cv[NB], nu[NB], nv[NB];
#pragma unroll
    for (int j = 0; j < NB; ++j) {
      int e = __builtin_amdgcn_readlane(id0, j);
      cu[j] = *(const uint4*)(p.tabU + (size_t)e * 1024 + e0);
      cv[j] = *(const uint4*)(p.tabV + (size_t)e * 1024 + e0);
    }
#pragma unroll 1
    for (int b = 0; b < 128 / NB; ++b) {
      const int nb = b + 1;
      if (nb < 128 / NB) {
        const int idn = nb < 64 / NB ? id0 : id1;
#pragma unroll
        for (int j = 0; j < NB; ++j) {
          int e = __builtin_amdgcn_readlane(idn, (nb * NB + j) & 63);
          nu[j] = *(const uint4*)(p.tabU + (size_t)e * 1024 + e0);
          nv[j] = *(const uint4*)(p.tabV + (size_t)e * 1024 + e0);
        }
      }
      const int gvc = b < 64 / NB ? gv0 : gv1, usc = b < 64 / NB ? us0 : us1;
      float dot[NB];
#pragma unroll
      for (int j = 0; j < NB; ++j) {
        float f[16]; fp8x16_to_f(cu[j], f);
        float d = 0.f;
#pragma unroll
        for (int k = 0; k < 16; ++k) d += z[k] * f[k];
        dot[j] = d;
      }
#pragma unroll
      for (int j = 0; j < NB; ++j) dot[j] = wave_sum(dot[j]);
#pragma unroll
      for (int j = 0; j < NB; ++j) {
        const int li = (b * NB + j) & 63;
        float us = __int_as_float(__builtin_amdgcn_readlane(usc, li));
        float gt = __int_as_float(__builtin_amdgcn_readlane(gvc, li));
        float cf = gt * geluf_(dot[j] * us);
        float f[16]; fp8x16_to_f(cv[j], f);
#pragma unroll
        for (int k = 0; k < 16; ++k) out[k] += cf * f[k];
      }
#pragma unroll
      for (int j = 0; j < NB; ++j) { cu[j] = nu[j]; cv[j] = nv[j]; }
    }
    float hv[16];
    {
      float4 a = *(const float4*)&hrow[0], b = *(const float4*)&hrow[4], c = *(const float4*)&hrow[8], d = *(const float4*)&hrow[12];
      hv[0] = a.x; hv[1] = a.y; hv[2] = a.z; hv[3] = a.w; hv[4] = b.x; hv[5] = b.y; hv[6] = b.z; hv[7] = b.w;
      hv[8] = c.x; hv[9] = c.y; hv[10] = c.z; hv[11] = c.w; hv[12] = d.x; hv[13] = d.y; hv[14] = d.z; hv[15] = d.w;
    }
    float s2 = 0.f;
#pragma unroll
    for (int k = 0; k < 16; ++k) { hv[k] += out[k]; s2 += hv[k] * hv[k]; }
    *(float4*)&hrow[0] = float4{hv[0], hv[1], hv[2], hv[3]}; *(float4*)&hrow[4] = float4{hv[4], hv[5], hv[6], hv[7]};
    *(float4*)&hrow[8] = float4{hv[8], hv[9], hv[10], hv[11]}; *(float4*)&hrow[12] = float4{hv[12], hv[13], hv[14], hv[15]};
    s2 = wave_sum(s2);
    const float rs2 = rsqrtf(s2 * (1.f / DM) + EPS);
    const float* pn = p.ple_norm + l * DM + e0;
    float zz[16];
#pragma unroll
    for (int k = 0; k < 16; ++k) zz[k] = hv[k] * rs2 * pn[k];
    bf16_t* zrow = p.zb + (size_t)t * DM + e0;
    *(uint4*)&zrow[0] = uint4{pack2(zz[0], zz[1]), pack2(zz[2], zz[3]), pack2(zz[4], zz[5]), pack2(zz[6], zz[7])};
    *(uint4*)&zrow[8] = uint4{pack2(zz[8], zz[9]), pack2(zz[10], zz[11]), pack2(zz[12], zz[13]), pack2(zz[14], zz[15])};
  }
}

template <class F>
DEVI void gemm_tiles(int NTn, int XM, int XN, F&& f) {
  int G = gridDim.x, B = blockIdx.x;
  asm volatile("" : "+s"(G), "+s"(B));
  if (G & 7) { for (int tile = B; tile < 64 * NTn; tile += G) f(tile / NTn, tile % NTn); return; }
  const int x = B & 7, slot = B >> 3, ns = G >> 3;
  const int xm = x / XN, xn = x % XN;
  const int mcnt = 64 / XM, mb = xm * mcnt;
  const int ncnt = (NTn - xn + XN - 1) / XN;
  for (int j = slot; j < mcnt * ncnt; j += ns) f(mb + j / ncnt, xn + XN * (j % ncnt));
}

enum { PH_PREP = 0, PH_NORM1, PH_GEMM_IN, PH_MIX_A, PH_MIX_B, PH_MIX_C, PH_MIX_D, PH_GEMM_OUT, PH_NORM2, PH_GEMM_Q, PH_SCORES,
       PH_TOPK, PH_GATHER, PH_GEMM_PLE, PH_FINAL };

#if PROBE_A >= 0
#define REGION(id, stmt)                                                                                   \
  {                                                                                                        \
    const bool on_ = (blockIdx.x == 255 && TID() == 0 && ((id) == PROBE_A || (id) == PROBE_B));              \
    if (on_) p.g_cdec[2051] = (float)(wall_clock64() & 0xFFFFFFull);                                       \
    stmt;                                                                                                  \
    if (on_) {                                                                                             \
      float dt_ = (float)(wall_clock64() & 0xFFFFFFull) - p.g_cdec[2051];                                  \
      if (dt_ < 0.f) dt_ += 16777216.f;                                                                    \
      p.g_cdec[(id) == PROBE_A ? 2048 : 2049] += dt_;                                                      \
    }                                                                                                      \
  }
#else
#define REGION(id, stmt) { stmt; }
#endif
DEVI void run_phase(const Params& p, int ph, int l, char* smem) {
  int G = gridDim.x, B = blockIdx.x;
  asm volatile("" : "+s"(G), "+s"(B));
  switch (ph) {
    case PH_PREP: ph_prep(p, smem); break;
    case PH_NORM1: ph_norm(l == 0 ? p.x : p.h, p.mix_norm + l * DM, p.zb, nullptr); break;
    case PH_GEMM_IN:
      gemm_tiles(23, 1, 8, [&](int mt_, int nt_) __attribute__((always_inline)) {
        int m0 = mt_ * 256, n0 = nt_ * 128;
        f32x4 acc[4][4];
        gemm_tile<0, 16>(acc, p.zb, DM, p.winT + (size_t)l * PW * 1024, 1024, 1024, m0, n0, nullptr, smem);
        GEMM_EPI_COORDS
#pragma unroll
        for (int i = 0; i < 4; ++i)
#pragma unroll
          for (int j = 0; j < 4; ++j)
            *(f32x4*)&p.proj[(size_t)(erow0 + i * 16) * PW + ecol0 + j * 16] = acc[i][j];
      });
      break;
    case PH_MIX_A:
      for (int it = B; it < 2048; it += G) {
        if (it < 1024) REGION(105, gdn_prep(p, l, it, smem))
        else if (it < 1536) REGION(106, ret_kv(p, l, it - 1024, smem))
        else if (it < 1792) REGION(107, lru_local(p, l, it - 1536, smem))
        else REGION(108, s5_local(p, l, it - 1792, smem))
      }
      break;
    case PH_MIX_B:
      for (int it = B; it < 256 + 35; it += G) {
        if (it < 256) { const int pr_ = (it & 7) * 4 + (it >> 6), cb_ = (it >> 3) & 7; REGION(100, gdn_chain<0>(p, pr_ >> 3, pr_ & 7, cb_, smem)) }
        else if (it < 256 + 32) ret_scan(p, it - 256);
        else if (it < 256 + 34) s5_scan(p, l, it - 288);
        else lru_scan(p);
      }
      break;
    case PH_MIX_C: {
      for (int k = 0;; ++k) {
        int ty = -1, idx = 0;
        if (G == 256) {
          if (B < 128) { if (k < 4) { ty = k; idx = B; } }
          else if (k == 0) { ty = 1; idx = B; }
          else if (k <= 3) { ty = 2; idx = 128 + (B - 128) * 3 + (k - 1); }
          else if (k == 4) { ty = 3; idx = B; }
        } else {
          const int it = B + k * G;
          if (it < 128) { ty = 0; idx = it; }
          else if (it < 640) { ty = 2; idx = it - 128; }
          else if (it < 896) { ty = 1; idx = it - 640; }
          else if (it < 1152) { ty = 3; idx = it - 896; }
        }
        if (ty < 0) break;
        if (ty == 0) { const int pr_ = (idx & 7) * 4 + (idx >> 5), cb_ = (idx >> 3) & 3; REGION(102, gdn_chain<1>(p, pr_ >> 3, pr_ & 7, cb_, smem)) }
        else if (ty == 1) REGION(103, s5_out(p, l, idx, smem))
        else if (ty == 2) REGION(101, ret_out(p, l, idx, smem))
        else REGION(104, lru_out(p, l, idx, smem))
      }
    } break;
    case PH_MIX_D:
      for (int it = B; it < 1024; it += G) REGION(109, gdn_out(p, l, it, smem))
      break;
    case PH_GEMM_OUT:
      gemm_tiles(8, 4, 2, [&](int mt_, int nt_) __attribute__((always_inline)) {
        int m0 = mt_ * 256, n0 = nt_ * 128;
        f32x4 acc[4][4];
        gemm_tile<1, 16>(acc, p.zb, DM, p.woutT + (size_t)l * 1024 * 1024, 1024, 1024, m0, n0, p.ssq, smem);
        GEMM_EPI_COORDS
#pragma unroll
        for (int i = 0; i < 4; ++i)
#pragma unroll
          for (int j = 0; j < 4; ++j)
            acc[i][j] += *(const f32x4*)&(l == 0 ? p.x : p.h)[(size_t)(erow0 + i * 16) * DM + ecol0 + j * 16];
#pragma unroll
        for (int i = 0; i < 4; ++i)
#pragma unroll
          for (int j = 0; j < 4; ++j)
            *(f32x4*)&p.h[(size_t)(erow0 + i * 16) * DM + ecol0 + j * 16] = acc[i][j];
      });
      break;
    case PH_NORM2:
      ph_norm(p.h, p.ffn_norm + l * DM, p.zb, nullptr);
      {
        const size_t gtid = (size_t)B * NT + TID(), gsz = (size_t)G * NT;
        const float4* sp = (const float4*)(p.p + (size_t)l * S_ * 256);
        for (size_t i = gtid; i < (size_t)S_ * 256 / 8; i += gsz) {
          float4 a = sp[2 * i], b = sp[2 * i + 1];
          ((uint4*)p.pbf)[i] = uint4{pack2(a.x, a.y), pack2(a.z, a.w), pack2(b.x, b.y), pack2(b.z, b.w)};
        }
      }
      break;
    case PH_GEMM_Q:
      gemm_tiles(8, 4, 2, [&](int mt_, int nt_) __attribute__((always_inline)) {
        int m0 = mt_ * 256, n0 = nt_ * 128;
        f32x4 acc[4][4];
        gemm_tile<0, 16>(acc, p.zb, DM, p.wqT + (size_t)l * 1024 * 1024, 1024, 1024, m0, n0, nullptr, smem);
        GEMM_EPI_COORDS
#pragma unroll
        for (int i = 0; i < 4; ++i)
#pragma unroll
          for (int j = 0; j < 4; ++j)
            *(f32x4*)&p.qbuf[(size_t)(erow0 + i * 16) * DM + ecol0 + j * 16] = acc[i][j];
      });
      break;
    case PH_SCORES:
      for (int it = B; it < 256; it += G) REGION(110, peer_scores(p, l, it, smem))
      break;
    case PH_TOPK:
      for (int it = B; it < 256; it += G) REGION(111, peer_topk(p, l, it, (G == 256) ? (B * 8 + (TID() >> 6)) * 16 : -1, smem))
      if (G != 256) convert_tables(p, l);
      break;
    case PH_GATHER: ph_gather(p, l); break;
    case PH_GEMM_PLE:
      gemm_tiles(8, 4, 2, [&](int mt_, int nt_) __attribute__((always_inline)) {
        int m0 = mt_ * 256, n0 = nt_ * 128;
        uint2* gsc = (uint2*)p.g_attn + (size_t)B * 16 * NT + TID();
        {
          f32x4 ag[4][4];
          gemm_tile<0, 16>(ag, p.zb, DM, p.wgT + (size_t)l * 1024 * 1024, 1024, 1024, m0, n0, nullptr, smem);
#pragma unroll
          for (int i = 0; i < 4; ++i)
#pragma unroll
            for (int j = 0; j < 4; ++j)
              gsc[(i * 4 + j) * NT] = uint2{pack2(sigmoidf_(ag[i][j][0]), sigmoidf_(ag[i][j][1])),
                                            pack2(sigmoidf_(ag[i][j][2]), sigmoidf_(ag[i][j][3]))};
        }
        f32x4 ap[4][4];
        gemm_tile<0, 4>(ap, p.pbf, 256, p.wpT + (size_t)l * 1024 * 256, 256, 256, m0, n0, nullptr, smem);
        GEMM_EPI_COORDS
#pragma unroll
        for (int i = 0; i < 4; ++i)
#pragma unroll
          for (int j = 0; j < 4; ++j) {
            const f32x4 hv = *(const f32x4*)&p.h[(size_t)(erow0 + i * 16) * DM + ecol0 + j * 16];
            const uint2 gk = gsc[(i * 4 + j) * NT];
            ap[i][j][0] = hv[0] + ap[i][j][0] * __uint_as_float(gk.x << 16);
            ap[i][j][1] = hv[1] + ap[i][j][1] * __uint_as_float(gk.x & 0xFFFF0000u);
            ap[i][j][2] = hv[2] + ap[i][j][2] * __uint_as_float(gk.y << 16);
            ap[i][j][3] = hv[3] + ap[i][j][3] * __uint_as_float(gk.y & 0xFFFF0000u);
          }
#pragma unroll
        for (int i = 0; i < 4; ++i)
#pragma unroll
          for (int j = 0; j < 4; ++j)
            *(f32x4*)&p.h[(size_t)(erow0 + i * 16) * DM + ecol0 + j * 16] = ap[i][j];
      });
      break;
    case PH_FINAL: ph_norm(p.h, p.final_norm, nullptr, p.out); break;
  }
}

#if !MEGA
__global__ void __launch_bounds__(NT) k_phase(Params p, int ph, int l) {
  extern __shared__ __align__(16) char smem[];
  run_phase(p, ph, l, smem);
}
#endif

#define XB_TMO      128
#define XB_XCNT(j)  (256  + 64 * (j))
#define XB_XSUB(j)  (1280 + 64 * (j))
#define XB_XGEN(j)  (2304 + 64 * (j))
#define XB_TOP      3328
#define XB_TOPGEN   3392
#define XCD_BAR_WORDS 3456
#define XB_SPIN_CAP (1u << 18)
#define LAS __attribute__((address_space(3)))
DEVI unsigned xb_ld(unsigned* p) { return __hip_atomic_load(p, __ATOMIC_RELAXED, __HIP_MEMORY_SCOPE_AGENT); }
DEVI unsigned xb_add(unsigned* p, unsigned v) { return __hip_atomic_fetch_add(p, v, __ATOMIC_RELAXED, __HIP_MEMORY_SCOPE_AGENT); }
DEVI unsigned xb_xcc_id() { return (unsigned)__builtin_amdgcn_s_getreg((3 << 11) | 20) & 0xFu; }
#define XB_SPIN(cond, bar) do { unsigned _sp = 0; while (cond) { __builtin_amdgcn_s_sleep(1); \
    if ((++_sp & 255u) == 0u) { if (xb_ld(&(bar)[XB_TMO])) break; if (_sp > XB_SPIN_CAP) { atomicAdd(&(bar)[XB_TMO], 1u); break; } } } } while (0)
struct XcdBarrier { unsigned* bar; unsigned x; volatile LAS unsigned* st; };
DEVI XcdBarrier xcd_barrier_post(unsigned* bar, volatile LAS unsigned* st) {
  XcdBarrier b; b.bar = bar; b.x = xb_xcc_id(); b.st = st;
  if (TID() == 0) (void)xb_add(&bar[XB_XCNT(b.x)], 1u);
  return b;
}
DEVI void xcd_barrier_complete(unsigned* bar, unsigned x, unsigned& nloc, unsigned& nx) {
  const unsigned G = gridDim.x * gridDim.y * gridDim.z;
  unsigned sum, cnt, mine, sp = 0u;
  for (;;) {
    sum = 0u; cnt = 0u; mine = 0u;
#pragma unroll
    for (unsigned j = 0; j < 16; ++j) { const unsigned c = xb_ld(&bar[XB_XCNT(j)]); sum += c; cnt += (c > 0u) ? 1u : 0u; mine = (j == x) ? c : mine; }
    if (sum == G) break;
    __builtin_amdgcn_s_sleep(1);
    if ((++sp & 255u) == 0u) { if (xb_ld(&bar[XB_TMO])) break; if (sp > XB_SPIN_CAP) { atomicAdd(&bar[XB_TMO], 1u); break; } }
  }
  nloc = mine > 0u ? mine : 1u; nx = cnt > 0u ? cnt : 1u;
}
DEVI void xcd_barrier(const XcdBarrier& b) {
  asm volatile("s_waitcnt vmcnt(0)" ::: "memory");
  __syncthreads();
  if (TID() == 0) {
    unsigned* bar = b.bar;
    __builtin_amdgcn_s_waitcnt(0);
    unsigned nloc = b.st[0], nx = b.st[1];
    if (nloc == 0u) { xcd_barrier_complete(bar, b.x, nloc, nx); b.st[0] = nloc; b.st[1] = nx; }
    const unsigned old = xb_add(&bar[XB_XSUB(b.x)], 1u);
    const unsigned gen = old / nloc;
    if (old + 1u == (gen + 1u) * nloc) {
      __builtin_amdgcn_fence(__ATOMIC_RELEASE, "agent");
      asm volatile("s_waitcnt vmcnt(0)" ::: "memory");
      const unsigned og = xb_add(&bar[XB_TOP], 1u);
      const unsigned tg = og / nx;
      if (og + 1u == (tg + 1u) * nx) xb_add(&bar[XB_TOPGEN], 1u);
      else XB_SPIN(xb_ld(&bar[XB_TOPGEN]) == tg, bar);
      __builtin_amdgcn_fence(__ATOMIC_ACQUIRE, "agent");
      xb_add(&bar[XB_XGEN(b.x)], 1u);
      asm volatile("s_waitcnt vmcnt(0)" ::: "memory");
    } else {
      XB_SPIN(xb_ld(&bar[XB_XGEN(b.x)]) == gen, bar);
      __builtin_amdgcn_fence(__ATOMIC_ACQUIRE, "agent");
      asm volatile("s_waitcnt vmcnt(0)" ::: "memory");
    }
  }
  __syncthreads();
}

#if MEGA
template <int ph, int l>
DEVI void mega_step(const Params& p, char* smem, const XcdBarrier& xb) {
#if PROBE_A >= 0
  if (blockIdx.x == 0 && TID() == 0 && (ph == PROBE_A || ph == PROBE_B)) p.g_cdec[2050] = (float)(wall_clock64() & 0xFFFFFFull);
  run_phase(p, ph, l, smem);
  xcd_barrier(xb);
  if (blockIdx.x == 0 && TID() == 0 && (ph == PROBE_A || ph == PROBE_B)) {
    float dt = (float)(wall_clock64() & 0xFFFFFFull) - p.g_cdec[2050];
    if (dt < 0.f) dt += 16777216.f;
    p.g_cdec[ph == PROBE_A ? 2048 : 2049] += dt;
  }
#else
  run_phase(p, ph, l, smem);
  xcd_barrier(xb);
#endif
}
template <int l>
DEVI void mega_layer(const Params& p, char* smem, const XcdBarrier& xb) {
  mega_step<PH_NORM1, l>(p, smem, xb);
  mega_step<PH_GEMM_IN, l>(p, smem, xb);
  mega_step<PH_MIX_A, l>(p, smem, xb);
  mega_step<PH_MIX_B, l>(p, smem, xb);
  mega_step<PH_MIX_C, l>(p, smem, xb);
  mega_step<PH_MIX_D, l>(p, smem, xb);
  mega_step<PH_GEMM_OUT, l>(p, smem, xb);
  mega_step<PH_NORM2, l>(p, smem, xb);
  mega_step<PH_GEMM_Q, l>(p, smem, xb);
  mega_step<PH_SCORES, l>(p, smem, xb);
  mega_step<PH_TOPK, l>(p, smem, xb);
  mega_step<PH_GATHER, l>(p, smem, xb);
  mega_step<PH_GEMM_PLE, l>(p, smem, xb);
}
__global__ void __launch_bounds__(NT) k_mega(Params p) {
  extern __shared__ __align__(16) char smem[];
  cg::grid_group grid = cg::this_grid();
#if PROBE_A >= 0
  if (blockIdx.x == 0 && TID() == 0) { p.g_cdec[2048] = 0.f; p.g_cdec[2049] = 0.f; }
#endif
  __shared__ uint4 xb_words;
  if (TID() == 0) xb_words = uint4{0u, 0u, 0u, 0u};
  __syncthreads();
  const XcdBarrier xb = xcd_barrier_post(p.bar, (volatile LAS unsigned*)&xb_words);
  grid.sync();
  mega_step<PH_PREP, 0>(p, smem, xb);
  mega_layer<0>(p, smem, xb);
  mega_layer<1>(p, smem, xb);
  run_phase(p, PH_FINAL, 0, smem);
#if PROBE_A >= 0
  xcd_barrier(xb);
  {
    const float qa_ = expf(rintf(logf(p.g_cdec[2048] * 0.01f) * 4.f) * 0.25f), qb_ = expf(rintf(logf(p.g_cdec[2049] * 0.01f) * 4.f) * 0.25f);
    const float va = sqrtf(qa_), vb = qb_;
    const size_t gtid = (size_t)blockIdx.x * NT + TID(), gsz = (size_t)gridDim.x * NT;
    for (size_t i = gtid; i < (size_t)S_ * DM; i += gsz) p.out[i] = (i == 0) ? vb : va;
  }
#endif
}
#endif

extern "C" void kernel_launch(void* const* d_in, const int* in_sizes, int n_in, void* d_out, int out_size, void* d_ws,
                              size_t ws_size, hipStream_t stream) {
  Params p{};
  const float* const* f = (const float* const*)d_in;
  p.x = f[0]; p.p = f[1]; p.pos = (const int*)d_in[2];
  p.mix_norm = f[3]; p.w_in = f[4]; p.ret_gn = f[5]; p.lru_conv_w = f[6]; p.lru_conv_b = f[7]; p.lru_w_a = f[8];
  p.lru_b_a = f[9]; p.lru_w_x = f[10]; p.lru_b_x = f[11]; p.lru_lambda = f[12];
  p.s5_a_re = f[13]; p.s5_a_im = f[14]; p.s5_b_re = f[15]; p.s5_b_im = f[16]; p.s5_c_re = f[17]; p.s5_c_im = f[18];
  p.s5_d = f[19]; p.s5_log_dt = f[20]; p.s5_glu_w = f[21]; p.s5_glu_b = f[22];
  p.gdn_conv_w = f[23]; p.gdn_a_log = f[24]; p.gdn_dt_bias = f[25]; p.gdn_norm = f[26]; p.branch_norm = f[27];
  p.w_out = f[28]; p.ffn_norm = f[29]; p.peer_wq = f[30]; p.peer_subkeys = f[31]; p.peer_u = f[32]; p.peer_v = f[33];
  p.ple_norm = f[34]; p.ple_wg = f[35]; p.ple_wp = f[36]; p.final_norm = f[37];
  p.out = (float*)d_out;
  char* ws = (char*)d_ws;
  const size_t MiB = 1024 * 1024;
  p.h = (float*)(ws + 0 * MiB);
  p.zb = (bf16_t*)(ws + 64 * MiB);
  p.proj = (float*)(ws + 96 * MiB);
  p.qbuf = (float*)(ws + 96 * MiB);
  p.scores = (float*)(ws + 160 * MiB);
  p.g_u = (float*)(ws + 288 * MiB); p.g_w = (float*)(ws + 304 * MiB); p.g_attn = (float*)(ws + 320 * MiB);
  p.g_qd = (float*)(ws + 336 * MiB); p.g_kd = (float*)(ws + 352 * MiB);
  p.ids = (int*)(ws + 288 * MiB); p.gates = (float*)(ws + 296 * MiB);
  p.lru_h = (float*)(ws + 368 * MiB); p.lru_p = (float*)(ws + 384 * MiB);
  p.ret_kv = (float*)(ws + 400 * MiB);
  p.tabU = (uint8_t*)(ws + 408 * MiB); p.tabV = (uint8_t*)(ws + 440 * MiB);
  p.uinv = (float*)(ws + 505 * MiB); p.vinv = (float*)(ws + 505 * MiB + 65536);
  p.g_sst = (float*)(ws + 408 * MiB);
  {
    char* wb = ws + 472 * MiB;
    p.winT = (bf16_t*)wb; wb += (size_t)2 * PW * 1024 * 2;
    p.woutT = (bf16_t*)wb; wb += (size_t)2 * 1024 * 1024 * 2;
    p.wqT = (bf16_t*)wb; wb += (size_t)2 * 1024 * 1024 * 2;
    p.wgT = (bf16_t*)wb; wb += (size_t)2 * 1024 * 1024 * 2;
    p.wpT = (bf16_t*)wb; wb += (size_t)2 * 1024 * 256 * 2;
    p.gluT = (bf16_t*)wb; wb += (size_t)2 * 512 * 256 * 2;
  }
  p.rope = (float*)(ws + 497 * MiB);
  p.ssq = (float*)(ws + 501 * MiB);
  p.xloc = (float*)(ws + 502 * MiB);
  p.lru_hs = (float*)(ws + 504 * MiB);
  p.lru_ps = (float*)(ws + 504 * MiB + 256 * 256 * 4);
  p.g_cdec = (float*)(ws + 504 * MiB + 2 * 256 * 256 * 4);
  p.g_comp = (float*)(ws + 506 * MiB);
  p.pbf = (bf16_t*)(ws + 304 * MiB);
  p.bar = (unsigned*)(ws + 507 * MiB);

  static int grid_blocks = 0;
  if (!grid_blocks) {
#if MEGA
    hipFuncSetAttribute((const void*)k_mega, hipFuncAttributeMaxDynamicSharedMemorySize, LDS_BYTES);
#endif
#if !MEGA
    hipFuncSetAttribute((const void*)k_phase, hipFuncAttributeMaxDynamicSharedMemorySize, LDS_BYTES);
#endif
    int dev = 0, cus = 0, per_cu = 0;
    hipGetDevice(&dev);
    hipDeviceGetAttribute(&cus, hipDeviceAttributeMultiprocessorCount, dev);
#if MEGA
    hipOccupancyMaxActiveBlocksPerMultiprocessor(&per_cu, k_mega, NT, LDS_BYTES);
#else
    hipOccupancyMaxActiveBlocksPerMultiprocessor(&per_cu, k_phase, NT, LDS_BYTES);
#endif
    if (per_cu < 1) per_cu = 1;
    grid_blocks = cus * per_cu;
  }
#if MEGA
  hipMemsetAsync(p.bar, 0, XCD_BAR_WORDS * 4, stream);
  void* args[] = {&p};
  hipError_t e = hipLaunchCooperativeKernel((void*)k_mega, dim3(grid_blocks), dim3(NT), args, LDS_BYTES, stream);
  if (e != hipSuccess) fprintf(stderr, "cooperative launch failed: %s (grid %d)\n", hipGetErrorString(e), grid_blocks);
#else
  k_phase<<<grid_blocks, NT, LDS_BYTES, stream>>>(p, PH_PREP, 0);
  for (int l = 0; l < NL; ++l)
    for (int ph = PH_NORM1; ph <= PH_GEMM_PLE; ++ph) k_phase<<<grid_blocks, NT, LDS_BYTES, stream>>>(p, ph, l);
  k_phase<<<grid_blocks, NT, LDS_BYTES, stream>>>(p, PH_FINAL, 0);
#endif
}
```

```cpp
#include <hip/hip_runtime.h>
#include <hip/hip_bf16.h>
#include <hip/hip_cooperative_groups.h>
#include <cstdio>
#include <cstdint>
namespace cg = cooperative_groups;

#ifndef MEGA
#define MEGA 1
#endif

#ifndef PROBE_A
#define PROBE_A -1
#endif
#ifndef PROBE_B
#define PROBE_B -1
#endif
#define DEVI __device__ __forceinline__

typedef __attribute__((ext_vector_type(8))) short bf16x8;
typedef __attribute__((ext_vector_type(4))) float f32x4;
typedef unsigned short bf16_t;

constexpr int NT = 512;
constexpr int S_ = 16384, DM = 1024, NL = 2, PW = 2944, INW = 2824;
constexpr int RQ = 0, RK = 256, RV = 512, RG = 768, LG = 1024, LX = 1280, SU = 1536, DQ = 1792,
              DB = 2560, DA = 2564, DG = 2568;
constexpr float EPS = 1e-6f;
constexpr int LDS_BYTES = 132 * 1024;

struct Params {
  const float *x, *p; const int* pos;
  const float *mix_norm, *w_in, *ret_gn, *lru_conv_w, *lru_conv_b, *lru_w_a, *lru_b_a, *lru_w_x, *lru_b_x, *lru_lambda;
  const float *s5_a_re, *s5_a_im, *s5_b_re, *s5_b_im, *s5_c_re, *s5_c_im, *s5_d, *s5_log_dt, *s5_glu_w, *s5_glu_b;
  const float *gdn_conv_w, *gdn_a_log, *gdn_dt_bias, *gdn_norm, *branch_norm, *w_out, *ffn_norm, *peer_wq, *peer_subkeys;
  const float *peer_u, *peer_v, *ple_norm, *ple_wg, *ple_wp, *final_norm;
  float* out;
  float* h; bf16_t* zb; float* proj; float* qbuf; float* scores;
  float *g_u, *g_w, *g_attn, *g_qd, *g_kd, *g_sst, *g_cdec, *g_comp;
  int* ids; float* gates;
  float *lru_h, *lru_p, *lru_hs, *lru_ps;
  float* ret_kv; float* xloc;
  uint8_t *tabU, *tabV; float *uinv, *vinv;
  bf16_t *winT, *woutT, *wqT, *wgT, *wpT, *gluT;
  float* rope; float* ssq; bf16_t* pbf; unsigned* bar;
};

DEVI int TID() { int t = __builtin_amdgcn_workitem_id_x(); asm volatile("" : "+v"(t)); return t; }
DEVI bf16_t f2bf(float f) { unsigned u = __float_as_uint(f); u += 0x7FFFu + ((u >> 16) & 1u); return (bf16_t)(u >> 16); }
DEVI float bf2f(bf16_t b) { return __uint_as_float(((unsigned)b) << 16); }
DEVI unsigned pack2(float a, float b) { return (unsigned)f2bf(a) | ((unsigned)f2bf(b) << 16); }
DEVI float sigmoidf_(float x) { return 1.f / (1.f + expf(-x)); }
DEVI float siluf_(float x) { return x / (1.f + expf(-x)); }
DEVI float geluf_(float x) { float u = 0.7978845608028654f * (x + 0.044715f * x * x * x); return 0.5f * x * (1.f + tanhf(u)); }
DEVI float softplusf_(float x) { return x > 20.f ? x : log1pf(expf(x)); }
DEVI float wave_sum(float v) {
  v += __shfl_xor(v, 32); v += __shfl_xor(v, 16); v += __shfl_xor(v, 8);
  v += __shfl_xor(v, 4); v += __shfl_xor(v, 2); v += __shfl_xor(v, 1); return v;
}
DEVI float sum16(float v) {
  v += __shfl_xor(v, 8); v += __shfl_xor(v, 4); v += __shfl_xor(v, 2); v += __shfl_xor(v, 1); return v;
}

template <int NTL>
DEVI void mm16(f32x4 (&acc)[NTL], const float* A, int sam, int sak, const float* B, int sbk, int sbn, int K) {
  const int l = TID() & 63, r = l & 15, q = l >> 4;
  const float* ap = A + r * sam + q * sak;
  const float* bp = B + q * sbk + r * sbn;
#pragma unroll 4
  for (int k = 0; k < K; k += 4) {
    float a = ap[k * sak];
#pragma unroll
    for (int t = 0; t < NTL; ++t) {
      float b = bp[k * sbk + t * 16 * sbn];
      acc[t] = __builtin_amdgcn_mfma_f32_16x16x4f32(a, b, acc[t], 0, 0, 0);
    }
  }
}

template <int NTL>
DEVI void mm16_gB64(f32x4 (&acc)[NTL], const float* A, int sam, const float* __restrict__ Bg) {
  const int l = TID() & 63, r = l & 15, q = l >> 4;
  float bv[16][NTL];
#pragma unroll
  for (int k = 0; k < 16; ++k)
#pragma unroll
    for (int t = 0; t < NTL; ++t) bv[k][t] = Bg[(4 * k + q) * 64 + t * 16 + r];
#pragma unroll
  for (int k = 0; k < 16; ++k) {
    const float a = A[r * sam + 4 * k + q];
#pragma unroll
    for (int t = 0; t < NTL; ++t) acc[t] = __builtin_amdgcn_mfma_f32_16x16x4f32(a, bv[k][t], acc[t], 0, 0, 0);
  }
}

template <int AMODE, int NK>
DEVI void gemm_tile(f32x4 (&acc)[4][4], const void* Aptr, int lda, const bf16_t* Bt, int ldb, int K, int m0, int n0,
                    const float* ssq, char* smem) {
  constexpr int LDT = 72, BUF = (256 + 128) * LDT;
  bf16_t* sbase = (bf16_t*)smem;
  const int tid = TID(), lane = tid & 63, wave = tid >> 6;
  const int wm = wave >> 1, wn = wave & 1, r = lane & 15, q = lane >> 4;
  const int lrow = tid >> 3, lkc = tid & 7;
  uint4 raS00, raS01, raS02, raS03, rbS00, rbS01, raS10, raS11, raS12, raS13, rbS10, rbS11, raS20, raS21, raS22, raS23, rbS20, rbS21;
  float rs0 = 1.f, rs1 = 1.f, rs2 = 1.f, rs3 = 1.f;
#pragma unroll
  for (int i = 0; i < 4; ++i)
#pragma unroll
    for (int j = 0; j < 4; ++j) acc[i][j] = f32x4{0.f, 0.f, 0.f, 0.f};
  const bf16_t* Ab = (const bf16_t*)Aptr + (size_t)(m0 + lrow) * lda + lkc * 8;
  const bf16_t* Bb = Bt + (size_t)(n0 + lrow) * ldb + lkc * 8;
#define GL(S, k0_)                                                    \
  {                                                                   \
    ra##S##0 = *(const uint4*)(Ab + (k0_));                           \
    ra##S##1 = *(const uint4*)(Ab + (size_t)64 * lda + (k0_));        \
    ra##S##2 = *(const uint4*)(Ab + (size_t)128 * lda + (k0_));       \
    ra##S##3 = *(const uint4*)(Ab + (size_t)192 * lda + (k0_));       \
    rb##S##0 = *(const uint4*)(Bb + (k0_));                           \
    rb##S##1 = *(const uint4*)(Bb + (size_t)64 * ldb + (k0_));        \
  }
  auto scale = [&](uint4 v, float s) {
    unsigned w[4] = {v.x, v.y, v.z, v.w};
#pragma unroll
    for (int j = 0; j < 4; ++j) {
      float lo = __uint_as_float(w[j] << 16) * s, hi = __uint_as_float(w[j] & 0xFFFF0000u) * s;
      w[j] = pack2(lo, hi);
    }
    return uint4{w[0], w[1], w[2], w[3]};
  };
  auto rowscale = [&](int row, int k0) {
    const float* sp = ssq + (size_t)(m0 + row) * 16;
    int seg = k0 >> 8;
    float s = seg == 0 ? (sp[0] + sp[1] + sp[2] + sp[3]) : seg == 1 ? sp[4] : seg == 2 ? sp[5] : (sp[8] + sp[9] + sp[10] + sp[11]);
    return rsqrtf(s * (1.f / 256.f) + EPS);
  };
#define LS(S, k0_, bi_)                                                               \
  {                                                                                   \
    bf16_t* As_ = sbase + (bi_) * BUF; bf16_t* Bs_ = As_ + 256 * LDT;                 \
    if constexpr (AMODE == 1) {                                                       \
      if (((k0_) & 255) == 0) {                                                       \
        rs0 = rowscale(lrow, (k0_)); rs1 = rowscale(lrow + 64, (k0_));                \
        rs2 = rowscale(lrow + 128, (k0_)); rs3 = rowscale(lrow + 192, (k0_));         \
      }                                                                               \
      ra##S##0 = scale(ra##S##0, rs0); ra##S##1 = scale(ra##S##1, rs1);               \
      ra##S##2 = scale(ra##S##2, rs2); ra##S##3 = scale(ra##S##3, rs3);               \
    }                                                                                 \
    *(uint4*)&As_[(lrow) * LDT + lkc * 8] = ra##S##0;                                 \
    *(uint4*)&As_[(lrow + 64) * LDT + lkc * 8] = ra##S##1;                            \
    *(uint4*)&As_[(lrow + 128) * LDT + lkc * 8] = ra##S##2;                           \
    *(uint4*)&As_[(lrow + 192) * LDT + lkc * 8] = ra##S##3;                           \
    *(uint4*)&Bs_[(lrow) * LDT + lkc * 8] = rb##S##0;                                 \
    *(uint4*)&Bs_[(lrow + 64) * LDT + lkc * 8] = rb##S##1;                            \
  }
  auto compute = [&](int bi) {
    const bf16_t* As = sbase + bi * BUF; const bf16_t* Bs = As + 256 * LDT;
#pragma unroll
    for (int kk = 0; kk < 2; ++kk) {
      bf16x8 a[4], b[4];
#pragma unroll
      for (int i = 0; i < 4; ++i) a[i] = *(const bf16x8*)&As[(wm * 64 + i * 16 + r) * LDT + kk * 32 + q * 8];
#pragma unroll
      for (int j = 0; j < 4; ++j) b[j] = *(const bf16x8*)&Bs[(wn * 64 + j * 16 + r) * LDT + kk * 32 + q * 8];
#pragma unroll
      for (int i = 0; i < 4; ++i)
#pragma unroll
        for (int j = 0; j < 4; ++j)
          acc[i][j] = __builtin_amdgcn_mfma_f32_16x16x32_bf16(b[j], a[i], acc[i][j], 0, 0, 0);
    }
  };

  __syncthreads();
  if constexpr (NK == 16 && AMODE == 1) {
    GL(S0, 0)
    LS(S0, 0, 0)
    GL(S1, 64)
    __syncthreads();
#pragma unroll 1
    for (int kt = 0; kt < NK; kt += 2) {
      compute(0);
      LS(S1, ((kt + 1) << 6), 1)
      if (kt + 2 < NK) GL(S0, ((kt + 2) << 6))
      __syncthreads();
      compute(1);
      if (kt + 2 < NK) { LS(S0, ((kt + 2) << 6), 0) GL(S1, ((kt + 3) << 6)) }
      __syncthreads();
    }
  } else if constexpr (NK == 16) {
    GL(S0, 0) GL(S1, 64) GL(S2, 128)
    LS(S0, 0, 0)
    GL(S0, 192)
    __syncthreads();
    compute(0);
    LS(S1, 64, 1)
    GL(S1, 256)
    __syncthreads();
    compute(1);
    LS(S2, 128, 0)
    GL(S2, 320)
    __syncthreads();
    compute(0);
    LS(S0, 192, 1)
    GL(S0, 384)
    __syncthreads();
    compute(1);
    LS(S1, 256, 0)
    GL(S1, 448)
    __syncthreads();
    compute(0);
    LS(S2, 320, 1)
    GL(S2, 512)
    __syncthreads();
    compute(1);
    LS(S0, 384, 0)
    GL(S0, 576)
    __syncthreads();
    compute(0);
    LS(S1, 448, 1)
    GL(S1, 640)
    __syncthreads();
    compute(1);
    LS(S2, 512, 0)
    GL(S2, 704)
    __syncthreads();
    compute(0);
    LS(S0, 576, 1)
    GL(S0, 768)
    __syncthreads();
    compute(1);
    LS(S1, 640, 0)
    GL(S1, 832)
    __syncthreads();
    compute(0);
    LS(S2, 704, 1)
    GL(S2, 896)
    __syncthreads();
    compute(1);
    LS(S0, 768, 0)
    GL(S0, 960)
    __syncthreads();
    compute(0);
    LS(S1, 832, 1)
    __syncthreads();
    compute(1);
    LS(S2, 896, 0)
    __syncthreads();
    compute(0);
    LS(S0, 960, 1)
    __syncthreads();
    compute(1);
    __syncthreads();
  } else {
    GL(S0, 0) GL(S1, 64) GL(S2, 128)
    LS(S0, 0, 0)
    GL(S0, 192)
    __syncthreads();
    compute(0);
    LS(S1, 64, 1)
    __syncthreads();
    compute(1);
    LS(S2, 128, 0)
    __syncthreads();
    compute(0);
    LS(S0, 192, 1)
    __syncthreads();
    compute(1);
    __syncthreads();
  }
#undef GL
#undef LS
}
#define GEMM_EPI_COORDS                                                   \
  const int lane_ = TID() & 63, wave_ = TID() >> 6;           \
  const int erow0 = m0 + (wave_ >> 1) * 64 + (lane_ & 15);                \
  const int ecol0 = n0 + (wave_ & 1) * 64 + (lane_ >> 4) * 4;

DEVI void transpose_tile(const float* W, int ldw, int nvalid, bf16_t* Bt, int ldbt, int k0, int n0, char* smem) {
  float* t = (float*)smem;
  const int tid = TID();
  {
    int i = tid >> 4, j4 = tid & 15;
#pragma unroll
    for (int h2 = 0; h2 < 2; ++h2) {
      int kk = i + 32 * h2;
      int n = n0 + j4 * 4;
      float4 v = float4{0.f, 0.f, 0.f, 0.f};
      if (n < nvalid) v = *(const float4*)&W[(size_t)(k0 + kk) * ldw + n];
      t[(j4 * 4 + 0) * 65 + kk] = v.x; t[(j4 * 4 + 1) * 65 + kk] = v.y;
      t[(j4 * 4 + 2) * 65 + kk] = v.z; t[(j4 * 4 + 3) * 65 + kk] = v.w;
    }
  }
  __syncthreads();
  {
    int n = tid >> 3, k8 = tid & 7;
    const float* s = &t[n * 65 + k8 * 8];
    uint4 v;
    v.x = pack2(s[0], s[1]); v.y = pack2(s[2], s[3]); v.z = pack2(s[4], s[5]); v.w = pack2(s[6], s[7]);
    *(uint4*)&Bt[(size_t)(n0 + n) * ldbt + k0 + k8 * 8] = v;
  }
  __syncthreads();
}

DEVI void convert_tables(const Params& p, int l) {
  const int lane = TID() & 63, wave = TID() >> 6;
  const int nw = gridDim.x * 8, gw = blockIdx.x * 8 + wave;
  for (int r0 = gw; r0 < 2 * 16384; r0 += 4 * nw) {
    float4 va[4], vb[4], vc[4], vd[4];
#pragma unroll
    for (int k = 0; k < 4; ++k) {
      const int rr = r0 + k * nw;
      if (rr < 2 * 16384) {
        const int which = rr >> 14, row = rr & 16383;
        const float* s = (which ? p.peer_v : p.peer_u) + ((size_t)l * 16384 + row) * 1024 + lane * 16;
        va[k] = *(const float4*)s; vb[k] = *(const float4*)(s + 4); vc[k] = *(const float4*)(s + 8); vd[k] = *(const float4*)(s + 12);
      }
    }
#pragma unroll
    for (int k = 0; k < 4; ++k) {
      const int rr = r0 + k * nw;
      if (rr < 2 * 16384) {
        const int which = rr >> 14, row = rr & 16383;
        const float4 a = va[k], b = vb[k], c = vc[k], d = vd[k];
        float m = fmaxf(fmaxf(fmaxf(fabsf(a.x), fabsf(a.y)), fmaxf(fabsf(a.z), fabsf(a.w))),
                        fmaxf(fmaxf(fabsf(b.x), fabsf(b.y)), fmaxf(fabsf(b.z), fabsf(b.w))));
        m = fmaxf(m, fmaxf(fmaxf(fmaxf(fabsf(c.x), fabsf(c.y)), fmaxf(fabsf(c.z), fabsf(c.w))),
                           fmaxf(fmaxf(fabsf(d.x), fabsf(d.y)), fmaxf(fabsf(d.z), fabsf(d.w)))));
        m = fmaxf(m, __shfl_xor(m, 32)); m = fmaxf(m, __shfl_xor(m, 16)); m = fmaxf(m, __shfl_xor(m, 8));
        m = fmaxf(m, __shfl_xor(m, 4)); m = fmaxf(m, __shfl_xor(m, 2)); m = fmaxf(m, __shfl_xor(m, 1));
        const float sc = m > 0.f ? 256.f / m : 1.f;
        int w0 = 0, w1 = 0, w2 = 0, w3 = 0;
        w0 = __builtin_amdgcn_cvt_pk_fp8_f32(a.x * sc, a.y * sc, w0, false); w0 = __builtin_amdgcn_cvt_pk_fp8_f32(a.z * sc, a.w * sc, w0, true);
        w1 = __builtin_amdgcn_cvt_pk_fp8_f32(b.x * sc, b.y * sc, w1, false); w1 = __builtin_amdgcn_cvt_pk_fp8_f32(b.z * sc, b.w * sc, w1, true);
        w2 = __builtin_amdgcn_cvt_pk_fp8_f32(c.x * sc, c.y * sc, w2, false); w2 = __builtin_amdgcn_cvt_pk_fp8_f32(c.z * sc, c.w * sc, w2, true);
        w3 = __builtin_amdgcn_cvt_pk_fp8_f32(d.x * sc, d.y * sc, w3, false); w3 = __builtin_amdgcn_cvt_pk_fp8_f32(d.z * sc, d.w * sc, w3, true);
        *(uint4*)((which ? p.tabV : p.tabU) + (size_t)row * 1024 + lane * 16) = uint4{(unsigned)w0, (unsigned)w1, (unsigned)w2, (unsigned)w3};
        if (lane == 0) (which ? p.vinv : p.uinv)[row] = m > 0.f ? m * (1.f / 256.f) : 1.f;
      }
    }
  }
}

DEVI void ph_prep(const Params& p, char* smem) {
  const size_t gtid = (size_t)blockIdx.x * NT + TID(), gsz = (size_t)gridDim.x * NT;
  for (size_t i = gtid; i < (size_t)S_ * 32; i += gsz) {
    int t = (int)(i >> 5), f = (int)(i & 31);
    float inv = powf(10000.f, -(float)f / 32.f);
    float ang = (float)p.pos[t] * inv;
    p.rope[2 * i] = cosf(ang); p.rope[2 * i + 1] = sinf(ang);
  }
  for (int it = blockIdx.x; it < 2 * 1600; it += gridDim.x) {
    int l = it / 1600, idx = it % 1600;
    if (idx >= 1568) {
      int j = idx - 1568; int kt = j >> 3, nt = j & 7;
      transpose_tile(p.s5_glu_w + (size_t)l * 256 * 512, 512, 512, p.gluT + (size_t)l * 512 * 256, 256, kt * 64, nt * 64, smem);
    } else if (idx < 736) {
      int kt = idx / 46, nt = idx % 46;
      transpose_tile(p.w_in + (size_t)l * 1024 * INW, INW, INW, p.winT + (size_t)l * PW * 1024, 1024, kt * 64, nt * 64, smem);
    } else if (idx < 1504) {
      int j = idx - 736; int which = j >> 8; j &= 255;
      int kt = j >> 4, nt = j & 15;
      const float* src = (which == 0 ? p.w_out : which == 1 ? p.peer_wq : p.ple_wg) + (size_t)l * 1024 * 1024;
      bf16_t* dst = (which == 0 ? p.woutT : which == 1 ? p.wqT : p.wgT) + (size_t)l * 1024 * 1024;
      transpose_tile(src, 1024, 1024, dst, 1024, kt * 64, nt * 64, smem);
    } else {
      int j = idx - 1504; int kt = j >> 4, nt = j & 15;
      transpose_tile(p.ple_wp + (size_t)l * 256 * 1024, 1024, 1024, p.wpT + (size_t)l * 1024 * 256, 256, kt * 64, nt * 64, smem);
    }
  }
}

DEVI void ph_norm(const float* src, const float* g, bf16_t* dst, float* fout) {
  const int lane = TID() & 63, wave = TID() >> 6;
  const int nw = gridDim.x * 8, gw = blockIdx.x * 8 + wave;
  float4 gg[4];
#pragma unroll
  for (int i = 0; i < 4; ++i) gg[i] = *(const float4*)&g[i * 256 + lane * 4];
  for (int t = gw; t < S_; t += 4 * nw) {
    float4 v[4][4];
#pragma unroll
    for (int rr = 0; rr < 4; ++rr) {
      const int tr = t + rr * nw;
      if (tr < S_) {
#pragma unroll
        for (int i = 0; i < 4; ++i) v[rr][i] = *(const float4*)&src[(size_t)tr * DM + i * 256 + lane * 4];
      }
    }
#pragma unroll
    for (int rr = 0; rr < 4; ++rr) {
      const int tr = t + rr * nw;
      if (tr < S_) {
        float ss = 0.f;
#pragma unroll
        for (int i = 0; i < 4; ++i) ss += v[rr][i].x * v[rr][i].x + v[rr][i].y * v[rr][i].y + v[rr][i].z * v[rr][i].z + v[rr][i].w * v[rr][i].w;
        ss = wave_sum(ss);
        const float rs = rsqrtf(ss * (1.f / DM) + EPS);
#pragma unroll
        for (int i = 0; i < 4; ++i) {
          float a = v[rr][i].x * rs * gg[i].x, b = v[rr][i].y * rs * gg[i].y, c = v[rr][i].z * rs * gg[i].z, d = v[rr][i].w * rs * gg[i].w;
          if (dst) *(uint2*)&dst[(size_t)tr * DM + i * 256 + lane * 4] = uint2{pack2(a, b), pack2(c, d)};
          else *(float4*)&fout[(size_t)tr * DM + i * 256 + lane * 4] = float4{a, b, c, d};
        }
      }
    }
  }
}

DEVI void gdn_prep(const Params& p, int l, int item, char* smem) {
  const int c = item >> 2, hd = item & 3, t0 = c * 64;
  float* sq = (float*)smem; float* sk = sq + 64 * 65; float* sv = sk + 64 * 65;
  float* sL = sv + 64 * 65;
  float* sgc = sL + 64 * 68; float* sbeta = sgc + 64;
  const int tid = TID(), lane = tid & 63, wave = tid >> 6, r = lane & 15, qd = lane >> 4;
  const float* cw = p.gdn_conv_w + (size_t)l * 4 * 768;
  {
    const int d = tid & 63, tw = tid >> 6;
#pragma unroll
    for (int which = 0; which < 3; ++which) {
      const int ch = which * 256 + hd * 64 + d;
      const float w0 = cw[ch], w1 = cw[768 + ch], w2 = cw[2 * 768 + ch], w3 = cw[3 * 768 + ch];
      const float* pc = p.proj + DQ + ch;
      float xv[11];
#pragma unroll
      for (int k = 0; k < 11; ++k) {
        const int tt = t0 + 8 * tw - 3 + k;
        const float v = pc[(size_t)(tt < 0 ? 0 : tt) * PW];
        xv[k] = tt < 0 ? 0.f : v;
      }
#pragma unroll
      for (int m = 0; m < 8; ++m) {
        float acc = 0.f;
        acc += w0 * xv[m]; acc += w1 * xv[m + 1]; acc += w2 * xv[m + 2]; acc += w3 * xv[m + 3];
        const float sv_ = siluf_(acc);
        if (which == 0) sq[(8 * tw + m) * 65 + d] = sv_;
        else if (which == 1) sk[(8 * tw + m) * 65 + d] = sv_;
        else sv[(8 * tw + m) * 65 + d] = sv_;
      }
    }
  }
  __syncthreads();
  {
    const int rw = tid >> 2, part = tid & 3, t = rw & 63;
    float* row = (rw < 64 ? sq : sk) + t * 65 + part * 16;
    float s = 0.f;
#pragma unroll
    for (int d = 0; d < 16; ++d) s += row[d] * row[d];
    s += __shfl_xor(s, 1); s += __shfl_xor(s, 2);
    float sc = rsqrtf(s + EPS) * (rw < 64 ? 0.125f : 1.f);
#pragma unroll
    for (int d = 0; d < 16; ++d) row[d] *= sc;
  }
  if (wave == 2) {
    int t = tid - 128;
    float bl = p.proj[(size_t)(t0 + t) * PW + DB + hd];
    float al = p.proj[(size_t)(t0 + t) * PW + DA + hd];
    float la = -expf(p.gdn_a_log[l * 4 + hd]) * softplusf_(al + p.gdn_dt_bias[l * 4 + hd]);
    for (int off = 1; off < 64; off <<= 1) { float n = __shfl_up(la, off); if (lane >= off) la += n; }
    sgc[t] = la; sbeta[t] = sigmoidf_(bl);
  }
  __syncthreads();
  {
    int mat = wave >> 2, mt = wave & 3;
    f32x4 acc[4];
#pragma unroll
    for (int t = 0; t < 4; ++t) acc[t] = f32x4{0.f, 0.f, 0.f, 0.f};
    mm16<4>(acc, (mat == 0 ? sk : sq) + mt * 16 * 65, 65, 1, sk, 1, 65, 64);
#pragma unroll
    for (int t = 0; t < 4; ++t)
#pragma unroll
      for (int e = 0; e < 4; ++e) {
        int i = mt * 16 + 4 * qd + e, j = t * 16 + r;
        float g = (i >= j) ? expf(sgc[i] - sgc[j]) : 0.f;
        if (mat == 0) sL[i * 68 + j] = (i > j) ? acc[t][e] * sbeta[i] * g : 0.f;
        else p.g_attn[((size_t)item * 64 + i) * 64 + j] = (i >= j) ? acc[t][e] * g : 0.f;
      }
  }
  __syncthreads();
  if (tid < 128) {
    const bool isv = tid < 64; const int d = tid & 63;
    float X[64];
#pragma unroll
    for (int i = 0; i < 64; ++i) X[i] = 0.f;
    float* dst = (isv ? p.g_u : p.g_w) + (size_t)item * 4096 + d;
#pragma unroll
    for (int i = 0; i < 64; ++i) {
      float bi = sbeta[i];
      float s = isv ? sv[i * 65 + d] * bi : sk[i * 65 + d] * bi * expf(sgc[i]);
      float s1 = 0.f, s2 = 0.f, s3 = 0.f;
#pragma unroll
      for (int j4 = 0; j4 < (i + 3) / 4; ++j4) {
        float4 lv = *(const float4*)&sL[i * 68 + j4 * 4];
        s -= lv.x * X[j4 * 4 + 0]; s1 -= lv.y * X[j4 * 4 + 1]; s2 -= lv.z * X[j4 * 4 + 2]; s3 -= lv.w * X[j4 * 4 + 3];
      }
      s = (s + s1) + (s2 + s3);
      X[i] = s;
      dst[i * 64] = s;
    }
  } else {
    for (int i2 = tid - 128; i2 < 8192; i2 += 384) {
      int which = i2 >> 12, i = (i2 >> 6) & 63, d = i2 & 63;
      float val = which == 0 ? sq[i * 65 + d] * expf(sgc[i]) : sk[i * 65 + d] * expf(sgc[63] - sgc[i]);
      (which == 0 ? p.g_qd : p.g_kd)[(size_t)item * 4096 + i * 64 + d] = val;
    }
    if (tid == 128) p.g_cdec[item] = expf(sgc[63]);
  }
  __syncthreads();
}

DEVI f32x4 mm16_k64(const float* A, int sam, int sak, const float* B, int sbk, int sbn) {
  const int l = TID() & 63, r = l & 15, q = l >> 4;
  const float* ap = A + r * sam + q * sak;
  const float* bp = B + q * sbk + r * sbn;
  float av[16], bv[16];
#pragma unroll
  for (int k = 0; k < 16; ++k) { av[k] = ap[4 * k * sak]; bv[k] = bp[4 * k * sbk]; }
  f32x4 c0 = f32x4{0.f, 0.f, 0.f, 0.f}, c1 = f32x4{0.f, 0.f, 0.f, 0.f};
#pragma unroll
  for (int k = 0; k < 16; k += 2) {
    c0 = __builtin_amdgcn_mfma_f32_16x16x4f32(av[k], bv[k], c0, 0, 0, 0);
    c1 = __builtin_amdgcn_mfma_f32_16x16x4f32(av[k + 1], bv[k + 1], c1, 0, 0, 0);
  }
  return c0 + c1;
}

template <int MODE>
DEVI void gdn_chain(const Params& p, int hd, int grp, int cb, char* smem) {
  float* base = (float*)smem;
  constexpr int BUFSZ = 64 * 68 * 2 + 64 * 16;
  float* sS = base + 2 * BUFSZ; float* sVN = sS + 1024;
  const int tid = TID(), lane = tid & 63, wave = tid >> 6, r = lane & 15, qd = lane >> 4;
  const bool apart = (MODE == 0) && (cb >= 4);
  const int e0 = (cb & 3) * 16;
  const int c0 = grp * 32;
  float4 pw0, pw1, pkd0, pkd1, pu = float4{0.f, 0.f, 0.f, 0.f};
  const int lr0 = tid >> 4, lc0 = (tid & 15) * 4, lr1 = lr0 + 32;
  const int ur = tid >> 2, uc = (tid & 3) * 4;
#define GLOAD(c_)                                                            \
  {                                                                          \
    size_t b_ = (size_t)((c_) * 4 + hd) * 4096;                              \
    pw0 = *(const float4*)&p.g_w[b_ + lr0 * 64 + lc0];                       \
    pw1 = *(const float4*)&p.g_w[b_ + lr1 * 64 + lc0];                       \
    pkd0 = *(const float4*)&p.g_kd[b_ + lr0 * 64 + lc0];                     \
    pkd1 = *(const float4*)&p.g_kd[b_ + lr1 * 64 + lc0];                     \
    if (tid < 256 && !apart) pu = *(const float4*)&p.g_u[b_ + ur * 64 + e0 + uc]; \
  }
#define LSTORE(bi_)                                                          \
  {                                                                          \
    float* W_ = base + (bi_) * BUFSZ; float* KD_ = W_ + 64 * 68; float* U_ = KD_ + 64 * 68; \
    *(float4*)&W_[lr0 * 68 + lc0] = pw0; *(float4*)&W_[lr1 * 68 + lc0] = pw1;       \
    *(float4*)&KD_[lr0 * 68 + lc0] = pkd0; *(float4*)&KD_[lr1 * 68 + lc0] = pkd1;   \
    if (tid < 256) *(float4*)&U_[ur * 16 + uc] = pu;                         \
  }
  f32x4 sreg = f32x4{0.f, 0.f, 0.f, 0.f};
  if (MODE == 0) {
    for (int i = tid; i < 1024; i += NT) sS[i] = (apart && ((i >> 4) == e0 + (i & 15))) ? 1.f : 0.f;
    if (apart) {
#pragma unroll
      for (int e = 0; e < 4; ++e) sreg[e] = ((wave & 3) * 16 + 4 * qd + e == e0 + r) ? 1.f : 0.f;
    }
  } else {
    for (int i = tid; i < 1024; i += NT) sS[i] = 0.f;
    float* W = base;
    for (int g2 = 0; g2 < grp; ++g2) {
      const float* Ag = p.g_comp + ((size_t)(hd * 8 + g2) * 2 + 1) * 4096;
      const float* Bg = p.g_comp + ((size_t)(hd * 8 + g2) * 2 + 0) * 4096;
      __syncthreads();
      *(float4*)&W[lr0 * 68 + lc0] = *(const float4*)&Ag[lr0 * 64 + lc0];
      *(float4*)&W[lr1 * 68 + lc0] = *(const float4*)&Ag[lr1 * 64 + lc0];
      __syncthreads();
      f32x4 a = f32x4{0.f, 0.f, 0.f, 0.f};
      if (wave < 4) a = mm16_k64(W + wave * 16 * 68, 68, 1, sS, 16, 1);
      __syncthreads();
      if (wave < 4) {
#pragma unroll
        for (int e = 0; e < 4; ++e) {
          int d = wave * 16 + 4 * qd + e;
          sreg[e] = a[e] + Bg[d * 64 + e0 + r];
          sS[d * 16 + r] = sreg[e];
        }
      }
    }
    __syncthreads();
    if (wave < 4) {
#pragma unroll
      for (int e = 0; e < 4; ++e) {
        int d = wave * 16 + 4 * qd + e;
        p.g_sst[(size_t)(c0 * 4 + hd) * 4096 + d * 64 + e0 + r] = sreg[e];
      }
    }
  }
  GLOAD(c0) LSTORE(0)
  __syncthreads();
  for (int cc = 0; cc < 32; ++cc) {
    const int c = c0 + cc;
    if (cc + 1 < 32) GLOAD(c + 1)
    const float cd = p.g_cdec[c * 4 + hd];
    float* W = base + (cc & 1) * BUFSZ; float* KD = W + 64 * 68; float* U = KD + 64 * 68;
    const size_t it = (size_t)(c * 4 + hd);
    if (wave < 4) {
      f32x4 a1 = mm16_k64(W + wave * 16 * 68, 68, 1, sS, 16, 1);
#pragma unroll
      for (int e = 0; e < 4; ++e) {
        int i = wave * 16 + 4 * qd + e;
        float vn = (apart ? 0.f : U[i * 16 + r]) - a1[e];
        sVN[i * 16 + r] = vn;
        if (MODE == 1) p.g_u[it * 4096 + i * 64 + e0 + r] = vn;
      }
    }
    __syncthreads();
    if (wave < 4) {
      f32x4 a2 = mm16_k64(KD + wave * 16, 1, 68, sVN, 16, 1);
#pragma unroll
      for (int e = 0; e < 4; ++e) {
        int d = wave * 16 + 4 * qd + e;
        sreg[e] = sreg[e] * cd + a2[e];
        sS[d * 16 + r] = sreg[e];
        if (MODE == 1 && cc + 1 < 32) p.g_sst[(size_t)((c + 1) * 4 + hd) * 4096 + d * 64 + e0 + r] = sreg[e];
      }
    }
    if (cc + 1 < 32) LSTORE((cc + 1) & 1)
    __syncthreads();
  }
  if (MODE == 0 && wave < 4) {
    float* dst = p.g_comp + ((size_t)(hd * 8 + grp) * 2 + (apart ? 1 : 0)) * 4096;
#pragma unroll
    for (int e = 0; e < 4; ++e) {
      int d = wave * 16 + 4 * qd + e;
      dst[d * 64 + e0 + r] = sreg[e];
    }
  }
  __syncthreads();
}

DEVI void gdn_out(const Params& p, int l, int item, char* smem) {
  const int c = item >> 2, hd = item & 3, t0 = c * 64;
  float* sQD = (float*)smem; float* sS = sQD + 64 * 68; float* sAT = sS + 64 * 68; float* sVN = sAT + 64 * 68;
  const int tid = TID(), lane = tid & 63, wave = tid >> 6, r = lane & 15, qd = lane >> 4;
  const size_t b = (size_t)item * 4096;
#pragma unroll
  for (int idx = tid; idx < 1024; idx += NT) {
    int row = idx >> 4, c4 = idx & 15;
    *(float4*)&sQD[row * 68 + c4 * 4] = *(const float4*)&p.g_qd[b + row * 64 + c4 * 4];
    *(float4*)&sS[row * 68 + c4 * 4] = *(const float4*)&p.g_sst[b + row * 64 + c4 * 4];
    *(float4*)&sAT[row * 68 + c4 * 4] = *(const float4*)&p.g_attn[b + row * 64 + c4 * 4];
    *(float4*)&sVN[row * 68 + c4 * 4] = *(const float4*)&p.g_u[b + row * 64 + c4 * 4];
  }
  __syncthreads();
  const int mt = wave & 3, nh = wave >> 2;
  f32x4 acc[2]; acc[0] = acc[1] = f32x4{0.f, 0.f, 0.f, 0.f};
  mm16<2>(acc, sQD + mt * 16 * 68, 68, 1, sS + nh * 32, 68, 1, 64);
  mm16<2>(acc, sAT + mt * 16 * 68, 68, 1, sVN + nh * 32, 68, 1, 64);
  __syncthreads();
  float* sO = sQD;
#pragma unroll
  for (int t2 = 0; t2 < 2; ++t2)
#pragma unroll
    for (int e = 0; e < 4; ++e) sO[(mt * 16 + 4 * qd + e) * 68 + nh * 32 + t2 * 16 + r] = acc[t2][e];
  __syncthreads();
  {
    int row = tid >> 3, sub = tid & 7, t = t0 + row;
    float o[8], yv[8]; float ss = 0.f;
#pragma unroll
    for (int k = 0; k < 8; ++k) { o[k] = sO[row * 68 + sub * 8 + k]; ss += o[k] * o[k]; }
    ss += __shfl_xor(ss, 1); ss += __shfl_xor(ss, 2); ss += __shfl_xor(ss, 4);
    float rs = rsqrtf(ss * (1.f / 64.f) + EPS);
    float s2 = 0.f;
#pragma unroll
    for (int k = 0; k < 8; ++k) {
      int col = sub * 8 + k;
      float g = p.proj[(size_t)t * PW + DG + hd * 64 + col];
      float y = o[k] * rs * p.gdn_norm[l * 64 + col] * siluf_(g);
      s2 += y * y;
      yv[k] = y * p.branch_norm[(l * 4 + 3) * 256 + hd * 64 + col];
    }
    s2 += __shfl_xor(s2, 1); s2 += __shfl_xor(s2, 2); s2 += __shfl_xor(s2, 4);
    if (sub == 0) p.ssq[(size_t)t * 16 + 8 + hd] = s2;
    *(uint4*)&p.zb[(size_t)t * DM + 768 + hd * 64 + sub * 8] =
        uint4{pack2(yv[0], yv[1]), pack2(yv[2], yv[3]), pack2(yv[4], yv[5]), pack2(yv[6], yv[7])};
  }
  __syncthreads();
}

DEVI void ret_kv(const Params& p, int l, int item, char* smem) {
  const int c = item >> 2, hd = item & 3, t0 = c * 128;
  float* sK = (float*)smem; float* sV = sK + 128 * 65;
  const int tid = TID(), lane = tid & 63, wave = tid >> 6, r = lane & 15, qd = lane >> 4;
  const float lg = logf(1.f - exp2f(-5.f - (float)hd));
#pragma unroll
  for (int i = tid; i < 128 * 32; i += NT) {
    int t = i >> 5, f = i & 31; size_t tt = t0 + t;
    float k1 = p.proj[tt * PW + RK + hd * 64 + f], k2 = p.proj[tt * PW + RK + hd * 64 + 32 + f];
    float cs = p.rope[(tt * 32 + f) * 2], sn = p.rope[(tt * 32 + f) * 2 + 1];
    float dec = expf(lg * (float)(127 - t));
    sK[t * 65 + f] = (k1 * cs - k2 * sn) * dec;
    sK[t * 65 + 32 + f] = (k2 * cs + k1 * sn) * dec;
  }
#pragma unroll
  for (int i = tid; i < 128 * 64; i += NT) {
    int t = i >> 6, e = i & 63;
    sV[t * 65 + e] = p.proj[(size_t)(t0 + t) * PW + RV + hd * 64 + e];
  }
  __syncthreads();
  const int mt = wave & 3, nh = wave >> 2;
  f32x4 acc[2]; acc[0] = acc[1] = f32x4{0.f, 0.f, 0.f, 0.f};
  mm16<2>(acc, sK + mt * 16, 1, 65, sV + nh * 32, 65, 1, 128);
#pragma unroll
  for (int t2 = 0; t2 < 2; ++t2)
#pragma unroll
    for (int e = 0; e < 4; ++e)
      p.ret_kv[(size_t)item * 4096 + (mt * 16 + 4 * qd + e) * 64 + nh * 32 + t2 * 16 + r] = acc[t2][e];
  __syncthreads();
}

DEVI void ret_out(const Params& p, int l, int item, char* smem) {
  const int c = item >> 2, hd = item & 3, t0 = c * 128;
  float* sQ = (float*)smem; float* sK = sQ + 128 * 65; float* sV = sK + 128 * 65; float* sSt = sV + 128 * 65;
  const int tid = TID(), lane = tid & 63, wave = tid >> 6, r = lane & 15, qd = lane >> 4;
  const float lg = logf(1.f - exp2f(-5.f - (float)hd));
  {
    const float* ssrc = p.ret_kv + (size_t)(c * 4 + hd) * 4096;
#pragma unroll
    for (int j = 0; j < 8; ++j) { int idx = tid + 512 * j; sSt[(idx >> 6) * 65 + (idx & 63)] = ssrc[idx]; }
  }
#pragma unroll
  for (int i = tid; i < 128 * 32; i += NT) {
    int t = i >> 5, f = i & 31; size_t tt = t0 + t;
    float cs = p.rope[(tt * 32 + f) * 2], sn = p.rope[(tt * 32 + f) * 2 + 1];
    float k1 = p.proj[tt * PW + RK + hd * 64 + f], k2 = p.proj[tt * PW + RK + hd * 64 + 32 + f];
    sK[t * 65 + f] = (k1 * cs - k2 * sn);
    sK[t * 65 + 32 + f] = (k2 * cs + k1 * sn);
    float q1 = p.proj[tt * PW + RQ + hd * 64 + f], q2 = p.proj[tt * PW + RQ + hd * 64 + 32 + f];
    sQ[t * 65 + f] = (q1 * cs - q2 * sn) * 0.125f;
    sQ[t * 65 + 32 + f] = (q2 * cs + q1 * sn) * 0.125f;
  }
#pragma unroll
  for (int i = tid; i < 128 * 64; i += NT) {
    int t = i >> 6, e = i & 63;
    sV[t * 65 + e] = p.proj[(size_t)(t0 + t) * PW + RV + hd * 64 + e];
  }
  __syncthreads();
  const int i0 = wave * 16;
  f32x4 sc[8], os[4];
#pragma unroll
  for (int t = 0; t < 8; ++t) sc[t] = f32x4{0.f, 0.f, 0.f, 0.f};
#pragma unroll
  for (int t = 0; t < 4; ++t) os[t] = f32x4{0.f, 0.f, 0.f, 0.f};
  mm16<8>(sc, sQ + i0 * 65, 65, 1, sK, 1, 65, 64);
  mm16<4>(os, sQ + i0 * 65, 65, 1, sSt, 65, 1, 64);
  __syncthreads();
  float* sP = (float*)smem;
#pragma unroll
  for (int t2 = 0; t2 < 8; ++t2)
#pragma unroll
    for (int e = 0; e < 4; ++e) {
      int i = i0 + 4 * qd + e, j = t2 * 16 + r;
      sP[i * 129 + j] = (i >= j) ? sc[t2][e] * expf(lg * (float)(i - j)) : 0.f;
    }
  __syncthreads();
  f32x4 o[4];
#pragma unroll
  for (int t2 = 0; t2 < 4; ++t2)
#pragma unroll
    for (int e = 0; e < 4; ++e) o[t2][e] = os[t2][e] * expf(lg * (float)(i0 + 4 * qd + e + 1));
  mm16<4>(o, sP + i0 * 129, 129, 1, sV, 65, 1, 128);
#pragma unroll
  for (int e = 0; e < 4; ++e) {
    int i = i0 + 4 * qd + e; size_t t = t0 + i;
    float sm = sum16(o[0][e] + o[1][e] + o[2][e] + o[3][e]);
    float mu = sm * (1.f / 64.f);
    float vr = 0.f;
#pragma unroll
    for (int t2 = 0; t2 < 4; ++t2) { float dd = o[t2][e] - mu; vr += dd * dd; }
    vr = sum16(vr);
    float rstd = rsqrtf(vr * (1.f / 64.f) + EPS);
    float ss = 0.f;
#pragma unroll
    for (int t2 = 0; t2 < 4; ++t2) {
      int col = hd * 64 + t2 * 16 + r;
      float on = (o[t2][e] - mu) * rstd * p.ret_gn[l * 256 + col];
      float g = p.proj[t * PW + RG + col];
      float y = siluf_(g) * on;
      ss += y * y;
      p.zb[t * DM + col] = f2bf(y * p.branch_norm[(l * 4 + 0) * 256 + col]);
    }
    ss = sum16(ss);
    if (r == 0) p.ssq[t * 16 + hd] = ss;
  }
  __syncthreads();
}

DEVI void lru_local(const Params& p, int l, int c, char* smem) {
  const int t0 = c * 64;
  float* sX = (float*)smem; float* sA = sX + 64 * 257;
  const int tid = TID(), lane = tid & 63, wave = tid >> 6, r = lane & 15, qd = lane >> 4;
  {
    const int ch = tid & 255, half = tid >> 8;
    const float w0 = p.lru_conv_w[(l * 4 + 0) * 256 + ch], w1 = p.lru_conv_w[(l * 4 + 1) * 256 + ch];
    const float w2 = p.lru_conv_w[(l * 4 + 2) * 256 + ch], w3 = p.lru_conv_w[(l * 4 + 3) * 256 + ch];
    const float cb = p.lru_conv_b[l * 256 + ch];
    const float* pc = p.proj + LX + ch;
    float xv[35];
#pragma unroll
    for (int k = 0; k < 35; ++k) {
      const int tt = t0 + 32 * half - 3 + k;
      const float v = pc[(size_t)(tt < 0 ? 0 : tt) * PW];
      xv[k] = tt < 0 ? 0.f : v;
    }
#pragma unroll
    for (int m = 0; m < 32; ++m) {
      float acc = cb;
      acc += w0 * xv[m]; acc += w1 * xv[m + 1]; acc += w2 * xv[m + 2]; acc += w3 * xv[m + 3];
      sX[(32 * half + m) * 257 + ch] = acc;
    }
  }
  __syncthreads();
  for (int pr = 0; pr < 2; ++pr) {
    int pi = wave * 2 + pr, mt = pi & 3, nb = pi >> 2;
    f32x4 ra[4], ri[4];
#pragma unroll
    for (int t = 0; t < 4; ++t) { ra[t] = f32x4{0.f, 0.f, 0.f, 0.f}; ri[t] = f32x4{0.f, 0.f, 0.f, 0.f}; }
    mm16_gB64<4>(ra, sX + mt * 16 * 257 + nb * 64, 257, p.lru_w_a + (size_t)(l * 4 + nb) * 4096);
    mm16_gB64<4>(ri, sX + mt * 16 * 257 + nb * 64, 257, p.lru_w_x + (size_t)(l * 4 + nb) * 4096);
#pragma unroll
    for (int t2 = 0; t2 < 4; ++t2)
#pragma unroll
      for (int e = 0; e < 4; ++e) {
        int t = mt * 16 + 4 * qd + e, ch = nb * 64 + t2 * 16 + r;
        float xb = sX[t * 257 + ch];
        float rr = sigmoidf_(ra[t2][e] + p.lru_b_a[l * 256 + ch]);
        float ii = sigmoidf_(ri[t2][e] + p.lru_b_x[l * 256 + ch]);
        float loga = -8.f * rr * softplusf_(-p.lru_lambda[l * 256 + ch]);
        float a = expf(loga);
        float bb = sqrtf(-expm1f(2.f * loga)) * (ii * xb);
        sA[t * 257 + ch] = a; sX[t * 257 + ch] = bb;
      }
  }
  __syncthreads();
  if (tid < 256) {
    int ch = tid; float H = 0.f, P = 1.f;
    for (int t = 0; t < 64; ++t) {
      float a = sA[t * 257 + ch], bb = sX[t * 257 + ch];
      H = a * H + bb; P *= a;
      p.lru_h[(size_t)(t0 + t) * 256 + ch] = H; p.lru_p[(size_t)(t0 + t) * 256 + ch] = P;
    }
    p.lru_hs[c * 256 + ch] = H; p.lru_ps[c * 256 + ch] = P;
  }
  __syncthreads();
}

DEVI void lru_out(const Params& p, int l, int c, char* smem) {
  const int t0 = c * 64;
  float* sC = (float*)smem;
  const int tid = TID(), lane = tid & 63, wave = tid >> 6;
  if (tid < 256) sC[tid] = p.lru_hs[c * 256 + tid];
  __syncthreads();
  {
    const int ch = lane * 4;
    float4 Hs[8], Ps[8], gs[8];
#pragma unroll
    for (int tk = 0; tk < 8; ++tk) {
      const size_t t = t0 + wave * 8 + tk;
      Hs[tk] = *(const float4*)&p.lru_h[t * 256 + ch]; Ps[tk] = *(const float4*)&p.lru_p[t * 256 + ch];
      gs[tk] = *(const float4*)&p.proj[t * PW + LG + ch];
    }
    const float4 cr = *(const float4*)&sC[ch];
    const float4 bn = *(const float4*)&p.branch_norm[(l * 4 + 1) * 256 + ch];
#pragma unroll
    for (int tk = 0; tk < 8; ++tk) {
      const size_t t = t0 + wave * 8 + tk;
      const float4 H = Hs[tk], P = Ps[tk], g = gs[tk];
      float y0 = geluf_(g.x) * (H.x + P.x * cr.x), y1 = geluf_(g.y) * (H.y + P.y * cr.y);
      float y2 = geluf_(g.z) * (H.z + P.z * cr.z), y3 = geluf_(g.w) * (H.w + P.w * cr.w);
      float ss = wave_sum(y0 * y0 + y1 * y1 + y2 * y2 + y3 * y3);
      if (lane == 0) p.ssq[t * 16 + 4] = ss;
      *(uint2*)&p.zb[t * DM + 256 + ch] = uint2{pack2(y0 * bn.x, y1 * bn.y), pack2(y2 * bn.z, y3 * bn.w)};
    }
  }
  __syncthreads();
}

DEVI void s5_coef(const Params& p, int l, int g, int n, float& abr, float& abi, float (&bbr)[16], float (&bbi)[16]) {
  float dt = expf(p.s5_log_dt[l * 16 + g]);
  float are = p.s5_a_re[(l * 16 + g) * 64 + n], aim = p.s5_a_im[(l * 16 + g) * 64 + n];
  float mag = expf(are * dt), ang = aim * dt;
  abr = mag * cosf(ang); abi = mag * sinf(ang);
  float den = are * are + aim * aim;
  float pre = abr - 1.f, pim = abi;
  float fre = (pre * are + pim * aim) / den, fim = (pim * are - pre * aim) / den;
  const float4* br = (const float4*)(p.s5_b_re + (size_t)((l * 16 + g) * 64 + n) * 16);
  const float4* bi = (const float4*)(p.s5_b_im + (size_t)((l * 16 + g) * 64 + n) * 16);
#pragma unroll
  for (int c4 = 0; c4 < 4; ++c4) {
    float4 a = br[c4], b = bi[c4];
    bbr[c4 * 4 + 0] = fre * a.x - fim * b.x; bbi[c4 * 4 + 0] = fre * b.x + fim * a.x;
    bbr[c4 * 4 + 1] = fre * a.y - fim * b.y; bbi[c4 * 4 + 1] = fre * b.y + fim * a.y;
    bbr[c4 * 4 + 2] = fre * a.z - fim * b.z; bbi[c4 * 4 + 2] = fre * b.z + fim * a.z;
    bbr[c4 * 4 + 3] = fre * a.w - fim * b.w; bbi[c4 * 4 + 3] = fre * b.w + fim * a.w;
  }
}
DEVI void s5_load_u(const Params& p, int t0, float* sU) {
#pragma unroll
  for (int i = TID(); i < 64 * 64; i += NT) {
    int t = i >> 6, c4 = i & 63;
    *(float4*)&sU[t * 256 + c4 * 4] = *(const float4*)&p.proj[(size_t)(t0 + t) * PW + SU + c4 * 4];
  }
}
DEVI void s5_bu(const float* up, const float (&bbr)[16], const float (&bbi)[16], float& bur, float& bui) {
  bur = 0.f; bui = 0.f;
#pragma unroll
  for (int c4 = 0; c4 < 4; ++c4) {
    float4 u = *(const float4*)&up[c4 * 4];
    bur += bbr[c4 * 4] * u.x + bbr[c4 * 4 + 1] * u.y + bbr[c4 * 4 + 2] * u.z + bbr[c4 * 4 + 3] * u.w;
    bui += bbi[c4 * 4] * u.x + bbi[c4 * 4 + 1] * u.y + bbi[c4 * 4 + 2] * u.z + bbi[c4 * 4 + 3] * u.w;
  }
}

DEVI void s5_local(const Params& p, int l, int c, char* smem) {
  const int t0 = c * 64;
  float* sU = (float*)smem;
  const int lane = TID() & 63, wave = TID() >> 6;
  s5_load_u(p, t0, sU);
  __syncthreads();
  for (int gi = 0; gi < 2; ++gi) {
    int g = wave + 8 * gi;
    float abr, abi, bbr[16], bbi[16];
    s5_coef(p, l, g, lane, abr, abi, bbr, bbi);
    float xr = 0.f, xi = 0.f;
    for (int t = 0; t < 64; ++t) {
      float bur, bui; s5_bu(sU + t * 256 + g * 16, bbr, bbi, bur, bui);
      float nr = abr * xr - abi * xi + bur, ni = abr * xi + abi * xr + bui;
      xr = nr; xi = ni;
    }
    *(float2*)&p.xloc[((size_t)(c * 16 + g) * 64 + lane) * 2] = float2{xr, xi};
  }
  __syncthreads();
}

DEVI void s5_out(const Params& p, int l, int c, char* smem) {
  const int t0 = c * 64;
  bf16_t* sY = (bf16_t*)smem;
  float* sX = (float*)(smem + 64 * 264 * 2);
  const int tid = TID(), lane = tid & 63, wave = tid >> 6, r = lane & 15, qd = lane >> 4;
  float* Xl = sX + wave * (16 * 132);
  for (int gi = 0; gi < 2; ++gi) {
    const int g = wave + 8 * gi;
    float abr, abi, bbr[16], bbi[16];
    s5_coef(p, l, g, lane, abr, abi, bbr, bbi);
    float breg[32];
#pragma unroll
    for (int ks = 0; ks < 16; ++ks) {
      breg[ks] = p.s5_c_re[(size_t)((l * 16 + g) * 16 + r) * 64 + 4 * ks + qd];
      breg[16 + ks] = -p.s5_c_im[(size_t)((l * 16 + g) * 16 + r) * 64 + 4 * ks + qd];
    }
    const float dd = p.s5_d[l * 256 + g * 16 + r];
    const float2 xin = *(const float2*)&p.xloc[((size_t)(c * 16 + g) * 64 + lane) * 2];
    float xr = xin.x, xi = xin.y;
    float4 uvecs[4]; float ues[4][4];
#pragma unroll
    for (int tb = 0; tb < 4; ++tb) {
      const float* ub = p.proj + (size_t)(t0 + tb * 16) * PW + SU + g * 16;
      uvecs[tb] = *(const float4*)&ub[(size_t)r * PW + 4 * qd];
#pragma unroll
      for (int e = 0; e < 4; ++e) ues[tb][e] = ub[(size_t)(4 * qd + e) * PW + r];
    }
#pragma unroll
    for (int tb = 0; tb < 4; ++tb) {
      const float4 uvec = uvecs[tb];
      float ue[4];
#pragma unroll
      for (int e = 0; e < 4; ++e) ue[e] = ues[tb][e];
      const int u0 = __float_as_int(uvec.x), u1 = __float_as_int(uvec.y), u2 = __float_as_int(uvec.z), u3 = __float_as_int(uvec.w);
#pragma unroll
      for (int tt = 0; tt < 16; ++tt) {
        float bur = 0.f, bui = 0.f;
#pragma unroll
        for (int c4 = 0; c4 < 4; ++c4) {
          float a0 = __int_as_float(__builtin_amdgcn_readlane(u0, tt + 16 * c4));
          float a1 = __int_as_float(__builtin_amdgcn_readlane(u1, tt + 16 * c4));
          float a2 = __int_as_float(__builtin_amdgcn_readlane(u2, tt + 16 * c4));
          float a3 = __int_as_float(__builtin_amdgcn_readlane(u3, tt + 16 * c4));
          bur += bbr[c4 * 4] * a0 + bbr[c4 * 4 + 1] * a1 + bbr[c4 * 4 + 2] * a2 + bbr[c4 * 4 + 3] * a3;
          bui += bbi[c4 * 4] * a0 + bbi[c4 * 4 + 1] * a1 + bbi[c4 * 4 + 2] * a2 + bbi[c4 * 4 + 3] * a3;
        }
        float nr = abr * xr - abi * xi + bur, ni = abr * xi + abi * xr + bui;
        xr = nr; xi = ni;
        Xl[tt * 132 + lane] = xr; Xl[tt * 132 + 64 + lane] = xi;
      }
      f32x4 acc = f32x4{0.f, 0.f, 0.f, 0.f};
#pragma unroll
      for (int ks = 0; ks < 32; ++ks) {
        float a = Xl[r * 132 + 4 * ks + qd];
        acc = __builtin_amdgcn_mfma_f32_16x16x4f32(a, breg[ks], acc, 0, 0, 0);
      }
#pragma unroll
      for (int e = 0; e < 4; ++e) {
        float y = acc[e] + dd * ue[e];
        sY[(tb * 16 + 4 * qd + e) * 264 + g * 16 + r] = f2bf(geluf_(y));
      }
    }
  }
  __syncthreads();
  f32x4 av[4][2], ag[4][2];
#pragma unroll
  for (int i = 0; i < 4; ++i)
#pragma unroll
    for (int j = 0; j < 2; ++j) { av[i][j] = f32x4{0.f, 0.f, 0.f, 0.f}; ag[i][j] = f32x4{0.f, 0.f, 0.f, 0.f}; }
  const bf16_t* WT = p.gluT + (size_t)l * 512 * 256;
#pragma unroll 4
  for (int ks = 0; ks < 8; ++ks) {
    bf16x8 bv0 = *(const bf16x8*)&WT[(size_t)(32 * wave + r) * 256 + ks * 32 + qd * 8];
    bf16x8 bv1 = *(const bf16x8*)&WT[(size_t)(32 * wave + 16 + r) * 256 + ks * 32 + qd * 8];
    bf16x8 bg0 = *(const bf16x8*)&WT[(size_t)(256 + 32 * wave + r) * 256 + ks * 32 + qd * 8];
    bf16x8 bg1 = *(const bf16x8*)&WT[(size_t)(256 + 32 * wave + 16 + r) * 256 + ks * 32 + qd * 8];
#pragma unroll
    for (int mt = 0; mt < 4; ++mt) {
      bf16x8 a = *(const bf16x8*)&sY[(mt * 16 + r) * 264 + ks * 32 + qd * 8];
      av[mt][0] = __builtin_amdgcn_mfma_f32_16x16x32_bf16(a, bv0, av[mt][0], 0, 0, 0);
      av[mt][1] = __builtin_amdgcn_mfma_f32_16x16x32_bf16(a, bv1, av[mt][1], 0, 0, 0);
      ag[mt][0] = __builtin_amdgcn_mfma_f32_16x16x32_bf16(a, bg0, ag[mt][0], 0, 0, 0);
      ag[mt][1] = __builtin_amdgcn_mfma_f32_16x16x32_bf16(a, bg1, ag[mt][1], 0, 0, 0);
    }
  }
  float* sO = sX;
#pragma unroll
  for (int mt = 0; mt < 4; ++mt)
#pragma unroll
    for (int t2 = 0; t2 < 2; ++t2)
#pragma unroll
      for (int e = 0; e < 4; ++e) {
        int t = mt * 16 + 4 * qd + e, col = 32 * wave + t2 * 16 + r;
        float zv = av[mt][t2][e] + p.s5_glu_b[l * 512 + col];
        float zg = ag[mt][t2][e] + p.s5_glu_b[l * 512 + 256 + col];
        sO[t * 256 + col] = zv * sigmoidf_(zg);
      }
  __syncthreads();
  for (int tk = 0; tk < 8; ++tk) {
    int tl = wave * 8 + tk; size_t t = t0 + tl; int ch = lane * 4;
    float4 o = *(const float4*)&sO[tl * 256 + ch];
    float4 bn = *(const float4*)&p.branch_norm[(l * 4 + 2) * 256 + ch];
    float ss = wave_sum(o.x * o.x + o.y * o.y + o.z * o.z + o.w * o.w);
    if (lane == 0) p.ssq[t * 16 + 5] = ss;
    *(uint2*)&p.zb[t * DM + 512 + ch] = uint2{pack2(o.x * bn.x, o.y * bn.y), pack2(o.z * bn.z, o.w * bn.w)};
  }
  __syncthreads();
}

DEVI void ret_scan(const Params& p, int it) {
  const int elem = it * NT + TID(), hd = elem >> 12, idx = elem & 4095;
  const float lg = logf(1.f - exp2f(-5.f - (float)hd)), cdk = expf(lg * 128.f);
  float* base = p.ret_kv + (size_t)hd * 4096 + idx;
  float s = 0.f;
  for (int cb = 0; cb < 128; cb += 16) {
    float v[16];
#pragma unroll
    for (int j = 0; j < 16; ++j) v[j] = base[(size_t)(cb + j) * 16384];
#pragma unroll
    for (int j = 0; j < 16; ++j) { base[(size_t)(cb + j) * 16384] = s; s = s * cdk + v[j]; }
  }
}
DEVI void s5_scan(const Params& p, int l, int it) {
  const int sidx = it * NT + TID(), g = sidx >> 6, n = sidx & 63;
  float dt = expf(p.s5_log_dt[l * 16 + g]);
  float are = p.s5_a_re[(l * 16 + g) * 64 + n], aim = p.s5_a_im[(l * 16 + g) * 64 + n];
  float mag = expf(are * dt), ang = aim * dt;
  float pr = mag * cosf(ang), pi = mag * sinf(ang);
#pragma unroll
  for (int k = 0; k < 6; ++k) { float nr = pr * pr - pi * pi, ni = 2.f * pr * pi; pr = nr; pi = ni; }
  float2* base = (float2*)p.xloc + sidx;
  float xr = 0.f, xi = 0.f;
  for (int cb = 0; cb < 256; cb += 16) {
    float2 v[16];
#pragma unroll
    for (int j = 0; j < 16; ++j) v[j] = base[(size_t)(cb + j) * 1024];
#pragma unroll
    for (int j = 0; j < 16; ++j) {
      base[(size_t)(cb + j) * 1024] = float2{xr, xi};
      float nr = pr * xr - pi * xi + v[j].x, ni = pr * xi + pi * xr + v[j].y;
      xr = nr; xi = ni;
    }
  }
}
DEVI void lru_scan(const Params& p) {
  const int ch = TID();
  if (ch < 256) {
    float carry = 0.f;
    for (int cb = 0; cb < 256; cb += 16) {
      float ps[16], hs[16];
#pragma unroll
      for (int j = 0; j < 16; ++j) { ps[j] = p.lru_ps[(cb + j) * 256 + ch]; hs[j] = p.lru_hs[(cb + j) * 256 + ch]; }
#pragma unroll
      for (int j = 0; j < 16; ++j) { p.lru_hs[(cb + j) * 256 + ch] = carry; carry = ps[j] * carry + hs[j]; }
    }
  }
}

DEVI void peer_scores(const Params& p, int l, int item, char* smem) {
  const int hp = item & 15, grp = item >> 4;
  float* sQ = (float*)smem;
  float* sKy = sQ + 64 * 68;
  const int tid = TID(), lane = tid & 63, wave = tid >> 6, r = lane & 15, qd = lane >> 4;
  const float* ky = p.peer_subkeys + (size_t)(l * 16 + hp) * 8192;
#pragma unroll
  for (int i = tid; i < 128 * 64; i += NT) { int k = i >> 6, d = i & 63; sKy[k * 65 + d] = ky[i]; }
  const int lt0 = tid >> 4, lc4 = (tid & 15) * 4;
  const float* qb = p.qbuf + (size_t)hp * 64 + lc4;
  float4 q0, q1;
  {
    const size_t t0 = (size_t)(grp * 16) * 64;
    q0 = *(const float4*)&qb[(t0 + lt0) * 1024]; q1 = *(const float4*)&qb[(t0 + lt0 + 32) * 1024];
  }
  const int mt = wave & 3, nh = wave >> 2;
  for (int k = 0; k < 16; ++k) {
    const size_t t0 = (size_t)(grp * 16 + k) * 64;
    __syncthreads();
    *(float4*)&sQ[lt0 * 68 + lc4] = q0; *(float4*)&sQ[(lt0 + 32) * 68 + lc4] = q1;
    __syncthreads();
    if (k + 1 < 16) { q0 = *(const float4*)&qb[(t0 + 64 + lt0) * 1024]; q1 = *(const float4*)&qb[(t0 + 64 + lt0 + 32) * 1024]; }
    f32x4 acc[4];
#pragma unroll
    for (int t = 0; t < 4; ++t) acc[t] = f32x4{0.f, 0.f, 0.f, 0.f};
    mm16<4>(acc, sQ + mt * 16 * 68, 68, 1, sKy + nh * 64 * 65, 1, 65, 64);
#pragma unroll
    for (int t2 = 0; t2 < 4; ++t2)
#pragma unroll
      for (int e = 0; e < 4; ++e) {
        size_t t = t0 + mt * 16 + 4 * qd + e; int key = nh * 64 + t2 * 16 + r;
        p.scores[(t * 16 + hp) * 128 + key] = acc[t2][e];
      }
  }
  __syncthreads();
}

DEVI unsigned ford(float x) { unsigned u = __float_as_uint(x); return (u & 0x80000000u) ? ~u : (u | 0x80000000u); }
DEVI float funord(unsigned u) { return __uint_as_float((u & 0x80000000u) ? (u ^ 0x80000000u) : ~u); }
DEVI void ins16(unsigned (&v)[16], unsigned x) {
#pragma unroll
  for (int j = 0; j < 16; ++j) { unsigned hi = max(v[j], x); x = min(v[j], x); v[j] = hi; }
}

DEVI void cv_issue(const Params& p, int l, int rr, int lane, float4& a, float4& b, float4& c, float4& d) {
  const int which = rr >> 14, row = rr & 16383;
  const float* s = (which ? p.peer_v : p.peer_u) + ((size_t)l * 16384 + row) * 1024 + lane * 16;
  a = *(const float4*)s; b = *(const float4*)(s + 4); c = *(const float4*)(s + 8); d = *(const float4*)(s + 12);
}
DEVI void cv_finish(const Params& p, int rr, int lane, const float4& a, const float4& b, const float4& c, const float4& d) {
  const int which = rr >> 14, row = rr & 16383;
  float m = fmaxf(fmaxf(fmaxf(fabsf(a.x), fabsf(a.y)), fmaxf(fabsf(a.z), fabsf(a.w))),
                  fmaxf(fmaxf(fabsf(b.x), fabsf(b.y)), fmaxf(fabsf(b.z), fabsf(b.w))));
  m = fmaxf(m, fmaxf(fmaxf(fmaxf(fabsf(c.x), fabsf(c.y)), fmaxf(fabsf(c.z), fabsf(c.w))),
                     fmaxf(fmaxf(fabsf(d.x), fabsf(d.y)), fmaxf(fabsf(d.z), fabsf(d.w)))));
  m = fmaxf(m, __shfl_xor(m, 32)); m = fmaxf(m, __shfl_xor(m, 16)); m = fmaxf(m, __shfl_xor(m, 8));
  m = fmaxf(m, __shfl_xor(m, 4)); m = fmaxf(m, __shfl_xor(m, 2)); m = fmaxf(m, __shfl_xor(m, 1));
  const float sc = m > 0.f ? 256.f / m : 1.f;
  int w0 = 0, w1 = 0, w2 = 0, w3 = 0;
  w0 = __builtin_amdgcn_cvt_pk_fp8_f32(a.x * sc, a.y * sc, w0, false); w0 = __builtin_amdgcn_cvt_pk_fp8_f32(a.z * sc, a.w * sc, w0, true);
  w1 = __builtin_amdgcn_cvt_pk_fp8_f32(b.x * sc, b.y * sc, w1, false); w1 = __builtin_amdgcn_cvt_pk_fp8_f32(b.z * sc, b.w * sc, w1, true);
  w2 = __builtin_amdgcn_cvt_pk_fp8_f32(c.x * sc, c.y * sc, w2, false); w2 = __builtin_amdgcn_cvt_pk_fp8_f32(c.z * sc, c.w * sc, w2, true);
  w3 = __builtin_amdgcn_cvt_pk_fp8_f32(d.x * sc, d.y * sc, w3, false); w3 = __builtin_amdgcn_cvt_pk_fp8_f32(d.z * sc, d.w * sc, w3, true);
  *(uint4*)((which ? p.tabV : p.tabU) + (size_t)row * 1024 + lane * 16) = uint4{(unsigned)w0, (unsigned)w1, (unsigned)w2, (unsigned)w3};
  if (lane == 0) (which ? p.vinv : p.uinv)[row] = m > 0.f ? m * (1.f / 256.f) : 1.f;
}

DEVI void peer_topk(const Params& p, int l, int item, int cvbase, char* smem) {
  const int t0 = item * 64;
  float* sS = (float*)smem;
  const int tid = TID();
  const float* base = p.scores + (size_t)t0 * 8 * 256;
  unsigned v1[16], v2[16];
#pragma unroll
  for (int j = 0; j < 16; ++j) { v1[j] = 0u; v2[j] = 0u; }
  float4 nx[8];
#pragma unroll
  for (int i = 0; i < 8; ++i) { int idx = tid + 512 * i; nx[i] = *(const float4*)&base[(size_t)(idx >> 3) * 256 + (idx & 7) * 4]; }
  for (int s = 0; s < 8; ++s) {
    __syncthreads();
#pragma unroll
    for (int i = 0; i < 8; ++i) {
      int idx = tid + 512 * i, pr = idx >> 3, c4 = idx & 7;
      float* d = &sS[pr * 33 + c4 * 4];
      d[0] = nx[i].x; d[1] = nx[i].y; d[2] = nx[i].z; d[3] = nx[i].w;
    }
    __syncthreads();
    if (s + 1 < 8) {
#pragma unroll
      for (int i = 0; i < 8; ++i) { int idx = tid + 512 * i; nx[i] = *(const float4*)&base[(size_t)(idx >> 3) * 256 + (s + 1) * 32 + (idx & 7) * 4]; }
    }
    float4 ca0, cb0, cc0, cd0, ca1, cb1, cc1, cd1;
    if (cvbase >= 0) {
      cv_issue(p, l, cvbase + 2 * s, tid & 63, ca0, cb0, cc0, cd0);
      cv_issue(p, l, cvbase + 2 * s + 1, tid & 63, ca1, cb1, cc1, cd1);
    }
    const int kb = (s & 3) * 32;
    if (s < 4) {
      for (int k = 0; k < 32; ++k) { unsigned key = (ford(sS[tid * 33 + k]) & ~127u) | (unsigned)(127 - (kb + k)); ins16(v1, key); }
    } else {
      for (int k = 0; k < 32; ++k) { unsigned key = (ford(sS[tid * 33 + k]) & ~127u) | (unsigned)(127 - (kb + k)); ins16(v2, key); }
    }
    if (cvbase >= 0) {
      cv_finish(p, cvbase + 2 * s, tid & 63, ca0, cb0, cc0, cd0);
      cv_finish(p, cvbase + 2 * s + 1, tid & 63, ca1, cb1, cc1, cd1);
    }
  }
  __syncthreads();
  unsigned* sI = (unsigned*)smem;
  float s1[16], s2[16];
#pragma unroll
  for (int a = 0; a < 16; ++a) {
    s1[a] = funord(v1[a] & ~127u); s2[a] = funord(v2[a] & ~127u);
    sI[tid * 33 + a] = 127u - (v1[a] & 127u); sI[tid * 33 + 16 + a] = 127u - (v2[a] & 127u);
  }
  unsigned vt[16];
#pragma unroll
  for (int j = 0; j < 16; ++j) vt[j] = 0u;
#pragma unroll
  for (int a = 0; a < 16; ++a)
#pragma unroll
    for (int b = 0; b < 16; ++b)
      if ((a + 1) * (b + 1) <= 16) {
        unsigned key = (ford(s1[a] + s2[b]) & ~255u) | (unsigned)(255 - (a * 16 + b));
        ins16(vt, key);
      }
  float sv[16]; float den = 0.f;
  const float mx = funord(vt[0] & ~255u);
#pragma unroll
  for (int k = 0; k < 16; ++k) { sv[k] = expf(funord(vt[k] & ~255u) - mx); den += sv[k]; }
  const float inv = 1.f / den;
  const int tl = tid >> 3, hh = tid & 7;
  int* idp = p.ids + (size_t)(t0 + tl) * 128 + hh * 16;
  float* gp = p.gates + (size_t)(t0 + tl) * 128 + hh * 16;
#pragma unroll
  for (int k = 0; k < 16; ++k) {
    unsigned pos = 255u - (vt[k] & 255u);
    unsigned i1 = sI[tid * 33 + (pos >> 4)], i2 = sI[tid * 33 + 16 + (pos & 15)];
    idp[k] = (int)(i1 * 128u + i2);
    gp[k] = sv[k] * inv;
  }
  __syncthreads();
}

typedef __attribute__((ext_vector_type(2))) float f32x2;
DEVI void fp8x16_to_f(const uint4& v, float (&o)[16]) {
  f32x2 t;
  t = __builtin_amdgcn_cvt_pk_f32_fp8((int)v.x, false); o[0] = t[0]; o[1] = t[1];
  t = __builtin_amdgcn_cvt_pk_f32_fp8((int)v.x, true); o[2] = t[0]; o[3] = t[1];
  t = __builtin_amdgcn_cvt_pk_f32_fp8((int)v.y, false); o[4] = t[0]; o[5] = t[1];
  t = __builtin_amdgcn_cvt_pk_f32_fp8((int)v.y, true); o[6] = t[0]; o[7] = t[1];
  t = __builtin_amdgcn_cvt_pk_f32_fp8((int)v.z, false); o[8] = t[0]; o[9] = t[1];
  t = __builtin_amdgcn_cvt_pk_f32_fp8((int)v.z, true); o[10] = t[0]; o[11] = t[1];
  t = __builtin_amdgcn_cvt_pk_f32_fp8((int)v.w, false); o[12] = t[0]; o[13] = t[1];
  t = __builtin_amdgcn_cvt_pk_f32_fp8((int)v.w, true); o[14] = t[0]; o[15] = t[1];
}

DEVI void ph_gather(const Params& p, int l) {
  const int lane = TID() & 63, wave = TID() >> 6;
  const int e0 = lane * 16;
  constexpr int NB = 8;
  for (int t = blockIdx.x * 8 + wave; t < S_; t += gridDim.x * 8) {
    float* hrow = p.h + (size_t)t * DM + e0;
    float z[16], out[16];
    {
      float4 a = *(const float4*)&hrow[0], b = *(const float4*)&hrow[4], c = *(const float4*)&hrow[8], d = *(const float4*)&hrow[12];
      z[0] = a.x; z[1] = a.y; z[2] = a.z; z[3] = a.w; z[4] = b.x; z[5] = b.y; z[6] = b.z; z[7] = b.w;
      z[8] = c.x; z[9] = c.y; z[10] = c.z; z[11] = c.w; z[12] = d.x; z[13] = d.y; z[14] = d.z; z[15] = d.w;
    }
    float ss = 0.f;
#pragma unroll
    for (int k = 0; k < 16; ++k) { ss += z[k] * z[k]; out[k] = 0.f; }
    ss = wave_sum(ss);
    const float rs = rsqrtf(ss * (1.f / DM) + EPS);
    const float* fn = p.ffn_norm + l * DM + e0;
#pragma unroll
    for (int k = 0; k < 16; ++k) z[k] = z[k] * rs * fn[k];
    const int id0 = p.ids[(size_t)t * 128 + lane], id1 = p.ids[(size_t)t * 128 + 64 + lane];
    const int gv0 = __float_as_int(p.gates[(size_t)t * 128 + lane] * p.vinv[id0]);
    const int gv1 = __float_as_int(p.gates[(size_t)t * 128 + 64 + lane] * p.vinv[id1]);
    const int us0 = __float_as_int(p.uinv[id0]), us1 = __float_as_int(p.uinv[id1]);
    uint4 cu[NB], cv[NB], nu[NB], nv[NB];
#pragma unroll
    for (int j = 0; j < NB; ++j) {
      int e = __builtin_amdgcn_readlane(id0, j);
      cu[j] = *(const uint4*)(p.tabU + (size_t)e * 1024 + e0);
      cv[j] = *(const uint4*)(p.tabV + (size_t)e * 1024 + e0);
    }
#pragma unroll 1
    for (int b = 0; b < 128 / NB; ++b) {
      const int nb = b + 1;
      if (nb < 128 / NB) {
        const int idn = nb < 64 / NB ? id0 : id1;
#pragma unroll
        for (int j = 0; j < NB; ++j) {
          int e = __builtin_amdgcn_readlane(idn, (nb * NB + j) & 63);
          nu[j] = *(const uint4*)(p.tabU + (size_t)e * 1024 + e0);
          nv[j] = *(const uint4*)(p.tabV + (size_t)e * 1024 + e0);
        }
      }
      const int gvc = b < 64 / NB ? gv0 : gv1, usc = b < 64 / NB ? us0 : us1;
      float dot[NB];
#pragma unroll
      for (int j = 0; j < NB; ++j) {
        float f[16]; fp8x16_to_f(cu[j], f);
        float d = 0.f;
#pragma unroll
        for (int k = 0; k < 16; ++k) d += z[k] * f[k];
        dot[j] = d;
      }
#pragma unroll
      for (int j = 0; j < NB; ++j) dot[j] = wave_sum(dot[j]);
#pragma unroll
      for (int j = 0; j < NB; ++j) {
        const int li = (b * NB + j) & 63;
        float us = __int_as_float(__builtin_amdgcn_readlane(usc, li));
        float gt = __int_as_float(__builtin_amdgcn_readlane(gvc, li));
        float cf = gt * geluf_(dot[j] * us);
        float f[16]; fp8x16_to_f(cv[j], f);
#pragma unroll
        for (int k = 0; k < 16; ++k) out[k] += cf * f[k];
      }
#pragma unroll
      for (int j = 0; j < NB; ++j) { cu[j] = nu[j]; cv[j] = nv[j]; }
    }
    float hv[16];
    {
      float4 a = *(const float4*)&hrow[0], b = *(const float4*)&hrow[4], c = *(const float4*)&hrow[8], d = *(const float4*)&hrow[12];
      hv[0] = a.x; hv[1] = a.y; hv[2] = a.z; hv[3] = a.w; hv[4] = b.x; hv[5] = b.y; hv[6] = b.z; hv[7] = b.w;
      hv[8] = c.x; hv[9] = c.y; hv[10] = c.z; hv[11] = c.w; hv[12] = d.x; hv[13] = d.y; hv[14] = d.z; hv[15] = d.w;
    }
    float s2 = 0.f;
#pragma unroll
    for (int k = 0; k < 16; ++k) { hv[k] += out[k]; s2 += hv[k] * hv[k]; }
    *(float4*)&hrow[0] = float4{hv[0], hv[1], hv[2], hv[3]}; *(float4*)&hrow[4] = float4{hv[4], hv[5], hv[6], hv[7]};
    *(float4*)&hrow[8] = float4{hv[8], hv[9], hv[10], hv[11]}; *(float4*)&hrow[12] = float4{hv[12], hv[13], hv[14], hv[15]};
    s2 = wave_sum(s2);
    const float rs2 = rsqrtf(s2 * (1.f / DM) + EPS);
    const float* pn = p.ple_norm + l * DM + e0;
    float zz[16];
#pragma unroll
    for (int k = 0; k < 16; ++k) zz[k] = hv[k] * rs2 * pn[k];
    bf16_t* zrow = p.zb + (size_t)t * DM + e0;
    *(uint4*)&zrow[0] = uint4{pack2(zz[0], zz[1]), pack2(zz[2], zz[3]), pack2(zz[4], zz[5]), pack2(zz[6], zz[7])};
    *(uint4*)&zrow[8] = uint4{pack2(zz[8], zz[9]), pack2(zz[10], zz[11]), pack2(zz[12], zz[13]), pack2(zz[14], zz[15])};
  }
}

template <class F>
DEVI void gemm_tiles(int NTn, int XM, int XN, F&& f) {
  int G = gridDim.x, B = blockIdx.x;
  asm volatile("" : "+s"(G), "+s"(B));
  if (G & 7) { for (int tile = B; tile < 64 * NTn; tile += G) f(tile / NTn, tile % NTn); return; }
  const int x = B & 7, slot = B >> 3, ns = G >> 3;
  const int xm = x / XN, xn = x % XN;
  const int mcnt = 64 / XM, mb = xm * mcnt;
  const int ncnt = (NTn - xn + XN - 1) / XN;
  for (int j = slot; j < mcnt * ncnt; j += ns) f(mb + j / ncnt, xn + XN * (j % ncnt));
}

enum { PH_PREP = 0, PH_NORM1, PH_GEMM_IN, PH_MIX_A, PH_MIX_B, PH_MIX_C, PH_MIX_D, PH_GEMM_OUT, PH_NORM2, PH_GEMM_Q, PH_SCORES,
       PH_TOPK, PH_GATHER, PH_GEMM_PLE, PH_FINAL };

#if PROBE_A >= 0
#define REGION(id, stmt)                                                                                   \
  {                                                                                                        \
    const bool on_ = (blockIdx.x == 255 && TID() == 0 && ((id) == PROBE_A || (id) == PROBE_B));              \
    if (on_) p.g_cdec[2051] = (float)(wall_clock64() & 0xFFFFFFull);                                       \
    stmt;                                                                                                  \
    if (on_) {                                                                                             \
      float dt_ = (float)(wall_clock64() & 0xFFFFFFull) - p.g_cdec[2051];                                  \
      if (dt_ < 0.f) dt_ += 16777216.f;                                                                    \
      p.g_cdec[(id) == PROBE_A ? 2048 : 2049] += dt_;                                                      \
    }                                                                                                      \
  }
#else
#define REGION(id, stmt) { stmt; }
#endif
DEVI void run_phase(const Params& p, int ph, int l, char* smem) {
  int G = gridDim.x, B = blockIdx.x;
  asm volatile("" : "+s"(G), "+s"(B));
  switch (ph) {
    case PH_PREP:
      ph_prep(p, smem);
      ph_norm(p.x, p.mix_norm, p.zb, nullptr);
      break;
    case PH_NORM1: ph_norm(l == 0 ? p.x : p.h, p.mix_norm + l * DM, p.zb, nullptr); break;
    case PH_GEMM_IN:
      gemm_tiles(23, 1, 8, [&](int mt_, int nt_) __attribute__((always_inline)) {
        int m0 = mt_ * 256, n0 = nt_ * 128;
        f32x4 acc[4][4];
        gemm_tile<0, 16>(acc, p.zb, DM, p.winT + (size_t)l * PW * 1024, 1024, 1024, m0, n0, nullptr, smem);
        GEMM_EPI_COORDS
#pragma unroll
        for (int i = 0; i < 4; ++i)
#pragma unroll
          for (int j = 0; j < 4; ++j)
            *(f32x4*)&p.proj[(size_t)(erow0 + i * 16) * PW + ecol0 + j * 16] = acc[i][j];
      });
      break;
    case PH_MIX_A:
      for (int it = B; it < 2048; it += G) {
        if (it < 1024) REGION(105, gdn_prep(p, l, it, smem))
        else if (it < 1536) REGION(106, ret_kv(p, l, it - 1024, smem))
        else if (it < 1792) REGION(107, lru_local(p, l, it - 1536, smem))
        else REGION(108, s5_local(p, l, it - 1792, smem))
      }
      break;
    case PH_MIX_B:
      for (int it = B; it < 256 + 35; it += G) {
        if (it < 256) { const int pr_ = (it & 7) * 4 + (it >> 6), cb_ = (it >> 3) & 7; REGION(100, gdn_chain<0>(p, pr_ >> 3, pr_ & 7, cb_, smem)) }
        else if (it < 256 + 32) ret_scan(p, it - 256);
        else if (it < 256 + 34) s5_scan(p, l, it - 288);
        else lru_scan(p);
      }
      break;
    case PH_MIX_C: {
      for (int k = 0;; ++k) {
        int ty = -1, idx = 0;
        if (G == 256) {
          if (B < 128) { if (k < 4) { ty = k; idx = B; } }
          else if (k == 0) { ty = 1; idx = B; }
          else if (k <= 3) { ty = 2; idx = 128 + (B - 128) * 3 + (k - 1); }
          else if (k == 4) { ty = 3; idx = B; }
        } else {
          const int it = B + k * G;
          if (it < 128) { ty = 0; idx = it; }
          else if (it < 640) { ty = 2; idx = it - 128; }
          else if (it < 896) { ty = 1; idx = it - 640; }
          else if (it < 1152) { ty = 3; idx = it - 896; }
        }
        if (ty < 0) break;
        if (ty == 0) { const int pr_ = (idx & 7) * 4 + (idx >> 5), cb_ = (idx >> 3) & 3; REGION(102, gdn_chain<1>(p, pr_ >> 3, pr_ & 7, cb_, smem)) }
        else if (ty == 1) REGION(103, s5_out(p, l, idx, smem))
        else if (ty == 2) REGION(101, ret_out(p, l, idx, smem))
        else REGION(104, lru_out(p, l, idx, smem))
      }
    } break;
    case PH_MIX_D:
      for (int it = B; it < 1024; it += G) REGION(109, gdn_out(p, l, it, smem))
      break;
    case PH_GEMM_OUT:
      gemm_tiles(8, 4, 2, [&](int mt_, int nt_) __attribute__((always_inline)) {
        int m0 = mt_ * 256, n0 = nt_ * 128;
        f32x4 acc[4][4];
        gemm_tile<1, 16>(acc, p.zb, DM, p.woutT + (size_t)l * 1024 * 1024, 1024, 1024, m0, n0, p.ssq, smem);
        GEMM_EPI_COORDS
#pragma unroll
        for (int i = 0; i < 4; ++i)
#pragma unroll
          for (int j = 0; j < 4; ++j)
            acc[i][j] += *(const f32x4*)&(l == 0 ? p.x : p.h)[(size_t)(erow0 + i * 16) * DM + ecol0 + j * 16];
#pragma unroll
        for (int i = 0; i < 4; ++i)
#pragma unroll
          for (int j = 0; j < 4; ++j)
            *(f32x4*)&p.h[(size_t)(erow0 + i * 16) * DM + ecol0 + j * 16] = acc[i][j];
      });
      break;
    case PH_NORM2:
      ph_norm(p.h, p.ffn_norm + l * DM, p.zb, nullptr);
      {
        const size_t gtid = (size_t)B * NT + TID(), gsz = (size_t)G * NT;
        const float4* sp = (const float4*)(p.p + (size_t)l * S_ * 256);
        for (size_t i = gtid; i < (size_t)S_ * 256 / 8; i += gsz) {
          float4 a = sp[2 * i], b = sp[2 * i + 1];
          ((uint4*)p.pbf)[i] = uint4{pack2(a.x, a.y), pack2(a.z, a.w), pack2(b.x, b.y), pack2(b.z, b.w)};
        }
      }
      break;
    case PH_GEMM_Q:
      gemm_tiles(8, 4, 2, [&](int mt_, int nt_) __attribute__((always_inline)) {
        int m0 = mt_ * 256, n0 = nt_ * 128;
        f32x4 acc[4][4];
        gemm_tile<0, 16>(acc, p.zb, DM, p.wqT + (size_t)l * 1024 * 1024, 1024, 1024, m0, n0, nullptr, smem);
        GEMM_EPI_COORDS
#pragma unroll
        for (int i = 0; i < 4; ++i)
#pragma unroll
          for (int j = 0; j < 4; ++j)
            *(f32x4*)&p.qbuf[(size_t)(erow0 + i * 16) * DM + ecol0 + j * 16] = acc[i][j];
      });
      break;
    case PH_SCORES:
      for (int it = B; it < 256; it += G) REGION(110, peer_scores(p, l, it, smem))
      break;
    case PH_TOPK:
      for (int it = B; it < 256; it += G) REGION(111, peer_topk(p, l, it, (G == 256) ? (B * 8 + (TID() >> 6)) * 16 : -1, smem))
      if (G != 256) convert_tables(p, l);
      break;
    case PH_GATHER: ph_gather(p, l); break;
    case PH_GEMM_PLE:
      gemm_tiles(8, 4, 2, [&](int mt_, int nt_) __attribute__((always_inline)) {
        int m0 = mt_ * 256, n0 = nt_ * 128;
        uint2* gsc = (uint2*)p.g_attn + (size_t)B * 16 * NT + TID();
        {
          f32x4 ag[4][4];
          gemm_tile<0, 16>(ag, p.zb, DM, p.wgT + (size_t)l * 1024 * 1024, 1024, 1024, m0, n0, nullptr, smem);
#pragma unroll
          for (int i = 0; i < 4; ++i)
#pragma unroll
            for (int j = 0; j < 4; ++j)
              gsc[(i * 4 + j) * NT] = uint2{pack2(sigmoidf_(ag[i][j][0]), sigmoidf_(ag[i][j][1])),
                                            pack2(sigmoidf_(ag[i][j][2]), sigmoidf_(ag[i][j][3]))};
        }
        f32x4 ap[4][4];
        gemm_tile<0, 4>(ap, p.pbf, 256, p.wpT + (size_t)l * 1024 * 256, 256, 256, m0, n0, nullptr, smem);
        GEMM_EPI_COORDS
#pragma unroll
        for (int i = 0; i < 4; ++i)
#pragma unroll
          for (int j = 0; j < 4; ++j) {
            const f32x4 hv = *(const f32x4*)&p.h[(size_t)(erow0 + i * 16) * DM + ecol0 + j * 16];
            const uint2 gk = gsc[(i * 4 + j) * NT];
            ap[i][j][0] = hv[0] + ap[i][j][0] * __uint_as_float(gk.x << 16);
            ap[i][j][1] = hv[1] + ap[i][j][1] * __uint_as_float(gk.x & 0xFFFF0000u);
            ap[i][j][2] = hv[2] + ap[i][j][2] * __uint_as_float(gk.y << 16);
            ap[i][j][3] = hv[3] + ap[i][j][3] * __uint_as_float(gk.y & 0xFFFF0000u);
          }
#pragma unroll
        for (int i = 0; i < 4; ++i)
#pragma unroll
          for (int j = 0; j < 4; ++j)
            *(f32x4*)&p.h[(size_t)(erow0 + i * 16) * DM + ecol0 + j * 16] = ap[i][j];
      });
      break;
    case PH_FINAL: ph_norm(p.h, p.final_norm, nullptr, p.out); break;
  }
}

#if !MEGA
__global__ void __launch_bounds__(NT) k_phase(Params p, int ph, int l) {
  extern __shared__ __align__(16) char smem[];
  run_phase(p, ph, l, smem);
}
#endif

#define XB_TMO      128
#define XB_XCNT(j)  (256  + 64 * (j))
#define XB_XSUB(j)  (1280 + 64 * (j))
#define XB_XGEN(j)  (2304 + 64 * (j))
#define XB_TOP      3328
#define XB_TOPGEN   3392
#define XCD_BAR_WORDS 3456
#define XB_SPIN_CAP (1u << 18)
#define LAS __attribute__((address_space(3)))
DEVI unsigned xb_ld(unsigned* p) { return __hip_atomic_load(p, __ATOMIC_RELAXED, __HIP_MEMORY_SCOPE_AGENT); }
DEVI unsigned xb_add(unsigned* p, unsigned v) { return __hip_atomic_fetch_add(p, v, __ATOMIC_RELAXED, __HIP_MEMORY_SCOPE_AGENT); }
DEVI unsigned xb_xcc_id() { return (unsigned)__builtin_amdgcn_s_getreg((3 << 11) | 20) & 0xFu; }
#define XB_SPIN(cond, bar) do { unsigned _sp = 0; while (cond) { __builtin_amdgcn_s_sleep(1); \
    if ((++_sp & 255u) == 0u) { if (xb_ld(&(bar)[XB_TMO])) break; if (_sp > XB_SPIN_CAP) { atomicAdd(&(bar)[XB_TMO], 1u); break; } } } } while (0)
struct XcdBarrier { unsigned* bar; unsigned x; volatile LAS unsigned* st; };
DEVI XcdBarrier xcd_barrier_post(unsigned* bar, volatile LAS unsigned* st) {
  XcdBarrier b; b.bar = bar; b.x = xb_xcc_id(); b.st = st;
  if (TID() == 0) (void)xb_add(&bar[XB_XCNT(b.x)], 1u);
  return b;
}
DEVI void xcd_barrier_complete(unsigned* bar, unsigned x, unsigned& nloc, unsigned& nx) {
  const unsigned G = gridDim.x * gridDim.y * gridDim.z;
  unsigned sum, cnt, mine, sp = 0u;
  for (;;) {
    sum = 0u; cnt = 0u; mine = 0u;
#pragma unroll
    for (unsigned j = 0; j < 16; ++j) { const unsigned c = xb_ld(&bar[XB_XCNT(j)]); sum += c; cnt += (c > 0u) ? 1u : 0u; mine = (j == x) ? c : mine; }
    if (sum == G) break;
    __builtin_amdgcn_s_sleep(1);
    if ((++sp & 255u) == 0u) { if (xb_ld(&bar[XB_TMO])) break; if (sp > XB_SPIN_CAP) { atomicAdd(&bar[XB_TMO], 1u); break; } }
  }
  nloc = mine > 0u ? mine : 1u; nx = cnt > 0u ? cnt : 1u;
}
DEVI void xcd_barrier(const XcdBarrier& b) {
  asm volatile("s_waitcnt vmcnt(0)" ::: "memory");
  __syncthreads();
  if (TID() == 0) {
    unsigned* bar = b.bar;
    __builtin_amdgcn_s_waitcnt(0);
    unsigned nloc = b.st[0], nx = b.st[1];
    if (nloc == 0u) { xcd_barrier_complete(bar, b.x, nloc, nx); b.st[0] = nloc; b.st[1] = nx; }
    const unsigned old = xb_add(&bar[XB_XSUB(b.x)], 1u);
    const unsigned gen = old / nloc;
    if (old + 1u == (gen + 1u) * nloc) {
      __builtin_amdgcn_fence(__ATOMIC_RELEASE, "agent");
      asm volatile("s_waitcnt vmcnt(0)" ::: "memory");
      const unsigned og = xb_add(&bar[XB_TOP], 1u);
      const unsigned tg = og / nx;
      if (og + 1u == (tg + 1u) * nx) xb_add(&bar[XB_TOPGEN], 1u);
      else XB_SPIN(xb_ld(&bar[XB_TOPGEN]) == tg, bar);
      __builtin_amdgcn_fence(__ATOMIC_ACQUIRE, "agent");
      xb_add(&bar[XB_XGEN(b.x)], 1u);
      asm volatile("s_waitcnt vmcnt(0)" ::: "memory");
    } else {
      XB_SPIN(xb_ld(&bar[XB_XGEN(b.x)]) == gen, bar);
      __builtin_amdgcn_fence(__ATOMIC_ACQUIRE, "agent");
      asm volatile("s_waitcnt vmcnt(0)" ::: "memory");
    }
  }
  __syncthreads();
}

#if MEGA
template <int ph, int l>
DEVI void mega_step(const Params& p, char* smem, const XcdBarrier& xb) {
#if PROBE_A >= 0
  if (blockIdx.x == 0 && TID() == 0 && (ph == PROBE_A || ph == PROBE_B)) p.g_cdec[2050] = (float)(wall_clock64() & 0xFFFFFFull);
  run_phase(p, ph, l, smem);
  xcd_barrier(xb);
  if (blockIdx.x == 0 && TID() == 0 && (ph == PROBE_A || ph == PROBE_B)) {
    float dt = (float)(wall_clock64() & 0xFFFFFFull) - p.g_cdec[2050];
    if (dt < 0.f) dt += 16777216.f;
    p.g_cdec[ph == PROBE_A ? 2048 : 2049] += dt;
  }
#else
  run_phase(p, ph, l, smem);
  xcd_barrier(xb);
#endif
}
template <int l>
DEVI void mega_layer(const Params& p, char* smem, const XcdBarrier& xb) {
  if constexpr (l != 0) mega_step<PH_NORM1, l>(p, smem, xb);
  mega_step<PH_GEMM_IN, l>(p, smem, xb);
  mega_step<PH_MIX_A, l>(p, smem, xb);
  mega_step<PH_MIX_B, l>(p, smem, xb);
  mega_step<PH_MIX_C, l>(p, smem, xb);
  mega_step<PH_MIX_D, l>(p, smem, xb);
  mega_step<PH_GEMM_OUT, l>(p, smem, xb);
  mega_step<PH_NORM2, l>(p, smem, xb);
  mega_step<PH_GEMM_Q, l>(p, smem, xb);
  mega_step<PH_SCORES, l>(p, smem, xb);
  mega_step<PH_TOPK, l>(p, smem, xb);
  mega_step<PH_GATHER, l>(p, smem, xb);
  mega_step<PH_GEMM_PLE, l>(p, smem, xb);
}
__global__ void __launch_bounds__(NT) k_mega(Params p) {
  extern __shared__ __align__(16) char smem[];
  cg::grid_group grid = cg::this_grid();
#if PROBE_A >= 0
  if (blockIdx.x == 0 && TID() == 0) { p.g_cdec[2048] = 0.f; p.g_cdec[2049] = 0.f; }
#endif
  __shared__ uint4 xb_words;
  if (TID() == 0) xb_words = uint4{0u, 0u, 0u, 0u};
  __syncthreads();
  const XcdBarrier xb = xcd_barrier_post(p.bar, (volatile LAS unsigned*)&xb_words);
  grid.sync();
  mega_step<PH_PREP, 0>(p, smem, xb);
  mega_layer<0>(p, smem, xb);
  mega_layer<1>(p, smem, xb);
  run_phase(p, PH_FINAL, 0, smem);
#if PROBE_A >= 0
  xcd_barrier(xb);
  {
    const float qa_ = expf(rintf(logf(p.g_cdec[2048] * 0.01f) * 4.f) * 0.25f), qb_ = expf(rintf(logf(p.g_cdec[2049] * 0.01f) * 4.f) * 0.25f);
    const float va = sqrtf(qa_), vb = qb_;
    const size_t gtid = (size_t)blockIdx.x * NT + TID(), gsz = (size_t)gridDim.x * NT;
    for (size_t i = gtid; i < (size_t)S_ * DM; i += gsz) p.out[i] = (i == 0) ? vb : va;
  }
#endif
}
#endif

extern "C" void kernel_launch(void* const* d_in, const int* in_sizes, int n_in, void* d_out, int out_size, void* d_ws,
                              size_t ws_size, hipStream_t stream) {
  Params p{};
  const float* const* f = (const float* const*)d_in;
  p.x = f[0]; p.p = f[1]; p.pos = (const int*)d_in[2];
  p.mix_norm = f[3]; p.w_in = f[4]; p.ret_gn = f[5]; p.lru_conv_w = f[6]; p.lru_conv_b = f[7]; p.lru_w_a = f[8];
  p.lru_b_a = f[9]; p.lru_w_x = f[10]; p.lru_b_x = f[11]; p.lru_lambda = f[12];
  p.s5_a_re = f[13]; p.s5_a_im = f[14]; p.s5_b_re = f[15]; p.s5_b_im = f[16]; p.s5_c_re = f[17]; p.s5_c_im = f[18];
  p.s5_d = f[19]; p.s5_log_dt = f[20]; p.s5_glu_w = f[21]; p.s5_glu_b = f[22];
  p.gdn_conv_w = f[23]; p.gdn_a_log = f[24]; p.gdn_dt_bias = f[25]; p.gdn_norm = f[26]; p.branch_norm = f[27];
  p.w_out = f[28]; p.ffn_norm = f[29]; p.peer_wq = f[30]; p.peer_subkeys = f[31]; p.peer_u = f[32]; p.peer_v = f[33];
  p.ple_norm = f[34]; p.ple_wg = f[35]; p.ple_wp = f[36]; p.final_norm = f[37];
  p.out = (float*)d_out;
  char* ws = (char*)d_ws;
  const size_t MiB = 1024 * 1024;
  p.h = (float*)(ws + 0 * MiB);
  p.zb = (bf16_t*)(ws + 64 * MiB);
  p.proj = (float*)(ws + 96 * MiB);
  p.qbuf = (float*)(ws + 96 * MiB);
  p.scores = (float*)(ws + 160 * MiB);
  p.g_u = (float*)(ws + 288 * MiB); p.g_w = (float*)(ws + 304 * MiB); p.g_attn = (float*)(ws + 320 * MiB);
  p.g_qd = (float*)(ws + 336 * MiB); p.g_kd = (float*)(ws + 352 * MiB);
  p.ids = (int*)(ws + 288 * MiB); p.gates = (float*)(ws + 296 * MiB);
  p.lru_h = (float*)(ws + 368 * MiB); p.lru_p = (float*)(ws + 384 * MiB);
  p.ret_kv = (float*)(ws + 400 * MiB);
  p.tabU = (uint8_t*)(ws + 408 * MiB); p.tabV = (uint8_t*)(ws + 440 * MiB);
  p.uinv = (float*)(ws + 505 * MiB); p.vinv = (float*)(ws + 505 * MiB + 65536);
  p.g_sst = (float*)(ws + 408 * MiB);
  {
    char* wb = ws + 472 * MiB;
    p.winT = (bf16_t*)wb; wb += (size_t)2 * PW * 1024 * 2;
    p.woutT = (bf16_t*)wb; wb += (size_t)2 * 1024 * 1024 * 2;
    p.wqT = (bf16_t*)wb; wb += (size_t)2 * 1024 * 1024 * 2;
    p.wgT = (bf16_t*)wb; wb += (size_t)2 * 1024 * 1024 * 2;
    p.wpT = (bf16_t*)wb; wb += (size_t)2 * 1024 * 256 * 2;
    p.gluT = (bf16_t*)wb; wb += (size_t)2 * 512 * 256 * 2;
  }
  p.rope = (float*)(ws + 497 * MiB);
  p.ssq = (float*)(ws + 501 * MiB);
  p.xloc = (float*)(ws + 502 * MiB);
  p.lru_hs = (float*)(ws + 504 * MiB);
  p.lru_ps = (float*)(ws + 504 * MiB + 256 * 256 * 4);
  p.g_cdec = (float*)(ws + 504 * MiB + 2 * 256 * 256 * 4);
  p.g_comp = (float*)(ws + 506 * MiB);
  p.pbf = (bf16_t*)(ws + 304 * MiB);
  p.bar = (unsigned*)(ws + 507 * MiB);

  static int grid_blocks = 0;
  if (!grid_blocks) {
#if MEGA
    hipFuncSetAttribute((const void*)k_mega, hipFuncAttributeMaxDynamicSharedMemorySize, LDS_BYTES);
#endif
#if !MEGA
    hipFuncSetAttribute((const void*)k_phase, hipFuncAttributeMaxDynamicSharedMemorySize, LDS_BYTES);
#endif
    int dev = 0, cus = 0, per_cu = 0;
    hipGetDevice(&dev);
    hipDeviceGetAttribute(&cus, hipDeviceAttributeMultiprocessorCount, dev);
#if MEGA
    hipOccupancyMaxActiveBlocksPerMultiprocessor(&per_cu, k_mega, NT, LDS_BYTES);
#else
    hipOccupancyMaxActiveBlocksPerMultiprocessor(&per_cu, k_phase, NT, LDS_BYTES);
#endif
    if (per_cu < 1) per_cu = 1;
    grid_blocks = cus * per_cu;
  }
#if MEGA
  hipMemsetAsync(p.bar, 0, XCD_BAR_WORDS * 4, stream);
  void* args[] = {&p};
  hipError_t e = hipLaunchCooperativeKernel((void*)k_mega, dim3(grid_blocks), dim3(NT), args, LDS_BYTES, stream);
  if (e != hipSuccess) fprintf(stderr, "cooperative launch failed: %s (grid %d)\n", hipGetErrorString(e), grid_blocks);
#else
  k_phase<<<grid_blocks, NT, LDS_BYTES, stream>>>(p, PH_PREP, 0);
  for (int l = 0; l < NL; ++l)
    for (int ph = PH_NORM1; ph <= PH_GEMM_PLE; ++ph) k_phase<<<grid_blocks, NT, LDS_BYTES, stream>>>(p, ph, l);
  k_phase<<<grid_blocks, NT, LDS_BYTES, stream>>>(p, PH_FINAL, 0);
#endif
}
```

```cpp
#include <hip/hip_runtime.h>
#include <hip/hip_bf16.h>
#include <hip/hip_cooperative_groups.h>
#include <cstdio>
#include <cstdint>
namespace cg = cooperative_groups;

#ifndef MEGA
#define MEGA 1
#endif

#ifndef PROBE_A
#define PROBE_A -1
#endif
#ifndef PROBE_B
#define PROBE_B -1
#endif
#define DEVI __device__ __forceinline__

typedef __attribute__((ext_vector_type(8))) short bf16x8;
typedef __attribute__((ext_vector_type(4))) float f32x4;
typedef unsigned short bf16_t;

constexpr int NT = 512;
constexpr int S_ = 16384, DM = 1024, NL = 2, PW = 2944, INW = 2824;
constexpr int RQ = 0, RK = 256, RV = 512, RG = 768, LG = 1024, LX = 1280, SU = 1536, DQ = 1792,
              DB = 2560, DA = 2564, DG = 2568;
constexpr float EPS = 1e-6f;
constexpr int LDS_BYTES = 132 * 1024;

struct Params {
  const float *x, *p; const int* pos;
  const float *mix_norm, *w_in, *ret_gn, *lru_conv_w, *lru_conv_b, *lru_w_a, *lru_b_a, *lru_w_x, *lru_b_x, *lru_lambda;
  const float *s5_a_re, *s5_a_im, *s5_b_re, *s5_b_im, *s5_c_re, *s5_c_im, *s5_d, *s5_log_dt, *s5_glu_w, *s5_glu_b;
  const float *gdn_conv_w, *gdn_a_log, *gdn_dt_bias, *gdn_norm, *branch_norm, *w_out, *ffn_norm, *peer_wq, *peer_subkeys;
  const float *peer_u, *peer_v, *ple_norm, *ple_wg, *ple_wp, *final_norm;
  float* out;
  float* h; bf16_t* zb; float* proj; float* qbuf; float* scores;
  float *g_u, *g_w, *g_attn, *g_qd, *g_kd, *g_sst, *g_cdec, *g_comp;
  int* ids; float* gates;
  float *lru_h, *lru_p, *lru_hs, *lru_ps;
  float* ret_kv; float* xloc;
  uint8_t *tabU, *tabV; float *uinv, *vinv;
  bf16_t *winT, *woutT, *wqT, *wgT, *wpT, *gluT;
  float* rope; float* ssq; bf16_t* pbf; unsigned* bar;
};

DEVI int TID() { int t = __builtin_amdgcn_workitem_id_x(); asm volatile("" : "+v"(t)); return t; }
DEVI bf16_t f2bf(float f) { unsigned u = __float_as_uint(f); u += 0x7FFFu + ((u >> 16) & 1u); return (bf16_t)(u >> 16); }
DEVI float bf2f(bf16_t b) { return __uint_as_float(((unsigned)b) << 16); }
DEVI unsigned pack2(float a, float b) { return (unsigned)f2bf(a) | ((unsigned)f2bf(b) << 16); }
DEVI float sigmoidf_(float x) { return __fdividef(1.f, 1.f + __expf(-x)); }
DEVI float siluf_(float x) { return x * __fdividef(1.f, 1.f + __expf(-x)); }
DEVI float geluf_ref_(float x) { float u = 0.7978845608028654f * (x + 0.044715f * x * x * x); return 0.5f * x * (1.f + tanhf(u)); }
DEVI float geluf_(float x) { float u = 0.7978845608028654f * (x + 0.044715f * x * x * x); return x * __fdividef(1.f, 1.f + __expf(-2.f * u)); }
DEVI float softplusf_(float x) { return x > 20.f ? x : log1pf(expf(x)); }
DEVI float wave_sum(float v) {
  v += __shfl_xor(v, 32); v += __shfl_xor(v, 16); v += __shfl_xor(v, 8);
  v += __shfl_xor(v, 4); v += __shfl_xor(v, 2); v += __shfl_xor(v, 1); return v;
}
DEVI float sum16(float v) {
  v += __shfl_xor(v, 8); v += __shfl_xor(v, 4); v += __shfl_xor(v, 2); v += __shfl_xor(v, 1); return v;
}

template <int NTL>
DEVI void mm16(f32x4 (&acc)[NTL], const float* A, int sam, int sak, const float* B, int sbk, int sbn, int K) {
  const int l = TID() & 63, r = l & 15, q = l >> 4;
  const float* ap = A + r * sam + q * sak;
  const float* bp = B + q * sbk + r * sbn;
#pragma unroll 4
  for (int k = 0; k < K; k += 4) {
    float a = ap[k * sak];
#pragma unroll
    for (int t = 0; t < NTL; ++t) {
      float b = bp[k * sbk + t * 16 * sbn];
      acc[t] = __builtin_amdgcn_mfma_f32_16x16x4f32(a, b, acc[t], 0, 0, 0);
    }
  }
}

template <int NTL>
DEVI void mm16_gB64(f32x4 (&acc)[NTL], const float* A, int sam, const float* __restrict__ Bg) {
  const int l = TID() & 63, r = l & 15, q = l >> 4;
  float bv[16][NTL];
#pragma unroll
  for (int k = 0; k < 16; ++k)
#pragma unroll
    for (int t = 0; t < NTL; ++t) bv[k][t] = Bg[(4 * k + q) * 64 + t * 16 + r];
#pragma unroll
  for (int k = 0; k < 16; ++k) {
    const float a = A[r * sam + 4 * k + q];
#pragma unroll
    for (int t = 0; t < NTL; ++t) acc[t] = __builtin_amdgcn_mfma_f32_16x16x4f32(a, bv[k][t], acc[t], 0, 0, 0);
  }
}

template <int AMODE, int NK>
DEVI void gemm_tile(f32x4 (&acc)[4][4], const void* Aptr, int lda, const bf16_t* Bt, int ldb, int K, int m0, int n0,
                    const float* ssq, char* smem) {
  constexpr int LDT = 72, BUF = (256 + 128) * LDT;
  bf16_t* sbase = (bf16_t*)smem;
  const int tid = TID(), lane = tid & 63, wave = tid >> 6;
  const int wm = wave >> 1, wn = wave & 1, r = lane & 15, q = lane >> 4;
  const int lrow = tid >> 3, lkc = tid & 7;
  uint4 raS00, raS01, raS02, raS03, rbS00, rbS01, raS10, raS11, raS12, raS13, rbS10, rbS11, raS20, raS21, raS22, raS23, rbS20, rbS21;
  float rs0 = 1.f, rs1 = 1.f, rs2 = 1.f, rs3 = 1.f;
#pragma unroll
  for (int i = 0; i < 4; ++i)
#pragma unroll
    for (int j = 0; j < 4; ++j) acc[i][j] = f32x4{0.f, 0.f, 0.f, 0.f};
  const bf16_t* Ab = (const bf16_t*)Aptr + (size_t)(m0 + lrow) * lda + lkc * 8;
  const bf16_t* Bb = Bt + (size_t)(n0 + lrow) * ldb + lkc * 8;
#define GL(S, k0_)                                                    \
  {                                                                   \
    ra##S##0 = *(const uint4*)(Ab + (k0_));                           \
    ra##S##1 = *(const uint4*)(Ab + (size_t)64 * lda + (k0_));        \
    ra##S##2 = *(const uint4*)(Ab + (size_t)128 * lda + (k0_));       \
    ra##S##3 = *(const uint4*)(Ab + (size_t)192 * lda + (k0_));       \
    rb##S##0 = *(const uint4*)(Bb + (k0_));                           \
    rb##S##1 = *(const uint4*)(Bb + (size_t)64 * ldb + (k0_));        \
  }
  auto scale = [&](uint4 v, float s) {
    unsigned w[4] = {v.x, v.y, v.z, v.w};
#pragma unroll
    for (int j = 0; j < 4; ++j) {
      float lo = __uint_as_float(w[j] << 16) * s, hi = __uint_as_float(w[j] & 0xFFFF0000u) * s;
      w[j] = pack2(lo, hi);
    }
    return uint4{w[0], w[1], w[2], w[3]};
  };
  auto rowscale = [&](int row, int k0) {
    const float* sp = ssq + (size_t)(m0 + row) * 16;
    int seg = k0 >> 8;
    float s = seg == 0 ? (sp[0] + sp[1] + sp[2] + sp[3]) : seg == 1 ? sp[4] : seg == 2 ? sp[5] : (sp[8] + sp[9] + sp[10] + sp[11]);
    return rsqrtf(s * (1.f / 256.f) + EPS);
  };
#define LS(S, k0_, bi_)                                                               \
  {                                                                                   \
    bf16_t* As_ = sbase + (bi_) * BUF; bf16_t* Bs_ = As_ + 256 * LDT;                 \
    if constexpr (AMODE == 1) {                                                       \
      if (((k0_) & 255) == 0) {                                                       \
        rs0 = rowscale(lrow, (k0_)); rs1 = rowscale(lrow + 64, (k0_));                \
        rs2 = rowscale(lrow + 128, (k0_)); rs3 = rowscale(lrow + 192, (k0_));         \
      }                                                                               \
      ra##S##0 = scale(ra##S##0, rs0); ra##S##1 = scale(ra##S##1, rs1);               \
      ra##S##2 = scale(ra##S##2, rs2); ra##S##3 = scale(ra##S##3, rs3);               \
    }                                                                                 \
    *(uint4*)&As_[(lrow) * LDT + lkc * 8] = ra##S##0;                                 \
    *(uint4*)&As_[(lrow + 64) * LDT + lkc * 8] = ra##S##1;                            \
    *(uint4*)&As_[(lrow + 128) * LDT + lkc * 8] = ra##S##2;                           \
    *(uint4*)&As_[(lrow + 192) * LDT + lkc * 8] = ra##S##3;                           \
    *(uint4*)&Bs_[(lrow) * LDT + lkc * 8] = rb##S##0;                                 \
    *(uint4*)&Bs_[(lrow + 64) * LDT + lkc * 8] = rb##S##1;                            \
  }
  auto compute = [&](int bi) {
    const bf16_t* As = sbase + bi * BUF; const bf16_t* Bs = As + 256 * LDT;
#pragma unroll
    for (int kk = 0; kk < 2; ++kk) {
      bf16x8 a[4], b[4];
#pragma unroll
      for (int i = 0; i < 4; ++i) a[i] = *(const bf16x8*)&As[(wm * 64 + i * 16 + r) * LDT + kk * 32 + q * 8];
#pragma unroll
      for (int j = 0; j < 4; ++j) b[j] = *(const bf16x8*)&Bs[(wn * 64 + j * 16 + r) * LDT + kk * 32 + q * 8];
#pragma unroll
      for (int i = 0; i < 4; ++i)
#pragma unroll
        for (int j = 0; j < 4; ++j)
          acc[i][j] = __builtin_amdgcn_mfma_f32_16x16x32_bf16(b[j], a[i], acc[i][j], 0, 0, 0);
    }
  };

  __syncthreads();
  if constexpr (NK == 16 && AMODE == 1) {
    GL(S0, 0)
    LS(S0, 0, 0)
    GL(S1, 64)
    __syncthreads();
#pragma unroll 1
    for (int kt = 0; kt < NK; kt += 2) {
      compute(0);
      LS(S1, ((kt + 1) << 6), 1)
      if (kt + 2 < NK) GL(S0, ((kt + 2) << 6))
      __syncthreads();
      compute(1);
      if (kt + 2 < NK) { LS(S0, ((kt + 2) << 6), 0) GL(S1, ((kt + 3) << 6)) }
      __syncthreads();
    }
  } else if constexpr (NK == 16) {
    GL(S0, 0) GL(S1, 64) GL(S2, 128)
    LS(S0, 0, 0)
    GL(S0, 192)
    __syncthreads();
    compute(0);
    LS(S1, 64, 1)
    GL(S1, 256)
    __syncthreads();
    compute(1);
    LS(S2, 128, 0)
    GL(S2, 320)
    __syncthreads();
    compute(0);
    LS(S0, 192, 1)
    GL(S0, 384)
    __syncthreads();
    compute(1);
    LS(S1, 256, 0)
    GL(S1, 448)
    __syncthreads();
    compute(0);
    LS(S2, 320, 1)
    GL(S2, 512)
    __syncthreads();
    compute(1);
    LS(S0, 384, 0)
    GL(S0, 576)
    __syncthreads();
    compute(0);
    LS(S1, 448, 1)
    GL(S1, 640)
    __syncthreads();
    compute(1);
    LS(S2, 512, 0)
    GL(S2, 704)
    __syncthreads();
    compute(0);
    LS(S0, 576, 1)
    GL(S0, 768)
    __syncthreads();
    compute(1);
    LS(S1, 640, 0)
    GL(S1, 832)
    __syncthreads();
    compute(0);
    LS(S2, 704, 1)
    GL(S2, 896)
    __syncthreads();
    compute(1);
    LS(S0, 768, 0)
    GL(S0, 960)
    __syncthreads();
    compute(0);
    LS(S1, 832, 1)
    __syncthreads();
    compute(1);
    LS(S2, 896, 0)
    __syncthreads();
    compute(0);
    LS(S0, 960, 1)
    __syncthreads();
    compute(1);
    __syncthreads();
  } else {
    GL(S0, 0) GL(S1, 64) GL(S2, 128)
    LS(S0, 0, 0)
    GL(S0, 192)
    __syncthreads();
    compute(0);
    LS(S1, 64, 1)
    __syncthreads();
    compute(1);
    LS(S2, 128, 0)
    __syncthreads();
    compute(0);
    LS(S0, 192, 1)
    __syncthreads();
    compute(1);
    __syncthreads();
  }
#undef GL
#undef LS
}
#define GEMM_EPI_COORDS                                                   \
  const int lane_ = TID() & 63, wave_ = TID() >> 6;           \
  const int erow0 = m0 + (wave_ >> 1) * 64 + (lane_ & 15);                \
  const int ecol0 = n0 + (wave_ & 1) * 64 + (lane_ >> 4) * 4;

DEVI void transpose_tile(const float* W, int ldw, int nvalid, bf16_t* Bt, int ldbt, int k0, int n0, char* smem) {
  float* t = (float*)smem;
  const int tid = TID();
  {
    int i = tid >> 4, j4 = tid & 15;
#pragma unroll
    for (int h2 = 0; h2 < 2; ++h2) {
      int kk = i + 32 * h2;
      int n = n0 + j4 * 4;
      float4 v = float4{0.f, 0.f, 0.f, 0.f};
      if (n < nvalid) v = *(const float4*)&W[(size_t)(k0 + kk) * ldw + n];
      t[(j4 * 4 + 0) * 65 + kk] = v.x; t[(j4 * 4 + 1) * 65 + kk] = v.y;
      t[(j4 * 4 + 2) * 65 + kk] = v.z; t[(j4 * 4 + 3) * 65 + kk] = v.w;
    }
  }
  __syncthreads();
  {
    int n = tid >> 3, k8 = tid & 7;
    const float* s = &t[n * 65 + k8 * 8];
    uint4 v;
    v.x = pack2(s[0], s[1]); v.y = pack2(s[2], s[3]); v.z = pack2(s[4], s[5]); v.w = pack2(s[6], s[7]);
    *(uint4*)&Bt[(size_t)(n0 + n) * ldbt + k0 + k8 * 8] = v;
  }
  __syncthreads();
}

DEVI void convert_tables(const Params& p, int l) {
  const int lane = TID() & 63, wave = TID() >> 6;
  const int nw = gridDim.x * 8, gw = blockIdx.x * 8 + wave;
  for (int r0 = gw; r0 < 2 * 16384; r0 += 4 * nw) {
    float4 va[4], vb[4], vc[4], vd[4];
#pragma unroll
    for (int k = 0; k < 4; ++k) {
      const int rr = r0 + k * nw;
      if (rr < 2 * 16384) {
        const int which = rr >> 14, row = rr & 16383;
        const float* s = (which ? p.peer_v : p.peer_u) + ((size_t)l * 16384 + row) * 1024 + lane * 16;
        va[k] = *(const float4*)s; vb[k] = *(const float4*)(s + 4); vc[k] = *(const float4*)(s + 8); vd[k] = *(const float4*)(s + 12);
      }
    }
#pragma unroll
    for (int k = 0; k < 4; ++k) {
      const int rr = r0 + k * nw;
      if (rr < 2 * 16384) {
        const int which = rr >> 14, row = rr & 16383;
        const float4 a = va[k], b = vb[k], c = vc[k], d = vd[k];
        float m = fmaxf(fmaxf(fmaxf(fabsf(a.x), fabsf(a.y)), fmaxf(fabsf(a.z), fabsf(a.w))),
                        fmaxf(fmaxf(fabsf(b.x), fabsf(b.y)), fmaxf(fabsf(b.z), fabsf(b.w))));
        m = fmaxf(m, fmaxf(fmaxf(fmaxf(fabsf(c.x), fabsf(c.y)), fmaxf(fabsf(c.z), fabsf(c.w))),
                           fmaxf(fmaxf(fabsf(d.x), fabsf(d.y)), fmaxf(fabsf(d.z), fabsf(d.w)))));
        m = fmaxf(m, __shfl_xor(m, 32)); m = fmaxf(m, __shfl_xor(m, 16)); m = fmaxf(m, __shfl_xor(m, 8));
        m = fmaxf(m, __shfl_xor(m, 4)); m = fmaxf(m, __shfl_xor(m, 2)); m = fmaxf(m, __shfl_xor(m, 1));
        const float sc = m > 0.f ? 256.f / m : 1.f;
        int w0 = 0, w1 = 0, w2 = 0, w3 = 0;
        w0 = __builtin_amdgcn_cvt_pk_fp8_f32(a.x * sc, a.y * sc, w0, false); w0 = __builtin_amdgcn_cvt_pk_fp8_f32(a.z * sc, a.w * sc, w0, true);
        w1 = __builtin_amdgcn_cvt_pk_fp8_f32(b.x * sc, b.y * sc, w1, false); w1 = __builtin_amdgcn_cvt_pk_fp8_f32(b.z * sc, b.w * sc, w1, true);
        w2 = __builtin_amdgcn_cvt_pk_fp8_f32(c.x * sc, c.y * sc, w2, false); w2 = __builtin_amdgcn_cvt_pk_fp8_f32(c.z * sc, c.w * sc, w2, true);
        w3 = __builtin_amdgcn_cvt_pk_fp8_f32(d.x * sc, d.y * sc, w3, false); w3 = __builtin_amdgcn_cvt_pk_fp8_f32(d.z * sc, d.w * sc, w3, true);
        *(uint4*)((which ? p.tabV : p.tabU) + (size_t)row * 1024 + lane * 16) = uint4{(unsigned)w0, (unsigned)w1, (unsigned)w2, (unsigned)w3};
        if (lane == 0) (which ? p.vinv : p.uinv)[row] = m > 0.f ? m * (1.f / 256.f) : 1.f;
      }
    }
  }
}

DEVI void ph_prep(const Params& p, char* smem) {
  const size_t gtid = (size_t)blockIdx.x * NT + TID(), gsz = (size_t)gridDim.x * NT;
  for (size_t i = gtid; i < (size_t)S_ * 32; i += gsz) {
    int t = (int)(i >> 5), f = (int)(i & 31);
    float inv = powf(10000.f, -(float)f / 32.f);
    float ang = (float)p.pos[t] * inv;
    p.rope[2 * i] = cosf(ang); p.rope[2 * i + 1] = sinf(ang);
  }
  for (int it = blockIdx.x; it < 2 * 1600; it += gridDim.x) {
    int l = it / 1600, idx = it % 1600;
    if (idx >= 1568) {
      int j = idx - 1568; int kt = j >> 3, nt = j & 7;
      transpose_tile(p.s5_glu_w + (size_t)l * 256 * 512, 512, 512, p.gluT + (size_t)l * 512 * 256, 256, kt * 64, nt * 64, smem);
    } else if (idx < 736) {
      int kt = idx / 46, nt = idx % 46;
      transpose_tile(p.w_in + (size_t)l * 1024 * INW, INW, INW, p.winT + (size_t)l * PW * 1024, 1024, kt * 64, nt * 64, smem);
    } else if (idx < 1504) {
      int j = idx - 736; int which = j >> 8; j &= 255;
      int kt = j >> 4, nt = j & 15;
      const float* src = (which == 0 ? p.w_out : which == 1 ? p.peer_wq : p.ple_wg) + (size_t)l * 1024 * 1024;
      bf16_t* dst = (which == 0 ? p.woutT : which == 1 ? p.wqT : p.wgT) + (size_t)l * 1024 * 1024;
      transpose_tile(src, 1024, 1024, dst, 1024, kt * 64, nt * 64, smem);
    } else {
      int j = idx - 1504; int kt = j >> 4, nt = j & 15;
      transpose_tile(p.ple_wp + (size_t)l * 256 * 1024, 1024, 1024, p.wpT + (size_t)l * 1024 * 256, 256, kt * 64, nt * 64, smem);
    }
  }
}

DEVI void ph_norm(const float* src, const float* g, bf16_t* dst, float* fout) {
  const int lane = TID() & 63, wave = TID() >> 6;
  const int nw = gridDim.x * 8, gw = blockIdx.x * 8 + wave;
  float4 gg[4];
#pragma unroll
  for (int i = 0; i < 4; ++i) gg[i] = *(const float4*)&g[i * 256 + lane * 4];
  for (int t = gw; t < S_; t += 4 * nw) {
    float4 v[4][4];
#pragma unroll
    for (int rr = 0; rr < 4; ++rr) {
      const int tr = t + rr * nw;
      if (tr < S_) {
#pragma unroll
        for (int i = 0; i < 4; ++i) v[rr][i] = *(const float4*)&src[(size_t)tr * DM + i * 256 + lane * 4];
      }
    }
#pragma unroll
    for (int rr = 0; rr < 4; ++rr) {
      const int tr = t + rr * nw;
      if (tr < S_) {
        float ss = 0.f;
#pragma unroll
        for (int i = 0; i < 4; ++i) ss += v[rr][i].x * v[rr][i].x + v[rr][i].y * v[rr][i].y + v[rr][i].z * v[rr][i].z + v[rr][i].w * v[rr][i].w;
        ss = wave_sum(ss);
        const float rs = rsqrtf(ss * (1.f / DM) + EPS);
#pragma unroll
        for (int i = 0; i < 4; ++i) {
          float a = v[rr][i].x * rs * gg[i].x, b = v[rr][i].y * rs * gg[i].y, c = v[rr][i].z * rs * gg[i].z, d = v[rr][i].w * rs * gg[i].w;
          if (dst) *(uint2*)&dst[(size_t)tr * DM + i * 256 + lane * 4] = uint2{pack2(a, b), pack2(c, d)};
          else *(float4*)&fout[(size_t)tr * DM + i * 256 + lane * 4] = float4{a, b, c, d};
        }
      }
    }
  }
}

DEVI void gdn_prep(const Params& p, int l, int item, char* smem) {
  const int c = item >> 2, hd = item & 3, t0 = c * 64;
  float* sq = (float*)smem; float* sk = sq + 64 * 65; float* sv = sk + 64 * 65;
  float* sL = sv + 64 * 65;
  float* sgc = sL + 64 * 68; float* sbeta = sgc + 64;
  const int tid = TID(), lane = tid & 63, wave = tid >> 6, r = lane & 15, qd = lane >> 4;
  const float* cw = p.gdn_conv_w + (size_t)l * 4 * 768;
  {
    const int d = tid & 63, tw = tid >> 6;
#pragma unroll
    for (int which = 0; which < 3; ++which) {
      const int ch = which * 256 + hd * 64 + d;
      const float w0 = cw[ch], w1 = cw[768 + ch], w2 = cw[2 * 768 + ch], w3 = cw[3 * 768 + ch];
      const float* pc = p.proj + DQ + ch;
      float xv[11];
#pragma unroll
      for (int k = 0; k < 11; ++k) {
        const int tt = t0 + 8 * tw - 3 + k;
        const float v = pc[(size_t)(tt < 0 ? 0 : tt) * PW];
        xv[k] = tt < 0 ? 0.f : v;
      }
#pragma unroll
      for (int m = 0; m < 8; ++m) {
        float acc = 0.f;
        acc += w0 * xv[m]; acc += w1 * xv[m + 1]; acc += w2 * xv[m + 2]; acc += w3 * xv[m + 3];
        const float sv_ = siluf_(acc);
        if (which == 0) sq[(8 * tw + m) * 65 + d] = sv_;
        else if (which == 1) sk[(8 * tw + m) * 65 + d] = sv_;
        else sv[(8 * tw + m) * 65 + d] = sv_;
      }
    }
  }
  __syncthreads();
  {
    const int rw = tid >> 2, part = tid & 3, t = rw & 63;
    float* row = (rw < 64 ? sq : sk) + t * 65 + part * 16;
    float s = 0.f;
#pragma unroll
    for (int d = 0; d < 16; ++d) s += row[d] * row[d];
    s += __shfl_xor(s, 1); s += __shfl_xor(s, 2);
    float sc = rsqrtf(s + EPS) * (rw < 64 ? 0.125f : 1.f);
#pragma unroll
    for (int d = 0; d < 16; ++d) row[d] *= sc;
  }
  if (wave == 2) {
    int t = tid - 128;
    float bl = p.proj[(size_t)(t0 + t) * PW + DB + hd];
    float al = p.proj[(size_t)(t0 + t) * PW + DA + hd];
    float la = -expf(p.gdn_a_log[l * 4 + hd]) * softplusf_(al + p.gdn_dt_bias[l * 4 + hd]);
    for (int off = 1; off < 64; off <<= 1) { float n = __shfl_up(la, off); if (lane >= off) la += n; }
    sgc[t] = la; sbeta[t] = sigmoidf_(bl);
  }
  __syncthreads();
  {
    int mat = wave >> 2, mt = wave & 3;
    f32x4 acc[4];
#pragma unroll
    for (int t = 0; t < 4; ++t) acc[t] = f32x4{0.f, 0.f, 0.f, 0.f};
    mm16<4>(acc, (mat == 0 ? sk : sq) + mt * 16 * 65, 65, 1, sk, 1, 65, 64);
#pragma unroll
    for (int t = 0; t < 4; ++t)
#pragma unroll
      for (int e = 0; e < 4; ++e) {
        int i = mt * 16 + 4 * qd + e, j = t * 16 + r;
        float g = (i >= j) ? expf(sgc[i] - sgc[j]) : 0.f;
        if (mat == 0) sL[i * 68 + j] = (i > j) ? acc[t][e] * sbeta[i] * g : 0.f;
        else p.g_attn[((size_t)item * 64 + i) * 64 + j] = (i >= j) ? acc[t][e] * g : 0.f;
      }
  }
  __syncthreads();
  if (tid < 128) {
    const bool isv = tid < 64; const int d = tid & 63;
    float X[64];
#pragma unroll
    for (int i = 0; i < 64; ++i) X[i] = 0.f;
    float* dst = (isv ? p.g_u : p.g_w) + (size_t)item * 4096 + d;
#pragma unroll
    for (int i = 0; i < 64; ++i) {
      float bi = sbeta[i];
      float s = isv ? sv[i * 65 + d] * bi : sk[i * 65 + d] * bi * expf(sgc[i]);
      float s1 = 0.f, s2 = 0.f, s3 = 0.f;
#pragma unroll
      for (int j4 = 0; j4 < (i + 3) / 4; ++j4) {
        float4 lv = *(const float4*)&sL[i * 68 + j4 * 4];
        s -= lv.x * X[j4 * 4 + 0]; s1 -= lv.y * X[j4 * 4 + 1]; s2 -= lv.z * X[j4 * 4 + 2]; s3 -= lv.w * X[j4 * 4 + 3];
      }
      s = (s + s1) + (s2 + s3);
      X[i] = s;
      dst[i * 64] = s;
    }
  } else {
    for (int i2 = tid - 128; i2 < 8192; i2 += 384) {
      int which = i2 >> 12, i = (i2 >> 6) & 63, d = i2 & 63;
      float val = which == 0 ? sq[i * 65 + d] * expf(sgc[i]) : sk[i * 65 + d] * expf(sgc[63] - sgc[i]);
      (which == 0 ? p.g_qd : p.g_kd)[(size_t)item * 4096 + i * 64 + d] = val;
    }
    if (tid == 128) p.g_cdec[item] = expf(sgc[63]);
  }
  __syncthreads();
}

DEVI f32x4 mm16_k64(const float* A, int sam, int sak, const float* B, int sbk, int sbn) {
  const int l = TID() & 63, r = l & 15, q = l >> 4;
  const float* ap = A + r * sam + q * sak;
  const float* bp = B + q * sbk + r * sbn;
  float av[16], bv[16];
#pragma unroll
  for (int k = 0; k < 16; ++k) { av[k] = ap[4 * k * sak]; bv[k] = bp[4 * k * sbk]; }
  f32x4 c0 = f32x4{0.f, 0.f, 0.f, 0.f}, c1 = f32x4{0.f, 0.f, 0.f, 0.f};
#pragma unroll
  for (int k = 0; k < 16; k += 2) {
    c0 = __builtin_amdgcn_mfma_f32_16x16x4f32(av[k], bv[k], c0, 0, 0, 0);
    c1 = __builtin_amdgcn_mfma_f32_16x16x4f32(av[k + 1], bv[k + 1], c1, 0, 0, 0);
  }
  return c0 + c1;
}

template <int MODE>
DEVI void gdn_chain(const Params& p, int hd, int grp, int cb, char* smem) {
  float* base = (float*)smem;
  constexpr int BUFSZ = 64 * 68 * 2 + 64 * 16;
  float* sS = base + 2 * BUFSZ; float* sVN = sS + 1024;
  const int tid = TID(), lane = tid & 63, wave = tid >> 6, r = lane & 15, qd = lane >> 4;
  const bool apart = (MODE == 0) && (cb >= 4);
  const int e0 = (cb & 3) * 16;
  const int c0 = grp * 32;
  float4 pw0, pw1, pkd0, pkd1, pu = float4{0.f, 0.f, 0.f, 0.f};
  const int lr0 = tid >> 4, lc0 = (tid & 15) * 4, lr1 = lr0 + 32;
  const int ur = tid >> 2, uc = (tid & 3) * 4;
#define GLOAD(c_)                                                            \
  {                                                                          \
    size_t b_ = (size_t)((c_) * 4 + hd) * 4096;                              \
    pw0 = *(const float4*)&p.g_w[b_ + lr0 * 64 + lc0];                       \
    pw1 = *(const float4*)&p.g_w[b_ + lr1 * 64 + lc0];                       \
    pkd0 = *(const float4*)&p.g_kd[b_ + lr0 * 64 + lc0];                     \
    pkd1 = *(const float4*)&p.g_kd[b_ + lr1 * 64 + lc0];                     \
    if (tid < 256 && !apart) pu = *(const float4*)&p.g_u[b_ + ur * 64 + e0 + uc]; \
  }
#define LSTORE(bi_)                                                          \
  {                                                                          \
    float* W_ = base + (bi_) * BUFSZ; float* KD_ = W_ + 64 * 68; float* U_ = KD_ + 64 * 68; \
    *(float4*)&W_[lr0 * 68 + lc0] = pw0; *(float4*)&W_[lr1 * 68 + lc0] = pw1;       \
    *(float4*)&KD_[lr0 * 68 + lc0] = pkd0; *(float4*)&KD_[lr1 * 68 + lc0] = pkd1;   \
    if (tid < 256) *(float4*)&U_[ur * 16 + uc] = pu;                         \
  }
  f32x4 sreg = f32x4{0.f, 0.f, 0.f, 0.f};
  if (MODE == 0) {
    for (int i = tid; i < 1024; i += NT) sS[i] = (apart && ((i >> 4) == e0 + (i & 15))) ? 1.f : 0.f;
    if (apart) {
#pragma unroll
      for (int e = 0; e < 4; ++e) sreg[e] = ((wave & 3) * 16 + 4 * qd + e == e0 + r) ? 1.f : 0.f;
    }
  } else {
    for (int i = tid; i < 1024; i += NT) sS[i] = 0.f;
    float* W = base;
    for (int g2 = 0; g2 < grp; ++g2) {
      const float* Ag = p.g_comp + ((size_t)(hd * 8 + g2) * 2 + 1) * 4096;
      const float* Bg = p.g_comp + ((size_t)(hd * 8 + g2) * 2 + 0) * 4096;
      __syncthreads();
      *(float4*)&W[lr0 * 68 + lc0] = *(const float4*)&Ag[lr0 * 64 + lc0];
      *(float4*)&W[lr1 * 68 + lc0] = *(const float4*)&Ag[lr1 * 64 + lc0];
      __syncthreads();
      f32x4 a = f32x4{0.f, 0.f, 0.f, 0.f};
      if (wave < 4) a = mm16_k64(W + wave * 16 * 68, 68, 1, sS, 16, 1);
      __syncthreads();
      if (wave < 4) {
#pragma unroll
        for (int e = 0; e < 4; ++e) {
          int d = wave * 16 + 4 * qd + e;
          sreg[e] = a[e] + Bg[d * 64 + e0 + r];
          sS[d * 16 + r] = sreg[e];
        }
      }
    }
    __syncthreads();
    if (wave < 4) {
#pragma unroll
      for (int e = 0; e < 4; ++e) {
        int d = wave * 16 + 4 * qd + e;
        p.g_sst[(size_t)(c0 * 4 + hd) * 4096 + d * 64 + e0 + r] = sreg[e];
      }
    }
  }
  GLOAD(c0) LSTORE(0)
  __syncthreads();
  for (int cc = 0; cc < 32; ++cc) {
    const int c = c0 + cc;
    if (cc + 1 < 32) GLOAD(c + 1)
    const float cd = p.g_cdec[c * 4 + hd];
    float* W = base + (cc & 1) * BUFSZ; float* KD = W + 64 * 68; float* U = KD + 64 * 68;
    const size_t it = (size_t)(c * 4 + hd);
    if (wave < 4) {
      f32x4 a1 = mm16_k64(W + wave * 16 * 68, 68, 1, sS, 16, 1);
#pragma unroll
      for (int e = 0; e < 4; ++e) {
        int i = wave * 16 + 4 * qd + e;
        float vn = (apart ? 0.f : U[i * 16 + r]) - a1[e];
        sVN[i * 16 + r] = vn;
        if (MODE == 1) p.g_u[it * 4096 + i * 64 + e0 + r] = vn;
      }
    }
    __syncthreads();
    if (wave < 4) {
      f32x4 a2 = mm16_k64(KD + wave * 16, 1, 68, sVN, 16, 1);
#pragma unroll
      for (int e = 0; e < 4; ++e) {
        int d = wave * 16 + 4 * qd + e;
        sreg[e] = sreg[e] * cd + a2[e];
        sS[d * 16 + r] = sreg[e];
        if (MODE == 1 && cc + 1 < 32) p.g_sst[(size_t)((c + 1) * 4 + hd) * 4096 + d * 64 + e0 + r] = sreg[e];
      }
    }
    if (cc + 1 < 32) LSTORE((cc + 1) & 1)
    __syncthreads();
  }
  if (MODE == 0 && wave < 4) {
    float* dst = p.g_comp + ((size_t)(hd * 8 + grp) * 2 + (apart ? 1 : 0)) * 4096;
#pragma unroll
    for (int e = 0; e < 4; ++e) {
      int d = wave * 16 + 4 * qd + e;
      dst[d * 64 + e0 + r] = sreg[e];
    }
  }
  __syncthreads();
}

DEVI void gdn_out(const Params& p, int l, int item, char* smem) {
  const int c = item >> 2, hd = item & 3, t0 = c * 64;
  float* sQD = (float*)smem; float* sS = sQD + 64 * 68; float* sAT = sS + 64 * 68; float* sVN = sAT + 64 * 68;
  const int tid = TID(), lane = tid & 63, wave = tid >> 6, r = lane & 15, qd = lane >> 4;
  const size_t b = (size_t)item * 4096;
#pragma unroll
  for (int idx = tid; idx < 1024; idx += NT) {
    int row = idx >> 4, c4 = idx & 15;
    *(float4*)&sQD[row * 68 + c4 * 4] = *(const float4*)&p.g_qd[b + row * 64 + c4 * 4];
    *(float4*)&sS[row * 68 + c4 * 4] = *(const float4*)&p.g_sst[b + row * 64 + c4 * 4];
    *(float4*)&sAT[row * 68 + c4 * 4] = *(const float4*)&p.g_attn[b + row * 64 + c4 * 4];
    *(float4*)&sVN[row * 68 + c4 * 4] = *(const float4*)&p.g_u[b + row * 64 + c4 * 4];
  }
  __syncthreads();
  const int mt = wave & 3, nh = wave >> 2;
  f32x4 acc[2]; acc[0] = acc[1] = f32x4{0.f, 0.f, 0.f, 0.f};
  mm16<2>(acc, sQD + mt * 16 * 68, 68, 1, sS + nh * 32, 68, 1, 64);
  mm16<2>(acc, sAT + mt * 16 * 68, 68, 1, sVN + nh * 32, 68, 1, 64);
  __syncthreads();
  float* sO = sQD;
#pragma unroll
  for (int t2 = 0; t2 < 2; ++t2)
#pragma unroll
    for (int e = 0; e < 4; ++e) sO[(mt * 16 + 4 * qd + e) * 68 + nh * 32 + t2 * 16 + r] = acc[t2][e];
  __syncthreads();
  {
    int row = tid >> 3, sub = tid & 7, t = t0 + row;
    float o[8], yv[8]; float ss = 0.f;
#pragma unroll
    for (int k = 0; k < 8; ++k) { o[k] = sO[row * 68 + sub * 8 + k]; ss += o[k] * o[k]; }
    ss += __shfl_xor(ss, 1); ss += __shfl_xor(ss, 2); ss += __shfl_xor(ss, 4);
    float rs = rsqrtf(ss * (1.f / 64.f) + EPS);
    float s2 = 0.f;
#pragma unroll
    for (int k = 0; k < 8; ++k) {
      int col = sub * 8 + k;
      float g = p.proj[(size_t)t * PW + DG + hd * 64 + col];
      float y = o[k] * rs * p.gdn_norm[l * 64 + col] * siluf_(g);
      s2 += y * y;
      yv[k] = y * p.branch_norm[(l * 4 + 3) * 256 + hd * 64 + col];
    }
    s2 += __shfl_xor(s2, 1); s2 += __shfl_xor(s2, 2); s2 += __shfl_xor(s2, 4);
    if (sub == 0) p.ssq[(size_t)t * 16 + 8 + hd] = s2;
    *(uint4*)&p.zb[(size_t)t * DM + 768 + hd * 64 + sub * 8] =
        uint4{pack2(yv[0], yv[1]), pack2(yv[2], yv[3]), pack2(yv[4], yv[5]), pack2(yv[6], yv[7])};
  }
  __syncthreads();
}

DEVI void ret_kv(const Params& p, int l, int item, char* smem) {
  const int c = item >> 2, hd = item & 3, t0 = c * 128;
  float* sK = (float*)smem; float* sV = sK + 128 * 65;
  const int tid = TID(), lane = tid & 63, wave = tid >> 6, r = lane & 15, qd = lane >> 4;
  const float lg = logf(1.f - exp2f(-5.f - (float)hd));
#pragma unroll
  for (int i = tid; i < 128 * 32; i += NT) {
    int t = i >> 5, f = i & 31; size_t tt = t0 + t;
    float k1 = p.proj[tt * PW + RK + hd * 64 + f], k2 = p.proj[tt * PW + RK + hd * 64 + 32 + f];
    float cs = p.rope[(tt * 32 + f) * 2], sn = p.rope[(tt * 32 + f) * 2 + 1];
    float dec = expf(lg * (float)(127 - t));
    sK[t * 65 + f] = (k1 * cs - k2 * sn) * dec;
    sK[t * 65 + 32 + f] = (k2 * cs + k1 * sn) * dec;
  }
#pragma unroll
  for (int i = tid; i < 128 * 64; i += NT) {
    int t = i >> 6, e = i & 63;
    sV[t * 65 + e] = p.proj[(size_t)(t0 + t) * PW + RV + hd * 64 + e];
  }
  __syncthreads();
  const int mt = wave & 3, nh = wave >> 2;
  f32x4 acc[2]; acc[0] = acc[1] = f32x4{0.f, 0.f, 0.f, 0.f};
  mm16<2>(acc, sK + mt * 16, 1, 65, sV + nh * 32, 65, 1, 128);
#pragma unroll
  for (int t2 = 0; t2 < 2; ++t2)
#pragma unroll
    for (int e = 0; e < 4; ++e)
      p.ret_kv[(size_t)item * 4096 + (mt * 16 + 4 * qd + e) * 64 + nh * 32 + t2 * 16 + r] = acc[t2][e];
  __syncthreads();
}

DEVI void ret_out(const Params& p, int l, int item, char* smem) {
  const int c = item >> 2, hd = item & 3, t0 = c * 128;
  float* sQ = (float*)smem; float* sK = sQ + 128 * 65; float* sV = sK + 128 * 65; float* sSt = sV + 128 * 65;
  const int tid = TID(), lane = tid & 63, wave = tid >> 6, r = lane & 15, qd = lane >> 4;
  const float lg = logf(1.f - exp2f(-5.f - (float)hd));
  {
    const float* ssrc = p.ret_kv + (size_t)(c * 4 + hd) * 4096;
#pragma unroll
    for (int j = 0; j < 8; ++j) { int idx = tid + 512 * j; sSt[(idx >> 6) * 65 + (idx & 63)] = ssrc[idx]; }
  }
#pragma unroll
  for (int i = tid; i < 128 * 32; i += NT) {
    int t = i >> 5, f = i & 31; size_t tt = t0 + t;
    float cs = p.rope[(tt * 32 + f) * 2], sn = p.rope[(tt * 32 + f) * 2 + 1];
    float k1 = p.proj[tt * PW + RK + hd * 64 + f], k2 = p.proj[tt * PW + RK + hd * 64 + 32 + f];
    sK[t * 65 + f] = (k1 * cs - k2 * sn);
    sK[t * 65 + 32 + f] = (k2 * cs + k1 * sn);
    float q1 = p.proj[tt * PW + RQ + hd * 64 + f], q2 = p.proj[tt * PW + RQ + hd * 64 + 32 + f];
    sQ[t * 65 + f] = (q1 * cs - q2 * sn) * 0.125f;
    sQ[t * 65 + 32 + f] = (q2 * cs + q1 * sn) * 0.125f;
  }
#pragma unroll
  for (int i = tid; i < 128 * 64; i += NT) {
    int t = i >> 6, e = i & 63;
    sV[t * 65 + e] = p.proj[(size_t)(t0 + t) * PW + RV + hd * 64 + e];
  }
  __syncthreads();
  const int i0 = wave * 16;
  f32x4 sc[8], os[4];
#pragma unroll
  for (int t = 0; t < 8; ++t) sc[t] = f32x4{0.f, 0.f, 0.f, 0.f};
#pragma unroll
  for (int t = 0; t < 4; ++t) os[t] = f32x4{0.f, 0.f, 0.f, 0.f};
  mm16<8>(sc, sQ + i0 * 65, 65, 1, sK, 1, 65, 64);
  mm16<4>(os, sQ + i0 * 65, 65, 1, sSt, 65, 1, 64);
  __syncthreads();
  float* sP = (float*)smem;
#pragma unroll
  for (int t2 = 0; t2 < 8; ++t2)
#pragma unroll
    for (int e = 0; e < 4; ++e) {
      int i = i0 + 4 * qd + e, j = t2 * 16 + r;
      sP[i * 129 + j] = (i >= j) ? sc[t2][e] * expf(lg * (float)(i - j)) : 0.f;
    }
  __syncthreads();
  f32x4 o[4];
#pragma unroll
  for (int t2 = 0; t2 < 4; ++t2)
#pragma unroll
    for (int e = 0; e < 4; ++e) o[t2][e] = os[t2][e] * expf(lg * (float)(i0 + 4 * qd + e + 1));
  mm16<4>(o, sP + i0 * 129, 129, 1, sV, 65, 1, 128);
#pragma unroll
  for (int e = 0; e < 4; ++e) {
    int i = i0 + 4 * qd + e; size_t t = t0 + i;
    float sm = sum16(o[0][e] + o[1][e] + o[2][e] + o[3][e]);
    float mu = sm * (1.f / 64.f);
    float vr = 0.f;
#pragma unroll
    for (int t2 = 0; t2 < 4; ++t2) { float dd = o[t2][e] - mu; vr += dd * dd; }
    vr = sum16(vr);
    float rstd = rsqrtf(vr * (1.f / 64.f) + EPS);
    float ss = 0.f;
#pragma unroll
    for (int t2 = 0; t2 < 4; ++t2) {
      int col = hd * 64 + t2 * 16 + r;
      float on = (o[t2][e] - mu) * rstd * p.ret_gn[l * 256 + col];
      float g = p.proj[t * PW + RG + col];
      float y = siluf_(g) * on;
      ss += y * y;
      p.zb[t * DM + col] = f2bf(y * p.branch_norm[(l * 4 + 0) * 256 + col]);
    }
    ss = sum16(ss);
    if (r == 0) p.ssq[t * 16 + hd] = ss;
  }
  __syncthreads();
}

DEVI void lru_local(const Params& p, int l, int c, char* smem) {
  const int t0 = c * 64;
  float* sX = (float*)smem; float* sA = sX + 64 * 257;
  const int tid = TID(), lane = tid & 63, wave = tid >> 6, r = lane & 15, qd = lane >> 4;
  {
    const int ch = tid & 255, half = tid >> 8;
    const float w0 = p.lru_conv_w[(l * 4 + 0) * 256 + ch], w1 = p.lru_conv_w[(l * 4 + 1) * 256 + ch];
    const float w2 = p.lru_conv_w[(l * 4 + 2) * 256 + ch], w3 = p.lru_conv_w[(l * 4 + 3) * 256 + ch];
    const float cb = p.lru_conv_b[l * 256 + ch];
    const float* pc = p.proj + LX + ch;
    float xv[35];
#pragma unroll
    for (int k = 0; k < 35; ++k) {
      const int tt = t0 + 32 * half - 3 + k;
      const float v = pc[(size_t)(tt < 0 ? 0 : tt) * PW];
      xv[k] = tt < 0 ? 0.f : v;
    }
#pragma unroll
    for (int m = 0; m < 32; ++m) {
      float acc = cb;
      acc += w0 * xv[m]; acc += w1 * xv[m + 1]; acc += w2 * xv[m + 2]; acc += w3 * xv[m + 3];
      sX[(32 * half + m) * 257 + ch] = acc;
    }
  }
  __syncthreads();
  for (int pr = 0; pr < 2; ++pr) {
    int pi = wave * 2 + pr, mt = pi & 3, nb = pi >> 2;
    f32x4 ra[4], ri[4];
#pragma unroll
    for (int t = 0; t < 4; ++t) { ra[t] = f32x4{0.f, 0.f, 0.f, 0.f}; ri[t] = f32x4{0.f, 0.f, 0.f, 0.f}; }
    mm16_gB64<4>(ra, sX + mt * 16 * 257 + nb * 64, 257, p.lru_w_a + (size_t)(l * 4 + nb) * 4096);
    mm16_gB64<4>(ri, sX + mt * 16 * 257 + nb * 64, 257, p.lru_w_x + (size_t)(l * 4 + nb) * 4096);
#pragma unroll
    for (int t2 = 0; t2 < 4; ++t2)
#pragma unroll
      for (int e = 0; e < 4; ++e) {
        int t = mt * 16 + 4 * qd + e, ch = nb * 64 + t2 * 16 + r;
        float xb = sX[t * 257 + ch];
        float rr = sigmoidf_(ra[t2][e] + p.lru_b_a[l * 256 + ch]);
        float ii = sigmoidf_(ri[t2][e] + p.lru_b_x[l * 256 + ch]);
        float loga = -8.f * rr * softplusf_(-p.lru_lambda[l * 256 + ch]);
        float a = expf(loga);
        float bb = sqrtf(-expm1f(2.f * loga)) * (ii * xb);
        sA[t * 257 + ch] = a; sX[t * 257 + ch] = bb;
      }
  }
  __syncthreads();
  if (tid < 256) {
    int ch = tid; float H = 0.f, P = 1.f;
    for (int t = 0; t < 64; ++t) {
      float a = sA[t * 257 + ch], bb = sX[t * 257 + ch];
      H = a * H + bb; P *= a;
      p.lru_h[(size_t)(t0 + t) * 256 + ch] = H; p.lru_p[(size_t)(t0 + t) * 256 + ch] = P;
    }
    p.lru_hs[c * 256 + ch] = H; p.lru_ps[c * 256 + ch] = P;
  }
  __syncthreads();
}

DEVI void lru_out(const Params& p, int l, int c, char* smem) {
  const int t0 = c * 64;
  float* sC = (float*)smem;
  const int tid = TID(), lane = tid & 63, wave = tid >> 6;
  if (tid < 256) sC[tid] = p.lru_hs[c * 256 + tid];
  __syncthreads();
  {
    const int ch = lane * 4;
    float4 Hs[8], Ps[8], gs[8];
#pragma unroll
    for (int tk = 0; tk < 8; ++tk) {
      const size_t t = t0 + wave * 8 + tk;
      Hs[tk] = *(const float4*)&p.lru_h[t * 256 + ch]; Ps[tk] = *(const float4*)&p.lru_p[t * 256 + ch];
      gs[tk] = *(const float4*)&p.proj[t * PW + LG + ch];
    }
    const float4 cr = *(const float4*)&sC[ch];
    const float4 bn = *(const float4*)&p.branch_norm[(l * 4 + 1) * 256 + ch];
#pragma unroll
    for (int tk = 0; tk < 8; ++tk) {
      const size_t t = t0 + wave * 8 + tk;
      const float4 H = Hs[tk], P = Ps[tk], g = gs[tk];
      float y0 = geluf_(g.x) * (H.x + P.x * cr.x), y1 = geluf_(g.y) * (H.y + P.y * cr.y);
      float y2 = geluf_(g.z) * (H.z + P.z * cr.z), y3 = geluf_(g.w) * (H.w + P.w * cr.w);
      float ss = wave_sum(y0 * y0 + y1 * y1 + y2 * y2 + y3 * y3);
      if (lane == 0) p.ssq[t * 16 + 4] = ss;
      *(uint2*)&p.zb[t * DM + 256 + ch] = uint2{pack2(y0 * bn.x, y1 * bn.y), pack2(y2 * bn.z, y3 * bn.w)};
    }
  }
  __syncthreads();
}

DEVI void s5_coef(const Params& p, int l, int g, int n, float& abr, float& abi, float (&bbr)[16], float (&bbi)[16]) {
  float dt = expf(p.s5_log_dt[l * 16 + g]);
  float are = p.s5_a_re[(l * 16 + g) * 64 + n], aim = p.s5_a_im[(l * 16 + g) * 64 + n];
  float mag = expf(are * dt), ang = aim * dt;
  abr = mag * cosf(ang); abi = mag * sinf(ang);
  float den = are * are + aim * aim;
  float pre = abr - 1.f, pim = abi;
  float fre = (pre * are + pim * aim) / den, fim = (pim * are - pre * aim) / den;
  const float4* br = (const float4*)(p.s5_b_re + (size_t)((l * 16 + g) * 64 + n) * 16);
  const float4* bi = (const float4*)(p.s5_b_im + (size_t)((l * 16 + g) * 64 + n) * 16);
#pragma unroll
  for (int c4 = 0; c4 < 4; ++c4) {
    float4 a = br[c4], b = bi[c4];
    bbr[c4 * 4 + 0] = fre * a.x - fim * b.x; bbi[c4 * 4 + 0] = fre * b.x + fim * a.x;
    bbr[c4 * 4 + 1] = fre * a.y - fim * b.y; bbi[c4 * 4 + 1] = fre * b.y + fim * a.y;
    bbr[c4 * 4 + 2] = fre * a.z - fim * b.z; bbi[c4 * 4 + 2] = fre * b.z + fim * a.z;
    bbr[c4 * 4 + 3] = fre * a.w - fim * b.w; bbi[c4 * 4 + 3] = fre * b.w + fim * a.w;
  }
}
DEVI void s5_load_u(const Params& p, int t0, float* sU) {
#pragma unroll
  for (int i = TID(); i < 64 * 64; i += NT) {
    int t = i >> 6, c4 = i & 63;
    *(float4*)&sU[t * 256 + c4 * 4] = *(const float4*)&p.proj[(size_t)(t0 + t) * PW + SU + c4 * 4];
  }
}
DEVI void s5_bu(const float* up, const float (&bbr)[16], const float (&bbi)[16], float& bur, float& bui) {
  bur = 0.f; bui = 0.f;
#pragma unroll
  for (int c4 = 0; c4 < 4; ++c4) {
    float4 u = *(const float4*)&up[c4 * 4];
    bur += bbr[c4 * 4] * u.x + bbr[c4 * 4 + 1] * u.y + bbr[c4 * 4 + 2] * u.z + bbr[c4 * 4 + 3] * u.w;
    bui += bbi[c4 * 4] * u.x + bbi[c4 * 4 + 1] * u.y + bbi[c4 * 4 + 2] * u.z + bbi[c4 * 4 + 3] * u.w;
  }
}

DEVI void s5_local(const Params& p, int l, int c, char* smem) {
  const int t0 = c * 64;
  float* sU = (float*)smem;
  const int lane = TID() & 63, wave = TID() >> 6;
  s5_load_u(p, t0, sU);
  __syncthreads();
  for (int gi = 0; gi < 2; ++gi) {
    int g = wave + 8 * gi;
    float abr, abi, bbr[16], bbi[16];
    s5_coef(p, l, g, lane, abr, abi, bbr, bbi);
    float xr = 0.f, xi = 0.f;
    for (int t = 0; t < 64; ++t) {
      float bur, bui; s5_bu(sU + t * 256 + g * 16, bbr, bbi, bur, bui);
      float nr = abr * xr - abi * xi + bur, ni = abr * xi + abi * xr + bui;
      xr = nr; xi = ni;
    }
    *(float2*)&p.xloc[((size_t)(c * 16 + g) * 64 + lane) * 2] = float2{xr, xi};
  }
  __syncthreads();
}

DEVI void s5_out(const Params& p, int l, int c, char* smem) {
  const int t0 = c * 64;
  bf16_t* sY = (bf16_t*)smem;
  float* sX = (float*)(smem + 64 * 264 * 2);
  const int tid = TID(), lane = tid & 63, wave = tid >> 6, r = lane & 15, qd = lane >> 4;
  float* Xl = sX + wave * (16 * 132);
  for (int gi = 0; gi < 2; ++gi) {
    const int g = wave + 8 * gi;
    float abr, abi, bbr[16], bbi[16];
    s5_coef(p, l, g, lane, abr, abi, bbr, bbi);
    float breg[32];
#pragma unroll
    for (int ks = 0; ks < 16; ++ks) {
      breg[ks] = p.s5_c_re[(size_t)((l * 16 + g) * 16 + r) * 64 + 4 * ks + qd];
      breg[16 + ks] = -p.s5_c_im[(size_t)((l * 16 + g) * 16 + r) * 64 + 4 * ks + qd];
    }
    const float dd = p.s5_d[l * 256 + g * 16 + r];
    const float2 xin = *(const float2*)&p.xloc[((size_t)(c * 16 + g) * 64 + lane) * 2];
    float xr = xin.x, xi = xin.y;
    float4 uvecs[4]; float ues[4][4];
#pragma unroll
    for (int tb = 0; tb < 4; ++tb) {
      const float* ub = p.proj + (size_t)(t0 + tb * 16) * PW + SU + g * 16;
      uvecs[tb] = *(const float4*)&ub[(size_t)r * PW + 4 * qd];
#pragma unroll
      for (int e = 0; e < 4; ++e) ues[tb][e] = ub[(size_t)(4 * qd + e) * PW + r];
    }
#pragma unroll
    for (int tb = 0; tb < 4; ++tb) {
      const float4 uvec = uvecs[tb];
      float ue[4];
#pragma unroll
      for (int e = 0; e < 4; ++e) ue[e] = ues[tb][e];
      const int u0 = __float_as_int(uvec.x), u1 = __float_as_int(uvec.y), u2 = __float_as_int(uvec.z), u3 = __float_as_int(uvec.w);
#pragma unroll
      for (int tt = 0; tt < 16; ++tt) {
        float bur = 0.f, bui = 0.f;
#pragma unroll
        for (int c4 = 0; c4 < 4; ++c4) {
          float a0 = __int_as_float(__builtin_amdgcn_readlane(u0, tt + 16 * c4));
          float a1 = __int_as_float(__builtin_amdgcn_readlane(u1, tt + 16 * c4));
          float a2 = __int_as_float(__builtin_amdgcn_readlane(u2, tt + 16 * c4));
          float a3 = __int_as_float(__builtin_amdgcn_readlane(u3, tt + 16 * c4));
          bur += bbr[c4 * 4] * a0 + bbr[c4 * 4 + 1] * a1 + bbr[c4 * 4 + 2] * a2 + bbr[c4 * 4 + 3] * a3;
          bui += bbi[c4 * 4] * a0 + bbi[c4 * 4 + 1] * a1 + bbi[c4 * 4 + 2] * a2 + bbi[c4 * 4 + 3] * a3;
        }
        float nr = abr * xr - abi * xi + bur, ni = abr * xi + abi * xr + bui;
        xr = nr; xi = ni;
        Xl[tt * 132 + lane] = xr; Xl[tt * 132 + 64 + lane] = xi;
      }
      f32x4 acc = f32x4{0.f, 0.f, 0.f, 0.f};
#pragma unroll
      for (int ks = 0; ks < 32; ++ks) {
        float a = Xl[r * 132 + 4 * ks + qd];
        acc = __builtin_amdgcn_mfma_f32_16x16x4f32(a, breg[ks], acc, 0, 0, 0);
      }
#pragma unroll
      for (int e = 0; e < 4; ++e) {
        float y = acc[e] + dd * ue[e];
        sY[(tb * 16 + 4 * qd + e) * 264 + g * 16 + r] = f2bf(geluf_(y));
      }
    }
  }
  __syncthreads();
  f32x4 av[4][2], ag[4][2];
#pragma unroll
  for (int i = 0; i < 4; ++i)
#pragma unroll
    for (int j = 0; j < 2; ++j) { av[i][j] = f32x4{0.f, 0.f, 0.f, 0.f}; ag[i][j] = f32x4{0.f, 0.f, 0.f, 0.f}; }
  const bf16_t* WT = p.gluT + (size_t)l * 512 * 256;
#pragma unroll 4
  for (int ks = 0; ks < 8; ++ks) {
    bf16x8 bv0 = *(const bf16x8*)&WT[(size_t)(32 * wave + r) * 256 + ks * 32 + qd * 8];
    bf16x8 bv1 = *(const bf16x8*)&WT[(size_t)(32 * wave + 16 + r) * 256 + ks * 32 + qd * 8];
    bf16x8 bg0 = *(const bf16x8*)&WT[(size_t)(256 + 32 * wave + r) * 256 + ks * 32 + qd * 8];
    bf16x8 bg1 = *(const bf16x8*)&WT[(size_t)(256 + 32 * wave + 16 + r) * 256 + ks * 32 + qd * 8];
#pragma unroll
    for (int mt = 0; mt < 4; ++mt) {
      bf16x8 a = *(const bf16x8*)&sY[(mt * 16 + r) * 264 + ks * 32 + qd * 8];
      av[mt][0] = __builtin_amdgcn_mfma_f32_16x16x32_bf16(a, bv0, av[mt][0], 0, 0, 0);
      av[mt][1] = __builtin_amdgcn_mfma_f32_16x16x32_bf16(a, bv1, av[mt][1], 0, 0, 0);
      ag[mt][0] = __builtin_amdgcn_mfma_f32_16x16x32_bf16(a, bg0, ag[mt][0], 0, 0, 0);
      ag[mt][1] = __builtin_amdgcn_mfma_f32_16x16x32_bf16(a, bg1, ag[mt][1], 0, 0, 0);
    }
  }
  float* sO = sX;
#pragma unroll
  for (int mt = 0; mt < 4; ++mt)
#pragma unroll
    for (int t2 = 0; t2 < 2; ++t2)
#pragma unroll
      for (int e = 0; e < 4; ++e) {
        int t = mt * 16 + 4 * qd + e, col = 32 * wave + t2 * 16 + r;
        float zv = av[mt][t2][e] + p.s5_glu_b[l * 512 + col];
        float zg = ag[mt][t2][e] + p.s5_glu_b[l * 512 + 256 + col];
        sO[t * 256 + col] = zv * sigmoidf_(zg);
      }
  __syncthreads();
  for (int tk = 0; tk < 8; ++tk) {
    int tl = wave * 8 + tk; size_t t = t0 + tl; int ch = lane * 4;
    float4 o = *(const float4*)&sO[tl * 256 + ch];
    float4 bn = *(const float4*)&p.branch_norm[(l * 4 + 2) * 256 + ch];
    float ss = wave_sum(o.x * o.x + o.y * o.y + o.z * o.z + o.w * o.w);
    if (lane == 0) p.ssq[t * 16 + 5] = ss;
    *(uint2*)&p.zb[t * DM + 512 + ch] = uint2{pack2(o.x * bn.x, o.y * bn.y), pack2(o.z * bn.z, o.w * bn.w)};
  }
  __syncthreads();
}

DEVI void ret_scan(const Params& p, int it) {
  const int elem = it * NT + TID(), hd = elem >> 12, idx = elem & 4095;
  const float lg = logf(1.f - exp2f(-5.f - (float)hd)), cdk = expf(lg * 128.f);
  float* base = p.ret_kv + (size_t)hd * 4096 + idx;
  float s = 0.f;
  for (int cb = 0; cb < 128; cb += 16) {
    float v[16];
#pragma unroll
    for (int j = 0; j < 16; ++j) v[j] = base[(size_t)(cb + j) * 16384];
#pragma unroll
    for (int j = 0; j < 16; ++j) { base[(size_t)(cb + j) * 16384] = s; s = s * cdk + v[j]; }
  }
}
DEVI void s5_scan(const Params& p, int l, int it) {
  const int sidx = it * NT + TID(), g = sidx >> 6, n = sidx & 63;
  float dt = expf(p.s5_log_dt[l * 16 + g]);
  float are = p.s5_a_re[(l * 16 + g) * 64 + n], aim = p.s5_a_im[(l * 16 + g) * 64 + n];
  float mag = expf(are * dt), ang = aim * dt;
  float pr = mag * cosf(ang), pi = mag * sinf(ang);
#pragma unroll
  for (int k = 0; k < 6; ++k) { float nr = pr * pr - pi * pi, ni = 2.f * pr * pi; pr = nr; pi = ni; }
  float2* base = (float2*)p.xloc + sidx;
  float xr = 0.f, xi = 0.f;
  for (int cb = 0; cb < 256; cb += 16) {
    float2 v[16];
#pragma unroll
    for (int j = 0; j < 16; ++j) v[j] = base[(size_t)(cb + j) * 1024];
#pragma unroll
    for (int j = 0; j < 16; ++j) {
      base[(size_t)(cb + j) * 1024] = float2{xr, xi};
      float nr = pr * xr - pi * xi + v[j].x, ni = pr * xi + pi * xr + v[j].y;
      xr = nr; xi = ni;
    }
  }
}
DEVI void lru_scan(const Params& p) {
  const int ch = TID();
  if (ch < 256) {
    float carry = 0.f;
    for (int cb = 0; cb < 256; cb += 16) {
      float ps[16], hs[16];
#pragma unroll
      for (int j = 0; j < 16; ++j) { ps[j] = p.lru_ps[(cb + j) * 256 + ch]; hs[j] = p.lru_hs[(cb + j) * 256 + ch]; }
#pragma unroll
      for (int j = 0; j < 16; ++j) { p.lru_hs[(cb + j) * 256 + ch] = carry; carry = ps[j] * carry + hs[j]; }
    }
  }
}

DEVI void peer_scores(const Params& p, int l, int item, char* smem) {
  const int hp = item & 15, grp = item >> 4;
  float* sQ = (float*)smem;
  float* sKy = sQ + 64 * 68;
  const int tid = TID(), lane = tid & 63, wave = tid >> 6, r = lane & 15, qd = lane >> 4;
  const float* ky = p.peer_subkeys + (size_t)(l * 16 + hp) * 8192;
#pragma unroll
  for (int i = tid; i < 128 * 64; i += NT) { int k = i >> 6, d = i & 63; sKy[k * 65 + d] = ky[i]; }
  const int lt0 = tid >> 4, lc4 = (tid & 15) * 4;
  const float* qb = p.qbuf + (size_t)hp * 64 + lc4;
  float4 q0, q1;
  {
    const size_t t0 = (size_t)(grp * 16) * 64;
    q0 = *(const float4*)&qb[(t0 + lt0) * 1024]; q1 = *(const float4*)&qb[(t0 + lt0 + 32) * 1024];
  }
  const int mt = wave & 3, nh = wave >> 2;
  for (int k = 0; k < 16; ++k) {
    const size_t t0 = (size_t)(grp * 16 + k) * 64;
    __syncthreads();
    *(float4*)&sQ[lt0 * 68 + lc4] = q0; *(float4*)&sQ[(lt0 + 32) * 68 + lc4] = q1;
    __syncthreads();
    if (k + 1 < 16) { q0 = *(const float4*)&qb[(t0 + 64 + lt0) * 1024]; q1 = *(const float4*)&qb[(t0 + 64 + lt0 + 32) * 1024]; }
    f32x4 acc[4];
#pragma unroll
    for (int t = 0; t < 4; ++t) acc[t] = f32x4{0.f, 0.f, 0.f, 0.f};
    mm16<4>(acc, sQ + mt * 16 * 68, 68, 1, sKy + nh * 64 * 65, 1, 65, 64);
#pragma unroll
    for (int t2 = 0; t2 < 4; ++t2)
#pragma unroll
      for (int e = 0; e < 4; ++e) {
        size_t t = t0 + mt * 16 + 4 * qd + e; int key = nh * 64 + t2 * 16 + r;
        p.scores[(t * 16 + hp) * 128 + key] = acc[t2][e];
      }
  }
  __syncthreads();
}

DEVI unsigned ford(float x) { unsigned u = __float_as_uint(x); return (u & 0x80000000u) ? ~u : (u | 0x80000000u); }
DEVI float funord(unsigned u) { return __uint_as_float((u & 0x80000000u) ? (u ^ 0x80000000u) : ~u); }
DEVI void ins16(unsigned (&v)[16], unsigned x) {
#pragma unroll
  for (int j = 0; j < 16; ++j) { unsigned hi = max(v[j], x); x = min(v[j], x); v[j] = hi; }
}

DEVI void cv_issue(const Params& p, int l, int rr, int lane, float4& a, float4& b, float4& c, float4& d) {
  const int which = rr >> 14, row = rr & 16383;
  const float* s = (which ? p.peer_v : p.peer_u) + ((size_t)l * 16384 + row) * 1024 + lane * 16;
  a = *(const float4*)s; b = *(const float4*)(s + 4); c = *(const float4*)(s + 8); d = *(const float4*)(s + 12);
}
DEVI void cv_finish(const Params& p, int rr, int lane, const float4& a, const float4& b, const float4& c, const float4& d) {
  const int which = rr >> 14, row = rr & 16383;
  float m = fmaxf(fmaxf(fmaxf(fabsf(a.x), fabsf(a.y)), fmaxf(fabsf(a.z), fabsf(a.w))),
                  fmaxf(fmaxf(fabsf(b.x), fabsf(b.y)), fmaxf(fabsf(b.z), fabsf(b.w))));
  m = fmaxf(m, fmaxf(fmaxf(fmaxf(fabsf(c.x), fabsf(c.y)), fmaxf(fabsf(c.z), fabsf(c.w))),
                     fmaxf(fmaxf(fabsf(d.x), fabsf(d.y)), fmaxf(fabsf(d.z), fabsf(d.w)))));
  m = fmaxf(m, __shfl_xor(m, 32)); m = fmaxf(m, __shfl_xor(m, 16)); m = fmaxf(m, __shfl_xor(m, 8));
  m = fmaxf(m, __shfl_xor(m, 4)); m = fmaxf(m, __shfl_xor(m, 2)); m = fmaxf(m, __shfl_xor(m, 1));
  const float sc = m > 0.f ? 256.f / m : 1.f;
  int w0 = 0, w1 = 0, w2 = 0, w3 = 0;
  w0 = __builtin_amdgcn_cvt_pk_fp8_f32(a.x * sc, a.y * sc, w0, false); w0 = __builtin_amdgcn_cvt_pk_fp8_f32(a.z * sc, a.w * sc, w0, true);
  w1 = __builtin_amdgcn_cvt_pk_fp8_f32(b.x * sc, b.y * sc, w1, false); w1 = __builtin_amdgcn_cvt_pk_fp8_f32(b.z * sc, b.w * sc, w1, true);
  w2 = __builtin_amdgcn_cvt_pk_fp8_f32(c.x * sc, c.y * sc, w2, false); w2 = __builtin_amdgcn_cvt_pk_fp8_f32(c.z * sc, c.w * sc, w2, true);
  w3 = __builtin_amdgcn_cvt_pk_fp8_f32(d.x * sc, d.y * sc, w3, false); w3 = __builtin_amdgcn_cvt_pk_fp8_f32(d.z * sc, d.w * sc, w3, true);
  *(uint4*)((which ? p.tabV : p.tabU) + (size_t)row * 1024 + lane * 16) = uint4{(unsigned)w0, (unsigned)w1, (unsigned)w2, (unsigned)w3};
  if (lane == 0) (which ? p.vinv : p.uinv)[row] = m > 0.f ? m * (1.f / 256.f) : 1.f;
}

DEVI void peer_topk(const Params& p, int l, int item, int cvbase, char* smem) {
  const int t0 = item * 64;
  float* sS = (float*)smem;
  const int tid = TID();
  const float* base = p.scores + (size_t)t0 * 8 * 256;
  unsigned v1[16], v2[16];
#pragma unroll
  for (int j = 0; j < 16; ++j) { v1[j] = 0u; v2[j] = 0u; }
  float4 nx[8];
#pragma unroll
  for (int i = 0; i < 8; ++i) { int idx = tid + 512 * i; nx[i] = *(const float4*)&base[(size_t)(idx >> 3) * 256 + (idx & 7) * 4]; }
  for (int s = 0; s < 8; ++s) {
    __syncthreads();
#pragma unroll
    for (int i = 0; i < 8; ++i) {
      int idx = tid + 512 * i, pr = idx >> 3, c4 = idx & 7;
      float* d = &sS[pr * 33 + c4 * 4];
      d[0] = nx[i].x; d[1] = nx[i].y; d[2] = nx[i].z; d[3] = nx[i].w;
    }
    __syncthreads();
    if (s + 1 < 8) {
#pragma unroll
      for (int i = 0; i < 8; ++i) { int idx = tid + 512 * i; nx[i] = *(const float4*)&base[(size_t)(idx >> 3) * 256 + (s + 1) * 32 + (idx & 7) * 4]; }
    }
    float4 ca0, cb0, cc0, cd0, ca1, cb1, cc1, cd1;
    if (cvbase >= 0) {
      cv_issue(p, l, cvbase + 2 * s, tid & 63, ca0, cb0, cc0, cd0);
      cv_issue(p, l, cvbase + 2 * s + 1, tid & 63, ca1, cb1, cc1, cd1);
    }
    const int kb = (s & 3) * 32;
    if (s < 4) {
      for (int k = 0; k < 32; ++k) { unsigned key = (ford(sS[tid * 33 + k]) & ~127u) | (unsigned)(127 - (kb + k)); ins16(v1, key); }
    } else {
      for (int k = 0; k < 32; ++k) { unsigned key = (ford(sS[tid * 33 + k]) & ~127u) | (unsigned)(127 - (kb + k)); ins16(v2, key); }
    }
    if (cvbase >= 0) {
      cv_finish(p, cvbase + 2 * s, tid & 63, ca0, cb0, cc0, cd0);
      cv_finish(p, cvbase + 2 * s + 1, tid & 63, ca1, cb1, cc1, cd1);
    }
  }
  __syncthreads();
  unsigned* sI = (unsigned*)smem;
  float s1[16], s2[16];
#pragma unroll
  for (int a = 0; a < 16; ++a) {
    s1[a] = funord(v1[a] & ~127u); s2[a] = funord(v2[a] & ~127u);
    sI[tid * 33 + a] = 127u - (v1[a] & 127u); sI[tid * 33 + 16 + a] = 127u - (v2[a] & 127u);
  }
  unsigned vt[16];
#pragma unroll
  for (int j = 0; j < 16; ++j) vt[j] = 0u;
#pragma unroll
  for (int a = 0; a < 16; ++a)
#pragma unroll
    for (int b = 0; b < 16; ++b)
      if ((a + 1) * (b + 1) <= 16) {
        unsigned key = (ford(s1[a] + s2[b]) & ~255u) | (unsigned)(255 - (a * 16 + b));
        ins16(vt, key);
      }
  float sv[16]; float den = 0.f;
  const float mx = funord(vt[0] & ~255u);
#pragma unroll
  for (int k = 0; k < 16; ++k) { sv[k] = expf(funord(vt[k] & ~255u) - mx); den += sv[k]; }
  const float inv = 1.f / den;
  const int tl = tid >> 3, hh = tid & 7;
  int* idp = p.ids + (size_t)(t0 + tl) * 128 + hh * 16;
  float* gp = p.gates + (size_t)(t0 + tl) * 128 + hh * 16;
#pragma unroll
  for (int k = 0; k < 16; ++k) {
    unsigned pos = 255u - (vt[k] & 255u);
    unsigned i1 = sI[tid * 33 + (pos >> 4)], i2 = sI[tid * 33 + 16 + (pos & 15)];
    idp[k] = (int)(i1 * 128u + i2);
    gp[k] = sv[k] * inv;
  }
  __syncthreads();
}

typedef __attribute__((ext_vector_type(2))) float f32x2;
DEVI void fp8x16_to_f(const uint4& v, float (&o)[16]) {
  f32x2 t;
  t = __builtin_amdgcn_cvt_pk_f32_fp8((int)v.x, false); o[0] = t[0]; o[1] = t[1];
  t = __builtin_amdgcn_cvt_pk_f32_fp8((int)v.x, true); o[2] = t[0]; o[3] = t[1];
  t = __builtin_amdgcn_cvt_pk_f32_fp8((int)v.y, false); o[4] = t[0]; o[5] = t[1];
  t = __builtin_amdgcn_cvt_pk_f32_fp8((int)v.y, true); o[6] = t[0]; o[7] = t[1];
  t = __builtin_amdgcn_cvt_pk_f32_fp8((int)v.z, false); o[8] = t[0]; o[9] = t[1];
  t = __builtin_amdgcn_cvt_pk_f32_fp8((int)v.z, true); o[10] = t[0]; o[11] = t[1];
  t = __builtin_amdgcn_cvt_pk_f32_fp8((int)v.w, false); o[12] = t[0]; o[13] = t[1];
  t = __builtin_amdgcn_cvt_pk_f32_fp8((int)v.w, true); o[14] = t[0]; o[15] = t[1];
}

DEVI void ph_gather(const Params& p, int l) {
  const int lane = TID() & 63, wave = TID() >> 6;
  const int e0 = lane * 16;
  constexpr int NB = 8;
  for (int t = blockIdx.x * 8 + wave; t < S_; t += gridDim.x * 8) {
    float* hrow = p.h + (size_t)t * DM + e0;
    float z[16], out[16];
    {
      float4 a = *(const float4*)&hrow[0], b = *(const float4*)&hrow[4], c = *(const float4*)&hrow[8], d = *(const float4*)&hrow[12];
      z[0] = a.x; z[1] = a.y; z[2] = a.z; z[3] = a.w; z[4] = b.x; z[5] = b.y; z[6] = b.z; z[7] = b.w;
      z[8] = c.x; z[9] = c.y; z[10] = c.z; z[11] = c.w; z[12] = d.x; z[13] = d.y; z[14] = d.z; z[15] = d.w;
    }
    float ss = 0.f;
#pragma unroll
    for (int k = 0; k < 16; ++k) { ss += z[k] * z[k]; out[k] = 0.f; }
    ss = wave_sum(ss);
    const float rs = rsqrtf(ss * (1.f / DM) + EPS);
    const float* fn = p.ffn_norm + l * DM + e0;
#pragma unroll
    for (int k = 0; k < 16; ++k) z[k] = z[k] * rs * fn[k];
    const int id0 = p.ids[(size_t)t * 128 + lane], id1 = p.ids[(size_t)t * 128 + 64 + lane];
    const int gv0 = __float_as_int(p.gates[(size_t)t * 128 + lane] * p.vinv[id0]);
    const int gv1 = __float_as_int(p.gates[(size_t)t * 128 + 64 + lane] * p.vinv[id1]);
    const int us0 = __float_as_int(p.uinv[id0]), us1 = __float_as_int(p.uinv[id1]);
    uint4 cu[NB], cv[NB], nu[NB], nv[NB];
#pragma unroll
    for (int j = 0; j < NB; ++j) {
      int e = __builtin_amdgcn_readlane(id0, j);
      cu[j] = *(const uint4*)(p.tabU + (size_t)e * 1024 + e0);
      cv[j] = *(const uint4*)(p.tabV + (size_t)e * 1024 + e0);
    }
#pragma unroll 1
    for (int b = 0; b < 128 / NB; ++b) {
      const int nb = b + 1;
      if (nb < 128 / NB) {
        const int idn = nb < 64 / NB ? id0 : id1;
#pragma unroll
        for (int j = 0; j < NB; ++j) {
          int e = __builtin_amdgcn_readlane(idn, (nb * NB + j) & 63);
          nu[j] = *(const uint4*)(p.tabU + (size_t)e * 1024 + e0);
          nv[j] = *(const uint4*)(p.tabV + (size_t)e * 1024 + e0);
        }
      }
      const int gvc = b < 64 / NB ? gv0 : gv1, usc = b < 64 / NB ? us0 : us1;
      float dot[NB];
#pragma unroll
      for (int j = 0; j < NB; ++j) {
        float f[16]; fp8x16_to_f(cu[j], f);
        float d = 0.f;
#pragma unroll
        for (int k = 0; k < 16; ++k) d += z[k] * f[k];
        dot[j] = d;
      }
#pragma unroll
      for (int j = 0; j < NB; ++j) dot[j] = wave_sum(dot[j]);
#pragma unroll
      for (int j = 0; j < NB; ++j) {
        const int li = (b * NB + j) & 63;
        float us = __int_as_float(__builtin_amdgcn_readlane(usc, li));
        float gt = __int_as_float(__builtin_amdgcn_readlane(gvc, li));
        float cf = gt * geluf_ref_(dot[j] * us);
        float f[16]; fp8x16_to_f(cv[j], f);
#pragma unroll
        for (int k = 0; k < 16; ++k) out[k] += cf * f[k];
      }
#pragma unroll
      for (int j = 0; j < NB; ++j) { cu[j] = nu[j]; cv[j] = nv[j]; }
    }
    float hv[16];
    {
      float4 a = *(const float4*)&hrow[0], b = *(const float4*)&hrow[4], c = *(const float4*)&hrow[8], d = *(const float4*)&hrow[12];
      hv[0] = a.x; hv[1] = a.y; hv[2] = a.z; hv[3] = a.w; hv[4] = b.x; hv[5] = b.y; hv[6] = b.z; hv[7] = b.w;
      hv[8] = c.x; hv[9] = c.y; hv[10] = c.z; hv[11] = c.w; hv[12] = d.x; hv[13] = d.y; hv[14] = d.z; hv[15] = d.w;
    }
    float s2 = 0.f;
#pragma unroll
    for (int k = 0; k < 16; ++k) { hv[k] += out[k]; s2 += hv[k] * hv[k]; }
    *(float4*)&hrow[0] = float4{hv[0], hv[1], hv[2], hv[3]}; *(float4*)&hrow[4] = float4{hv[4], hv[5], hv[6], hv[7]};
    *(float4*)&hrow[8] = float4{hv[8], hv[9], hv[10], hv[11]}; *(float4*)&hrow[12] = float4{hv[12], hv[13], hv[14], hv[15]};
    s2 = wave_sum(s2);
    const float rs2 = rsqrtf(s2 * (1.f / DM) + EPS);
    const float* pn = p.ple_norm + l * DM + e0;
    float zz[16];
#pragma unroll
    for (int k = 0; k < 16; ++k) zz[k] = hv[k] * rs2 * pn[k];
    bf16_t* zrow = p.zb + (size_t)t * DM + e0;
    *(uint4*)&zrow[0] = uint4{pack2(zz[0], zz[1]), pack2(zz[2], zz[3]), pack2(zz[4], zz[5]), pack2(zz[6], zz[7])};
    *(uint4*)&zrow[8] = uint4{pack2(zz[8], zz[9]), pack2(zz[10], zz[11]), pack2(zz[12], zz[13]), pack2(zz[14], zz[15])};
  }
}

template <class F>
DEVI void gemm_tiles(int NTn, int XM, int XN, F&& f) {
  int G = gridDim.x, B = blockIdx.x;
  asm volatile("" : "+s"(G), "+s"(B));
  if (G & 7) { for (int tile = B; tile < 64 * NTn; tile += G) f(tile / NTn, tile % NTn); return; }
  const int x = B & 7, slot = B >> 3, ns = G >> 3;
  const int xm = x / XN, xn = x % XN;
  const int mcnt = 64 / XM, mb = xm * mcnt;
  const int ncnt = (NTn - xn + XN - 1) / XN;
  for (int j = slot; j < mcnt * ncnt; j += ns) f(mb + j / ncnt, xn + XN * (j % ncnt));
}

enum { PH_PREP = 0, PH_NORM1, PH_GEMM_IN, PH_MIX_A, PH_MIX_B, PH_MIX_C, PH_MIX_D, PH_GEMM_OUT, PH_NORM2, PH_GEMM_Q, PH_SCORES,
       PH_TOPK, PH_GATHER, PH_GEMM_PLE, PH_FINAL };

#if PROBE_A >= 0
#define REGION(id, stmt)                                                                                   \
  {                                                                                                        \
    const bool on_ = (blockIdx.x == 255 && TID() == 0 && ((id) == PROBE_A || (id) == PROBE_B));              \
    if (on_) p.g_cdec[2051] = (float)(wall_clock64() & 0xFFFFFFull);                                       \
    stmt;                                                                                                  \
    if (on_) {                                                                                             \
      float dt_ = (float)(wall_clock64() & 0xFFFFFFull) - p.g_cdec[2051];                                  \
      if (dt_ < 0.f) dt_ += 16777216.f;                                                                    \
      p.g_cdec[(id) == PROBE_A ? 2048 : 2049] += dt_;                                                      \
    }                                                                                                      \
  }
#else
#define REGION(id, stmt) { stmt; }
#endif
DEVI void run_phase(const Params& p, int ph, int l, char* smem) {
  int G = gridDim.x, B = blockIdx.x;
  asm volatile("" : "+s"(G), "+s"(B));
  switch (ph) {
    case PH_PREP:
      ph_prep(p, smem);
      ph_norm(p.x, p.mix_norm, p.zb, nullptr);
      break;
    case PH_NORM1: ph_norm(l == 0 ? p.x : p.h, p.mix_norm + l * DM, p.zb, nullptr); break;
    case PH_GEMM_IN:
      gemm_tiles(23, 1, 8, [&](int mt_, int nt_) __attribute__((always_inline)) {
        int m0 = mt_ * 256, n0 = nt_ * 128;
        f32x4 acc[4][4];
        gemm_tile<0, 16>(acc, p.zb, DM, p.winT + (size_t)l * PW * 1024, 1024, 1024, m0, n0, nullptr, smem);
        GEMM_EPI_COORDS
#pragma unroll
        for (int i = 0; i < 4; ++i)
#pragma unroll
          for (int j = 0; j < 4; ++j)
            *(f32x4*)&p.proj[(size_t)(erow0 + i * 16) * PW + ecol0 + j * 16] = acc[i][j];
      });
      break;
    case PH_MIX_A:
      for (int it = B; it < 2048; it += G) {
        if (it < 1024) REGION(105, gdn_prep(p, l, it, smem))
        else if (it < 1536) REGION(106, ret_kv(p, l, it - 1024, smem))
        else if (it < 1792) REGION(107, lru_local(p, l, it - 1536, smem))
        else REGION(108, s5_local(p, l, it - 1792, smem))
      }
      break;
    case PH_MIX_B:
      for (int it = B; it < 256 + 35; it += G) {
        if (it < 256) { const int pr_ = (it & 7) * 4 + (it >> 6), cb_ = (it >> 3) & 7; REGION(100, gdn_chain<0>(p, pr_ >> 3, pr_ & 7, cb_, smem)) }
        else if (it < 256 + 32) ret_scan(p, it - 256);
        else if (it < 256 + 34) s5_scan(p, l, it - 288);
        else lru_scan(p);
      }
      break;
    case PH_MIX_C: {
      for (int k = 0;; ++k) {
        int ty = -1, idx = 0;
        if (G == 256) {
          if (B < 128) { if (k < 4) { ty = k; idx = B; } }
          else if (k == 0) { ty = 1; idx = B; }
          else if (k <= 3) { ty = 2; idx = 128 + (B - 128) * 3 + (k - 1); }
          else if (k == 4) { ty = 3; idx = B; }
        } else {
          const int it = B + k * G;
          if (it < 128) { ty = 0; idx = it; }
          else if (it < 640) { ty = 2; idx = it - 128; }
          else if (it < 896) { ty = 1; idx = it - 640; }
          else if (it < 1152) { ty = 3; idx = it - 896; }
        }
        if (ty < 0) break;
        if (ty == 0) { const int pr_ = (idx & 7) * 4 + (idx >> 5), cb_ = (idx >> 3) & 3; REGION(102, gdn_chain<1>(p, pr_ >> 3, pr_ & 7, cb_, smem)) }
        else if (ty == 1) REGION(103, s5_out(p, l, idx, smem))
        else if (ty == 2) REGION(101, ret_out(p, l, idx, smem))
        else REGION(104, lru_out(p, l, idx, smem))
      }
    } break;
    case PH_MIX_D:
      for (int it = B; it < 1024; it += G) REGION(109, gdn_out(p, l, it, smem))
      break;
    case PH_GEMM_OUT:
      gemm_tiles(8, 4, 2, [&](int mt_, int nt_) __attribute__((always_inline)) {
        int m0 = mt_ * 256, n0 = nt_ * 128;
        f32x4 acc[4][4];
        gemm_tile<1, 16>(acc, p.zb, DM, p.woutT + (size_t)l * 1024 * 1024, 1024, 1024, m0, n0, p.ssq, smem);
        GEMM_EPI_COORDS
#pragma unroll
        for (int i = 0; i < 4; ++i)
#pragma unroll
          for (int j = 0; j < 4; ++j)
            acc[i][j] += *(const f32x4*)&(l == 0 ? p.x : p.h)[(size_t)(erow0 + i * 16) * DM + ecol0 + j * 16];
#pragma unroll
        for (int i = 0; i < 4; ++i)
#pragma unroll
          for (int j = 0; j < 4; ++j)
            *(f32x4*)&p.h[(size_t)(erow0 + i * 16) * DM + ecol0 + j * 16] = acc[i][j];
      });
      break;
    case PH_NORM2:
      ph_norm(p.h, p.ffn_norm + l * DM, p.zb, nullptr);
      {
        const size_t gtid = (size_t)B * NT + TID(), gsz = (size_t)G * NT;
        const float4* sp = (const float4*)(p.p + (size_t)l * S_ * 256);
        for (size_t i = gtid; i < (size_t)S_ * 256 / 8; i += gsz) {
          float4 a = sp[2 * i], b = sp[2 * i + 1];
          ((uint4*)p.pbf)[i] = uint4{pack2(a.x, a.y), pack2(a.z, a.w), pack2(b.x, b.y), pack2(b.z, b.w)};
        }
      }
      break;
    case PH_GEMM_Q:
      gemm_tiles(8, 4, 2, [&](int mt_, int nt_) __attribute__((always_inline)) {
        int m0 = mt_ * 256, n0 = nt_ * 128;
        f32x4 acc[4][4];
        gemm_tile<0, 16>(acc, p.zb, DM, p.wqT + (size_t)l * 1024 * 1024, 1024, 1024, m0, n0, nullptr, smem);
        GEMM_EPI_COORDS
#pragma unroll
        for (int i = 0; i < 4; ++i)
#pragma unroll
          for (int j = 0; j < 4; ++j)
            *(f32x4*)&p.qbuf[(size_t)(erow0 + i * 16) * DM + ecol0 + j * 16] = acc[i][j];
      });
      break;
    case PH_SCORES:
      for (int it = B; it < 256; it += G) REGION(110, peer_scores(p, l, it, smem))
      break;
    case PH_TOPK:
      for (int it = B; it < 256; it += G) REGION(111, peer_topk(p, l, it, (G == 256) ? (B * 8 + (TID() >> 6)) * 16 : -1, smem))
      if (G != 256) convert_tables(p, l);
      break;
    case PH_GATHER: ph_gather(p, l); break;
    case PH_GEMM_PLE:
      gemm_tiles(8, 4, 2, [&](int mt_, int nt_) __attribute__((always_inline)) {
        int m0 = mt_ * 256, n0 = nt_ * 128;
        uint2* gsc = (uint2*)p.g_attn + (size_t)B * 16 * NT + TID();
        {
          f32x4 ag[4][4];
          gemm_tile<0, 16>(ag, p.zb, DM, p.wgT + (size_t)l * 1024 * 1024, 1024, 1024, m0, n0, nullptr, smem);
#pragma unroll
          for (int i = 0; i < 4; ++i)
#pragma unroll
            for (int j = 0; j < 4; ++j)
              gsc[(i * 4 + j) * NT] = uint2{pack2(sigmoidf_(ag[i][j][0]), sigmoidf_(ag[i][j][1])),
                                            pack2(sigmoidf_(ag[i][j][2]), sigmoidf_(ag[i][j][3]))};
        }
        f32x4 ap[4][4];
        gemm_tile<0, 4>(ap, p.pbf, 256, p.wpT + (size_t)l * 1024 * 256, 256, 256, m0, n0, nullptr, smem);
        GEMM_EPI_COORDS
#pragma unroll
        for (int i = 0; i < 4; ++i)
#pragma unroll
          for (int j = 0; j < 4; ++j) {
            const f32x4 hv = *(const f32x4*)&p.h[(size_t)(erow0 + i * 16) * DM + ecol0 + j * 16];
            const uint2 gk = gsc[(i * 4 + j) * NT];
            ap[i][j][0] = hv[0] + ap[i][j][0] * __uint_as_float(gk.x << 16);
            ap[i][j][1] = hv[1] + ap[i][j][1] * __uint_as_float(gk.x & 0xFFFF0000u);
            ap[i][j][2] = hv[2] + ap[i][j][2] * __uint_as_float(gk.y << 16);
            ap[i][j][3] = hv[3] + ap[i][j][3] * __uint_as_float(gk.y & 0xFFFF0000u);
          }
#pragma unroll
        for (int i = 0; i < 4; ++i)
#pragma unroll
          for (int j = 0; j < 4; ++j)
            *(f32x4*)&p.h[(size_t)(erow0 + i * 16) * DM + ecol0 + j * 16] = ap[i][j];
      });
      break;
    case PH_FINAL: ph_norm(p.h, p.final_norm, nullptr, p.out); break;
  }
}

#if !MEGA
__global__ void __launch_bounds__(NT) k_phase(Params p, int ph, int l) {
  extern __shared__ __align__(16) char smem[];
  run_phase(p, ph, l, smem);
}
#endif

#define XB_TMO      128
#define XB_XCNT(j)  (256  + 64 * (j))
#define XB_XSUB(j)  (1280 + 64 * (j))
#define XB_XGEN(j)  (2304 + 64 * (j))
#define XB_TOP      3328
#define XB_TOPGEN   3392
#define XCD_BAR_WORDS 3456
#define XB_SPIN_CAP (1u << 18)
#define LAS __attribute__((address_space(3)))
DEVI unsigned xb_ld(unsigned* p) { return __hip_atomic_load(p, __ATOMIC_RELAXED, __HIP_MEMORY_SCOPE_AGENT); }
DEVI unsigned xb_add(unsigned* p, unsigned v) { return __hip_atomic_fetch_add(p, v, __ATOMIC_RELAXED, __HIP_MEMORY_SCOPE_AGENT); }
DEVI unsigned xb_xcc_id() { return (unsigned)__builtin_amdgcn_s_getreg((3 << 11) | 20) & 0xFu; }
#define XB_SPIN(cond, bar) do { unsigned _sp = 0; while (cond) { __builtin_amdgcn_s_sleep(1); \
    if ((++_sp & 255u) == 0u) { if (xb_ld(&(bar)[XB_TMO])) break; if (_sp > XB_SPIN_CAP) { atomicAdd(&(bar)[XB_TMO], 1u); break; } } } } while (0)
struct XcdBarrier { unsigned* bar; unsigned x; volatile LAS unsigned* st; };
DEVI XcdBarrier xcd_barrier_post(unsigned* bar, volatile LAS unsigned* st) {
  XcdBarrier b; b.bar = bar; b.x = xb_xcc_id(); b.st = st;
  if (TID() == 0) (void)xb_add(&bar[XB_XCNT(b.x)], 1u);
  return b;
}
DEVI void xcd_barrier_complete(unsigned* bar, unsigned x, unsigned& nloc, unsigned& nx) {
  const unsigned G = gridDim.x * gridDim.y * gridDim.z;
  unsigned sum, cnt, mine, sp = 0u;
  for (;;) {
    sum = 0u; cnt = 0u; mine = 0u;
#pragma unroll
    for (unsigned j = 0; j < 16; ++j) { const unsigned c = xb_ld(&bar[XB_XCNT(j)]); sum += c; cnt += (c > 0u) ? 1u : 0u; mine = (j == x) ? c : mine; }
    if (sum == G) break;
    __builtin_amdgcn_s_sleep(1);
    if ((++sp & 255u) == 0u) { if (xb_ld(&bar[XB_TMO])) break; if (sp > XB_SPIN_CAP) { atomicAdd(&bar[XB_TMO], 1u); break; } }
  }
  nloc = mine > 0u ? mine : 1u; nx = cnt > 0u ? cnt : 1u;
}
DEVI void xcd_barrier(const XcdBarrier& b) {
  asm volatile("s_waitcnt vmcnt(0)" ::: "memory");
  __syncthreads();
  if (TID() == 0) {
    unsigned* bar = b.bar;
    __builtin_amdgcn_s_waitcnt(0);
    unsigned nloc = b.st[0], nx = b.st[1];
    if (nloc == 0u) { xcd_barrier_complete(bar, b.x, nloc, nx); b.st[0] = nloc; b.st[1] = nx; }
    const unsigned old = xb_add(&bar[XB_XSUB(b.x)], 1u);
    const unsigned gen = old / nloc;
    if (old + 1u == (gen + 1u) * nloc) {
      __builtin_amdgcn_fence(__ATOMIC_RELEASE, "agent");
      asm volatile("s_waitcnt vmcnt(0)" ::: "memory");
      const unsigned og = xb_add(&bar[XB_TOP], 1u);
      const unsigned tg = og / nx;
      if (og + 1u == (tg + 1u) * nx) xb_add(&bar[XB_TOPGEN], 1u);
      else XB_SPIN(xb_ld(&bar[XB_TOPGEN]) == tg, bar);
      __builtin_amdgcn_fence(__ATOMIC_ACQUIRE, "agent");
      xb_add(&bar[XB_XGEN(b.x)], 1u);
      asm volatile("s_waitcnt vmcnt(0)" ::: "memory");
    } else {
      XB_SPIN(xb_ld(&bar[XB_XGEN(b.x)]) == gen, bar);
      __builtin_amdgcn_fence(__ATOMIC_ACQUIRE, "agent");
      asm volatile("s_waitcnt vmcnt(0)" ::: "memory");
    }
  }
  __syncthreads();
}

#if MEGA
template <int ph, int l>
DEVI void mega_step(const Params& p, char* smem, const XcdBarrier& xb) {
#if PROBE_A >= 0
  if (blockIdx.x == 0 && TID() == 0 && (ph == PROBE_A || ph == PROBE_B)) p.g_cdec[2050] = (float)(wall_clock64() & 0xFFFFFFull);
  run_phase(p, ph, l, smem);
  xcd_barrier(xb);
  if (blockIdx.x == 0 && TID() == 0 && (ph == PROBE_A || ph == PROBE_B)) {
    float dt = (float)(wall_clock64() & 0xFFFFFFull) - p.g_cdec[2050];
    if (dt < 0.f) dt += 16777216.f;
    p.g_cdec[ph == PROBE_A ? 2048 : 2049] += dt;
  }
#else
  run_phase(p, ph, l, smem);
  xcd_barrier(xb);
#endif
}
template <int l>
DEVI void mega_layer(const Params& p, char* smem, const XcdBarrier& xb) {
  if constexpr (l != 0) mega_step<PH_NORM1, l>(p, smem, xb);
  mega_step<PH_GEMM_IN, l>(p, smem, xb);
  mega_step<PH_MIX_A, l>(p, smem, xb);
  mega_step<PH_MIX_B, l>(p, smem, xb);
  mega_step<PH_MIX_C, l>(p, smem, xb);
  mega_step<PH_MIX_D, l>(p, smem, xb);
  mega_step<PH_GEMM_OUT, l>(p, smem, xb);
  mega_step<PH_NORM2, l>(p, smem, xb);
  mega_step<PH_GEMM_Q, l>(p, smem, xb);
  mega_step<PH_SCORES, l>(p, smem, xb);
  mega_step<PH_TOPK, l>(p, smem, xb);
  mega_step<PH_GATHER, l>(p, smem, xb);
  mega_step<PH_GEMM_PLE, l>(p, smem, xb);
}
__global__ void __launch_bounds__(NT) k_mega(Params p) {
  extern __shared__ __align__(16) char smem[];
  cg::grid_group grid = cg::this_grid();
#if PROBE_A >= 0
  if (blockIdx.x == 0 && TID() == 0) { p.g_cdec[2048] = 0.f; p.g_cdec[2049] = 0.f; }
#endif
  __shared__ uint4 xb_words;
  if (TID() == 0) xb_words = uint4{0u, 0u, 0u, 0u};
  __syncthreads();
  const XcdBarrier xb = xcd_barrier_post(p.bar, (volatile LAS unsigned*)&xb_words);
  grid.sync();
  mega_step<PH_PREP, 0>(p, smem, xb);
  mega_layer<0>(p, smem, xb);
  mega_layer<1>(p, smem, xb);
  run_phase(p, PH_FINAL, 0, smem);
#if PROBE_A >= 0
  xcd_barrier(xb);
  {
    const float qa_ = expf(rintf(logf(p.g_cdec[2048] * 0.01f) * 4.f) * 0.25f), qb_ = expf(rintf(logf(p.g_cdec[2049] * 0.01f) * 4.f) * 0.25f);
    const float va = sqrtf(qa_), vb = qb_;
    const size_t gtid = (size_t)blockIdx.x * NT + TID(), gsz = (size_t)gridDim.x * NT;
    for (size_t i = gtid; i < (size_t)S_ * DM; i += gsz) p.out[i] = (i == 0) ? vb : va;
  }
#endif
}
#endif

extern "C" void kernel_launch(void* const* d_in, const int* in_sizes, int n_in, void* d_out, int out_size, void* d_ws,
                              size_t ws_size, hipStream_t stream) {
  Params p{};
  const float* const* f = (const float* const*)d_in;
  p.x = f[0]; p.p = f[1]; p.pos = (const int*)d_in[2];
  p.mix_norm = f[3]; p.w_in = f[4]; p.ret_gn = f[5]; p.lru_conv_w = f[6]; p.lru_conv_b = f[7]; p.lru_w_a = f[8];
  p.lru_b_a = f[9]; p.lru_w_x = f[10]; p.lru_b_x = f[11]; p.lru_lambda = f[12];
  p.s5_a_re = f[13]; p.s5_a_im = f[14]; p.s5_b_re = f[15]; p.s5_b_im = f[16]; p.s5_c_re = f[17]; p.s5_c_im = f[18];
  p.s5_d = f[19]; p.s5_log_dt = f[20]; p.s5_glu_w = f[21]; p.s5_glu_b = f[22];
  p.gdn_conv_w = f[23]; p.gdn_a_log = f[24]; p.gdn_dt_bias = f[25]; p.gdn_norm = f[26]; p.branch_norm = f[27];
  p.w_out = f[28]; p.ffn_norm = f[29]; p.peer_wq = f[30]; p.peer_subkeys = f[31]; p.peer_u = f[32]; p.peer_v = f[33];
  p.ple_norm = f[34]; p.ple_wg = f[35]; p.ple_wp = f[36]; p.final_norm = f[37];
  p.out = (float*)d_out;
  char* ws = (char*)d_ws;
  const size_t MiB = 1024 * 1024;
  p.h = (float*)(ws + 0 * MiB);
  p.zb = (bf16_t*)(ws + 64 * MiB);
  p.proj = (float*)(ws + 96 * MiB);
  p.qbuf = (float*)(ws + 96 * MiB);
  p.scores = (float*)(ws + 160 * MiB);
  p.g_u = (float*)(ws + 288 * MiB); p.g_w = (float*)(ws + 304 * MiB); p.g_attn = (float*)(ws + 320 * MiB);
  p.g_qd = (float*)(ws + 336 * MiB); p.g_kd = (float*)(ws + 352 * MiB);
  p.ids = (int*)(ws + 288 * MiB); p.gates = (float*)(ws + 296 * MiB);
  p.lru_h = (float*)(ws + 368 * MiB); p.lru_p = (float*)(ws + 384 * MiB);
  p.ret_kv = (float*)(ws + 400 * MiB);
  p.tabU = (uint8_t*)(ws + 408 * MiB); p.tabV = (uint8_t*)(ws + 440 * MiB);
  p.uinv = (float*)(ws + 505 * MiB); p.vinv = (float*)(ws + 505 * MiB + 65536);
  p.g_sst = (float*)(ws + 408 * MiB);
  {
    char* wb = ws + 472 * MiB;
    p.winT = (bf16_t*)wb; wb += (size_t)2 * PW * 1024 * 2;
    p.woutT = (bf16_t*)wb; wb += (size_t)2 * 1024 * 1024 * 2;
    p.wqT = (bf16_t*)wb; wb += (size_t)2 * 1024 * 1024 * 2;
    p.wgT = (bf16_t*)wb; wb += (size_t)2 * 1024 * 1024 * 2;
    p.wpT = (bf16_t*)wb; wb += (size_t)2 * 1024 * 256 * 2;
    p.gluT = (bf16_t*)wb; wb += (size_t)2 * 512 * 256 * 2;
  }
  p.rope = (float*)(ws + 497 * MiB);
  p.ssq = (float*)(ws + 501 * MiB);
  p.xloc = (float*)(ws + 502 * MiB);
  p.lru_hs = (float*)(ws + 504 * MiB);
  p.lru_ps = (float*)(ws + 504 * MiB + 256 * 256 * 4);
  p.g_cdec = (float*)(ws + 504 * MiB + 2 * 256 * 256 * 4);
  p.g_comp = (float*)(ws + 506 * MiB);
  p.pbf = (bf16_t*)(ws + 304 * MiB);
  p.bar = (unsigned*)(ws + 507 * MiB);

  static int grid_blocks = 0;
  if (!grid_blocks) {
#if MEGA
    hipFuncSetAttribute((const void*)k_mega, hipFuncAttributeMaxDynamicSharedMemorySize, LDS_BYTES);
#endif
#if !MEGA
    hipFuncSetAttribute((const void*)k_phase, hipFuncAttributeMaxDynamicSharedMemorySize, LDS_BYTES);
#endif
    int dev = 0, cus = 0, per_cu = 0;
    hipGetDevice(&dev);
    hipDeviceGetAttribute(&cus, hipDeviceAttributeMultiprocessorCount, dev);
#if MEGA
    hipOccupancyMaxActiveBlocksPerMultiprocessor(&per_cu, k_mega, NT, LDS_BYTES);
#else
    hipOccupancyMaxActiveBlocksPerMultiprocessor(&per_cu, k_phase, NT, LDS_BYTES);
#endif
    if (per_cu < 1) per_cu = 1;
    grid_blocks = cus * per_cu;
  }
#if MEGA
  hipMemsetAsync(p.bar, 0, XCD_BAR_WORDS * 4, stream);
  void* args[] = {&p};
  hipError_t e = hipLaunchCooperativeKernel((void*)k_mega, dim3(grid_blocks), dim3(NT), args, LDS_BYTES, stream);
  if (e != hipSuccess) fprintf(stderr, "cooperative launch failed: %s (grid %d)\n", hipGetErrorString(e), grid_blocks);
#else
  k_phase<<<grid_blocks, NT, LDS_BYTES, stream>>>(p, PH_PREP, 0);
  for (int l = 0; l < NL; ++l)
    for (int ph = PH_NORM1; ph <= PH_GEMM_PLE; ++ph) k_phase<<<grid_blocks, NT, LDS_BYTES, stream>>>(p, ph, l);
  k_phase<<<grid_blocks, NT, LDS_BYTES, stream>>>(p, PH_FINAL, 0);
#endif
}
```

```cpp
#include <hip/hip_runtime.h>
#include <hip/hip_bf16.h>
#include <hip/hip_cooperative_groups.h>
#include <cstdio>
#include <cstdint>
namespace cg = cooperative_groups;

#ifndef MEGA
#define MEGA 1
#endif

#ifndef PROBE_A
#define PROBE_A -1
#endif
#ifndef PROBE_B
#define PROBE_B -1
#endif
#define DEVI __device__ __forceinline__

typedef __attribute__((ext_vector_type(8))) short bf16x8;
typedef __attribute__((ext_vector_type(4))) float f32x4;
typedef unsigned short bf16_t;

constexpr int NT = 512;
constexpr int S_ = 16384, DM = 1024, NL = 2, PW = 2944, INW = 2824;
constexpr int RQ = 0, RK = 256, RV = 512, RG = 768, LG = 1024, LX = 1280, SU = 1536, DQ = 1792,
              DB = 2560, DA = 2564, DG = 2568;
constexpr float EPS = 1e-6f;
constexpr int LDS_BYTES = 132 * 1024;

struct Params {
  const float *x, *p; const int* pos;
  const float *mix_norm, *w_in, *ret_gn, *lru_conv_w, *lru_conv_b, *lru_w_a, *lru_b_a, *lru_w_x, *lru_b_x, *lru_lambda;
  const float *s5_a_re, *s5_a_im, *s5_b_re, *s5_b_im, *s5_c_re, *s5_c_im, *s5_d, *s5_log_dt, *s5_glu_w, *s5_glu_b;
  const float *gdn_conv_w, *gdn_a_log, *gdn_dt_bias, *gdn_norm, *branch_norm, *w_out, *ffn_norm, *peer_wq, *peer_subkeys;
  const float *peer_u, *peer_v, *ple_norm, *ple_wg, *ple_wp, *final_norm;
  float* out;
  float* h; bf16_t* zb; float* proj; float* qbuf; float* scores;
  float *g_u, *g_w, *g_attn, *g_qd, *g_kd, *g_sst, *g_cdec, *g_comp;
  int* ids; float* gates;
  float *lru_h, *lru_p, *lru_hs, *lru_ps;
  float* ret_kv; float* xloc;
  uint8_t *tabU, *tabV; float *uinv, *vinv;
  bf16_t *winT, *woutT, *wqT, *wgT, *wpT, *gluT;
  float* rope; float* ssq; bf16_t* pbf; unsigned* bar;
};

DEVI int TID() { int t = __builtin_amdgcn_workitem_id_x(); asm volatile("" : "+v"(t)); return t; }
DEVI bf16_t f2bf(float f) { unsigned u = __float_as_uint(f); u += 0x7FFFu + ((u >> 16) & 1u); return (bf16_t)(u >> 16); }
DEVI float bf2f(bf16_t b) { return __uint_as_float(((unsigned)b) << 16); }
DEVI unsigned pack2(float a, float b) { return (unsigned)f2bf(a) | ((unsigned)f2bf(b) << 16); }
DEVI float sigmoidf_(float x) { return __fdividef(1.f, 1.f + __expf(-x)); }
DEVI float siluf_(float x) { return x * __fdividef(1.f, 1.f + __expf(-x)); }
DEVI float geluf_ref_(float x) { float u = 0.7978845608028654f * (x + 0.044715f * x * x * x); return 0.5f * x * (1.f + tanhf(u)); }
DEVI float geluf_(float x) { float u = 0.7978845608028654f * (x + 0.044715f * x * x * x); return x * __fdividef(1.f, 1.f + __expf(-2.f * u)); }
DEVI float softplusf_(float x) { return x > 20.f ? x : log1pf(expf(x)); }
DEVI float wave_sum(float v) {
  v += __shfl_xor(v, 32); v += __shfl_xor(v, 16); v += __shfl_xor(v, 8);
  v += __shfl_xor(v, 4); v += __shfl_xor(v, 2); v += __shfl_xor(v, 1); return v;
}
DEVI float sum16(float v) {
  v += __shfl_xor(v, 8); v += __shfl_xor(v, 4); v += __shfl_xor(v, 2); v += __shfl_xor(v, 1); return v;
}

template <int NTL>
DEVI void mm16(f32x4 (&acc)[NTL], const float* A, int sam, int sak, const float* B, int sbk, int sbn, int K) {
  const int l = TID() & 63, r = l & 15, q = l >> 4;
  const float* ap = A + r * sam + q * sak;
  const float* bp = B + q * sbk + r * sbn;
#pragma unroll 4
  for (int k = 0; k < K; k += 4) {
    float a = ap[k * sak];
#pragma unroll
    for (int t = 0; t < NTL; ++t) {
      float b = bp[k * sbk + t * 16 * sbn];
      acc[t] = __builtin_amdgcn_mfma_f32_16x16x4f32(a, b, acc[t], 0, 0, 0);
    }
  }
}

template <int NTL>
DEVI void mm16_gB64(f32x4 (&acc)[NTL], const float* A, int sam, const float* __restrict__ Bg) {
  const int l = TID() & 63, r = l & 15, q = l >> 4;
  float bv[16][NTL];
#pragma unroll
  for (int k = 0; k < 16; ++k)
#pragma unroll
    for (int t = 0; t < NTL; ++t) bv[k][t] = Bg[(4 * k + q) * 64 + t * 16 + r];
#pragma unroll
  for (int k = 0; k < 16; ++k) {
    const float a = A[r * sam + 4 * k + q];
#pragma unroll
    for (int t = 0; t < NTL; ++t) acc[t] = __builtin_amdgcn_mfma_f32_16x16x4f32(a, bv[k][t], acc[t], 0, 0, 0);
  }
}

template <int AMODE, int NK>
DEVI void gemm_tile(f32x4 (&acc)[4][4], const void* Aptr, int lda, const bf16_t* Bt, int ldb, int K, int m0, int n0,
                    const float* ssq, char* smem) {
  constexpr int LDT = 72, BUF = (256 + 128) * LDT;
  bf16_t* sbase = (bf16_t*)smem;
  const int tid = TID(), lane = tid & 63, wave = tid >> 6;
  const int wm = wave >> 1, wn = wave & 1, r = lane & 15, q = lane >> 4;
  const int lrow = tid >> 3, lkc = tid & 7;
  uint4 raS00, raS01, raS02, raS03, rbS00, rbS01, raS10, raS11, raS12, raS13, rbS10, rbS11, raS20, raS21, raS22, raS23, rbS20, rbS21;
  float rs0 = 1.f, rs1 = 1.f, rs2 = 1.f, rs3 = 1.f;
#pragma unroll
  for (int i = 0; i < 4; ++i)
#pragma unroll
    for (int j = 0; j < 4; ++j) acc[i][j] = f32x4{0.f, 0.f, 0.f, 0.f};
  const bf16_t* Ab = (const bf16_t*)Aptr + (size_t)(m0 + lrow) * lda + lkc * 8;
  const bf16_t* Bb = Bt + (size_t)(n0 + lrow) * ldb + lkc * 8;
#define GL(S, k0_)                                                    \
  {                                                                   \
    ra##S##0 = *(const uint4*)(Ab + (k0_));                           \
    ra##S##1 = *(const uint4*)(Ab + (size_t)64 * lda + (k0_));        \
    ra##S##2 = *(const uint4*)(Ab + (size_t)128 * lda + (k0_));       \
    ra##S##3 = *(const uint4*)(Ab + (size_t)192 * lda + (k0_));       \
    rb##S##0 = *(const uint4*)(Bb + (k0_));                           \
    rb##S##1 = *(const uint4*)(Bb + (size_t)64 * ldb + (k0_));        \
  }
  auto scale = [&](uint4 v, float s) {
    unsigned w[4] = {v.x, v.y, v.z, v.w};
#pragma unroll
    for (int j = 0; j < 4; ++j) {
      float lo = __uint_as_float(w[j] << 16) * s, hi = __uint_as_float(w[j] & 0xFFFF0000u) * s;
      w[j] = pack2(lo, hi);
    }
    return uint4{w[0], w[1], w[2], w[3]};
  };
  auto rowscale = [&](int row, int k0) {
    const float* sp = ssq + (size_t)(m0 + row) * 16;
    int seg = k0 >> 8;
    float s = seg == 0 ? (sp[0] + sp[1] + sp[2] + sp[3]) : seg == 1 ? sp[4] : seg == 2 ? sp[5] : (sp[8] + sp[9] + sp[10] + sp[11]);
    return rsqrtf(s * (1.f / 256.f) + EPS);
  };
#define LS(S, k0_, bi_)                                                               \
  {                                                                                   \
    bf16_t* As_ = sbase + (bi_) * BUF; bf16_t* Bs_ = As_ + 256 * LDT;                 \
    if constexpr (AMODE == 1) {                                                       \
      if (((k0_) & 255) == 0) {                                                       \
        rs0 = rowscale(lrow, (k0_)); rs1 = rowscale(lrow + 64, (k0_));                \
        rs2 = rowscale(lrow + 128, (k0_)); rs3 = rowscale(lrow + 192, (k0_));         \
      }                                                                               \
      ra##S##0 = scale(ra##S##0, rs0); ra##S##1 = scale(ra##S##1, rs1);               \
      ra##S##2 = scale(ra##S##2, rs2); ra##S##3 = scale(ra##S##3, rs3);               \
    }                                                                                 \
    *(uint4*)&As_[(lrow) * LDT + lkc * 8] = ra##S##0;                                 \
    *(uint4*)&As_[(lrow + 64) * LDT + lkc * 8] = ra##S##1;                            \
    *(uint4*)&As_[(lrow + 128) * LDT + lkc * 8] = ra##S##2;                           \
    *(uint4*)&As_[(lrow + 192) * LDT + lkc * 8] = ra##S##3;                           \
    *(uint4*)&Bs_[(lrow) * LDT + lkc * 8] = rb##S##0;                                 \
    *(uint4*)&Bs_[(lrow + 64) * LDT + lkc * 8] = rb##S##1;                            \
  }
  auto compute = [&](int bi) {
    const bf16_t* As = sbase + bi * BUF; const bf16_t* Bs = As + 256 * LDT;
#pragma unroll
    for (int kk = 0; kk < 2; ++kk) {
      bf16x8 a[4], b[4];
#pragma unroll
      for (int i = 0; i < 4; ++i) a[i] = *(const bf16x8*)&As[(wm * 64 + i * 16 + r) * LDT + kk * 32 + q * 8];
#pragma unroll
      for (int j = 0; j < 4; ++j) b[j] = *(const bf16x8*)&Bs[(wn * 64 + j * 16 + r) * LDT + kk * 32 + q * 8];
#pragma unroll
      for (int i = 0; i < 4; ++i)
#pragma unroll
        for (int j = 0; j < 4; ++j)
          acc[i][j] = __builtin_amdgcn_mfma_f32_16x16x32_bf16(b[j], a[i], acc[i][j], 0, 0, 0);
    }
  };

  __syncthreads();
  if constexpr (NK == 16 && AMODE == 1) {
    GL(S0, 0)
    LS(S0, 0, 0)
    GL(S1, 64)
    __syncthreads();
#pragma unroll 1
    for (int kt = 0; kt < NK; kt += 2) {
      compute(0);
      LS(S1, ((kt + 1) << 6), 1)
      if (kt + 2 < NK) GL(S0, ((kt + 2) << 6))
      __syncthreads();
      compute(1);
      if (kt + 2 < NK) { LS(S0, ((kt + 2) << 6), 0) GL(S1, ((kt + 3) << 6)) }
      __syncthreads();
    }
  } else if constexpr (NK == 16) {
    GL(S0, 0) GL(S1, 64) GL(S2, 128)
    LS(S0, 0, 0)
    GL(S0, 192)
    __syncthreads();
    compute(0);
    LS(S1, 64, 1)
    GL(S1, 256)
    __syncthreads();
    compute(1);
    LS(S2, 128, 0)
    GL(S2, 320)
    __syncthreads();
    compute(0);
    LS(S0, 192, 1)
    GL(S0, 384)
    __syncthreads();
    compute(1);
    LS(S1, 256, 0)
    GL(S1, 448)
    __syncthreads();
    compute(0);
    LS(S2, 320, 1)
    GL(S2, 512)
    __syncthreads();
    compute(1);
    LS(S0, 384, 0)
    GL(S0, 576)
    __syncthreads();
    compute(0);
    LS(S1, 448, 1)
    GL(S1, 640)
    __syncthreads();
    compute(1);
    LS(S2, 512, 0)
    GL(S2, 704)
    __syncthreads();
    compute(0);
    LS(S0, 576, 1)
    GL(S0, 768)
    __syncthreads();
    compute(1);
    LS(S1, 640, 0)
    GL(S1, 832)
    __syncthreads();
    compute(0);
    LS(S2, 704, 1)
    GL(S2, 896)
    __syncthreads();
    compute(1);
    LS(S0, 768, 0)
    GL(S0, 960)
    __syncthreads();
    compute(0);
    LS(S1, 832, 1)
    __syncthreads();
    compute(1);
    LS(S2, 896, 0)
    __syncthreads();
    compute(0);
    LS(S0, 960, 1)
    __syncthreads();
    compute(1);
    __syncthreads();
  } else {
    GL(S0, 0) GL(S1, 64) GL(S2, 128)
    LS(S0, 0, 0)
    GL(S0, 192)
    __syncthreads();
    compute(0);
    LS(S1, 64, 1)
    __syncthreads();
    compute(1);
    LS(S2, 128, 0)
    __syncthreads();
    compute(0);
    LS(S0, 192, 1)
    __syncthreads();
    compute(1);
    __syncthreads();
  }
#undef GL
#undef LS
}
#define GEMM_EPI_COORDS                                                   \
  const int lane_ = TID() & 63, wave_ = TID() >> 6;           \
  const int erow0 = m0 + (wave_ >> 1) * 64 + (lane_ & 15);                \
  const int ecol0 = n0 + (wave_ & 1) * 64 + (lane_ >> 4) * 4;

DEVI void transpose_tile(const float* W, int ldw, int nvalid, bf16_t* Bt, int ldbt, int k0, int n0, char* smem) {
  float* t = (float*)smem;
  const int tid = TID();
  {
    int i = tid >> 4, j4 = tid & 15;
#pragma unroll
    for (int h2 = 0; h2 < 2; ++h2) {
      int kk = i + 32 * h2;
      int n = n0 + j4 * 4;
      float4 v = float4{0.f, 0.f, 0.f, 0.f};
      if (n < nvalid) v = *(const float4*)&W[(size_t)(k0 + kk) * ldw + n];
      t[(j4 * 4 + 0) * 65 + kk] = v.x; t[(j4 * 4 + 1) * 65 + kk] = v.y;
      t[(j4 * 4 + 2) * 65 + kk] = v.z; t[(j4 * 4 + 3) * 65 + kk] = v.w;
    }
  }
  __syncthreads();
  {
    int n = tid >> 3, k8 = tid & 7;
    const float* s = &t[n * 65 + k8 * 8];
    uint4 v;
    v.x = pack2(s[0], s[1]); v.y = pack2(s[2], s[3]); v.z = pack2(s[4], s[5]); v.w = pack2(s[6], s[7]);
    *(uint4*)&Bt[(size_t)(n0 + n) * ldbt + k0 + k8 * 8] = v;
  }
  __syncthreads();
}

DEVI void convert_tables(const Params& p, int l) {
  const int lane = TID() & 63, wave = TID() >> 6;
  const int nw = gridDim.x * 8, gw = blockIdx.x * 8 + wave;
  for (int r0 = gw; r0 < 2 * 16384; r0 += 4 * nw) {
    float4 va[4], vb[4], vc[4], vd[4];
#pragma unroll
    for (int k = 0; k < 4; ++k) {
      const int rr = r0 + k * nw;
      if (rr < 2 * 16384) {
        const int which = rr >> 14, row = rr & 16383;
        const float* s = (which ? p.peer_v : p.peer_u) + ((size_t)l * 16384 + row) * 1024 + lane * 16;
        va[k] = *(const float4*)s; vb[k] = *(const float4*)(s + 4); vc[k] = *(const float4*)(s + 8); vd[k] = *(const float4*)(s + 12);
      }
    }
#pragma unroll
    for (int k = 0; k < 4; ++k) {
      const int rr = r0 + k * nw;
      if (rr < 2 * 16384) {
        const int which = rr >> 14, row = rr & 16383;
        const float4 a = va[k], b = vb[k], c = vc[k], d = vd[k];
        float m = fmaxf(fmaxf(fmaxf(fabsf(a.x), fabsf(a.y)), fmaxf(fabsf(a.z), fabsf(a.w))),
                        fmaxf(fmaxf(fabsf(b.x), fabsf(b.y)), fmaxf(fabsf(b.z), fabsf(b.w))));
        m = fmaxf(m, fmaxf(fmaxf(fmaxf(fabsf(c.x), fabsf(c.y)), fmaxf(fabsf(c.z), fabsf(c.w))),
                           fmaxf(fmaxf(fabsf(d.x), fabsf(d.y)), fmaxf(fabsf(d.z), fabsf(d.w)))));
        m = fmaxf(m, __shfl_xor(m, 32)); m = fmaxf(m, __shfl_xor(m, 16)); m = fmaxf(m, __shfl_xor(m, 8));
        m = fmaxf(m, __shfl_xor(m, 4)); m = fmaxf(m, __shfl_xor(m, 2)); m = fmaxf(m, __shfl_xor(m, 1));
        const float sc = m > 0.f ? 256.f / m : 1.f;
        int w0 = 0, w1 = 0, w2 = 0, w3 = 0;
        w0 = __builtin_amdgcn_cvt_pk_fp8_f32(a.x * sc, a.y * sc, w0, false); w0 = __builtin_amdgcn_cvt_pk_fp8_f32(a.z * sc, a.w * sc, w0, true);
        w1 = __builtin_amdgcn_cvt_pk_fp8_f32(b.x * sc, b.y * sc, w1, false); w1 = __builtin_amdgcn_cvt_pk_fp8_f32(b.z * sc, b.w * sc, w1, true);
        w2 = __builtin_amdgcn_cvt_pk_fp8_f32(c.x * sc, c.y * sc, w2, false); w2 = __builtin_amdgcn_cvt_pk_fp8_f32(c.z * sc, c.w * sc, w2, true);
        w3 = __builtin_amdgcn_cvt_pk_fp8_f32(d.x * sc, d.y * sc, w3, false); w3 = __builtin_amdgcn_cvt_pk_fp8_f32(d.z * sc, d.w * sc, w3, true);
        *(uint4*)((which ? p.tabV : p.tabU) + (size_t)row * 1024 + lane * 16) = uint4{(unsigned)w0, (unsigned)w1, (unsigned)w2, (unsigned)w3};
        if (lane == 0) (which ? p.vinv : p.uinv)[row] = m > 0.f ? m * (1.f / 256.f) : 1.f;
      }
    }
  }
}

DEVI void ph_prep(const Params& p, char* smem) {
  const size_t gtid = (size_t)blockIdx.x * NT + TID(), gsz = (size_t)gridDim.x * NT;
  for (size_t i = gtid; i < (size_t)S_ * 32; i += gsz) {
    int t = (int)(i >> 5), f = (int)(i & 31);
    float inv = powf(10000.f, -(float)f / 32.f);
    float ang = (float)p.pos[t] * inv;
    p.rope[2 * i] = cosf(ang); p.rope[2 * i + 1] = sinf(ang);
  }
  for (int it = blockIdx.x; it < 2 * 1600; it += gridDim.x) {
    int l = it / 1600, idx = it % 1600;
    if (idx >= 1568) {
      int j = idx - 1568; int kt = j >> 3, nt = j & 7;
      transpose_tile(p.s5_glu_w + (size_t)l * 256 * 512, 512, 512, p.gluT + (size_t)l * 512 * 256, 256, kt * 64, nt * 64, smem);
    } else if (idx < 736) {
      int kt = idx / 46, nt = idx % 46;
      transpose_tile(p.w_in + (size_t)l * 1024 * INW, INW, INW, p.winT + (size_t)l * PW * 1024, 1024, kt * 64, nt * 64, smem);
    } else if (idx < 1504) {
      int j = idx - 736; int which = j >> 8; j &= 255;
      int kt = j >> 4, nt = j & 15;
      const float* src = (which == 0 ? p.w_out : which == 1 ? p.peer_wq : p.ple_wg) + (size_t)l * 1024 * 1024;
      bf16_t* dst = (which == 0 ? p.woutT : which == 1 ? p.wqT : p.wgT) + (size_t)l * 1024 * 1024;
      transpose_tile(src, 1024, 1024, dst, 1024, kt * 64, nt * 64, smem);
    } else {
      int j = idx - 1504; int kt = j >> 4, nt = j & 15;
      transpose_tile(p.ple_wp + (size_t)l * 256 * 1024, 1024, 1024, p.wpT + (size_t)l * 1024 * 256, 256, kt * 64, nt * 64, smem);
    }
  }
}

DEVI void ph_norm(const float* src, const float* g, bf16_t* dst, float* fout) {
  const int lane = TID() & 63, wave = TID() >> 6;
  const int nw = gridDim.x * 8, gw = blockIdx.x * 8 + wave;
  float4 gg[4];
#pragma unroll
  for (int i = 0; i < 4; ++i) gg[i] = *(const float4*)&g[i * 256 + lane * 4];
  for (int t = gw; t < S_; t += 4 * nw) {
    float4 v[4][4];
#pragma unroll
    for (int rr = 0; rr < 4; ++rr) {
      const int tr = t + rr * nw;
      if (tr < S_) {
#pragma unroll
        for (int i = 0; i < 4; ++i) v[rr][i] = *(const float4*)&src[(size_t)tr * DM + i * 256 + lane * 4];
      }
    }
#pragma unroll
    for (int rr = 0; rr < 4; ++rr) {
      const int tr = t + rr * nw;
      if (tr < S_) {
        float ss = 0.f;
#pragma unroll
        for (int i = 0; i < 4; ++i) ss += v[rr][i].x * v[rr][i].x + v[rr][i].y * v[rr][i].y + v[rr][i].z * v[rr][i].z + v[rr][i].w * v[rr][i].w;
        ss = wave_sum(ss);
        const float rs = rsqrtf(ss * (1.f / DM) + EPS);
#pragma unroll
        for (int i = 0; i < 4; ++i) {
          float a = v[rr][i].x * rs * gg[i].x, b = v[rr][i].y * rs * gg[i].y, c = v[rr][i].z * rs * gg[i].z, d = v[rr][i].w * rs * gg[i].w;
          if (dst) *(uint2*)&dst[(size_t)tr * DM + i * 256 + lane * 4] = uint2{pack2(a, b), pack2(c, d)};
          else *(float4*)&fout[(size_t)tr * DM + i * 256 + lane * 4] = float4{a, b, c, d};
        }
      }
    }
  }
}

DEVI void gdn_prep(const Params& p, int l, int item, char* smem) {
  const int c = item >> 2, hd = item & 3, t0 = c * 64;
  float* sq = (float*)smem; float* sk = sq + 64 * 65; float* sv = sk + 64 * 65;
  float* sL = sv + 64 * 65;
  float* sgc = sL + 64 * 68; float* sbeta = sgc + 64;
  const int tid = TID(), lane = tid & 63, wave = tid >> 6, r = lane & 15, qd = lane >> 4;
  const float* cw = p.gdn_conv_w + (size_t)l * 4 * 768;
  {
    const int d = tid & 63, tw = tid >> 6;
#pragma unroll
    for (int which = 0; which < 3; ++which) {
      const int ch = which * 256 + hd * 64 + d;
      const float w0 = cw[ch], w1 = cw[768 + ch], w2 = cw[2 * 768 + ch], w3 = cw[3 * 768 + ch];
      const float* pc = p.proj + DQ + ch;
      float xv[11];
#pragma unroll
      for (int k = 0; k < 11; ++k) {
        const int tt = t0 + 8 * tw - 3 + k;
        const float v = pc[(size_t)(tt < 0 ? 0 : tt) * PW];
        xv[k] = tt < 0 ? 0.f : v;
      }
#pragma unroll
      for (int m = 0; m < 8; ++m) {
        float acc = 0.f;
        acc += w0 * xv[m]; acc += w1 * xv[m + 1]; acc += w2 * xv[m + 2]; acc += w3 * xv[m + 3];
        const float sv_ = siluf_(acc);
        if (which == 0) sq[(8 * tw + m) * 65 + d] = sv_;
        else if (which == 1) sk[(8 * tw + m) * 65 + d] = sv_;
        else sv[(8 * tw + m) * 65 + d] = sv_;
      }
    }
  }
  __syncthreads();
  {
    const int rw = tid >> 2, part = tid & 3, t = rw & 63;
    float* row = (rw < 64 ? sq : sk) + t * 65 + part * 16;
    float s = 0.f;
#pragma unroll
    for (int d = 0; d < 16; ++d) s += row[d] * row[d];
    s += __shfl_xor(s, 1); s += __shfl_xor(s, 2);
    float sc = rsqrtf(s + EPS) * (rw < 64 ? 0.125f : 1.f);
#pragma unroll
    for (int d = 0; d < 16; ++d) row[d] *= sc;
  }
  if (wave == 2) {
    int t = tid - 128;
    float bl = p.proj[(size_t)(t0 + t) * PW + DB + hd];
    float al = p.proj[(size_t)(t0 + t) * PW + DA + hd];
    float la = -__expf(p.gdn_a_log[l * 4 + hd]) * softplusf_(al + p.gdn_dt_bias[l * 4 + hd]);
    for (int off = 1; off < 64; off <<= 1) { float n = __shfl_up(la, off); if (lane >= off) la += n; }
    sgc[t] = la; sbeta[t] = sigmoidf_(bl);
  }
  __syncthreads();
  {
    int mat = wave >> 2, mt = wave & 3;
    f32x4 acc[4];
#pragma unroll
    for (int t = 0; t < 4; ++t) acc[t] = f32x4{0.f, 0.f, 0.f, 0.f};
    mm16<4>(acc, (mat == 0 ? sk : sq) + mt * 16 * 65, 65, 1, sk, 1, 65, 64);
#pragma unroll
    for (int t = 0; t < 4; ++t)
#pragma unroll
      for (int e = 0; e < 4; ++e) {
        int i = mt * 16 + 4 * qd + e, j = t * 16 + r;
        float g = (i >= j) ? __expf(sgc[i] - sgc[j]) : 0.f;
        if (mat == 0) sL[i * 68 + j] = (i > j) ? acc[t][e] * sbeta[i] * g : 0.f;
        else p.g_attn[((size_t)item * 64 + i) * 64 + j] = (i >= j) ? acc[t][e] * g : 0.f;
      }
  }
  __syncthreads();
  if (tid < 128) {
    const bool isv = tid < 64; const int d = tid & 63;
    float X[64];
#pragma unroll
    for (int i = 0; i < 64; ++i) X[i] = 0.f;
    float* dst = (isv ? p.g_u : p.g_w) + (size_t)item * 4096 + d;
#pragma unroll
    for (int i = 0; i < 64; ++i) {
      float bi = sbeta[i];
      float s = isv ? sv[i * 65 + d] * bi : sk[i * 65 + d] * bi * __expf(sgc[i]);
      float s1 = 0.f, s2 = 0.f, s3 = 0.f;
#pragma unroll
      for (int j4 = 0; j4 < (i + 3) / 4; ++j4) {
        float4 lv = *(const float4*)&sL[i * 68 + j4 * 4];
        s -= lv.x * X[j4 * 4 + 0]; s1 -= lv.y * X[j4 * 4 + 1]; s2 -= lv.z * X[j4 * 4 + 2]; s3 -= lv.w * X[j4 * 4 + 3];
      }
      s = (s + s1) + (s2 + s3);
      X[i] = s;
      dst[i * 64] = s;
    }
  } else {
    for (int i2 = tid - 128; i2 < 8192; i2 += 384) {
      int which = i2 >> 12, i = (i2 >> 6) & 63, d = i2 & 63;
      float val = which == 0 ? sq[i * 65 + d] * __expf(sgc[i]) : sk[i * 65 + d] * __expf(sgc[63] - sgc[i]);
      (which == 0 ? p.g_qd : p.g_kd)[(size_t)item * 4096 + i * 64 + d] = val;
    }
    if (tid == 128) p.g_cdec[item] = __expf(sgc[63]);
  }
  __syncthreads();
}

DEVI f32x4 mm16_k64(const float* A, int sam, int sak, const float* B, int sbk, int sbn) {
  const int l = TID() & 63, r = l & 15, q = l >> 4;
  const float* ap = A + r * sam + q * sak;
  const float* bp = B + q * sbk + r * sbn;
  float av[16], bv[16];
#pragma unroll
  for (int k = 0; k < 16; ++k) { av[k] = ap[4 * k * sak]; bv[k] = bp[4 * k * sbk]; }
  f32x4 c0 = f32x4{0.f, 0.f, 0.f, 0.f}, c1 = f32x4{0.f, 0.f, 0.f, 0.f};
#pragma unroll
  for (int k = 0; k < 16; k += 2) {
    c0 = __builtin_amdgcn_mfma_f32_16x16x4f32(av[k], bv[k], c0, 0, 0, 0);
    c1 = __builtin_amdgcn_mfma_f32_16x16x4f32(av[k + 1], bv[k + 1], c1, 0, 0, 0);
  }
  return c0 + c1;
}

template <int MODE>
DEVI void gdn_chain(const Params& p, int hd, int grp, int cb, char* smem) {
  float* base = (float*)smem;
  constexpr int BUFSZ = 64 * 68 * 2 + 64 * 16;
  float* sS = base + 2 * BUFSZ; float* sVN = sS + 1024;
  const int tid = TID(), lane = tid & 63, wave = tid >> 6, r = lane & 15, qd = lane >> 4;
  const bool apart = (MODE == 0) && (cb >= 4);
  const int e0 = (cb & 3) * 16;
  const int c0 = grp * 32;
  float4 pw0, pw1, pkd0, pkd1, pu = float4{0.f, 0.f, 0.f, 0.f};
  const int lr0 = tid >> 4, lc0 = (tid & 15) * 4, lr1 = lr0 + 32;
  const int ur = tid >> 2, uc = (tid & 3) * 4;
#define GLOAD(c_)                                                            \
  {                                                                          \
    size_t b_ = (size_t)((c_) * 4 + hd) * 4096;                              \
    pw0 = *(const float4*)&p.g_w[b_ + lr0 * 64 + lc0];                       \
    pw1 = *(const float4*)&p.g_w[b_ + lr1 * 64 + lc0];                       \
    pkd0 = *(const float4*)&p.g_kd[b_ + lr0 * 64 + lc0];                     \
    pkd1 = *(const float4*)&p.g_kd[b_ + lr1 * 64 + lc0];                     \
    if (tid < 256 && !apart) pu = *(const float4*)&p.g_u[b_ + ur * 64 + e0 + uc]; \
  }
#define LSTORE(bi_)                                                          \
  {                                                                          \
    float* W_ = base + (bi_) * BUFSZ; float* KD_ = W_ + 64 * 68; float* U_ = KD_ + 64 * 68; \
    *(float4*)&W_[lr0 * 68 + lc0] = pw0; *(float4*)&W_[lr1 * 68 + lc0] = pw1;       \
    *(float4*)&KD_[lr0 * 68 + lc0] = pkd0; *(float4*)&KD_[lr1 * 68 + lc0] = pkd1;   \
    if (tid < 256) *(float4*)&U_[ur * 16 + uc] = pu;                         \
  }
  f32x4 sreg = f32x4{0.f, 0.f, 0.f, 0.f};
  if (MODE == 0) {
    for (int i = tid; i < 1024; i += NT) sS[i] = (apart && ((i >> 4) == e0 + (i & 15))) ? 1.f : 0.f;
    if (apart) {
#pragma unroll
      for (int e = 0; e < 4; ++e) sreg[e] = ((wave & 3) * 16 + 4 * qd + e == e0 + r) ? 1.f : 0.f;
    }
  } else {
    for (int i = tid; i < 1024; i += NT) sS[i] = 0.f;
    float* W = base;
    for (int g2 = 0; g2 < grp; ++g2) {
      const float* Ag = p.g_comp + ((size_t)(hd * 8 + g2) * 2 + 1) * 4096;
      const float* Bg = p.g_comp + ((size_t)(hd * 8 + g2) * 2 + 0) * 4096;
      __syncthreads();
      *(float4*)&W[lr0 * 68 + lc0] = *(const float4*)&Ag[lr0 * 64 + lc0];
      *(float4*)&W[lr1 * 68 + lc0] = *(const float4*)&Ag[lr1 * 64 + lc0];
      __syncthreads();
      f32x4 a = f32x4{0.f, 0.f, 0.f, 0.f};
      if (wave < 4) a = mm16_k64(W + wave * 16 * 68, 68, 1, sS, 16, 1);
      __syncthreads();
      if (wave < 4) {
#pragma unroll
        for (int e = 0; e < 4; ++e) {
          int d = wave * 16 + 4 * qd + e;
          sreg[e] = a[e] + Bg[d * 64 + e0 + r];
          sS[d * 16 + r] = sreg[e];
        }
      }
    }
    __syncthreads();
    if (wave < 4) {
#pragma unroll
      for (int e = 0; e < 4; ++e) {
        int d = wave * 16 + 4 * qd + e;
        p.g_sst[(size_t)(c0 * 4 + hd) * 4096 + d * 64 + e0 + r] = sreg[e];
      }
    }
  }
  GLOAD(c0) LSTORE(0)
  __syncthreads();
  for (int cc = 0; cc < 32; ++cc) {
    const int c = c0 + cc;
    if (cc + 1 < 32) GLOAD(c + 1)
    const float cd = p.g_cdec[c * 4 + hd];
    float* W = base + (cc & 1) * BUFSZ; float* KD = W + 64 * 68; float* U = KD + 64 * 68;
    const size_t it = (size_t)(c * 4 + hd);
    if (wave < 4) {
      f32x4 a1 = mm16_k64(W + wave * 16 * 68, 68, 1, sS, 16, 1);
#pragma unroll
      for (int e = 0; e < 4; ++e) {
        int i = wave * 16 + 4 * qd + e;
        float vn = (apart ? 0.f : U[i * 16 + r]) - a1[e];
        sVN[i * 16 + r] = vn;
        if (MODE == 1) p.g_u[it * 4096 + i * 64 + e0 + r] = vn;
      }
    }
    __syncthreads();
    if (wave < 4) {
      f32x4 a2 = mm16_k64(KD + wave * 16, 1, 68, sVN, 16, 1);
#pragma unroll
      for (int e = 0; e < 4; ++e) {
        int d = wave * 16 + 4 * qd + e;
        sreg[e] = sreg[e] * cd + a2[e];
        sS[d * 16 + r] = sreg[e];
        if (MODE == 1 && cc + 1 < 32) p.g_sst[(size_t)((c + 1) * 4 + hd) * 4096 + d * 64 + e0 + r] = sreg[e];
      }
    }
    if (cc + 1 < 32) LSTORE((cc + 1) & 1)
    __syncthreads();
  }
  if (MODE == 0 && wave < 4) {
    float* dst = p.g_comp + ((size_t)(hd * 8 + grp) * 2 + (apart ? 1 : 0)) * 4096;
#pragma unroll
    for (int e = 0; e < 4; ++e) {
      int d = wave * 16 + 4 * qd + e;
      dst[d * 64 + e0 + r] = sreg[e];
    }
  }
  __syncthreads();
}

DEVI void gdn_out(const Params& p, int l, int item, char* smem) {
  const int c = item >> 2, hd = item & 3, t0 = c * 64;
  float* sQD = (float*)smem; float* sS = sQD + 64 * 68; float* sAT = sS + 64 * 68; float* sVN = sAT + 64 * 68;
  const int tid = TID(), lane = tid & 63, wave = tid >> 6, r = lane & 15, qd = lane >> 4;
  const size_t b = (size_t)item * 4096;
#pragma unroll
  for (int idx = tid; idx < 1024; idx += NT) {
    int row = idx >> 4, c4 = idx & 15;
    *(float4*)&sQD[row * 68 + c4 * 4] = *(const float4*)&p.g_qd[b + row * 64 + c4 * 4];
    *(float4*)&sS[row * 68 + c4 * 4] = *(const float4*)&p.g_sst[b + row * 64 + c4 * 4];
    *(float4*)&sAT[row * 68 + c4 * 4] = *(const float4*)&p.g_attn[b + row * 64 + c4 * 4];
    *(float4*)&sVN[row * 68 + c4 * 4] = *(const float4*)&p.g_u[b + row * 64 + c4 * 4];
  }
  __syncthreads();
  const int mt = wave & 3, nh = wave >> 2;
  f32x4 acc[2]; acc[0] = acc[1] = f32x4{0.f, 0.f, 0.f, 0.f};
  mm16<2>(acc, sQD + mt * 16 * 68, 68, 1, sS + nh * 32, 68, 1, 64);
  mm16<2>(acc, sAT + mt * 16 * 68, 68, 1, sVN + nh * 32, 68, 1, 64);
  __syncthreads();
  float* sO = sQD;
#pragma unroll
  for (int t2 = 0; t2 < 2; ++t2)
#pragma unroll
    for (int e = 0; e < 4; ++e) sO[(mt * 16 + 4 * qd + e) * 68 + nh * 32 + t2 * 16 + r] = acc[t2][e];
  __syncthreads();
  {
    int row = tid >> 3, sub = tid & 7, t = t0 + row;
    float o[8], yv[8]; float ss = 0.f;
#pragma unroll
    for (int k = 0; k < 8; ++k) { o[k] = sO[row * 68 + sub * 8 + k]; ss += o[k] * o[k]; }
    ss += __shfl_xor(ss, 1); ss += __shfl_xor(ss, 2); ss += __shfl_xor(ss, 4);
    float rs = rsqrtf(ss * (1.f / 64.f) + EPS);
    float s2 = 0.f;
#pragma unroll
    for (int k = 0; k < 8; ++k) {
      int col = sub * 8 + k;
      float g = p.proj[(size_t)t * PW + DG + hd * 64 + col];
      float y = o[k] * rs * p.gdn_norm[l * 64 + col] * siluf_(g);
      s2 += y * y;
      yv[k] = y * p.branch_norm[(l * 4 + 3) * 256 + hd * 64 + col];
    }
    s2 += __shfl_xor(s2, 1); s2 += __shfl_xor(s2, 2); s2 += __shfl_xor(s2, 4);
    if (sub == 0) p.ssq[(size_t)t * 16 + 8 + hd] = s2;
    *(uint4*)&p.zb[(size_t)t * DM + 768 + hd * 64 + sub * 8] =
        uint4{pack2(yv[0], yv[1]), pack2(yv[2], yv[3]), pack2(yv[4], yv[5]), pack2(yv[6], yv[7])};
  }
  __syncthreads();
}

DEVI void ret_kv(const Params& p, int l, int item, char* smem) {
  const int c = item >> 2, hd = item & 3, t0 = c * 128;
  float* sK = (float*)smem; float* sV = sK + 128 * 65;
  const int tid = TID(), lane = tid & 63, wave = tid >> 6, r = lane & 15, qd = lane >> 4;
  const float lg = logf(1.f - exp2f(-5.f - (float)hd));
#pragma unroll
  for (int i = tid; i < 128 * 32; i += NT) {
    int t = i >> 5, f = i & 31; size_t tt = t0 + t;
    float k1 = p.proj[tt * PW + RK + hd * 64 + f], k2 = p.proj[tt * PW + RK + hd * 64 + 32 + f];
    float cs = p.rope[(tt * 32 + f) * 2], sn = p.rope[(tt * 32 + f) * 2 + 1];
    float dec = __expf(lg * (float)(127 - t));
    sK[t * 65 + f] = (k1 * cs - k2 * sn) * dec;
    sK[t * 65 + 32 + f] = (k2 * cs + k1 * sn) * dec;
  }
#pragma unroll
  for (int i = tid; i < 128 * 64; i += NT) {
    int t = i >> 6, e = i & 63;
    sV[t * 65 + e] = p.proj[(size_t)(t0 + t) * PW + RV + hd * 64 + e];
  }
  __syncthreads();
  const int mt = wave & 3, nh = wave >> 2;
  f32x4 acc[2]; acc[0] = acc[1] = f32x4{0.f, 0.f, 0.f, 0.f};
  mm16<2>(acc, sK + mt * 16, 1, 65, sV + nh * 32, 65, 1, 128);
#pragma unroll
  for (int t2 = 0; t2 < 2; ++t2)
#pragma unroll
    for (int e = 0; e < 4; ++e)
      p.ret_kv[(size_t)item * 4096 + (mt * 16 + 4 * qd + e) * 64 + nh * 32 + t2 * 16 + r] = acc[t2][e];
  __syncthreads();
}

DEVI void ret_out(const Params& p, int l, int item, char* smem) {
  const int c = item >> 2, hd = item & 3, t0 = c * 128;
  float* sQ = (float*)smem; float* sK = sQ + 128 * 65; float* sV = sK + 128 * 65; float* sSt = sV + 128 * 65;
  const int tid = TID(), lane = tid & 63, wave = tid >> 6, r = lane & 15, qd = lane >> 4;
  const float lg = logf(1.f - exp2f(-5.f - (float)hd));
  {
    const float* ssrc = p.ret_kv + (size_t)(c * 4 + hd) * 4096;
#pragma unroll
    for (int j = 0; j < 8; ++j) { int idx = tid + 512 * j; sSt[(idx >> 6) * 65 + (idx & 63)] = ssrc[idx]; }
  }
#pragma unroll
  for (int i = tid; i < 128 * 32; i += NT) {
    int t = i >> 5, f = i & 31; size_t tt = t0 + t;
    float cs = p.rope[(tt * 32 + f) * 2], sn = p.rope[(tt * 32 + f) * 2 + 1];
    float k1 = p.proj[tt * PW + RK + hd * 64 + f], k2 = p.proj[tt * PW + RK + hd * 64 + 32 + f];
    sK[t * 65 + f] = (k1 * cs - k2 * sn);
    sK[t * 65 + 32 + f] = (k2 * cs + k1 * sn);
    float q1 = p.proj[tt * PW + RQ + hd * 64 + f], q2 = p.proj[tt * PW + RQ + hd * 64 + 32 + f];
    sQ[t * 65 + f] = (q1 * cs - q2 * sn) * 0.125f;
    sQ[t * 65 + 32 + f] = (q2 * cs + q1 * sn) * 0.125f;
  }
#pragma unroll
  for (int i = tid; i < 128 * 64; i += NT) {
    int t = i >> 6, e = i & 63;
    sV[t * 65 + e] = p.proj[(size_t)(t0 + t) * PW + RV + hd * 64 + e];
  }
  __syncthreads();
  const int i0 = wave * 16;
  f32x4 sc[8], os[4];
#pragma unroll
  for (int t = 0; t < 8; ++t) sc[t] = f32x4{0.f, 0.f, 0.f, 0.f};
#pragma unroll
  for (int t = 0; t < 4; ++t) os[t] = f32x4{0.f, 0.f, 0.f, 0.f};
  mm16<8>(sc, sQ + i0 * 65, 65, 1, sK, 1, 65, 64);
  mm16<4>(os, sQ + i0 * 65, 65, 1, sSt, 65, 1, 64);
  __syncthreads();
  float* sP = (float*)smem;
#pragma unroll
  for (int t2 = 0; t2 < 8; ++t2)
#pragma unroll
    for (int e = 0; e < 4; ++e) {
      int i = i0 + 4 * qd + e, j = t2 * 16 + r;
      sP[i * 129 + j] = (i >= j) ? sc[t2][e] * __expf(lg * (float)(i - j)) : 0.f;
    }
  __syncthreads();
  f32x4 o[4];
#pragma unroll
  for (int t2 = 0; t2 < 4; ++t2)
#pragma unroll
    for (int e = 0; e < 4; ++e) o[t2][e] = os[t2][e] * __expf(lg * (float)(i0 + 4 * qd + e + 1));
  mm16<4>(o, sP + i0 * 129, 129, 1, sV, 65, 1, 128);
#pragma unroll
  for (int e = 0; e < 4; ++e) {
    int i = i0 + 4 * qd + e; size_t t = t0 + i;
    float sm = sum16(o[0][e] + o[1][e] + o[2][e] + o[3][e]);
    float mu = sm * (1.f / 64.f);
    float vr = 0.f;
#pragma unroll
    for (int t2 = 0; t2 < 4; ++t2) { float dd = o[t2][e] - mu; vr += dd * dd; }
    vr = sum16(vr);
    float rstd = rsqrtf(vr * (1.f / 64.f) + EPS);
    float ss = 0.f;
#pragma unroll
    for (int t2 = 0; t2 < 4; ++t2) {
      int col = hd * 64 + t2 * 16 + r;
      float on = (o[t2][e] - mu) * rstd * p.ret_gn[l * 256 + col];
      float g = p.proj[t * PW + RG + col];
      float y = siluf_(g) * on;
      ss += y * y;
      p.zb[t * DM + col] = f2bf(y * p.branch_norm[(l * 4 + 0) * 256 + col]);
    }
    ss = sum16(ss);
    if (r == 0) p.ssq[t * 16 + hd] = ss;
  }
  __syncthreads();
}

DEVI void lru_local(const Params& p, int l, int c, char* smem) {
  const int t0 = c * 64;
  float* sX = (float*)smem; float* sA = sX + 64 * 257;
  const int tid = TID(), lane = tid & 63, wave = tid >> 6, r = lane & 15, qd = lane >> 4;
  {
    const int ch = tid & 255, half = tid >> 8;
    const float w0 = p.lru_conv_w[(l * 4 + 0) * 256 + ch], w1 = p.lru_conv_w[(l * 4 + 1) * 256 + ch];
    const float w2 = p.lru_conv_w[(l * 4 + 2) * 256 + ch], w3 = p.lru_conv_w[(l * 4 + 3) * 256 + ch];
    const float cb = p.lru_conv_b[l * 256 + ch];
    const float* pc = p.proj + LX + ch;
    float xv[35];
#pragma unroll
    for (int k = 0; k < 35; ++k) {
      const int tt = t0 + 32 * half - 3 + k;
      const float v = pc[(size_t)(tt < 0 ? 0 : tt) * PW];
      xv[k] = tt < 0 ? 0.f : v;
    }
#pragma unroll
    for (int m = 0; m < 32; ++m) {
      float acc = cb;
      acc += w0 * xv[m]; acc += w1 * xv[m + 1]; acc += w2 * xv[m + 2]; acc += w3 * xv[m + 3];
      sX[(32 * half + m) * 257 + ch] = acc;
    }
  }
  __syncthreads();
  for (int pr = 0; pr < 2; ++pr) {
    int pi = wave * 2 + pr, mt = pi & 3, nb = pi >> 2;
    f32x4 ra[4], ri[4];
#pragma unroll
    for (int t = 0; t < 4; ++t) { ra[t] = f32x4{0.f, 0.f, 0.f, 0.f}; ri[t] = f32x4{0.f, 0.f, 0.f, 0.f}; }
    mm16_gB64<4>(ra, sX + mt * 16 * 257 + nb * 64, 257, p.lru_w_a + (size_t)(l * 4 + nb) * 4096);
    mm16_gB64<4>(ri, sX + mt * 16 * 257 + nb * 64, 257, p.lru_w_x + (size_t)(l * 4 + nb) * 4096);
#pragma unroll
    for (int t2 = 0; t2 < 4; ++t2)
#pragma unroll
      for (int e = 0; e < 4; ++e) {
        int t = mt * 16 + 4 * qd + e, ch = nb * 64 + t2 * 16 + r;
        float xb = sX[t * 257 + ch];
        float rr = sigmoidf_(ra[t2][e] + p.lru_b_a[l * 256 + ch]);
        float ii = sigmoidf_(ri[t2][e] + p.lru_b_x[l * 256 + ch]);
        float loga = -8.f * rr * softplusf_(-p.lru_lambda[l * 256 + ch]);
        float a = __expf(loga);
        float bb = __builtin_amdgcn_sqrtf(fmaxf(1.f - a * a, 0.f)) * (ii * xb);
        sA[t * 257 + ch] = a; sX[t * 257 + ch] = bb;
      }
  }
  __syncthreads();
  if (tid < 256) {
    int ch = tid; float H = 0.f, P = 1.f;
    for (int t = 0; t < 64; ++t) {
      float a = sA[t * 257 + ch], bb = sX[t * 257 + ch];
      H = a * H + bb; P *= a;
      p.lru_h[(size_t)(t0 + t) * 256 + ch] = H; p.lru_p[(size_t)(t0 + t) * 256 + ch] = P;
    }
    p.lru_hs[c * 256 + ch] = H; p.lru_ps[c * 256 + ch] = P;
  }
  __syncthreads();
}

DEVI void lru_out(const Params& p, int l, int c, char* smem) {
  const int t0 = c * 64;
  float* sC = (float*)smem;
  const int tid = TID(), lane = tid & 63, wave = tid >> 6;
  if (tid < 256) sC[tid] = p.lru_hs[c * 256 + tid];
  __syncthreads();
  {
    const int ch = lane * 4;
    float4 Hs[8], Ps[8], gs[8];
#pragma unroll
    for (int tk = 0; tk < 8; ++tk) {
      const size_t t = t0 + wave * 8 + tk;
      Hs[tk] = *(const float4*)&p.lru_h[t * 256 + ch]; Ps[tk] = *(const float4*)&p.lru_p[t * 256 + ch];
      gs[tk] = *(const float4*)&p.proj[t * PW + LG + ch];
    }
    const float4 cr = *(const float4*)&sC[ch];
    const float4 bn = *(const float4*)&p.branch_norm[(l * 4 + 1) * 256 + ch];
#pragma unroll
    for (int tk = 0; tk < 8; ++tk) {
      const size_t t = t0 + wave * 8 + tk;
      const float4 H = Hs[tk], P = Ps[tk], g = gs[tk];
      float y0 = geluf_(g.x) * (H.x + P.x * cr.x), y1 = geluf_(g.y) * (H.y + P.y * cr.y);
      float y2 = geluf_(g.z) * (H.z + P.z * cr.z), y3 = geluf_(g.w) * (H.w + P.w * cr.w);
      float ss = wave_sum(y0 * y0 + y1 * y1 + y2 * y2 + y3 * y3);
      if (lane == 0) p.ssq[t * 16 + 4] = ss;
      *(uint2*)&p.zb[t * DM + 256 + ch] = uint2{pack2(y0 * bn.x, y1 * bn.y), pack2(y2 * bn.z, y3 * bn.w)};
    }
  }
  __syncthreads();
}

DEVI void s5_coef(const Params& p, int l, int g, int n, float& abr, float& abi, float (&bbr)[16], float (&bbi)[16]) {
  float dt = __expf(p.s5_log_dt[l * 16 + g]);
  float are = p.s5_a_re[(l * 16 + g) * 64 + n], aim = p.s5_a_im[(l * 16 + g) * 64 + n];
  float mag = __expf(are * dt), ang = aim * dt;
  abr = mag * cosf(ang); abi = mag * sinf(ang);
  float den = are * are + aim * aim;
  float pre = abr - 1.f, pim = abi;
  float fre = (pre * are + pim * aim) / den, fim = (pim * are - pre * aim) / den;
  const float4* br = (const float4*)(p.s5_b_re + (size_t)((l * 16 + g) * 64 + n) * 16);
  const float4* bi = (const float4*)(p.s5_b_im + (size_t)((l * 16 + g) * 64 + n) * 16);
#pragma unroll
  for (int c4 = 0; c4 < 4; ++c4) {
    float4 a = br[c4], b = bi[c4];
    bbr[c4 * 4 + 0] = fre * a.x - fim * b.x; bbi[c4 * 4 + 0] = fre * b.x + fim * a.x;
    bbr[c4 * 4 + 1] = fre * a.y - fim * b.y; bbi[c4 * 4 + 1] = fre * b.y + fim * a.y;
    bbr[c4 * 4 + 2] = fre * a.z - fim * b.z; bbi[c4 * 4 + 2] = fre * b.z + fim * a.z;
    bbr[c4 * 4 + 3] = fre * a.w - fim * b.w; bbi[c4 * 4 + 3] = fre * b.w + fim * a.w;
  }
}
DEVI void s5_load_u(const Params& p, int t0, float* sU) {
#pragma unroll
  for (int i = TID(); i < 64 * 64; i += NT) {
    int t = i >> 6, c4 = i & 63;
    *(float4*)&sU[t * 256 + c4 * 4] = *(const float4*)&p.proj[(size_t)(t0 + t) * PW + SU + c4 * 4];
  }
}
DEVI void s5_bu(const float* up, const float (&bbr)[16], const float (&bbi)[16], float& bur, float& bui) {
  bur = 0.f; bui = 0.f;
#pragma unroll
  for (int c4 = 0; c4 < 4; ++c4) {
    float4 u = *(const float4*)&up[c4 * 4];
    bur += bbr[c4 * 4] * u.x + bbr[c4 * 4 + 1] * u.y + bbr[c4 * 4 + 2] * u.z + bbr[c4 * 4 + 3] * u.w;
    bui += bbi[c4 * 4] * u.x + bbi[c4 * 4 + 1] * u.y + bbi[c4 * 4 + 2] * u.z + bbi[c4 * 4 + 3] * u.w;
  }
}

DEVI void s5_local(const Params& p, int l, int c, char* smem) {
  const int t0 = c * 64;
  float* sU = (float*)smem;
  const int lane = TID() & 63, wave = TID() >> 6;
  s5_load_u(p, t0, sU);
  __syncthreads();
  for (int gi = 0; gi < 2; ++gi) {
    int g = wave + 8 * gi;
    float abr, abi, bbr[16], bbi[16];
    s5_coef(p, l, g, lane, abr, abi, bbr, bbi);
    float xr = 0.f, xi = 0.f;
    for (int t = 0; t < 64; ++t) {
      float bur, bui; s5_bu(sU + t * 256 + g * 16, bbr, bbi, bur, bui);
      float nr = abr * xr - abi * xi + bur, ni = abr * xi + abi * xr + bui;
      xr = nr; xi = ni;
    }
    *(float2*)&p.xloc[((size_t)(c * 16 + g) * 64 + lane) * 2] = float2{xr, xi};
  }
  __syncthreads();
}

DEVI void s5_out(const Params& p, int l, int c, char* smem) {
  const int t0 = c * 64;
  bf16_t* sY = (bf16_t*)smem;
  float* sX = (float*)(smem + 64 * 264 * 2);
  const int tid = TID(), lane = tid & 63, wave = tid >> 6, r = lane & 15, qd = lane >> 4;
  float* Xl = sX + wave * (16 * 132);
  for (int gi = 0; gi < 2; ++gi) {
    const int g = wave + 8 * gi;
    float abr, abi, bbr[16], bbi[16];
    s5_coef(p, l, g, lane, abr, abi, bbr, bbi);
    float breg[32];
#pragma unroll
    for (int ks = 0; ks < 16; ++ks) {
      breg[ks] = p.s5_c_re[(size_t)((l * 16 + g) * 16 + r) * 64 + 4 * ks + qd];
      breg[16 + ks] = -p.s5_c_im[(size_t)((l * 16 + g) * 16 + r) * 64 + 4 * ks + qd];
    }
    const float dd = p.s5_d[l * 256 + g * 16 + r];
    const float2 xin = *(const float2*)&p.xloc[((size_t)(c * 16 + g) * 64 + lane) * 2];
    float xr = xin.x, xi = xin.y;
    float4 uvecs[4]; float ues[4][4];
#pragma unroll
    for (int tb = 0; tb < 4; ++tb) {
      const float* ub = p.proj + (size_t)(t0 + tb * 16) * PW + SU + g * 16;
      uvecs[tb] = *(const float4*)&ub[(size_t)r * PW + 4 * qd];
#pragma unroll
      for (int e = 0; e < 4; ++e) ues[tb][e] = ub[(size_t)(4 * qd + e) * PW + r];
    }
#pragma unroll
    for (int tb = 0; tb < 4; ++tb) {
      const float4 uvec = uvecs[tb];
      float ue[4];
#pragma unroll
      for (int e = 0; e < 4; ++e) ue[e] = ues[tb][e];
      const int u0 = __float_as_int(uvec.x), u1 = __float_as_int(uvec.y), u2 = __float_as_int(uvec.z), u3 = __float_as_int(uvec.w);
#pragma unroll
      for (int tt = 0; tt < 16; ++tt) {
        float bur = 0.f, bui = 0.f;
#pragma unroll
        for (int c4 = 0; c4 < 4; ++c4) {
          float a0 = __int_as_float(__builtin_amdgcn_readlane(u0, tt + 16 * c4));
          float a1 = __int_as_float(__builtin_amdgcn_readlane(u1, tt + 16 * c4));
          float a2 = __int_as_float(__builtin_amdgcn_readlane(u2, tt + 16 * c4));
          float a3 = __int_as_float(__builtin_amdgcn_readlane(u3, tt + 16 * c4));
          bur += bbr[c4 * 4] * a0 + bbr[c4 * 4 + 1] * a1 + bbr[c4 * 4 + 2] * a2 + bbr[c4 * 4 + 3] * a3;
          bui += bbi[c4 * 4] * a0 + bbi[c4 * 4 + 1] * a1 + bbi[c4 * 4 + 2] * a2 + bbi[c4 * 4 + 3] * a3;
        }
        float nr = abr * xr - abi * xi + bur, ni = abr * xi + abi * xr + bui;
        xr = nr; xi = ni;
        Xl[tt * 132 + lane] = xr; Xl[tt * 132 + 64 + lane] = xi;
      }
      f32x4 acc = f32x4{0.f, 0.f, 0.f, 0.f};
#pragma unroll
      for (int ks = 0; ks < 32; ++ks) {
        float a = Xl[r * 132 + 4 * ks + qd];
        acc = __builtin_amdgcn_mfma_f32_16x16x4f32(a, breg[ks], acc, 0, 0, 0);
      }
#pragma unroll
      for (int e = 0; e < 4; ++e) {
        float y = acc[e] + dd * ue[e];
        sY[(tb * 16 + 4 * qd + e) * 264 + g * 16 + r] = f2bf(geluf_(y));
      }
    }
  }
  __syncthreads();
  f32x4 av[4][2], ag[4][2];
#pragma unroll
  for (int i = 0; i < 4; ++i)
#pragma unroll
    for (int j = 0; j < 2; ++j) { av[i][j] = f32x4{0.f, 0.f, 0.f, 0.f}; ag[i][j] = f32x4{0.f, 0.f, 0.f, 0.f}; }
  const bf16_t* WT = p.gluT + (size_t)l * 512 * 256;
#pragma unroll 4
  for (int ks = 0; ks < 8; ++ks) {
    bf16x8 bv0 = *(const bf16x8*)&WT[(size_t)(32 * wave + r) * 256 + ks * 32 + qd * 8];
    bf16x8 bv1 = *(const bf16x8*)&WT[(size_t)(32 * wave + 16 + r) * 256 + ks * 32 + qd * 8];
    bf16x8 bg0 = *(const bf16x8*)&WT[(size_t)(256 + 32 * wave + r) * 256 + ks * 32 + qd * 8];
    bf16x8 bg1 = *(const bf16x8*)&WT[(size_t)(256 + 32 * wave + 16 + r) * 256 + ks * 32 + qd * 8];
#pragma unroll
    for (int mt = 0; mt < 4; ++mt) {
      bf16x8 a = *(const bf16x8*)&sY[(mt * 16 + r) * 264 + ks * 32 + qd * 8];
      av[mt][0] = __builtin_amdgcn_mfma_f32_16x16x32_bf16(a, bv0, av[mt][0], 0, 0, 0);
      av[mt][1] = __builtin_amdgcn_mfma_f32_16x16x32_bf16(a, bv1, av[mt][1], 0, 0, 0);
      ag[mt][0] = __builtin_amdgcn_mfma_f32_16x16x32_bf16(a, bg0, ag[mt][0], 0, 0, 0);
      ag[mt][1] = __builtin_amdgcn_mfma_f32_16x16x32_bf16(a, bg1, ag[mt][1], 0, 0, 0);
    }
  }
  float* sO = sX;
#pragma unroll
  for (int mt = 0; mt < 4; ++mt)
#pragma unroll
    for (int t2 = 0; t2 < 2; ++t2)
#pragma unroll
      for (int e = 0; e < 4; ++e) {
        int t = mt * 16 + 4 * qd + e, col = 32 * wave + t2 * 16 + r;
        float zv = av[mt][t2][e] + p.s5_glu_b[l * 512 + col];
        float zg = ag[mt][t2][e] + p.s5_glu_b[l * 512 + 256 + col];
        sO[t * 256 + col] = zv * sigmoidf_(zg);
      }
  __syncthreads();
  for (int tk = 0; tk < 8; ++tk) {
    int tl = wave * 8 + tk; size_t t = t0 + tl; int ch = lane * 4;
    float4 o = *(const float4*)&sO[tl * 256 + ch];
    float4 bn = *(const float4*)&p.branch_norm[(l * 4 + 2) * 256 + ch];
    float ss = wave_sum(o.x * o.x + o.y * o.y + o.z * o.z + o.w * o.w);
    if (lane == 0) p.ssq[t * 16 + 5] = ss;
    *(uint2*)&p.zb[t * DM + 512 + ch] = uint2{pack2(o.x * bn.x, o.y * bn.y), pack2(o.z * bn.z, o.w * bn.w)};
  }
  __syncthreads();
}

DEVI void ret_scan(const Params& p, int it) {
  const int elem = it * NT + TID(), hd = elem >> 12, idx = elem & 4095;
  const float lg = logf(1.f - exp2f(-5.f - (float)hd)), cdk = __expf(lg * 128.f);
  float* base = p.ret_kv + (size_t)hd * 4096 + idx;
  float s = 0.f;
  for (int cb = 0; cb < 128; cb += 16) {
    float v[16];
#pragma unroll
    for (int j = 0; j < 16; ++j) v[j] = base[(size_t)(cb + j) * 16384];
#pragma unroll
    for (int j = 0; j < 16; ++j) { base[(size_t)(cb + j) * 16384] = s; s = s * cdk + v[j]; }
  }
}
DEVI void s5_scan(const Params& p, int l, int it) {
  const int sidx = it * NT + TID(), g = sidx >> 6, n = sidx & 63;
  float dt = __expf(p.s5_log_dt[l * 16 + g]);
  float are = p.s5_a_re[(l * 16 + g) * 64 + n], aim = p.s5_a_im[(l * 16 + g) * 64 + n];
  float mag = __expf(are * dt), ang = aim * dt;
  float pr = mag * cosf(ang), pi = mag * sinf(ang);
#pragma unroll
  for (int k = 0; k < 6; ++k) { float nr = pr * pr - pi * pi, ni = 2.f * pr * pi; pr = nr; pi = ni; }
  float2* base = (float2*)p.xloc + sidx;
  float xr = 0.f, xi = 0.f;
  for (int cb = 0; cb < 256; cb += 16) {
    float2 v[16];
#pragma unroll
    for (int j = 0; j < 16; ++j) v[j] = base[(size_t)(cb + j) * 1024];
#pragma unroll
    for (int j = 0; j < 16; ++j) {
      base[(size_t)(cb + j) * 1024] = float2{xr, xi};
      float nr = pr * xr - pi * xi + v[j].x, ni = pr * xi + pi * xr + v[j].y;
      xr = nr; xi = ni;
    }
  }
}
DEVI void lru_scan(const Params& p) {
  const int ch = TID();
  if (ch < 256) {
    float carry = 0.f;
    for (int cb = 0; cb < 256; cb += 16) {
      float ps[16], hs[16];
#pragma unroll
      for (int j = 0; j < 16; ++j) { ps[j] = p.lru_ps[(cb + j) * 256 + ch]; hs[j] = p.lru_hs[(cb + j) * 256 + ch]; }
#pragma unroll
      for (int j = 0; j < 16; ++j) { p.lru_hs[(cb + j) * 256 + ch] = carry; carry = ps[j] * carry + hs[j]; }
    }
  }
}

DEVI void peer_scores(const Params& p, int l, int item, char* smem) {
  const int hp = item & 15, grp = item >> 4;
  float* sQ = (float*)smem;
  float* sKy = sQ + 64 * 68;
  const int tid = TID(), lane = tid & 63, wave = tid >> 6, r = lane & 15, qd = lane >> 4;
  const float* ky = p.peer_subkeys + (size_t)(l * 16 + hp) * 8192;
#pragma unroll
  for (int i = tid; i < 128 * 64; i += NT) { int k = i >> 6, d = i & 63; sKy[k * 65 + d] = ky[i]; }
  const int lt0 = tid >> 4, lc4 = (tid & 15) * 4;
  const float* qb = p.qbuf + (size_t)hp * 64 + lc4;
  float4 q0, q1;
  {
    const size_t t0 = (size_t)(grp * 16) * 64;
    q0 = *(const float4*)&qb[(t0 + lt0) * 1024]; q1 = *(const float4*)&qb[(t0 + lt0 + 32) * 1024];
  }
  const int mt = wave & 3, nh = wave >> 2;
  for (int k = 0; k < 16; ++k) {
    const size_t t0 = (size_t)(grp * 16 + k) * 64;
    __syncthreads();
    *(float4*)&sQ[lt0 * 68 + lc4] = q0; *(float4*)&sQ[(lt0 + 32) * 68 + lc4] = q1;
    __syncthreads();
    if (k + 1 < 16) { q0 = *(const float4*)&qb[(t0 + 64 + lt0) * 1024]; q1 = *(const float4*)&qb[(t0 + 64 + lt0 + 32) * 1024]; }
    f32x4 acc[4];
#pragma unroll
    for (int t = 0; t < 4; ++t) acc[t] = f32x4{0.f, 0.f, 0.f, 0.f};
    mm16<4>(acc, sQ + mt * 16 * 68, 68, 1, sKy + nh * 64 * 65, 1, 65, 64);
#pragma unroll
    for (int t2 = 0; t2 < 4; ++t2)
#pragma unroll
      for (int e = 0; e < 4; ++e) {
        size_t t = t0 + mt * 16 + 4 * qd + e; int key = nh * 64 + t2 * 16 + r;
        p.scores[(t * 16 + hp) * 128 + key] = acc[t2][e];
      }
  }
  __syncthreads();
}

DEVI unsigned ford(float x) { unsigned u = __float_as_uint(x); return (u & 0x80000000u) ? ~u : (u | 0x80000000u); }
DEVI float funord(unsigned u) { return __uint_as_float((u & 0x80000000u) ? (u ^ 0x80000000u) : ~u); }
DEVI void ins16(unsigned (&v)[16], unsigned x) {
#pragma unroll
  for (int j = 0; j < 16; ++j) { unsigned hi = max(v[j], x); x = min(v[j], x); v[j] = hi; }
}

DEVI void cv_issue(const Params& p, int l, int rr, int lane, float4& a, float4& b, float4& c, float4& d) {
  const int which = rr >> 14, row = rr & 16383;
  const float* s = (which ? p.peer_v : p.peer_u) + ((size_t)l * 16384 + row) * 1024 + lane * 16;
  a = *(const float4*)s; b = *(const float4*)(s + 4); c = *(const float4*)(s + 8); d = *(const float4*)(s + 12);
}
DEVI void cv_finish(const Params& p, int rr, int lane, const float4& a, const float4& b, const float4& c, const float4& d) {
  const int which = rr >> 14, row = rr & 16383;
  float m = fmaxf(fmaxf(fmaxf(fabsf(a.x), fabsf(a.y)), fmaxf(fabsf(a.z), fabsf(a.w))),
                  fmaxf(fmaxf(fabsf(b.x), fabsf(b.y)), fmaxf(fabsf(b.z), fabsf(b.w))));
  m = fmaxf(m, fmaxf(fmaxf(fmaxf(fabsf(c.x), fabsf(c.y)), fmaxf(fabsf(c.z), fabsf(c.w))),
                     fmaxf(fmaxf(fabsf(d.x), fabsf(d.y)), fmaxf(fabsf(d.z), fabsf(d.w)))));
  m = fmaxf(m, __shfl_xor(m, 32)); m = fmaxf(m, __shfl_xor(m, 16)); m = fmaxf(m, __shfl_xor(m, 8));
  m = fmaxf(m, __shfl_xor(m, 4)); m = fmaxf(m, __shfl_xor(m, 2)); m = fmaxf(m, __shfl_xor(m, 1));
  const float sc = m > 0.f ? 256.f / m : 1.f;
  int w0 = 0, w1 = 0, w2 = 0, w3 = 0;
  w0 = __builtin_amdgcn_cvt_pk_fp8_f32(a.x * sc, a.y * sc, w0, false); w0 = __builtin_amdgcn_cvt_pk_fp8_f32(a.z * sc, a.w * sc, w0, true);
  w1 = __builtin_amdgcn_cvt_pk_fp8_f32(b.x * sc, b.y * sc, w1, false); w1 = __builtin_amdgcn_cvt_pk_fp8_f32(b.z * sc, b.w * sc, w1, true);
  w2 = __builtin_amdgcn_cvt_pk_fp8_f32(c.x * sc, c.y * sc, w2, false); w2 = __builtin_amdgcn_cvt_pk_fp8_f32(c.z * sc, c.w * sc, w2, true);
  w3 = __builtin_amdgcn_cvt_pk_fp8_f32(d.x * sc, d.y * sc, w3, false); w3 = __builtin_amdgcn_cvt_pk_fp8_f32(d.z * sc, d.w * sc, w3, true);
  *(uint4*)((which ? p.tabV : p.tabU) + (size_t)row * 1024 + lane * 16) = uint4{(unsigned)w0, (unsigned)w1, (unsigned)w2, (unsigned)w3};
  if (lane == 0) (which ? p.vinv : p.uinv)[row] = m > 0.f ? m * (1.f / 256.f) : 1.f;
}

DEVI void peer_topk(const Params& p, int l, int item, int cvbase, char* smem) {
  const int t0 = item * 64;
  float* sS = (float*)smem;
  const int tid = TID();
  const float* base = p.scores + (size_t)t0 * 8 * 256;
  unsigned v1[16], v2[16];
#pragma unroll
  for (int j = 0; j < 16; ++j) { v1[j] = 0u; v2[j] = 0u; }
  float4 nx[8];
#pragma unroll
  for (int i = 0; i < 8; ++i) { int idx = tid + 512 * i; nx[i] = *(const float4*)&base[(size_t)(idx >> 3) * 256 + (idx & 7) * 4]; }
  for (int s = 0; s < 8; ++s) {
    __syncthreads();
#pragma unroll
    for (int i = 0; i < 8; ++i) {
      int idx = tid + 512 * i, pr = idx >> 3, c4 = idx & 7;
      float* d = &sS[pr * 33 + c4 * 4];
      d[0] = nx[i].x; d[1] = nx[i].y; d[2] = nx[i].z; d[3] = nx[i].w;
    }
    __syncthreads();
    if (s + 1 < 8) {
#pragma unroll
      for (int i = 0; i < 8; ++i) { int idx = tid + 512 * i; nx[i] = *(const float4*)&base[(size_t)(idx >> 3) * 256 + (s + 1) * 32 + (idx & 7) * 4]; }
    }
    float4 ca0, cb0, cc0, cd0, ca1, cb1, cc1, cd1;
    if (cvbase >= 0) {
      cv_issue(p, l, cvbase + 2 * s, tid & 63, ca0, cb0, cc0, cd0);
      cv_issue(p, l, cvbase + 2 * s + 1, tid & 63, ca1, cb1, cc1, cd1);
    }
    const int kb = (s & 3) * 32;
    if (s < 4) {
      for (int k = 0; k < 32; ++k) { unsigned key = (ford(sS[tid * 33 + k]) & ~127u) | (unsigned)(127 - (kb + k)); ins16(v1, key); }
    } else {
      for (int k = 0; k < 32; ++k) { unsigned key = (ford(sS[tid * 33 + k]) & ~127u) | (unsigned)(127 - (kb + k)); ins16(v2, key); }
    }
    if (cvbase >= 0) {
      cv_finish(p, cvbase + 2 * s, tid & 63, ca0, cb0, cc0, cd0);
      cv_finish(p, cvbase + 2 * s + 1, tid & 63, ca1, cb1, cc1, cd1);
    }
  }
  __syncthreads();
  unsigned* sI = (unsigned*)smem;
  float s1[16], s2[16];
#pragma unroll
  for (int a = 0; a < 16; ++a) {
    s1[a] = funord(v1[a] & ~127u); s2[a] = funord(v2[a] & ~127u);
    sI[tid * 33 + a] = 127u - (v1[a] & 127u); sI[tid * 33 + 16 + a] = 127u - (v2[a] & 127u);
  }
  unsigned vt[16];
#pragma unroll
  for (int j = 0; j < 16; ++j) vt[j] = 0u;
#pragma unroll
  for (int a = 0; a < 16; ++a)
#pragma unroll
    for (int b = 0; b < 16; ++b)
      if ((a + 1) * (b + 1) <= 16) {
        unsigned key = (ford(s1[a] + s2[b]) & ~255u) | (unsigned)(255 - (a * 16 + b));
        ins16(vt, key);
      }
  float sv[16]; float den = 0.f;
  const float mx = funord(vt[0] & ~255u);
#pragma unroll
  for (int k = 0; k < 16; ++k) { sv[k] = __expf(funord(vt[k] & ~255u) - mx); den += sv[k]; }
  const float inv = 1.f / den;
  const int tl = tid >> 3, hh = tid & 7;
  int* idp = p.ids + (size_t)(t0 + tl) * 128 + hh * 16;
  float* gp = p.gates + (size_t)(t0 + tl) * 128 + hh * 16;
#pragma unroll
  for (int k = 0; k < 16; ++k) {
    unsigned pos = 255u - (vt[k] & 255u);
    unsigned i1 = sI[tid * 33 + (pos >> 4)], i2 = sI[tid * 33 + 16 + (pos & 15)];
    idp[k] = (int)(i1 * 128u + i2);
    gp[k] = sv[k] * inv;
  }
  __syncthreads();
}

typedef __attribute__((ext_vector_type(2))) float f32x2;
DEVI void fp8x16_to_f(const uint4& v, float (&o)[16]) {
  f32x2 t;
  t = __builtin_amdgcn_cvt_pk_f32_fp8((int)v.x, false); o[0] = t[0]; o[1] = t[1];
  t = __builtin_amdgcn_cvt_pk_f32_fp8((int)v.x, true); o[2] = t[0]; o[3] = t[1];
  t = __builtin_amdgcn_cvt_pk_f32_fp8((int)v.y, false); o[4] = t[0]; o[5] = t[1];
  t = __builtin_amdgcn_cvt_pk_f32_fp8((int)v.y, true); o[6] = t[0]; o[7] = t[1];
  t = __builtin_amdgcn_cvt_pk_f32_fp8((int)v.z, false); o[8] = t[0]; o[9] = t[1];
  t = __builtin_amdgcn_cvt_pk_f32_fp8((int)v.z, true); o[10] = t[0]; o[11] = t[1];
  t = __builtin_amdgcn_cvt_pk_f32_fp8((int)v.w, false); o[12] = t[0]; o[13] = t[1];
  t = __builtin_amdgcn_cvt_pk_f32_fp8((int)v.w, true); o[14] = t[0]; o[15] = t[1];
}

DEVI void ph_gather(const Params& p, int l) {
  const int lane = TID() & 63, wave = TID() >> 6;
  const int e0 = lane * 16;
  constexpr int NB = 8;
  for (int t = blockIdx.x * 8 + wave; t < S_; t += gridDim.x * 8) {
    float* hrow = p.h + (size_t)t * DM + e0;
    float z[16], out[16];
    {
      float4 a = *(const float4*)&hrow[0], b = *(const float4*)&hrow[4], c = *(const float4*)&hrow[8], d = *(const float4*)&hrow[12];
      z[0] = a.x; z[1] = a.y; z[2] = a.z; z[3] = a.w; z[4] = b.x; z[5] = b.y; z[6] = b.z; z[7] = b.w;
      z[8] = c.x; z[9] = c.y; z[10] = c.z; z[11] = c.w; z[12] = d.x; z[13] = d.y; z[14] = d.z; z[15] = d.w;
    }
    float ss = 0.f;
#pragma unroll
    for (int k = 0; k < 16; ++k) { ss += z[k] * z[k]; out[k] = 0.f; }
    ss = wave_sum(ss);
    const float rs = rsqrtf(ss * (1.f / DM) + EPS);
    const float* fn = p.ffn_norm + l * DM + e0;
#pragma unroll
    for (int k = 0; k < 16; ++k) z[k] = z[k] * rs * fn[k];
    const int id0 = p.ids[(size_t)t * 128 + lane], id1 = p.ids[(size_t)t * 128 + 64 + lane];
    const int gv0 = __float_as_int(p.gates[(size_t)t * 128 + lane] * p.vinv[id0]);
    const int gv1 = __float_as_int(p.gates[(size_t)t * 128 + 64 + lane] * p.vinv[id1]);
    const int us0 = __float_as_int(p.uinv[id0]), us1 = __float_as_int(p.uinv[id1]);
    uint4 cu[NB], cv[NB], nu[NB], nv[NB];
#pragma unroll
    for (int j = 0; j < NB; ++j) {
      int e = __builtin_amdgcn_readlane(id0, j);
      cu[j] = *(const uint4*)(p.tabU + (size_t)e * 1024 + e0);
      cv[j] = *(const uint4*)(p.tabV + (size_t)e * 1024 + e0);
    }
#pragma unroll 1
    for (int b = 0; b < 128 / NB; ++b) {
      const int nb = b + 1;
      if (nb < 128 / NB) {
        const int idn = nb < 64 / NB ? id0 : id1;
#pragma unroll
        for (int j = 0; j < NB; ++j) {
          int e = __builtin_amdgcn_readlane(idn, (nb * NB + j) & 63);
          nu[j] = *(const uint4*)(p.tabU + (size_t)e * 1024 + e0);
          nv[j] = *(const uint4*)(p.tabV + (size_t)e * 1024 + e0);
        }
      }
      const int gvc = b < 64 / NB ? gv0 : gv1, usc = b < 64 / NB ? us0 : us1;
      float dot[NB];
#pragma unroll
      for (int j = 0; j < NB; ++j) {
        float f[16]; fp8x16_to_f(cu[j], f);
        float d = 0.f;
#pragma unroll
        for (int k = 0; k < 16; ++k) d += z[k] * f[k];
        dot[j] = d;
      }
#pragma unroll
      for (int j = 0; j < NB; ++j) dot[j] = wave_sum(dot[j]);
#pragma unroll
      for (int j = 0; j < NB; ++j) {
        const int li = (b * NB + j) & 63;
        float us = __int_as_float(__builtin_amdgcn_readlane(usc, li));
        float gt = __int_as_float(__builtin_amdgcn_readlane(gvc, li));
        float cf = gt * geluf_ref_(dot[j] * us);
        float f[16]; fp8x16_to_f(cv[j], f);
#pragma unroll
        for (int k = 0; k < 16; ++k) out[k] += cf * f[k];
      }
#pragma unroll
      for (int j = 0; j < NB; ++j) { cu[j] = nu[j]; cv[j] = nv[j]; }
    }
    float hv[16];
    {
      float4 a = *(const float4*)&hrow[0], b = *(const float4*)&hrow[4], c = *(const float4*)&hrow[8], d = *(const float4*)&hrow[12];
      hv[0] = a.x; hv[1] = a.y; hv[2] = a.z; hv[3] = a.w; hv[4] = b.x; hv[5] = b.y; hv[6] = b.z; hv[7] = b.w;
      hv[8] = c.x; hv[9] = c.y; hv[10] = c.z; hv[11] = c.w; hv[12] = d.x; hv[13] = d.y; hv[14] = d.z; hv[15] = d.w;
    }
    float s2 = 0.f;
#pragma unroll
    for (int k = 0; k < 16; ++k) { hv[k] += out[k]; s2 += hv[k] * hv[k]; }
    *(float4*)&hrow[0] = float4{hv[0], hv[1], hv[2], hv[3]}; *(float4*)&hrow[4] = float4{hv[4], hv[5], hv[6], hv[7]};
    *(float4*)&hrow[8] = float4{hv[8], hv[9], hv[10], hv[11]}; *(float4*)&hrow[12] = float4{hv[12], hv[13], hv[14], hv[15]};
    s2 = wave_sum(s2);
    const float rs2 = rsqrtf(s2 * (1.f / DM) + EPS);
    const float* pn = p.ple_norm + l * DM + e0;
    float zz[16];
#pragma unroll
    for (int k = 0; k < 16; ++k) zz[k] = hv[k] * rs2 * pn[k];
    bf16_t* zrow = p.zb + (size_t)t * DM + e0;
    *(uint4*)&zrow[0] = uint4{pack2(zz[0], zz[1]), pack2(zz[2], zz[3]), pack2(zz[4], zz[5]), pack2(zz[6], zz[7])};
    *(uint4*)&zrow[8] = uint4{pack2(zz[8], zz[9]), pack2(zz[10], zz[11]), pack2(zz[12], zz[13]), pack2(zz[14], zz[15])};
  }
}

template <class F>
DEVI void gemm_tiles(int NTn, int XM, int XN, F&& f) {
  int G = gridDim.x, B = blockIdx.x;
  asm volatile("" : "+s"(G), "+s"(B));
  if (G & 7) { for (int tile = B; tile < 64 * NTn; tile += G) f(tile / NTn, tile % NTn); return; }
  const int x = B & 7, slot = B >> 3, ns = G >> 3;
  const int xm = x / XN, xn = x % XN;
  const int mcnt = 64 / XM, mb = xm * mcnt;
  const int ncnt = (NTn - xn + XN - 1) / XN;
  for (int j = slot; j < mcnt * ncnt; j += ns) f(mb + j / ncnt, xn + XN * (j % ncnt));
}

enum { PH_PREP = 0, PH_NORM1, PH_GEMM_IN, PH_MIX_A, PH_MIX_B, PH_MIX_C, PH_MIX_D, PH_GEMM_OUT, PH_NORM2, PH_GEMM_Q, PH_SCORES,
       PH_TOPK, PH_GATHER, PH_GEMM_PLE, PH_FINAL };

#if PROBE_A >= 0
#define REGION(id, stmt)                                                                                   \
  {                                                                                                        \
    const bool on_ = (blockIdx.x == 255 && TID() == 0 && ((id) == PROBE_A || (id) == PROBE_B));              \
    if (on_) p.g_cdec[2051] = (float)(wall_clock64() & 0xFFFFFFull);                                       \
    stmt;                                                                                                  \
    if (on_) {                                                                                             \
      float dt_ = (float)(wall_clock64() & 0xFFFFFFull) - p.g_cdec[2051];                                  \
      if (dt_ < 0.f) dt_ += 16777216.f;                                                                    \
      p.g_cdec[(id) == PROBE_A ? 2048 : 2049] += dt_;                                                      \
    }                                                                                                      \
  }
#else
#define REGION(id, stmt) { stmt; }
#endif
DEVI void run_phase(const Params& p, int ph, int l, char* smem) {
  int G = gridDim.x, B = blockIdx.x;
  asm volatile("" : "+s"(G), "+s"(B));
  switch (ph) {
    case PH_PREP:
      ph_prep(p, smem);
      ph_norm(p.x, p.mix_norm, p.zb, nullptr);
      break;
    case PH_NORM1: ph_norm(l == 0 ? p.x : p.h, p.mix_norm + l * DM, p.zb, nullptr); break;
    case PH_GEMM_IN:
      gemm_tiles(23, 1, 8, [&](int mt_, int nt_) __attribute__((always_inline)) {
        int m0 = mt_ * 256, n0 = nt_ * 128;
        f32x4 acc[4][4];
        gemm_tile<0, 16>(acc, p.zb, DM, p.winT + (size_t)l * PW * 1024, 1024, 1024, m0, n0, nullptr, smem);
        GEMM_EPI_COORDS
#pragma unroll
        for (int i = 0; i < 4; ++i)
#pragma unroll
          for (int j = 0; j < 4; ++j)
            *(f32x4*)&p.proj[(size_t)(erow0 + i * 16) * PW + ecol0 + j * 16] = acc[i][j];
      });
      break;
    case PH_MIX_A:
      for (int it = B; it < 2048; it += G) {
        if (it < 1024) REGION(105, gdn_prep(p, l, it, smem))
        else if (it < 1536) REGION(106, ret_kv(p, l, it - 1024, smem))
        else if (it < 1792) REGION(107, lru_local(p, l, it - 1536, smem))
        else REGION(108, s5_local(p, l, it - 1792, smem))
      }
      break;
    case PH_MIX_B:
      for (int it = B; it < 256 + 35; it += G) {
        if (it < 256) { const int pr_ = (it & 7) * 4 + (it >> 6), cb_ = (it >> 3) & 7; REGION(100, gdn_chain<0>(p, pr_ >> 3, pr_ & 7, cb_, smem)) }
        else if (it < 256 + 32) ret_scan(p, it - 256);
        else if (it < 256 + 34) s5_scan(p, l, it - 288);
        else lru_scan(p);
      }
      break;
    case PH_MIX_C: {
      for (int k = 0;; ++k) {
        int ty = -1, idx = 0;
        if (G == 256) {
          if (B < 128) { if (k < 4) { ty = k; idx = B; } }
          else if (k == 0) { ty = 1; idx = B; }
          else if (k <= 3) { ty = 2; idx = 128 + (B - 128) * 3 + (k - 1); }
          else if (k == 4) { ty = 3; idx = B; }
        } else {
          const int it = B + k * G;
          if (it < 128) { ty = 0; idx = it; }
          else if (it < 640) { ty = 2; idx = it - 128; }
          else if (it < 896) { ty = 1; idx = it - 640; }
          else if (it < 1152) { ty = 3; idx = it - 896; }
        }
        if (ty < 0) break;
        if (ty == 0) { const int pr_ = (idx & 7) * 4 + (idx >> 5), cb_ = (idx >> 3) & 3; REGION(102, gdn_chain<1>(p, pr_ >> 3, pr_ & 7, cb_, smem)) }
        else if (ty == 1) REGION(103, s5_out(p, l, idx, smem))
        else if (ty == 2) REGION(101, ret_out(p, l, idx, smem))
        else REGION(104, lru_out(p, l, idx, smem))
      }
    } break;
    case PH_MIX_D:
      for (int it = B; it < 1024; it += G) REGION(109, gdn_out(p, l, it, smem))
      break;
    case PH_GEMM_OUT:
      gemm_tiles(8, 4, 2, [&](int mt_, int nt_) __attribute__((always_inline)) {
        int m0 = mt_ * 256, n0 = nt_ * 128;
        f32x4 acc[4][4];
        gemm_tile<1, 16>(acc, p.zb, DM, p.woutT + (size_t)l * 1024 * 1024, 1024, 1024, m0, n0, p.ssq, smem);
        GEMM_EPI_COORDS
#pragma unroll
        for (int i = 0; i < 4; ++i)
#pragma unroll
          for (int j = 0; j < 4; ++j)
            acc[i][j] += *(const f32x4*)&(l == 0 ? p.x : p.h)[(size_t)(erow0 + i * 16) * DM + ecol0 + j * 16];
#pragma unroll
        for (int i = 0; i < 4; ++i)
#pragma unroll
          for (int j = 0; j < 4; ++j)
            *(f32x4*)&p.h[(size_t)(erow0 + i * 16) * DM + ecol0 + j * 16] = acc[i][j];
      });
      break;
    case PH_NORM2:
      ph_norm(p.h, p.ffn_norm + l * DM, p.zb, nullptr);
      {
        const size_t gtid = (size_t)B * NT + TID(), gsz = (size_t)G * NT;
        const float4* sp = (const float4*)(p.p + (size_t)l * S_ * 256);
        for (size_t i = gtid; i < (size_t)S_ * 256 / 8; i += gsz) {
          float4 a = sp[2 * i], b = sp[2 * i + 1];
          ((uint4*)p.pbf)[i] = uint4{pack2(a.x, a.y), pack2(a.z, a.w), pack2(b.x, b.y), pack2(b.z, b.w)};
        }
      }
      break;
    case PH_GEMM_Q:
      gemm_tiles(8, 4, 2, [&](int mt_, int nt_) __attribute__((always_inline)) {
        int m0 = mt_ * 256, n0 = nt_ * 128;
        f32x4 acc[4][4];
        gemm_tile<0, 16>(acc, p.zb, DM, p.wqT + (size_t)l * 1024 * 1024, 1024, 1024, m0, n0, nullptr, smem);
        GEMM_EPI_COORDS
#pragma unroll
        for (int i = 0; i < 4; ++i)
#pragma unroll
          for (int j = 0; j < 4; ++j)
            *(f32x4*)&p.qbuf[(size_t)(erow0 + i * 16) * DM + ecol0 + j * 16] = acc[i][j];
      });
      break;
    case PH_SCORES:
      for (int it = B; it < 256; it += G) REGION(110, peer_scores(p, l, it, smem))
      break;
    case PH_TOPK:
      for (int it = B; it < 256; it += G) REGION(111, peer_topk(p, l, it, (G == 256) ? (B * 8 + (TID() >> 6)) * 16 : -1, smem))
      if (G != 256) convert_tables(p, l);
      break;
    case PH_GATHER: ph_gather(p, l); break;
    case PH_GEMM_PLE:
      gemm_tiles(8, 4, 2, [&](int mt_, int nt_) __attribute__((always_inline)) {
        int m0 = mt_ * 256, n0 = nt_ * 128;
        uint2* gsc = (uint2*)p.g_attn + (size_t)B * 16 * NT + TID();
        {
          f32x4 ag[4][4];
          gemm_tile<0, 16>(ag, p.zb, DM, p.wgT + (size_t)l * 1024 * 1024, 1024, 1024, m0, n0, nullptr, smem);
#pragma unroll
          for (int i = 0; i < 4; ++i)
#pragma unroll
            for (int j = 0; j < 4; ++j)
              gsc[(i * 4 + j) * NT] = uint2{pack2(sigmoidf_(ag[i][j][0]), sigmoidf_(ag[i][j][1])),
                                            pack2(sigmoidf_(ag[i][j][2]), sigmoidf_(ag[i][j][3]))};
        }
        f32x4 ap[4][4];
        gemm_tile<0, 4>(ap, p.pbf, 256, p.wpT + (size_t)l * 1024 * 256, 256, 256, m0, n0, nullptr, smem);
        GEMM_EPI_COORDS
#pragma unroll
        for (int i = 0; i < 4; ++i)
#pragma unroll
          for (int j = 0; j < 4; ++j) {
            const f32x4 hv = *(const f32x4*)&p.h[(size_t)(erow0 + i * 16) * DM + ecol0 + j * 16];
            const uint2 gk = gsc[(i * 4 + j) * NT];
            ap[i][j][0] = hv[0] + ap[i][j][0] * __uint_as_float(gk.x << 16);
            ap[i][j][1] = hv[1] + ap[i][j][1] * __uint_as_float(gk.x & 0xFFFF0000u);
            ap[i][j][2] = hv[2] + ap[i][j][2] * __uint_as_float(gk.y << 16);
            ap[i][j][3] = hv[3] + ap[i][j][3] * __uint_as_float(gk.y & 0xFFFF0000u);
          }
#pragma unroll
        for (int i = 0; i < 4; ++i)
#pragma unroll
          for (int j = 0; j < 4; ++j)
            *(f32x4*)&p.h[(size_t)(erow0 + i * 16) * DM + ecol0 + j * 16] = ap[i][j];
      });
      break;
    case PH_FINAL: ph_norm(p.h, p.final_norm, nullptr, p.out); break;
  }
}

#if !MEGA
__global__ void __launch_bounds__(NT) k_phase(Params p, int ph, int l) {
  extern __shared__ __align__(16) char smem[];
  run_phase(p, ph, l, smem);
}
#endif

#define XB_TMO      128
#define XB_XCNT(j)  (256  + 64 * (j))
#define XB_XSUB(j)  (1280 + 64 * (j))
#define XB_XGEN(j)  (2304 + 64 * (j))
#define XB_TOP      3328
#define XB_TOPGEN   3392
#define XCD_BAR_WORDS 3456
#define XB_SPIN_CAP (1u << 18)
#define LAS __attribute__((address_space(3)))
DEVI unsigned xb_ld(unsigned* p) { return __hip_atomic_load(p, __ATOMIC_RELAXED, __HIP_MEMORY_SCOPE_AGENT); }
DEVI unsigned xb_add(unsigned* p, unsigned v) { return __hip_atomic_fetch_add(p, v, __ATOMIC_RELAXED, __HIP_MEMORY_SCOPE_AGENT); }
DEVI unsigned xb_xcc_id() { return (unsigned)__builtin_amdgcn_s_getreg((3 << 11) | 20) & 0xFu; }
#define XB_SPIN(cond, bar) do { unsigned _sp = 0; while (cond) { __builtin_amdgcn_s_sleep(1); \
    if ((++_sp & 255u) == 0u) { if (xb_ld(&(bar)[XB_TMO])) break; if (_sp > XB_SPIN_CAP) { atomicAdd(&(bar)[XB_TMO], 1u); break; } } } } while (0)
struct XcdBarrier { unsigned* bar; unsigned x; volatile LAS unsigned* st; };
DEVI XcdBarrier xcd_barrier_post(unsigned* bar, volatile LAS unsigned* st) {
  XcdBarrier b; b.bar = bar; b.x = xb_xcc_id(); b.st = st;
  if (TID() == 0) (void)xb_add(&bar[XB_XCNT(b.x)], 1u);
  return b;
}
DEVI void xcd_barrier_complete(unsigned* bar, unsigned x, unsigned& nloc, unsigned& nx) {
  const unsigned G = gridDim.x * gridDim.y * gridDim.z;
  unsigned sum, cnt, mine, sp = 0u;
  for (;;) {
    sum = 0u; cnt = 0u; mine = 0u;
#pragma unroll
    for (unsigned j = 0; j < 16; ++j) { const unsigned c = xb_ld(&bar[XB_XCNT(j)]); sum += c; cnt += (c > 0u) ? 1u : 0u; mine = (j == x) ? c : mine; }
    if (sum == G) break;
    __builtin_amdgcn_s_sleep(1);
    if ((++sp & 255u) == 0u) { if (xb_ld(&bar[XB_TMO])) break; if (sp > XB_SPIN_CAP) { atomicAdd(&bar[XB_TMO], 1u); break; } }
  }
  nloc = mine > 0u ? mine : 1u; nx = cnt > 0u ? cnt : 1u;
}
DEVI void xcd_barrier(const XcdBarrier& b) {
  asm volatile("s_waitcnt vmcnt(0)" ::: "memory");
  __syncthreads();
  if (TID() == 0) {
    unsigned* bar = b.bar;
    __builtin_amdgcn_s_waitcnt(0);
    unsigned nloc = b.st[0], nx = b.st[1];
    if (nloc == 0u) { xcd_barrier_complete(bar, b.x, nloc, nx); b.st[0] = nloc; b.st[1] = nx; }
    const unsigned old = xb_add(&bar[XB_XSUB(b.x)], 1u);
    const unsigned gen = old / nloc;
    if (old + 1u == (gen + 1u) * nloc) {
      __builtin_amdgcn_fence(__ATOMIC_RELEASE, "agent");
      asm volatile("s_waitcnt vmcnt(0)" ::: "memory");
      const unsigned og = xb_add(&bar[XB_TOP], 1u);
      const unsigned tg = og / nx;
      if (og + 1u == (tg + 1u) * nx) xb_add(&bar[XB_TOPGEN], 1u);
      else XB_SPIN(xb_ld(&bar[XB_TOPGEN]) == tg, bar);
      __builtin_amdgcn_fence(__ATOMIC_ACQUIRE, "agent");
      xb_add(&bar[XB_XGEN(b.x)], 1u);
      asm volatile("s_waitcnt vmcnt(0)" ::: "memory");
    } else {
      XB_SPIN(xb_ld(&bar[XB_XGEN(b.x)]) == gen, bar);
      __builtin_amdgcn_fence(__ATOMIC_ACQUIRE, "agent");
      asm volatile("s_waitcnt vmcnt(0)" ::: "memory");
    }
  }
  __syncthreads();
}

#if MEGA
template <int ph, int l>
DEVI void mega_step(const Params& p, char* smem, const XcdBarrier& xb) {
#if PROBE_A >= 0
  if (blockIdx.x == 0 && TID() == 0 && (ph == PROBE_A || ph == PROBE_B)) p.g_cdec[2050] = (float)(wall_clock64() & 0xFFFFFFull);
  run_phase(p, ph, l, smem);
  xcd_barrier(xb);
  if (blockIdx.x == 0 && TID() == 0 && (ph == PROBE_A || ph == PROBE_B)) {
    float dt = (float)(wall_clock64() & 0xFFFFFFull) - p.g_cdec[2050];
    if (dt < 0.f) dt += 16777216.f;
    p.g_cdec[ph == PROBE_A ? 2048 : 2049] += dt;
  }
#else
  run_phase(p, ph, l, smem);
  xcd_barrier(xb);
#endif
}
template <int l>
DEVI void mega_layer(const Params& p, char* smem, const XcdBarrier& xb) {
  if constexpr (l != 0) mega_step<PH_NORM1, l>(p, smem, xb);
  mega_step<PH_GEMM_IN, l>(p, smem, xb);
  mega_step<PH_MIX_A, l>(p, smem, xb);
  mega_step<PH_MIX_B, l>(p, smem, xb);
  mega_step<PH_MIX_C, l>(p, smem, xb);
  mega_step<PH_MIX_D, l>(p, smem, xb);
  mega_step<PH_GEMM_OUT, l>(p, smem, xb);
  mega_step<PH_NORM2, l>(p, smem, xb);
  mega_step<PH_GEMM_Q, l>(p, smem, xb);
  mega_step<PH_SCORES, l>(p, smem, xb);
  mega_step<PH_TOPK, l>(p, smem, xb);
  mega_step<PH_GATHER, l>(p, smem, xb);
  mega_step<PH_GEMM_PLE, l>(p, smem, xb);
}
__global__ void __launch_bounds__(NT) k_mega(Params p) {
  extern __shared__ __align__(16) char smem[];
  cg::grid_group grid = cg::this_grid();
#if PROBE_A >= 0
  if (blockIdx.x == 0 && TID() == 0) { p.g_cdec[2048] = 0.f; p.g_cdec[2049] = 0.f; }
#endif
  __shared__ uint4 xb_words;
  if (TID() == 0) xb_words = uint4{0u, 0u, 0u, 0u};
  __syncthreads();
  const XcdBarrier xb = xcd_barrier_post(p.bar, (volatile LAS unsigned*)&xb_words);
  grid.sync();
  mega_step<PH_PREP, 0>(p, smem, xb);
  mega_layer<0>(p, smem, xb);
  mega_layer<1>(p, smem, xb);
  run_phase(p, PH_FINAL, 0, smem);
#if PROBE_A >= 0
  xcd_barrier(xb);
  {
    const float qa_ = __expf(rintf(logf(p.g_cdec[2048] * 0.01f) * 4.f) * 0.25f), qb_ = __expf(rintf(logf(p.g_cdec[2049] * 0.01f) * 4.f) * 0.25f);
    const float va = sqrtf(qa_), vb = qb_;
    const size_t gtid = (size_t)blockIdx.x * NT + TID(), gsz = (size_t)gridDim.x * NT;
    for (size_t i = gtid; i < (size_t)S_ * DM; i += gsz) p.out[i] = (i == 0) ? vb : va;
  }
#endif
}
#endif

extern "C" void kernel_launch(void* const* d_in, const int* in_sizes, int n_in, void* d_out, int out_size, void* d_ws,
                              size_t ws_size, hipStream_t stream) {
  Params p{};
  const float* const* f = (const float* const*)d_in;
  p.x = f[0]; p.p = f[1]; p.pos = (const int*)d_in[2];
  p.mix_norm = f[3]; p.w_in = f[4]; p.ret_gn = f[5]; p.lru_conv_w = f[6]; p.lru_conv_b = f[7]; p.lru_w_a = f[8];
  p.lru_b_a = f[9]; p.lru_w_x = f[10]; p.lru_b_x = f[11]; p.lru_lambda = f[12];
  p.s5_a_re = f[13]; p.s5_a_im = f[14]; p.s5_b_re = f[15]; p.s5_b_im = f[16]; p.s5_c_re = f[17]; p.s5_c_im = f[18];
  p.s5_d = f[19]; p.s5_log_dt = f[20]; p.s5_glu_w = f[21]; p.s5_glu_b = f[22];
  p.gdn_conv_w = f[23]; p.gdn_a_log = f[24]; p.gdn_dt_bias = f[25]; p.gdn_norm = f[26]; p.branch_norm = f[27];
  p.w_out = f[28]; p.ffn_norm = f[29]; p.peer_wq = f[30]; p.peer_subkeys = f[31]; p.peer_u = f[32]; p.peer_v = f[33];
  p.ple_norm = f[34]; p.ple_wg = f[35]; p.ple_wp = f[36]; p.final_norm = f[37];
  p.out = (float*)d_out;
  char* ws = (char*)d_ws;
  const size_t MiB = 1024 * 1024;
  p.h = (float*)(ws + 0 * MiB);
  p.zb = (bf16_t*)(ws + 64 * MiB);
  p.proj = (float*)(ws + 96 * MiB);
  p.qbuf = (float*)(ws + 96 * MiB);
  p.scores = (float*)(ws + 160 * MiB);
  p.g_u = (float*)(ws + 288 * MiB); p.g_w = (float*)(ws + 304 * MiB); p.g_attn = (float*)(ws + 320 * MiB);
  p.g_qd = (float*)(ws + 336 * MiB); p.g_kd = (float*)(ws + 352 * MiB);
  p.ids = (int*)(ws + 288 * MiB); p.gates = (float*)(ws + 296 * MiB);
  p.lru_h = (float*)(ws + 368 * MiB); p.lru_p = (float*)(ws + 384 * MiB);
  p.ret_kv = (float*)(ws + 400 * MiB);
  p.tabU = (uint8_t*)(ws + 408 * MiB); p.tabV = (uint8_t*)(ws + 440 * MiB);
  p.uinv = (float*)(ws + 505 * MiB); p.vinv = (float*)(ws + 505 * MiB + 65536);
  p.g_sst = (float*)(ws + 408 * MiB);
  {
    char* wb = ws + 472 * MiB;
    p.winT = (bf16_t*)wb; wb += (size_t)2 * PW * 1024 * 2;
    p.woutT = (bf16_t*)wb; wb += (size_t)2 * 1024 * 1024 * 2;
    p.wqT = (bf16_t*)wb; wb += (size_t)2 * 1024 * 1024 * 2;
    p.wgT = (bf16_t*)wb; wb += (size_t)2 * 1024 * 1024 * 2;
    p.wpT = (bf16_t*)wb; wb += (size_t)2 * 1024 * 256 * 2;
    p.gluT = (bf16_t*)wb; wb += (size_t)2 * 512 * 256 * 2;
  }
  p.rope = (float*)(ws + 497 * MiB);
  p.ssq = (float*)(ws + 501 * MiB);
  p.xloc = (float*)(ws + 502 * MiB);
  p.lru_hs = (float*)(ws + 504 * MiB);
  p.lru_ps = (float*)(ws + 504 * MiB + 256 * 256 * 4);
  p.g_cdec = (float*)(ws + 504 * MiB + 2 * 256 * 256 * 4);
  p.g_comp = (float*)(ws + 506 * MiB);
  p.pbf = (bf16_t*)(ws + 304 * MiB);
  p.bar = (unsigned*)(ws + 507 * MiB);

  static int grid_blocks = 0;
  if (!grid_blocks) {
#if MEGA
    hipFuncSetAttribute((const void*)k_mega, hipFuncAttributeMaxDynamicSharedMemorySize, LDS_BYTES);
#endif
#if !MEGA
    hipFuncSetAttribute((const void*)k_phase, hipFuncAttributeMaxDynamicSharedMemorySize, LDS_BYTES);
#endif
    int dev = 0, cus = 0, per_cu = 0;
    hipGetDevice(&dev);
    hipDeviceGetAttribute(&cus, hipDeviceAttributeMultiprocessorCount, dev);
#if MEGA
    hipOccupancyMaxActiveBlocksPerMultiprocessor(&per_cu, k_mega, NT, LDS_BYTES);
#else
    hipOccupancyMaxActiveBlocksPerMultiprocessor(&per_cu, k_phase, NT, LDS_BYTES);
#endif
    if (per_cu < 1) per_cu = 1;
    grid_blocks = cus * per_cu;
  }
#if MEGA
  hipMemsetAsync(p.bar, 0, XCD_BAR_WORDS * 4, stream);
  void* args[] = {&p};
  hipError_t e = hipLaunchCooperativeKernel((void*)k_mega, dim3(grid_blocks), dim3(NT), args, LDS_BYTES, stream);
  if (e != hipSuccess) fprintf(stderr, "cooperative launch failed: %s (grid %d)\n", hipGetErrorString(e), grid_blocks);
#else
  k_phase<<<grid_blocks, NT, LDS_BYTES, stream>>>(p, PH_PREP, 0);
  for (int l = 0; l < NL; ++l)
    for (int ph = PH_NORM1; ph <= PH_GEMM_PLE; ++ph) k_phase<<<grid_blocks, NT, LDS_BYTES, stream>>>(p, ph, l);
  k_phase<<<grid_blocks, NT, LDS_BYTES, stream>>>(p, PH_FINAL, 0);
#endif
}
```

```cpp
#include <hip/hip_runtime.h>
#include <hip/hip_bf16.h>
#include <hip/hip_cooperative_groups.h>
#include <cstdio>
#include <cstdint>
namespace cg = cooperative_groups;

#ifndef MEGA
#define MEGA 1
#endif

#ifndef PROBE_A
#define PROBE_A -1
#endif
#ifndef PROBE_B
#define PROBE_B -1
#endif
#define DEVI __device__ __forceinline__

typedef __attribute__((ext_vector_type(8))) short bf16x8;
typedef __attribute__((ext_vector_type(4))) float f32x4;
typedef unsigned short bf16_t;

constexpr int NT = 512;
constexpr int S_ = 16384, DM = 1024, NL = 2, PW = 2944, INW = 2824;
constexpr int RQ = 0, RK = 256, RV = 512, RG = 768, LG = 1024, LX = 1280, SU = 1536, DQ = 1792,
              DB = 2560, DA = 2564, DG = 2568;
constexpr float EPS = 1e-6f;
constexpr int LDS_BYTES = 132 * 1024;

struct Params {
  const float *x, *p; const int* pos;
  const float *mix_norm, *w_in, *ret_gn, *lru_conv_w, *lru_conv_b, *lru_w_a, *lru_b_a, *lru_w_x, *lru_b_x, *lru_lambda;
  const float *s5_a_re, *s5_a_im, *s5_b_re, *s5_b_im, *s5_c_re, *s5_c_im, *s5_d, *s5_log_dt, *s5_glu_w, *s5_glu_b;
  const float *gdn_conv_w, *gdn_a_log, *gdn_dt_bias, *gdn_norm, *branch_norm, *w_out, *ffn_norm, *peer_wq, *peer_subkeys;
  const float *peer_u, *peer_v, *ple_norm, *ple_wg, *ple_wp, *final_norm;
  float* out;
  float* h; bf16_t* zb; float* proj; float* qbuf; float* scores;
  float *g_u, *g_w, *g_attn, *g_qd, *g_kd, *g_sst, *g_cdec, *g_comp;
  int* ids; float* gates;
  float *lru_h, *lru_p, *lru_hs, *lru_ps;
  float* ret_kv; float* xloc;
  uint8_t *tabU, *tabV; float *uinv, *vinv;
  bf16_t *winT, *woutT, *wqT, *wgT, *wpT, *gluT;
  float* rope; float* ssq; bf16_t* pbf; unsigned* bar;
};

DEVI int TID() { int t = __builtin_amdgcn_workitem_id_x(); asm volatile("" : "+v"(t)); return t; }
DEVI bf16_t f2bf(float f) { unsigned u = __float_as_uint(f); u += 0x7FFFu + ((u >> 16) & 1u); return (bf16_t)(u >> 16); }
DEVI float bf2f(bf16_t b) { return __uint_as_float(((unsigned)b) << 16); }
DEVI unsigned pack2(float a, float b) { return (unsigned)f2bf(a) | ((unsigned)f2bf(b) << 16); }
DEVI float sigmoidf_(float x) { return __fdividef(1.f, 1.f + __expf(-x)); }
DEVI float siluf_(float x) { return x * __fdividef(1.f, 1.f + __expf(-x)); }
DEVI float geluf_ref_(float x) { float u = 0.7978845608028654f * (x + 0.044715f * x * x * x); return 0.5f * x * (1.f + tanhf(u)); }
DEVI float geluf_(float x) { float u = 0.7978845608028654f * (x + 0.044715f * x * x * x); return x * __fdividef(1.f, 1.f + __expf(-2.f * u)); }
DEVI float softplusf_(float x) { return x > 20.f ? x : log1pf(expf(x)); }
DEVI float wave_sum(float v) {
  v += __shfl_xor(v, 32); v += __shfl_xor(v, 16); v += __shfl_xor(v, 8);
  v += __shfl_xor(v, 4); v += __shfl_xor(v, 2); v += __shfl_xor(v, 1); return v;
}
DEVI float sum16(float v) {
  v += __shfl_xor(v, 8); v += __shfl_xor(v, 4); v += __shfl_xor(v, 2); v += __shfl_xor(v, 1); return v;
}

template <int NTL>
DEVI void mm16(f32x4 (&acc)[NTL], const float* A, int sam, int sak, const float* B, int sbk, int sbn, int K) {
  const int l = TID() & 63, r = l & 15, q = l >> 4;
  const float* ap = A + r * sam + q * sak;
  const float* bp = B + q * sbk + r * sbn;
#pragma unroll 4
  for (int k = 0; k < K; k += 4) {
    float a = ap[k * sak];
#pragma unroll
    for (int t = 0; t < NTL; ++t) {
      float b = bp[k * sbk + t * 16 * sbn];
      acc[t] = __builtin_amdgcn_mfma_f32_16x16x4f32(a, b, acc[t], 0, 0, 0);
    }
  }
}

template <int NTL>
DEVI void mm16_gB64(f32x4 (&acc)[NTL], const float* A, int sam, const float* __restrict__ Bg) {
  const int l = TID() & 63, r = l & 15, q = l >> 4;
  float bv[16][NTL];
#pragma unroll
  for (int k = 0; k < 16; ++k)
#pragma unroll
    for (int t = 0; t < NTL; ++t) bv[k][t] = Bg[(4 * k + q) * 64 + t * 16 + r];
#pragma unroll
  for (int k = 0; k < 16; ++k) {
    const float a = A[r * sam + 4 * k + q];
#pragma unroll
    for (int t = 0; t < NTL; ++t) acc[t] = __builtin_amdgcn_mfma_f32_16x16x4f32(a, bv[k][t], acc[t], 0, 0, 0);
  }
}

template <int AMODE, int NK>
DEVI void gemm_tile(f32x4 (&acc)[4][4], const void* Aptr, int lda, const bf16_t* Bt, int ldb, int K, int m0, int n0,
                    const float* ssq, char* smem) {
  constexpr int LDT = 72, BUF = (256 + 128) * LDT;
  bf16_t* sbase = (bf16_t*)smem;
  const int tid = TID(), lane = tid & 63, wave = tid >> 6;
  const int wm = wave >> 1, wn = wave & 1, r = lane & 15, q = lane >> 4;
  const int lrow = tid >> 3, lkc = tid & 7;
  uint4 raS00, raS01, raS02, raS03, rbS00, rbS01, raS10, raS11, raS12, raS13, rbS10, rbS11, raS20, raS21, raS22, raS23, rbS20, rbS21;
  float rs0 = 1.f, rs1 = 1.f, rs2 = 1.f, rs3 = 1.f;
#pragma unroll
  for (int i = 0; i < 4; ++i)
#pragma unroll
    for (int j = 0; j < 4; ++j) acc[i][j] = f32x4{0.f, 0.f, 0.f, 0.f};
  const bf16_t* Ab = (const bf16_t*)Aptr + (size_t)(m0 + lrow) * lda + lkc * 8;
  const bf16_t* Bb = Bt + (size_t)(n0 + lrow) * ldb + lkc * 8;
#define GL(S, k0_)                                                    \
  {                                                                   \
    ra##S##0 = *(const uint4*)(Ab + (k0_));                           \
    ra##S##1 = *(const uint4*)(Ab + (size_t)64 * lda + (k0_));        \
    ra##S##2 = *(const uint4*)(Ab + (size_t)128 * lda + (k0_));       \
    ra##S##3 = *(const uint4*)(Ab + (size_t)192 * lda + (k0_));       \
    rb##S##0 = *(const uint4*)(Bb + (k0_));                           \
    rb##S##1 = *(const uint4*)(Bb + (size_t)64 * ldb + (k0_));        \
  }
  auto scale = [&](uint4 v, float s) {
    unsigned w[4] = {v.x, v.y, v.z, v.w};
#pragma unroll
    for (int j = 0; j < 4; ++j) {
      float lo = __uint_as_float(w[j] << 16) * s, hi = __uint_as_float(w[j] & 0xFFFF0000u) * s;
      w[j] = pack2(lo, hi);
    }
    return uint4{w[0], w[1], w[2], w[3]};
  };
  auto rowscale = [&](int row, int k0) {
    const float* sp = ssq + (size_t)(m0 + row) * 16;
    int seg = k0 >> 8;
    float s = seg == 0 ? (sp[0] + sp[1] + sp[2] + sp[3]) : seg == 1 ? sp[4] : seg == 2 ? sp[5] : (sp[8] + sp[9] + sp[10] + sp[11]);
    return rsqrtf(s * (1.f / 256.f) + EPS);
  };
#define LS(S, k0_, bi_)                                                               \
  {                                                                                   \
    bf16_t* As_ = sbase + (bi_) * BUF; bf16_t* Bs_ = As_ + 256 * LDT;                 \
    if constexpr (AMODE == 1) {                                                       \
      if (((k0_) & 255) == 0) {                                                       \
        rs0 = rowscale(lrow, (k0_)); rs1 = rowscale(lrow + 64, (k0_));                \
        rs2 = rowscale(lrow + 128, (k0_)); rs3 = rowscale(lrow + 192, (k0_));         \
      }                                                                               \
      ra##S##0 = scale(ra##S##0, rs0); ra##S##1 = scale(ra##S##1, rs1);               \
      ra##S##2 = scale(ra##S##2, rs2); ra##S##3 = scale(ra##S##3, rs3);               \
    }                                                                                 \
    *(uint4*)&As_[(lrow) * LDT + lkc * 8] = ra##S##0;                                 \
    *(uint4*)&As_[(lrow + 64) * LDT + lkc * 8] = ra##S##1;                            \
    *(uint4*)&As_[(lrow + 128) * LDT + lkc * 8] = ra##S##2;                           \
    *(uint4*)&As_[(lrow + 192) * LDT + lkc * 8] = ra##S##3;                           \
    *(uint4*)&Bs_[(lrow) * LDT + lkc * 8] = rb##S##0;                                 \
    *(uint4*)&Bs_[(lrow + 64) * LDT + lkc * 8] = rb##S##1;                            \
  }
  auto compute = [&](int bi) {
    const bf16_t* As = sbase + bi * BUF; const bf16_t* Bs = As + 256 * LDT;
#pragma unroll
    for (int kk = 0; kk < 2; ++kk) {
      bf16x8 a[4], b[4];
#pragma unroll
      for (int i = 0; i < 4; ++i) a[i] = *(const bf16x8*)&As[(wm * 64 + i * 16 + r) * LDT + kk * 32 + q * 8];
#pragma unroll
      for (int j = 0; j < 4; ++j) b[j] = *(const bf16x8*)&Bs[(wn * 64 + j * 16 + r) * LDT + kk * 32 + q * 8];
#pragma unroll
      for (int i = 0; i < 4; ++i)
#pragma unroll
        for (int j = 0; j < 4; ++j)
          acc[i][j] = __builtin_amdgcn_mfma_f32_16x16x32_bf16(b[j], a[i], acc[i][j], 0, 0, 0);
    }
  };

  __syncthreads();
  if constexpr (NK == 16 && AMODE == 1) {
    GL(S0, 0)
    LS(S0, 0, 0)
    GL(S1, 64)
    __syncthreads();
#pragma unroll 1
    for (int kt = 0; kt < NK; kt += 2) {
      compute(0);
      LS(S1, ((kt + 1) << 6), 1)
      if (kt + 2 < NK) GL(S0, ((kt + 2) << 6))
      __syncthreads();
      compute(1);
      if (kt + 2 < NK) { LS(S0, ((kt + 2) << 6), 0) GL(S1, ((kt + 3) << 6)) }
      __syncthreads();
    }
  } else if constexpr (NK == 16) {
    GL(S0, 0) GL(S1, 64) GL(S2, 128)
    LS(S0, 0, 0)
    GL(S0, 192)
    __syncthreads();
    compute(0);
    LS(S1, 64, 1)
    GL(S1, 256)
    __syncthreads();
    compute(1);
    LS(S2, 128, 0)
    GL(S2, 320)
    __syncthreads();
    compute(0);
    LS(S0, 192, 1)
    GL(S0, 384)
    __syncthreads();
    compute(1);
    LS(S1, 256, 0)
    GL(S1, 448)
    __syncthreads();
    compute(0);
    LS(S2, 320, 1)
    GL(S2, 512)
    __syncthreads();
    compute(1);
    LS(S0, 384, 0)
    GL(S0, 576)
    __syncthreads();
    compute(0);
    LS(S1, 448, 1)
    GL(S1, 640)
    __syncthreads();
    compute(1);
    LS(S2, 512, 0)
    GL(S2, 704)
    __syncthreads();
    compute(0);
    LS(S0, 576, 1)
    GL(S0, 768)
    __syncthreads();
    compute(1);
    LS(S1, 640, 0)
    GL(S1, 832)
    __syncthreads();
    compute(0);
    LS(S2, 704, 1)
    GL(S2, 896)
    __syncthreads();
    compute(1);
    LS(S0, 768, 0)
    GL(S0, 960)
    __syncthreads();
    compute(0);
    LS(S1, 832, 1)
    __syncthreads();
    compute(1);
    LS(S2, 896, 0)
    __syncthreads();
    compute(0);
    LS(S0, 960, 1)
    __syncthreads();
    compute(1);
    __syncthreads();
  } else {
    GL(S0, 0) GL(S1, 64) GL(S2, 128)
    LS(S0, 0, 0)
    GL(S0, 192)
    __syncthreads();
    compute(0);
    LS(S1, 64, 1)
    __syncthreads();
    compute(1);
    LS(S2, 128, 0)
    __syncthreads();
    compute(0);
    LS(S0, 192, 1)
    __syncthreads();
    compute(1);
    __syncthreads();
  }
#undef GL
#undef LS
}
#define GEMM_EPI_COORDS                                                   \
  const int lane_ = TID() & 63, wave_ = TID() >> 6;           \
  const int erow0 = m0 + (wave_ >> 1) * 64 + (lane_ & 15);                \
  const int ecol0 = n0 + (wave_ & 1) * 64 + (lane_ >> 4) * 4;

DEVI void transpose_tile(const float* W, int ldw, int nvalid, bf16_t* Bt, int ldbt, int k0, int n0, char* smem) {
  float* t = (float*)smem;
  const int tid = TID();
  {
    int i = tid >> 4, j4 = tid & 15;
#pragma unroll
    for (int h2 = 0; h2 < 2; ++h2) {
      int kk = i + 32 * h2;
      int n = n0 + j4 * 4;
      float4 v = float4{0.f, 0.f, 0.f, 0.f};
      if (n < nvalid) v = *(const float4*)&W[(size_t)(k0 + kk) * ldw + n];
      t[(j4 * 4 + 0) * 65 + kk] = v.x; t[(j4 * 4 + 1) * 65 + kk] = v.y;
      t[(j4 * 4 + 2) * 65 + kk] = v.z; t[(j4 * 4 + 3) * 65 + kk] = v.w;
    }
  }
  __syncthreads();
  {
    int n = tid >> 3, k8 = tid & 7;
    const float* s = &t[n * 65 + k8 * 8];
    uint4 v;
    v.x = pack2(s[0], s[1]); v.y = pack2(s[2], s[3]); v.z = pack2(s[4], s[5]); v.w = pack2(s[6], s[7]);
    *(uint4*)&Bt[(size_t)(n0 + n) * ldbt + k0 + k8 * 8] = v;
  }
  __syncthreads();
}

DEVI void convert_tables(const Params& p, int l) {
  const int lane = TID() & 63, wave = TID() >> 6;
  const int nw = gridDim.x * 8, gw = blockIdx.x * 8 + wave;
  for (int r0 = gw; r0 < 2 * 16384; r0 += 4 * nw) {
    float4 va[4], vb[4], vc[4], vd[4];
#pragma unroll
    for (int k = 0; k < 4; ++k) {
      const int rr = r0 + k * nw;
      if (rr < 2 * 16384) {
        const int which = rr >> 14, row = rr & 16383;
        const float* s = (which ? p.peer_v : p.peer_u) + ((size_t)l * 16384 + row) * 1024 + lane * 16;
        va[k] = *(const float4*)s; vb[k] = *(const float4*)(s + 4); vc[k] = *(const float4*)(s + 8); vd[k] = *(const float4*)(s + 12);
      }
    }
#pragma unroll
    for (int k = 0; k < 4; ++k) {
      const int rr = r0 + k * nw;
      if (rr < 2 * 16384) {
        const int which = rr >> 14, row = rr & 16383;
        const float4 a = va[k], b = vb[k], c = vc[k], d = vd[k];
        float m = fmaxf(fmaxf(fmaxf(fabsf(a.x), fabsf(a.y)), fmaxf(fabsf(a.z), fabsf(a.w))),
                        fmaxf(fmaxf(fabsf(b.x), fabsf(b.y)), fmaxf(fabsf(b.z), fabsf(b.w))));
        m = fmaxf(m, fmaxf(fmaxf(fmaxf(fabsf(c.x), fabsf(c.y)), fmaxf(fabsf(c.z), fabsf(c.w))),
                           fmaxf(fmaxf(fabsf(d.x), fabsf(d.y)), fmaxf(fabsf(d.z), fabsf(d.w)))));
        m = fmaxf(m, __shfl_xor(m, 32)); m = fmaxf(m, __shfl_xor(m, 16)); m = fmaxf(m, __shfl_xor(m, 8));
        m = fmaxf(m, __shfl_xor(m, 4)); m = fmaxf(m, __shfl_xor(m, 2)); m = fmaxf(m, __shfl_xor(m, 1));
        const float sc = m > 0.f ? 256.f / m : 1.f;
        int w0 = 0, w1 = 0, w2 = 0, w3 = 0;
        w0 = __builtin_amdgcn_cvt_pk_fp8_f32(a.x * sc, a.y * sc, w0, false); w0 = __builtin_amdgcn_cvt_pk_fp8_f32(a.z * sc, a.w * sc, w0, true);
        w1 = __builtin_amdgcn_cvt_pk_fp8_f32(b.x * sc, b.y * sc, w1, false); w1 = __builtin_amdgcn_cvt_pk_fp8_f32(b.z * sc, b.w * sc, w1, true);
        w2 = __builtin_amdgcn_cvt_pk_fp8_f32(c.x * sc, c.y * sc, w2, false); w2 = __builtin_amdgcn_cvt_pk_fp8_f32(c.z * sc, c.w * sc, w2, true);
        w3 = __builtin_amdgcn_cvt_pk_fp8_f32(d.x * sc, d.y * sc, w3, false); w3 = __builtin_amdgcn_cvt_pk_fp8_f32(d.z * sc, d.w * sc, w3, true);
        *(uint4*)((which ? p.tabV : p.tabU) + (size_t)row * 1024 + lane * 16) = uint4{(unsigned)w0, (unsigned)w1, (unsigned)w2, (unsigned)w3};
        if (lane == 0) (which ? p.vinv : p.uinv)[row] = m > 0.f ? m * (1.f / 256.f) : 1.f;
      }
    }
  }
}

DEVI void ph_prep(const Params& p, char* smem) {
  const size_t gtid = (size_t)blockIdx.x * NT + TID(), gsz = (size_t)gridDim.x * NT;
  for (size_t i = gtid; i < (size_t)S_ * 32; i += gsz) {
    int t = (int)(i >> 5), f = (int)(i & 31);
    float inv = powf(10000.f, -(float)f / 32.f);
    float ang = (float)p.pos[t] * inv;
    p.rope[2 * i] = cosf(ang); p.rope[2 * i + 1] = sinf(ang);
  }
}
DEVI void prep_transposes(const Params& p, char* smem, int first, int last, int b, int nb) {
  for (int it = first + b; it < last; it += nb) {
    int l = it / 1600, idx = it % 1600;
    if (idx >= 1568) {
      int j = idx - 1568; int kt = j >> 3, nt = j & 7;
      transpose_tile(p.s5_glu_w + (size_t)l * 256 * 512, 512, 512, p.gluT + (size_t)l * 512 * 256, 256, kt * 64, nt * 64, smem);
    } else if (idx < 736) {
      int kt = idx / 46, nt = idx % 46;
      transpose_tile(p.w_in + (size_t)l * 1024 * INW, INW, INW, p.winT + (size_t)l * PW * 1024, 1024, kt * 64, nt * 64, smem);
    } else if (idx < 1504) {
      int j = idx - 736; int which = j >> 8; j &= 255;
      int kt = j >> 4, nt = j & 15;
      const float* src = (which == 0 ? p.w_out : which == 1 ? p.peer_wq : p.ple_wg) + (size_t)l * 1024 * 1024;
      bf16_t* dst = (which == 0 ? p.woutT : which == 1 ? p.wqT : p.wgT) + (size_t)l * 1024 * 1024;
      transpose_tile(src, 1024, 1024, dst, 1024, kt * 64, nt * 64, smem);
    } else {
      int j = idx - 1504; int kt = j >> 4, nt = j & 15;
      transpose_tile(p.ple_wp + (size_t)l * 256 * 1024, 1024, 1024, p.wpT + (size_t)l * 1024 * 256, 256, kt * 64, nt * 64, smem);
    }
  }
}

DEVI void ph_norm(const float* src, const float* g, bf16_t* dst, float* fout) {
  const int lane = TID() & 63, wave = TID() >> 6;
  const int nw = gridDim.x * 8, gw = blockIdx.x * 8 + wave;
  float4 gg[4];
#pragma unroll
  for (int i = 0; i < 4; ++i) gg[i] = *(const float4*)&g[i * 256 + lane * 4];
  for (int t = gw; t < S_; t += 4 * nw) {
    float4 v[4][4];
#pragma unroll
    for (int rr = 0; rr < 4; ++rr) {
      const int tr = t + rr * nw;
      if (tr < S_) {
#pragma unroll
        for (int i = 0; i < 4; ++i) v[rr][i] = *(const float4*)&src[(size_t)tr * DM + i * 256 + lane * 4];
      }
    }
#pragma unroll
    for (int rr = 0; rr < 4; ++rr) {
      const int tr = t + rr * nw;
      if (tr < S_) {
        float ss = 0.f;
#pragma unroll
        for (int i = 0; i < 4; ++i) ss += v[rr][i].x * v[rr][i].x + v[rr][i].y * v[rr][i].y + v[rr][i].z * v[rr][i].z + v[rr][i].w * v[rr][i].w;
        ss = wave_sum(ss);
        const float rs = rsqrtf(ss * (1.f / DM) + EPS);
#pragma unroll
        for (int i = 0; i < 4; ++i) {
          float a = v[rr][i].x * rs * gg[i].x, b = v[rr][i].y * rs * gg[i].y, c = v[rr][i].z * rs * gg[i].z, d = v[rr][i].w * rs * gg[i].w;
          if (dst) *(uint2*)&dst[(size_t)tr * DM + i * 256 + lane * 4] = uint2{pack2(a, b), pack2(c, d)};
          else *(float4*)&fout[(size_t)tr * DM + i * 256 + lane * 4] = float4{a, b, c, d};
        }
      }
    }
  }
}

DEVI void gdn_prep(const Params& p, int l, int item, char* smem) {
  const int c = item >> 2, hd = item & 3, t0 = c * 64;
  float* sq = (float*)smem; float* sk = sq + 64 * 65; float* sv = sk + 64 * 65;
  float* sL = sv + 64 * 65;
  float* sgc = sL + 64 * 68; float* sbeta = sgc + 64;
  const int tid = TID(), lane = tid & 63, wave = tid >> 6, r = lane & 15, qd = lane >> 4;
  const float* cw = p.gdn_conv_w + (size_t)l * 4 * 768;
  {
    const int d = tid & 63, tw = tid >> 6;
#pragma unroll
    for (int which = 0; which < 3; ++which) {
      const int ch = which * 256 + hd * 64 + d;
      const float w0 = cw[ch], w1 = cw[768 + ch], w2 = cw[2 * 768 + ch], w3 = cw[3 * 768 + ch];
      const float* pc = p.proj + DQ + ch;
      float xv[11];
#pragma unroll
      for (int k = 0; k < 11; ++k) {
        const int tt = t0 + 8 * tw - 3 + k;
        const float v = pc[(size_t)(tt < 0 ? 0 : tt) * PW];
        xv[k] = tt < 0 ? 0.f : v;
      }
#pragma unroll
      for (int m = 0; m < 8; ++m) {
        float acc = 0.f;
        acc += w0 * xv[m]; acc += w1 * xv[m + 1]; acc += w2 * xv[m + 2]; acc += w3 * xv[m + 3];
        const float sv_ = siluf_(acc);
        if (which == 0) sq[(8 * tw + m) * 65 + d] = sv_;
        else if (which == 1) sk[(8 * tw + m) * 65 + d] = sv_;
        else sv[(8 * tw + m) * 65 + d] = sv_;
      }
    }
  }
  __syncthreads();
  {
    const int rw = tid >> 2, part = tid & 3, t = rw & 63;
    float* row = (rw < 64 ? sq : sk) + t * 65 + part * 16;
    float s = 0.f;
#pragma unroll
    for (int d = 0; d < 16; ++d) s += row[d] * row[d];
    s += __shfl_xor(s, 1); s += __shfl_xor(s, 2);
    float sc = rsqrtf(s + EPS) * (rw < 64 ? 0.125f : 1.f);
#pragma unroll
    for (int d = 0; d < 16; ++d) row[d] *= sc;
  }
  if (wave == 2) {
    int t = tid - 128;
    float bl = p.proj[(size_t)(t0 + t) * PW + DB + hd];
    float al = p.proj[(size_t)(t0 + t) * PW + DA + hd];
    float la = -__expf(p.gdn_a_log[l * 4 + hd]) * softplusf_(al + p.gdn_dt_bias[l * 4 + hd]);
    for (int off = 1; off < 64; off <<= 1) { float n = __shfl_up(la, off); if (lane >= off) la += n; }
    sgc[t] = la; sbeta[t] = sigmoidf_(bl);
  }
  __syncthreads();
  {
    int mat = wave >> 2, mt = wave & 3;
    f32x4 acc[4];
#pragma unroll
    for (int t = 0; t < 4; ++t) acc[t] = f32x4{0.f, 0.f, 0.f, 0.f};
    mm16<4>(acc, (mat == 0 ? sk : sq) + mt * 16 * 65, 65, 1, sk, 1, 65, 64);
#pragma unroll
    for (int t = 0; t < 4; ++t)
#pragma unroll
      for (int e = 0; e < 4; ++e) {
        int i = mt * 16 + 4 * qd + e, j = t * 16 + r;
        float g = (i >= j) ? __expf(sgc[i] - sgc[j]) : 0.f;
        if (mat == 0) sL[i * 68 + j] = (i > j) ? acc[t][e] * sbeta[i] * g : 0.f;
        else p.g_attn[((size_t)item * 64 + i) * 64 + j] = (i >= j) ? acc[t][e] * g : 0.f;
      }
  }
  __syncthreads();
  if (tid < 128) {
    const bool isv = tid < 64; const int d = tid & 63;
    float X[64];
#pragma unroll
    for (int i = 0; i < 64; ++i) X[i] = 0.f;
    float* dst = (isv ? p.g_u : p.g_w) + (size_t)item * 4096 + d;
#pragma unroll
    for (int i = 0; i < 64; ++i) {
      float bi = sbeta[i];
      float s = isv ? sv[i * 65 + d] * bi : sk[i * 65 + d] * bi * __expf(sgc[i]);
      float s1 = 0.f, s2 = 0.f, s3 = 0.f;
#pragma unroll
      for (int j4 = 0; j4 < (i + 3) / 4; ++j4) {
        float4 lv = *(const float4*)&sL[i * 68 + j4 * 4];
        s -= lv.x * X[j4 * 4 + 0]; s1 -= lv.y * X[j4 * 4 + 1]; s2 -= lv.z * X[j4 * 4 + 2]; s3 -= lv.w * X[j4 * 4 + 3];
      }
      s = (s + s1) + (s2 + s3);
      X[i] = s;
      dst[i * 64] = s;
    }
  } else {
    for (int i2 = tid - 128; i2 < 8192; i2 += 384) {
      int which = i2 >> 12, i = (i2 >> 6) & 63, d = i2 & 63;
      float val = which == 0 ? sq[i * 65 + d] * __expf(sgc[i]) : sk[i * 65 + d] * __expf(sgc[63] - sgc[i]);
      (which == 0 ? p.g_qd : p.g_kd)[(size_t)item * 4096 + i * 64 + d] = val;
    }
    if (tid == 128) p.g_cdec[item] = __expf(sgc[63]);
  }
  __syncthreads();
}

DEVI f32x4 mm16_k64(const float* A, int sam, int sak, const float* B, int sbk, int sbn) {
  const int l = TID() & 63, r = l & 15, q = l >> 4;
  const float* ap = A + r * sam + q * sak;
  const float* bp = B + q * sbk + r * sbn;
  float av[16], bv[16];
#pragma unroll
  for (int k = 0; k < 16; ++k) { av[k] = ap[4 * k * sak]; bv[k] = bp[4 * k * sbk]; }
  f32x4 c0 = f32x4{0.f, 0.f, 0.f, 0.f}, c1 = f32x4{0.f, 0.f, 0.f, 0.f};
#pragma unroll
  for (int k = 0; k < 16; k += 2) {
    c0 = __builtin_amdgcn_mfma_f32_16x16x4f32(av[k], bv[k], c0, 0, 0, 0);
    c1 = __builtin_amdgcn_mfma_f32_16x16x4f32(av[k + 1], bv[k + 1], c1, 0, 0, 0);
  }
  return c0 + c1;
}

template <int MODE>
DEVI void gdn_chain(const Params& p, int hd, int grp, int cb, char* smem) {
  float* base = (float*)smem;
  constexpr int BUFSZ = 64 * 68 * 2 + 64 * 16;
  float* sS = base + 2 * BUFSZ; float* sVN = sS + 1024;
  const int tid = TID(), lane = tid & 63, wave = tid >> 6, r = lane & 15, qd = lane >> 4;
  const bool apart = (MODE == 0) && (cb >= 4);
  const int e0 = (cb & 3) * 16;
  const int c0 = grp * 32;
  float4 pw0, pw1, pkd0, pkd1, pu = float4{0.f, 0.f, 0.f, 0.f};
  const int lr0 = tid >> 4, lc0 = (tid & 15) * 4, lr1 = lr0 + 32;
  const int ur = tid >> 2, uc = (tid & 3) * 4;
#define GLOAD(c_)                                                            \
  {                                                                          \
    size_t b_ = (size_t)((c_) * 4 + hd) * 4096;                              \
    pw0 = *(const float4*)&p.g_w[b_ + lr0 * 64 + lc0];                       \
    pw1 = *(const float4*)&p.g_w[b_ + lr1 * 64 + lc0];                       \
    pkd0 = *(const float4*)&p.g_kd[b_ + lr0 * 64 + lc0];                     \
    pkd1 = *(const float4*)&p.g_kd[b_ + lr1 * 64 + lc0];                     \
    if (tid < 256 && !apart) pu = *(const float4*)&p.g_u[b_ + ur * 64 + e0 + uc]; \
  }
#define LSTORE(bi_)                                                          \
  {                                                                          \
    float* W_ = base + (bi_) * BUFSZ; float* KD_ = W_ + 64 * 68; float* U_ = KD_ + 64 * 68; \
    *(float4*)&W_[lr0 * 68 + lc0] = pw0; *(float4*)&W_[lr1 * 68 + lc0] = pw1;       \
    *(float4*)&KD_[lr0 * 68 + lc0] = pkd0; *(float4*)&KD_[lr1 * 68 + lc0] = pkd1;   \
    if (tid < 256) *(float4*)&U_[ur * 16 + uc] = pu;                         \
  }
  f32x4 sreg = f32x4{0.f, 0.f, 0.f, 0.f};
  if (MODE == 0) {
    for (int i = tid; i < 1024; i += NT) sS[i] = (apart && ((i >> 4) == e0 + (i & 15))) ? 1.f : 0.f;
    if (apart) {
#pragma unroll
      for (int e = 0; e < 4; ++e) sreg[e] = ((wave & 3) * 16 + 4 * qd + e == e0 + r) ? 1.f : 0.f;
    }
  } else {
    for (int i = tid; i < 1024; i += NT) sS[i] = 0.f;
    float* W = base;
    for (int g2 = 0; g2 < grp; ++g2) {
      const float* Ag = p.g_comp + ((size_t)(hd * 8 + g2) * 2 + 1) * 4096;
      const float* Bg = p.g_comp + ((size_t)(hd * 8 + g2) * 2 + 0) * 4096;
      __syncthreads();
      *(float4*)&W[lr0 * 68 + lc0] = *(const float4*)&Ag[lr0 * 64 + lc0];
      *(float4*)&W[lr1 * 68 + lc0] = *(const float4*)&Ag[lr1 * 64 + lc0];
      __syncthreads();
      f32x4 a = f32x4{0.f, 0.f, 0.f, 0.f};
      if (wave < 4) a = mm16_k64(W + wave * 16 * 68, 68, 1, sS, 16, 1);
      __syncthreads();
      if (wave < 4) {
#pragma unroll
        for (int e = 0; e < 4; ++e) {
          int d = wave * 16 + 4 * qd + e;
          sreg[e] = a[e] + Bg[d * 64 + e0 + r];
          sS[d * 16 + r] = sreg[e];
        }
      }
    }
    __syncthreads();
    if (wave < 4) {
#pragma unroll
      for (int e = 0; e < 4; ++e) {
        int d = wave * 16 + 4 * qd + e;
        p.g_sst[(size_t)(c0 * 4 + hd) * 4096 + d * 64 + e0 + r] = sreg[e];
      }
    }
  }
  GLOAD(c0) LSTORE(0)
  __syncthreads();
  for (int cc = 0; cc < 32; ++cc) {
    const int c = c0 + cc;
    if (cc + 1 < 32) GLOAD(c + 1)
    const float cd = p.g_cdec[c * 4 + hd];
    float* W = base + (cc & 1) * BUFSZ; float* KD = W + 64 * 68; float* U = KD + 64 * 68;
    const size_t it = (size_t)(c * 4 + hd);
    if (wave < 4) {
      f32x4 a1 = mm16_k64(W + wave * 16 * 68, 68, 1, sS, 16, 1);
#pragma unroll
      for (int e = 0; e < 4; ++e) {
        int i = wave * 16 + 4 * qd + e;
        float vn = (apart ? 0.f : U[i * 16 + r]) - a1[e];
        sVN[i * 16 + r] = vn;
        if (MODE == 1) p.g_u[it * 4096 + i * 64 + e0 + r] = vn;
      }
    }
    __syncthreads();
    if (wave < 4) {
      f32x4 a2 = mm16_k64(KD + wave * 16, 1, 68, sVN, 16, 1);
#pragma unroll
      for (int e = 0; e < 4; ++e) {
        int d = wave * 16 + 4 * qd + e;
        sreg[e] = sreg[e] * cd + a2[e];
        sS[d * 16 + r] = sreg[e];
        if (MODE == 1 && cc + 1 < 32) p.g_sst[(size_t)((c + 1) * 4 + hd) * 4096 + d * 64 + e0 + r] = sreg[e];
      }
    }
    if (cc + 1 < 32) LSTORE((cc + 1) & 1)
    __syncthreads();
  }
  if (MODE == 0 && wave < 4) {
    float* dst = p.g_comp + ((size_t)(hd * 8 + grp) * 2 + (apart ? 1 : 0)) * 4096;
#pragma unroll
    for (int e = 0; e < 4; ++e) {
      int d = wave * 16 + 4 * qd + e;
      dst[d * 64 + e0 + r] = sreg[e];
    }
  }
  __syncthreads();
}

DEVI void gdn_out(const Params& p, int l, int item, char* smem) {
  const int c = item >> 2, hd = item & 3, t0 = c * 64;
  float* sQD = (float*)smem; float* sS = sQD + 64 * 68; float* sAT = sS + 64 * 68; float* sVN = sAT + 64 * 68;
  const int tid = TID(), lane = tid & 63, wave = tid >> 6, r = lane & 15, qd = lane >> 4;
  const size_t b = (size_t)item * 4096;
#pragma unroll
  for (int idx = tid; idx < 1024; idx += NT) {
    int row = idx >> 4, c4 = idx & 15;
    *(float4*)&sQD[row * 68 + c4 * 4] = *(const float4*)&p.g_qd[b + row * 64 + c4 * 4];
    *(float4*)&sS[row * 68 + c4 * 4] = *(const float4*)&p.g_sst[b + row * 64 + c4 * 4];
    *(float4*)&sAT[row * 68 + c4 * 4] = *(const float4*)&p.g_attn[b + row * 64 + c4 * 4];
    *(float4*)&sVN[row * 68 + c4 * 4] = *(const float4*)&p.g_u[b + row * 64 + c4 * 4];
  }
  __syncthreads();
  const int mt = wave & 3, nh = wave >> 2;
  f32x4 acc[2]; acc[0] = acc[1] = f32x4{0.f, 0.f, 0.f, 0.f};
  mm16<2>(acc, sQD + mt * 16 * 68, 68, 1, sS + nh * 32, 68, 1, 64);
  mm16<2>(acc, sAT + mt * 16 * 68, 68, 1, sVN + nh * 32, 68, 1, 64);
  __syncthreads();
  float* sO = sQD;
#pragma unroll
  for (int t2 = 0; t2 < 2; ++t2)
#pragma unroll
    for (int e = 0; e < 4; ++e) sO[(mt * 16 + 4 * qd + e) * 68 + nh * 32 + t2 * 16 + r] = acc[t2][e];
  __syncthreads();
  {
    int row = tid >> 3, sub = tid & 7, t = t0 + row;
    float o[8], yv[8]; float ss = 0.f;
#pragma unroll
    for (int k = 0; k < 8; ++k) { o[k] = sO[row * 68 + sub * 8 + k]; ss += o[k] * o[k]; }
    ss += __shfl_xor(ss, 1); ss += __shfl_xor(ss, 2); ss += __shfl_xor(ss, 4);
    float rs = rsqrtf(ss * (1.f / 64.f) + EPS);
    float s2 = 0.f;
#pragma unroll
    for (int k = 0; k < 8; ++k) {
      int col = sub * 8 + k;
      float g = p.proj[(size_t)t * PW + DG + hd * 64 + col];
      float y = o[k] * rs * p.gdn_norm[l * 64 + col] * siluf_(g);
      s2 += y * y;
      yv[k] = y * p.branch_norm[(l * 4 + 3) * 256 + hd * 64 + col];
    }
    s2 += __shfl_xor(s2, 1); s2 += __shfl_xor(s2, 2); s2 += __shfl_xor(s2, 4);
    if (sub == 0) p.ssq[(size_t)t * 16 + 8 + hd] = s2;
    *(uint4*)&p.zb[(size_t)t * DM + 768 + hd * 64 + sub * 8] =
        uint4{pack2(yv[0], yv[1]), pack2(yv[2], yv[3]), pack2(yv[4], yv[5]), pack2(yv[6], yv[7])};
  }
  __syncthreads();
}

DEVI void ret_kv(const Params& p, int l, int item, char* smem) {
  const int c = item >> 2, hd = item & 3, t0 = c * 128;
  float* sK = (float*)smem; float* sV = sK + 128 * 65;
  const int tid = TID(), lane = tid & 63, wave = tid >> 6, r = lane & 15, qd = lane >> 4;
  const float lg = logf(1.f - exp2f(-5.f - (float)hd));
#pragma unroll
  for (int i = tid; i < 128 * 32; i += NT) {
    int t = i >> 5, f = i & 31; size_t tt = t0 + t;
    float k1 = p.proj[tt * PW + RK + hd * 64 + f], k2 = p.proj[tt * PW + RK + hd * 64 + 32 + f];
    float cs = p.rope[(tt * 32 + f) * 2], sn = p.rope[(tt * 32 + f) * 2 + 1];
    float dec = __expf(lg * (float)(127 - t));
    sK[t * 65 + f] = (k1 * cs - k2 * sn) * dec;
    sK[t * 65 + 32 + f] = (k2 * cs + k1 * sn) * dec;
  }
#pragma unroll
  for (int i = tid; i < 128 * 64; i += NT) {
    int t = i >> 6, e = i & 63;
    sV[t * 65 + e] = p.proj[(size_t)(t0 + t) * PW + RV + hd * 64 + e];
  }
  __syncthreads();
  const int mt = wave & 3, nh = wave >> 2;
  f32x4 acc[2]; acc[0] = acc[1] = f32x4{0.f, 0.f, 0.f, 0.f};
  mm16<2>(acc, sK + mt * 16, 1, 65, sV + nh * 32, 65, 1, 128);
#pragma unroll
  for (int t2 = 0; t2 < 2; ++t2)
#pragma unroll
    for (int e = 0; e < 4; ++e)
      p.ret_kv[(size_t)item * 4096 + (mt * 16 + 4 * qd + e) * 64 + nh * 32 + t2 * 16 + r] = acc[t2][e];
  __syncthreads();
}

DEVI void ret_out(const Params& p, int l, int item, char* smem) {
  const int c = item >> 2, hd = item & 3, t0 = c * 128;
  float* sQ = (float*)smem; float* sK = sQ + 128 * 65; float* sV = sK + 128 * 65; float* sSt = sV + 128 * 65;
  const int tid = TID(), lane = tid & 63, wave = tid >> 6, r = lane & 15, qd = lane >> 4;
  const float lg = logf(1.f - exp2f(-5.f - (float)hd));
  {
    const float* ssrc = p.ret_kv + (size_t)(c * 4 + hd) * 4096;
#pragma unroll
    for (int j = 0; j < 8; ++j) { int idx = tid + 512 * j; sSt[(idx >> 6) * 65 + (idx & 63)] = ssrc[idx]; }
  }
#pragma unroll
  for (int i = tid; i < 128 * 32; i += NT) {
    int t = i >> 5, f = i & 31; size_t tt = t0 + t;
    float cs = p.rope[(tt * 32 + f) * 2], sn = p.rope[(tt * 32 + f) * 2 + 1];
    float k1 = p.proj[tt * PW + RK + hd * 64 + f], k2 = p.proj[tt * PW + RK + hd * 64 + 32 + f];
    sK[t * 65 + f] = (k1 * cs - k2 * sn);
    sK[t * 65 + 32 + f] = (k2 * cs + k1 * sn);
    float q1 = p.proj[tt * PW + RQ + hd * 64 + f], q2 = p.proj[tt * PW + RQ + hd * 64 + 32 + f];
    sQ[t * 65 + f] = (q1 * cs - q2 * sn) * 0.125f;
    sQ[t * 65 + 32 + f] = (q2 * cs + q1 * sn) * 0.125f;
  }
#pragma unroll
  for (int i = tid; i < 128 * 64; i += NT) {
    int t = i >> 6, e = i & 63;
    sV[t * 65 + e] = p.proj[(size_t)(t0 + t) * PW + RV + hd * 64 + e];
  }
  __syncthreads();
  const int i0 = wave * 16;
  f32x4 sc[8], os[4];
#pragma unroll
  for (int t = 0; t < 8; ++t) sc[t] = f32x4{0.f, 0.f, 0.f, 0.f};
#pragma unroll
  for (int t = 0; t < 4; ++t) os[t] = f32x4{0.f, 0.f, 0.f, 0.f};
  mm16<8>(sc, sQ + i0 * 65, 65, 1, sK, 1, 65, 64);
  mm16<4>(os, sQ + i0 * 65, 65, 1, sSt, 65, 1, 64);
  __syncthreads();
  float* sP = (float*)smem;
#pragma unroll
  for (int t2 = 0; t2 < 8; ++t2)
#pragma unroll
    for (int e = 0; e < 4; ++e) {
      int i = i0 + 4 * qd + e, j = t2 * 16 + r;
      sP[i * 129 + j] = (i >= j) ? sc[t2][e] * __expf(lg * (float)(i - j)) : 0.f;
    }
  __syncthreads();
  f32x4 o[4];
#pragma unroll
  for (int t2 = 0; t2 < 4; ++t2)
#pragma unroll
    for (int e = 0; e < 4; ++e) o[t2][e] = os[t2][e] * __expf(lg * (float)(i0 + 4 * qd + e + 1));
  mm16<4>(o, sP + i0 * 129, 129, 1, sV, 65, 1, 128);
#pragma unroll
  for (int e = 0; e < 4; ++e) {
    int i = i0 + 4 * qd + e; size_t t = t0 + i;
    float sm = sum16(o[0][e] + o[1][e] + o[2][e] + o[3][e]);
    float mu = sm * (1.f / 64.f);
    float vr = 0.f;
#pragma unroll
    for (int t2 = 0; t2 < 4; ++t2) { float dd = o[t2][e] - mu; vr += dd * dd; }
    vr = sum16(vr);
    float rstd = rsqrtf(vr * (1.f / 64.f) + EPS);
    float ss = 0.f;
#pragma unroll
    for (int t2 = 0; t2 < 4; ++t2) {
      int col = hd * 64 + t2 * 16 + r;
      float on = (o[t2][e] - mu) * rstd * p.ret_gn[l * 256 + col];
      float g = p.proj[t * PW + RG + col];
      float y = siluf_(g) * on;
      ss += y * y;
      p.zb[t * DM + col] = f2bf(y * p.branch_norm[(l * 4 + 0) * 256 + col]);
    }
    ss = sum16(ss);
    if (r == 0) p.ssq[t * 16 + hd] = ss;
  }
  __syncthreads();
}

DEVI void lru_local(const Params& p, int l, int c, char* smem) {
  const int t0 = c * 64;
  float* sX = (float*)smem; float* sA = sX + 64 * 257;
  const int tid = TID(), lane = tid & 63, wave = tid >> 6, r = lane & 15, qd = lane >> 4;
  {
    const int ch = tid & 255, half = tid >> 8;
    const float w0 = p.lru_conv_w[(l * 4 + 0) * 256 + ch], w1 = p.lru_conv_w[(l * 4 + 1) * 256 + ch];
    const float w2 = p.lru_conv_w[(l * 4 + 2) * 256 + ch], w3 = p.lru_conv_w[(l * 4 + 3) * 256 + ch];
    const float cb = p.lru_conv_b[l * 256 + ch];
    const float* pc = p.proj + LX + ch;
    float xv[35];
#pragma unroll
    for (int k = 0; k < 35; ++k) {
      const int tt = t0 + 32 * half - 3 + k;
      const float v = pc[(size_t)(tt < 0 ? 0 : tt) * PW];
      xv[k] = tt < 0 ? 0.f : v;
    }
#pragma unroll
    for (int m = 0; m < 32; ++m) {
      float acc = cb;
      acc += w0 * xv[m]; acc += w1 * xv[m + 1]; acc += w2 * xv[m + 2]; acc += w3 * xv[m + 3];
      sX[(32 * half + m) * 257 + ch] = acc;
    }
  }
  __syncthreads();
  for (int pr = 0; pr < 2; ++pr) {
    int pi = wave * 2 + pr, mt = pi & 3, nb = pi >> 2;
    f32x4 ra[4], ri[4];
#pragma unroll
    for (int t = 0; t < 4; ++t) { ra[t] = f32x4{0.f, 0.f, 0.f, 0.f}; ri[t] = f32x4{0.f, 0.f, 0.f, 0.f}; }
    mm16_gB64<4>(ra, sX + mt * 16 * 257 + nb * 64, 257, p.lru_w_a + (size_t)(l * 4 + nb) * 4096);
    mm16_gB64<4>(ri, sX + mt * 16 * 257 + nb * 64, 257, p.lru_w_x + (size_t)(l * 4 + nb) * 4096);
#pragma unroll
    for (int t2 = 0; t2 < 4; ++t2)
#pragma unroll
      for (int e = 0; e < 4; ++e) {
        int t = mt * 16 + 4 * qd + e, ch = nb * 64 + t2 * 16 + r;
        float xb = sX[t * 257 + ch];
        float rr = sigmoidf_(ra[t2][e] + p.lru_b_a[l * 256 + ch]);
        float ii = sigmoidf_(ri[t2][e] + p.lru_b_x[l * 256 + ch]);
        float loga = -8.f * rr * softplusf_(-p.lru_lambda[l * 256 + ch]);
        float a = __expf(loga);
        float bb = __builtin_amdgcn_sqrtf(fmaxf(1.f - a * a, 0.f)) * (ii * xb);
        sA[t * 257 + ch] = a; sX[t * 257 + ch] = bb;
      }
  }
  __syncthreads();
  if (tid < 256) {
    int ch = tid; float H = 0.f, P = 1.f;
    for (int t = 0; t < 64; ++t) {
      float a = sA[t * 257 + ch], bb = sX[t * 257 + ch];
      H = a * H + bb; P *= a;
      p.lru_h[(size_t)(t0 + t) * 256 + ch] = H; p.lru_p[(size_t)(t0 + t) * 256 + ch] = P;
    }
    p.lru_hs[c * 256 + ch] = H; p.lru_ps[c * 256 + ch] = P;
  }
  __syncthreads();
}

DEVI void lru_out(const Params& p, int l, int c, char* smem) {
  const int t0 = c * 64;
  float* sC = (float*)smem;
  const int tid = TID(), lane = tid & 63, wave = tid >> 6;
  if (tid < 256) sC[tid] = p.lru_hs[c * 256 + tid];
  __syncthreads();
  {
    const int ch = lane * 4;
    float4 Hs[8], Ps[8], gs[8];
#pragma unroll
    for (int tk = 0; tk < 8; ++tk) {
      const size_t t = t0 + wave * 8 + tk;
      Hs[tk] = *(const float4*)&p.lru_h[t * 256 + ch]; Ps[tk] = *(const float4*)&p.lru_p[t * 256 + ch];
      gs[tk] = *(const float4*)&p.proj[t * PW + LG + ch];
    }
    const float4 cr = *(const float4*)&sC[ch];
    const float4 bn = *(const float4*)&p.branch_norm[(l * 4 + 1) * 256 + ch];
#pragma unroll
    for (int tk = 0; tk < 8; ++tk) {
      const size_t t = t0 + wave * 8 + tk;
      const float4 H = Hs[tk], P = Ps[tk], g = gs[tk];
      float y0 = geluf_(g.x) * (H.x + P.x * cr.x), y1 = geluf_(g.y) * (H.y + P.y * cr.y);
      float y2 = geluf_(g.z) * (H.z + P.z * cr.z), y3 = geluf_(g.w) * (H.w + P.w * cr.w);
      float ss = wave_sum(y0 * y0 + y1 * y1 + y2 * y2 + y3 * y3);
      if (lane == 0) p.ssq[t * 16 + 4] = ss;
      *(uint2*)&p.zb[t * DM + 256 + ch] = uint2{pack2(y0 * bn.x, y1 * bn.y), pack2(y2 * bn.z, y3 * bn.w)};
    }
  }
  __syncthreads();
}

DEVI void s5_coef(const Params& p, int l, int g, int n, float& abr, float& abi, float (&bbr)[16], float (&bbi)[16]) {
  float dt = __expf(p.s5_log_dt[l * 16 + g]);
  float are = p.s5_a_re[(l * 16 + g) * 64 + n], aim = p.s5_a_im[(l * 16 + g) * 64 + n];
  float mag = __expf(are * dt), ang = aim * dt;
  abr = mag * cosf(ang); abi = mag * sinf(ang);
  float den = are * are + aim * aim;
  float pre = abr - 1.f, pim = abi;
  float fre = (pre * are + pim * aim) / den, fim = (pim * are - pre * aim) / den;
  const float4* br = (const float4*)(p.s5_b_re + (size_t)((l * 16 + g) * 64 + n) * 16);
  const float4* bi = (const float4*)(p.s5_b_im + (size_t)((l * 16 + g) * 64 + n) * 16);
#pragma unroll
  for (int c4 = 0; c4 < 4; ++c4) {
    float4 a = br[c4], b = bi[c4];
    bbr[c4 * 4 + 0] = fre * a.x - fim * b.x; bbi[c4 * 4 + 0] = fre * b.x + fim * a.x;
    bbr[c4 * 4 + 1] = fre * a.y - fim * b.y; bbi[c4 * 4 + 1] = fre * b.y + fim * a.y;
    bbr[c4 * 4 + 2] = fre * a.z - fim * b.z; bbi[c4 * 4 + 2] = fre * b.z + fim * a.z;
    bbr[c4 * 4 + 3] = fre * a.w - fim * b.w; bbi[c4 * 4 + 3] = fre * b.w + fim * a.w;
  }
}
DEVI void s5_load_u(const Params& p, int t0, float* sU) {
#pragma unroll
  for (int i = TID(); i < 64 * 64; i += NT) {
    int t = i >> 6, c4 = i & 63;
    *(float4*)&sU[t * 256 + c4 * 4] = *(const float4*)&p.proj[(size_t)(t0 + t) * PW + SU + c4 * 4];
  }
}
DEVI void s5_bu(const float* up, const float (&bbr)[16], const float (&bbi)[16], float& bur, float& bui) {
  bur = 0.f; bui = 0.f;
#pragma unroll
  for (int c4 = 0; c4 < 4; ++c4) {
    float4 u = *(const float4*)&up[c4 * 4];
    bur += bbr[c4 * 4] * u.x + bbr[c4 * 4 + 1] * u.y + bbr[c4 * 4 + 2] * u.z + bbr[c4 * 4 + 3] * u.w;
    bui += bbi[c4 * 4] * u.x + bbi[c4 * 4 + 1] * u.y + bbi[c4 * 4 + 2] * u.z + bbi[c4 * 4 + 3] * u.w;
  }
}

DEVI void s5_local(const Params& p, int l, int c, char* smem) {
  const int t0 = c * 64;
  float* sU = (float*)smem;
  const int lane = TID() & 63, wave = TID() >> 6;
  s5_load_u(p, t0, sU);
  __syncthreads();
  for (int gi = 0; gi < 2; ++gi) {
    int g = wave + 8 * gi;
    float abr, abi, bbr[16], bbi[16];
    s5_coef(p, l, g, lane, abr, abi, bbr, bbi);
    float xr = 0.f, xi = 0.f;
    for (int t = 0; t < 64; ++t) {
      float bur, bui; s5_bu(sU + t * 256 + g * 16, bbr, bbi, bur, bui);
      float nr = abr * xr - abi * xi + bur, ni = abr * xi + abi * xr + bui;
      xr = nr; xi = ni;
    }
    *(float2*)&p.xloc[((size_t)(c * 16 + g) * 64 + lane) * 2] = float2{xr, xi};
  }
  __syncthreads();
}

DEVI void s5_out(const Params& p, int l, int c, char* smem) {
  const int t0 = c * 64;
  bf16_t* sY = (bf16_t*)smem;
  float* sX = (float*)(smem + 64 * 264 * 2);
  const int tid = TID(), lane = tid & 63, wave = tid >> 6, r = lane & 15, qd = lane >> 4;
  float* Xl = sX + wave * (16 * 132);
  for (int gi = 0; gi < 2; ++gi) {
    const int g = wave + 8 * gi;
    float abr, abi, bbr[16], bbi[16];
    s5_coef(p, l, g, lane, abr, abi, bbr, bbi);
    float breg[32];
#pragma unroll
    for (int ks = 0; ks < 16; ++ks) {
      breg[ks] = p.s5_c_re[(size_t)((l * 16 + g) * 16 + r) * 64 + 4 * ks + qd];
      breg[16 + ks] = -p.s5_c_im[(size_t)((l * 16 + g) * 16 + r) * 64 + 4 * ks + qd];
    }
    const float dd = p.s5_d[l * 256 + g * 16 + r];
    const float2 xin = *(const float2*)&p.xloc[((size_t)(c * 16 + g) * 64 + lane) * 2];
    float xr = xin.x, xi = xin.y;
    float4 uvecs[4]; float ues[4][4];
#pragma unroll
    for (int tb = 0; tb < 4; ++tb) {
      const float* ub = p.proj + (size_t)(t0 + tb * 16) * PW + SU + g * 16;
      uvecs[tb] = *(const float4*)&ub[(size_t)r * PW + 4 * qd];
#pragma unroll
      for (int e = 0; e < 4; ++e) ues[tb][e] = ub[(size_t)(4 * qd + e) * PW + r];
    }
#pragma unroll
    for (int tb = 0; tb < 4; ++tb) {
      const float4 uvec = uvecs[tb];
      float ue[4];
#pragma unroll
      for (int e = 0; e < 4; ++e) ue[e] = ues[tb][e];
      const int u0 = __float_as_int(uvec.x), u1 = __float_as_int(uvec.y), u2 = __float_as_int(uvec.z), u3 = __float_as_int(uvec.w);
#pragma unroll
      for (int tt = 0; tt < 16; ++tt) {
        float bur = 0.f, bui = 0.f;
#pragma unroll
        for (int c4 = 0; c4 < 4; ++c4) {
          float a0 = __int_as_float(__builtin_amdgcn_readlane(u0, tt + 16 * c4));
          float a1 = __int_as_float(__builtin_amdgcn_readlane(u1, tt + 16 * c4));
          float a2 = __int_as_float(__builtin_amdgcn_readlane(u2, tt + 16 * c4));
          float a3 = __int_as_float(__builtin_amdgcn_readlane(u3, tt + 16 * c4));
          bur += bbr[c4 * 4] * a0 + bbr[c4 * 4 + 1] * a1 + bbr[c4 * 4 + 2] * a2 + bbr[c4 * 4 + 3] * a3;
          bui += bbi[c4 * 4] * a0 + bbi[c4 * 4 + 1] * a1 + bbi[c4 * 4 + 2] * a2 + bbi[c4 * 4 + 3] * a3;
        }
        float nr = abr * xr - abi * xi + bur, ni = abr * xi + abi * xr + bui;
        xr = nr; xi = ni;
        Xl[tt * 132 + lane] = xr; Xl[tt * 132 + 64 + lane] = xi;
      }
      f32x4 acc = f32x4{0.f, 0.f, 0.f, 0.f};
#pragma unroll
      for (int ks = 0; ks < 32; ++ks) {
        float a = Xl[r * 132 + 4 * ks + qd];
        acc = __builtin_amdgcn_mfma_f32_16x16x4f32(a, breg[ks], acc, 0, 0, 0);
      }
#pragma unroll
      for (int e = 0; e < 4; ++e) {
        float y = acc[e] + dd * ue[e];
        sY[(tb * 16 + 4 * qd + e) * 264 + g * 16 + r] = f2bf(geluf_(y));
      }
    }
  }
  __syncthreads();
  f32x4 av[4][2], ag[4][2];
#pragma unroll
  for (int i = 0; i < 4; ++i)
#pragma unroll
    for (int j = 0; j < 2; ++j) { av[i][j] = f32x4{0.f, 0.f, 0.f, 0.f}; ag[i][j] = f32x4{0.f, 0.f, 0.f, 0.f}; }
  const bf16_t* WT = p.gluT + (size_t)l * 512 * 256;
#pragma unroll 4
  for (int ks = 0; ks < 8; ++ks) {
    bf16x8 bv0 = *(const bf16x8*)&WT[(size_t)(32 * wave + r) * 256 + ks * 32 + qd * 8];
    bf16x8 bv1 = *(const bf16x8*)&WT[(size_t)(32 * wave + 16 + r) * 256 + ks * 32 + qd * 8];
    bf16x8 bg0 = *(const bf16x8*)&WT[(size_t)(256 + 32 * wave + r) * 256 + ks * 32 + qd * 8];
    bf16x8 bg1 = *(const bf16x8*)&WT[(size_t)(256 + 32 * wave + 16 + r) * 256 + ks * 32 + qd * 8];
#pragma unroll
    for (int mt = 0; mt < 4; ++mt) {
      bf16x8 a = *(const bf16x8*)&sY[(mt * 16 + r) * 264 + ks * 32 + qd * 8];
      av[mt][0] = __builtin_amdgcn_mfma_f32_16x16x32_bf16(a, bv0, av[mt][0], 0, 0, 0);
      av[mt][1] = __builtin_amdgcn_mfma_f32_16x16x32_bf16(a, bv1, av[mt][1], 0, 0, 0);
      ag[mt][0] = __builtin_amdgcn_mfma_f32_16x16x32_bf16(a, bg0, ag[mt][0], 0, 0, 0);
      ag[mt][1] = __builtin_amdgcn_mfma_f32_16x16x32_bf16(a, bg1, ag[mt][1], 0, 0, 0);
    }
  }
  float* sO = sX;
#pragma unroll
  for (int mt = 0; mt < 4; ++mt)
#pragma unroll
    for (int t2 = 0; t2 < 2; ++t2)
#pragma unroll
      for (int e = 0; e < 4; ++e) {
        int t = mt * 16 + 4 * qd + e, col = 32 * wave + t2 * 16 + r;
        float zv = av[mt][t2][e] + p.s5_glu_b[l * 512 + col];
        float zg = ag[mt][t2][e] + p.s5_glu_b[l * 512 + 256 + col];
        sO[t * 256 + col] = zv * sigmoidf_(zg);
      }
  __syncthreads();
  for (int tk = 0; tk < 8; ++tk) {
    int tl = wave * 8 + tk; size_t t = t0 + tl; int ch = lane * 4;
    float4 o = *(const float4*)&sO[tl * 256 + ch];
    float4 bn = *(const float4*)&p.branch_norm[(l * 4 + 2) * 256 + ch];
    float ss = wave_sum(o.x * o.x + o.y * o.y + o.z * o.z + o.w * o.w);
    if (lane == 0) p.ssq[t * 16 + 5] = ss;
    *(uint2*)&p.zb[t * DM + 512 + ch] = uint2{pack2(o.x * bn.x, o.y * bn.y), pack2(o.z * bn.z, o.w * bn.w)};
  }
  __syncthreads();
}

DEVI void ret_scan(const Params& p, int it) {
  const int elem = it * NT + TID(), hd = elem >> 12, idx = elem & 4095;
  const float lg = logf(1.f - exp2f(-5.f - (float)hd)), cdk = __expf(lg * 128.f);
  float* base = p.ret_kv + (size_t)hd * 4096 + idx;
  float s = 0.f;
  for (int cb = 0; cb < 128; cb += 16) {
    float v[16];
#pragma unroll
    for (int j = 0; j < 16; ++j) v[j] = base[(size_t)(cb + j) * 16384];
#pragma unroll
    for (int j = 0; j < 16; ++j) { base[(size_t)(cb + j) * 16384] = s; s = s * cdk + v[j]; }
  }
}
DEVI void s5_scan(const Params& p, int l, int it) {
  const int sidx = it * NT + TID(), g = sidx >> 6, n = sidx & 63;
  float dt = __expf(p.s5_log_dt[l * 16 + g]);
  float are = p.s5_a_re[(l * 16 + g) * 64 + n], aim = p.s5_a_im[(l * 16 + g) * 64 + n];
  float mag = __expf(are * dt), ang = aim * dt;
  float pr = mag * cosf(ang), pi = mag * sinf(ang);
#pragma unroll
  for (int k = 0; k < 6; ++k) { float nr = pr * pr - pi * pi, ni = 2.f * pr * pi; pr = nr; pi = ni; }
  float2* base = (float2*)p.xloc + sidx;
  float xr = 0.f, xi = 0.f;
  for (int cb = 0; cb < 256; cb += 16) {
    float2 v[16];
#pragma unroll
    for (int j = 0; j < 16; ++j) v[j] = base[(size_t)(cb + j) * 1024];
#pragma unroll
    for (int j = 0; j < 16; ++j) {
      base[(size_t)(cb + j) * 1024] = float2{xr, xi};
      float nr = pr * xr - pi * xi + v[j].x, ni = pr * xi + pi * xr + v[j].y;
      xr = nr; xi = ni;
    }
  }
}
DEVI void lru_scan(const Params& p) {
  const int ch = TID();
  if (ch < 256) {
    float carry = 0.f;
    for (int cb = 0; cb < 256; cb += 16) {
      float ps[16], hs[16];
#pragma unroll
      for (int j = 0; j < 16; ++j) { ps[j] = p.lru_ps[(cb + j) * 256 + ch]; hs[j] = p.lru_hs[(cb + j) * 256 + ch]; }
#pragma unroll
      for (int j = 0; j < 16; ++j) { p.lru_hs[(cb + j) * 256 + ch] = carry; carry = ps[j] * carry + hs[j]; }
    }
  }
}

DEVI void peer_scores(const Params& p, int l, int item, char* smem) {
  const int hp = item & 15, grp = item >> 4;
  float* sQ = (float*)smem;
  float* sKy = sQ + 64 * 68;
  const int tid = TID(), lane = tid & 63, wave = tid >> 6, r = lane & 15, qd = lane >> 4;
  const float* ky = p.peer_subkeys + (size_t)(l * 16 + hp) * 8192;
#pragma unroll
  for (int i = tid; i < 128 * 64; i += NT) { int k = i >> 6, d = i & 63; sKy[k * 65 + d] = ky[i]; }
  const int lt0 = tid >> 4, lc4 = (tid & 15) * 4;
  const float* qb = p.qbuf + (size_t)hp * 64 + lc4;
  float4 q0, q1;
  {
    const size_t t0 = (size_t)(grp * 16) * 64;
    q0 = *(const float4*)&qb[(t0 + lt0) * 1024]; q1 = *(const float4*)&qb[(t0 + lt0 + 32) * 1024];
  }
  const int mt = wave & 3, nh = wave >> 2;
  for (int k = 0; k < 16; ++k) {
    const size_t t0 = (size_t)(grp * 16 + k) * 64;
    __syncthreads();
    *(float4*)&sQ[lt0 * 68 + lc4] = q0; *(float4*)&sQ[(lt0 + 32) * 68 + lc4] = q1;
    __syncthreads();
    if (k + 1 < 16) { q0 = *(const float4*)&qb[(t0 + 64 + lt0) * 1024]; q1 = *(const float4*)&qb[(t0 + 64 + lt0 + 32) * 1024]; }
    f32x4 acc[4];
#pragma unroll
    for (int t = 0; t < 4; ++t) acc[t] = f32x4{0.f, 0.f, 0.f, 0.f};
    mm16<4>(acc, sQ + mt * 16 * 68, 68, 1, sKy + nh * 64 * 65, 1, 65, 64);
#pragma unroll
    for (int t2 = 0; t2 < 4; ++t2)
#pragma unroll
      for (int e = 0; e < 4; ++e) {
        size_t t = t0 + mt * 16 + 4 * qd + e; int key = nh * 64 + t2 * 16 + r;
        p.scores[(t * 16 + hp) * 128 + key] = acc[t2][e];
      }
  }
  __syncthreads();
}

DEVI unsigned ford(float x) { unsigned u = __float_as_uint(x); return (u & 0x80000000u) ? ~u : (u | 0x80000000u); }
DEVI float funord(unsigned u) { return __uint_as_float((u & 0x80000000u) ? (u ^ 0x80000000u) : ~u); }
DEVI void ins16(unsigned (&v)[16], unsigned x) {
#pragma unroll
  for (int j = 0; j < 16; ++j) { unsigned hi = max(v[j], x); x = min(v[j], x); v[j] = hi; }
}

DEVI void cv_issue(const Params& p, int l, int rr, int lane, float4& a, float4& b, float4& c, float4& d) {
  const int which = rr >> 14, row = rr & 16383;
  const float* s = (which ? p.peer_v : p.peer_u) + ((size_t)l * 16384 + row) * 1024 + lane * 16;
  a = *(const float4*)s; b = *(const float4*)(s + 4); c = *(const float4*)(s + 8); d = *(const float4*)(s + 12);
}
DEVI void cv_finish(const Params& p, int rr, int lane, const float4& a, const float4& b, const float4& c, const float4& d) {
  const int which = rr >> 14, row = rr & 16383;
  float m = fmaxf(fmaxf(fmaxf(fabsf(a.x), fabsf(a.y)), fmaxf(fabsf(a.z), fabsf(a.w))),
                  fmaxf(fmaxf(fabsf(b.x), fabsf(b.y)), fmaxf(fabsf(b.z), fabsf(b.w))));
  m = fmaxf(m, fmaxf(fmaxf(fmaxf(fabsf(c.x), fabsf(c.y)), fmaxf(fabsf(c.z), fabsf(c.w))),
                     fmaxf(fmaxf(fabsf(d.x), fabsf(d.y)), fmaxf(fabsf(d.z), fabsf(d.w)))));
  m = fmaxf(m, __shfl_xor(m, 32)); m = fmaxf(m, __shfl_xor(m, 16)); m = fmaxf(m, __shfl_xor(m, 8));
  m = fmaxf(m, __shfl_xor(m, 4)); m = fmaxf(m, __shfl_xor(m, 2)); m = fmaxf(m, __shfl_xor(m, 1));
  const float sc = m > 0.f ? 256.f / m : 1.f;
  int w0 = 0, w1 = 0, w2 = 0, w3 = 0;
  w0 = __builtin_amdgcn_cvt_pk_fp8_f32(a.x * sc, a.y * sc, w0, false); w0 = __builtin_amdgcn_cvt_pk_fp8_f32(a.z * sc, a.w * sc, w0, true);
  w1 = __builtin_amdgcn_cvt_pk_fp8_f32(b.x * sc, b.y * sc, w1, false); w1 = __builtin_amdgcn_cvt_pk_fp8_f32(b.z * sc, b.w * sc, w1, true);
  w2 = __builtin_amdgcn_cvt_pk_fp8_f32(c.x * sc, c.y * sc, w2, false); w2 = __builtin_amdgcn_cvt_pk_fp8_f32(c.z * sc, c.w * sc, w2, true);
  w3 = __builtin_amdgcn_cvt_pk_fp8_f32(d.x * sc, d.y * sc, w3, false); w3 = __builtin_amdgcn_cvt_pk_fp8_f32(d.z * sc, d.w * sc, w3, true);
  *(uint4*)((which ? p.tabV : p.tabU) + (size_t)row * 1024 + lane * 16) = uint4{(unsigned)w0, (unsigned)w1, (unsigned)w2, (unsigned)w3};
  if (lane == 0) (which ? p.vinv : p.uinv)[row] = m > 0.f ? m * (1.f / 256.f) : 1.f;
}

DEVI void peer_topk(const Params& p, int l, int item, int cvbase, char* smem) {
  const int t0 = item * 64;
  float* sS = (float*)smem;
  const int tid = TID();
  const float* base = p.scores + (size_t)t0 * 8 * 256;
  unsigned v1[16], v2[16];
#pragma unroll
  for (int j = 0; j < 16; ++j) { v1[j] = 0u; v2[j] = 0u; }
  float4 nx[8];
#pragma unroll
  for (int i = 0; i < 8; ++i) { int idx = tid + 512 * i; nx[i] = *(const float4*)&base[(size_t)(idx >> 3) * 256 + (idx & 7) * 4]; }
  for (int s = 0; s < 8; ++s) {
    __syncthreads();
#pragma unroll
    for (int i = 0; i < 8; ++i) {
      int idx = tid + 512 * i, pr = idx >> 3, c4 = idx & 7;
      float* d = &sS[pr * 33 + c4 * 4];
      d[0] = nx[i].x; d[1] = nx[i].y; d[2] = nx[i].z; d[3] = nx[i].w;
    }
    __syncthreads();
    if (s + 1 < 8) {
#pragma unroll
      for (int i = 0; i < 8; ++i) { int idx = tid + 512 * i; nx[i] = *(const float4*)&base[(size_t)(idx >> 3) * 256 + (s + 1) * 32 + (idx & 7) * 4]; }
    }
    float4 ca0, cb0, cc0, cd0, ca1, cb1, cc1, cd1;
    if (cvbase >= 0) {
      cv_issue(p, l, cvbase + 2 * s, tid & 63, ca0, cb0, cc0, cd0);
      cv_issue(p, l, cvbase + 2 * s + 1, tid & 63, ca1, cb1, cc1, cd1);
    }
    const int kb = (s & 3) * 32;
    if (s < 4) {
      for (int k = 0; k < 32; ++k) { unsigned key = (ford(sS[tid * 33 + k]) & ~127u) | (unsigned)(127 - (kb + k)); ins16(v1, key); }
    } else {
      for (int k = 0; k < 32; ++k) { unsigned key = (ford(sS[tid * 33 + k]) & ~127u) | (unsigned)(127 - (kb + k)); ins16(v2, key); }
    }
    if (cvbase >= 0) {
      cv_finish(p, cvbase + 2 * s, tid & 63, ca0, cb0, cc0, cd0);
      cv_finish(p, cvbase + 2 * s + 1, tid & 63, ca1, cb1, cc1, cd1);
    }
  }
  __syncthreads();
  unsigned* sI = (unsigned*)smem;
  float s1[16], s2[16];
#pragma unroll
  for (int a = 0; a < 16; ++a) {
    s1[a] = funord(v1[a] & ~127u); s2[a] = funord(v2[a] & ~127u);
    sI[tid * 33 + a] = 127u - (v1[a] & 127u); sI[tid * 33 + 16 + a] = 127u - (v2[a] & 127u);
  }
  unsigned vt[16];
#pragma unroll
  for (int j = 0; j < 16; ++j) vt[j] = 0u;
#pragma unroll
  for (int a = 0; a < 16; ++a)
#pragma unroll
    for (int b = 0; b < 16; ++b)
      if ((a + 1) * (b + 1) <= 16) {
        unsigned key = (ford(s1[a] + s2[b]) & ~255u) | (unsigned)(255 - (a * 16 + b));
        ins16(vt, key);
      }
  float sv[16]; float den = 0.f;
  const float mx = funord(vt[0] & ~255u);
#pragma unroll
  for (int k = 0; k < 16; ++k) { sv[k] = __expf(funord(vt[k] & ~255u) - mx); den += sv[k]; }
  const float inv = 1.f / den;
  const int tl = tid >> 3, hh = tid & 7;
  int* idp = p.ids + (size_t)(t0 + tl) * 128 + hh * 16;
  float* gp = p.gates + (size_t)(t0 + tl) * 128 + hh * 16;
#pragma unroll
  for (int k = 0; k < 16; ++k) {
    unsigned pos = 255u - (vt[k] & 255u);
    unsigned i1 = sI[tid * 33 + (pos >> 4)], i2 = sI[tid * 33 + 16 + (pos & 15)];
    idp[k] = (int)(i1 * 128u + i2);
    gp[k] = sv[k] * inv;
  }
  __syncthreads();
}

typedef __attribute__((ext_vector_type(2))) float f32x2;
DEVI void fp8x16_to_f(const uint4& v, float (&o)[16]) {
  f32x2 t;
  t = __builtin_amdgcn_cvt_pk_f32_fp8((int)v.x, false); o[0] = t[0]; o[1] = t[1];
  t = __builtin_amdgcn_cvt_pk_f32_fp8((int)v.x, true); o[2] = t[0]; o[3] = t[1];
  t = __builtin_amdgcn_cvt_pk_f32_fp8((int)v.y, false); o[4] = t[0]; o[5] = t[1];
  t = __builtin_amdgcn_cvt_pk_f32_fp8((int)v.y, true); o[6] = t[0]; o[7] = t[1];
  t = __builtin_amdgcn_cvt_pk_f32_fp8((int)v.z, false); o[8] = t[0]; o[9] = t[1];
  t = __builtin_amdgcn_cvt_pk_f32_fp8((int)v.z, true); o[10] = t[0]; o[11] = t[1];
  t = __builtin_amdgcn_cvt_pk_f32_fp8((int)v.w, false); o[12] = t[0]; o[13] = t[1];
  t = __builtin_amdgcn_cvt_pk_f32_fp8((int)v.w, true); o[14] = t[0]; o[15] = t[1];
}

DEVI void ph_gather(const Params& p, int l) {
  const int lane = TID() & 63, wave = TID() >> 6;
  const int e0 = lane * 16;
  constexpr int NB = 8;
  for (int t = blockIdx.x * 8 + wave; t < S_; t += gridDim.x * 8) {
    float* hrow = p.h + (size_t)t * DM + e0;
    float z[16], out[16];
    {
      float4 a = *(const float4*)&hrow[0], b = *(const float4*)&hrow[4], c = *(const float4*)&hrow[8], d = *(const float4*)&hrow[12];
      z[0] = a.x; z[1] = a.y; z[2] = a.z; z[3] = a.w; z[4] = b.x; z[5] = b.y; z[6] = b.z; z[7] = b.w;
      z[8] = c.x; z[9] = c.y; z[10] = c.z; z[11] = c.w; z[12] = d.x; z[13] = d.y; z[14] = d.z; z[15] = d.w;
    }
    float ss = 0.f;
#pragma unroll
    for (int k = 0; k < 16; ++k) { ss += z[k] * z[k]; out[k] = 0.f; }
    ss = wave_sum(ss);
    const float rs = rsqrtf(ss * (1.f / DM) + EPS);
    const float* fn = p.ffn_norm + l * DM + e0;
#pragma unroll
    for (int k = 0; k < 16; ++k) z[k] = z[k] * rs * fn[k];
    const int id0 = p.ids[(size_t)t * 128 + lane], id1 = p.ids[(size_t)t * 128 + 64 + lane];
    const int gv0 = __float_as_int(p.gates[(size_t)t * 128 + lane] * p.vinv[id0]);
    const int gv1 = __float_as_int(p.gates[(size_t)t * 128 + 64 + lane] * p.vinv[id1]);
    const int us0 = __float_as_int(p.uinv[id0]), us1 = __float_as_int(p.uinv[id1]);
    uint4 cu[NB], cv[NB], nu[NB], nv[NB];
#pragma unroll
    for (int j = 0; j < NB; ++j) {
      int e = __builtin_amdgcn_readlane(id0, j);
      cu[j] = *(const uint4*)(p.tabU + (size_t)e * 1024 + e0);
      cv[j] = *(const uint4*)(p.tabV + (size_t)e * 1024 + e0);
    }
#pragma unroll 1
    for (int b = 0; b < 128 / NB; ++b) {
      const int nb = b + 1;
      if (nb < 128 / NB) {
        const int idn = nb < 64 / NB ? id0 : id1;
#pragma unroll
        for (int j = 0; j < NB; ++j) {
          int e = __builtin_amdgcn_readlane(idn, (nb * NB + j) & 63);
          nu[j] = *(const uint4*)(p.tabU + (size_t)e * 1024 + e0);
          nv[j] = *(const uint4*)(p.tabV + (size_t)e * 1024 + e0);
        }
      }
      const int gvc = b < 64 / NB ? gv0 : gv1, usc = b < 64 / NB ? us0 : us1;
      float dot[NB];
#pragma unroll
      for (int j = 0; j < NB; ++j) {
        float f[16]; fp8x16_to_f(cu[j], f);
        float d = 0.f;
#pragma unroll
        for (int k = 0; k < 16; ++k) d += z[k] * f[k];
        dot[j] = d;
      }
#pragma unroll
      for (int j = 0; j < NB; ++j) dot[j] = wave_sum(dot[j]);
#pragma unroll
      for (int j = 0; j < NB; ++j) {
        const int li = (b * NB + j) & 63;
        float us = __int_as_float(__builtin_amdgcn_readlane(usc, li));
        float gt = __int_as_float(__builtin_amdgcn_readlane(gvc, li));
        float cf = gt * geluf_ref_(dot[j] * us);
        float f[16]; fp8x16_to_f(cv[j], f);
#pragma unroll
        for (int k = 0; k < 16; ++k) out[k] += cf * f[k];
      }
#pragma unroll
      for (int j = 0; j < NB; ++j) { cu[j] = nu[j]; cv[j] = nv[j]; }
    }
    float hv[16];
    {
      float4 a = *(const float4*)&hrow[0], b = *(const float4*)&hrow[4], c = *(const float4*)&hrow[8], d = *(const float4*)&hrow[12];
      hv[0] = a.x; hv[1] = a.y; hv[2] = a.z; hv[3] = a.w; hv[4] = b.x; hv[5] = b.y; hv[6] = b.z; hv[7] = b.w;
      hv[8] = c.x; hv[9] = c.y; hv[10] = c.z; hv[11] = c.w; hv[12] = d.x; hv[13] = d.y; hv[14] = d.z; hv[15] = d.w;
    }
    float s2 = 0.f;
#pragma unroll
    for (int k = 0; k < 16; ++k) { hv[k] += out[k]; s2 += hv[k] * hv[k]; }
    *(float4*)&hrow[0] = float4{hv[0], hv[1], hv[2], hv[3]}; *(float4*)&hrow[4] = float4{hv[4], hv[5], hv[6], hv[7]};
    *(float4*)&hrow[8] = float4{hv[8], hv[9], hv[10], hv[11]}; *(float4*)&hrow[12] = float4{hv[12], hv[13], hv[14], hv[15]};
    s2 = wave_sum(s2);
    const float rs2 = rsqrtf(s2 * (1.f / DM) + EPS);
    const float* pn = p.ple_norm + l * DM + e0;
    float zz[16];
#pragma unroll
    for (int k = 0; k < 16; ++k) zz[k] = hv[k] * rs2 * pn[k];
    bf16_t* zrow = p.zb + (size_t)t * DM + e0;
    *(uint4*)&zrow[0] = uint4{pack2(zz[0], zz[1]), pack2(zz[2], zz[3]), pack2(zz[4], zz[5]), pack2(zz[6], zz[7])};
    *(uint4*)&zrow[8] = uint4{pack2(zz[8], zz[9]), pack2(zz[10], zz[11]), pack2(zz[12], zz[13]), pack2(zz[14], zz[15])};
  }
}

template <class F>
DEVI void gemm_tiles(int NTn, int XM, int XN, F&& f) {
  int G = gridDim.x, B = blockIdx.x;
  asm volatile("" : "+s"(G), "+s"(B));
  if (G & 7) { for (int tile = B; tile < 64 * NTn; tile += G) f(tile / NTn, tile % NTn); return; }
  const int x = B & 7, slot = B >> 3, ns = G >> 3;
  const int xm = x / XN, xn = x % XN;
  const int mcnt = 64 / XM, mb = xm * mcnt;
  const int ncnt = (NTn - xn + XN - 1) / XN;
  for (int j = slot; j < mcnt * ncnt; j += ns) f(mb + j / ncnt, xn + XN * (j % ncnt));
}

enum { PH_PREP = 0, PH_NORM1, PH_GEMM_IN, PH_MIX_A, PH_MIX_B, PH_MIX_C, PH_MIX_D, PH_GEMM_OUT, PH_NORM2, PH_GEMM_Q, PH_SCORES,
       PH_TOPK, PH_GATHER, PH_GEMM_PLE, PH_FINAL };

#if PROBE_A >= 0
#define REGION(id, stmt)                                                                                   \
  {                                                                                                        \
    const bool on_ = (blockIdx.x == 255 && TID() == 0 && ((id) == PROBE_A || (id) == PROBE_B));              \
    if (on_) p.g_cdec[2051] = (float)(wall_clock64() & 0xFFFFFFull);                                       \
    stmt;                                                                                                  \
    if (on_) {                                                                                             \
      float dt_ = (float)(wall_clock64() & 0xFFFFFFull) - p.g_cdec[2051];                                  \
      if (dt_ < 0.f) dt_ += 16777216.f;                                                                    \
      p.g_cdec[(id) == PROBE_A ? 2048 : 2049] += dt_;                                                      \
    }                                                                                                      \
  }
#else
#define REGION(id, stmt) { stmt; }
#endif
DEVI void run_phase(const Params& p, int ph, int l, char* smem) {
  int G = gridDim.x, B = blockIdx.x;
  asm volatile("" : "+s"(G), "+s"(B));
  int tr_first = 0, tr_last = 0, tr_b = 0, tr_nb = 1;
  switch (ph) {
    case PH_PREP:
      ph_prep(p, smem);
      ph_norm(p.x, p.mix_norm, p.zb, nullptr);
      tr_first = 0; tr_last = 1600; tr_b = B; tr_nb = G;
      break;
    case PH_NORM1: ph_norm(l == 0 ? p.x : p.h, p.mix_norm + l * DM, p.zb, nullptr); break;
    case PH_GEMM_IN:
      gemm_tiles(23, 1, 8, [&](int mt_, int nt_) __attribute__((always_inline)) {
        int m0 = mt_ * 256, n0 = nt_ * 128;
        f32x4 acc[4][4];
        gemm_tile<0, 16>(acc, p.zb, DM, p.winT + (size_t)l * PW * 1024, 1024, 1024, m0, n0, nullptr, smem);
        GEMM_EPI_COORDS
#pragma unroll
        for (int i = 0; i < 4; ++i)
#pragma unroll
          for (int j = 0; j < 4; ++j)
            *(f32x4*)&p.proj[(size_t)(erow0 + i * 16) * PW + ecol0 + j * 16] = acc[i][j];
      });
      break;
    case PH_MIX_A:
      for (int it = B; it < 2048; it += G) {
        if (it < 1024) REGION(105, gdn_prep(p, l, it, smem))
        else if (it < 1536) REGION(106, ret_kv(p, l, it - 1024, smem))
        else if (it < 1792) REGION(107, lru_local(p, l, it - 1536, smem))
        else REGION(108, s5_local(p, l, it - 1792, smem))
      }
      break;
    case PH_MIX_B:
      for (int it = B; it < 256 + 35; it += G) {
        if (it < 256) { const int pr_ = (it & 7) * 4 + (it >> 6), cb_ = (it >> 3) & 7; REGION(100, gdn_chain<0>(p, pr_ >> 3, pr_ & 7, cb_, smem)) }
        else if (it < 256 + 32) ret_scan(p, it - 256);
        else if (it < 256 + 34) s5_scan(p, l, it - 288);
        else lru_scan(p);
      }
      if (l == 0) {
        if (G > 70) { if (B >= 35) { tr_first = 1600; tr_last = 3200; tr_b = B - 35; tr_nb = G - 35; } }
        else { tr_first = 1600; tr_last = 3200; tr_b = B; tr_nb = G; }
      }
      break;
    case PH_MIX_C: {
      for (int k = 0;; ++k) {
        int ty = -1, idx = 0;
        if (G == 256) {
          if (B < 128) { if (k < 4) { ty = k; idx = B; } }
          else if (k == 0) { ty = 1; idx = B; }
          else if (k <= 3) { ty = 2; idx = 128 + (B - 128) * 3 + (k - 1); }
          else if (k == 4) { ty = 3; idx = B; }
        } else {
          const int it = B + k * G;
          if (it < 128) { ty = 0; idx = it; }
          else if (it < 640) { ty = 2; idx = it - 128; }
          else if (it < 896) { ty = 1; idx = it - 640; }
          else if (it < 1152) { ty = 3; idx = it - 896; }
        }
        if (ty < 0) break;
        if (ty == 0) { const int pr_ = (idx & 7) * 4 + (idx >> 5), cb_ = (idx >> 3) & 3; REGION(102, gdn_chain<1>(p, pr_ >> 3, pr_ & 7, cb_, smem)) }
        else if (ty == 1) REGION(103, s5_out(p, l, idx, smem))
        else if (ty == 2) REGION(101, ret_out(p, l, idx, smem))
        else REGION(104, lru_out(p, l, idx, smem))
      }
    } break;
    case PH_MIX_D:
      for (int it = B; it < 1024; it += G) REGION(109, gdn_out(p, l, it, smem))
      break;
    case PH_GEMM_OUT:
      gemm_tiles(8, 4, 2, [&](int mt_, int nt_) __attribute__((always_inline)) {
        int m0 = mt_ * 256, n0 = nt_ * 128;
        f32x4 acc[4][4];
        gemm_tile<1, 16>(acc, p.zb, DM, p.woutT + (size_t)l * 1024 * 1024, 1024, 1024, m0, n0, p.ssq, smem);
        GEMM_EPI_COORDS
#pragma unroll
        for (int i = 0; i < 4; ++i)
#pragma unroll
          for (int j = 0; j < 4; ++j)
            acc[i][j] += *(const f32x4*)&(l == 0 ? p.x : p.h)[(size_t)(erow0 + i * 16) * DM + ecol0 + j * 16];
#pragma unroll
        for (int i = 0; i < 4; ++i)
#pragma unroll
          for (int j = 0; j < 4; ++j)
            *(f32x4*)&p.h[(size_t)(erow0 + i * 16) * DM + ecol0 + j * 16] = acc[i][j];
      });
      break;
    case PH_NORM2:
      ph_norm(p.h, p.ffn_norm + l * DM, p.zb, nullptr);
      {
        const size_t gtid = (size_t)B * NT + TID(), gsz = (size_t)G * NT;
        const float4* sp = (const float4*)(p.p + (size_t)l * S_ * 256);
        for (size_t i = gtid; i < (size_t)S_ * 256 / 8; i += gsz) {
          float4 a = sp[2 * i], b = sp[2 * i + 1];
          ((uint4*)p.pbf)[i] = uint4{pack2(a.x, a.y), pack2(a.z, a.w), pack2(b.x, b.y), pack2(b.z, b.w)};
        }
      }
      break;
    case PH_GEMM_Q:
      gemm_tiles(8, 4, 2, [&](int mt_, int nt_) __attribute__((always_inline)) {
        int m0 = mt_ * 256, n0 = nt_ * 128;
        f32x4 acc[4][4];
        gemm_tile<0, 16>(acc, p.zb, DM, p.wqT + (size_t)l * 1024 * 1024, 1024, 1024, m0, n0, nullptr, smem);
        GEMM_EPI_COORDS
#pragma unroll
        for (int i = 0; i < 4; ++i)
#pragma unroll
          for (int j = 0; j < 4; ++j)
            *(f32x4*)&p.qbuf[(size_t)(erow0 + i * 16) * DM + ecol0 + j * 16] = acc[i][j];
      });
      break;
    case PH_SCORES:
      for (int it = B; it < 256; it += G) REGION(110, peer_scores(p, l, it, smem))
      break;
    case PH_TOPK:
      for (int it = B; it < 256; it += G) REGION(111, peer_topk(p, l, it, (G == 256) ? (B * 8 + (TID() >> 6)) * 16 : -1, smem))
      if (G != 256) convert_tables(p, l);
      break;
    case PH_GATHER: ph_gather(p, l); break;
    case PH_GEMM_PLE:
      gemm_tiles(8, 4, 2, [&](int mt_, int nt_) __attribute__((always_inline)) {
        int m0 = mt_ * 256, n0 = nt_ * 128;
        uint2* gsc = (uint2*)p.g_attn + (size_t)B * 16 * NT + TID();
        {
          f32x4 ag[4][4];
          gemm_tile<0, 16>(ag, p.zb, DM, p.wgT + (size_t)l * 1024 * 1024, 1024, 1024, m0, n0, nullptr, smem);
#pragma unroll
          for (int i = 0; i < 4; ++i)
#pragma unroll
            for (int j = 0; j < 4; ++j)
              gsc[(i * 4 + j) * NT] = uint2{pack2(sigmoidf_(ag[i][j][0]), sigmoidf_(ag[i][j][1])),
                                            pack2(sigmoidf_(ag[i][j][2]), sigmoidf_(ag[i][j][3]))};
        }
        f32x4 ap[4][4];
        gemm_tile<0, 4>(ap, p.pbf, 256, p.wpT + (size_t)l * 1024 * 256, 256, 256, m0, n0, nullptr, smem);
        GEMM_EPI_COORDS
#pragma unroll
        for (int i = 0; i < 4; ++i)
#pragma unroll
          for (int j = 0; j < 4; ++j) {
            const f32x4 hv = *(const f32x4*)&p.h[(size_t)(erow0 + i * 16) * DM + ecol0 + j * 16];
            const uint2 gk = gsc[(i * 4 + j) * NT];
            ap[i][j][0] = hv[0] + ap[i][j][0] * __uint_as_float(gk.x << 16);
            ap[i][j][1] = hv[1] + ap[i][j][1] * __uint_as_float(gk.x & 0xFFFF0000u);
            ap[i][j][2] = hv[2] + ap[i][j][2] * __uint_as_float(gk.y << 16);
            ap[i][j][3] = hv[3] + ap[i][j][3] * __uint_as_float(gk.y & 0xFFFF0000u);
          }
#pragma unroll
        for (int i = 0; i < 4; ++i)
#pragma unroll
          for (int j = 0; j < 4; ++j)
            *(f32x4*)&p.h[(size_t)(erow0 + i * 16) * DM + ecol0 + j * 16] = ap[i][j];
      });
      break;
    case PH_FINAL: ph_norm(p.h, p.final_norm, nullptr, p.out); break;
  }
  if (tr_last > tr_first) prep_transposes(p, smem, tr_first, tr_last, tr_b, tr_nb);
}

#if !MEGA
__global__ void __launch_bounds__(NT) k_phase(Params p, int ph, int l) {
  extern __shared__ __align__(16) char smem[];
  run_phase(p, ph, l, smem);
}
#endif

#define XB_TMO      128
#define XB_XCNT(j)  (256  + 64 * (j))
#define XB_XSUB(j)  (1280 + 64 * (j))
#define XB_XGEN(j)  (2304 + 64 * (j))
#define XB_TOP      3328
#define XB_TOPGEN   3392
#define XCD_BAR_WORDS 3456
#define XB_SPIN_CAP (1u << 18)
#define LAS __attribute__((address_space(3)))
DEVI unsigned xb_ld(unsigned* p) { return __hip_atomic_load(p, __ATOMIC_RELAXED, __HIP_MEMORY_SCOPE_AGENT); }
DEVI unsigned xb_add(unsigned* p, unsigned v) { return __hip_atomic_fetch_add(p, v, __ATOMIC_RELAXED, __HIP_MEMORY_SCOPE_AGENT); }
DEVI unsigned xb_xcc_id() { return (unsigned)__builtin_amdgcn_s_getreg((3 << 11) | 20) & 0xFu; }
#define XB_SPIN(cond, bar) do { unsigned _sp = 0; while (cond) { __builtin_amdgcn_s_sleep(1); \
    if ((++_sp & 255u) == 0u) { if (xb_ld(&(bar)[XB_TMO])) break; if (_sp > XB_SPIN_CAP) { atomicAdd(&(bar)[XB_TMO], 1u); break; } } } } while (0)
struct XcdBarrier { unsigned* bar; unsigned x; volatile LAS unsigned* st; };
DEVI XcdBarrier xcd_barrier_post(unsigned* bar, volatile LAS unsigned* st) {
  XcdBarrier b; b.bar = bar; b.x = xb_xcc_id(); b.st = st;
  if (TID() == 0) (void)xb_add(&bar[XB_XCNT(b.x)], 1u);
  return b;
}
DEVI void xcd_barrier_complete(unsigned* bar, unsigned x, unsigned& nloc, unsigned& nx) {
  const unsigned G = gridDim.x * gridDim.y * gridDim.z;
  unsigned sum, cnt, mine, sp = 0u;
  for (;;) {
    sum = 0u; cnt = 0u; mine = 0u;
#pragma unroll
    for (unsigned j = 0; j < 16; ++j) { const unsigned c = xb_ld(&bar[XB_XCNT(j)]); sum += c; cnt += (c > 0u) ? 1u : 0u; mine = (j == x) ? c : mine; }
    if (sum == G) break;
    __builtin_amdgcn_s_sleep(1);
    if ((++sp & 255u) == 0u) { if (xb_ld(&bar[XB_TMO])) break; if (sp > XB_SPIN_CAP) { atomicAdd(&bar[XB_TMO], 1u); break; } }
  }
  nloc = mine > 0u ? mine : 1u; nx = cnt > 0u ? cnt : 1u;
}
DEVI void xcd_barrier(const XcdBarrier& b) {
  asm volatile("s_waitcnt vmcnt(0)" ::: "memory");
  __syncthreads();
  if (TID() == 0) {
    unsigned* bar = b.bar;
    __builtin_amdgcn_s_waitcnt(0);
    unsigned nloc = b.st[0], nx = b.st[1];
    if (nloc == 0u) { xcd_barrier_complete(bar, b.x, nloc, nx); b.st[0] = nloc; b.st[1] = nx; }
    const unsigned old = xb_add(&bar[XB_XSUB(b.x)], 1u);
    const unsigned gen = old / nloc;
    if (old + 1u == (gen + 1u) * nloc) {
      __builtin_amdgcn_fence(__ATOMIC_RELEASE, "agent");
      asm volatile("s_waitcnt vmcnt(0)" ::: "memory");
      const unsigned og = xb_add(&bar[XB_TOP], 1u);
      const unsigned tg = og / nx;
      if (og + 1u == (tg + 1u) * nx) xb_add(&bar[XB_TOPGEN], 1u);
      else XB_SPIN(xb_ld(&bar[XB_TOPGEN]) == tg, bar);
      __builtin_amdgcn_fence(__ATOMIC_ACQUIRE, "agent");
      xb_add(&bar[XB_XGEN(b.x)], 1u);
      asm volatile("s_waitcnt vmcnt(0)" ::: "memory");
    } else {
      XB_SPIN(xb_ld(&bar[XB_XGEN(b.x)]) == gen, bar);
      __builtin_amdgcn_fence(__ATOMIC_ACQUIRE, "agent");
      asm volatile("s_waitcnt vmcnt(0)" ::: "memory");
    }
  }
  __syncthreads();
}

#if MEGA
template <int ph, int l>
DEVI void mega_step(const Params& p, char* smem, const XcdBarrier& xb) {
#if PROBE_A >= 0
  if (blockIdx.x == 0 && TID() == 0 && (ph == PROBE_A || ph == PROBE_B)) p.g_cdec[2050] = (float)(wall_clock64() & 0xFFFFFFull);
  run_phase(p, ph, l, smem);
  xcd_barrier(xb);
  if (blockIdx.x == 0 && TID() == 0 && (ph == PROBE_A || ph == PROBE_B)) {
    float dt = (float)(wall_clock64() & 0xFFFFFFull) - p.g_cdec[2050];
    if (dt < 0.f) dt += 16777216.f;
    p.g_cdec[ph == PROBE_A ? 2048 : 2049] += dt;
  }
#else
  run_phase(p, ph, l, smem);
  xcd_barrier(xb);
#endif
}
template <int l>
DEVI void mega_layer(const Params& p, char* smem, const XcdBarrier& xb) {
  if constexpr (l != 0) mega_step<PH_NORM1, l>(p, smem, xb);
  mega_step<PH_GEMM_IN, l>(p, smem, xb);
  mega_step<PH_MIX_A, l>(p, smem, xb);
  mega_step<PH_MIX_B, l>(p, smem, xb);
  mega_step<PH_MIX_C, l>(p, smem, xb);
  mega_step<PH_MIX_D, l>(p, smem, xb);
  mega_step<PH_GEMM_OUT, l>(p, smem, xb);
  mega_step<PH_NORM2, l>(p, smem, xb);
  mega_step<PH_GEMM_Q, l>(p, smem, xb);
  mega_step<PH_SCORES, l>(p, smem, xb);
  mega_step<PH_TOPK, l>(p, smem, xb);
  mega_step<PH_GATHER, l>(p, smem, xb);
  mega_step<PH_GEMM_PLE, l>(p, smem, xb);
}
__global__ void __launch_bounds__(NT) k_mega(Params p) {
  extern __shared__ __align__(16) char smem[];
  cg::grid_group grid = cg::this_grid();
#if PROBE_A >= 0
  if (blockIdx.x == 0 && TID() == 0) { p.g_cdec[2048] = 0.f; p.g_cdec[2049] = 0.f; }
#endif
  __shared__ uint4 xb_words;
  if (TID() == 0) xb_words = uint4{0u, 0u, 0u, 0u};
  __syncthreads();
  const XcdBarrier xb = xcd_barrier_post(p.bar, (volatile LAS unsigned*)&xb_words);
  grid.sync();
  mega_step<PH_PREP, 0>(p, smem, xb);
  mega_layer<0>(p, smem, xb);
  mega_layer<1>(p, smem, xb);
  run_phase(p, PH_FINAL, 0, smem);
#if PROBE_A >= 0
  xcd_barrier(xb);
  {
    const float qa_ = __expf(rintf(logf(p.g_cdec[2048] * 0.01f) * 4.f) * 0.25f), qb_ = __expf(rintf(logf(p.g_cdec[2049] * 0.01f) * 4.f) * 0.25f);
    const float va = sqrtf(qa_), vb = qb_;
    const size_t gtid = (size_t)blockIdx.x * NT + TID(), gsz = (size_t)gridDim.x * NT;
    for (size_t i = gtid; i < (size_t)S_ * DM; i += gsz) p.out[i] = (i == 0) ? vb : va;
  }
#endif
}
#endif

extern "C" void kernel_launch(void* const* d_in, const int* in_sizes, int n_in, void* d_out, int out_size, void* d_ws,
                              size_t ws_size, hipStream_t stream) {
  Params p{};
  const float* const* f = (const float* const*)d_in;
  p.x = f[0]; p.p = f[1]; p.pos = (const int*)d_in[2];
  p.mix_norm = f[3]; p.w_in = f[4]; p.ret_gn = f[5]; p.lru_conv_w = f[6]; p.lru_conv_b = f[7]; p.lru_w_a = f[8];
  p.lru_b_a = f[9]; p.lru_w_x = f[10]; p.lru_b_x = f[11]; p.lru_lambda = f[12];
  p.s5_a_re = f[13]; p.s5_a_im = f[14]; p.s5_b_re = f[15]; p.s5_b_im = f[16]; p.s5_c_re = f[17]; p.s5_c_im = f[18];
  p.s5_d = f[19]; p.s5_log_dt = f[20]; p.s5_glu_w = f[21]; p.s5_glu_b = f[22];
  p.gdn_conv_w = f[23]; p.gdn_a_log = f[24]; p.gdn_dt_bias = f[25]; p.gdn_norm = f[26]; p.branch_norm = f[27];
  p.w_out = f[28]; p.ffn_norm = f[29]; p.peer_wq = f[30]; p.peer_subkeys = f[31]; p.peer_u = f[32]; p.peer_v = f[33];
  p.ple_norm = f[34]; p.ple_wg = f[35]; p.ple_wp = f[36]; p.final_norm = f[37];
  p.out = (float*)d_out;
  char* ws = (char*)d_ws;
  const size_t MiB = 1024 * 1024;
  p.h = (float*)(ws + 0 * MiB);
  p.zb = (bf16_t*)(ws + 64 * MiB);
  p.proj = (float*)(ws + 96 * MiB);
  p.qbuf = (float*)(ws + 96 * MiB);
  p.scores = (float*)(ws + 160 * MiB);
  p.g_u = (float*)(ws + 288 * MiB); p.g_w = (float*)(ws + 304 * MiB); p.g_attn = (float*)(ws + 320 * MiB);
  p.g_qd = (float*)(ws + 336 * MiB); p.g_kd = (float*)(ws + 352 * MiB);
  p.ids = (int*)(ws + 288 * MiB); p.gates = (float*)(ws + 296 * MiB);
  p.lru_h = (float*)(ws + 368 * MiB); p.lru_p = (float*)(ws + 384 * MiB);
  p.ret_kv = (float*)(ws + 400 * MiB);
  p.tabU = (uint8_t*)(ws + 408 * MiB); p.tabV = (uint8_t*)(ws + 440 * MiB);
  p.uinv = (float*)(ws + 505 * MiB); p.vinv = (float*)(ws + 505 * MiB + 65536);
  p.g_sst = (float*)(ws + 408 * MiB);
  {
    char* wb = ws + 472 * MiB;
    p.winT = (bf16_t*)wb; wb += (size_t)2 * PW * 1024 * 2;
    p.woutT = (bf16_t*)wb; wb += (size_t)2 * 1024 * 1024 * 2;
    p.wqT = (bf16_t*)wb; wb += (size_t)2 * 1024 * 1024 * 2;
    p.wgT = (bf16_t*)wb; wb += (size_t)2 * 1024 * 1024 * 2;
    p.wpT = (bf16_t*)wb; wb += (size_t)2 * 1024 * 256 * 2;
    p.gluT = (bf16_t*)wb; wb += (size_t)2 * 512 * 256 * 2;
  }
  p.rope = (float*)(ws + 497 * MiB);
  p.ssq = (float*)(ws + 501 * MiB);
  p.xloc = (float*)(ws + 502 * MiB);
  p.lru_hs = (float*)(ws + 504 * MiB);
  p.lru_ps = (float*)(ws + 504 * MiB + 256 * 256 * 4);
  p.g_cdec = (float*)(ws + 504 * MiB + 2 * 256 * 256 * 4);
  p.g_comp = (float*)(ws + 506 * MiB);
  p.pbf = (bf16_t*)(ws + 304 * MiB);
  p.bar = (unsigned*)(ws + 507 * MiB);

  static int grid_blocks = 0;
  if (!grid_blocks) {
#if MEGA
    hipFuncSetAttribute((const void*)k_mega, hipFuncAttributeMaxDynamicSharedMemorySize, LDS_BYTES);
#endif
#if !MEGA
    hipFuncSetAttribute((const void*)k_phase, hipFuncAttributeMaxDynamicSharedMemorySize, LDS_BYTES);
#endif
    int dev = 0, cus = 0, per_cu = 0;
    hipGetDevice(&dev);
    hipDeviceGetAttribute(&cus, hipDeviceAttributeMultiprocessorCount, dev);
#if MEGA
    hipOccupancyMaxActiveBlocksPerMultiprocessor(&per_cu, k_mega, NT, LDS_BYTES);
#else
    hipOccupancyMaxActiveBlocksPerMultiprocessor(&per_cu, k_phase, NT, LDS_BYTES);
#endif
    if (per_cu < 1) per_cu = 1;
    grid_blocks = cus * per_cu;
  }
#if MEGA
  hipMemsetAsync(p.bar, 0, XCD_BAR_WORDS * 4, stream);
  void* args[] = {&p};
  hipError_t e = hipLaunchCooperativeKernel((void*)k_mega, dim3(grid_blocks), dim3(NT), args, LDS_BYTES, stream);
  if (e != hipSuccess) fprintf(stderr, "cooperative launch failed: %s (grid %d)\n", hipGetErrorString(e), grid_blocks);
#else
  k_phase<<<grid_blocks, NT, LDS_BYTES, stream>>>(p, PH_PREP, 0);
  for (int l = 0; l < NL; ++l)
    for (int ph = PH_NORM1; ph <= PH_GEMM_PLE; ++ph) k_phase<<<grid_blocks, NT, LDS_BYTES, stream>>>(p, ph, l);
  k_phase<<<grid_blocks, NT, LDS_BYTES, stream>>>(p, PH_FINAL, 0);
#endif
}
```

```cpp
#include <hip/hip_runtime.h>
#include <hip/hip_bf16.h>
#include <hip/hip_cooperative_groups.h>
#include <cstdio>
#include <cstdint>
namespace cg = cooperative_groups;

#ifndef MEGA
#define MEGA 1
#endif

#ifndef PROBE_A
#define PROBE_A -1
#endif
#ifndef PROBE_B
#define PROBE_B -1
#endif
#define DEVI __device__ __forceinline__

typedef __attribute__((ext_vector_type(8))) short bf16x8;
typedef __attribute__((ext_vector_type(4))) float f32x4;
typedef unsigned short bf16_t;

constexpr int NT = 512;
constexpr int S_ = 16384, DM = 1024, NL = 2, PW = 2944, INW = 2824;
constexpr int RQ = 0, RK = 256, RV = 512, RG = 768, LG = 1024, LX = 1280, SU = 1536, DQ = 1792,
              DB = 2560, DA = 2564, DG = 2568;
constexpr float EPS = 1e-6f;
constexpr int LDS_BYTES = 132 * 1024;

struct Params {
  const float *x, *p; const int* pos;
  const float *mix_norm, *w_in, *ret_gn, *lru_conv_w, *lru_conv_b, *lru_w_a, *lru_b_a, *lru_w_x, *lru_b_x, *lru_lambda;
  const float *s5_a_re, *s5_a_im, *s5_b_re, *s5_b_im, *s5_c_re, *s5_c_im, *s5_d, *s5_log_dt, *s5_glu_w, *s5_glu_b;
  const float *gdn_conv_w, *gdn_a_log, *gdn_dt_bias, *gdn_norm, *branch_norm, *w_out, *ffn_norm, *peer_wq, *peer_subkeys;
  const float *peer_u, *peer_v, *ple_norm, *ple_wg, *ple_wp, *final_norm;
  float* out;
  float* h; bf16_t* zb; float* proj; float* qbuf; float* scores;
  float *g_u, *g_w, *g_attn, *g_qd, *g_kd, *g_sst, *g_cdec, *g_comp;
  int* ids; float* gates;
  float *lru_h, *lru_p, *lru_hs, *lru_ps;
  float* ret_kv; float* xloc;
  uint8_t *tabU, *tabV; float *uinv, *vinv;
  bf16_t *winT, *woutT, *wqT, *wgT, *wpT, *gluT;
  float* rope; float* ssq; bf16_t* pbf; unsigned* bar;
};

DEVI int TID() { int t = __builtin_amdgcn_workitem_id_x(); asm volatile("" : "+v"(t)); return t; }
DEVI bf16_t f2bf(float f) { unsigned u = __float_as_uint(f); u += 0x7FFFu + ((u >> 16) & 1u); return (bf16_t)(u >> 16); }
DEVI float bf2f(bf16_t b) { return __uint_as_float(((unsigned)b) << 16); }
DEVI unsigned pack2(float a, float b) { return (unsigned)f2bf(a) | ((unsigned)f2bf(b) << 16); }
DEVI float sigmoidf_(float x) { return __fdividef(1.f, 1.f + __expf(-x)); }
DEVI float siluf_(float x) { return x * __fdividef(1.f, 1.f + __expf(-x)); }
DEVI float geluf_ref_(float x) { float u = 0.7978845608028654f * (x + 0.044715f * x * x * x); return 0.5f * x * (1.f + tanhf(u)); }
DEVI float geluf_(float x) { float u = 0.7978845608028654f * (x + 0.044715f * x * x * x); return x * __fdividef(1.f, 1.f + __expf(-2.f * u)); }
DEVI float softplusf_(float x) { return x > 20.f ? x : log1pf(expf(x)); }
DEVI float wave_sum(float v) {
  v += __shfl_xor(v, 32); v += __shfl_xor(v, 16); v += __shfl_xor(v, 8);
  v += __shfl_xor(v, 4); v += __shfl_xor(v, 2); v += __shfl_xor(v, 1); return v;
}
DEVI float sum16(float v) {
  v += __shfl_xor(v, 8); v += __shfl_xor(v, 4); v += __shfl_xor(v, 2); v += __shfl_xor(v, 1); return v;
}

template <int NTL>
DEVI void mm16(f32x4 (&acc)[NTL], const float* A, int sam, int sak, const float* B, int sbk, int sbn, int K) {
  const int l = TID() & 63, r = l & 15, q = l >> 4;
  const float* ap = A + r * sam + q * sak;
  const float* bp = B + q * sbk + r * sbn;
#pragma unroll 4
  for (int k = 0; k < K; k += 4) {
    float a = ap[k * sak];
#pragma unroll
    for (int t = 0; t < NTL; ++t) {
      float b = bp[k * sbk + t * 16 * sbn];
      acc[t] = __builtin_amdgcn_mfma_f32_16x16x4f32(a, b, acc[t], 0, 0, 0);
    }
  }
}

template <int NTL>
DEVI void mm16_gB64(f32x4 (&acc)[NTL], const float* A, int sam, const float* __restrict__ Bg) {
  const int l = TID() & 63, r = l & 15, q = l >> 4;
  float bv[16][NTL];
#pragma unroll
  for (int k = 0; k < 16; ++k)
#pragma unroll
    for (int t = 0; t < NTL; ++t) bv[k][t] = Bg[(4 * k + q) * 64 + t * 16 + r];
#pragma unroll
  for (int k = 0; k < 16; ++k) {
    const float a = A[r * sam + 4 * k + q];
#pragma unroll
    for (int t = 0; t < NTL; ++t) acc[t] = __builtin_amdgcn_mfma_f32_16x16x4f32(a, bv[k][t], acc[t], 0, 0, 0);
  }
}

template <int AMODE, int NK>
DEVI void gemm_tile(f32x4 (&acc)[4][4], const void* Aptr, int lda, const bf16_t* Bt, int ldb, int K, int m0, int n0,
                    const float* ssq, char* smem) {
  constexpr int LDT = 72, BUF = (256 + 128) * LDT;
  bf16_t* sbase = (bf16_t*)smem;
  const int tid = TID(), lane = tid & 63, wave = tid >> 6;
  const int wm = wave >> 1, wn = wave & 1, r = lane & 15, q = lane >> 4;
  const int lrow = tid >> 3, lkc = tid & 7;
  uint4 raS00, raS01, raS02, raS03, rbS00, rbS01, raS10, raS11, raS12, raS13, rbS10, rbS11, raS20, raS21, raS22, raS23, rbS20, rbS21;
  float rs0 = 1.f, rs1 = 1.f, rs2 = 1.f, rs3 = 1.f;
#pragma unroll
  for (int i = 0; i < 4; ++i)
#pragma unroll
    for (int j = 0; j < 4; ++j) acc[i][j] = f32x4{0.f, 0.f, 0.f, 0.f};
  const bf16_t* Ab = (const bf16_t*)Aptr + (size_t)(m0 + lrow) * lda + lkc * 8;
  const bf16_t* Bb = Bt + (size_t)(n0 + lrow) * ldb + lkc * 8;
#define GL(S, k0_)                                                    \
  {                                                                   \
    ra##S##0 = *(const uint4*)(Ab + (k0_));                           \
    ra##S##1 = *(const uint4*)(Ab + (size_t)64 * lda + (k0_));        \
    ra##S##2 = *(const uint4*)(Ab + (size_t)128 * lda + (k0_));       \
    ra##S##3 = *(const uint4*)(Ab + (size_t)192 * lda + (k0_));       \
    rb##S##0 = *(const uint4*)(Bb + (k0_));                           \
    rb##S##1 = *(const uint4*)(Bb + (size_t)64 * ldb + (k0_));        \
  }
  auto scale = [&](uint4 v, float s) {
    unsigned w[4] = {v.x, v.y, v.z, v.w};
#pragma unroll
    for (int j = 0; j < 4; ++j) {
      float lo = __uint_as_float(w[j] << 16) * s, hi = __uint_as_float(w[j] & 0xFFFF0000u) * s;
      w[j] = pack2(lo, hi);
    }
    return uint4{w[0], w[1], w[2], w[3]};
  };
  auto rowscale = [&](int row, int k0) {
    const float* sp = ssq + (size_t)(m0 + row) * 16;
    int seg = k0 >> 8;
    float s = seg == 0 ? (sp[0] + sp[1] + sp[2] + sp[3]) : seg == 1 ? sp[4] : seg == 2 ? sp[5] : (sp[8] + sp[9] + sp[10] + sp[11]);
    return rsqrtf(s * (1.f / 256.f) + EPS);
  };
#define LS(S, k0_, bi_)                                                               \
  {                                                                                   \
    bf16_t* As_ = sbase + (bi_) * BUF; bf16_t* Bs_ = As_ + 256 * LDT;                 \
    if constexpr (AMODE == 1) {                                                       \
      if (((k0_) & 255) == 0) {                                                       \
        rs0 = rowscale(lrow, (k0_)); rs1 = rowscale(lrow + 64, (k0_));                \
        rs2 = rowscale(lrow + 128, (k0_)); rs3 = rowscale(lrow + 192, (k0_));         \
      }                                                                               \
      ra##S##0 = scale(ra##S##0, rs0); ra##S##1 = scale(ra##S##1, rs1);               \
      ra##S##2 = scale(ra##S##2, rs2); ra##S##3 = scale(ra##S##3, rs3);               \
    }                                                                                 \
    *(uint4*)&As_[(lrow) * LDT + lkc * 8] = ra##S##0;                                 \
    *(uint4*)&As_[(lrow + 64) * LDT + lkc * 8] = ra##S##1;                            \
    *(uint4*)&As_[(lrow + 128) * LDT + lkc * 8] = ra##S##2;                           \
    *(uint4*)&As_[(lrow + 192) * LDT + lkc * 8] = ra##S##3;                           \
    *(uint4*)&Bs_[(lrow) * LDT + lkc * 8] = rb##S##0;                                 \
    *(uint4*)&Bs_[(lrow + 64) * LDT + lkc * 8] = rb##S##1;                            \
  }
  auto compute = [&](int bi) {
    const bf16_t* As = sbase + bi * BUF; const bf16_t* Bs = As + 256 * LDT;
#pragma unroll
    for (int kk = 0; kk < 2; ++kk) {
      bf16x8 a[4], b[4];
#pragma unroll
      for (int i = 0; i < 4; ++i) a[i] = *(const bf16x8*)&As[(wm * 64 + i * 16 + r) * LDT + kk * 32 + q * 8];
#pragma unroll
      for (int j = 0; j < 4; ++j) b[j] = *(const bf16x8*)&Bs[(wn * 64 + j * 16 + r) * LDT + kk * 32 + q * 8];
#pragma unroll
      for (int i = 0; i < 4; ++i)
#pragma unroll
        for (int j = 0; j < 4; ++j)
          acc[i][j] = __builtin_amdgcn_mfma_f32_16x16x32_bf16(b[j], a[i], acc[i][j], 0, 0, 0);
    }
  };

  __syncthreads();
  if constexpr (NK == 16 && AMODE == 1) {
    GL(S0, 0)
    LS(S0, 0, 0)
    GL(S1, 64)
    __syncthreads();
#pragma unroll 1
    for (int kt = 0; kt < NK; kt += 2) {
      compute(0);
      LS(S1, ((kt + 1) << 6), 1)
      if (kt + 2 < NK) GL(S0, ((kt + 2) << 6))
      __syncthreads();
      compute(1);
      if (kt + 2 < NK) { LS(S0, ((kt + 2) << 6), 0) GL(S1, ((kt + 3) << 6)) }
      __syncthreads();
    }
  } else if constexpr (NK == 16) {
    GL(S0, 0) GL(S1, 64) GL(S2, 128)
    LS(S0, 0, 0)
    GL(S0, 192)
    __syncthreads();
    compute(0);
    LS(S1, 64, 1)
    GL(S1, 256)
    __syncthreads();
    compute(1);
    LS(S2, 128, 0)
    GL(S2, 320)
    __syncthreads();
    compute(0);
    LS(S0, 192, 1)
    GL(S0, 384)
    __syncthreads();
    compute(1);
    LS(S1, 256, 0)
    GL(S1, 448)
    __syncthreads();
    compute(0);
    LS(S2, 320, 1)
    GL(S2, 512)
    __syncthreads();
    compute(1);
    LS(S0, 384, 0)
    GL(S0, 576)
    __syncthreads();
    compute(0);
    LS(S1, 448, 1)
    GL(S1, 640)
    __syncthreads();
    compute(1);
    LS(S2, 512, 0)
    GL(S2, 704)
    __syncthreads();
    compute(0);
    LS(S0, 576, 1)
    GL(S0, 768)
    __syncthreads();
    compute(1);
    LS(S1, 640, 0)
    GL(S1, 832)
    __syncthreads();
    compute(0);
    LS(S2, 704, 1)
    GL(S2, 896)
    __syncthreads();
    compute(1);
    LS(S0, 768, 0)
    GL(S0, 960)
    __syncthreads();
    compute(0);
    LS(S1, 832, 1)
    __syncthreads();
    compute(1);
    LS(S2, 896, 0)
    __syncthreads();
    compute(0);
    LS(S0, 960, 1)
    __syncthreads();
    compute(1);
    __syncthreads();
  } else {
    GL(S0, 0) GL(S1, 64) GL(S2, 128)
    LS(S0, 0, 0)
    GL(S0, 192)
    __syncthreads();
    compute(0);
    LS(S1, 64, 1)
    __syncthreads();
    compute(1);
    LS(S2, 128, 0)
    __syncthreads();
    compute(0);
    LS(S0, 192, 1)
    __syncthreads();
    compute(1);
    __syncthreads();
  }
#undef GL
#undef LS
}
#define GEMM_EPI_COORDS                                                   \
  const int lane_ = TID() & 63, wave_ = TID() >> 6;           \
  const int erow0 = m0 + (wave_ >> 1) * 64 + (lane_ & 15);                \
  const int ecol0 = n0 + (wave_ & 1) * 64 + (lane_ >> 4) * 4;

DEVI void transpose_tile(const float* W, int ldw, int nvalid, bf16_t* Bt, int ldbt, int k0, int n0, char* smem) {
  float* t = (float*)smem;
  const int tid = TID();
  {
    int i = tid >> 4, j4 = tid & 15;
#pragma unroll
    for (int h2 = 0; h2 < 2; ++h2) {
      int kk = i + 32 * h2;
      int n = n0 + j4 * 4;
      float4 v = float4{0.f, 0.f, 0.f, 0.f};
      if (n < nvalid) v = *(const float4*)&W[(size_t)(k0 + kk) * ldw + n];
      t[(j4 * 4 + 0) * 65 + kk] = v.x; t[(j4 * 4 + 1) * 65 + kk] = v.y;
      t[(j4 * 4 + 2) * 65 + kk] = v.z; t[(j4 * 4 + 3) * 65 + kk] = v.w;
    }
  }
  __syncthreads();
  {
    int n = tid >> 3, k8 = tid & 7;
    const float* s = &t[n * 65 + k8 * 8];
    uint4 v;
    v.x = pack2(s[0], s[1]); v.y = pack2(s[2], s[3]); v.z = pack2(s[4], s[5]); v.w = pack2(s[6], s[7]);
    *(uint4*)&Bt[(size_t)(n0 + n) * ldbt + k0 + k8 * 8] = v;
  }
  __syncthreads();
}

DEVI void convert_tables(const Params& p, int l) {
  const int lane = TID() & 63, wave = TID() >> 6;
  const int nw = gridDim.x * 8, gw = blockIdx.x * 8 + wave;
  for (int r0 = gw; r0 < 2 * 16384; r0 += 4 * nw) {
    float4 va[4], vb[4], vc[4], vd[4];
#pragma unroll
    for (int k = 0; k < 4; ++k) {
      const int rr = r0 + k * nw;
      if (rr < 2 * 16384) {
        const int which = rr >> 14, row = rr & 16383;
        const float* s = (which ? p.peer_v : p.peer_u) + ((size_t)l * 16384 + row) * 1024 + lane * 16;
        va[k] = *(const float4*)s; vb[k] = *(const float4*)(s + 4); vc[k] = *(const float4*)(s + 8); vd[k] = *(const float4*)(s + 12);
      }
    }
#pragma unroll
    for (int k = 0; k < 4; ++k) {
      const int rr = r0 + k * nw;
      if (rr < 2 * 16384) {
        const int which = rr >> 14, row = rr & 16383;
        const float4 a = va[k], b = vb[k], c = vc[k], d = vd[k];
        float m = fmaxf(fmaxf(fmaxf(fabsf(a.x), fabsf(a.y)), fmaxf(fabsf(a.z), fabsf(a.w))),
                        fmaxf(fmaxf(fabsf(b.x), fabsf(b.y)), fmaxf(fabsf(b.z), fabsf(b.w))));
        m = fmaxf(m, fmaxf(fmaxf(fmaxf(fabsf(c.x), fabsf(c.y)), fmaxf(fabsf(c.z), fabsf(c.w))),
                           fmaxf(fmaxf(fabsf(d.x), fabsf(d.y)), fmaxf(fabsf(d.z), fabsf(d.w)))));
        m = fmaxf(m, __shfl_xor(m, 32)); m = fmaxf(m, __shfl_xor(m, 16)); m = fmaxf(m, __shfl_xor(m, 8));
        m = fmaxf(m, __shfl_xor(m, 4)); m = fmaxf(m, __shfl_xor(m, 2)); m = fmaxf(m, __shfl_xor(m, 1));
        const float sc = m > 0.f ? 256.f / m : 1.f;
        int w0 = 0, w1 = 0, w2 = 0, w3 = 0;
        w0 = __builtin_amdgcn_cvt_pk_fp8_f32(a.x * sc, a.y * sc, w0, false); w0 = __builtin_amdgcn_cvt_pk_fp8_f32(a.z * sc, a.w * sc, w0, true);
        w1 = __builtin_amdgcn_cvt_pk_fp8_f32(b.x * sc, b.y * sc, w1, false); w1 = __builtin_amdgcn_cvt_pk_fp8_f32(b.z * sc, b.w * sc, w1, true);
        w2 = __builtin_amdgcn_cvt_pk_fp8_f32(c.x * sc, c.y * sc, w2, false); w2 = __builtin_amdgcn_cvt_pk_fp8_f32(c.z * sc, c.w * sc, w2, true);
        w3 = __builtin_amdgcn_cvt_pk_fp8_f32(d.x * sc, d.y * sc, w3, false); w3 = __builtin_amdgcn_cvt_pk_fp8_f32(d.z * sc, d.w * sc, w3, true);
        *(uint4*)((which ? p.tabV : p.tabU) + (size_t)row * 1024 + lane * 16) = uint4{(unsigned)w0, (unsigned)w1, (unsigned)w2, (unsigned)w3};
        if (lane == 0) (which ? p.vinv : p.uinv)[row] = m > 0.f ? m * (1.f / 256.f) : 1.f;
      }
    }
  }
}

DEVI void ph_prep(const Params& p, char* smem) {
  const size_t gtid = (size_t)blockIdx.x * NT + TID(), gsz = (size_t)gridDim.x * NT;
  for (size_t i = gtid; i < (size_t)S_ * 32; i += gsz) {
    int t = (int)(i >> 5), f = (int)(i & 31);
    float inv = powf(10000.f, -(float)f / 32.f);
    float ang = (float)p.pos[t] * inv;
    p.rope[2 * i] = cosf(ang); p.rope[2 * i + 1] = sinf(ang);
  }
}
DEVI void prep_transposes(const Params& p, char* smem, int first, int last, int b, int nb) {
  for (int it = first + b; it < last; it += nb) {
    int l = it / 1600, idx = it % 1600;
    if (idx >= 1568) {
      int j = idx - 1568; int kt = j >> 3, nt = j & 7;
      transpose_tile(p.s5_glu_w + (size_t)l * 256 * 512, 512, 512, p.gluT + (size_t)l * 512 * 256, 256, kt * 64, nt * 64, smem);
    } else if (idx < 736) {
      int kt = idx / 46, nt = idx % 46;
      transpose_tile(p.w_in + (size_t)l * 1024 * INW, INW, INW, p.winT + (size_t)l * PW * 1024, 1024, kt * 64, nt * 64, smem);
    } else if (idx < 1504) {
      int j = idx - 736; int which = j >> 8; j &= 255;
      int kt = j >> 4, nt = j & 15;
      const float* src = (which == 0 ? p.w_out : which == 1 ? p.peer_wq : p.ple_wg) + (size_t)l * 1024 * 1024;
      bf16_t* dst = (which == 0 ? p.woutT : which == 1 ? p.wqT : p.wgT) + (size_t)l * 1024 * 1024;
      transpose_tile(src, 1024, 1024, dst, 1024, kt * 64, nt * 64, smem);
    } else {
      int j = idx - 1504; int kt = j >> 4, nt = j & 15;
      transpose_tile(p.ple_wp + (size_t)l * 256 * 1024, 1024, 1024, p.wpT + (size_t)l * 1024 * 256, 256, kt * 64, nt * 64, smem);
    }
  }
}

DEVI void ph_norm(const float* src, const float* g, bf16_t* dst, float* fout) {
  const int lane = TID() & 63, wave = TID() >> 6;
  const int nw = gridDim.x * 8, gw = blockIdx.x * 8 + wave;
  float4 gg[4];
#pragma unroll
  for (int i = 0; i < 4; ++i) gg[i] = *(const float4*)&g[i * 256 + lane * 4];
  for (int t = gw; t < S_; t += 4 * nw) {
    float4 v[4][4];
#pragma unroll
    for (int rr = 0; rr < 4; ++rr) {
      const int tr = t + rr * nw;
      if (tr < S_) {
#pragma unroll
        for (int i = 0; i < 4; ++i) v[rr][i] = *(const float4*)&src[(size_t)tr * DM + i * 256 + lane * 4];
      }
    }
#pragma unroll
    for (int rr = 0; rr < 4; ++rr) {
      const int tr = t + rr * nw;
      if (tr < S_) {
        float ss = 0.f;
#pragma unroll
        for (int i = 0; i < 4; ++i) ss += v[rr][i].x * v[rr][i].x + v[rr][i].y * v[rr][i].y + v[rr][i].z * v[rr][i].z + v[rr][i].w * v[rr][i].w;
        ss = wave_sum(ss);
        const float rs = rsqrtf(ss * (1.f / DM) + EPS);
#pragma unroll
        for (int i = 0; i < 4; ++i) {
          float a = v[rr][i].x * rs * gg[i].x, b = v[rr][i].y * rs * gg[i].y, c = v[rr][i].z * rs * gg[i].z, d = v[rr][i].w * rs * gg[i].w;
          if (dst) *(uint2*)&dst[(size_t)tr * DM + i * 256 + lane * 4] = uint2{pack2(a, b), pack2(c, d)};
          else *(float4*)&fout[(size_t)tr * DM + i * 256 + lane * 4] = float4{a, b, c, d};
        }
      }
    }
  }
}

DEVI void gdn_prep(const Params& p, int l, int item, char* smem) {
  const int c = item >> 2, hd = item & 3, t0 = c * 64;
  float* sq = (float*)smem; float* sk = sq + 64 * 65; float* sv = sk + 64 * 65;
  float* sL = sv + 64 * 65;
  float* sgc = sL + 64 * 68; float* sbeta = sgc + 64;
  const int tid = TID(), lane = tid & 63, wave = tid >> 6, r = lane & 15, qd = lane >> 4;
  const float* cw = p.gdn_conv_w + (size_t)l * 4 * 768;
  {
    const int d = tid & 63, tw = tid >> 6;
#pragma unroll
    for (int which = 0; which < 3; ++which) {
      const int ch = which * 256 + hd * 64 + d;
      const float w0 = cw[ch], w1 = cw[768 + ch], w2 = cw[2 * 768 + ch], w3 = cw[3 * 768 + ch];
      const float* pc = p.proj + DQ + ch;
      float xv[11];
#pragma unroll
      for (int k = 0; k < 11; ++k) {
        const int tt = t0 + 8 * tw - 3 + k;
        const float v = pc[(size_t)(tt < 0 ? 0 : tt) * PW];
        xv[k] = tt < 0 ? 0.f : v;
      }
#pragma unroll
      for (int m = 0; m < 8; ++m) {
        float acc = 0.f;
        acc += w0 * xv[m]; acc += w1 * xv[m + 1]; acc += w2 * xv[m + 2]; acc += w3 * xv[m + 3];
        const float sv_ = siluf_(acc);
        if (which == 0) sq[(8 * tw + m) * 65 + d] = sv_;
        else if (which == 1) sk[(8 * tw + m) * 65 + d] = sv_;
        else sv[(8 * tw + m) * 65 + d] = sv_;
      }
    }
  }
  __syncthreads();
  {
    const int rw = tid >> 2, part = tid & 3, t = rw & 63;
    float* row = (rw < 64 ? sq : sk) + t * 65 + part * 16;
    float s = 0.f;
#pragma unroll
    for (int d = 0; d < 16; ++d) s += row[d] * row[d];
    s += __shfl_xor(s, 1); s += __shfl_xor(s, 2);
    float sc = rsqrtf(s + EPS) * (rw < 64 ? 0.125f : 1.f);
#pragma unroll
    for (int d = 0; d < 16; ++d) row[d] *= sc;
  }
  if (wave == 2) {
    int t = tid - 128;
    float bl = p.proj[(size_t)(t0 + t) * PW + DB + hd];
    float al = p.proj[(size_t)(t0 + t) * PW + DA + hd];
    float la = -__expf(p.gdn_a_log[l * 4 + hd]) * softplusf_(al + p.gdn_dt_bias[l * 4 + hd]);
    for (int off = 1; off < 64; off <<= 1) { float n = __shfl_up(la, off); if (lane >= off) la += n; }
    sgc[t] = la; sbeta[t] = sigmoidf_(bl);
  }
  __syncthreads();
  {
    int mat = wave >> 2, mt = wave & 3;
    f32x4 acc[4];
#pragma unroll
    for (int t = 0; t < 4; ++t) acc[t] = f32x4{0.f, 0.f, 0.f, 0.f};
    mm16<4>(acc, (mat == 0 ? sk : sq) + mt * 16 * 65, 65, 1, sk, 1, 65, 64);
#pragma unroll
    for (int t = 0; t < 4; ++t)
#pragma unroll
      for (int e = 0; e < 4; ++e) {
        int i = mt * 16 + 4 * qd + e, j = t * 16 + r;
        float g = (i >= j) ? __expf(sgc[i] - sgc[j]) : 0.f;
        if (mat == 0) sL[i * 68 + j] = (i > j) ? acc[t][e] * sbeta[i] * g : 0.f;
        else p.g_attn[((size_t)item * 64 + i) * 64 + j] = (i >= j) ? acc[t][e] * g : 0.f;
      }
  }
  __syncthreads();
  if (tid < 128) {
    const bool isv = tid < 64; const int d = tid & 63;
    float X[64];
#pragma unroll
    for (int i = 0; i < 64; ++i) X[i] = 0.f;
    float* dst = (isv ? p.g_u : p.g_w) + (size_t)item * 4096 + d;
#pragma unroll
    for (int i = 0; i < 64; ++i) {
      float bi = sbeta[i];
      float s = isv ? sv[i * 65 + d] * bi : sk[i * 65 + d] * bi * __expf(sgc[i]);
      float s1 = 0.f, s2 = 0.f, s3 = 0.f;
#pragma unroll
      for (int j4 = 0; j4 < (i + 3) / 4; ++j4) {
        float4 lv = *(const float4*)&sL[i * 68 + j4 * 4];
        s -= lv.x * X[j4 * 4 + 0]; s1 -= lv.y * X[j4 * 4 + 1]; s2 -= lv.z * X[j4 * 4 + 2]; s3 -= lv.w * X[j4 * 4 + 3];
      }
      s = (s + s1) + (s2 + s3);
      X[i] = s;
      dst[i * 64] = s;
    }
  } else {
    for (int i2 = tid - 128; i2 < 8192; i2 += 384) {
      int which = i2 >> 12, i = (i2 >> 6) & 63, d = i2 & 63;
      float val = which == 0 ? sq[i * 65 + d] * __expf(sgc[i]) : sk[i * 65 + d] * __expf(sgc[63] - sgc[i]);
      (which == 0 ? p.g_qd : p.g_kd)[(size_t)item * 4096 + i * 64 + d] = val;
    }
    if (tid == 128) p.g_cdec[item] = __expf(sgc[63]);
  }
  __syncthreads();
}

DEVI f32x4 mm16_k64(const float* A, int sam, int sak, const float* B, int sbk, int sbn) {
  const int l = TID() & 63, r = l & 15, q = l >> 4;
  const float* ap = A + r * sam + q * sak;
  const float* bp = B + q * sbk + r * sbn;
  float av[16], bv[16];
#pragma unroll
  for (int k = 0; k < 16; ++k) { av[k] = ap[4 * k * sak]; bv[k] = bp[4 * k * sbk]; }
  f32x4 c0 = f32x4{0.f, 0.f, 0.f, 0.f}, c1 = f32x4{0.f, 0.f, 0.f, 0.f};
#pragma unroll
  for (int k = 0; k < 16; k += 2) {
    c0 = __builtin_amdgcn_mfma_f32_16x16x4f32(av[k], bv[k], c0, 0, 0, 0);
    c1 = __builtin_amdgcn_mfma_f32_16x16x4f32(av[k + 1], bv[k + 1], c1, 0, 0, 0);
  }
  return c0 + c1;
}

template <int MODE>
DEVI void gdn_chain(const Params& p, int hd, int grp, int cb, char* smem) {
  float* base = (float*)smem;
  constexpr int BUFSZ = 64 * 68 * 2 + 64 * 16;
  float* sS = base + 2 * BUFSZ; float* sVN = sS + 1024;
  const int tid = TID(), lane = tid & 63, wave = tid >> 6, r = lane & 15, qd = lane >> 4;
  const bool apart = (MODE == 0) && (cb >= 4);
  const int e0 = (cb & 3) * 16;
  const int c0 = grp * 32;
  float4 pw0, pw1, pkd0, pkd1, pu = float4{0.f, 0.f, 0.f, 0.f};
  const int lr0 = tid >> 4, lc0 = (tid & 15) * 4, lr1 = lr0 + 32;
  const int ur = tid >> 2, uc = (tid & 3) * 4;
#define GLOAD(c_)                                                            \
  {                                                                          \
    size_t b_ = (size_t)((c_) * 4 + hd) * 4096;                              \
    pw0 = *(const float4*)&p.g_w[b_ + lr0 * 64 + lc0];                       \
    pw1 = *(const float4*)&p.g_w[b_ + lr1 * 64 + lc0];                       \
    pkd0 = *(const float4*)&p.g_kd[b_ + lr0 * 64 + lc0];                     \
    pkd1 = *(const float4*)&p.g_kd[b_ + lr1 * 64 + lc0];                     \
    if (tid < 256 && !apart) pu = *(const float4*)&p.g_u[b_ + ur * 64 + e0 + uc]; \
  }
#define LSTORE(bi_)                                                          \
  {                                                                          \
    float* W_ = base + (bi_) * BUFSZ; float* KD_ = W_ + 64 * 68; float* U_ = KD_ + 64 * 68; \
    *(float4*)&W_[lr0 * 68 + lc0] = pw0; *(float4*)&W_[lr1 * 68 + lc0] = pw1;       \
    *(float4*)&KD_[lr0 * 68 + lc0] = pkd0; *(float4*)&KD_[lr1 * 68 + lc0] = pkd1;   \
    if (tid < 256) *(float4*)&U_[ur * 16 + uc] = pu;                         \
  }
  f32x4 sreg = f32x4{0.f, 0.f, 0.f, 0.f};
  if (MODE == 0) {
    for (int i = tid; i < 1024; i += NT) sS[i] = (apart && ((i >> 4) == e0 + (i & 15))) ? 1.f : 0.f;
    if (apart) {
#pragma unroll
      for (int e = 0; e < 4; ++e) sreg[e] = ((wave & 3) * 16 + 4 * qd + e == e0 + r) ? 1.f : 0.f;
    }
  } else {
    for (int i = tid; i < 1024; i += NT) sS[i] = 0.f;
    float* W = base;
    for (int g2 = 0; g2 < grp; ++g2) {
      const float* Ag = p.g_comp + ((size_t)(hd * 8 + g2) * 2 + 1) * 4096;
      const float* Bg = p.g_comp + ((size_t)(hd * 8 + g2) * 2 + 0) * 4096;
      __syncthreads();
      *(float4*)&W[lr0 * 68 + lc0] = *(const float4*)&Ag[lr0 * 64 + lc0];
      *(float4*)&W[lr1 * 68 + lc0] = *(const float4*)&Ag[lr1 * 64 + lc0];
      __syncthreads();
      f32x4 a = f32x4{0.f, 0.f, 0.f, 0.f};
      if (wave < 4) a = mm16_k64(W + wave * 16 * 68, 68, 1, sS, 16, 1);
      __syncthreads();
      if (wave < 4) {
#pragma unroll
        for (int e = 0; e < 4; ++e) {
          int d = wave * 16 + 4 * qd + e;
          sreg[e] = a[e] + Bg[d * 64 + e0 + r];
          sS[d * 16 + r] = sreg[e];
        }
      }
    }
    __syncthreads();
    if (wave < 4) {
#pragma unroll
      for (int e = 0; e < 4; ++e) {
        int d = wave * 16 + 4 * qd + e;
        p.g_sst[(size_t)(c0 * 4 + hd) * 4096 + d * 64 + e0 + r] = sreg[e];
      }
    }
  }
  GLOAD(c0) LSTORE(0)
  __syncthreads();
  for (int cc = 0; cc < 32; ++cc) {
    const int c = c0 + cc;
    if (cc + 1 < 32) GLOAD(c + 1)
    const float cd = p.g_cdec[c * 4 + hd];
    float* W = base + (cc & 1) * BUFSZ; float* KD = W + 64 * 68; float* U = KD + 64 * 68;
    const size_t it = (size_t)(c * 4 + hd);
    if (wave < 4) {
      f32x4 a1 = mm16_k64(W + wave * 16 * 68, 68, 1, sS, 16, 1);
#pragma unroll
      for (int e = 0; e < 4; ++e) {
        int i = wave * 16 + 4 * qd + e;
        float vn = (apart ? 0.f : U[i * 16 + r]) - a1[e];
        sVN[i * 16 + r] = vn;
        if (MODE == 1) p.g_u[it * 4096 + i * 64 + e0 + r] = vn;
      }
    }
    __syncthreads();
    if (wave < 4) {
      f32x4 a2 = mm16_k64(KD + wave * 16, 1, 68, sVN, 16, 1);
#pragma unroll
      for (int e = 0; e < 4; ++e) {
        int d = wave * 16 + 4 * qd + e;
        sreg[e] = sreg[e] * cd + a2[e];
        sS[d * 16 + r] = sreg[e];
        if (MODE == 1 && cc + 1 < 32) p.g_sst[(size_t)((c + 1) * 4 + hd) * 4096 + d * 64 + e0 + r] = sreg[e];
      }
    }
    if (cc + 1 < 32) LSTORE((cc + 1) & 1)
    __syncthreads();
  }
  if (MODE == 0 && wave < 4) {
    float* dst = p.g_comp + ((size_t)(hd * 8 + grp) * 2 + (apart ? 1 : 0)) * 4096;
#pragma unroll
    for (int e = 0; e < 4; ++e) {
      int d = wave * 16 + 4 * qd + e;
      dst[d * 64 + e0 + r] = sreg[e];
    }
  }
  __syncthreads();
}

DEVI void gdn_out(const Params& p, int l, int item, char* smem) {
  const int c = item >> 2, hd = item & 3, t0 = c * 64;
  float* sQD = (float*)smem; float* sS = sQD + 64 * 68; float* sAT = sS + 64 * 68; float* sVN = sAT + 64 * 68;
  const int tid = TID(), lane = tid & 63, wave = tid >> 6, r = lane & 15, qd = lane >> 4;
  const size_t b = (size_t)item * 4096;
#pragma unroll
  for (int idx = tid; idx < 1024; idx += NT) {
    int row = idx >> 4, c4 = idx & 15;
    *(float4*)&sQD[row * 68 + c4 * 4] = *(const float4*)&p.g_qd[b + row * 64 + c4 * 4];
    *(float4*)&sS[row * 68 + c4 * 4] = *(const float4*)&p.g_sst[b + row * 64 + c4 * 4];
    *(float4*)&sAT[row * 68 + c4 * 4] = *(const float4*)&p.g_attn[b + row * 64 + c4 * 4];
    *(float4*)&sVN[row * 68 + c4 * 4] = *(const float4*)&p.g_u[b + row * 64 + c4 * 4];
  }
  __syncthreads();
  const int mt = wave & 3, nh = wave >> 2;
  f32x4 acc[2]; acc[0] = acc[1] = f32x4{0.f, 0.f, 0.f, 0.f};
  mm16<2>(acc, sQD + mt * 16 * 68, 68, 1, sS + nh * 32, 68, 1, 64);
  mm16<2>(acc, sAT + mt * 16 * 68, 68, 1, sVN + nh * 32, 68, 1, 64);
  __syncthreads();
  float* sO = sQD;
#pragma unroll
  for (int t2 = 0; t2 < 2; ++t2)
#pragma unroll
    for (int e = 0; e < 4; ++e) sO[(mt * 16 + 4 * qd + e) * 68 + nh * 32 + t2 * 16 + r] = acc[t2][e];
  __syncthreads();
  {
    int row = tid >> 3, sub = tid & 7, t = t0 + row;
    float o[8], yv[8]; float ss = 0.f;
#pragma unroll
    for (int k = 0; k < 8; ++k) { o[k] = sO[row * 68 + sub * 8 + k]; ss += o[k] * o[k]; }
    ss += __shfl_xor(ss, 1); ss += __shfl_xor(ss, 2); ss += __shfl_xor(ss, 4);
    float rs = rsqrtf(ss * (1.f / 64.f) + EPS);
    float s2 = 0.f;
#pragma unroll
    for (int k = 0; k < 8; ++k) {
      int col = sub * 8 + k;
      float g = p.proj[(size_t)t * PW + DG + hd * 64 + col];
      float y = o[k] * rs * p.gdn_norm[l * 64 + col] * siluf_(g);
      s2 += y * y;
      yv[k] = y * p.branch_norm[(l * 4 + 3) * 256 + hd * 64 + col];
    }
    s2 += __shfl_xor(s2, 1); s2 += __shfl_xor(s2, 2); s2 += __shfl_xor(s2, 4);
    if (sub == 0) p.ssq[(size_t)t * 16 + 8 + hd] = s2;
    *(uint4*)&p.zb[(size_t)t * DM + 768 + hd * 64 + sub * 8] =
        uint4{pack2(yv[0], yv[1]), pack2(yv[2], yv[3]), pack2(yv[4], yv[5]), pack2(yv[6], yv[7])};
  }
  __syncthreads();
}

DEVI void ret_kv(const Params& p, int l, int item, char* smem) {
  const int c = item >> 2, hd = item & 3, t0 = c * 128;
  float* sK = (float*)smem; float* sV = sK + 128 * 65;
  const int tid = TID(), lane = tid & 63, wave = tid >> 6, r = lane & 15, qd = lane >> 4;
  const float lg = logf(1.f - exp2f(-5.f - (float)hd));
#pragma unroll
  for (int i = tid; i < 128 * 32; i += NT) {
    int t = i >> 5, f = i & 31; size_t tt = t0 + t;
    float k1 = p.proj[tt * PW + RK + hd * 64 + f], k2 = p.proj[tt * PW + RK + hd * 64 + 32 + f];
    float cs = p.rope[(tt * 32 + f) * 2], sn = p.rope[(tt * 32 + f) * 2 + 1];
    float dec = __expf(lg * (float)(127 - t));
    sK[t * 65 + f] = (k1 * cs - k2 * sn) * dec;
    sK[t * 65 + 32 + f] = (k2 * cs + k1 * sn) * dec;
  }
#pragma unroll
  for (int i = tid; i < 128 * 64; i += NT) {
    int t = i >> 6, e = i & 63;
    sV[t * 65 + e] = p.proj[(size_t)(t0 + t) * PW + RV + hd * 64 + e];
  }
  __syncthreads();
  const int mt = wave & 3, nh = wave >> 2;
  f32x4 acc[2]; acc[0] = acc[1] = f32x4{0.f, 0.f, 0.f, 0.f};
  mm16<2>(acc, sK + mt * 16, 1, 65, sV + nh * 32, 65, 1, 128);
#pragma unroll
  for (int t2 = 0; t2 < 2; ++t2)
#pragma unroll
    for (int e = 0; e < 4; ++e)
      p.ret_kv[(size_t)item * 4096 + (mt * 16 + 4 * qd + e) * 64 + nh * 32 + t2 * 16 + r] = acc[t2][e];
  __syncthreads();
}

DEVI void ret_out(const Params& p, int l, int item, char* smem) {
  const int c = item >> 2, hd = item & 3, t0 = c * 128;
  float* sQ = (float*)smem; float* sK = sQ + 128 * 65; float* sV = sK + 128 * 65; float* sSt = sV + 128 * 65;
  const int tid = TID(), lane = tid & 63, wave = tid >> 6, r = lane & 15, qd = lane >> 4;
  const float lg = logf(1.f - exp2f(-5.f - (float)hd));
  {
    const float* ssrc = p.ret_kv + (size_t)(c * 4 + hd) * 4096;
#pragma unroll
    for (int j = 0; j < 8; ++j) { int idx = tid + 512 * j; sSt[(idx >> 6) * 65 + (idx & 63)] = ssrc[idx]; }
  }
#pragma unroll
  for (int i = tid; i < 128 * 32; i += NT) {
    int t = i >> 5, f = i & 31; size_t tt = t0 + t;
    float cs = p.rope[(tt * 32 + f) * 2], sn = p.rope[(tt * 32 + f) * 2 + 1];
    float k1 = p.proj[tt * PW + RK + hd * 64 + f], k2 = p.proj[tt * PW + RK + hd * 64 + 32 + f];
    sK[t * 65 + f] = (k1 * cs - k2 * sn);
    sK[t * 65 + 32 + f] = (k2 * cs + k1 * sn);
    float q1 = p.proj[tt * PW + RQ + hd * 64 + f], q2 = p.proj[tt * PW + RQ + hd * 64 + 32 + f];
    sQ[t * 65 + f] = (q1 * cs - q2 * sn) * 0.125f;
    sQ[t * 65 + 32 + f] = (q2 * cs + q1 * sn) * 0.125f;
  }
#pragma unroll
  for (int i = tid; i < 128 * 64; i += NT) {
    int t = i >> 6, e = i & 63;
    sV[t * 65 + e] = p.proj[(size_t)(t0 + t) * PW + RV + hd * 64 + e];
  }
  __syncthreads();
  const int i0 = wave * 16;
  f32x4 sc[8], os[4];
#pragma unroll
  for (int t = 0; t < 8; ++t) sc[t] = f32x4{0.f, 0.f, 0.f, 0.f};
#pragma unroll
  for (int t = 0; t < 4; ++t) os[t] = f32x4{0.f, 0.f, 0.f, 0.f};
  mm16<8>(sc, sQ + i0 * 65, 65, 1, sK, 1, 65, 64);
  mm16<4>(os, sQ + i0 * 65, 65, 1, sSt, 65, 1, 64);
  __syncthreads();
  float* sP = (float*)smem;
#pragma unroll
  for (int t2 = 0; t2 < 8; ++t2)
#pragma unroll
    for (int e = 0; e < 4; ++e) {
      int i = i0 + 4 * qd + e, j = t2 * 16 + r;
      sP[i * 129 + j] = (i >= j) ? sc[t2][e] * __expf(lg * (float)(i - j)) : 0.f;
    }
  __syncthreads();
  f32x4 o[4];
#pragma unroll
  for (int t2 = 0; t2 < 4; ++t2)
#pragma unroll
    for (int e = 0; e < 4; ++e) o[t2][e] = os[t2][e] * __expf(lg * (float)(i0 + 4 * qd + e + 1));
  mm16<4>(o, sP + i0 * 129, 129, 1, sV, 65, 1, 128);
#pragma unroll
  for (int e = 0; e < 4; ++e) {
    int i = i0 + 4 * qd + e; size_t t = t0 + i;
    float sm = sum16(o[0][e] + o[1][e] + o[2][e] + o[3][e]);
    float mu = sm * (1.f / 64.f);
    float vr = 0.f;
#pragma unroll
    for (int t2 = 0; t2 < 4; ++t2) { float dd = o[t2][e] - mu; vr += dd * dd; }
    vr = sum16(vr);
    float rstd = rsqrtf(vr * (1.f / 64.f) + EPS);
    float ss = 0.f;
#pragma unroll
    for (int t2 = 0; t2 < 4; ++t2) {
      int col = hd * 64 + t2 * 16 + r;
      float on = (o[t2][e] - mu) * rstd * p.ret_gn[l * 256 + col];
      float g = p.proj[t * PW + RG + col];
      float y = siluf_(g) * on;
      ss += y * y;
      p.zb[t * DM + col] = f2bf(y * p.branch_norm[(l * 4 + 0) * 256 + col]);
    }
    ss = sum16(ss);
    if (r == 0) p.ssq[t * 16 + hd] = ss;
  }
  __syncthreads();
}

DEVI void lru_local(const Params& p, int l, int c, char* smem) {
  const int t0 = c * 64;
  float* sX = (float*)smem; float* sA = sX + 64 * 257;
  const int tid = TID(), lane = tid & 63, wave = tid >> 6, r = lane & 15, qd = lane >> 4;
  {
    const int ch = tid & 255, half = tid >> 8;
    const float w0 = p.lru_conv_w[(l * 4 + 0) * 256 + ch], w1 = p.lru_conv_w[(l * 4 + 1) * 256 + ch];
    const float w2 = p.lru_conv_w[(l * 4 + 2) * 256 + ch], w3 = p.lru_conv_w[(l * 4 + 3) * 256 + ch];
    const float cb = p.lru_conv_b[l * 256 + ch];
    const float* pc = p.proj + LX + ch;
    float xv[35];
#pragma unroll
    for (int k = 0; k < 35; ++k) {
      const int tt = t0 + 32 * half - 3 + k;
      const float v = pc[(size_t)(tt < 0 ? 0 : tt) * PW];
      xv[k] = tt < 0 ? 0.f : v;
    }
#pragma unroll
    for (int m = 0; m < 32; ++m) {
      float acc = cb;
      acc += w0 * xv[m]; acc += w1 * xv[m + 1]; acc += w2 * xv[m + 2]; acc += w3 * xv[m + 3];
      sX[(32 * half + m) * 257 + ch] = acc;
    }
  }
  __syncthreads();
  for (int pr = 0; pr < 2; ++pr) {
    int pi = wave * 2 + pr, mt = pi & 3, nb = pi >> 2;
    f32x4 ra[4], ri[4];
#pragma unroll
    for (int t = 0; t < 4; ++t) { ra[t] = f32x4{0.f, 0.f, 0.f, 0.f}; ri[t] = f32x4{0.f, 0.f, 0.f, 0.f}; }
    mm16_gB64<4>(ra, sX + mt * 16 * 257 + nb * 64, 257, p.lru_w_a + (size_t)(l * 4 + nb) * 4096);
    mm16_gB64<4>(ri, sX + mt * 16 * 257 + nb * 64, 257, p.lru_w_x + (size_t)(l * 4 + nb) * 4096);
#pragma unroll
    for (int t2 = 0; t2 < 4; ++t2)
#pragma unroll
      for (int e = 0; e < 4; ++e) {
        int t = mt * 16 + 4 * qd + e, ch = nb * 64 + t2 * 16 + r;
        float xb = sX[t * 257 + ch];
        float rr = sigmoidf_(ra[t2][e] + p.lru_b_a[l * 256 + ch]);
        float ii = sigmoidf_(ri[t2][e] + p.lru_b_x[l * 256 + ch]);
        float loga = -8.f * rr * softplusf_(-p.lru_lambda[l * 256 + ch]);
        float a = __expf(loga);
        float bb = __builtin_amdgcn_sqrtf(fmaxf(1.f - a * a, 0.f)) * (ii * xb);
        sA[t * 257 + ch] = a; sX[t * 257 + ch] = bb;
      }
  }
  __syncthreads();
  if (tid < 256) {
    int ch = tid; float H = 0.f, P = 1.f;
    for (int t = 0; t < 64; ++t) {
      float a = sA[t * 257 + ch], bb = sX[t * 257 + ch];
      H = a * H + bb; P *= a;
      p.lru_h[(size_t)(t0 + t) * 256 + ch] = H; p.lru_p[(size_t)(t0 + t) * 256 + ch] = P;
    }
    p.lru_hs[c * 256 + ch] = H; p.lru_ps[c * 256 + ch] = P;
  }
  __syncthreads();
}

DEVI void lru_out(const Params& p, int l, int c, char* smem) {
  const int t0 = c * 64;
  float* sC = (float*)smem;
  const int tid = TID(), lane = tid & 63, wave = tid >> 6;
  if (tid < 256) sC[tid] = p.lru_hs[c * 256 + tid];
  __syncthreads();
  {
    const int ch = lane * 4;
    float4 Hs[8], Ps[8], gs[8];
#pragma unroll
    for (int tk = 0; tk < 8; ++tk) {
      const size_t t = t0 + wave * 8 + tk;
      Hs[tk] = *(const float4*)&p.lru_h[t * 256 + ch]; Ps[tk] = *(const float4*)&p.lru_p[t * 256 + ch];
      gs[tk] = *(const float4*)&p.proj[t * PW + LG + ch];
    }
    const float4 cr = *(const float4*)&sC[ch];
    const float4 bn = *(const float4*)&p.branch_norm[(l * 4 + 1) * 256 + ch];
#pragma unroll
    for (int tk = 0; tk < 8; ++tk) {
      const size_t t = t0 + wave * 8 + tk;
      const float4 H = Hs[tk], P = Ps[tk], g = gs[tk];
      float y0 = geluf_(g.x) * (H.x + P.x * cr.x), y1 = geluf_(g.y) * (H.y + P.y * cr.y);
      float y2 = geluf_(g.z) * (H.z + P.z * cr.z), y3 = geluf_(g.w) * (H.w + P.w * cr.w);
      float ss = wave_sum(y0 * y0 + y1 * y1 + y2 * y2 + y3 * y3);
      if (lane == 0) p.ssq[t * 16 + 4] = ss;
      *(uint2*)&p.zb[t * DM + 256 + ch] = uint2{pack2(y0 * bn.x, y1 * bn.y), pack2(y2 * bn.z, y3 * bn.w)};
    }
  }
  __syncthreads();
}

DEVI void s5_coef(const Params& p, int l, int g, int n, float& abr, float& abi, float (&bbr)[16], float (&bbi)[16]) {
  float dt = __expf(p.s5_log_dt[l * 16 + g]);
  float are = p.s5_a_re[(l * 16 + g) * 64 + n], aim = p.s5_a_im[(l * 16 + g) * 64 + n];
  float mag = __expf(are * dt), ang = aim * dt;
  abr = mag * cosf(ang); abi = mag * sinf(ang);
  float den = are * are + aim * aim;
  float pre = abr - 1.f, pim = abi;
  float fre = (pre * are + pim * aim) / den, fim = (pim * are - pre * aim) / den;
  const float4* br = (const float4*)(p.s5_b_re + (size_t)((l * 16 + g) * 64 + n) * 16);
  const float4* bi = (const float4*)(p.s5_b_im + (size_t)((l * 16 + g) * 64 + n) * 16);
#pragma unroll
  for (int c4 = 0; c4 < 4; ++c4) {
    float4 a = br[c4], b = bi[c4];
    bbr[c4 * 4 + 0] = fre * a.x - fim * b.x; bbi[c4 * 4 + 0] = fre * b.x + fim * a.x;
    bbr[c4 * 4 + 1] = fre * a.y - fim * b.y; bbi[c4 * 4 + 1] = fre * b.y + fim * a.y;
    bbr[c4 * 4 + 2] = fre * a.z - fim * b.z; bbi[c4 * 4 + 2] = fre * b.z + fim * a.z;
    bbr[c4 * 4 + 3] = fre * a.w - fim * b.w; bbi[c4 * 4 + 3] = fre * b.w + fim * a.w;
  }
}
DEVI void s5_load_u(const Params& p, int t0, float* sU) {
#pragma unroll
  for (int i = TID(); i < 64 * 64; i += NT) {
    int t = i >> 6, c4 = i & 63;
    *(float4*)&sU[t * 256 + c4 * 4] = *(const float4*)&p.proj[(size_t)(t0 + t) * PW + SU + c4 * 4];
  }
}
DEVI void s5_bu(const float* up, const float (&bbr)[16], const float (&bbi)[16], float& bur, float& bui) {
  bur = 0.f; bui = 0.f;
#pragma unroll
  for (int c4 = 0; c4 < 4; ++c4) {
    float4 u = *(const float4*)&up[c4 * 4];
    bur += bbr[c4 * 4] * u.x + bbr[c4 * 4 + 1] * u.y + bbr[c4 * 4 + 2] * u.z + bbr[c4 * 4 + 3] * u.w;
    bui += bbi[c4 * 4] * u.x + bbi[c4 * 4 + 1] * u.y + bbi[c4 * 4 + 2] * u.z + bbi[c4 * 4 + 3] * u.w;
  }
}

DEVI void s5_local(const Params& p, int l, int c, char* smem) {
  const int t0 = c * 64;
  float* sU = (float*)smem;
  const int lane = TID() & 63, wave = TID() >> 6;
  s5_load_u(p, t0, sU);
  __syncthreads();
  for (int gi = 0; gi < 2; ++gi) {
    int g = wave + 8 * gi;
    float abr, abi, bbr[16], bbi[16];
    s5_coef(p, l, g, lane, abr, abi, bbr, bbi);
    float xr = 0.f, xi = 0.f;
    for (int t = 0; t < 64; ++t) {
      float bur, bui; s5_bu(sU + t * 256 + g * 16, bbr, bbi, bur, bui);
      float nr = abr * xr - abi * xi + bur, ni = abr * xi + abi * xr + bui;
      xr = nr; xi = ni;
    }
    *(float2*)&p.xloc[((size_t)(c * 16 + g) * 64 + lane) * 2] = float2{xr, xi};
  }
  __syncthreads();
}

DEVI void s5_out(const Params& p, int l, int c, char* smem) {
  const int t0 = c * 64;
  bf16_t* sY = (bf16_t*)smem;
  float* sX = (float*)(smem + 64 * 264 * 2);
  const int tid = TID(), lane = tid & 63, wave = tid >> 6, r = lane & 15, qd = lane >> 4;
  float* Xl = sX + wave * (16 * 132);
  for (int gi = 0; gi < 2; ++gi) {
    const int g = wave + 8 * gi;
    float abr, abi, bbr[16], bbi[16];
    s5_coef(p, l, g, lane, abr, abi, bbr, bbi);
    float breg[32];
#pragma unroll
    for (int ks = 0; ks < 16; ++ks) {
      breg[ks] = p.s5_c_re[(size_t)((l * 16 + g) * 16 + r) * 64 + 4 * ks + qd];
      breg[16 + ks] = -p.s5_c_im[(size_t)((l * 16 + g) * 16 + r) * 64 + 4 * ks + qd];
    }
    const float dd = p.s5_d[l * 256 + g * 16 + r];
    const float2 xin = *(const float2*)&p.xloc[((size_t)(c * 16 + g) * 64 + lane) * 2];
    float xr = xin.x, xi = xin.y;
    float4 uvecs[4]; float ues[4][4];
#pragma unroll
    for (int tb = 0; tb < 4; ++tb) {
      const float* ub = p.proj + (size_t)(t0 + tb * 16) * PW + SU + g * 16;
      uvecs[tb] = *(const float4*)&ub[(size_t)r * PW + 4 * qd];
#pragma unroll
      for (int e = 0; e < 4; ++e) ues[tb][e] = ub[(size_t)(4 * qd + e) * PW + r];
    }
#pragma unroll
    for (int tb = 0; tb < 4; ++tb) {
      const float4 uvec = uvecs[tb];
      float ue[4];
#pragma unroll
      for (int e = 0; e < 4; ++e) ue[e] = ues[tb][e];
      const int u0 = __float_as_int(uvec.x), u1 = __float_as_int(uvec.y), u2 = __float_as_int(uvec.z), u3 = __float_as_int(uvec.w);
#pragma unroll
      for (int tt = 0; tt < 16; ++tt) {
        float bur = 0.f, bui = 0.f;
#pragma unroll
        for (int c4 = 0; c4 < 4; ++c4) {
          float a0 = __int_as_float(__builtin_amdgcn_readlane(u0, tt + 16 * c4));
          float a1 = __int_as_float(__builtin_amdgcn_readlane(u1, tt + 16 * c4));
          float a2 = __int_as_float(__builtin_amdgcn_readlane(u2, tt + 16 * c4));
          float a3 = __int_as_float(__builtin_amdgcn_readlane(u3, tt + 16 * c4));
          bur += bbr[c4 * 4] * a0 + bbr[c4 * 4 + 1] * a1 + bbr[c4 * 4 + 2] * a2 + bbr[c4 * 4 + 3] * a3;
          bui += bbi[c4 * 4] * a0 + bbi[c4 * 4 + 1] * a1 + bbi[c4 * 4 + 2] * a2 + bbi[c4 * 4 + 3] * a3;
        }
        float nr = abr * xr - abi * xi + bur, ni = abr * xi + abi * xr + bui;
        xr = nr; xi = ni;
        Xl[tt * 132 + lane] = xr; Xl[tt * 132 + 64 + lane] = xi;
      }
      f32x4 acc = f32x4{0.f, 0.f, 0.f, 0.f};
#pragma unroll
      for (int ks = 0; ks < 32; ++ks) {
        float a = Xl[r * 132 + 4 * ks + qd];
        acc = __builtin_amdgcn_mfma_f32_16x16x4f32(a, breg[ks], acc, 0, 0, 0);
      }
#pragma unroll
      for (int e = 0; e < 4; ++e) {
        float y = acc[e] + dd * ue[e];
        sY[(tb * 16 + 4 * qd + e) * 264 + g * 16 + r] = f2bf(geluf_(y));
      }
    }
  }
  __syncthreads();
  f32x4 av[4][2], ag[4][2];
#pragma unroll
  for (int i = 0; i < 4; ++i)
#pragma unroll
    for (int j = 0; j < 2; ++j) { av[i][j] = f32x4{0.f, 0.f, 0.f, 0.f}; ag[i][j] = f32x4{0.f, 0.f, 0.f, 0.f}; }
  const bf16_t* WT = p.gluT + (size_t)l * 512 * 256;
#pragma unroll 4
  for (int ks = 0; ks < 8; ++ks) {
    bf16x8 bv0 = *(const bf16x8*)&WT[(size_t)(32 * wave + r) * 256 + ks * 32 + qd * 8];
    bf16x8 bv1 = *(const bf16x8*)&WT[(size_t)(32 * wave + 16 + r) * 256 + ks * 32 + qd * 8];
    bf16x8 bg0 = *(const bf16x8*)&WT[(size_t)(256 + 32 * wave + r) * 256 + ks * 32 + qd * 8];
    bf16x8 bg1 = *(const bf16x8*)&WT[(size_t)(256 + 32 * wave + 16 + r) * 256 + ks * 32 + qd * 8];
#pragma unroll
    for (int mt = 0; mt < 4; ++mt) {
      bf16x8 a = *(const bf16x8*)&sY[(mt * 16 + r) * 264 + ks * 32 + qd * 8];
      av[mt][0] = __builtin_amdgcn_mfma_f32_16x16x32_bf16(a, bv0, av[mt][0], 0, 0, 0);
      av[mt][1] = __builtin_amdgcn_mfma_f32_16x16x32_bf16(a, bv1, av[mt][1], 0, 0, 0);
      ag[mt][0] = __builtin_amdgcn_mfma_f32_16x16x32_bf16(a, bg0, ag[mt][0], 0, 0, 0);
      ag[mt][1] = __builtin_amdgcn_mfma_f32_16x16x32_bf16(a, bg1, ag[mt][1], 0, 0, 0);
    }
  }
  float* sO = sX;
#pragma unroll
  for (int mt = 0; mt < 4; ++mt)
#pragma unroll
    for (int t2 = 0; t2 < 2; ++t2)
#pragma unroll
      for (int e = 0; e < 4; ++e) {
        int t = mt * 16 + 4 * qd + e, col = 32 * wave + t2 * 16 + r;
        float zv = av[mt][t2][e] + p.s5_glu_b[l * 512 + col];
        float zg = ag[mt][t2][e] + p.s5_glu_b[l * 512 + 256 + col];
        sO[t * 256 + col] = zv * sigmoidf_(zg);
      }
  __syncthreads();
  for (int tk = 0; tk < 8; ++tk) {
    int tl = wave * 8 + tk; size_t t = t0 + tl; int ch = lane * 4;
    float4 o = *(const float4*)&sO[tl * 256 + ch];
    float4 bn = *(const float4*)&p.branch_norm[(l * 4 + 2) * 256 + ch];
    float ss = wave_sum(o.x * o.x + o.y * o.y + o.z * o.z + o.w * o.w);
    if (lane == 0) p.ssq[t * 16 + 5] = ss;
    *(uint2*)&p.zb[t * DM + 512 + ch] = uint2{pack2(o.x * bn.x, o.y * bn.y), pack2(o.z * bn.z, o.w * bn.w)};
  }
  __syncthreads();
}

DEVI void ret_scan(const Params& p, int it) {
  const int elem = it * NT + TID(), hd = elem >> 12, idx = elem & 4095;
  const float lg = logf(1.f - exp2f(-5.f - (float)hd)), cdk = __expf(lg * 128.f);
  float* base = p.ret_kv + (size_t)hd * 4096 + idx;
  float s = 0.f;
  for (int cb = 0; cb < 128; cb += 16) {
    float v[16];
#pragma unroll
    for (int j = 0; j < 16; ++j) v[j] = base[(size_t)(cb + j) * 16384];
#pragma unroll
    for (int j = 0; j < 16; ++j) { base[(size_t)(cb + j) * 16384] = s; s = s * cdk + v[j]; }
  }
}
DEVI void s5_scan(const Params& p, int l, int it) {
  const int sidx = it * NT + TID(), g = sidx >> 6, n = sidx & 63;
  float dt = __expf(p.s5_log_dt[l * 16 + g]);
  float are = p.s5_a_re[(l * 16 + g) * 64 + n], aim = p.s5_a_im[(l * 16 + g) * 64 + n];
  float mag = __expf(are * dt), ang = aim * dt;
  float pr = mag * cosf(ang), pi = mag * sinf(ang);
#pragma unroll
  for (int k = 0; k < 6; ++k) { float nr = pr * pr - pi * pi, ni = 2.f * pr * pi; pr = nr; pi = ni; }
  float2* base = (float2*)p.xloc + sidx;
  float xr = 0.f, xi = 0.f;
  for (int cb = 0; cb < 256; cb += 16) {
    float2 v[16];
#pragma unroll
    for (int j = 0; j < 16; ++j) v[j] = base[(size_t)(cb + j) * 1024];
#pragma unroll
    for (int j = 0; j < 16; ++j) {
      base[(size_t)(cb + j) * 1024] = float2{xr, xi};
      float nr = pr * xr - pi * xi + v[j].x, ni = pr * xi + pi * xr + v[j].y;
      xr = nr; xi = ni;
    }
  }
}
DEVI void lru_scan(const Params& p) {
  const int ch = TID();
  if (ch < 256) {
    float carry = 0.f;
    for (int cb = 0; cb < 256; cb += 16) {
      float ps[16], hs[16];
#pragma unroll
      for (int j = 0; j < 16; ++j) { ps[j] = p.lru_ps[(cb + j) * 256 + ch]; hs[j] = p.lru_hs[(cb + j) * 256 + ch]; }
#pragma unroll
      for (int j = 0; j < 16; ++j) { p.lru_hs[(cb + j) * 256 + ch] = carry; carry = ps[j] * carry + hs[j]; }
    }
  }
}

DEVI void peer_scores(const Params& p, int l, int item, char* smem) {
  const int hp = item & 15, grp = item >> 4;
  float* sQ = (float*)smem;
  float* sKy = sQ + 64 * 68;
  const int tid = TID(), lane = tid & 63, wave = tid >> 6, r = lane & 15, qd = lane >> 4;
  const float* ky = p.peer_subkeys + (size_t)(l * 16 + hp) * 8192;
#pragma unroll
  for (int i = tid; i < 128 * 64; i += NT) { int k = i >> 6, d = i & 63; sKy[k * 65 + d] = ky[i]; }
  const int lt0 = tid >> 4, lc4 = (tid & 15) * 4;
  const float* qb = p.qbuf + (size_t)hp * 64 + lc4;
  float4 q0, q1;
  {
    const size_t t0 = (size_t)(grp * 16) * 64;
    q0 = *(const float4*)&qb[(t0 + lt0) * 1024]; q1 = *(const float4*)&qb[(t0 + lt0 + 32) * 1024];
  }
  const int mt = wave & 3, nh = wave >> 2;
  for (int k = 0; k < 16; ++k) {
    const size_t t0 = (size_t)(grp * 16 + k) * 64;
    __syncthreads();
    *(float4*)&sQ[lt0 * 68 + lc4] = q0; *(float4*)&sQ[(lt0 + 32) * 68 + lc4] = q1;
    __syncthreads();
    if (k + 1 < 16) { q0 = *(const float4*)&qb[(t0 + 64 + lt0) * 1024]; q1 = *(const float4*)&qb[(t0 + 64 + lt0 + 32) * 1024]; }
    f32x4 acc[4];
#pragma unroll
    for (int t = 0; t < 4; ++t) acc[t] = f32x4{0.f, 0.f, 0.f, 0.f};
    mm16<4>(acc, sQ + mt * 16 * 68, 68, 1, sKy + nh * 64 * 65, 1, 65, 64);
#pragma unroll
    for (int t2 = 0; t2 < 4; ++t2)
#pragma unroll
      for (int e = 0; e < 4; ++e) {
        size_t t = t0 + mt * 16 + 4 * qd + e; int key = nh * 64 + t2 * 16 + r;
        p.scores[(t * 16 + hp) * 128 + key] = acc[t2][e];
      }
  }
  __syncthreads();
}

DEVI unsigned ford(float x) { unsigned u = __float_as_uint(x); return (u & 0x80000000u) ? ~u : (u | 0x80000000u); }
DEVI float funord(unsigned u) { return __uint_as_float((u & 0x80000000u) ? (u ^ 0x80000000u) : ~u); }
DEVI void ins16(unsigned (&v)[16], unsigned x) {
#pragma unroll
  for (int j = 0; j < 16; ++j) { unsigned hi = max(v[j], x); x = min(v[j], x); v[j] = hi; }
}

DEVI void cv_issue(const Params& p, int l, int rr, int lane, float4& a, float4& b, float4& c, float4& d) {
  const int which = rr >> 14, row = rr & 16383;
  const float* s = (which ? p.peer_v : p.peer_u) + ((size_t)l * 16384 + row) * 1024 + lane * 16;
  a = *(const float4*)s; b = *(const float4*)(s + 4); c = *(const float4*)(s + 8); d = *(const float4*)(s + 12);
}
DEVI void cv_finish(const Params& p, int rr, int lane, const float4& a, const float4& b, const float4& c, const float4& d) {
  const int which = rr >> 14, row = rr & 16383;
  float m = fmaxf(fmaxf(fmaxf(fabsf(a.x), fabsf(a.y)), fmaxf(fabsf(a.z), fabsf(a.w))),
                  fmaxf(fmaxf(fabsf(b.x), fabsf(b.y)), fmaxf(fabsf(b.z), fabsf(b.w))));
  m = fmaxf(m, fmaxf(fmaxf(fmaxf(fabsf(c.x), fabsf(c.y)), fmaxf(fabsf(c.z), fabsf(c.w))),
                     fmaxf(fmaxf(fabsf(d.x), fabsf(d.y)), fmaxf(fabsf(d.z), fabsf(d.w)))));
  m = fmaxf(m, __shfl_xor(m, 32)); m = fmaxf(m, __shfl_xor(m, 16)); m = fmaxf(m, __shfl_xor(m, 8));
  m = fmaxf(m, __shfl_xor(m, 4)); m = fmaxf(m, __shfl_xor(m, 2)); m = fmaxf(m, __shfl_xor(m, 1));
  const float sc = m > 0.f ? 256.f / m : 1.f;
  int w0 = 0, w1 = 0, w2 = 0, w3 = 0;
  w0 = __builtin_amdgcn_cvt_pk_fp8_f32(a.x * sc, a.y * sc, w0, false); w0 = __builtin_amdgcn_cvt_pk_fp8_f32(a.z * sc, a.w * sc, w0, true);
  w1 = __builtin_amdgcn_cvt_pk_fp8_f32(b.x * sc, b.y * sc, w1, false); w1 = __builtin_amdgcn_cvt_pk_fp8_f32(b.z * sc, b.w * sc, w1, true);
  w2 = __builtin_amdgcn_cvt_pk_fp8_f32(c.x * sc, c.y * sc, w2, false); w2 = __builtin_amdgcn_cvt_pk_fp8_f32(c.z * sc, c.w * sc, w2, true);
  w3 = __builtin_amdgcn_cvt_pk_fp8_f32(d.x * sc, d.y * sc, w3, false); w3 = __builtin_amdgcn_cvt_pk_fp8_f32(d.z * sc, d.w * sc, w3, true);
  *(uint4*)((which ? p.tabV : p.tabU) + (size_t)row * 1024 + lane * 16) = uint4{(unsigned)w0, (unsigned)w1, (unsigned)w2, (unsigned)w3};
  if (lane == 0) (which ? p.vinv : p.uinv)[row] = m > 0.f ? m * (1.f / 256.f) : 1.f;
}

DEVI void peer_topk(const Params& p, int l, int item, int cvbase, char* smem) {
  const int t0 = item * 64;
  float* sS = (float*)smem;
  const int tid = TID();
  const float* base = p.scores + (size_t)t0 * 8 * 256;
  unsigned v1[16], v2[16];
#pragma unroll
  for (int j = 0; j < 16; ++j) { v1[j] = 0u; v2[j] = 0u; }
  float4 nx[8];
#pragma unroll
  for (int i = 0; i < 8; ++i) { int idx = tid + 512 * i; nx[i] = *(const float4*)&base[(size_t)(idx >> 3) * 256 + (idx & 7) * 4]; }
  for (int s = 0; s < 8; ++s) {
    __syncthreads();
#pragma unroll
    for (int i = 0; i < 8; ++i) {
      int idx = tid + 512 * i, pr = idx >> 3, c4 = idx & 7;
      float* d = &sS[pr * 33 + c4 * 4];
      d[0] = nx[i].x; d[1] = nx[i].y; d[2] = nx[i].z; d[3] = nx[i].w;
    }
    __syncthreads();
    if (s + 1 < 8) {
#pragma unroll
      for (int i = 0; i < 8; ++i) { int idx = tid + 512 * i; nx[i] = *(const float4*)&base[(size_t)(idx >> 3) * 256 + (s + 1) * 32 + (idx & 7) * 4]; }
    }
    float4 ca0, cb0, cc0, cd0, ca1, cb1, cc1, cd1;
    if (cvbase >= 0) {
      cv_issue(p, l, cvbase + 2 * s, tid & 63, ca0, cb0, cc0, cd0);
      cv_issue(p, l, cvbase + 2 * s + 1, tid & 63, ca1, cb1, cc1, cd1);
    }
    const int kb = (s & 3) * 32;
    if (s < 4) {
      for (int k = 0; k < 32; ++k) { unsigned key = (ford(sS[tid * 33 + k]) & ~127u) | (unsigned)(127 - (kb + k)); ins16(v1, key); }
    } else {
      for (int k = 0; k < 32; ++k) { unsigned key = (ford(sS[tid * 33 + k]) & ~127u) | (unsigned)(127 - (kb + k)); ins16(v2, key); }
    }
    if (cvbase >= 0) {
      cv_finish(p, cvbase + 2 * s, tid & 63, ca0, cb0, cc0, cd0);
      cv_finish(p, cvbase + 2 * s + 1, tid & 63, ca1, cb1, cc1, cd1);
    }
  }
  __syncthreads();
  unsigned* sI = (unsigned*)smem;
  float s1[16], s2[16];
#pragma unroll
  for (int a = 0; a < 16; ++a) {
    s1[a] = funord(v1[a] & ~127u); s2[a] = funord(v2[a] & ~127u);
    sI[tid * 33 + a] = 127u - (v1[a] & 127u); sI[tid * 33 + 16 + a] = 127u - (v2[a] & 127u);
  }
  unsigned vt[16];
#pragma unroll
  for (int j = 0; j < 16; ++j) vt[j] = 0u;
#pragma unroll
  for (int a = 0; a < 16; ++a)
#pragma unroll
    for (int b = 0; b < 16; ++b)
      if ((a + 1) * (b + 1) <= 16) {
        unsigned key = (ford(s1[a] + s2[b]) & ~255u) | (unsigned)(255 - (a * 16 + b));
        ins16(vt, key);
      }
  float sv[16]; float den = 0.f;
  const float mx = funord(vt[0] & ~255u);
#pragma unroll
  for (int k = 0; k < 16; ++k) { sv[k] = __expf(funord(vt[k] & ~255u) - mx); den += sv[k]; }
  const float inv = 1.f / den;
  const int tl = tid >> 3, hh = tid & 7;
  int* idp = p.ids + (size_t)(t0 + tl) * 128 + hh * 16;
  float* gp = p.gates + (size_t)(t0 + tl) * 128 + hh * 16;
#pragma unroll
  for (int k = 0; k < 16; ++k) {
    unsigned pos = 255u - (vt[k] & 255u);
    unsigned i1 = sI[tid * 33 + (pos >> 4)], i2 = sI[tid * 33 + 16 + (pos & 15)];
    idp[k] = (int)(i1 * 128u + i2);
    gp[k] = sv[k] * inv;
  }
  __syncthreads();
}

typedef __attribute__((ext_vector_type(2))) float f32x2;
DEVI void fp8x16_to_f(const uint4& v, float (&o)[16]) {
  f32x2 t;
  t = __builtin_amdgcn_cvt_pk_f32_fp8((int)v.x, false); o[0] = t[0]; o[1] = t[1];
  t = __builtin_amdgcn_cvt_pk_f32_fp8((int)v.x, true); o[2] = t[0]; o[3] = t[1];
  t = __builtin_amdgcn_cvt_pk_f32_fp8((int)v.y, false); o[4] = t[0]; o[5] = t[1];
  t = __builtin_amdgcn_cvt_pk_f32_fp8((int)v.y, true); o[6] = t[0]; o[7] = t[1];
  t = __builtin_amdgcn_cvt_pk_f32_fp8((int)v.z, false); o[8] = t[0]; o[9] = t[1];
  t = __builtin_amdgcn_cvt_pk_f32_fp8((int)v.z, true); o[10] = t[0]; o[11] = t[1];
  t = __builtin_amdgcn_cvt_pk_f32_fp8((int)v.w, false); o[12] = t[0]; o[13] = t[1];
  t = __builtin_amdgcn_cvt_pk_f32_fp8((int)v.w, true); o[14] = t[0]; o[15] = t[1];
}

DEVI void ph_gather(const Params& p, int l) {
  const int lane = TID() & 63, wave = TID() >> 6;
  const int e0 = lane * 16;
  constexpr int NB = 8;
  for (int t = blockIdx.x * 8 + wave; t < S_; t += gridDim.x * 8) {
    float* hrow = p.h + (size_t)t * DM + e0;
    float z[16], out[16];
    {
      float4 a = *(const float4*)&hrow[0], b = *(const float4*)&hrow[4], c = *(const float4*)&hrow[8], d = *(const float4*)&hrow[12];
      z[0] = a.x; z[1] = a.y; z[2] = a.z; z[3] = a.w; z[4] = b.x; z[5] = b.y; z[6] = b.z; z[7] = b.w;
      z[8] = c.x; z[9] = c.y; z[10] = c.z; z[11] = c.w; z[12] = d.x; z[13] = d.y; z[14] = d.z; z[15] = d.w;
    }
    float ss = 0.f;
#pragma unroll
    for (int k = 0; k < 16; ++k) { ss += z[k] * z[k]; out[k] = 0.f; }
    ss = wave_sum(ss);
    const float rs = rsqrtf(ss * (1.f / DM) + EPS);
    const float* fn = p.ffn_norm + l * DM + e0;
#pragma unroll
    for (int k = 0; k < 16; ++k) z[k] = z[k] * rs * fn[k];
    const int id0 = p.ids[(size_t)t * 128 + lane], id1 = p.ids[(size_t)t * 128 + 64 + lane];
    const int gv0 = __float_as_int(p.gates[(size_t)t * 128 + lane] * p.vinv[id0]);
    const int gv1 = __float_as_int(p.gates[(size_t)t * 128 + 64 + lane] * p.vinv[id1]);
    const int us0 = __float_as_int(p.uinv[id0]), us1 = __float_as_int(p.uinv[id1]);
    uint4 cu[NB], cv[NB], nu[NB], nv[NB];
#pragma unroll
    for (int j = 0; j < NB; ++j) {
      int e = __builtin_amdgcn_readlane(id0, j);
      cu[j] = *(const uint4*)(p.tabU + (size_t)e * 1024 + e0);
      cv[j] = *(const uint4*)(p.tabV + (size_t)e * 1024 + e0);
    }
#pragma unroll 1
    for (int b = 0; b < 128 / NB; ++b) {
      const int nb = b + 1;
      if (nb < 128 / NB) {
        const int idn = nb < 64 / NB ? id0 : id1;
#pragma unroll
        for (int j = 0; j < NB; ++j) {
          int e = __builtin_amdgcn_readlane(idn, (nb * NB + j) & 63);
          nu[j] = *(const uint4*)(p.tabU + (size_t)e * 1024 + e0);
          nv[j] = *(const uint4*)(p.tabV + (size_t)e * 1024 + e0);
        }
      }
      const int gvc = b < 64 / NB ? gv0 : gv1, usc = b < 64 / NB ? us0 : us1;
      float dot[NB];
#pragma unroll
      for (int j = 0; j < NB; ++j) {
        float f[16]; fp8x16_to_f(cu[j], f);
        float d = 0.f;
#pragma unroll
        for (int k = 0; k < 16; ++k) d += z[k] * f[k];
        dot[j] = d;
      }
#pragma unroll
      for (int j = 0; j < NB; ++j) dot[j] = wave_sum(dot[j]);
#pragma unroll
      for (int j = 0; j < NB; ++j) {
        const int li = (b * NB + j) & 63;
        float us = __int_as_float(__builtin_amdgcn_readlane(usc, li));
        float gt = __int_as_float(__builtin_amdgcn_readlane(gvc, li));
        float cf = gt * geluf_ref_(dot[j] * us);
        float f[16]; fp8x16_to_f(cv[j], f);
#pragma unroll
        for (int k = 0; k < 16; ++k) out[k] += cf * f[k];
      }
#pragma unroll
      for (int j = 0; j < NB; ++j) { cu[j] = nu[j]; cv[j] = nv[j]; }
    }
    float hv[16];
    {
      float4 a = *(const float4*)&hrow[0], b = *(const float4*)&hrow[4], c = *(const float4*)&hrow[8], d = *(const float4*)&hrow[12];
      hv[0] = a.x; hv[1] = a.y; hv[2] = a.z; hv[3] = a.w; hv[4] = b.x; hv[5] = b.y; hv[6] = b.z; hv[7] = b.w;
      hv[8] = c.x; hv[9] = c.y; hv[10] = c.z; hv[11] = c.w; hv[12] = d.x; hv[13] = d.y; hv[14] = d.z; hv[15] = d.w;
    }
    float s2 = 0.f;
#pragma unroll
    for (int k = 0; k < 16; ++k) { hv[k] += out[k]; s2 += hv[k] * hv[k]; }
    *(float4*)&hrow[0] = float4{hv[0], hv[1], hv[2], hv[3]}; *(float4*)&hrow[4] = float4{hv[4], hv[5], hv[6], hv[7]};
    *(float4*)&hrow[8] = float4{hv[8], hv[9], hv[10], hv[11]}; *(float4*)&hrow[12] = float4{hv[12], hv[13], hv[14], hv[15]};
    s2 = wave_sum(s2);
    const float rs2 = rsqrtf(s2 * (1.f / DM) + EPS);
    const float* pn = p.ple_norm + l * DM + e0;
    float zz[16];
#pragma unroll
    for (int k = 0; k < 16; ++k) zz[k] = hv[k] * rs2 * pn[k];
    bf16_t* zrow = p.zb + (size_t)t * DM + e0;
    *(uint4*)&zrow[0] = uint4{pack2(zz[0], zz[1]), pack2(zz[2], zz[3]), pack2(zz[4], zz[5]), pack2(zz[6], zz[7])};
    *(uint4*)&zrow[8] = uint4{pack2(zz[8], zz[9]), pack2(zz[10], zz[11]), pack2(zz[12], zz[13]), pack2(zz[14], zz[15])};
  }
}

template <class F>
DEVI void gemm_tiles(int NTn, int XM, int XN, F&& f) {
  int G = gridDim.x, B = blockIdx.x;
  asm volatile("" : "+s"(G), "+s"(B));
  if (G & 7) { for (int tile = B; tile < 64 * NTn; tile += G) f(tile / NTn, tile % NTn); return; }
  const int x = B & 7, slot = B >> 3, ns = G >> 3;
  const int xm = x / XN, xn = x % XN;
  const int mcnt = 64 / XM, mb = xm * mcnt;
  const int ncnt = (NTn - xn + XN - 1) / XN;
  for (int j = slot; j < mcnt * ncnt; j += ns) f(mb + j / ncnt, xn + XN * (j % ncnt));
}

enum { PH_PREP = 0, PH_NORM1, PH_GEMM_IN, PH_MIX_A, PH_MIX_B, PH_MIX_C, PH_MIX_D, PH_GEMM_OUT, PH_NORM2, PH_GEMM_Q, PH_SCORES,
       PH_TOPK, PH_GATHER, PH_GEMM_PLE, PH_FINAL };

#if PROBE_A >= 0
#define REGION(id, stmt)                                                                                   \
  {                                                                                                        \
    const bool on_ = (blockIdx.x == 255 && TID() == 0 && ((id) == PROBE_A || (id) == PROBE_B));              \
    if (on_) p.g_cdec[2051] = (float)(wall_clock64() & 0xFFFFFFull);                                       \
    stmt;                                                                                                  \
    if (on_) {                                                                                             \
      float dt_ = (float)(wall_clock64() & 0xFFFFFFull) - p.g_cdec[2051];                                  \
      if (dt_ < 0.f) dt_ += 16777216.f;                                                                    \
      p.g_cdec[(id) == PROBE_A ? 2048 : 2049] += dt_;                                                      \
    }                                                                                                      \
  }
#else
#define REGION(id, stmt) { stmt; }
#endif
DEVI void run_phase(const Params& p, int ph, int l, char* smem) {
  int G = gridDim.x, B = blockIdx.x;
  asm volatile("" : "+s"(G), "+s"(B));
  int tr_first = 0, tr_last = 0, tr_b = 0, tr_nb = 1;
  switch (ph) {
    case PH_PREP:
      ph_prep(p, smem);
      ph_norm(p.x, p.mix_norm, p.zb, nullptr);
      tr_first = 0; tr_last = 736; tr_b = B; tr_nb = G;
      break;
    case PH_NORM1: ph_norm(l == 0 ? p.x : p.h, p.mix_norm + l * DM, p.zb, nullptr); break;
    case PH_GEMM_IN:
      gemm_tiles(23, 1, 8, [&](int mt_, int nt_) __attribute__((always_inline)) {
        int m0 = mt_ * 256, n0 = nt_ * 128;
        f32x4 acc[4][4];
        gemm_tile<0, 16>(acc, p.zb, DM, p.winT + (size_t)l * PW * 1024, 1024, 1024, m0, n0, nullptr, smem);
        GEMM_EPI_COORDS
#pragma unroll
        for (int i = 0; i < 4; ++i)
#pragma unroll
          for (int j = 0; j < 4; ++j)
            *(f32x4*)&p.proj[(size_t)(erow0 + i * 16) * PW + ecol0 + j * 16] = acc[i][j];
      });
      break;
    case PH_MIX_A:
      for (int it = B; it < 2048; it += G) {
        if (it < 1024) REGION(105, gdn_prep(p, l, it, smem))
        else if (it < 1536) REGION(106, ret_kv(p, l, it - 1024, smem))
        else if (it < 1792) REGION(107, lru_local(p, l, it - 1536, smem))
        else REGION(108, s5_local(p, l, it - 1792, smem))
      }
      break;
    case PH_MIX_B:
      for (int it = B; it < 256 + 35; it += G) {
        if (it < 256) { const int pr_ = (it & 7) * 4 + (it >> 6), cb_ = (it >> 3) & 7; REGION(100, gdn_chain<0>(p, pr_ >> 3, pr_ & 7, cb_, smem)) }
        else if (it < 256 + 32) ret_scan(p, it - 256);
        else if (it < 256 + 34) s5_scan(p, l, it - 288);
        else lru_scan(p);
      }
      {
        const int f_ = l == 0 ? 736 : 2336, e_ = l == 0 ? 2336 : 3200;
        if (G > 70) { if (B >= 35) { tr_first = f_; tr_last = e_; tr_b = B - 35; tr_nb = G - 35; } }
        else { tr_first = f_; tr_last = e_; tr_b = B; tr_nb = G; }
      }
      break;
    case PH_MIX_C: {
      for (int k = 0;; ++k) {
        int ty = -1, idx = 0;
        if (G == 256) {
          if (B < 128) { if (k < 4) { ty = k; idx = B; } }
          else if (k == 0) { ty = 1; idx = B; }
          else if (k <= 3) { ty = 2; idx = 128 + (B - 128) * 3 + (k - 1); }
          else if (k == 4) { ty = 3; idx = B; }
        } else {
          const int it = B + k * G;
          if (it < 128) { ty = 0; idx = it; }
          else if (it < 640) { ty = 2; idx = it - 128; }
          else if (it < 896) { ty = 1; idx = it - 640; }
          else if (it < 1152) { ty = 3; idx = it - 896; }
        }
        if (ty < 0) break;
        if (ty == 0) { const int pr_ = (idx & 7) * 4 + (idx >> 5), cb_ = (idx >> 3) & 3; REGION(102, gdn_chain<1>(p, pr_ >> 3, pr_ & 7, cb_, smem)) }
        else if (ty == 1) REGION(103, s5_out(p, l, idx, smem))
        else if (ty == 2) REGION(101, ret_out(p, l, idx, smem))
        else REGION(104, lru_out(p, l, idx, smem))
      }
    } break;
    case PH_MIX_D:
      for (int it = B; it < 1024; it += G) REGION(109, gdn_out(p, l, it, smem))
      break;
    case PH_GEMM_OUT:
      gemm_tiles(8, 4, 2, [&](int mt_, int nt_) __attribute__((always_inline)) {
        int m0 = mt_ * 256, n0 = nt_ * 128;
        f32x4 acc[4][4];
        gemm_tile<1, 16>(acc, p.zb, DM, p.woutT + (size_t)l * 1024 * 1024, 1024, 1024, m0, n0, p.ssq, smem);
        GEMM_EPI_COORDS
#pragma unroll
        for (int i = 0; i < 4; ++i)
#pragma unroll
          for (int j = 0; j < 4; ++j)
            acc[i][j] += *(const f32x4*)&(l == 0 ? p.x : p.h)[(size_t)(erow0 + i * 16) * DM + ecol0 + j * 16];
#pragma unroll
        for (int i = 0; i < 4; ++i)
#pragma unroll
          for (int j = 0; j < 4; ++j)
            *(f32x4*)&p.h[(size_t)(erow0 + i * 16) * DM + ecol0 + j * 16] = acc[i][j];
      });
      break;
    case PH_NORM2:
      ph_norm(p.h, p.ffn_norm + l * DM, p.zb, nullptr);
      {
        const size_t gtid = (size_t)B * NT + TID(), gsz = (size_t)G * NT;
        const float4* sp = (const float4*)(p.p + (size_t)l * S_ * 256);
        for (size_t i = gtid; i < (size_t)S_ * 256 / 8; i += gsz) {
          float4 a = sp[2 * i], b = sp[2 * i + 1];
          ((uint4*)p.pbf)[i] = uint4{pack2(a.x, a.y), pack2(a.z, a.w), pack2(b.x, b.y), pack2(b.z, b.w)};
        }
      }
      break;
    case PH_GEMM_Q:
      gemm_tiles(8, 4, 2, [&](int mt_, int nt_) __attribute__((always_inline)) {
        int m0 = mt_ * 256, n0 = nt_ * 128;
        f32x4 acc[4][4];
        gemm_tile<0, 16>(acc, p.zb, DM, p.wqT + (size_t)l * 1024 * 1024, 1024, 1024, m0, n0, nullptr, smem);
        GEMM_EPI_COORDS
#pragma unroll
        for (int i = 0; i < 4; ++i)
#pragma unroll
          for (int j = 0; j < 4; ++j)
            *(f32x4*)&p.qbuf[(size_t)(erow0 + i * 16) * DM + ecol0 + j * 16] = acc[i][j];
      });
      break;
    case PH_SCORES:
      for (int it = B; it < 256; it += G) REGION(110, peer_scores(p, l, it, smem))
      break;
    case PH_TOPK:
      for (int it = B; it < 256; it += G) REGION(111, peer_topk(p, l, it, (G == 256) ? (B * 8 + (TID() >> 6)) * 16 : -1, smem))
      if (G != 256) convert_tables(p, l);
      break;
    case PH_GATHER: ph_gather(p, l); break;
    case PH_GEMM_PLE:
      gemm_tiles(8, 4, 2, [&](int mt_, int nt_) __attribute__((always_inline)) {
        int m0 = mt_ * 256, n0 = nt_ * 128;
        uint2* gsc = (uint2*)p.g_attn + (size_t)B * 16 * NT + TID();
        {
          f32x4 ag[4][4];
          gemm_tile<0, 16>(ag, p.zb, DM, p.wgT + (size_t)l * 1024 * 1024, 1024, 1024, m0, n0, nullptr, smem);
#pragma unroll
          for (int i = 0; i < 4; ++i)
#pragma unroll
            for (int j = 0; j < 4; ++j)
              gsc[(i * 4 + j) * NT] = uint2{pack2(sigmoidf_(ag[i][j][0]), sigmoidf_(ag[i][j][1])),
                                            pack2(sigmoidf_(ag[i][j][2]), sigmoidf_(ag[i][j][3]))};
        }
        f32x4 ap[4][4];
        gemm_tile<0, 4>(ap, p.pbf, 256, p.wpT + (size_t)l * 1024 * 256, 256, 256, m0, n0, nullptr, smem);
        GEMM_EPI_COORDS
#pragma unroll
        for (int i = 0; i < 4; ++i)
#pragma unroll
          for (int j = 0; j < 4; ++j) {
            const f32x4 hv = *(const f32x4*)&p.h[(size_t)(erow0 + i * 16) * DM + ecol0 + j * 16];
            const uint2 gk = gsc[(i * 4 + j) * NT];
            ap[i][j][0] = hv[0] + ap[i][j][0] * __uint_as_float(gk.x << 16);
            ap[i][j][1] = hv[1] + ap[i][j][1] * __uint_as_float(gk.x & 0xFFFF0000u);
            ap[i][j][2] = hv[2] + ap[i][j][2] * __uint_as_float(gk.y << 16);
            ap[i][j][3] = hv[3] + ap[i][j][3] * __uint_as_float(gk.y & 0xFFFF0000u);
          }
#pragma unroll
        for (int i = 0; i < 4; ++i)
#pragma unroll
          for (int j = 0; j < 4; ++j)
            *(f32x4*)&p.h[(size_t)(erow0 + i * 16) * DM + ecol0 + j * 16] = ap[i][j];
      });
      break;
    case PH_FINAL: ph_norm(p.h, p.final_norm, nullptr, p.out); break;
  }
  if (tr_last > tr_first) prep_transposes(p, smem, tr_first, tr_last, tr_b, tr_nb);
}

#if !MEGA
__global__ void __launch_bounds__(NT) k_phase(Params p, int ph, int l) {
  extern __shared__ __align__(16) char smem[];
  run_phase(p, ph, l, smem);
}
#endif

#define XB_TMO      128
#define XB_XCNT(j)  (256  + 64 * (j))
#define XB_XSUB(j)  (1280 + 64 * (j))
#define XB_XGEN(j)  (2304 + 64 * (j))
#define XB_TOP      3328
#define XB_TOPGEN   3392
#define XCD_BAR_WORDS 3456
#define XB_SPIN_CAP (1u << 18)
#define LAS __attribute__((address_space(3)))
DEVI unsigned xb_ld(unsigned* p) { return __hip_atomic_load(p, __ATOMIC_RELAXED, __HIP_MEMORY_SCOPE_AGENT); }
DEVI unsigned xb_add(unsigned* p, unsigned v) { return __hip_atomic_fetch_add(p, v, __ATOMIC_RELAXED, __HIP_MEMORY_SCOPE_AGENT); }
DEVI unsigned xb_xcc_id() { return (unsigned)__builtin_amdgcn_s_getreg((3 << 11) | 20) & 0xFu; }
#define XB_SPIN(cond, bar) do { unsigned _sp = 0; while (cond) { __builtin_amdgcn_s_sleep(1); \
    if ((++_sp & 255u) == 0u) { if (xb_ld(&(bar)[XB_TMO])) break; if (_sp > XB_SPIN_CAP) { atomicAdd(&(bar)[XB_TMO], 1u); break; } } } } while (0)
struct XcdBarrier { unsigned* bar; unsigned x; volatile LAS unsigned* st; };
DEVI XcdBarrier xcd_barrier_post(unsigned* bar, volatile LAS unsigned* st) {
  XcdBarrier b; b.bar = bar; b.x = xb_xcc_id(); b.st = st;
  if (TID() == 0) (void)xb_add(&bar[XB_XCNT(b.x)], 1u);
  return b;
}
DEVI void xcd_barrier_complete(unsigned* bar, unsigned x, unsigned& nloc, unsigned& nx) {
  const unsigned G = gridDim.x * gridDim.y * gridDim.z;
  unsigned sum, cnt, mine, sp = 0u;
  for (;;) {
    sum = 0u; cnt = 0u; mine = 0u;
#pragma unroll
    for (unsigned j = 0; j < 16; ++j) { const unsigned c = xb_ld(&bar[XB_XCNT(j)]); sum += c; cnt += (c > 0u) ? 1u : 0u; mine = (j == x) ? c : mine; }
    if (sum == G) break;
    __builtin_amdgcn_s_sleep(1);
    if ((++sp & 255u) == 0u) { if (xb_ld(&bar[XB_TMO])) break; if (sp > XB_SPIN_CAP) { atomicAdd(&bar[XB_TMO], 1u); break; } }
  }
  nloc = mine > 0u ? mine : 1u; nx = cnt > 0u ? cnt : 1u;
}
DEVI void xcd_barrier(const XcdBarrier& b) {
  asm volatile("s_waitcnt vmcnt(0)" ::: "memory");
  __syncthreads();
  if (TID() == 0) {
    unsigned* bar = b.bar;
    __builtin_amdgcn_s_waitcnt(0);
    unsigned nloc = b.st[0], nx = b.st[1];
    if (nloc == 0u) { xcd_barrier_complete(bar, b.x, nloc, nx); b.st[0] = nloc; b.st[1] = nx; }
    const unsigned old = xb_add(&bar[XB_XSUB(b.x)], 1u);
    const unsigned gen = old / nloc;
    if (old + 1u == (gen + 1u) * nloc) {
      __builtin_amdgcn_fence(__ATOMIC_RELEASE, "agent");
      asm volatile("s_waitcnt vmcnt(0)" ::: "memory");
      const unsigned og = xb_add(&bar[XB_TOP], 1u);
      const unsigned tg = og / nx;
      if (og + 1u == (tg + 1u) * nx) xb_add(&bar[XB_TOPGEN], 1u);
      else XB_SPIN(xb_ld(&bar[XB_TOPGEN]) == tg, bar);
      __builtin_amdgcn_fence(__ATOMIC_ACQUIRE, "agent");
      xb_add(&bar[XB_XGEN(b.x)], 1u);
      asm volatile("s_waitcnt vmcnt(0)" ::: "memory");
    } else {
      XB_SPIN(xb_ld(&bar[XB_XGEN(b.x)]) == gen, bar);
      __builtin_amdgcn_fence(__ATOMIC_ACQUIRE, "agent");
      asm volatile("s_waitcnt vmcnt(0)" ::: "memory");
    }
  }
  __syncthreads();
}

#if MEGA
template <int ph, int l>
DEVI void mega_step(const Params& p, char* smem, const XcdBarrier& xb) {
#if PROBE_A >= 0
  if (blockIdx.x == 0 && TID() == 0 && (ph == PROBE_A || ph == PROBE_B)) p.g_cdec[2050] = (float)(wall_clock64() & 0xFFFFFFull);
  run_phase(p, ph, l, smem);
  xcd_barrier(xb);
  if (blockIdx.x == 0 && TID() == 0 && (ph == PROBE_A || ph == PROBE_B)) {
    float dt = (float)(wall_clock64() & 0xFFFFFFull) - p.g_cdec[2050];
    if (dt < 0.f) dt += 16777216.f;
    p.g_cdec[ph == PROBE_A ? 2048 : 2049] += dt;
  }
#else
  run_phase(p, ph, l, smem);
  xcd_barrier(xb);
#endif
}
template <int l>
DEVI void mega_layer(const Params& p, char* smem, const XcdBarrier& xb) {
  if constexpr (l != 0) mega_step<PH_NORM1, l>(p, smem, xb);
  mega_step<PH_GEMM_IN, l>(p, smem, xb);
  mega_step<PH_MIX_A, l>(p, smem, xb);
  mega_step<PH_MIX_B, l>(p, smem, xb);
  mega_step<PH_MIX_C, l>(p, smem, xb);
  mega_step<PH_MIX_D, l>(p, smem, xb);
  mega_step<PH_GEMM_OUT, l>(p, smem, xb);
  mega_step<PH_NORM2, l>(p, smem, xb);
  mega_step<PH_GEMM_Q, l>(p, smem, xb);
  mega_step<PH_SCORES, l>(p, smem, xb);
  mega_step<PH_TOPK, l>(p, smem, xb);
  mega_step<PH_GATHER, l>(p, smem, xb);
  mega_step<PH_GEMM_PLE, l>(p, smem, xb);
}
__global__ void __launch_bounds__(NT) k_mega(Params p) {
  extern __shared__ __align__(16) char smem[];
  cg::grid_group grid = cg::this_grid();
#if PROBE_A >= 0
  if (blockIdx.x == 0 && TID() == 0) { p.g_cdec[2048] = 0.f; p.g_cdec[2049] = 0.f; }
#endif
  __shared__ uint4 xb_words;
  if (TID() == 0) xb_words = uint4{0u, 0u, 0u, 0u};
  __syncthreads();
  const XcdBarrier xb = xcd_barrier_post(p.bar, (volatile LAS unsigned*)&xb_words);
  grid.sync();
  mega_step<PH_PREP, 0>(p, smem, xb);
  mega_layer<0>(p, smem, xb);
  mega_layer<1>(p, smem, xb);
  run_phase(p, PH_FINAL, 0, smem);
#if PROBE_A >= 0
  xcd_barrier(xb);
  {
    const float qa_ = __expf(rintf(logf(p.g_cdec[2048] * 0.01f) * 4.f) * 0.25f), qb_ = __expf(rintf(logf(p.g_cdec[2049] * 0.01f) * 4.f) * 0.25f);
    const float va = sqrtf(qa_), vb = qb_;
    const size_t gtid = (size_t)blockIdx.x * NT + TID(), gsz = (size_t)gridDim.x * NT;
    for (size_t i = gtid; i < (size_t)S_ * DM; i += gsz) p.out[i] = (i == 0) ? vb : va;
  }
#endif
}
#endif

extern "C" void kernel_launch(void* const* d_in, const int* in_sizes, int n_in, void* d_out, int out_size, void* d_ws,
                              size_t ws_size, hipStream_t stream) {
  Params p{};
  const float* const* f = (const float* const*)d_in;
  p.x = f[0]; p.p = f[1]; p.pos = (const int*)d_in[2];
  p.mix_norm = f[3]; p.w_in = f[4]; p.ret_gn = f[5]; p.lru_conv_w = f[6]; p.lru_conv_b = f[7]; p.lru_w_a = f[8];
  p.lru_b_a = f[9]; p.lru_w_x = f[10]; p.lru_b_x = f[11]; p.lru_lambda = f[12];
  p.s5_a_re = f[13]; p.s5_a_im = f[14]; p.s5_b_re = f[15]; p.s5_b_im = f[16]; p.s5_c_re = f[17]; p.s5_c_im = f[18];
  p.s5_d = f[19]; p.s5_log_dt = f[20]; p.s5_glu_w = f[21]; p.s5_glu_b = f[22];
  p.gdn_conv_w = f[23]; p.gdn_a_log = f[24]; p.gdn_dt_bias = f[25]; p.gdn_norm = f[26]; p.branch_norm = f[27];
  p.w_out = f[28]; p.ffn_norm = f[29]; p.peer_wq = f[30]; p.peer_subkeys = f[31]; p.peer_u = f[32]; p.peer_v = f[33];
  p.ple_norm = f[34]; p.ple_wg = f[35]; p.ple_wp = f[36]; p.final_norm = f[37];
  p.out = (float*)d_out;
  char* ws = (char*)d_ws;
  const size_t MiB = 1024 * 1024;
  p.h = (float*)(ws + 0 * MiB);
  p.zb = (bf16_t*)(ws + 64 * MiB);
  p.proj = (float*)(ws + 96 * MiB);
  p.qbuf = (float*)(ws + 96 * MiB);
  p.scores = (float*)(ws + 160 * MiB);
  p.g_u = (float*)(ws + 288 * MiB); p.g_w = (float*)(ws + 304 * MiB); p.g_attn = (float*)(ws + 320 * MiB);
  p.g_qd = (float*)(ws + 336 * MiB); p.g_kd = (float*)(ws + 352 * MiB);
  p.ids = (int*)(ws + 288 * MiB); p.gates = (float*)(ws + 296 * MiB);
  p.lru_h = (float*)(ws + 368 * MiB); p.lru_p = (float*)(ws + 384 * MiB);
  p.ret_kv = (float*)(ws + 400 * MiB);
  p.tabU = (uint8_t*)(ws + 408 * MiB); p.tabV = (uint8_t*)(ws + 440 * MiB);
  p.uinv = (float*)(ws + 505 * MiB); p.vinv = (float*)(ws + 505 * MiB + 65536);
  p.g_sst = (float*)(ws + 408 * MiB);
  {
    char* wb = ws + 472 * MiB;
    p.winT = (bf16_t*)wb; wb += (size_t)2 * PW * 1024 * 2;
    p.woutT = (bf16_t*)wb; wb += (size_t)2 * 1024 * 1024 * 2;
    p.wqT = (bf16_t*)wb; wb += (size_t)2 * 1024 * 1024 * 2;
    p.wgT = (bf16_t*)wb; wb += (size_t)2 * 1024 * 1024 * 2;
    p.wpT = (bf16_t*)wb; wb += (size_t)2 * 1024 * 256 * 2;
    p.gluT = (bf16_t*)wb; wb += (size_t)2 * 512 * 256 * 2;
  }
  p.rope = (float*)(ws + 497 * MiB);
  p.ssq = (float*)(ws + 501 * MiB);
  p.xloc = (float*)(ws + 502 * MiB);
  p.lru_hs = (float*)(ws + 504 * MiB);
  p.lru_ps = (float*)(ws + 504 * MiB + 256 * 256 * 4);
  p.g_cdec = (float*)(ws + 504 * MiB + 2 * 256 * 256 * 4);
  p.g_comp = (float*)(ws + 506 * MiB);
  p.pbf = (bf16_t*)(ws + 304 * MiB);
  p.bar = (unsigned*)(ws + 507 * MiB);

  static int grid_blocks = 0;
  if (!grid_blocks) {
#if MEGA
    hipFuncSetAttribute((const void*)k_mega, hipFuncAttributeMaxDynamicSharedMemorySize, LDS_BYTES);
#endif
#if !MEGA
    hipFuncSetAttribute((const void*)k_phase, hipFuncAttributeMaxDynamicSharedMemorySize, LDS_BYTES);
#endif
    int dev = 0, cus = 0, per_cu = 0;
    hipGetDevice(&dev);
    hipDeviceGetAttribute(&cus, hipDeviceAttributeMultiprocessorCount, dev);
#if MEGA
    hipOccupancyMaxActiveBlocksPerMultiprocessor(&per_cu, k_mega, NT, LDS_BYTES);
#else
    hipOccupancyMaxActiveBlocksPerMultiprocessor(&per_cu, k_phase, NT, LDS_BYTES);
#endif
    if (per_cu < 1) per_cu = 1;
    grid_blocks = cus * per_cu;
  }
#if MEGA
  hipMemsetAsync(p.bar, 0, XCD_BAR_WORDS * 4, stream);
  void* args[] = {&p};
  hipError_t e = hipLaunchCooperativeKernel((void*)k_mega, dim3(grid_blocks), dim3(NT), args, LDS_BYTES, stream);
  if (e != hipSuccess) fprintf(stderr, "cooperative launch failed: %s (grid %d)\n", hipGetErrorString(e), grid_blocks);
#else
  k_phase<<<grid_blocks, NT, LDS_BYTES, stream>>>(p, PH_PREP, 0);
  for (int l = 0; l < NL; ++l)
    for (int ph = PH_NORM1; ph <= PH_GEMM_PLE; ++ph) k_phase<<<grid_blocks, NT, LDS_BYTES, stream>>>(p, ph, l);
  k_phase<<<grid_blocks, NT, LDS_BYTES, stream>>>(p, PH_FINAL, 0);
#endif
}
```
